# Optimizing an MI355X kernel written in HIP

```python
import math
import jax, jax.numpy as jnp
from jax import lax
import numpy as np

D_MODEL = 1024
BATCH = 4
SEQ = 8192
DEPTH = 2

CHUNK = 64
N_MEM = 256
BRANCH_W = 256
N_BRANCH = 4
D_A = BRANCH_W
CONV_W = 3
D_B = BRANCH_W
SG_BLOCK = 128
SG_GROUPS = 4
RW_HEADS = 4
RW_HEAD_DIM = 64
D_C = RW_HEADS * RW_HEAD_DIM
RW_DECAY_LORA = 64
RW_AAA_LORA = 64
RW_GATE_LORA = 128
RW_IN = 3 * D_C + RW_DECAY_LORA + RW_AAA_LORA + RW_GATE_LORA
RW_LN_EPS = 64e-5
D_S = BRANCH_W
S5_CH = 16
S5_GROUPS = D_S // S5_CH
S5_STATE = 64
OFF_B = 3 * D_A
OFF_C = OFF_B + 2 * D_B
OFF_D = OFF_C + RW_IN
OFF_G = OFF_D + D_S
N_IN = OFF_G + N_BRANCH * D_MODEL
XA_HEADS = 4
XA_HEAD_DIM = D_MODEL // XA_HEADS
N_EXPERTS = 32
TOP_K = 4
D_FF = D_MODEL
SWIGLU_LIMIT = 7.0
SWIGLU_ALPHA = 1.702
MOE_BLOCK = 512
LN_EPS = 1e-5
DN_ALPHA = (2 * DEPTH) ** 0.25
DN_BETA = (8 * DEPTH) ** -0.25

kernel_name = "hybrid_chunk_causal_gated_branch_moe_encoder"


def layer_norm(x, g, b, eps=LN_EPS):
    xf = x.astype(jnp.float32)
    mu = xf.mean(-1, keepdims=True)
    var = jnp.square(xf - mu).mean(-1, keepdims=True)
    y = (xf - mu) * lax.rsqrt(var + eps)
    return (y * g.astype(jnp.float32) + b.astype(jnp.float32)).astype(x.dtype)


def shift_time(z, n=1):
    return jnp.pad(z, ((0, 0), (n, 0), (0, 0)))[:, :z.shape[1]]


def short_conv_mixer(z, conv_w):
    b_gate, c_gate, hin = jnp.split(z, 3, axis=-1)
    ch = c_gate * hin
    y = conv_w[CONV_W - 1] * ch
    for i in range(CONV_W - 1):
        y = y + conv_w[i] * shift_time(ch, CONV_W - 1 - i)
    return b_gate * y


def spatial_gating_mixer(z, norm_g, norm_b, w_s, b_s):
    u, v = jnp.split(z, 2, axis=-1)
    v = layer_norm(v, norm_g, norm_b)
    B_, S_, _ = v.shape
    nb = S_ // SG_BLOCK
    v = v.reshape(B_, nb, SG_BLOCK, SG_GROUPS, D_B // SG_GROUPS)
    pos = jnp.arange(SG_BLOCK)
    mask = (pos[None, :] // CHUNK) <= (pos[:, None] // CHUNK)
    w = jnp.where(mask[None], w_s, 0)
    sv = jnp.einsum('gij,bnjgc->bnigc', w, v) + b_s.T[None, None, :, :, None]
    return u * sv.reshape(B_, S_, D_B)


def rwkv7_mixer(z, mu, w0, w_up, a0, a_up, g_up, k_k, k_a, r_k, ln_g, ln_b):
    B_, S_, _ = z.shape
    f32 = jnp.float32
    z = z + (shift_time(z) - z) * mu
    r, k, v, xw, xa, xg = jnp.split(
        z, [D_C, 2 * D_C, 3 * D_C, 3 * D_C + RW_DECAY_LORA,
            3 * D_C + RW_DECAY_LORA + RW_AAA_LORA], axis=-1)
    w = -jax.nn.softplus(-(w0 + jnp.tanh(xw) @ w_up)) - 0.5
    decay = jnp.exp(-jnp.exp(w.astype(f32)))
    a = jax.nn.sigmoid(a0 + xa @ a_up)
    g = jax.nn.sigmoid(xg) @ g_up
    kk = k * k_k
    k = k * (1.0 + (a - 1.0) * k_a)

    def heads(t):
        return t.astype(f32).reshape(B_, S_, RW_HEADS, RW_HEAD_DIM)

    r, k, v, kk, a, decay = (heads(t) for t in (r, k, v, kk, a, decay))
    kk = kk / jnp.maximum(jnp.linalg.norm(kk, axis=-1, keepdims=True), 1e-12)

    def step(state, inp):
        r_t, w_t, k_t, v_t, kk_t, a_t = inp
        sa = jnp.einsum('bhvk,bhk->bhv', state, -kk_t)
        state = (state * w_t[:, :, None, :]
                 + sa[..., None] * (kk_t * a_t)[:, :, None, :]
                 + v_t[..., None] * k_t[:, :, None, :])
        y_t = jnp.einsum('bhvk,bhk->bhv', state, r_t)
        return state, y_t

    xs = tuple(jnp.moveaxis(t, 1, 0) for t in (r, decay, k, v, kk, a))
    state0 = jnp.zeros((B_, RW_HEADS, RW_HEAD_DIM, RW_HEAD_DIM), f32)
    _, y = lax.scan(step, state0, xs)
    y = jnp.moveaxis(y, 0, 1)
    m = y.mean(-1, keepdims=True)
    var = jnp.square(y - m).mean(-1, keepdims=True)
    yn = ((y - m) * lax.rsqrt(var + RW_LN_EPS)).reshape(B_, S_, D_C)
    yn = yn * ln_g.astype(f32) + ln_b.astype(f32)
    bonus = (jnp.sum(r * k * r_k.astype(f32), -1, keepdims=True) * v).reshape(B_, S_, D_C)
    return ((yn + bonus) * g.astype(f32)).astype(z.dtype)


def _complex_affine_combine(e1, e2):
    a1r, a1i, b1r, b1i = e1
    a2r, a2i, b2r, b2i = e2
    return (a2r * a1r - a2i * a1i,
            a2r * a1i + a2i * a1r,
            a2r * b1r - a2i * b1i + b2r,
            a2r * b1i + a2i * b1r + b2i)


def s5_mixer(u, a_re, a_im, b_re, b_im, c_re, c_im, d, log_dt, glu_w, glu_b):
    B_, S_, _ = u.shape
    f32 = jnp.float32
    a_re, a_im, b_re, b_im, c_re, c_im = (p.astype(f32) for p in (a_re, a_im, b_re, b_im, c_re, c_im))
    uf = u.astype(f32)
    dt = jnp.exp(log_dt.astype(f32))[:, None]
    mag = jnp.exp(a_re * dt)
    abar_re = mag * jnp.cos(a_im * dt)
    abar_im = mag * jnp.sin(a_im * dt)
    den = a_re * a_re + a_im * a_im
    num_re = abar_re - 1.0
    coef_re = (num_re * a_re + abar_im * a_im) / den
    coef_im = (abar_im * a_re - num_re * a_im) / den
    bbar_re = coef_re[..., None] * b_re - coef_im[..., None] * b_im
    bbar_im = coef_re[..., None] * b_im + coef_im[..., None] * b_re
    ug = uf.reshape(B_, S_, S5_GROUPS, S5_CH)
    bu_re = jnp.einsum('gpc,bsgc->bsgp', bbar_re, ug)
    bu_im = jnp.einsum('gpc,bsgc->bsgp', bbar_im, ug)
    shp = (1, S_, S5_GROUPS, S5_STATE)
    elems = (jnp.broadcast_to(abar_re, shp), jnp.broadcast_to(abar_im, shp), bu_re, bu_im)
    _, _, x_re, x_im = lax.associative_scan(_complex_affine_combine, elems, axis=1)
    y = jnp.einsum('gcp,bsgp->bsgc', c_re, x_re) - jnp.einsum('gcp,bsgp->bsgc', c_im, x_im)
    y = y.reshape(B_, S_, D_S) + d.astype(f32) * uf
    y = jax.nn.gelu(y)
    y = y * jax.nn.sigmoid(y @ glu_w.astype(f32) + glu_b.astype(f32))
    return y.astype(u.dtype)


def memory_cross_attention(h, mem, wq, wk, wv, wo):
    B_, S_, _ = h.shape
    M_ = mem.shape[1]
    q = (h @ wq).reshape(B_, S_, XA_HEADS, XA_HEAD_DIM)
    k = (mem @ wk).reshape(B_, M_, XA_HEADS, XA_HEAD_DIM)
    v = (mem @ wv).reshape(B_, M_, XA_HEADS, XA_HEAD_DIM)
    s = jnp.einsum('bshd,bmhd->bhsm', q.astype(jnp.float32), k.astype(jnp.float32))
    p = jax.nn.softmax(s * (XA_HEAD_DIM ** -0.5), axis=-1).astype(v.dtype)
    o = jnp.einsum('bhsm,bmhd->bshd', p, v).reshape(B_, S_, D_MODEL)
    return o @ wo


def moe_ffn(h, router_w, router_b, w1, b1, w2, b2):
    B_, S_, D_ = h.shape
    t = h.reshape(B_ * S_, D_)
    n_tok = t.shape[0]
    n_asg = n_tok * TOP_K
    logits = (t @ router_w + router_b).astype(jnp.float32)
    top_val, top_idx = lax.top_k(logits, TOP_K)
    top_w = jax.nn.softmax(top_val, axis=-1)
    flat_e = top_idx.reshape(-1)
    order = jnp.argsort(flat_e)
    sorted_e = flat_e[order]
    counts = jnp.bincount(flat_e, length=N_EXPERTS)
    padded = (counts + MOE_BLOCK - 1) // MOE_BLOCK * MOE_BLOCK
    pad_end = jnp.cumsum(padded)
    pad_start = pad_end - padded
    grp_start = jnp.cumsum(counts) - counts
    dest = pad_start[sorted_e] + jnp.arange(n_asg) - grp_start[sorted_e]
    n_blocks = -(-n_asg // MOE_BLOCK) + N_EXPERTS
    n_slots = n_blocks * MOE_BLOCK
    slot_tok = jnp.full((n_slots,), n_tok, jnp.int32).at[dest].set((order // TOP_K).astype(jnp.int32))
    slot_w = jnp.zeros((n_slots,), jnp.float32).at[dest].set(top_w.reshape(-1)[order])
    blk_e = jnp.minimum(jnp.searchsorted(pad_end, jnp.arange(n_blocks) * MOE_BLOCK, side='right'),
                        N_EXPERTS - 1)
    t_pad = jnp.concatenate([t, jnp.zeros((1, D_), t.dtype)], axis=0)
    xb = t_pad[slot_tok].reshape(n_blocks, MOE_BLOCK, D_)

    def expert_block(args):
        xblk, e = args
        hid = xblk @ w1[e] + b1[e]
        gate = jnp.minimum(hid[:, 0::2], SWIGLU_LIMIT)
        up = jnp.clip(hid[:, 1::2], -SWIGLU_LIMIT, SWIGLU_LIMIT)
        act = (up + 1.0) * gate * jax.nn.sigmoid(SWIGLU_ALPHA * gate)
        return act @ w2[e] + b2[e]

    yb = lax.map(expert_block, (xb, blk_e))
    y = (yb.reshape(n_slots, D_).astype(jnp.float32) * slot_w[:, None]).astype(t.dtype)
    out = jnp.zeros((n_tok + 1, D_), t.dtype).at[slot_tok].add(y)[:n_tok]
    return out.reshape(B_, S_, D_)


def setup_inputs(seed: int = 0) -> dict:
    key = jax.random.key(seed)
    keys = jax.random.split(key, 64)
    counter = [0]

    def nk():
        k = keys[counter[0]]
        counter[0] += 1
        return k

    def nrm(shape, scale):
        return jax.random.normal(nk(), shape, jnp.float32) * scale

    def unif(shape, lo, hi):
        return jax.random.uniform(nk(), shape, jnp.float32, lo, hi)

    L, D = DEPTH, D_MODEL
    inp = {}
    inp["x"] = nrm((BATCH, SEQ, D), 1.0)
    inp["mem"] = nrm((BATCH, N_MEM, D), 1.0)
    inp["ln_in_g"] = 1.0 + nrm((D,), 0.02)
    inp["ln_in_b"] = nrm((D,), 0.02)
    inp["w_in"] = nrm((L, D, N_IN), D ** -0.5)
    inp["conv_w"] = nrm((L, CONV_W, D_A), CONV_W ** -0.5)
    inp["sg_norm_g"] = 1.0 + nrm((L, D_B), 0.02)
    inp["sg_norm_b"] = nrm((L, D_B), 0.02)
    inp["sg_w"] = nrm((L, SG_GROUPS, SG_BLOCK, SG_BLOCK), SG_BLOCK ** -0.5)
    inp["sg_b"] = 1.0 + nrm((L, SG_GROUPS, SG_BLOCK), 0.02)
    inp["rw_mu"] = unif((L, RW_IN), 0.0, 1.0)
    inp["rw_w0"] = unif((L, D_C), -6.5, -1.0)
    inp["rw_w_up"] = nrm((L, RW_DECAY_LORA, D_C), 0.1)
    inp["rw_a0"] = nrm((L, D_C), 0.1)
    inp["rw_a_up"] = nrm((L, RW_AAA_LORA, D_C), 0.1)
    inp["rw_g_up"] = nrm((L, RW_GATE_LORA, D_C), RW_GATE_LORA ** -0.5)
    inp["rw_k_k"] = 0.85 + nrm((L, D_C), 0.02)
    inp["rw_k_a"] = 1.0 + nrm((L, D_C), 0.02)
    inp["rw_r_k"] = nrm((L, RW_HEADS, RW_HEAD_DIM), 0.1)
    inp["rw_ln_g"] = 1.0 + nrm((L, D_C), 0.02)
    inp["rw_ln_b"] = nrm((L, D_C), 0.02)
    inp["s5_a_re"] = -0.5 + nrm((L, S5_GROUPS, S5_STATE), 0.01)
    inp["s5_a_im"] = (jnp.pi * jnp.arange(S5_STATE, dtype=jnp.float32))[None, None, :] + nrm((L, S5_GROUPS, S5_STATE), 0.01)
    inp["s5_b_re"] = nrm((L, S5_GROUPS, S5_STATE, S5_CH), (2 * S5_CH) ** -0.5)
    inp["s5_b_im"] = nrm((L, S5_GROUPS, S5_STATE, S5_CH), (2 * S5_CH) ** -0.5)
    inp["s5_c_re"] = nrm((L, S5_GROUPS, S5_CH, S5_STATE), (2 * S5_STATE) ** -0.5)
    inp["s5_c_im"] = nrm((L, S5_GROUPS, S5_CH, S5_STATE), (2 * S5_STATE) ** -0.5)
    inp["s5_d"] = nrm((L, D_S), 1.0)
    inp["s5_log_dt"] = unif((L, S5_GROUPS), math.log(1e-3), math.log(1e-1))
    inp["s5_glu_w"] = nrm((L, D_S, D_S), D_S ** -0.5)
    inp["s5_glu_b"] = nrm((L, D_S), 0.02)
    inp["br_proj"] = nrm((L, N_BRANCH, BRANCH_W, D), BRANCH_W ** -0.5)
    inp["gate_b"] = nrm((L, N_BRANCH, D), 0.02)
    inp["w_out"] = nrm((L, D, D), D ** -0.5 * DN_BETA)
    inp["ln1_g"] = 1.0 + nrm((L, D), 0.02)
    inp["ln1_b"] = nrm((L, D), 0.02)
    inp["xa_wq"] = nrm((L, D, D), D ** -0.5)
    inp["xa_wk"] = nrm((L, D, D), D ** -0.5)
    inp["xa_wv"] = nrm((L, D, D), D ** -0.5)
    inp["xa_wo"] = nrm((L, D, D), D ** -0.5 * DN_BETA)
    inp["ln2_g"] = 1.0 + nrm((L, D), 0.02)
    inp["ln2_b"] = nrm((L, D), 0.02)
    inp["router_w"] = nrm((L, D, N_EXPERTS), D ** -0.5)
    inp["router_b"] = nrm((L, N_EXPERTS), 0.01)
    inp["ex_w1"] = nrm((L, N_EXPERTS, D, 2 * D_FF), D ** -0.5)
    inp["ex_b1"] = nrm((L, N_EXPERTS, 2 * D_FF), 0.01)
    inp["ex_w2"] = nrm((L, N_EXPERTS, D_FF, D), D_FF ** -0.5 * DN_BETA)
    inp["ex_b2"] = nrm((L, N_EXPERTS, D), 0.01)
    inp["ln3_g"] = 1.0 + nrm((L, D), 0.02)
    inp["ln3_b"] = nrm((L, D), 0.02)
    return inp


def reference(x, mem, ln_in_g, ln_in_b, w_in, conv_w, sg_norm_g, sg_norm_b, sg_w, sg_b,
              rw_mu, rw_w0, rw_w_up, rw_a0, rw_a_up, rw_g_up, rw_k_k, rw_k_a, rw_r_k,
              rw_ln_g, rw_ln_b, s5_a_re, s5_a_im, s5_b_re, s5_b_im, s5_c_re, s5_c_im,
              s5_d, s5_log_dt, s5_glu_w, s5_glu_b, br_proj, gate_b, w_out, ln1_g, ln1_b,
              xa_wq, xa_wk, xa_wv, xa_wo, ln2_g, ln2_b, router_w, router_b,
              ex_w1, ex_b1, ex_w2, ex_b2, ln3_g, ln3_b):
    h = layer_norm(x, ln_in_g, ln_in_b)
    for l in range(DEPTH):
        z = h @ w_in[l]
        za, zb, zc, zd, zg = jnp.split(z, [OFF_B, OFF_C, OFF_D, OFF_G], axis=-1)
        o_a = short_conv_mixer(za, conv_w[l])
        o_b = spatial_gating_mixer(zb, sg_norm_g[l], sg_norm_b[l], sg_w[l], sg_b[l])
        o_c = rwkv7_mixer(zc, rw_mu[l], rw_w0[l], rw_w_up[l], rw_a0[l], rw_a_up[l],
                          rw_g_up[l], rw_k_k[l], rw_k_a[l], rw_r_k[l], rw_ln_g[l], rw_ln_b[l])
        o_d = s5_mixer(zd, s5_a_re[l], s5_a_im[l], s5_b_re[l], s5_b_im[l], s5_c_re[l],
                       s5_c_im[l], s5_d[l], s5_log_dt[l], s5_glu_w[l], s5_glu_b[l])
        branches = (o_a, o_b, o_c, o_d)
        gate_pre = jnp.split(zg, N_BRANCH, axis=-1)
        merged = None
        for i in range(N_BRANCH):
            term = jax.nn.sigmoid(gate_pre[i] + gate_b[l, i]) * (branches[i] @ br_proj[l, i])
            merged = term if merged is None else merged + term
        h = layer_norm(DN_ALPHA * h + merged @ w_out[l], ln1_g[l], ln1_b[l])
        h = layer_norm(DN_ALPHA * h + memory_cross_attention(h, mem, xa_wq[l], xa_wk[l],
                                                             xa_wv[l], xa_wo[l]),
                       ln2_g[l], ln2_b[l])
        h = layer_norm(DN_ALPHA * h + moe_ffn(h, router_w[l], router_b[l], ex_w1[l], ex_b1[l],
                                              ex_w2[l], ex_b2[l]),
                       ln3_g[l], ln3_b[l])
    return h
```

```cpp
#include <hip/hip_runtime.h>
#include <cstdio>
#include <cstdint>

#ifndef N_LAUNCHES
#define N_LAUNCHES 1
#endif

#define GAS __attribute__((address_space(1)))
#define LAS __attribute__((address_space(3)))
typedef unsigned short bf16;
typedef unsigned v4u __attribute__((ext_vector_type(4)));
typedef unsigned v2u __attribute__((ext_vector_type(2)));
typedef float f32x4 __attribute__((ext_vector_type(4)));
typedef float f32x2 __attribute__((ext_vector_type(2)));
typedef short bf16x8 __attribute__((ext_vector_type(8)));
typedef short bf16x4 __attribute__((ext_vector_type(4)));

constexpr int NL = 2, NB = 4, SEQ = 8192, T = NB * SEQ, D = 1024;
constexpr int NMEM = 256;
constexpr int OFF_B = 768, OFF_C = 1280, OFF_D = 2304, OFF_G = 2560, N_IN = 6656, ZLD = 2560;
constexpr int NE = 32, TOPK = 4, DFF = 1024;
constexpr int CH = 64;
constexpr int NCH = SEQ / CH;
constexpr int NCHT = T / CH;
constexpr int S5K = 1152;
constexpr int SLOT_ROWS = T * TOPK + NE * 256;
constexpr float LN_EPS = 1e-5f, RW_LN_EPS = 64e-5f;
constexpr float DN_ALPHA = 1.41421356237309515f;

constexpr size_t MiB = 1u << 20;
constexpr size_t WS_CTL = 0, CTL_ZERO_BYTES = 1 * MiB;
constexpr size_t WS_W1T = 2 * MiB;
constexpr size_t WS_W2T = 258 * MiB;
constexpr size_t WS_WINT = 386 * MiB;
constexpr size_t WS_BRT = 412 * MiB;
constexpr size_t WS_WOUTT = 416 * MiB, WS_WQT = 420 * MiB, WS_WKT = 424 * MiB, WS_WVT = 428 * MiB, WS_WOT = 432 * MiB;
constexpr size_t WS_GLUT = 436 * MiB;
constexpr size_t WS_MEM16 = 437 * MiB;
constexpr size_t WS_S5BT = 440 * MiB;
constexpr size_t WS_S5BC = 512 * MiB;
constexpr size_t WS_H32 = 528 * MiB;
constexpr size_t WS_H16 = 656 * MiB;
constexpr size_t WS_Z = 720 * MiB;
constexpr size_t WS_XG = 720 * MiB;
constexpr size_t WS_SG = 1040 * MiB;
constexpr size_t WS_YS = 1040 * MiB;
constexpr size_t WS_O16 = 1312 * MiB, WS_MG16 = 1376 * MiB, WS_Q16 = 1440 * MiB, WS_AO16 = 1504 * MiB;
constexpr size_t WS_RWOP = 1568 * MiB;
constexpr size_t WS_ACT = 1568 * MiB;
constexpr size_t WS_QH = 1760 * MiB, WS_YL = 1792 * MiB, WS_GC = 1824 * MiB, WS_HC = 1856 * MiB, WS_SC = 1888 * MiB, WS_RWG = 1920 * MiB;
constexpr size_t WS_RK = 1952 * MiB;
constexpr size_t WS_AOUT = 1954 * MiB;
constexpr size_t WS_XLOC = 1972 * MiB;
constexpr size_t WS_YD16 = 1976 * MiB;
constexpr size_t WS_KM16 = 1992 * MiB, WS_VMT16 = 1994 * MiB;
constexpr size_t WS_TOKE = 1996 * MiB, WS_TOKW = 1997 * MiB, WS_TOKS = 1998 * MiB, WS_SLOTW = 1999 * MiB;
constexpr size_t WS_END = 2000 * MiB;
static_assert(WS_XG + (size_t)SLOT_ROWS * D * 2 <= WS_SG && WS_YS + (size_t)SLOT_ROWS * D * 2 <= WS_O16 && WS_ACT + (size_t)SLOT_ROWS * D * 2 <= WS_RK, "overlays");
constexpr int CW_BAR = 4096;
constexpr int CW_CNT = 16384;
constexpr int CW_CUR = 16384 + 128;

constexpr int LDS_BYTES = 163840;
constexpr int MISC_OFF = LDS_BYTES - 1024;
constexpr int RING_BYTES = 131072;
constexpr int NWAVES = 8, NTHREADS = 512;

#define LDS_WAIT() asm volatile("s_waitcnt lgkmcnt(0)" ::: "memory")
#define VM_WAIT() asm volatile("s_waitcnt vmcnt(0)" ::: "memory")
__device__ __forceinline__ unsigned f2bf(float f) { unsigned u = __float_as_uint(f); return (u + 0x7fffu + ((u >> 16) & 1u)) >> 16; }
__device__ __forceinline__ unsigned pk2(float lo, float hi) { return f2bf(lo) | (f2bf(hi) << 16); }
__device__ __forceinline__ float bf2f(unsigned h) { return __uint_as_float(h << 16); }
__device__ __forceinline__ float sigmoidf_(float x) { return 1.0f / (1.0f + __expf(-x)); }
__device__ __forceinline__ float wave_sum(float v) {
#pragma unroll
    for (int o = 1; o < 64; o <<= 1) v += __shfl_xor(v, o);
    return v;
}

#define XB_TMO      128
#define XB_XCNT(j)  (256  + 64 * (j))
#define XB_XSUB(j)  (1280 + 64 * (j))
#define XB_XGEN(j)  (2304 + 64 * (j))
#define XB_TOP      3328
#define XB_TOPGEN   3392
#define XCD_BAR_WORDS 3456
#define XB_SPIN_CAP (1u << 24)
__device__ __forceinline__ unsigned xb_ld(unsigned* p)              { return __hip_atomic_load(p, __ATOMIC_RELAXED, __HIP_MEMORY_SCOPE_AGENT); }
__device__ __forceinline__ unsigned xb_add(unsigned* p, unsigned v) { return __hip_atomic_fetch_add(p, v, __ATOMIC_RELAXED, __HIP_MEMORY_SCOPE_AGENT); }
__device__ __forceinline__ unsigned xb_xcc_id() { return (unsigned)__builtin_amdgcn_s_getreg((3 << 11) | 20) & 0xFu; }
#define XB_SPIN(cond, bar) do { unsigned _sp = 0; while (cond) { __builtin_amdgcn_s_sleep(1); \
    if ((++_sp & 255u) == 0u) { if (xb_ld(&(bar)[XB_TMO])) break; if (_sp > XB_SPIN_CAP) { atomicAdd(&(bar)[XB_TMO], 1u); break; } } } } while (0)
struct XcdBarrier { unsigned* bar; unsigned x; volatile LAS unsigned* st; };
__device__ __forceinline__ XcdBarrier xcd_barrier_post(unsigned* bar, volatile LAS unsigned* st) {
    XcdBarrier b; b.bar = bar; b.x = xb_xcc_id(); b.st = st;
    if (threadIdx.x == 0) (void)xb_add(&bar[XB_XCNT(b.x)], 1u);
    return b;
}
__device__ __forceinline__ void xcd_barrier_complete(unsigned* bar, unsigned x, unsigned& nloc, unsigned& nx) {
    const unsigned G = gridDim.x * gridDim.y * gridDim.z;
    unsigned sum, cnt, mine, sp = 0u;
    for (;;) {
        sum = 0u; cnt = 0u; mine = 0u;
#pragma unroll
        for (unsigned j = 0; j < 16; ++j) { const unsigned c = xb_ld(&bar[XB_XCNT(j)]); sum += c; cnt += (c > 0u) ? 1u : 0u; mine = (j == x) ? c : mine; }
        if (sum == G) break;
        __builtin_amdgcn_s_sleep(1);
        if ((++sp & 255u) == 0u) { if (xb_ld(&bar[XB_TMO])) break; if (sp > XB_SPIN_CAP) { atomicAdd(&bar[XB_TMO], 1u); break; } }
    }
    nloc = mine > 0u ? mine : 1u; nx = cnt > 0u ? cnt : 1u;
}
__device__ __forceinline__ void xcd_barrier(const XcdBarrier& b) {
    asm volatile("s_waitcnt vmcnt(0)" ::: "memory");
    __syncthreads();
    if (threadIdx.x == 0) {
        unsigned* bar = b.bar; unsigned bx = b.x;
        asm volatile("" : "+s"(bar), "+s"(bx));
        __builtin_amdgcn_s_waitcnt(0);
        unsigned nloc = b.st[0], nx = b.st[1];
        if (nloc == 0u) { xcd_barrier_complete(bar, bx, nloc, nx); b.st[0] = nloc; b.st[1] = nx; }
        const unsigned old = xb_add(&bar[XB_XSUB(bx)], 1u);
        const unsigned gen = old / nloc;
        if (old + 1u == (gen + 1u) * nloc) {
            __builtin_amdgcn_fence(__ATOMIC_RELEASE, "agent");
            asm volatile("s_waitcnt vmcnt(0)" ::: "memory");
            const unsigned og = xb_add(&bar[XB_TOP], 1u);
            const unsigned tg = og / nx;
            if (og + 1u == (tg + 1u) * nx) xb_add(&bar[XB_TOPGEN], 1u);
            else XB_SPIN(xb_ld(&bar[XB_TOPGEN]) == tg, bar);
            __builtin_amdgcn_fence(__ATOMIC_ACQUIRE, "agent");
            xb_add(&bar[XB_XGEN(bx)], 1u);
            asm volatile("s_waitcnt vmcnt(0)" ::: "memory");
        } else {
            XB_SPIN(xb_ld(&bar[XB_XGEN(bx)]) == gen, bar);
            __builtin_amdgcn_fence(__ATOMIC_ACQUIRE, "agent");
            asm volatile("s_waitcnt vmcnt(0)" ::: "memory");
        }
    }
    __syncthreads();
}

namespace pg8 {
constexpr int BM = 256, BK = 64, HALF = 128, HTB = HALF * BK * 2, STAGE_BYTES = 8 * HTB, NXCD = 8, WGM = 8;
__host__ __device__ __forceinline__ int lds_byte(int r, int c) { const int st = (r >> 4) * 2 + (c >> 5), rr = r & 15, cc = c & 31, ob = rr * 64 + cc * 2; return st * 1024 + (ob ^ (((ob >> 9) & 1) << 5)); }
__host__ __device__ __forceinline__ void stage_rc(int b, int& R, int& C) { const int st = b / 1024, sb = b % 1024, swz = sb ^ (((sb >> 9) & 1) << 5); R = (st >> 1) * 16 + swz / 64; C = (st & 1) * 32 + (swz % 64) / 2; }
struct Unit { int pm, pn, e; };
struct Gemm { int lda, ldb, K; };

__device__ __forceinline__ bool static_tile(int i, int G, int c, int nM, int nN, int& pm, int& pn) {
    const int nwg = nM * nN; const long L = (long)i * G + c; if (L >= nwg) return false;
    int wgid = (int)L; { const int q = nwg / NXCD, r = nwg % NXCD, xcd = wgid % NXCD, off = wgid / NXCD; wgid = (xcd < r ? xcd * (q + 1) : r * (q + 1) + (xcd - r) * q) + off; }
    const int nig = WGM * nN, gid = wgid / nig, fm = gid * WGM, gsz = (nM - fm) < WGM ? (nM - fm) : WGM;
    pm = fm + ((wgid % nig) % gsz); pn = (wgid % nig) / gsz; return true;
}
struct StaticOrder {
    const bf16* A; const bf16* Bt; int lda, ldb, nM, nN, G, c;
    __device__ __forceinline__ bool next(int i, Unit& u) const { u.e = 0; return static_tile(i, G, c, nM, nN, u.pm, u.pn); }
    __device__ __forceinline__ const char* a_base(const Unit& u) const { return (const char*)(A + (size_t)u.pm * BM * lda); }
    __device__ __forceinline__ const char* b_base(const Unit& u) const { return (const char*)(Bt + (size_t)u.pn * BM * ldb); }
};
struct BatchOrder {
    const bf16* A; const bf16* Bt; int lda, ldb, nM, nN, nb, G, c; size_t sA, sB;
    __device__ __forceinline__ bool next(int i, Unit& u) const {
        const long L = (long)i * G + c; const int per = nM * nN; if (L >= (long)per * nb) return false;
        u.e = (int)(L / per); const int r = (int)(L % per); u.pn = r / nM; u.pm = r % nM; return true; }
    __device__ __forceinline__ const char* a_base(const Unit& u) const { return (const char*)(A + (size_t)u.e * sA + (size_t)u.pm * BM * lda); }
    __device__ __forceinline__ const char* b_base(const Unit& u) const { return (const char*)(Bt + (size_t)u.e * sB + (size_t)u.pn * BM * ldb); }
};
struct MoeOrder {
    const bf16* A; const bf16* Bt; int lda, ldb, nN, G, c; size_t sB; const LAS int* toff;
    __device__ __forceinline__ bool next(int i, Unit& u) const {
        const long L = (long)i * G + c; const int nt = toff[NE]; if (L >= (long)nt * nN) return false;
        const int mt = (int)(L / nN); u.pn = (int)(L % nN); u.pm = mt; int e = 0;
#pragma unroll 1
        for (int k = 1; k < NE; ++k) e += (toff[k] <= mt) ? 1 : 0;
        u.e = e; return true; }
    __device__ __forceinline__ const char* a_base(const Unit& u) const { return (const char*)(A + (size_t)u.pm * BM * lda); }
    __device__ __forceinline__ const char* b_base(const Unit& u) const { return (const char*)(Bt + (size_t)u.e * sB + (size_t)u.pn * BM * ldb); }
};

template <class F> __device__ __forceinline__ void epi_foreach(const f32x4 (&acc)[2][2][4][2], const Unit& u, int wr, int wc, int fr, int fq, const F& f) {
#pragma unroll
    for (int ai = 0; ai < 2; ++ai)
#pragma unroll
        for (int m = 0; m < 4; ++m) { const int row = u.pm * BM + ai * HALF + wr * 64 + m * 16 + fr;
#pragma unroll
            for (int bj = 0; bj < 2; ++bj)
#pragma unroll
                for (int n = 0; n < 2; ++n) f(row, u.pn * BM + bj * HALF + wc * 32 + n * 16 + 4 * fq, acc[ai][bj][m][n]); }
}

template <class Epi, class Sched, bool ALIGN_EPI = true, bool SP2 = true>
__device__ __forceinline__ void gemm_phase(LAS unsigned char* lds, const int tid, const Gemm g, const Sched& S, const Epi& E) {
    const int wid = __builtin_amdgcn_readfirstlane(tid >> 6), lane = tid & 63, wr = wid >> 2, wc = wid & 3, fr = lane & 15, fq = lane >> 4;
    const int K = g.K, nt = K / BK;
    unsigned voffA[2], voffB[2];
#pragma unroll
    for (int i = 0; i < 2; ++i) { int R, C; stage_rc(tid * 16 + i * 8192, R, C);
        voffA[i] = (unsigned)(R * g.lda + C) * 2u; voffB[i] = (unsigned)(R * g.ldb + C) * 2u; }
    const size_t kstep = (size_t)(BK * 2);
    const size_t hstepA = (size_t)HALF * g.lda * 2, hstepB = (size_t)HALF * g.ldb * 2;
    const unsigned ldsw = (unsigned)wid * 1024u;
    const int aoff = lds_byte(wr * 64 + fr, fq * 8), boff = lds_byte(wc * 32 + fr, fq * 8);
#define PG8_SA(b, h) (((b) * 2 + (h)) * HTB)
#define PG8_SB(b, h) ((4 + (b) * 2 + (h)) * HTB)
#define PG8_STAGE(bufoff, gbase, voff) do { _Pragma("unroll") for (int _i = 0; _i < 2; ++_i) \
        __builtin_amdgcn_global_load_lds((const unsigned*)((const char*)(gbase) + (voff)[_i]), (LAS unsigned*)(lds + (bufoff) + ldsw + _i * 8192), 16, 0, 0); } while (0)
#define PG8_LDA(dst, b, h) do { _Pragma("unroll") for (int m = 0; m < 4; ++m) _Pragma("unroll") for (int k = 0; k < 2; ++k) dst[m][k] = *(const LAS bf16x8*)(lds + PG8_SA(b, h) + aoff + m * 2048 + k * 1024); } while (0)
#define PG8_LDB(dst, b, h) do { _Pragma("unroll") for (int n = 0; n < 2; ++n) _Pragma("unroll") for (int k = 0; k < 2; ++k) dst[n][k] = *(const LAS bf16x8*)(lds + PG8_SB(b, h) + boff + n * 2048 + k * 1024); } while (0)
#define PG8_MMA(ai, bj, At, Bt) do { __builtin_amdgcn_s_setprio(1); _Pragma("unroll") for (int m = 0; m < 4; ++m) _Pragma("unroll") for (int n = 0; n < 2; ++n) _Pragma("unroll") for (int k = 0; k < 2; ++k) \
        acc[ai][bj][m][n] = __builtin_amdgcn_mfma_f32_16x16x32_bf16(Bt[n][k], At[m][k], acc[ai][bj][m][n], 0, 0, 0); __builtin_amdgcn_s_setprio(0); } while (0)
#define PG8_WAIT_V(n) asm volatile("s_waitcnt vmcnt(" #n ")" ::: "memory")
#define PG8_WAIT_L(n) asm volatile("s_waitcnt lgkmcnt(" #n ")" ::: "memory")
#define PG8_BAR __builtin_amdgcn_s_barrier()
#define PG8_SCHED __builtin_amdgcn_sched_barrier(0)
    Unit cur, nxt; int ui = 0;
    if (!S.next(0, cur)) return;
    f32x4 acc[2][2][4][2];
#pragma unroll
    for (int a = 0; a < 2; ++a)
#pragma unroll
        for (int b = 0; b < 2; ++b)
#pragma unroll
            for (int m = 0; m < 4; ++m)
#pragma unroll
                for (int n = 0; n < 2; ++n) acc[a][b][m][n] = (f32x4){0.f, 0.f, 0.f, 0.f};
    bf16x8 At[4][2], B0[2][2], B1[2][2];
    const char* cA = S.a_base(cur); const char* cB = S.b_base(cur);
    if constexpr (SP2) {
        PG8_STAGE(PG8_SB(0, 0), cB, voffB); PG8_STAGE(PG8_SB(0, 1), cB + hstepB, voffB); PG8_STAGE(PG8_SA(0, 0), cA, voffA); PG8_STAGE(PG8_SA(0, 1), cA + hstepA, voffA);
        if (wr == 1) PG8_BAR;
        PG8_WAIT_V(2); PG8_BAR;
        PG8_STAGE(PG8_SB(1, 0), cB + kstep, voffB); PG8_STAGE(PG8_SA(1, 0), cA + kstep, voffA); PG8_STAGE(PG8_SB(1, 1), cB + hstepB + kstep, voffB);
        PG8_WAIT_V(6); PG8_BAR;
    } else {
        PG8_STAGE(PG8_SB(0, 0), cB, voffB); PG8_STAGE(PG8_SA(0, 0), cA, voffA); PG8_STAGE(PG8_SB(0, 1), cB + hstepB, voffB); PG8_STAGE(PG8_SA(0, 1), cA + hstepA, voffA);
        if (wr == 1) PG8_BAR;
        PG8_WAIT_V(4); PG8_BAR;
        PG8_STAGE(PG8_SB(1, 0), cB + kstep, voffB); PG8_STAGE(PG8_SA(1, 0), cA + kstep, voffA); PG8_STAGE(PG8_SB(1, 1), cB + hstepB + kstep, voffB);
        PG8_WAIT_V(6); PG8_BAR;
    }
    for (;;) {
        const bool has_next = S.next(ui + 1, nxt);
        const char* nA = has_next ? S.a_base(nxt) : cA; const char* nB = has_next ? S.b_base(nxt) : cB;
        for (int t = 0; t < nt; t += 2) {
            const bool last = (t == nt - 2);
            const char* a1 = cA + (size_t)(t + 1) * kstep;
            const char* a2 = last ? nA : cA + (size_t)(t + 2) * kstep; const char* b2 = last ? nB : cB + (size_t)(t + 2) * kstep;
            const char* a3 = a2 + kstep; const char* b3 = b2 + kstep;
            if constexpr (SP2) {
            PG8_LDB(B0, 0, 0); PG8_LDB(B1, 0, 1); PG8_SCHED; PG8_LDA(At, 0, 0); PG8_STAGE(PG8_SA(1, 1), a1 + hstepA, voffA);
            PG8_WAIT_V(8); PG8_WAIT_L(0); PG8_BAR; PG8_MMA(0, 0, At, B0); PG8_MMA(0, 1, At, B1); PG8_BAR; PG8_SCHED;
            PG8_LDA(At, 0, 1); PG8_STAGE(PG8_SB(0, 0), b2, voffB); PG8_STAGE(PG8_SB(0, 1), b2 + hstepB, voffB); PG8_STAGE(PG8_SA(0, 0), a2, voffA);
            PG8_WAIT_V(8); PG8_WAIT_L(0); PG8_BAR; PG8_MMA(1, 0, At, B0); PG8_MMA(1, 1, At, B1); PG8_BAR; PG8_SCHED;
            PG8_LDB(B0, 1, 0); PG8_LDB(B1, 1, 1); PG8_SCHED; PG8_LDA(At, 1, 0); PG8_STAGE(PG8_SA(0, 1), a2 + hstepA, voffA);
            PG8_WAIT_V(8); PG8_WAIT_L(0); PG8_BAR; PG8_MMA(0, 0, At, B0); PG8_MMA(0, 1, At, B1); PG8_BAR; PG8_SCHED;
            PG8_LDA(At, 1, 1); PG8_STAGE(PG8_SB(1, 0), b3, voffB); PG8_STAGE(PG8_SB(1, 1), b3 + hstepB, voffB); PG8_STAGE(PG8_SA(1, 0), a3, voffA);
            PG8_WAIT_V(8); PG8_WAIT_L(0); PG8_BAR; PG8_MMA(1, 0, At, B0); PG8_MMA(1, 1, At, B1); PG8_BAR; PG8_SCHED;
            } else {
            PG8_LDB(B0, 0, 0); PG8_SCHED; PG8_LDA(At, 0, 0); PG8_STAGE(PG8_SA(1, 1), a1 + hstepA, voffA);
            PG8_WAIT_L(8); PG8_BAR; PG8_WAIT_L(0); PG8_MMA(0, 0, At, B0); PG8_BAR; PG8_SCHED;
            PG8_LDB(B1, 0, 1); PG8_STAGE(PG8_SB(0, 0), b2, voffB);
            PG8_BAR; PG8_WAIT_L(0); PG8_MMA(0, 1, At, B1); PG8_BAR;
            PG8_LDA(At, 0, 1); PG8_STAGE(PG8_SA(0, 0), a2, voffA);
            PG8_BAR; PG8_WAIT_L(0); PG8_MMA(1, 0, At, B0); PG8_BAR; PG8_SCHED;
            PG8_STAGE(PG8_SB(0, 1), b2 + hstepB, voffB);
            PG8_WAIT_V(6); PG8_BAR; PG8_MMA(1, 1, At, B1); PG8_BAR;
            PG8_LDB(B0, 1, 0); PG8_SCHED; PG8_LDA(At, 1, 0); PG8_STAGE(PG8_SA(0, 1), a2 + hstepA, voffA);
            PG8_WAIT_L(8); PG8_BAR; PG8_WAIT_L(0); PG8_MMA(0, 0, At, B0); PG8_BAR; PG8_SCHED;
            PG8_LDB(B1, 1, 1); PG8_STAGE(PG8_SB(1, 0), b3, voffB);
            PG8_BAR; PG8_WAIT_L(0); PG8_MMA(0, 1, At, B1); PG8_BAR;
            PG8_LDA(At, 1, 1); PG8_STAGE(PG8_SA(1, 0), a3, voffA);
            PG8_BAR; PG8_WAIT_L(0); PG8_MMA(1, 0, At, B0); PG8_BAR; PG8_SCHED;
            PG8_STAGE(PG8_SB(1, 1), b3 + hstepB, voffB);
            PG8_WAIT_V(6); PG8_BAR; PG8_MMA(1, 1, At, B1); PG8_BAR;
            }
        }
        if constexpr (ALIGN_EPI) { if (wr == 0) PG8_BAR; }
        { int tz = tid; asm volatile("" : "+v"(tz));
          const int wid2 = __builtin_amdgcn_readfirstlane(tz >> 6), lane2 = tz & 63;
          E(acc, cur, wid2 >> 2, wid2 & 3, lane2 & 15, lane2 >> 4); }
        if (!has_next) break;
#pragma unroll
        for (int a = 0; a < 2; ++a)
#pragma unroll
            for (int b = 0; b < 2; ++b)
#pragma unroll
                for (int m = 0; m < 4; ++m)
#pragma unroll
                    for (int n = 0; n < 2; ++n) acc[a][b][m][n] = (f32x4){0.f, 0.f, 0.f, 0.f};
        cur = nxt; cA = nA; cB = nB; ++ui;
        if constexpr (ALIGN_EPI) { if (wr == 1) PG8_BAR; }
    }
    PG8_WAIT_V(0);
    if constexpr (!ALIGN_EPI) { if (wr == 0) PG8_BAR; }
    PG8_BAR;
#undef PG8_SA
#undef PG8_SB
#undef PG8_STAGE
#undef PG8_LDA
#undef PG8_LDB
#undef PG8_MMA
#undef PG8_WAIT_V
#undef PG8_WAIT_L
#undef PG8_BAR
#undef PG8_SCHED
}
}
using pg8::Unit;

struct Args { const float* in[50]; float* out; unsigned char* ws; int ph_lo, ph_hi; };
typedef const __attribute__((address_space(4))) Args KArgs;
__device__ __forceinline__ KArgs* kargs() { KArgs* p = (KArgs*)__builtin_amdgcn_kernarg_segment_ptr(); asm volatile("" : "+s"(p)); return p; }
__device__ __forceinline__ unsigned char* launder_p(unsigned char* p) { asm volatile("" : "+s"(p)); return (unsigned char*)(GAS unsigned char*)p; }
__device__ __forceinline__ const float* kin(KArgs& A, int i) { return (const float*)(const GAS float*)A.in[i]; }
__device__ __forceinline__ float* kout(KArgs& A) { return (float*)(GAS float*)A.out; }
__device__ __forceinline__ unsigned char* kws(KArgs& A) { return (unsigned char*)(GAS unsigned char*)A.ws; }
__device__ __forceinline__ int launder_i(int v) { asm volatile("" : "+s"(v)); return v; }
__device__ __forceinline__ int launder_v(int v) { asm volatile("" : "+v"(v)); return v; }
enum { I_X = 0, I_MEM, I_LN_IN_G, I_LN_IN_B, I_W_IN, I_CONV_W, I_SG_NG, I_SG_NB, I_SG_W, I_SG_B, I_RW_MU, I_RW_W0, I_RW_WUP, I_RW_A0, I_RW_AUP, I_RW_GUP,
       I_RW_KK, I_RW_KA, I_RW_RK, I_RW_LNG, I_RW_LNB, I_S5_ARE, I_S5_AIM, I_S5_BRE, I_S5_BIM, I_S5_CRE, I_S5_CIM, I_S5_D, I_S5_LOGDT, I_S5_GLUW, I_S5_GLUB,
       I_BR_PROJ, I_GATE_B, I_W_OUT, I_LN1_G, I_LN1_B, I_XA_WQ, I_XA_WK, I_XA_WV, I_XA_WO, I_LN2_G, I_LN2_B, I_ROUTER_W, I_ROUTER_B, I_EX_W1, I_EX_B1, I_EX_W2, I_EX_B2,
       I_LN3_G, I_LN3_B };
struct Frame { LAS unsigned char* lds; volatile LAS unsigned* MISC; unsigned* ctl; unsigned char* ws; int tid, lane, wave, G, bid; };
constexpr int MI_TOFF = 16, MI_HIST = 64;

__device__ __forceinline__ void ln_stats(const f32x4 (&v)[4], float& mean, float& rstd) {
    float s = 0.f;
#pragma unroll
    for (int j = 0; j < 4; ++j) s += (v[j].x + v[j].y) + (v[j].z + v[j].w);
    mean = wave_sum(s) * (1.f / D); float s2 = 0.f;
#pragma unroll
    for (int j = 0; j < 4; ++j) { const f32x4 d = v[j] - mean; s2 += (d.x * d.x + d.y * d.y) + (d.z * d.z + d.w * d.w); }
    rstd = 1.0f / sqrtf(wave_sum(s2) * (1.f / D) + LN_EPS);
}
__device__ __forceinline__ void ln_apply_store(const f32x4 (&v)[4], float mean, float rstd, const float* g, const float* b, float* o32, bf16* o16, int lane) {
#pragma unroll
    for (int j = 0; j < 4; ++j) {
        const f32x4 gg = *(const f32x4*)(g + 256 * j + 4 * lane), bb = *(const f32x4*)(b + 256 * j + 4 * lane);
        const f32x4 y = (v[j] - mean) * rstd * gg + bb;
        if (o32) *(f32x4*)(o32 + 256 * j + 4 * lane) = y;
        if (o16) { v2u w; w.x = pk2(y.x, y.y); w.y = pk2(y.z, y.w); *(v2u*)(o16 + 256 * j + 4 * lane) = w; }
    }
}

__device__ __forceinline__ void transpose_item(const float* W, int K, int N, bf16* WT, int mode, LAS float* scr, int item, int lane) {
    const int nblk = N / 32, kb = item / nblk, nb = item % nblk, k0 = 64 * kb, n0 = 32 * nb;
#pragma unroll 8
    for (int i = 0; i < 32; ++i) { const int kk = 2 * i + (lane >> 5); scr[kk * 33 + (lane & 31)] = W[(size_t)(k0 + kk) * N + n0 + (lane & 31)]; }
    LDS_WAIT();
    const int c = lane & 7;
#pragma unroll
    for (int j = 0; j < 4; ++j) { const int n = (lane >> 3) + 8 * j; const LAS float* s = scr + (8 * c) * 33 + n;
        v4u o; o.x = pk2(s[0 * 33], s[1 * 33]); o.y = pk2(s[2 * 33], s[3 * 33]); o.z = pk2(s[4 * 33], s[5 * 33]); o.w = pk2(s[6 * 33], s[7 * 33]);
        const int nn = n0 + n; const int jj = nn >> 1;
        const int row = mode ? ((jj >> 7) * 256 + (nn & 1) * 128 + (jj & 127)) : nn;
        *(v4u*)(WT + (size_t)row * K + k0 + 8 * c) = o; }
    LDS_WAIT();
}
__device__ __forceinline__ void s5_setup_item(KArgs& A, const Frame& F, int item) {
    const int l = item >> 4, g = item & 15, tid = F.tid;
    LAS float* Kt = (LAS float*)F.lds;
    LAS float* Pw = (LAS float*)(F.lds + 65536);
    LAS float* Bb = (LAS float*)(F.lds + 65536 + 33280);
    LAS float* Cc = Bb + 2048;
    const float* a_re = kin(A, I_S5_ARE) + (l * 16 + g) * 64; const float* a_im = kin(A, I_S5_AIM) + (l * 16 + g) * 64;
    const float* b_re = kin(A, I_S5_BRE) + (size_t)(l * 16 + g) * 1024; const float* b_im = kin(A, I_S5_BIM) + (size_t)(l * 16 + g) * 1024;
    const float* c_re = kin(A, I_S5_CRE) + (size_t)(l * 16 + g) * 1024; const float* c_im = kin(A, I_S5_CIM) + (size_t)(l * 16 + g) * 1024;
    const float dt = expf(kin(A, I_S5_LOGDT)[l * 16 + g]);
    for (int o = tid; o < 65 * 64; o += NTHREADS) { const int n = o >> 6, p = o & 63; const float mag = expf(a_re[p] * dt * (float)n); float sn, cs; sincosf(a_im[p] * dt * (float)n, &sn, &cs);
        Pw[o * 2] = mag * cs; Pw[o * 2 + 1] = mag * sn; }
    for (int o = tid; o < 1024; o += NTHREADS) { const int p = o >> 4;
        const float are = a_re[p], aim = a_im[p], mag = expf(are * dt); float sn, cs; sincosf(aim * dt, &sn, &cs); const float abr = mag * cs, abi = mag * sn;
        const float den = are * are + aim * aim, nr = abr - 1.0f, cr = (nr * are + abi * aim) / den, ci = (abi * are - nr * aim) / den;
        const float br = b_re[o], bi = b_im[o]; Bb[o * 2] = cr * br - ci * bi; Bb[o * 2 + 1] = cr * bi + ci * br; }
    for (int o = tid; o < 1024; o += NTHREADS) { Cc[o * 2] = c_re[o]; Cc[o * 2 + 1] = c_im[o]; }
    __syncthreads();
    for (int o = tid; o < 16384; o += NTHREADS) { const int tau = o >> 8, c = (o >> 4) & 15, cp = o & 15; float acc = 0.f;
        for (int p = 0; p < 64; ++p) { const float cr = Cc[(c * 64 + p) * 2], ci = Cc[(c * 64 + p) * 2 + 1], pr = Pw[(tau * 64 + p) * 2], pi = Pw[(tau * 64 + p) * 2 + 1];
            const float er = cr * pr - ci * pi, ei = cr * pi + ci * pr; acc += er * Bb[(p * 16 + cp) * 2] - ei * Bb[(p * 16 + cp) * 2 + 1]; }
        Kt[o] = acc; }
    __syncthreads();
    bf16* Bt = (bf16*)(F.ws + WS_S5BT) + (size_t)(l * 16 + g) * 1024 * S5K;
    for (int o = tid; o < 1024 * 128; o += NTHREADS) { const int rr = o >> 7, q = o & 127, t = rr >> 4, c = rr & 15, s = q >> 1, cp0 = (q & 1) * 8;
        v4u w = {0u, 0u, 0u, 0u};
        if (s <= t) { const LAS float* k = Kt + ((t - s) * 16 + c) * 16 + cp0; w.x = pk2(k[0], k[1]); w.y = pk2(k[2], k[3]); w.z = pk2(k[4], k[5]); w.w = pk2(k[6], k[7]); }
        *(v4u*)(Bt + (size_t)rr * S5K + q * 8) = w; }
    for (int o = tid; o < 1024 * 16; o += NTHREADS) { const int rr = o >> 4, q = o & 15, t = rr >> 4, c = rr & 15; float vals[8];
#pragma unroll
        for (int j = 0; j < 4; ++j) { const int p = 4 * q + j; const float cr = Cc[(c * 64 + p) * 2], ci = Cc[(c * 64 + p) * 2 + 1], pr = Pw[((t + 1) * 64 + p) * 2], pi = Pw[((t + 1) * 64 + p) * 2 + 1];
            vals[2 * j] = cr * pr - ci * pi; vals[2 * j + 1] = -(cr * pi + ci * pr); }
        v4u w; w.x = pk2(vals[0], vals[1]); w.y = pk2(vals[2], vals[3]); w.z = pk2(vals[4], vals[5]); w.w = pk2(vals[6], vals[7]);
        *(v4u*)(Bt + (size_t)rr * S5K + 1024 + q * 8) = w; }
    bf16* Bc = (bf16*)(F.ws + WS_S5BC) + (size_t)(l * 16 + g) * 256 * 1024;
    for (int o = tid; o < 128 * 128; o += NTHREADS) { const int row = o >> 7, q = o & 127, p = row >> 1, im = row & 1, s = q >> 1, cp0 = (q & 1) * 8;
        const float pr = Pw[((63 - s) * 64 + p) * 2], pi = Pw[((63 - s) * 64 + p) * 2 + 1]; float vals[8];
#pragma unroll
        for (int j = 0; j < 8; ++j) { const float br = Bb[(p * 16 + cp0 + j) * 2], bi = Bb[(p * 16 + cp0 + j) * 2 + 1]; vals[j] = im ? (pr * bi + pi * br) : (pr * br - pi * bi); }
        v4u w; w.x = pk2(vals[0], vals[1]); w.y = pk2(vals[2], vals[3]); w.z = pk2(vals[4], vals[5]); w.w = pk2(vals[6], vals[7]);
        *(v4u*)(Bc + (size_t)row * 1024 + q * 8) = w;
        *(v4u*)(Bc + (size_t)(128 + row) * 1024 + q * 8) = (v4u){0u, 0u, 0u, 0u}; }
    __syncthreads();
}
__device__ __forceinline__ void p_prologue(KArgs& A, const Frame& F) {
    const int gw = F.bid * NWAVES + F.wave, NGW = F.G * NWAVES, lane = F.lane;
    for (int item = F.bid; item < NL * 16; item += F.G) s5_setup_item(A, F, item);
    LAS float* scr = (LAS float*)(F.lds + F.wave * 16384);
#pragma unroll 1
    for (int d = 0; d < 10; ++d) {
        const float* src; bf16* dst; int K, N, batch, mode = 0;
        switch (d) {
            case 0: src = kin(A, I_EX_W1); dst = (bf16*)(F.ws + WS_W1T); K = 1024; N = 2048; batch = NL * NE; mode = 1; break;
            case 1: src = kin(A, I_EX_W2); dst = (bf16*)(F.ws + WS_W2T); K = 1024; N = 1024; batch = NL * NE; break;
            case 2: src = kin(A, I_W_IN); dst = (bf16*)(F.ws + WS_WINT); K = 1024; N = N_IN; batch = NL; break;
            case 3: src = kin(A, I_BR_PROJ); dst = (bf16*)(F.ws + WS_BRT); K = 256; N = 1024; batch = NL * 4; break;
            case 4: src = kin(A, I_W_OUT); dst = (bf16*)(F.ws + WS_WOUTT); K = 1024; N = 1024; batch = NL; break;
            case 5: src = kin(A, I_XA_WQ); dst = (bf16*)(F.ws + WS_WQT); K = 1024; N = 1024; batch = NL; break;
            case 6: src = kin(A, I_XA_WK); dst = (bf16*)(F.ws + WS_WKT); K = 1024; N = 1024; batch = NL; break;
            case 7: src = kin(A, I_XA_WV); dst = (bf16*)(F.ws + WS_WVT); K = 1024; N = 1024; batch = NL; break;
            case 8: src = kin(A, I_XA_WO); dst = (bf16*)(F.ws + WS_WOT); K = 1024; N = 1024; batch = NL; break;
            default: src = kin(A, I_S5_GLUW); dst = (bf16*)(F.ws + WS_GLUT); K = 256; N = 256; batch = NL; break;
        }
        const int per = (K / 64) * (N / 32), nitems = per * batch;
        for (int it = gw; it < nitems; it += NGW) { const int b = it / per, r = it - b * per;
            transpose_item(src + (size_t)b * K * N, K, N, dst + (size_t)b * K * N, mode, scr, r, lane); }
    }
    { const float* mem = kin(A, I_MEM); bf16* m16 = (bf16*)(F.ws + WS_MEM16);
      for (int r = gw; r < NB * NMEM; r += NGW) {
#pragma unroll
          for (int j = 0; j < 4; ++j) { const f32x4 v = *(const f32x4*)(mem + (size_t)r * D + 256 * j + 4 * lane); v2u w; w.x = pk2(v.x, v.y); w.y = pk2(v.z, v.w); *(v2u*)(m16 + (size_t)r * D + 256 * j + 4 * lane) = w; } } }
    { const float* x = kin(A, I_X); float* h32 = (float*)(F.ws + WS_H32); bf16* h16 = (bf16*)(F.ws + WS_H16);
      for (int r = gw; r < T; r += NGW) { f32x4 v[4];
#pragma unroll
          for (int j = 0; j < 4; ++j) v[j] = *(const f32x4*)(x + (size_t)r * D + 256 * j + 4 * lane);
          float mean, rstd; ln_stats(v, mean, rstd);
          ln_apply_store(v, mean, rstd, kin(A, I_LN_IN_G), kin(A, I_LN_IN_B), h32 + (size_t)r * D, h16 + (size_t)r * D, lane); } }
}

typedef f32x4 AccT[2][2][4][2];
#define EPI_BASES KArgs& KA = *kargs(); unsigned char* ws = kws(KA); (void)ws;
struct EpiIn { int l;
    __device__ __forceinline__ void operator()(const AccT& acc, const Unit& u, int wr, int wc, int fr, int fq) const { EPI_BASES
        float* Z = (float*)(ws + WS_Z); bf16* SG = (bf16*)(ws + WS_SG); bf16* AOUT = (bf16*)(ws + WS_AOUT); const float* gate_b = kin(KA, I_GATE_B) + (size_t)l * 4096;
        if (u.pn < 10) {
            pg8::epi_foreach(acc, u, wr, wc, fr, fq, [&](int row, int col, f32x4 v) {
                *(f32x4*)(Z + (size_t)row * ZLD + col) = v;
                if (u.pn == 9) { const int cc = col - OFF_D, g = cc >> 4, c0 = cc & 15, chunk = row >> 6, s = row & 63;
                    v2u w; w.x = pk2(v.x, v.y); w.y = pk2(v.z, v.w); *(v2u*)(AOUT + ((size_t)(g * NCHT + chunk)) * S5K + s * 16 + c0) = w; } });
        } else {
            pg8::epi_foreach(acc, u, wr, wc, fr, fq, [&](int row, int col, f32x4 v) {
                const int gc = col - OFF_G; const f32x4 gb = *(const f32x4*)(gate_b + gc);
                v2u w; w.x = pk2(sigmoidf_(v.x + gb.x), sigmoidf_(v.y + gb.y)); w.y = pk2(sigmoidf_(v.z + gb.z), sigmoidf_(v.w + gb.w));
                *(v2u*)(SG + (size_t)row * 4096 + gc) = w; });
        }
    } };
struct EpiBranch { int br;
    __device__ __forceinline__ void operator()(const AccT& acc, const Unit& u, int wr, int wc, int fr, int fq) const { EPI_BASES
        bf16* MG = (bf16*)(ws + WS_MG16); const bf16* SG = (const bf16*)(ws + WS_SG);
        pg8::epi_foreach(acc, u, wr, wc, fr, fq, [&](int row, int col, f32x4 v) {
            const v2u s = *(const v2u*)(SG + (size_t)row * 4096 + br * 1024 + col);
            f32x4 r; r.x = v.x * bf2f(s.x & 0xffffu); r.y = v.y * bf2f(s.x >> 16); r.z = v.z * bf2f(s.y & 0xffffu); r.w = v.w * bf2f(s.y >> 16);
            bf16* p = MG + (size_t)row * D + col;
            if (br > 0) { const v2u m = *(const v2u*)p; r.x += bf2f(m.x & 0xffffu); r.y += bf2f(m.x >> 16); r.z += bf2f(m.y & 0xffffu); r.w += bf2f(m.y >> 16); }
            v2u w; w.x = pk2(r.x, r.y); w.y = pk2(r.z, r.w); *(v2u*)p = w; });
    } };
struct EpiResid { int dummy;
    __device__ __forceinline__ void operator()(const AccT& acc, const Unit& u, int wr, int wc, int fr, int fq) const { EPI_BASES
        float* H = (float*)(ws + WS_H32);
        pg8::epi_foreach(acc, u, wr, wc, fr, fq, [&](int row, int col, f32x4 v) { float* p = H + (size_t)row * D + col; const f32x4 h = *(const f32x4*)p; *(f32x4*)p = h * DN_ALPHA + v; });
    } };
struct EpiBf16 { unsigned off_mib; float scale;
    __device__ __forceinline__ void operator()(const AccT& acc, const Unit& u, int wr, int wc, int fr, int fq) const { EPI_BASES
        bf16* O = (bf16*)(ws + (size_t)off_mib * MiB);
        pg8::epi_foreach(acc, u, wr, wc, fr, fq, [&](int row, int col, f32x4 v) { v2u w; w.x = pk2(v.x * scale, v.y * scale); w.y = pk2(v.z * scale, v.w * scale); *(v2u*)(O + (size_t)row * D + col) = w; });
    } };
struct EpiVT { int dummy;
    __device__ __forceinline__ void operator()(const AccT& acc, const Unit& u, int wr, int wc, int fr, int fq) const { EPI_BASES
        bf16* VT = (bf16*)(ws + WS_VMT16);
        pg8::epi_foreach(acc, u, wr, wc, fr, fq, [&](int row, int col, f32x4 v) { const int b = row >> 8, m = row & 255; bf16* p = VT + ((size_t)(b * D + col)) * NMEM + m;
            p[0] = (bf16)f2bf(v.x); p[NMEM] = (bf16)f2bf(v.y); p[2 * NMEM] = (bf16)f2bf(v.z); p[3 * NMEM] = (bf16)f2bf(v.w); });
    } };
struct EpiXloc { int dummy;
    __device__ __forceinline__ void operator()(const AccT& acc, const Unit& u, int wr, int wc, int fr, int fq) const { EPI_BASES
        float* X = (float*)(ws + WS_XLOC);
        pg8::epi_foreach(acc, u, wr, wc, fr, fq, [&](int row, int col, f32x4 v) { if (col < 128) *(f32x4*)(X + ((size_t)(u.e * NCHT + row)) * 128 + col) = v; });
    } };
__device__ __forceinline__ float gelu_tanh(float x) { const float u = 0.7978845608028654f * (x + 0.044715f * x * x * x); const float e = __expf(2.0f * u); const float th = 1.0f - 2.0f / (e + 1.0f); return 0.5f * x * (1.0f + th); }
struct EpiS5Y { int l;
    __device__ __forceinline__ void operator()(const AccT& acc, const Unit& u, int wr, int wc, int fr, int fq) const { EPI_BASES
        bf16* YD = (bf16*)(ws + WS_YD16); const float* Z = (const float*)(ws + WS_Z); const float* dvec = kin(KA, I_S5_D) + l * 256;
        pg8::epi_foreach(acc, u, wr, wc, fr, fq, [&](int row, int col, f32x4 v) { const int tok = row * CH + (col >> 4), ch = u.e * 16 + (col & 15);
            const f32x4 uu = *(const f32x4*)(Z + (size_t)tok * ZLD + OFF_D + ch), dd = *(const f32x4*)(dvec + ch);
            v2u w; w.x = pk2(gelu_tanh(v.x + dd.x * uu.x), gelu_tanh(v.y + dd.y * uu.y)); w.y = pk2(gelu_tanh(v.z + dd.z * uu.z), gelu_tanh(v.w + dd.w * uu.w));
            *(v2u*)(YD + (size_t)tok * 256 + ch) = w; });
    } };
struct EpiGlu { int l;
    __device__ __forceinline__ void operator()(const AccT& acc, const Unit& u, int wr, int wc, int fr, int fq) const { EPI_BASES
        bf16* O = (bf16*)(ws + WS_O16); const bf16* YD = (const bf16*)(ws + WS_YD16); const float* gb = kin(KA, I_S5_GLUB) + l * 256;
        pg8::epi_foreach(acc, u, wr, wc, fr, fq, [&](int row, int col, f32x4 v) { const v2u y = *(const v2u*)(YD + (size_t)row * 256 + col); const f32x4 b = *(const f32x4*)(gb + col);
            v2u w; w.x = pk2(bf2f(y.x & 0xffffu) * sigmoidf_(v.x + b.x), bf2f(y.x >> 16) * sigmoidf_(v.y + b.y)); w.y = pk2(bf2f(y.y & 0xffffu) * sigmoidf_(v.z + b.z), bf2f(y.y >> 16) * sigmoidf_(v.w + b.w));
            *(v2u*)(O + (size_t)row * D + 768 + col) = w; });
    } };
__device__ __forceinline__ float swiglu(float g, float u) { g = fminf(g, 7.0f); u = fminf(fmaxf(u, -7.0f), 7.0f); return (u + 1.0f) * g * sigmoidf_(1.702f * g); }
struct EpiSwiglu { int l;
    __device__ __forceinline__ void operator()(const AccT& acc, const Unit& u, int wr, int wc, int fr, int fq) const { EPI_BASES
        bf16* ACT = (bf16*)(ws + WS_ACT); const float* bb = kin(KA, I_EX_B1) + (size_t)(l * NE + u.e) * 2048;
#pragma unroll
        for (int ai = 0; ai < 2; ++ai)
#pragma unroll
            for (int m = 0; m < 4; ++m) { const int row = u.pm * 256 + ai * 128 + wr * 64 + m * 16 + fr;
#pragma unroll
                for (int n = 0; n < 2; ++n) { const int j = u.pn * 128 + wc * 32 + n * 16 + 4 * fq;
                    const f32x4 b0 = *(const f32x4*)(bb + 2 * j), b1v = *(const f32x4*)(bb + 2 * j + 4);
                    const f32x4 g = acc[ai][0][m][n], uu = acc[ai][1][m][n];
                    v2u w; w.x = pk2(swiglu(g.x + b0.x, uu.x + b0.y), swiglu(g.y + b0.z, uu.y + b0.w)); w.y = pk2(swiglu(g.z + b1v.x, uu.z + b1v.y), swiglu(g.w + b1v.z, uu.w + b1v.w));
                    *(v2u*)(ACT + (size_t)row * DFF + j) = w; } }
    } };
struct EpiMoeOut { int l;
    __device__ __forceinline__ void operator()(const AccT& acc, const Unit& u, int wr, int wc, int fr, int fq) const { EPI_BASES
        bf16* YS = (bf16*)(ws + WS_YS); const float* SLOTW = (const float*)(ws + WS_SLOTW); const float* bb = kin(KA, I_EX_B2) + (size_t)(l * NE + u.e) * D;
        pg8::epi_foreach(acc, u, wr, wc, fr, fq, [&](int row, int col, f32x4 v) { const float sw = SLOTW[row]; const f32x4 b = *(const f32x4*)(bb + col);
            v2u w; w.x = pk2((v.x + b.x) * sw, (v.y + b.y) * sw); w.y = pk2((v.z + b.z) * sw, (v.w + b.w) * sw); *(v2u*)(YS + (size_t)row * D + col) = w; });
    } };

__device__ __forceinline__ void p_mix1(KArgs& A, const Frame& F, int l) {
    const int gw = F.bid * NWAVES + F.wave, NGW = F.G * NWAVES, lane = F.lane, tid = F.tid;
    const float* Z = (const float*)(F.ws + WS_Z); bf16* O16 = (bf16*)(F.ws + WS_O16);
    { const float* cw = kin(A, I_CONV_W) + l * 3 * 256; const f32x4 w0 = *(const f32x4*)(cw + 4 * lane), w1 = *(const f32x4*)(cw + 256 + 4 * lane), w2 = *(const f32x4*)(cw + 512 + 4 * lane);
      for (int t = gw; t < T; t += NGW) { const int s = t & (SEQ - 1); const float* zr = Z + (size_t)t * ZLD + 4 * lane;
          const f32x4 bg = *(const f32x4*)zr; f32x4 y = w2 * (*(const f32x4*)(zr + 256) * *(const f32x4*)(zr + 512));
          if (s >= 1) y += w1 * (*(const f32x4*)(zr - ZLD + 256) * *(const f32x4*)(zr - ZLD + 512));
          if (s >= 2) y += w0 * (*(const f32x4*)(zr - 2 * ZLD + 256) * *(const f32x4*)(zr - 2 * ZLD + 512));
          y = y * bg; v2u w; w.x = pk2(y.x, y.y); w.y = pk2(y.z, y.w); *(v2u*)(O16 + (size_t)t * D + 4 * lane) = w; } }
    { LAS float* VN = (LAS float*)F.lds;
      const float* ng = kin(A, I_SG_NG) + l * 256; const float* nb = kin(A, I_SG_NB) + l * 256;
      for (int blk = F.bid; blk < T / 128; blk += F.G) {
          const f32x4 gg = *(const f32x4*)(ng + 4 * lane), bb = *(const f32x4*)(nb + 4 * lane);
          for (int r = F.wave; r < 128; r += NWAVES) { const int t = blk * 128 + r; const f32x4 v = *(const f32x4*)(Z + (size_t)t * ZLD + OFF_B + 256 + 4 * lane);
              const float mean = wave_sum((v.x + v.y) + (v.z + v.w)) * (1.f / 256); const f32x4 d = v - mean;
              const float var = wave_sum((d.x * d.x + d.y * d.y) + (d.z * d.z + d.w * d.w)) * (1.f / 256); const float rstd = 1.0f / sqrtf(var + LN_EPS);
              *(LAS f32x4*)(VN + r * 256 + 4 * lane) = d * rstd * gg + bb; }
          __syncthreads();
          const int i = tid >> 2, cq = tid & 3, t = blk * 128 + i, jmax = (i < 64) ? 64 : 128;
#pragma unroll 1
          for (int g = 0; g < 4; ++g) { f32x4 a0 = {0, 0, 0, 0}, a1 = a0, a2 = a0, a3 = a0;
              const float* wrow = kin(A, I_SG_W) + ((size_t)((l * 4 + g) * 128 + i)) * 128; const LAS float* vb = VN + g * 64 + cq * 16;
              for (int j = 0; j < jmax; j += 4) { const f32x4 w4 = *(const f32x4*)(wrow + j);
#pragma unroll
                  for (int jj = 0; jj < 4; ++jj) { const LAS f32x4* vp = (const LAS f32x4*)(vb + (j + jj) * 256); const float w = w4[jj];
                      a0 += vp[0] * w; a1 += vp[1] * w; a2 += vp[2] * w; a3 += vp[3] * w; } }
              const float bias = kin(A, I_SG_B)[(l * 4 + g) * 128 + i]; const float* up = Z + (size_t)t * ZLD + OFF_B + g * 64 + cq * 16;
              const f32x4 o0 = *(const f32x4*)(up) * (a0 + bias), o1 = *(const f32x4*)(up + 4) * (a1 + bias), o2 = *(const f32x4*)(up + 8) * (a2 + bias), o3 = *(const f32x4*)(up + 12) * (a3 + bias);
              v4u wa, wb; wa.x = pk2(o0.x, o0.y); wa.y = pk2(o0.z, o0.w); wa.z = pk2(o1.x, o1.y); wa.w = pk2(o1.z, o1.w); wb.x = pk2(o2.x, o2.y); wb.y = pk2(o2.z, o2.w); wb.z = pk2(o3.x, o3.y); wb.w = pk2(o3.z, o3.w);
              bf16* op = O16 + (size_t)t * D + 256 + g * 64 + cq * 16; *(v4u*)op = wa; *(v4u*)(op + 8) = wb; }
          __syncthreads();
      } }
    { LAS float* xin = (LAS float*)(F.lds + F.wave * 8192);
      float* RWOP = (float*)(F.ws + WS_RWOP); float* RWG = (float*)(F.ws + WS_RWG); float* RK = (float*)(F.ws + WS_RK);
      const float* mu = kin(A, I_RW_MU) + l * 1024; const float* wup = kin(A, I_RW_WUP) + (size_t)l * 64 * 256; const float* aup = kin(A, I_RW_AUP) + (size_t)l * 64 * 256; const float* gup = kin(A, I_RW_GUP) + (size_t)l * 128 * 256;
      const int c4 = 4 * lane, head = lane >> 4;
      const f32x4 w0v = *(const f32x4*)(kin(A, I_RW_W0) + l * 256 + c4), a0v = *(const f32x4*)(kin(A, I_RW_A0) + l * 256 + c4), kkv = *(const f32x4*)(kin(A, I_RW_KK) + l * 256 + c4),
                  kav = *(const f32x4*)(kin(A, I_RW_KA) + l * 256 + c4), rkv = *(const f32x4*)(kin(A, I_RW_RK) + l * 256 + c4);
      const f32x4 mul = *(const f32x4*)(mu + 768 + c4), mur = *(const f32x4*)(mu + c4), muk = *(const f32x4*)(mu + 256 + c4), muv = *(const f32x4*)(mu + 512 + c4);
      for (int grp = gw; grp < T / 8; grp += NGW) { const int t0 = grp * 8;
#pragma unroll
          for (int tk = 0; tk < 8; ++tk) { const int t = t0 + tk, s = t & (SEQ - 1); const float* zr = Z + (size_t)t * ZLD + OFF_C + 768 + c4;
              f32x4 x = *(const f32x4*)zr; f32x4 pv = {0, 0, 0, 0}; if (s > 0) pv = *(const f32x4*)(zr - ZLD); x = x + (pv - x) * mul;
              if (lane < 16) { x.x = tanhf(x.x); x.y = tanhf(x.y); x.z = tanhf(x.z); x.w = tanhf(x.w); }
              else if (lane >= 32) { x.x = sigmoidf_(x.x); x.y = sigmoidf_(x.y); x.z = sigmoidf_(x.z); x.w = sigmoidf_(x.w); }
              *(LAS f32x4*)(xin + tk * 256 + c4) = x; }
          LDS_WAIT();
          f32x4 dec[8], av[8];
          { f32x4 acc[8];
#pragma unroll
            for (int tk = 0; tk < 8; ++tk) acc[tk] = (f32x4){0, 0, 0, 0};
#pragma unroll 2
            for (int i = 0; i < 64; i += 4) { const f32x4 wa = *(const f32x4*)(wup + (size_t)(i + 0) * 256 + c4), wb = *(const f32x4*)(wup + (size_t)(i + 1) * 256 + c4), wc = *(const f32x4*)(wup + (size_t)(i + 2) * 256 + c4), wd = *(const f32x4*)(wup + (size_t)(i + 3) * 256 + c4);
#pragma unroll
                for (int tk = 0; tk < 8; ++tk) { const f32x4 xi = *(const LAS f32x4*)(xin + tk * 256 + i); acc[tk] += wa * xi.x + wb * xi.y + wc * xi.z + wd * xi.w; } }
#pragma unroll
            for (int tk = 0; tk < 8; ++tk) { const f32x4 wp = w0v + acc[tk];
#pragma unroll
                for (int e = 0; e < 4; ++e) { const float sp = log1pf(__expf(-wp[e])); const float w = -sp - 0.5f; dec[tk][e] = __expf(-__expf(w)); } } }
          { f32x4 acc[8];
#pragma unroll
            for (int tk = 0; tk < 8; ++tk) acc[tk] = (f32x4){0, 0, 0, 0};
#pragma unroll 2
            for (int i = 0; i < 64; i += 4) { const f32x4 wa = *(const f32x4*)(aup + (size_t)(i + 0) * 256 + c4), wb = *(const f32x4*)(aup + (size_t)(i + 1) * 256 + c4), wc = *(const f32x4*)(aup + (size_t)(i + 2) * 256 + c4), wd = *(const f32x4*)(aup + (size_t)(i + 3) * 256 + c4);
#pragma unroll
                for (int tk = 0; tk < 8; ++tk) { const f32x4 xi = *(const LAS f32x4*)(xin + tk * 256 + 64 + i); acc[tk] += wa * xi.x + wb * xi.y + wc * xi.z + wd * xi.w; } }
#pragma unroll
            for (int tk = 0; tk < 8; ++tk) { const f32x4 ap = a0v + acc[tk]; av[tk] = (f32x4){sigmoidf_(ap.x), sigmoidf_(ap.y), sigmoidf_(ap.z), sigmoidf_(ap.w)}; } }
          { f32x4 acc[8];
#pragma unroll
            for (int tk = 0; tk < 8; ++tk) acc[tk] = (f32x4){0, 0, 0, 0};
#pragma unroll 2
            for (int i = 0; i < 128; i += 4) { const f32x4 wa = *(const f32x4*)(gup + (size_t)(i + 0) * 256 + c4), wb = *(const f32x4*)(gup + (size_t)(i + 1) * 256 + c4), wc = *(const f32x4*)(gup + (size_t)(i + 2) * 256 + c4), wd = *(const f32x4*)(gup + (size_t)(i + 3) * 256 + c4);
#pragma unroll
                for (int tk = 0; tk < 8; ++tk) { const f32x4 xi = *(const LAS f32x4*)(xin + tk * 256 + 128 + i); acc[tk] += wa * xi.x + wb * xi.y + wc * xi.z + wd * xi.w; } }
#pragma unroll
            for (int tk = 0; tk < 8; ++tk) *(f32x4*)(RWG + (size_t)(t0 + tk) * 256 + c4) = acc[tk]; }
#pragma unroll
          for (int tk = 0; tk < 8; ++tk) { const int t = t0 + tk, s = t & (SEQ - 1), b = t >> 13; const float* zr = Z + (size_t)t * ZLD + OFF_C + c4;
              f32x4 r = *(const f32x4*)zr, k = *(const f32x4*)(zr + 256), v = *(const f32x4*)(zr + 512);
              f32x4 pr = {0, 0, 0, 0}, pk = pr, pvv = pr; if (s > 0) { pr = *(const f32x4*)(zr - ZLD); pk = *(const f32x4*)(zr - ZLD + 256); pvv = *(const f32x4*)(zr - ZLD + 512); }
              r = r + (pr - r) * mur; k = k + (pk - k) * muk; v = v + (pvv - v) * muv;
              const f32x4 a = av[tk]; f32x4 kk = k * kkv; const f32x4 k2 = k * (1.0f + (a - 1.0f) * kav);
              float ss = (kk.x * kk.x + kk.y * kk.y) + (kk.z * kk.z + kk.w * kk.w); float rk = (r.x * k2.x * rkv.x + r.y * k2.y * rkv.y) + (r.z * k2.z * rkv.z + r.w * k2.w * rkv.w);
#pragma unroll
              for (int o = 1; o < 16; o <<= 1) { ss += __shfl_xor(ss, o); rk += __shfl_xor(rk, o); }
              const float inv = 1.0f / fmaxf(sqrtf(ss), 1e-12f); kk = kk * inv;
              float* op = RWOP + ((size_t)((b * 4 + head) * SEQ + s)) * 384 + (lane & 15) * 4;
              *(f32x4*)(op) = -kk; *(f32x4*)(op + 64) = dec[tk]; *(f32x4*)(op + 128) = kk * a; *(f32x4*)(op + 192) = r; *(f32x4*)(op + 256) = k2; *(f32x4*)(op + 320) = v;
              if ((lane & 15) == 0) RK[(size_t)t * 4 + head] = rk; }
          LDS_WAIT();
      } }
}

__device__ __forceinline__ void p_rw_chunks(const Frame& F) {
    const int gw = F.bid * NWAVES + F.wave, NGW = F.G * NWAVES, lane = F.lane;
    const float* RWOP = (const float*)(F.ws + WS_RWOP); float* QH = (float*)(F.ws + WS_QH); float* YL = (float*)(F.ws + WS_YL); float* GC = (float*)(F.ws + WS_GC); float* HC = (float*)(F.ws + WS_HC);
    LAS float* wl = (LAS float*)(F.lds + F.wave * 16384);
    for (int task = gw; task < 16 * NCH; task += NGW) { const int bh = task / NCH, ck = task % NCH;
        float sp[64], sl[64];
        { const int ln = launder_v(lane);
#pragma unroll
          for (int k = 0; k < 64; ++k) { sp[k] = (k == ln) ? 1.0f : 0.0f; sl[k] = 0.0f; } }
        const float* src = RWOP + ((size_t)(bh * SEQ + ck * CH)) * 384;
#pragma unroll 1
        for (int sb = 0; sb < CH / 8; ++sb) {
            const f32x4* gsrc = (const f32x4*)(src + (size_t)sb * 8 * 384) + lane; LAS f32x4* ldst = (LAS f32x4*)wl + lane;
#pragma unroll
            for (int i = 0; i < 12; ++i) ldst[i * 64] = gsrc[i * 64];
            LDS_WAIT();
#pragma unroll 1
            for (int st = 0; st < 8; ++st) { const LAS f32x4* base = (const LAS f32x4*)(wl + st * 384);
                float saP = 0.f, saL = 0.f;
#pragma unroll
                for (int q = 0; q < 16; ++q) { const f32x4 nk = base[q];
                    saP += sp[4 * q] * nk.x; saP += sp[4 * q + 1] * nk.y; saP += sp[4 * q + 2] * nk.z; saP += sp[4 * q + 3] * nk.w;
                    saL += sl[4 * q] * nk.x; saL += sl[4 * q + 1] * nk.y; saL += sl[4 * q + 2] * nk.z; saL += sl[4 * q + 3] * nk.w;
                    if ((q & 3) == 3) __builtin_amdgcn_sched_barrier(0); }
                const float vj = wl[st * 384 + 320 + lane];
                float yP = 0.f, yL = 0.f;
                f32x4 w = base[16], b = base[32], r = base[48], kv = base[64];
#pragma unroll
                for (int q = 0; q < 16; ++q) { f32x4 wn = w, bn = b, rn = r, kn = kv;
                    if (q < 15) { wn = base[16 + q + 1]; bn = base[32 + q + 1]; rn = base[48 + q + 1]; kn = base[64 + q + 1]; }
#pragma unroll
                    for (int e = 0; e < 4; ++e) { const int k = 4 * q + e;
                        sp[k] = sp[k] * w[e] + saP * b[e]; sl[k] = sl[k] * w[e] + saL * b[e] + vj * kv[e];
                        yP += sp[k] * r[e]; yL += sl[k] * r[e]; }
                    __builtin_amdgcn_sched_barrier(0);
                    w = wn; b = bn; r = rn; kv = kn; }
                const size_t oi = ((size_t)(bh * SEQ + ck * CH + sb * 8 + st)) * 64 + lane;
                QH[oi] = yP; YL[oi] = yL; }
        }
        float* gp = GC + ((size_t)(bh * NCH + ck) * 64 + lane) * 64; float* hp = HC + ((size_t)(bh * NCH + ck) * 64 + lane) * 64;
#pragma unroll
        for (int q = 0; q < 16; ++q) { *(f32x4*)(gp + 4 * q) = (f32x4){sp[4 * q], sp[4 * q + 1], sp[4 * q + 2], sp[4 * q + 3]}; *(f32x4*)(hp + 4 * q) = (f32x4){sl[4 * q], sl[4 * q + 1], sl[4 * q + 2], sl[4 * q + 3]}; }
    }
}
__device__ __forceinline__ void p_s5_chain(KArgs& A, const Frame& F, int l) {
    const int gt = F.bid * NTHREADS + F.tid; if (gt >= NB * 16 * 64) return;
    const int b = gt >> 10, g = (gt >> 6) & 15, p = gt & 63;
    const float dt = expf(kin(A, I_S5_LOGDT)[l * 16 + g]); const float are = kin(A, I_S5_ARE)[(l * 16 + g) * 64 + p], aim = kin(A, I_S5_AIM)[(l * 16 + g) * 64 + p];
    const float mag = expf(are * dt * 64.0f); float sn, cs; sincosf(aim * dt * 64.0f, &sn, &cs); const float ar = mag * cs, ai = mag * sn;
    bf16* AO = (bf16*)(F.ws + WS_AOUT); const float* XL = (const float*)(F.ws + WS_XLOC);
    float xr = 0.f, xi = 0.f;
#pragma unroll 8
    for (int c = 0; c < NCH; ++c) { const size_t row = (size_t)g * NCHT + b * NCH + c;
        *(unsigned*)(AO + row * S5K + 1024 + 2 * p) = pk2(xr, xi);
        const f32x2 xl = *(const f32x2*)(XL + row * 128 + 2 * p);
        const float nr = ar * xr - ai * xi + xl.x, ni = ar * xi + ai * xr + xl.y; xr = nr; xi = ni; }
}
__device__ __forceinline__ void p_rw_chain(const Frame& F, int bh) {
    const int tid = F.tid, v = tid >> 3, kq = tid & 7;
    LAS float* Sl = (LAS float*)F.lds;
    LAS float* Gl = (LAS float*)(F.lds + 32768);
    const float* GC = (const float*)(F.ws + WS_GC) + (size_t)bh * NCH * 4096; const float* HC = (const float*)(F.ws + WS_HC) + (size_t)bh * NCH * 4096; float* SC = (float*)(F.ws + WS_SC) + (size_t)bh * NCH * 4096;
    *(LAS f32x4*)(Sl + tid * 8) = (f32x4){0, 0, 0, 0}; *(LAS f32x4*)(Sl + tid * 8 + 4) = (f32x4){0, 0, 0, 0};
    f32x4 g0 = *(const f32x4*)(GC + tid * 8), g1 = *(const f32x4*)(GC + tid * 8 + 4), h0 = *(const f32x4*)(HC + tid * 8), h1 = *(const f32x4*)(HC + tid * 8 + 4);
    f32x4 s0 = {0, 0, 0, 0}, s1 = s0;
#pragma unroll 1
    for (int c = 0; c < NCH; ++c) { const int cur = c & 1;
        *(f32x4*)(SC + (size_t)c * 4096 + tid * 8) = s0; *(f32x4*)(SC + (size_t)c * 4096 + tid * 8 + 4) = s1;
        *(LAS f32x4*)(Gl + tid * 8) = g0; *(LAS f32x4*)(Gl + tid * 8 + 4) = g1;
        f32x4 a0 = h0, a1 = h1;
        if (c + 1 < NCH) { g0 = *(const f32x4*)(GC + (size_t)(c + 1) * 4096 + tid * 8); g1 = *(const f32x4*)(GC + (size_t)(c + 1) * 4096 + tid * 8 + 4); h0 = *(const f32x4*)(HC + (size_t)(c + 1) * 4096 + tid * 8); h1 = *(const f32x4*)(HC + (size_t)(c + 1) * 4096 + tid * 8 + 4); }
        __syncthreads();
        const LAS float* sr = Sl + cur * 4096 + v * 64; const LAS float* gr = Gl + kq * 8;
#pragma unroll 8
        for (int j = 0; j < 64; ++j) { const float s = sr[j]; const f32x4 ga = *(const LAS f32x4*)(gr + j * 64), gb = *(const LAS f32x4*)(gr + j * 64 + 4); a0 += ga * s; a1 += gb * s; }
        s0 = a0; s1 = a1;
        *(LAS f32x4*)(Sl + (cur ^ 1) * 4096 + tid * 8) = s0; *(LAS f32x4*)(Sl + (cur ^ 1) * 4096 + tid * 8 + 4) = s1;
        __syncthreads();
    }
}
__device__ __forceinline__ void p_rw_out(KArgs& A, const Frame& F, int l) {
    const int gw = F.bid * NWAVES + F.wave, NGW = F.G * NWAVES, lane = F.lane;
    const float* RWOP = (const float*)(F.ws + WS_RWOP); const float* QH = (const float*)(F.ws + WS_QH); const float* YL = (const float*)(F.ws + WS_YL); const float* SC = (const float*)(F.ws + WS_SC);
    const float* RWG = (const float*)(F.ws + WS_RWG); const float* RK = (const float*)(F.ws + WS_RK); bf16* O16 = (bf16*)(F.ws + WS_O16);
    LAS float* Qw = (LAS float*)(F.lds + F.wave * 16384);
    for (int task = gw; task < 16 * NCH; task += NGW) { const int bh = task / NCH, ck = task % NCH, b = bh >> 2, head = bh & 3;
        const size_t ti0 = (size_t)(bh * SEQ + ck * CH); const int t0g = b * SEQ + ck * CH;
        { const f32x4* qsrc = (const f32x4*)(QH + ti0 * 64) + lane; LAS f32x4* qdst = (LAS f32x4*)Qw + lane;
#pragma unroll
          for (int i = 0; i < 16; ++i) qdst[i * 64] = qsrc[i * 64]; }
        float srow[64];
        { const f32x4* ssrc = (const f32x4*)(SC + (size_t)(bh * NCH + ck) * 4096 + lane * 64);
#pragma unroll
          for (int i = 0; i < 16; ++i) { const f32x4 x = ssrc[i]; srow[4 * i] = x.x; srow[4 * i + 1] = x.y; srow[4 * i + 2] = x.z; srow[4 * i + 3] = x.w; } }
        const float lgv = kin(A, I_RW_LNG)[l * 256 + head * 64 + lane], lbv = kin(A, I_RW_LNB)[l * 256 + head * 64 + lane];
        LDS_WAIT();
#pragma unroll 1
        for (int tb = 0; tb < CH; tb += 4) { float y[4], s1[4], s2[4];
#pragma unroll
            for (int u = 0; u < 4; ++u) { const int t = tb + u; float a = YL[(ti0 + t) * 64 + lane]; const LAS f32x4* qp = (const LAS f32x4*)(Qw + t * 64);
#pragma unroll
                for (int i = 0; i < 16; ++i) { const f32x4 qv = qp[i]; a += srow[4 * i] * qv.x; a += srow[4 * i + 1] * qv.y; a += srow[4 * i + 2] * qv.z; a += srow[4 * i + 3] * qv.w; }
                y[u] = a; s1[u] = a; s2[u] = a * a; }
#pragma unroll
            for (int o = 1; o < 64; o <<= 1) {
#pragma unroll
                for (int u = 0; u < 4; ++u) { s1[u] += __shfl_xor(s1[u], o); s2[u] += __shfl_xor(s2[u], o); } }
#pragma unroll
            for (int u = 0; u < 4; ++u) { const int t = tb + u; const float m = s1[u] * (1.f / 64), var = fmaxf(s2[u] * (1.f / 64) - m * m, 0.f); const float rstd = 1.0f / sqrtf(var + RW_LN_EPS);
                const float rk = RK[(size_t)(t0g + t) * 4 + head]; const float vv = RWOP[(ti0 + t) * 384 + 320 + lane]; const float gg = RWG[(size_t)(t0g + t) * 256 + head * 64 + lane];
                const float o = ((y[u] - m) * rstd * lgv + lbv + rk * vv) * gg;
                O16[(size_t)(t0g + t) * D + 512 + head * 64 + lane] = (bf16)f2bf(o); }
        }
        LDS_WAIT();
    }
}
__device__ __forceinline__ void p_attn(const Frame& F) {
    const int lane = F.lane, fr = lane & 15, fq = lane >> 4;
    const bf16* Q = (const bf16*)(F.ws + WS_Q16); const bf16* KM = (const bf16*)(F.ws + WS_KM16); const bf16* VT = (const bf16*)(F.ws + WS_VMT16); bf16* AO = (bf16*)(F.ws + WS_AO16);
    for (int unit = F.bid; unit < NB * 4 * (SEQ / 128); unit += F.G) {
        const int qb = unit % (SEQ / 128), bhd = unit / (SEQ / 128), head = bhd & 3, b = bhd >> 2;
        const int q0 = b * SEQ + qb * 128 + F.wave * 16;
        bf16x8 qf[8];
#pragma unroll
        for (int ks = 0; ks < 8; ++ks) qf[ks] = *(const bf16x8*)(Q + (size_t)(q0 + fr) * D + head * 256 + ks * 32 + fq * 8);
        f32x4 sT[16];
#pragma unroll
        for (int kt = 0; kt < 16; ++kt) { f32x4 a = {0, 0, 0, 0}; const bf16* kp = KM + (size_t)(b * NMEM + kt * 16 + fr) * D + head * 256 + fq * 8;
#pragma unroll
            for (int ks = 0; ks < 8; ++ks) { const bf16x8 kf = *(const bf16x8*)(kp + ks * 32); a = __builtin_amdgcn_mfma_f32_16x16x32_bf16(kf, qf[ks], a, 0, 0, 0); }
            sT[kt] = a; }
        float mx = -3.0e38f;
#pragma unroll
        for (int kt = 0; kt < 16; ++kt) mx = fmaxf(fmaxf(fmaxf(mx, sT[kt].x), fmaxf(sT[kt].y, sT[kt].z)), sT[kt].w);
        mx = fmaxf(mx, __shfl_xor(mx, 16)); mx = fmaxf(mx, __shfl_xor(mx, 32));
        float sum = 0.f;
#pragma unroll
        for (int kt = 0; kt < 16; ++kt) { sT[kt].x = __expf(sT[kt].x - mx); sT[kt].y = __expf(sT[kt].y - mx); sT[kt].z = __expf(sT[kt].z - mx); sT[kt].w = __expf(sT[kt].w - mx); sum += (sT[kt].x + sT[kt].y) + (sT[kt].z + sT[kt].w); }
        sum += __shfl_xor(sum, 16); sum += __shfl_xor(sum, 32);
        const float inv = 1.0f / sum;
        bf16x8 pf[8];
#pragma unroll
        for (int kp = 0; kp < 8; ++kp) { v4u w; w.x = pk2(sT[2 * kp].x, sT[2 * kp].y); w.y = pk2(sT[2 * kp].z, sT[2 * kp].w); w.z = pk2(sT[2 * kp + 1].x, sT[2 * kp + 1].y); w.w = pk2(sT[2 * kp + 1].z, sT[2 * kp + 1].w);
            pf[kp] = __builtin_bit_cast(bf16x8, w); }
#pragma unroll 4
        for (int dt = 0; dt < 16; ++dt) { f32x4 o = {0, 0, 0, 0}; const bf16* vp = VT + ((size_t)(b * D + head * 256 + dt * 16 + fr)) * NMEM + 4 * fq;
#pragma unroll
            for (int kp = 0; kp < 8; ++kp) { const v2u lo = *(const v2u*)(vp + 32 * kp), hi = *(const v2u*)(vp + 32 * kp + 16); v4u w; w.x = lo.x; w.y = lo.y; w.z = hi.x; w.w = hi.y;
                o = __builtin_amdgcn_mfma_f32_16x16x32_bf16(__builtin_bit_cast(bf16x8, w), pf[kp], o, 0, 0, 0); }
            v2u w; w.x = pk2(o.x * inv, o.y * inv); w.y = pk2(o.z * inv, o.w * inv);
            *(v2u*)(AO + (size_t)(q0 + fr) * D + head * 256 + dt * 16 + 4 * fq) = w; }
    }
}

__device__ __forceinline__ void p_ln(const Frame& F, const float* g, const float* b) {
    const int gw = F.bid * NWAVES + F.wave, NGW = F.G * NWAVES, lane = F.lane; float* H = (float*)(F.ws + WS_H32); bf16* H16 = (bf16*)(F.ws + WS_H16);
    for (int r = gw; r < T; r += NGW) { f32x4 v[4];
#pragma unroll
        for (int j = 0; j < 4; ++j) v[j] = *(const f32x4*)(H + (size_t)r * D + 256 * j + 4 * lane);
        float mean, rstd; ln_stats(v, mean, rstd); ln_apply_store(v, mean, rstd, g, b, H + (size_t)r * D, H16 + (size_t)r * D, lane); }
}
__device__ __forceinline__ void p_ln_router(KArgs& A, const Frame& F, int l) {
    const int gw = F.bid * NWAVES + F.wave, NGW = F.G * NWAVES, lane = F.lane, tid = F.tid;
    float* H = (float*)(F.ws + WS_H32); bf16* H16 = (bf16*)(F.ws + WS_H16); int* TOKE = (int*)(F.ws + WS_TOKE); float* TOKW = (float*)(F.ws + WS_TOKW);
    LAS float* RW = (LAS float*)F.lds;
    volatile LAS unsigned* hist = F.MISC + MI_HIST;
    const float* rw = kin(A, I_ROUTER_W) + (size_t)l * D * NE; const float* rb = kin(A, I_ROUTER_B) + l * NE; const float* g = kin(A, I_LN2_G) + l * D; const float* bb = kin(A, I_LN2_B) + l * D;
    for (int i = tid; i < D * NE / 4; i += NTHREADS) { const int d = i >> 3, e4 = (i & 7) * 4; *(LAS f32x4*)(RW + d * 36 + e4) = *(const f32x4*)(rw + d * NE + e4); }
    if (tid < NE) hist[tid] = 0u;
    __syncthreads();
    for (int r = gw; r < T; r += NGW) { float v[16]; float s = 0.f;
#pragma unroll
        for (int jj = 0; jj < 16; ++jj) { v[jj] = H[(size_t)r * D + 64 * jj + lane]; s += v[jj]; }
        const float mean = wave_sum(s) * (1.f / D); float s2 = 0.f;
#pragma unroll
        for (int jj = 0; jj < 16; ++jj) { v[jj] -= mean; s2 += v[jj] * v[jj]; }
        const float rstd = 1.0f / sqrtf(wave_sum(s2) * (1.f / D) + LN_EPS);
        float lg[NE];
#pragma unroll
        for (int e = 0; e < NE; ++e) lg[e] = 0.f;
#pragma unroll
        for (int jj = 0; jj < 16; ++jj) { const int d = 64 * jj + lane; const float y = v[jj] * rstd * g[d] + bb[d]; H[(size_t)r * D + d] = y; H16[(size_t)r * D + d] = (bf16)f2bf(y);
            const LAS f32x4* wp = (const LAS f32x4*)(RW + d * 36);
#pragma unroll
            for (int e4 = 0; e4 < 8; ++e4) { const f32x4 w = wp[e4]; lg[4 * e4] += y * w.x; lg[4 * e4 + 1] += y * w.y; lg[4 * e4 + 2] += y * w.z; lg[4 * e4 + 3] += y * w.w; } }
#pragma unroll
        for (int e = 0; e < NE; ++e) { lg[e] = wave_sum(lg[e]) + rb[e]; }
        int i0 = -1, i1 = -1, i2 = -1, i3 = -1; float v0 = -3.0e38f, v1 = -3.0e38f, v2 = -3.0e38f, v3 = -3.0e38f;
#pragma unroll
        for (int e = 0; e < NE; ++e) if (lg[e] > v0) { v0 = lg[e]; i0 = e; }
#pragma unroll
        for (int e = 0; e < NE; ++e) if (e != i0 && lg[e] > v1) { v1 = lg[e]; i1 = e; }
#pragma unroll
        for (int e = 0; e < NE; ++e) if (e != i0 && e != i1 && lg[e] > v2) { v2 = lg[e]; i2 = e; }
#pragma unroll
        for (int e = 0; e < NE; ++e) if (e != i0 && e != i1 && e != i2 && lg[e] > v3) { v3 = lg[e]; i3 = e; }
        const float e1 = __expf(v1 - v0), e2 = __expf(v2 - v0), e3 = __expf(v3 - v0), inv = 1.0f / (1.0f + e1 + e2 + e3);
        if (lane == 0) { *(int4*)(TOKE + (size_t)r * 4) = make_int4(i0, i1, i2, i3); *(f32x4*)(TOKW + (size_t)r * 4) = (f32x4){inv, e1 * inv, e2 * inv, e3 * inv};
            __hip_atomic_fetch_add((LAS unsigned*)&hist[i0], 1u, __ATOMIC_RELAXED, __HIP_MEMORY_SCOPE_WORKGROUP); __hip_atomic_fetch_add((LAS unsigned*)&hist[i1], 1u, __ATOMIC_RELAXED, __HIP_MEMORY_SCOPE_WORKGROUP);
            __hip_atomic_fetch_add((LAS unsigned*)&hist[i2], 1u, __ATOMIC_RELAXED, __HIP_MEMORY_SCOPE_WORKGROUP); __hip_atomic_fetch_add((LAS unsigned*)&hist[i3], 1u, __ATOMIC_RELAXED, __HIP_MEMORY_SCOPE_WORKGROUP); }
    }
    __syncthreads();
    if (tid < NE) { const unsigned c = hist[tid]; if (c) atomicAdd(F.ctl + CW_CNT + l * NE + tid, c); }
}
__device__ __forceinline__ void moe_offsets(const Frame& F, int l) {
    if (F.tid == 0) { int acc = 0;
        for (int e = 0; e < NE; ++e) { F.MISC[MI_TOFF + e] = (unsigned)acc; const unsigned c = __hip_atomic_load(F.ctl + CW_CNT + l * NE + e, __ATOMIC_RELAXED, __HIP_MEMORY_SCOPE_AGENT); acc += (int)((c + 255u) >> 8); }
        F.MISC[MI_TOFF + NE] = (unsigned)acc; }
    __syncthreads();
}
__device__ __forceinline__ void p_moe_slots(const Frame& F, int l) {
    const int gw = F.bid * NWAVES + F.wave, NGW = F.G * NWAVES, lane = F.lane;
    moe_offsets(F, l);
    const int* TOKE = (const int*)(F.ws + WS_TOKE); const float* TOKW = (const float*)(F.ws + WS_TOKW); int* TOKS = (int*)(F.ws + WS_TOKS); float* SLOTW = (float*)(F.ws + WS_SLOTW);
    const bf16* H16 = (const bf16*)(F.ws + WS_H16); bf16* XG = (bf16*)(F.ws + WS_XG);
    for (int r = gw; r < T; r += NGW) { int slot = 0;
        if (lane < 4) { const int e = TOKE[(size_t)r * 4 + lane]; const unsigned pos = atomicAdd(F.ctl + CW_CUR + l * NE + e, 1u); slot = (int)F.MISC[MI_TOFF + e] * 256 + (int)pos;
            TOKS[(size_t)r * 4 + lane] = slot; SLOTW[slot] = TOKW[(size_t)r * 4 + lane]; }
        const v4u a = *(const v4u*)(H16 + (size_t)r * D + 8 * lane), b = *(const v4u*)(H16 + (size_t)r * D + 512 + 8 * lane);
#pragma unroll
        for (int k = 0; k < 4; ++k) { const int sk = __shfl(slot, k); *(v4u*)(XG + (size_t)sk * D + 8 * lane) = a; *(v4u*)(XG + (size_t)sk * D + 512 + 8 * lane) = b; } }
}
__device__ __forceinline__ void p_moe_combine(KArgs& A, const Frame& F, int l) {
    const int gw = F.bid * NWAVES + F.wave, NGW = F.G * NWAVES, lane = F.lane;
    float* H = (float*)(F.ws + WS_H32); bf16* H16 = (bf16*)(F.ws + WS_H16); const int* TOKS = (const int*)(F.ws + WS_TOKS); const bf16* YS = (const bf16*)(F.ws + WS_YS);
    const bool last = (l == NL - 1);
    for (int r = gw; r < T; r += NGW) { f32x4 v[4]; const int4 sl = *(const int4*)(TOKS + (size_t)r * 4);
#pragma unroll
        for (int j = 0; j < 4; ++j) { v[j] = *(const f32x4*)(H + (size_t)r * D + 256 * j + 4 * lane) * DN_ALPHA;
            const v2u y0 = *(const v2u*)(YS + (size_t)sl.x * D + 256 * j + 4 * lane), y1 = *(const v2u*)(YS + (size_t)sl.y * D + 256 * j + 4 * lane), y2 = *(const v2u*)(YS + (size_t)sl.z * D + 256 * j + 4 * lane), y3 = *(const v2u*)(YS + (size_t)sl.w * D + 256 * j + 4 * lane);
            v[j].x += (bf2f(y0.x & 0xffffu) + bf2f(y1.x & 0xffffu)) + (bf2f(y2.x & 0xffffu) + bf2f(y3.x & 0xffffu));
            v[j].y += (bf2f(y0.x >> 16) + bf2f(y1.x >> 16)) + (bf2f(y2.x >> 16) + bf2f(y3.x >> 16));
            v[j].z += (bf2f(y0.y & 0xffffu) + bf2f(y1.y & 0xffffu)) + (bf2f(y2.y & 0xffffu) + bf2f(y3.y & 0xffffu));
            v[j].w += (bf2f(y0.y >> 16) + bf2f(y1.y >> 16)) + (bf2f(y2.y >> 16) + bf2f(y3.y >> 16)); }
        float mean, rstd; ln_stats(v, mean, rstd);
        if (last) ln_apply_store(v, mean, rstd, kin(A, I_LN3_G) + l * D, kin(A, I_LN3_B) + l * D, kout(A) + (size_t)r * D, (bf16*)nullptr, lane);
        else ln_apply_store(v, mean, rstd, kin(A, I_LN3_G) + l * D, kin(A, I_LN3_B) + l * D, H + (size_t)r * D, H16 + (size_t)r * D, lane); }
}

constexpr int NPL = 18;
constexpr int NPHASES = 1 + NL * NPL;
#ifndef ONLY
#define ONLY -1
#endif
#define EN(j) (ONLY < 0 || ONLY == (j))
__global__ void __launch_bounds__(NTHREADS, 2) fwd_kernel(Args args) {
    extern __shared__ __attribute__((aligned(16))) unsigned char lds_raw[];
    Frame F;
    F.lds = (LAS unsigned char*)lds_raw; F.MISC = (volatile LAS unsigned*)(F.lds + MISC_OFF);
    F.tid = threadIdx.x; F.lane = F.tid & 63; F.wave = __builtin_amdgcn_readfirstlane(F.tid >> 6); F.G = gridDim.x; F.bid = blockIdx.x;
    F.ws = (unsigned char*)(GAS unsigned char*)args.ws; F.ctl = (unsigned*)(F.ws + WS_CTL);
    for (int u = F.tid; u < (LDS_BYTES - MISC_OFF) / 4; u += NTHREADS) F.MISC[u] = 0u;
    __syncthreads();
    XcdBarrier bar; bar.bar = F.ctl + CW_BAR; bar.x = 0; bar.st = nullptr;
    const int lo = args.ph_lo, hi = args.ph_hi;
    if (hi - lo > 1) bar = xcd_barrier_post(F.ctl + CW_BAR, F.MISC + 8);
#define IN(k) (launder_i(lo) <= (k) && (k) < launder_i(hi))
#define SEAM(k) do { if (IN(k) && IN((k) + 1)) xcd_barrier(bar); } while (0)
#define PH_BEGIN KArgs& KA = *kargs(); unsigned char* ws = launder_p(args.ws); F.ws = ws; (void)KA; (void)ws; { int ln_; asm volatile("v_mbcnt_lo_u32_b32 %0, -1, 0\n\tv_mbcnt_hi_u32_b32 %0, -1, %0" : "=v"(ln_)); F.lane = ln_; } F.tid = F.wave * 64 + F.lane; F.bid = launder_i((int)blockIdx.x); F.G = launder_i((int)gridDim.x);

    if (EN(100) && IN(0)) { PH_BEGIN p_prologue(KA, F); } SEAM(0);

#pragma unroll 1
    for (int l_ = 0; l_ < NL; ++l_) {
        const int l = launder_i(l_); const int p0 = 1 + l * NPL;
        if (EN(0) && IN(p0 + 0)) { PH_BEGIN
            pg8::Gemm g{D, D, D}; pg8::StaticOrder S{(const bf16*)(ws + WS_H16), (const bf16*)(ws + WS_WINT) + (size_t)l * N_IN * D, D, D, T / 256, N_IN / 256, F.G, F.bid};
            EpiIn E{l};
            pg8::gemm_phase(F.lds, F.tid, g, S, E);
        } SEAM(p0 + 0);
        if (EN(1) && IN(p0 + 1)) { PH_BEGIN p_mix1(KA, F, l); } SEAM(p0 + 1);
        if (EN(2) && IN(p0 + 2)) { PH_BEGIN
            { pg8::Gemm g{S5K, 1024, 1024}; pg8::BatchOrder S{(const bf16*)(ws + WS_AOUT), (const bf16*)(ws + WS_S5BC) + (size_t)l * 16 * 256 * 1024, S5K, 1024, NCHT / 256, 1, 16, F.G, F.bid, (size_t)NCHT * S5K, (size_t)256 * 1024};
              EpiXloc E{0}; pg8::gemm_phase(F.lds, F.tid, g, S, E); }
            __syncthreads();
            { pg8::Gemm g{D, D, D}; pg8::StaticOrder S{(const bf16*)(ws + WS_MEM16), (const bf16*)(ws + WS_WKT) + (size_t)l * D * D, D, D, NB * NMEM / 256, D / 256, F.G, F.bid};
              EpiBf16 E{(unsigned)(WS_KM16 / MiB), 1.0f}; pg8::gemm_phase(F.lds, F.tid, g, S, E); }
            __syncthreads();
            { pg8::Gemm g{D, D, D}; pg8::StaticOrder S{(const bf16*)(ws + WS_MEM16), (const bf16*)(ws + WS_WVT) + (size_t)l * D * D, D, D, NB * NMEM / 256, D / 256, F.G, F.bid};
              EpiVT E{0}; pg8::gemm_phase(F.lds, F.tid, g, S, E); }
        } SEAM(p0 + 2);
        if (EN(3) && IN(p0 + 3)) { PH_BEGIN p_s5_chain(KA, F, l); p_rw_chunks(F); } SEAM(p0 + 3);
        if (EN(4) && IN(p0 + 4)) { PH_BEGIN
            const int nchain = (F.G >= 32) ? 16 : 0;
            if (F.bid < nchain) { p_rw_chain(F, F.bid); }
            else {
                if (nchain == 0) { for (int bh = F.bid; bh < 16; bh += F.G) { p_rw_chain(F, bh); __syncthreads(); } }
                pg8::Gemm g{S5K, S5K, S5K}; pg8::BatchOrder S{(const bf16*)(ws + WS_AOUT), (const bf16*)(ws + WS_S5BT) + (size_t)l * 16 * 1024 * S5K, S5K, S5K, NCHT / 256, 1024 / 256, 16, F.G - nchain, F.bid - nchain, (size_t)NCHT * S5K, (size_t)1024 * S5K};
                EpiS5Y E{l}; pg8::gemm_phase(F.lds, F.tid, g, S, E);
            }
        } SEAM(p0 + 4);
        if (EN(5) && IN(p0 + 5)) { PH_BEGIN p_rw_out(KA, F, l); } SEAM(p0 + 5);
        if (EN(6) && IN(p0 + 6)) { PH_BEGIN
            { pg8::Gemm g{256, 256, 256}; pg8::StaticOrder S{(const bf16*)(ws + WS_YD16), (const bf16*)(ws + WS_GLUT) + (size_t)l * 256 * 256, 256, 256, T / 256, 1, F.G, F.bid};
              EpiGlu E{l}; pg8::gemm_phase(F.lds, F.tid, g, S, E); }
        } SEAM(p0 + 6);
        if (EN(7) && IN(p0 + 7)) { PH_BEGIN
#pragma unroll 1
            for (int br = 0; br < 4; ++br) {
                pg8::Gemm g{D, 256, 256}; pg8::StaticOrder S{(const bf16*)(ws + WS_O16) + br * 256, (const bf16*)(ws + WS_BRT) + (size_t)(l * 4 + br) * D * 256, D, 256, T / 256, D / 256, F.G, F.bid};
                EpiBranch E{br}; pg8::gemm_phase(F.lds, F.tid, g, S, E);
                VM_WAIT(); __syncthreads();
            }
        } SEAM(p0 + 7);
        if (EN(8) && IN(p0 + 8)) { PH_BEGIN
            pg8::Gemm g{D, D, D}; pg8::StaticOrder S{(const bf16*)(ws + WS_MG16), (const bf16*)(ws + WS_WOUTT) + (size_t)l * D * D, D, D, T / 256, D / 256, F.G, F.bid};
            EpiResid E{0}; pg8::gemm_phase(F.lds, F.tid, g, S, E);
        } SEAM(p0 + 8);
        if (EN(9) && IN(p0 + 9)) { PH_BEGIN p_ln(F, kin(KA, I_LN1_G) + l * D, kin(KA, I_LN1_B) + l * D); } SEAM(p0 + 9);
        if (EN(10) && IN(p0 + 10)) { PH_BEGIN
            pg8::Gemm g{D, D, D}; pg8::StaticOrder S{(const bf16*)(ws + WS_H16), (const bf16*)(ws + WS_WQT) + (size_t)l * D * D, D, D, T / 256, D / 256, F.G, F.bid};
            EpiBf16 E{(unsigned)(WS_Q16 / MiB), 0.0625f}; pg8::gemm_phase(F.lds, F.tid, g, S, E);
        } SEAM(p0 + 10);
        if (EN(11) && IN(p0 + 11)) { PH_BEGIN p_attn(F); } SEAM(p0 + 11);
        if (EN(12) && IN(p0 + 12)) { PH_BEGIN
            pg8::Gemm g{D, D, D}; pg8::StaticOrder S{(const bf16*)(ws + WS_AO16), (const bf16*)(ws + WS_WOT) + (size_t)l * D * D, D, D, T / 256, D / 256, F.G, F.bid};
            EpiResid E{0}; pg8::gemm_phase(F.lds, F.tid, g, S, E);
        } SEAM(p0 + 12);
        if (EN(13) && IN(p0 + 13)) { PH_BEGIN p_ln_router(KA, F, l); } SEAM(p0 + 13);
        if (EN(14) && IN(p0 + 14)) { PH_BEGIN p_moe_slots(F, l); } SEAM(p0 + 14);
        if (EN(15) && IN(p0 + 15)) { PH_BEGIN
            moe_offsets(F, l);
            pg8::Gemm g{D, D, D}; pg8::MoeOrder S{(const bf16*)(ws + WS_XG), (const bf16*)(ws + WS_W1T) + (size_t)l * NE * 2048 * D, D, D, 2048 / 256, F.G, F.bid, (size_t)2048 * D, (const LAS int*)(F.MISC + MI_TOFF)};
            EpiSwiglu E{l}; pg8::gemm_phase(F.lds, F.tid, g, S, E);
        } SEAM(p0 + 15);
        if (EN(16) && IN(p0 + 16)) { PH_BEGIN
            moe_offsets(F, l);
            pg8::Gemm g{DFF, DFF, DFF}; pg8::MoeOrder S{(const bf16*)(ws + WS_ACT), (const bf16*)(ws + WS_W2T) + (size_t)l * NE * D * DFF, DFF, DFF, D / 256, F.G, F.bid, (size_t)D * DFF, (const LAS int*)(F.MISC + MI_TOFF)};
            EpiMoeOut E{l}; pg8::gemm_phase(F.lds, F.tid, g, S, E);
        } SEAM(p0 + 16);
        if (EN(17) && IN(p0 + 17)) { PH_BEGIN p_moe_combine(KA, F, l); } SEAM(p0 + 17);
    }
#undef IN
#undef SEAM
}

extern "C" void kernel_launch(void* const* d_in, const int* in_sizes, int n_in, void* d_out, int out_size, void* d_ws, size_t ws_size, hipStream_t stream) {
    static int grid = 0;
    if (grid == 0) {
        if (n_in != 50 || ws_size < WS_END) { fprintf(stderr, "kernel_launch: unexpected n_in %d / ws_size %zu\n", n_in, ws_size); grid = -1; return; }
        int dev = 0, cus = 0, per_cu = 0;
        if (hipGetDevice(&dev) != hipSuccess || hipDeviceGetAttribute(&cus, hipDeviceAttributeMultiprocessorCount, dev) != hipSuccess) { grid = -1; return; }
        if (hipFuncSetAttribute((const void*)fwd_kernel, hipFuncAttributeMaxDynamicSharedMemorySize, LDS_BYTES) != hipSuccess) { fprintf(stderr, "kernel_launch: hipFuncSetAttribute failed\n"); grid = -1; return; }
        if (hipOccupancyMaxActiveBlocksPerMultiprocessor(&per_cu, (const void*)fwd_kernel, NTHREADS, LDS_BYTES) != hipSuccess || per_cu < 1) { fprintf(stderr, "kernel_launch: occupancy query says %d\n", per_cu); }
        (void)hipGetLastError();
        grid = cus;
    }
    if (grid < 0) return;
    (void)hipMemsetAsync((char*)d_ws + WS_CTL, 0, CTL_ZERO_BYTES, stream);
    Args a{};
    for (int i = 0; i < 50; ++i) a.in[i] = (const float*)d_in[i];
    a.out = (float*)d_out; a.ws = (unsigned char*)d_ws;
#if N_LAUNCHES == 1
    a.ph_lo = 0; a.ph_hi = NPHASES;
    hipLaunchKernelGGL(fwd_kernel, dim3(grid), dim3(NTHREADS), LDS_BYTES, stream, a);
#else
    for (int p = 0; p < NPHASES; ++p) { a.ph_lo = p; a.ph_hi = p + 1; hipLaunchKernelGGL(fwd_kernel, dim3(grid), dim3(NTHREADS), LDS_BYTES, stream, a); }
#endif
}
```

```cpp
#include <hip/hip_runtime.h>
#include <cstdio>
#include <cstdint>

#ifndef N_LAUNCHES
#define N_LAUNCHES 1
#endif

#ifndef PROBE_PHASE
#define PROBE_PHASE -1
#endif
#ifndef PROBE_REPS
#define PROBE_REPS 3
#endif
#define GAS __attribute__((address_space(1)))
#define LAS __attribute__((address_space(3)))
typedef unsigned short bf16;
typedef unsigned v4u __attribute__((ext_vector_type(4)));
typedef unsigned v2u __attribute__((ext_vector_type(2)));
typedef float f32x4 __attribute__((ext_vector_type(4)));
typedef float f32x2 __attribute__((ext_vector_type(2)));
typedef short bf16x8 __attribute__((ext_vector_type(8)));
typedef short bf16x4 __attribute__((ext_vector_type(4)));

constexpr int NL = 2, NB = 4, SEQ = 8192, T = NB * SEQ, D = 1024;
constexpr int NMEM = 256;
constexpr int OFF_B = 768, OFF_C = 1280, OFF_D = 2304, OFF_G = 2560, N_IN = 6656, ZLD = 2560;
constexpr int NE = 32, TOPK = 4, DFF = 1024;
constexpr int CH = 64;
constexpr int NCH = SEQ / CH;
constexpr int NCHT = T / CH;
constexpr int S5K = 1152;
constexpr int SLOT_ROWS = T * TOPK + NE * 256;
constexpr float LN_EPS = 1e-5f, RW_LN_EPS = 64e-5f;
constexpr float DN_ALPHA = 1.41421356237309515f;

constexpr size_t MiB = 1u << 20;
constexpr size_t WS_CTL = 0, CTL_ZERO_BYTES = 1 * MiB;
constexpr size_t WS_W1T = 2 * MiB;
constexpr size_t WS_W2T = 258 * MiB;
constexpr size_t WS_WINT = 386 * MiB;
constexpr size_t WS_BRT = 412 * MiB;
constexpr size_t WS_WOUTT = 416 * MiB, WS_WQT = 420 * MiB, WS_WKT = 424 * MiB, WS_WVT = 428 * MiB, WS_WOT = 432 * MiB;
constexpr size_t WS_GLUT = 436 * MiB;
constexpr size_t WS_MEM16 = 437 * MiB;
constexpr size_t WS_S5BT = 440 * MiB;
constexpr size_t WS_S5BC = 512 * MiB;
constexpr size_t WS_H32 = 528 * MiB;
constexpr size_t WS_H16 = 656 * MiB;
constexpr size_t WS_Z = 720 * MiB;
constexpr size_t WS_XG = 720 * MiB;
constexpr size_t WS_SG = 1040 * MiB;
constexpr size_t WS_YS = 1040 * MiB;
constexpr size_t WS_O16 = 1312 * MiB, WS_MG16 = 1376 * MiB, WS_Q16 = 1440 * MiB, WS_AO16 = 1504 * MiB;
constexpr size_t WS_RWOP = 1568 * MiB;
constexpr size_t WS_ACT = 1568 * MiB;
constexpr size_t WS_QH = 1760 * MiB, WS_YL = 1792 * MiB, WS_GC = 1824 * MiB, WS_HC = 1856 * MiB, WS_SC = 1888 * MiB, WS_RWG = 1920 * MiB;
constexpr size_t WS_RK = 1952 * MiB;
constexpr size_t WS_AOUT = 1954 * MiB;
constexpr size_t WS_XLOC = 1972 * MiB;
constexpr size_t WS_YD16 = 1976 * MiB;
constexpr size_t WS_KM16 = 1992 * MiB, WS_VMT16 = 1994 * MiB;
constexpr size_t WS_TOKE = 1996 * MiB, WS_TOKW = 1997 * MiB, WS_TOKS = 1998 * MiB, WS_SLOTW = 1999 * MiB;
constexpr size_t WS_GB = 2000 * MiB, WS_HB = 2004 * MiB, WS_SB = 2008 * MiB;
constexpr size_t WS_END = 2012 * MiB;
static_assert(WS_XG + (size_t)SLOT_ROWS * D * 2 <= WS_SG && WS_YS + (size_t)SLOT_ROWS * D * 2 <= WS_O16 && WS_ACT + (size_t)SLOT_ROWS * D * 2 <= WS_RK, "overlays");
constexpr int CW_BAR = 4096;
constexpr int CW_CNT = 16384;
constexpr int CW_CUR = 16384 + 128;

constexpr int LDS_BYTES = 163840;
constexpr int MISC_OFF = LDS_BYTES - 1024;
constexpr int RING_BYTES = 131072;
constexpr int NWAVES = 8, NTHREADS = 512;

#define LDS_WAIT() asm volatile("s_waitcnt lgkmcnt(0)" ::: "memory")
#define VM_WAIT() asm volatile("s_waitcnt vmcnt(0)" ::: "memory")
__device__ __forceinline__ unsigned f2bf(float f) { unsigned u = __float_as_uint(f); return (u + 0x7fffu + ((u >> 16) & 1u)) >> 16; }
__device__ __forceinline__ unsigned pk2(float lo, float hi) { return f2bf(lo) | (f2bf(hi) << 16); }
__device__ __forceinline__ float bf2f(unsigned h) { return __uint_as_float(h << 16); }
__device__ __forceinline__ float sigmoidf_(float x) { return 1.0f / (1.0f + __expf(-x)); }
__device__ __forceinline__ int my_lane() { int l; asm volatile("v_mbcnt_lo_u32_b32 %0, -1, 0\n\tv_mbcnt_hi_u32_b32 %0, -1, %0" : "=v"(l)); return l; }
__device__ __forceinline__ float shfl_xor_l(float v, int o, int lane) { return __builtin_bit_cast(float, __builtin_amdgcn_ds_bpermute((lane ^ o) << 2, __builtin_bit_cast(int, v))); }
__device__ __forceinline__ int shfl_idx_l(int v, int src) { return __builtin_amdgcn_ds_bpermute(src << 2, v); }
__device__ __forceinline__ float wave_sum(float v) {
    const int ln = my_lane();
#pragma unroll
    for (int o = 1; o < 64; o <<= 1) v += shfl_xor_l(v, o, ln);
    return v;
}

#define XB_TMO      128
#define XB_XCNT(j)  (256  + 64 * (j))
#define XB_XSUB(j)  (1280 + 64 * (j))
#define XB_XGEN(j)  (2304 + 64 * (j))
#define XB_TOP      3328
#define XB_TOPGEN   3392
#define XCD_BAR_WORDS 3456
#define XB_SPIN_CAP (1u << 24)
__device__ __forceinline__ unsigned xb_ld(unsigned* p)              { return __hip_atomic_load(p, __ATOMIC_RELAXED, __HIP_MEMORY_SCOPE_AGENT); }
__device__ __forceinline__ unsigned xb_add(unsigned* p, unsigned v) { return __hip_atomic_fetch_add(p, v, __ATOMIC_RELAXED, __HIP_MEMORY_SCOPE_AGENT); }
__device__ __forceinline__ unsigned xb_xcc_id() { return (unsigned)__builtin_amdgcn_s_getreg((3 << 11) | 20) & 0xFu; }
#define XB_SPIN(cond, bar) do { unsigned _sp = 0; while (cond) { __builtin_amdgcn_s_sleep(1); \
    if ((++_sp & 255u) == 0u) { if (xb_ld(&(bar)[XB_TMO])) break; if (_sp > XB_SPIN_CAP) { atomicAdd(&(bar)[XB_TMO], 1u); break; } } } } while (0)
struct XcdBarrier { unsigned* bar; unsigned x; volatile LAS unsigned* st; };
__device__ __forceinline__ XcdBarrier xcd_barrier_post(unsigned* bar, volatile LAS unsigned* st) {
    XcdBarrier b; b.bar = bar; b.x = xb_xcc_id(); b.st = st;
    if (threadIdx.x == 0) (void)xb_add(&bar[XB_XCNT(b.x)], 1u);
    return b;
}
__device__ __forceinline__ void xcd_barrier_complete(unsigned* bar, unsigned x, unsigned& nloc, unsigned& nx) {
    const unsigned G = gridDim.x * gridDim.y * gridDim.z;
    unsigned sum, cnt, mine, sp = 0u;
    for (;;) {
        sum = 0u; cnt = 0u; mine = 0u;
#pragma unroll
        for (unsigned j = 0; j < 16; ++j) { const unsigned c = xb_ld(&bar[XB_XCNT(j)]); sum += c; cnt += (c > 0u) ? 1u : 0u; mine = (j == x) ? c : mine; }
        if (sum == G) break;
        __builtin_amdgcn_s_sleep(1);
        if ((++sp & 255u) == 0u) { if (xb_ld(&bar[XB_TMO])) break; if (sp > XB_SPIN_CAP) { atomicAdd(&bar[XB_TMO], 1u); break; } }
    }
    nloc = mine > 0u ? mine : 1u; nx = cnt > 0u ? cnt : 1u;
}
__device__ __forceinline__ void xcd_barrier(const XcdBarrier& b) {
    asm volatile("s_waitcnt vmcnt(0)" ::: "memory");
    __syncthreads();
    if (threadIdx.x == 0) {
        unsigned* bar = b.bar; unsigned bx = b.x;
        asm volatile("" : "+s"(bar), "+s"(bx));
        __builtin_amdgcn_s_waitcnt(0);
        unsigned nloc = b.st[0], nx = b.st[1];
        if (nloc == 0u) { xcd_barrier_complete(bar, bx, nloc, nx); b.st[0] = nloc; b.st[1] = nx; }
        const unsigned old = xb_add(&bar[XB_XSUB(bx)], 1u);
        const unsigned gen = old / nloc;
        if (old + 1u == (gen + 1u) * nloc) {
            __builtin_amdgcn_fence(__ATOMIC_RELEASE, "agent");
            asm volatile("s_waitcnt vmcnt(0)" ::: "memory");
            const unsigned og = xb_add(&bar[XB_TOP], 1u);
            const unsigned tg = og / nx;
            if (og + 1u == (tg + 1u) * nx) xb_add(&bar[XB_TOPGEN], 1u);
            else XB_SPIN(xb_ld(&bar[XB_TOPGEN]) == tg, bar);
            __builtin_amdgcn_fence(__ATOMIC_ACQUIRE, "agent");
            xb_add(&bar[XB_XGEN(bx)], 1u);
            asm volatile("s_waitcnt vmcnt(0)" ::: "memory");
        } else {
            XB_SPIN(xb_ld(&bar[XB_XGEN(bx)]) == gen, bar);
            __builtin_amdgcn_fence(__ATOMIC_ACQUIRE, "agent");
            asm volatile("s_waitcnt vmcnt(0)" ::: "memory");
        }
    }
    __syncthreads();
}

namespace pg8 {
constexpr int BM = 256, BK = 64, HALF = 128, HTB = HALF * BK * 2, STAGE_BYTES = 8 * HTB, NXCD = 8, WGM = 8;
__host__ __device__ __forceinline__ int lds_byte(int r, int c) { const int st = (r >> 4) * 2 + (c >> 5), rr = r & 15, cc = c & 31, ob = rr * 64 + cc * 2; return st * 1024 + (ob ^ (((ob >> 9) & 1) << 5)); }
__host__ __device__ __forceinline__ void stage_rc(int b, int& R, int& C) { const int st = b / 1024, sb = b % 1024, swz = sb ^ (((sb >> 9) & 1) << 5); R = (st >> 1) * 16 + swz / 64; C = (st & 1) * 32 + (swz % 64) / 2; }
struct Unit { int pm, pn, e; };
struct Gemm { int lda, ldb, K; };

__device__ __forceinline__ bool static_tile(int i, int G, int c, int nM, int nN, int& pm, int& pn) {
    const int nwg = nM * nN; const long L = (long)i * G + c; if (L >= nwg) return false;
    int wgid = (int)L; { const int q = nwg / NXCD, r = nwg % NXCD, xcd = wgid % NXCD, off = wgid / NXCD; wgid = (xcd < r ? xcd * (q + 1) : r * (q + 1) + (xcd - r) * q) + off; }
    const int nig = WGM * nN, gid = wgid / nig, fm = gid * WGM, gsz = (nM - fm) < WGM ? (nM - fm) : WGM;
    pm = fm + ((wgid % nig) % gsz); pn = (wgid % nig) / gsz; return true;
}
struct StaticOrder {
    const bf16* A; const bf16* Bt; int lda, ldb, nM, nN, G, c;
    __device__ __forceinline__ bool next(int i, Unit& u) const { u.e = 0; return static_tile(i, G, c, nM, nN, u.pm, u.pn); }
    __device__ __forceinline__ const char* a_base(const Unit& u) const { return (const char*)(A + (size_t)u.pm * BM * lda); }
    __device__ __forceinline__ const char* b_base(const Unit& u) const { return (const char*)(Bt + (size_t)u.pn * BM * ldb); }
};
struct BatchOrder {
    const bf16* A; const bf16* Bt; int lda, ldb, nM, nN, nb, G, c; size_t sA, sB;
    __device__ __forceinline__ bool next(int i, Unit& u) const {
        const long L = (long)i * G + c; const int per = nM * nN; if (L >= (long)per * nb) return false;
        u.e = (int)(L / per); const int r = (int)(L % per); u.pn = r / nM; u.pm = r % nM; return true; }
    __device__ __forceinline__ const char* a_base(const Unit& u) const { return (const char*)(A + (size_t)u.e * sA + (size_t)u.pm * BM * lda); }
    __device__ __forceinline__ const char* b_base(const Unit& u) const { return (const char*)(Bt + (size_t)u.e * sB + (size_t)u.pn * BM * ldb); }
};
struct MoeOrder {
    const bf16* A; const bf16* Bt; int lda, ldb, nN, G, c; size_t sB; const LAS int* toff;
    __device__ __forceinline__ bool next(int i, Unit& u) const {
        const long L = (long)i * G + c; const int nt = toff[NE]; if (L >= (long)nt * nN) return false;
        const int mt = (int)(L / nN); u.pn = (int)(L % nN); u.pm = mt; int e = 0;
#pragma unroll 1
        for (int k = 1; k < NE; ++k) e += (toff[k] <= mt) ? 1 : 0;
        u.e = e; return true; }
    __device__ __forceinline__ const char* a_base(const Unit& u) const { return (const char*)(A + (size_t)u.pm * BM * lda); }
    __device__ __forceinline__ const char* b_base(const Unit& u) const { return (const char*)(Bt + (size_t)u.e * sB + (size_t)u.pn * BM * ldb); }
};

template <class F> __device__ __forceinline__ void epi_foreach(const f32x4 (&acc)[2][2][4][2], const Unit& u, int wr, int wc, int fr, int fq, const F& f) {
#pragma unroll
    for (int ai = 0; ai < 2; ++ai)
#pragma unroll
        for (int m = 0; m < 4; ++m) { const int row = u.pm * BM + ai * HALF + wr * 64 + m * 16 + fr;
#pragma unroll
            for (int bj = 0; bj < 2; ++bj)
#pragma unroll
                for (int n = 0; n < 2; ++n) f(row, u.pn * BM + bj * HALF + wc * 32 + n * 16 + 4 * fq, acc[ai][bj][m][n]);
            __builtin_amdgcn_sched_barrier(0); }
}

template <class Epi, class Sched, bool ALIGN_EPI = true, bool SP2 = true>
__device__ __forceinline__ void gemm_phase(LAS unsigned char* lds, const int tid, const Gemm g, const Sched& S, const Epi& E) {
    const int wid = __builtin_amdgcn_readfirstlane(tid >> 6), lane = tid & 63, wr = wid >> 2, wc = wid & 3, fr = lane & 15, fq = lane >> 4;
    const int K = g.K, nt = K / BK;
    unsigned voffA[2], voffB[2];
#pragma unroll
    for (int i = 0; i < 2; ++i) { int R, C; stage_rc(tid * 16 + i * 8192, R, C);
        voffA[i] = (unsigned)(R * g.lda + C) * 2u; voffB[i] = (unsigned)(R * g.ldb + C) * 2u; }
    const size_t kstep = (size_t)(BK * 2);
    const size_t hstepA = (size_t)HALF * g.lda * 2, hstepB = (size_t)HALF * g.ldb * 2;
    const unsigned ldsw = (unsigned)wid * 1024u;
    const int aoff = lds_byte(wr * 64 + fr, fq * 8), boff = lds_byte(wc * 32 + fr, fq * 8);
#define PG8_SA(b, h) (((b) * 2 + (h)) * HTB)
#define PG8_SB(b, h) ((4 + (b) * 2 + (h)) * HTB)
#define PG8_STAGE(bufoff, gbase, voff) do { _Pragma("unroll") for (int _i = 0; _i < 2; ++_i) \
        __builtin_amdgcn_global_load_lds((const unsigned*)((const char*)(gbase) + (voff)[_i]), (LAS unsigned*)(lds + (bufoff) + ldsw + _i * 8192), 16, 0, 0); } while (0)
#define PG8_LDA(dst, b, h) do { _Pragma("unroll") for (int m = 0; m < 4; ++m) _Pragma("unroll") for (int k = 0; k < 2; ++k) dst[m][k] = *(const LAS bf16x8*)(lds + PG8_SA(b, h) + aoff + m * 2048 + k * 1024); } while (0)
#define PG8_LDB(dst, b, h) do { _Pragma("unroll") for (int n = 0; n < 2; ++n) _Pragma("unroll") for (int k = 0; k < 2; ++k) dst[n][k] = *(const LAS bf16x8*)(lds + PG8_SB(b, h) + boff + n * 2048 + k * 1024); } while (0)
#define PG8_MMA(ai, bj, At, Bt) do { __builtin_amdgcn_s_setprio(1); _Pragma("unroll") for (int m = 0; m < 4; ++m) _Pragma("unroll") for (int n = 0; n < 2; ++n) _Pragma("unroll") for (int k = 0; k < 2; ++k) \
        acc[ai][bj][m][n] = __builtin_amdgcn_mfma_f32_16x16x32_bf16(Bt[n][k], At[m][k], acc[ai][bj][m][n], 0, 0, 0); __builtin_amdgcn_s_setprio(0); } while (0)
#define PG8_WAIT_V(n) asm volatile("s_waitcnt vmcnt(" #n ")" ::: "memory")
#define PG8_WAIT_L(n) asm volatile("s_waitcnt lgkmcnt(" #n ")" ::: "memory")
#define PG8_BAR __builtin_amdgcn_s_barrier()
#define PG8_SCHED __builtin_amdgcn_sched_barrier(0)
    Unit cur, nxt; int ui = 0;
    if (!S.next(0, cur)) return;
    f32x4 acc[2][2][4][2];
#pragma unroll
    for (int a = 0; a < 2; ++a)
#pragma unroll
        for (int b = 0; b < 2; ++b)
#pragma unroll
            for (int m = 0; m < 4; ++m)
#pragma unroll
                for (int n = 0; n < 2; ++n) acc[a][b][m][n] = (f32x4){0.f, 0.f, 0.f, 0.f};
    bf16x8 At[4][2], B0[2][2], B1[2][2];
    const char* cA = S.a_base(cur); const char* cB = S.b_base(cur);
    if constexpr (SP2) {
        PG8_STAGE(PG8_SB(0, 0), cB, voffB); PG8_STAGE(PG8_SB(0, 1), cB + hstepB, voffB); PG8_STAGE(PG8_SA(0, 0), cA, voffA); PG8_STAGE(PG8_SA(0, 1), cA + hstepA, voffA);
        if (wr == 1) PG8_BAR;
        PG8_WAIT_V(2); PG8_BAR;
        PG8_STAGE(PG8_SB(1, 0), cB + kstep, voffB); PG8_STAGE(PG8_SA(1, 0), cA + kstep, voffA); PG8_STAGE(PG8_SB(1, 1), cB + hstepB + kstep, voffB);
        PG8_WAIT_V(6); PG8_BAR;
    } else {
        PG8_STAGE(PG8_SB(0, 0), cB, voffB); PG8_STAGE(PG8_SA(0, 0), cA, voffA); PG8_STAGE(PG8_SB(0, 1), cB + hstepB, voffB); PG8_STAGE(PG8_SA(0, 1), cA + hstepA, voffA);
        if (wr == 1) PG8_BAR;
        PG8_WAIT_V(4); PG8_BAR;
        PG8_STAGE(PG8_SB(1, 0), cB + kstep, voffB); PG8_STAGE(PG8_SA(1, 0), cA + kstep, voffA); PG8_STAGE(PG8_SB(1, 1), cB + hstepB + kstep, voffB);
        PG8_WAIT_V(6); PG8_BAR;
    }
    for (;;) {
        const bool has_next = S.next(ui + 1, nxt);
        const char* nA = has_next ? S.a_base(nxt) : cA; const char* nB = has_next ? S.b_base(nxt) : cB;
        for (int t = 0; t < nt; t += 2) {
            const bool last = (t == nt - 2);
            const char* a1 = cA + (size_t)(t + 1) * kstep;
            const char* a2 = last ? nA : cA + (size_t)(t + 2) * kstep; const char* b2 = last ? nB : cB + (size_t)(t + 2) * kstep;
            const char* a3 = a2 + kstep; const char* b3 = b2 + kstep;
            if constexpr (SP2) {
            PG8_LDB(B0, 0, 0); PG8_LDB(B1, 0, 1); PG8_SCHED; PG8_LDA(At, 0, 0); PG8_STAGE(PG8_SA(1, 1), a1 + hstepA, voffA);
            PG8_WAIT_V(8); PG8_WAIT_L(0); PG8_BAR; PG8_MMA(0, 0, At, B0); PG8_MMA(0, 1, At, B1); PG8_BAR; PG8_SCHED;
            PG8_LDA(At, 0, 1); PG8_STAGE(PG8_SB(0, 0), b2, voffB); PG8_STAGE(PG8_SB(0, 1), b2 + hstepB, voffB); PG8_STAGE(PG8_SA(0, 0), a2, voffA);
            PG8_WAIT_V(8); PG8_WAIT_L(0); PG8_BAR; PG8_MMA(1, 0, At, B0); PG8_MMA(1, 1, At, B1); PG8_BAR; PG8_SCHED;
            PG8_LDB(B0, 1, 0); PG8_LDB(B1, 1, 1); PG8_SCHED; PG8_LDA(At, 1, 0); PG8_STAGE(PG8_SA(0, 1), a2 + hstepA, voffA);
            PG8_WAIT_V(8); PG8_WAIT_L(0); PG8_BAR; PG8_MMA(0, 0, At, B0); PG8_MMA(0, 1, At, B1); PG8_BAR; PG8_SCHED;
            PG8_LDA(At, 1, 1); PG8_STAGE(PG8_SB(1, 0), b3, voffB); PG8_STAGE(PG8_SB(1, 1), b3 + hstepB, voffB); PG8_STAGE(PG8_SA(1, 0), a3, voffA);
            PG8_WAIT_V(8); PG8_WAIT_L(0); PG8_BAR; PG8_MMA(1, 0, At, B0); PG8_MMA(1, 1, At, B1); PG8_BAR; PG8_SCHED;
            } else {
            PG8_LDB(B0, 0, 0); PG8_SCHED; PG8_LDA(At, 0, 0); PG8_STAGE(PG8_SA(1, 1), a1 + hstepA, voffA);
            PG8_WAIT_L(8); PG8_BAR; PG8_WAIT_L(0); PG8_MMA(0, 0, At, B0); PG8_BAR; PG8_SCHED;
            PG8_LDB(B1, 0, 1); PG8_STAGE(PG8_SB(0, 0), b2, voffB);
            PG8_BAR; PG8_WAIT_L(0); PG8_MMA(0, 1, At, B1); PG8_BAR;
            PG8_LDA(At, 0, 1); PG8_STAGE(PG8_SA(0, 0), a2, voffA);
            PG8_BAR; PG8_WAIT_L(0); PG8_MMA(1, 0, At, B0); PG8_BAR; PG8_SCHED;
            PG8_STAGE(PG8_SB(0, 1), b2 + hstepB, voffB);
            PG8_WAIT_V(6); PG8_BAR; PG8_MMA(1, 1, At, B1); PG8_BAR;
            PG8_LDB(B0, 1, 0); PG8_SCHED; PG8_LDA(At, 1, 0); PG8_STAGE(PG8_SA(0, 1), a2 + hstepA, voffA);
            PG8_WAIT_L(8); PG8_BAR; PG8_WAIT_L(0); PG8_MMA(0, 0, At, B0); PG8_BAR; PG8_SCHED;
            PG8_LDB(B1, 1, 1); PG8_STAGE(PG8_SB(1, 0), b3, voffB);
            PG8_BAR; PG8_WAIT_L(0); PG8_MMA(0, 1, At, B1); PG8_BAR;
            PG8_LDA(At, 1, 1); PG8_STAGE(PG8_SA(1, 0), a3, voffA);
            PG8_BAR; PG8_WAIT_L(0); PG8_MMA(1, 0, At, B0); PG8_BAR; PG8_SCHED;
            PG8_STAGE(PG8_SB(1, 1), b3 + hstepB, voffB);
            PG8_WAIT_V(6); PG8_BAR; PG8_MMA(1, 1, At, B1); PG8_BAR;
            }
        }
        if constexpr (ALIGN_EPI) { if (wr == 0) PG8_BAR; }
        { int tz = tid; asm volatile("" : "+v"(tz));
          const int wid2 = __builtin_amdgcn_readfirstlane(tz >> 6), lane2 = tz & 63;
          E(acc, cur, wid2 >> 2, wid2 & 3, lane2 & 15, lane2 >> 4); }
        if (!has_next) break;
#pragma unroll
        for (int a = 0; a < 2; ++a)
#pragma unroll
            for (int b = 0; b < 2; ++b)
#pragma unroll
                for (int m = 0; m < 4; ++m)
#pragma unroll
                    for (int n = 0; n < 2; ++n) acc[a][b][m][n] = (f32x4){0.f, 0.f, 0.f, 0.f};
        cur = nxt; cA = nA; cB = nB; ++ui;
        if constexpr (ALIGN_EPI) { if (wr == 1) PG8_BAR; }
    }
    PG8_WAIT_V(0);
    if constexpr (!ALIGN_EPI) { if (wr == 0) PG8_BAR; }
    PG8_BAR;
#undef PG8_SA
#undef PG8_SB
#undef PG8_STAGE
#undef PG8_LDA
#undef PG8_LDB
#undef PG8_MMA
#undef PG8_WAIT_V
#undef PG8_WAIT_L
#undef PG8_BAR
#undef PG8_SCHED
}
}
using pg8::Unit;

struct Args { const float* in[50]; float* out; unsigned char* ws; int ph_lo, ph_hi; };
typedef const __attribute__((address_space(4))) Args KArgs;
__device__ __forceinline__ KArgs* kargs() { KArgs* p = (KArgs*)__builtin_amdgcn_kernarg_segment_ptr(); asm volatile("" : "+s"(p)); return p; }
__device__ __forceinline__ unsigned char* launder_p(unsigned char* p) { asm volatile("" : "+s"(p)); return (unsigned char*)(GAS unsigned char*)p; }
__device__ __forceinline__ const float* kin(KArgs& A, int i) { return (const float*)(const GAS float*)A.in[i]; }
__device__ __forceinline__ float* kout(KArgs& A) { return (float*)(GAS float*)A.out; }
__device__ __forceinline__ unsigned char* kws(KArgs& A) { return (unsigned char*)(GAS unsigned char*)A.ws; }
__device__ __forceinline__ int launder_i(int v) { asm volatile("" : "+s"(v)); return v; }
__device__ __forceinline__ int launder_v(int v) { asm volatile("" : "+v"(v)); return v; }
enum { I_X = 0, I_MEM, I_LN_IN_G, I_LN_IN_B, I_W_IN, I_CONV_W, I_SG_NG, I_SG_NB, I_SG_W, I_SG_B, I_RW_MU, I_RW_W0, I_RW_WUP, I_RW_A0, I_RW_AUP, I_RW_GUP,
       I_RW_KK, I_RW_KA, I_RW_RK, I_RW_LNG, I_RW_LNB, I_S5_ARE, I_S5_AIM, I_S5_BRE, I_S5_BIM, I_S5_CRE, I_S5_CIM, I_S5_D, I_S5_LOGDT, I_S5_GLUW, I_S5_GLUB,
       I_BR_PROJ, I_GATE_B, I_W_OUT, I_LN1_G, I_LN1_B, I_XA_WQ, I_XA_WK, I_XA_WV, I_XA_WO, I_LN2_G, I_LN2_B, I_ROUTER_W, I_ROUTER_B, I_EX_W1, I_EX_B1, I_EX_W2, I_EX_B2,
       I_LN3_G, I_LN3_B };
struct Frame { LAS unsigned char* lds; volatile LAS unsigned* MISC; unsigned* ctl; unsigned char* ws; int tid, lane, wave, G, bid; };
constexpr int MI_TOFF = 16, MI_HIST = 64;

__device__ __forceinline__ void ln_stats(const f32x4 (&v)[4], float& mean, float& rstd) {
    float s = 0.f;
#pragma unroll
    for (int j = 0; j < 4; ++j) s += (v[j].x + v[j].y) + (v[j].z + v[j].w);
    mean = wave_sum(s) * (1.f / D); float s2 = 0.f;
#pragma unroll
    for (int j = 0; j < 4; ++j) { const f32x4 d = v[j] - mean; s2 += (d.x * d.x + d.y * d.y) + (d.z * d.z + d.w * d.w); }
    rstd = 1.0f / sqrtf(wave_sum(s2) * (1.f / D) + LN_EPS);
}
__device__ __forceinline__ void ln_apply_store(const f32x4 (&v)[4], float mean, float rstd, const float* g, const float* b, float* o32, bf16* o16, int lane) {
#pragma unroll
    for (int j = 0; j < 4; ++j) {
        const f32x4 gg = *(const f32x4*)(g + 256 * j + 4 * lane), bb = *(const f32x4*)(b + 256 * j + 4 * lane);
        const f32x4 y = (v[j] - mean) * rstd * gg + bb;
        if (o32) *(f32x4*)(o32 + 256 * j + 4 * lane) = y;
        if (o16) { v2u w; w.x = pk2(y.x, y.y); w.y = pk2(y.z, y.w); *(v2u*)(o16 + 256 * j + 4 * lane) = w; }
    }
}

__device__ __forceinline__ void transpose_item(const float* W, int K, int N, bf16* WT, int mode, LAS float* scr, int item, int lane) {
    const int nblk = N / 32, kb = item / nblk, nb = item % nblk, k0 = 64 * kb, n0 = 32 * nb;
#pragma unroll 8
    for (int i = 0; i < 32; ++i) { const int kk = 2 * i + (lane >> 5); scr[kk * 33 + (lane & 31)] = W[(size_t)(k0 + kk) * N + n0 + (lane & 31)]; }
    LDS_WAIT();
    const int c = lane & 7;
#pragma unroll
    for (int j = 0; j < 4; ++j) { const int n = (lane >> 3) + 8 * j; const LAS float* s = scr + (8 * c) * 33 + n;
        v4u o; o.x = pk2(s[0 * 33], s[1 * 33]); o.y = pk2(s[2 * 33], s[3 * 33]); o.z = pk2(s[4 * 33], s[5 * 33]); o.w = pk2(s[6 * 33], s[7 * 33]);
        const int nn = n0 + n; const int jj = nn >> 1;
        const int row = mode ? ((jj >> 7) * 256 + (nn & 1) * 128 + (jj & 127)) : nn;
        *(v4u*)(WT + (size_t)row * K + k0 + 8 * c) = o; }
    LDS_WAIT();
}
__device__ __forceinline__ void s5_setup_item(KArgs& A, const Frame& F, int item) {
    const int l = item >> 4, g = item & 15, tid = F.tid;
    LAS float* Kt = (LAS float*)F.lds;
    LAS float* Pw = (LAS float*)(F.lds + 65536);
    LAS float* Bb = (LAS float*)(F.lds + 65536 + 33280);
    LAS float* Cc = Bb + 2048;
    const float* a_re = kin(A, I_S5_ARE) + (l * 16 + g) * 64; const float* a_im = kin(A, I_S5_AIM) + (l * 16 + g) * 64;
    const float* b_re = kin(A, I_S5_BRE) + (size_t)(l * 16 + g) * 1024; const float* b_im = kin(A, I_S5_BIM) + (size_t)(l * 16 + g) * 1024;
    const float* c_re = kin(A, I_S5_CRE) + (size_t)(l * 16 + g) * 1024; const float* c_im = kin(A, I_S5_CIM) + (size_t)(l * 16 + g) * 1024;
    const float dt = expf(kin(A, I_S5_LOGDT)[l * 16 + g]);
    for (int o = tid; o < 65 * 64; o += NTHREADS) { const int n = o >> 6, p = o & 63; const float mag = expf(a_re[p] * dt * (float)n); float sn, cs; sincosf(a_im[p] * dt * (float)n, &sn, &cs);
        Pw[o * 2] = mag * cs; Pw[o * 2 + 1] = mag * sn; }
    for (int o = tid; o < 1024; o += NTHREADS) { const int p = o >> 4;
        const float are = a_re[p], aim = a_im[p], mag = expf(are * dt); float sn, cs; sincosf(aim * dt, &sn, &cs); const float abr = mag * cs, abi = mag * sn;
        const float den = are * are + aim * aim, nr = abr - 1.0f, cr = (nr * are + abi * aim) / den, ci = (abi * are - nr * aim) / den;
        const float br = b_re[o], bi = b_im[o]; Bb[o * 2] = cr * br - ci * bi; Bb[o * 2 + 1] = cr * bi + ci * br; }
    for (int o = tid; o < 1024; o += NTHREADS) { Cc[o * 2] = c_re[o]; Cc[o * 2 + 1] = c_im[o]; }
    __syncthreads();
    for (int o = tid; o < 16384; o += NTHREADS) { const int tau = o >> 8, c = (o >> 4) & 15, cp = o & 15; float acc = 0.f;
        for (int p = 0; p < 64; ++p) { const float cr = Cc[(c * 64 + p) * 2], ci = Cc[(c * 64 + p) * 2 + 1], pr = Pw[(tau * 64 + p) * 2], pi = Pw[(tau * 64 + p) * 2 + 1];
            const float er = cr * pr - ci * pi, ei = cr * pi + ci * pr; acc += er * Bb[(p * 16 + cp) * 2] - ei * Bb[(p * 16 + cp) * 2 + 1]; }
        Kt[o] = acc; }
    __syncthreads();
    bf16* Bt = (bf16*)(F.ws + WS_S5BT) + (size_t)(l * 16 + g) * 1024 * S5K;
    for (int o = tid; o < 1024 * 128; o += NTHREADS) { const int rr = o >> 7, q = o & 127, t = rr >> 4, c = rr & 15, s = q >> 1, cp0 = (q & 1) * 8;
        v4u w = {0u, 0u, 0u, 0u};
        if (s <= t) { const LAS float* k = Kt + ((t - s) * 16 + c) * 16 + cp0; w.x = pk2(k[0], k[1]); w.y = pk2(k[2], k[3]); w.z = pk2(k[4], k[5]); w.w = pk2(k[6], k[7]); }
        *(v4u*)(Bt + (size_t)rr * S5K + q * 8) = w; }
    for (int o = tid; o < 1024 * 16; o += NTHREADS) { const int rr = o >> 4, q = o & 15, t = rr >> 4, c = rr & 15; float vals[8];
#pragma unroll
        for (int j = 0; j < 4; ++j) { const int p = 4 * q + j; const float cr = Cc[(c * 64 + p) * 2], ci = Cc[(c * 64 + p) * 2 + 1], pr = Pw[((t + 1) * 64 + p) * 2], pi = Pw[((t + 1) * 64 + p) * 2 + 1];
            vals[2 * j] = cr * pr - ci * pi; vals[2 * j + 1] = -(cr * pi + ci * pr); }
        v4u w; w.x = pk2(vals[0], vals[1]); w.y = pk2(vals[2], vals[3]); w.z = pk2(vals[4], vals[5]); w.w = pk2(vals[6], vals[7]);
        *(v4u*)(Bt + (size_t)rr * S5K + 1024 + q * 8) = w; }
    bf16* Bc = (bf16*)(F.ws + WS_S5BC) + (size_t)(l * 16 + g) * 256 * 1024;
    for (int o = tid; o < 128 * 128; o += NTHREADS) { const int row = o >> 7, q = o & 127, p = row >> 1, im = row & 1, s = q >> 1, cp0 = (q & 1) * 8;
        const float pr = Pw[((63 - s) * 64 + p) * 2], pi = Pw[((63 - s) * 64 + p) * 2 + 1]; float vals[8];
#pragma unroll
        for (int j = 0; j < 8; ++j) { const float br = Bb[(p * 16 + cp0 + j) * 2], bi = Bb[(p * 16 + cp0 + j) * 2 + 1]; vals[j] = im ? (pr * bi + pi * br) : (pr * br - pi * bi); }
        v4u w; w.x = pk2(vals[0], vals[1]); w.y = pk2(vals[2], vals[3]); w.z = pk2(vals[4], vals[5]); w.w = pk2(vals[6], vals[7]);
        *(v4u*)(Bc + (size_t)row * 1024 + q * 8) = w;
        *(v4u*)(Bc + (size_t)(128 + row) * 1024 + q * 8) = (v4u){0u, 0u, 0u, 0u}; }
    __syncthreads();
}
__device__ __forceinline__ void p_prologue(KArgs& A, const Frame& F) {
    const int gw = F.bid * NWAVES + F.wave, NGW = F.G * NWAVES, lane = F.lane;
    for (int item = F.bid; item < NL * 16; item += F.G) s5_setup_item(A, F, item);
    LAS float* scr = (LAS float*)(F.lds + F.wave * 16384);
#pragma unroll 1
    for (int d = 0; d < 10; ++d) {
        const float* src; bf16* dst; int K, N, batch, mode = 0;
        switch (d) {
            case 0: src = kin(A, I_EX_W1); dst = (bf16*)(F.ws + WS_W1T); K = 1024; N = 2048; batch = NL * NE; mode = 1; break;
            case 1: src = kin(A, I_EX_W2); dst = (bf16*)(F.ws + WS_W2T); K = 1024; N = 1024; batch = NL * NE; break;
            case 2: src = kin(A, I_W_IN); dst = (bf16*)(F.ws + WS_WINT); K = 1024; N = N_IN; batch = NL; break;
            case 3: src = kin(A, I_BR_PROJ); dst = (bf16*)(F.ws + WS_BRT); K = 256; N = 1024; batch = NL * 4; break;
            case 4: src = kin(A, I_W_OUT); dst = (bf16*)(F.ws + WS_WOUTT); K = 1024; N = 1024; batch = NL; break;
            case 5: src = kin(A, I_XA_WQ); dst = (bf16*)(F.ws + WS_WQT); K = 1024; N = 1024; batch = NL; break;
            case 6: src = kin(A, I_XA_WK); dst = (bf16*)(F.ws + WS_WKT); K = 1024; N = 1024; batch = NL; break;
            case 7: src = kin(A, I_XA_WV); dst = (bf16*)(F.ws + WS_WVT); K = 1024; N = 1024; batch = NL; break;
            case 8: src = kin(A, I_XA_WO); dst = (bf16*)(F.ws + WS_WOT); K = 1024; N = 1024; batch = NL; break;
            default: src = kin(A, I_S5_GLUW); dst = (bf16*)(F.ws + WS_GLUT); K = 256; N = 256; batch = NL; break;
        }
        const int per = (K / 64) * (N / 32), nitems = per * batch;
        for (int it = gw; it < nitems; it += NGW) { const int b = it / per, r = it - b * per;
            transpose_item(src + (size_t)b * K * N, K, N, dst + (size_t)b * K * N, mode, scr, r, lane); }
    }
    { const float* mem = kin(A, I_MEM); bf16* m16 = (bf16*)(F.ws + WS_MEM16);
      for (int r = gw; r < NB * NMEM; r += NGW) {
#pragma unroll
          for (int j = 0; j < 4; ++j) { const f32x4 v = *(const f32x4*)(mem + (size_t)r * D + 256 * j + 4 * lane); v2u w; w.x = pk2(v.x, v.y); w.y = pk2(v.z, v.w); *(v2u*)(m16 + (size_t)r * D + 256 * j + 4 * lane) = w; } } }
    { const float* x = kin(A, I_X); float* h32 = (float*)(F.ws + WS_H32); bf16* h16 = (bf16*)(F.ws + WS_H16);
      for (int r = gw; r < T; r += NGW) { f32x4 v[4];
#pragma unroll
          for (int j = 0; j < 4; ++j) v[j] = *(const f32x4*)(x + (size_t)r * D + 256 * j + 4 * lane);
          float mean, rstd; ln_stats(v, mean, rstd);
          ln_apply_store(v, mean, rstd, kin(A, I_LN_IN_G), kin(A, I_LN_IN_B), h32 + (size_t)r * D, h16 + (size_t)r * D, lane); } }
}

typedef f32x4 AccT[2][2][4][2];
#define EPI_BASES KArgs& KA = *kargs(); unsigned char* ws = kws(KA); (void)ws;
struct EpiIn { int l;
    __device__ __forceinline__ void operator()(const AccT& acc, const Unit& u, int wr, int wc, int fr, int fq) const { EPI_BASES
        float* Z = (float*)(ws + WS_Z); bf16* SG = (bf16*)(ws + WS_SG); bf16* AOUT = (bf16*)(ws + WS_AOUT); const float* gate_b = kin(KA, I_GATE_B) + (size_t)l * 4096;
        if (u.pn < 10) {
            pg8::epi_foreach(acc, u, wr, wc, fr, fq, [&](int row, int col, f32x4 v) {
                *(f32x4*)(Z + (size_t)row * ZLD + col) = v;
                if (u.pn == 9) { const int cc = col - OFF_D, g = cc >> 4, c0 = cc & 15, chunk = row >> 6, s = row & 63;
                    v2u w; w.x = pk2(v.x, v.y); w.y = pk2(v.z, v.w); *(v2u*)(AOUT + ((size_t)(g * NCHT + chunk)) * S5K + s * 16 + c0) = w; } });
        } else {
            pg8::epi_foreach(acc, u, wr, wc, fr, fq, [&](int row, int col, f32x4 v) {
                const int gc = col - OFF_G; const f32x4 gb = *(const f32x4*)(gate_b + gc);
                v2u w; w.x = pk2(sigmoidf_(v.x + gb.x), sigmoidf_(v.y + gb.y)); w.y = pk2(sigmoidf_(v.z + gb.z), sigmoidf_(v.w + gb.w));
                *(v2u*)(SG + (size_t)row * 4096 + gc) = w; });
        }
    } };
struct EpiBranch { int br;
    __device__ __forceinline__ void operator()(const AccT& acc, const Unit& u, int wr, int wc, int fr, int fq) const { EPI_BASES
        bf16* MG = (bf16*)(ws + WS_MG16); const bf16* SG = (const bf16*)(ws + WS_SG);
        pg8::epi_foreach(acc, u, wr, wc, fr, fq, [&](int row, int col, f32x4 v) {
            const v2u s = *(const v2u*)(SG + (size_t)row * 4096 + br * 1024 + col);
            f32x4 r; r.x = v.x * bf2f(s.x & 0xffffu); r.y = v.y * bf2f(s.x >> 16); r.z = v.z * bf2f(s.y & 0xffffu); r.w = v.w * bf2f(s.y >> 16);
            bf16* p = MG + (size_t)row * D + col;
            if (br > 0) { const v2u m = *(const v2u*)p; r.x += bf2f(m.x & 0xffffu); r.y += bf2f(m.x >> 16); r.z += bf2f(m.y & 0xffffu); r.w += bf2f(m.y >> 16); }
            v2u w; w.x = pk2(r.x, r.y); w.y = pk2(r.z, r.w); *(v2u*)p = w; });
    } };
struct EpiResid { int dummy;
    __device__ __forceinline__ void operator()(const AccT& acc, const Unit& u, int wr, int wc, int fr, int fq) const { EPI_BASES
        float* H = (float*)(ws + WS_H32);
        pg8::epi_foreach(acc, u, wr, wc, fr, fq, [&](int row, int col, f32x4 v) { float* p = H + (size_t)row * D + col; const f32x4 h = *(const f32x4*)p; *(f32x4*)p = h * DN_ALPHA + v; });
    } };
struct EpiBf16 { unsigned off_mib; float scale;
    __device__ __forceinline__ void operator()(const AccT& acc, const Unit& u, int wr, int wc, int fr, int fq) const { EPI_BASES
        bf16* O = (bf16*)(ws + (size_t)off_mib * MiB);
        pg8::epi_foreach(acc, u, wr, wc, fr, fq, [&](int row, int col, f32x4 v) { v2u w; w.x = pk2(v.x * scale, v.y * scale); w.y = pk2(v.z * scale, v.w * scale); *(v2u*)(O + (size_t)row * D + col) = w; });
    } };
struct EpiVT { int dummy;
    __device__ __forceinline__ void operator()(const AccT& acc, const Unit& u, int wr, int wc, int fr, int fq) const { EPI_BASES
        bf16* VT = (bf16*)(ws + WS_VMT16);
        pg8::epi_foreach(acc, u, wr, wc, fr, fq, [&](int row, int col, f32x4 v) { const int b = row >> 8, m = row & 255; bf16* p = VT + ((size_t)(b * D + col)) * NMEM + m;
            p[0] = (bf16)f2bf(v.x); p[NMEM] = (bf16)f2bf(v.y); p[2 * NMEM] = (bf16)f2bf(v.z); p[3 * NMEM] = (bf16)f2bf(v.w); });
    } };
struct EpiXloc { int dummy;
    __device__ __forceinline__ void operator()(const AccT& acc, const Unit& u, int wr, int wc, int fr, int fq) const { EPI_BASES
        float* X = (float*)(ws + WS_XLOC);
        pg8::epi_foreach(acc, u, wr, wc, fr, fq, [&](int row, int col, f32x4 v) { if (col < 128) *(f32x4*)(X + ((size_t)(u.e * NCHT + row)) * 128 + col) = v; });
    } };
__device__ __forceinline__ float gelu_tanh(float x) { const float u = 0.7978845608028654f * (x + 0.044715f * x * x * x); const float e = __expf(2.0f * u); const float th = 1.0f - 2.0f / (e + 1.0f); return 0.5f * x * (1.0f + th); }
struct EpiS5Y { int l;
    __device__ __forceinline__ void operator()(const AccT& acc, const Unit& u, int wr, int wc, int fr, int fq) const { EPI_BASES
        bf16* YD = (bf16*)(ws + WS_YD16); const float* Z = (const float*)(ws + WS_Z); const float* dvec = kin(KA, I_S5_D) + l * 256;
        pg8::epi_foreach(acc, u, wr, wc, fr, fq, [&](int row, int col, f32x4 v) { const int tok = row * CH + (col >> 4), ch = u.e * 16 + (col & 15);
            const f32x4 uu = *(const f32x4*)(Z + (size_t)tok * ZLD + OFF_D + ch), dd = *(const f32x4*)(dvec + ch);
            v2u w; w.x = pk2(gelu_tanh(v.x + dd.x * uu.x), gelu_tanh(v.y + dd.y * uu.y)); w.y = pk2(gelu_tanh(v.z + dd.z * uu.z), gelu_tanh(v.w + dd.w * uu.w));
            *(v2u*)(YD + (size_t)tok * 256 + ch) = w; });
    } };
struct EpiGlu { int l;
    __device__ __forceinline__ void operator()(const AccT& acc, const Unit& u, int wr, int wc, int fr, int fq) const { EPI_BASES
        bf16* O = (bf16*)(ws + WS_O16); const bf16* YD = (const bf16*)(ws + WS_YD16); const float* gb = kin(KA, I_S5_GLUB) + l * 256;
        pg8::epi_foreach(acc, u, wr, wc, fr, fq, [&](int row, int col, f32x4 v) { const v2u y = *(const v2u*)(YD + (size_t)row * 256 + col); const f32x4 b = *(const f32x4*)(gb + col);
            v2u w; w.x = pk2(bf2f(y.x & 0xffffu) * sigmoidf_(v.x + b.x), bf2f(y.x >> 16) * sigmoidf_(v.y + b.y)); w.y = pk2(bf2f(y.y & 0xffffu) * sigmoidf_(v.z + b.z), bf2f(y.y >> 16) * sigmoidf_(v.w + b.w));
            *(v2u*)(O + (size_t)row * D + 768 + col) = w; });
    } };
__device__ __forceinline__ float swiglu(float g, float u) { g = fminf(g, 7.0f); u = fminf(fmaxf(u, -7.0f), 7.0f); return (u + 1.0f) * g * sigmoidf_(1.702f * g); }
struct EpiSwiglu { int l;
    __device__ __forceinline__ void operator()(const AccT& acc, const Unit& u, int wr, int wc, int fr, int fq) const { EPI_BASES
        bf16* ACT = (bf16*)(ws + WS_ACT); const float* bb = kin(KA, I_EX_B1) + (size_t)(l * NE + u.e) * 2048;
#pragma unroll
        for (int ai = 0; ai < 2; ++ai)
#pragma unroll
            for (int m = 0; m < 4; ++m) { const int row = u.pm * 256 + ai * 128 + wr * 64 + m * 16 + fr;
#pragma unroll
                for (int n = 0; n < 2; ++n) { const int j = u.pn * 128 + wc * 32 + n * 16 + 4 * fq;
                    const f32x4 b0 = *(const f32x4*)(bb + 2 * j), b1v = *(const f32x4*)(bb + 2 * j + 4);
                    const f32x4 g = acc[ai][0][m][n], uu = acc[ai][1][m][n];
                    v2u w; w.x = pk2(swiglu(g.x + b0.x, uu.x + b0.y), swiglu(g.y + b0.z, uu.y + b0.w)); w.y = pk2(swiglu(g.z + b1v.x, uu.z + b1v.y), swiglu(g.w + b1v.z, uu.w + b1v.w));
                    *(v2u*)(ACT + (size_t)row * DFF + j) = w; } }
    } };
struct EpiMoeOut { int l;
    __device__ __forceinline__ void operator()(const AccT& acc, const Unit& u, int wr, int wc, int fr, int fq) const { EPI_BASES
        bf16* YS = (bf16*)(ws + WS_YS); const float* SLOTW = (const float*)(ws + WS_SLOTW); const float* bb = kin(KA, I_EX_B2) + (size_t)(l * NE + u.e) * D;
        pg8::epi_foreach(acc, u, wr, wc, fr, fq, [&](int row, int col, f32x4 v) { const float sw = SLOTW[row]; const f32x4 b = *(const f32x4*)(bb + col);
            v2u w; w.x = pk2((v.x + b.x) * sw, (v.y + b.y) * sw); w.y = pk2((v.z + b.z) * sw, (v.w + b.w) * sw); *(v2u*)(YS + (size_t)row * D + col) = w; });
    } };

__device__ __forceinline__ void p_mix1(KArgs& A, const Frame& F, int l) {
    const int gw = F.bid * NWAVES + F.wave, NGW = F.G * NWAVES, lane = F.lane, tid = F.tid;
    const float* Z = (const float*)(F.ws + WS_Z); bf16* O16 = (bf16*)(F.ws + WS_O16);
    for (int rp_ = 0; rp_ < ((PROBE_PHASE == 101) ? PROBE_REPS : 1); ++rp_) { const float* cw = kin(A, I_CONV_W) + l * 3 * 256; const f32x4 w0 = *(const f32x4*)(cw + 4 * lane), w1 = *(const f32x4*)(cw + 256 + 4 * lane), w2 = *(const f32x4*)(cw + 512 + 4 * lane);
      for (int t = gw; t < T; t += NGW) { const int s = t & (SEQ - 1); const float* zr = Z + (size_t)t * ZLD + 4 * lane;
          const f32x4 bg = *(const f32x4*)zr; f32x4 y = w2 * (*(const f32x4*)(zr + 256) * *(const f32x4*)(zr + 512));
          if (s >= 1) y += w1 * (*(const f32x4*)(zr - ZLD + 256) * *(const f32x4*)(zr - ZLD + 512));
          if (s >= 2) y += w0 * (*(const f32x4*)(zr - 2 * ZLD + 256) * *(const f32x4*)(zr - 2 * ZLD + 512));
          y = y * bg; v2u w; w.x = pk2(y.x, y.y); w.y = pk2(y.z, y.w); *(v2u*)(O16 + (size_t)t * D + 4 * lane) = w; } }
    for (int rp_ = 0; rp_ < ((PROBE_PHASE == 102) ? PROBE_REPS : 1); ++rp_) { LAS float* VN = (LAS float*)F.lds;
      const float* ng = kin(A, I_SG_NG) + l * 256; const float* nb = kin(A, I_SG_NB) + l * 256;
      for (int blk = F.bid; blk < T / 128; blk += F.G) {
          const f32x4 gg = *(const f32x4*)(ng + 4 * lane), bb = *(const f32x4*)(nb + 4 * lane);
          for (int r = F.wave; r < 128; r += NWAVES) { const int t = blk * 128 + r; const f32x4 v = *(const f32x4*)(Z + (size_t)t * ZLD + OFF_B + 256 + 4 * lane);
              const float mean = wave_sum((v.x + v.y) + (v.z + v.w)) * (1.f / 256); const f32x4 d = v - mean;
              const float var = wave_sum((d.x * d.x + d.y * d.y) + (d.z * d.z + d.w * d.w)) * (1.f / 256); const float rstd = 1.0f / sqrtf(var + LN_EPS);
              *(LAS f32x4*)(VN + r * 256 + 4 * lane) = d * rstd * gg + bb; }
          __syncthreads();
          const int i = tid >> 2, cq = tid & 3, t = blk * 128 + i, jmax = (i < 64) ? 64 : 128;
#pragma unroll 1
          for (int g = 0; g < 4; ++g) { f32x4 a0 = {0, 0, 0, 0}, a1 = a0, a2 = a0, a3 = a0;
              const float* wrow = kin(A, I_SG_W) + ((size_t)((l * 4 + g) * 128 + i)) * 128; const LAS float* vb = VN + g * 64 + cq * 16;
              for (int j = 0; j < jmax; j += 4) { const f32x4 w4 = *(const f32x4*)(wrow + j);
#pragma unroll
                  for (int jj = 0; jj < 4; ++jj) { const LAS f32x4* vp = (const LAS f32x4*)(vb + (j + jj) * 256); const float w = w4[jj];
                      a0 += vp[0] * w; a1 += vp[1] * w; a2 += vp[2] * w; a3 += vp[3] * w; } }
              const float bias = kin(A, I_SG_B)[(l * 4 + g) * 128 + i]; const float* up = Z + (size_t)t * ZLD + OFF_B + g * 64 + cq * 16;
              const f32x4 o0 = *(const f32x4*)(up) * (a0 + bias), o1 = *(const f32x4*)(up + 4) * (a1 + bias), o2 = *(const f32x4*)(up + 8) * (a2 + bias), o3 = *(const f32x4*)(up + 12) * (a3 + bias);
              v4u wa, wb; wa.x = pk2(o0.x, o0.y); wa.y = pk2(o0.z, o0.w); wa.z = pk2(o1.x, o1.y); wa.w = pk2(o1.z, o1.w); wb.x = pk2(o2.x, o2.y); wb.y = pk2(o2.z, o2.w); wb.z = pk2(o3.x, o3.y); wb.w = pk2(o3.z, o3.w);
              bf16* op = O16 + (size_t)t * D + 256 + g * 64 + cq * 16; *(v4u*)op = wa; *(v4u*)(op + 8) = wb; }
          __syncthreads();
      } }
    for (int rp_ = 0; rp_ < ((PROBE_PHASE == 103) ? PROBE_REPS : 1); ++rp_) { LAS float* xin = (LAS float*)(F.lds + F.wave * 8192);
      float* RWOP = (float*)(F.ws + WS_RWOP); float* RWG = (float*)(F.ws + WS_RWG); float* RK = (float*)(F.ws + WS_RK);
      const float* mu = kin(A, I_RW_MU) + l * 1024; const float* wup = kin(A, I_RW_WUP) + (size_t)l * 64 * 256; const float* aup = kin(A, I_RW_AUP) + (size_t)l * 64 * 256; const float* gup = kin(A, I_RW_GUP) + (size_t)l * 128 * 256;
      const int c4 = 4 * lane, head = lane >> 4;
      const f32x4 w0v = *(const f32x4*)(kin(A, I_RW_W0) + l * 256 + c4), a0v = *(const f32x4*)(kin(A, I_RW_A0) + l * 256 + c4), kkv = *(const f32x4*)(kin(A, I_RW_KK) + l * 256 + c4),
                  kav = *(const f32x4*)(kin(A, I_RW_KA) + l * 256 + c4), rkv = *(const f32x4*)(kin(A, I_RW_RK) + l * 256 + c4);
      const f32x4 mul = *(const f32x4*)(mu + 768 + c4), mur = *(const f32x4*)(mu + c4), muk = *(const f32x4*)(mu + 256 + c4), muv = *(const f32x4*)(mu + 512 + c4);
      for (int grp = gw; grp < T / 8; grp += NGW) { const int t0 = grp * 8;
#pragma unroll
          for (int tk = 0; tk < 8; ++tk) { const int t = t0 + tk, s = t & (SEQ - 1); const float* zr = Z + (size_t)t * ZLD + OFF_C + 768 + c4;
              f32x4 x = *(const f32x4*)zr; f32x4 pv = {0, 0, 0, 0}; if (s > 0) pv = *(const f32x4*)(zr - ZLD); x = x + (pv - x) * mul;
              if (lane < 16) { x.x = tanhf(x.x); x.y = tanhf(x.y); x.z = tanhf(x.z); x.w = tanhf(x.w); }
              else if (lane >= 32) { x.x = sigmoidf_(x.x); x.y = sigmoidf_(x.y); x.z = sigmoidf_(x.z); x.w = sigmoidf_(x.w); }
              *(LAS f32x4*)(xin + tk * 256 + c4) = x; }
          LDS_WAIT();
          f32x4 dec[8], av[8];
          { f32x4 acc[8];
#pragma unroll
            for (int tk = 0; tk < 8; ++tk) acc[tk] = (f32x4){0, 0, 0, 0};
#pragma unroll 2
            for (int i = 0; i < 64; i += 4) { const f32x4 wa = *(const f32x4*)(wup + (size_t)(i + 0) * 256 + c4), wb = *(const f32x4*)(wup + (size_t)(i + 1) * 256 + c4), wc = *(const f32x4*)(wup + (size_t)(i + 2) * 256 + c4), wd = *(const f32x4*)(wup + (size_t)(i + 3) * 256 + c4);
#pragma unroll
                for (int tk = 0; tk < 8; ++tk) { const f32x4 xi = *(const LAS f32x4*)(xin + tk * 256 + i); acc[tk] += wa * xi.x + wb * xi.y + wc * xi.z + wd * xi.w; } }
#pragma unroll
            for (int tk = 0; tk < 8; ++tk) { const f32x4 wp = w0v + acc[tk];
#pragma unroll
                for (int e = 0; e < 4; ++e) { const float sp = log1pf(__expf(-wp[e])); const float w = -sp - 0.5f; dec[tk][e] = __expf(-__expf(w)); } } }
          { f32x4 acc[8];
#pragma unroll
            for (int tk = 0; tk < 8; ++tk) acc[tk] = (f32x4){0, 0, 0, 0};
#pragma unroll 2
            for (int i = 0; i < 64; i += 4) { const f32x4 wa = *(const f32x4*)(aup + (size_t)(i + 0) * 256 + c4), wb = *(const f32x4*)(aup + (size_t)(i + 1) * 256 + c4), wc = *(const f32x4*)(aup + (size_t)(i + 2) * 256 + c4), wd = *(const f32x4*)(aup + (size_t)(i + 3) * 256 + c4);
#pragma unroll
                for (int tk = 0; tk < 8; ++tk) { const f32x4 xi = *(const LAS f32x4*)(xin + tk * 256 + 64 + i); acc[tk] += wa * xi.x + wb * xi.y + wc * xi.z + wd * xi.w; } }
#pragma unroll
            for (int tk = 0; tk < 8; ++tk) { const f32x4 ap = a0v + acc[tk]; av[tk] = (f32x4){sigmoidf_(ap.x), sigmoidf_(ap.y), sigmoidf_(ap.z), sigmoidf_(ap.w)}; } }
          { f32x4 acc[8];
#pragma unroll
            for (int tk = 0; tk < 8; ++tk) acc[tk] = (f32x4){0, 0, 0, 0};
#pragma unroll 2
            for (int i = 0; i < 128; i += 4) { const f32x4 wa = *(const f32x4*)(gup + (size_t)(i + 0) * 256 + c4), wb = *(const f32x4*)(gup + (size_t)(i + 1) * 256 + c4), wc = *(const f32x4*)(gup + (size_t)(i + 2) * 256 + c4), wd = *(const f32x4*)(gup + (size_t)(i + 3) * 256 + c4);
#pragma unroll
                for (int tk = 0; tk < 8; ++tk) { const f32x4 xi = *(const LAS f32x4*)(xin + tk * 256 + 128 + i); acc[tk] += wa * xi.x + wb * xi.y + wc * xi.z + wd * xi.w; } }
#pragma unroll
            for (int tk = 0; tk < 8; ++tk) *(f32x4*)(RWG + (size_t)(t0 + tk) * 256 + c4) = acc[tk]; }
#pragma unroll
          for (int tk = 0; tk < 8; ++tk) { const int t = t0 + tk, s = t & (SEQ - 1), b = t >> 13; const float* zr = Z + (size_t)t * ZLD + OFF_C + c4;
              f32x4 r = *(const f32x4*)zr, k = *(const f32x4*)(zr + 256), v = *(const f32x4*)(zr + 512);
              f32x4 pr = {0, 0, 0, 0}, pk = pr, pvv = pr; if (s > 0) { pr = *(const f32x4*)(zr - ZLD); pk = *(const f32x4*)(zr - ZLD + 256); pvv = *(const f32x4*)(zr - ZLD + 512); }
              r = r + (pr - r) * mur; k = k + (pk - k) * muk; v = v + (pvv - v) * muv;
              const f32x4 a = av[tk]; f32x4 kk = k * kkv; const f32x4 k2 = k * (1.0f + (a - 1.0f) * kav);
              float ss = (kk.x * kk.x + kk.y * kk.y) + (kk.z * kk.z + kk.w * kk.w); float rk = (r.x * k2.x * rkv.x + r.y * k2.y * rkv.y) + (r.z * k2.z * rkv.z + r.w * k2.w * rkv.w);
#pragma unroll
              for (int o = 1; o < 16; o <<= 1) { ss += shfl_xor_l(ss, o, lane); rk += shfl_xor_l(rk, o, lane); }
              const float inv = 1.0f / fmaxf(sqrtf(ss), 1e-12f); kk = kk * inv;
              float* op = RWOP + ((size_t)((b * 4 + head) * SEQ + s)) * 384 + (lane & 15) * 4;
              *(f32x4*)(op) = -kk; *(f32x4*)(op + 64) = dec[tk]; *(f32x4*)(op + 128) = kk * a; *(f32x4*)(op + 192) = r; *(f32x4*)(op + 256) = k2; *(f32x4*)(op + 320) = v;
              if ((lane & 15) == 0) RK[(size_t)t * 4 + head] = rk; }
          LDS_WAIT();
      } }
}

__device__ __forceinline__ void p_rw_chunks(const Frame& F) {
    const int gw = F.bid * NWAVES + F.wave, NGW = F.G * NWAVES, lane = F.lane;
    const float* RWOP = (const float*)(F.ws + WS_RWOP); float* QH = (float*)(F.ws + WS_QH); float* YL = (float*)(F.ws + WS_YL); float* GC = (float*)(F.ws + WS_GC); float* HC = (float*)(F.ws + WS_HC);
    LAS float* wl = (LAS float*)(F.lds + F.wave * 16384);
    for (int task = gw; task < 16 * NCH; task += NGW) { const int bh = task / NCH, ck = task % NCH;
        float sp[64], sl[64];
        { const int ln = launder_v(lane);
#pragma unroll
          for (int k = 0; k < 64; ++k) { sp[k] = (k == ln) ? 1.0f : 0.0f; sl[k] = 0.0f; } }
        const float* src = RWOP + ((size_t)(bh * SEQ + ck * CH)) * 384;
#pragma unroll 1
        for (int sb = 0; sb < CH / 8; ++sb) {
            const f32x4* gsrc = (const f32x4*)(src + (size_t)sb * 8 * 384) + lane; LAS f32x4* ldst = (LAS f32x4*)wl + lane;
#pragma unroll
            for (int i = 0; i < 12; ++i) ldst[i * 64] = gsrc[i * 64];
            LDS_WAIT();
#pragma unroll 1
            for (int st = 0; st < 8; ++st) { const LAS f32x4* base = (const LAS f32x4*)(wl + st * 384);
                float saP = 0.f, saL = 0.f;
#pragma unroll
                for (int q = 0; q < 16; ++q) { const f32x4 nk = base[q];
                    saP += sp[4 * q] * nk.x; saP += sp[4 * q + 1] * nk.y; saP += sp[4 * q + 2] * nk.z; saP += sp[4 * q + 3] * nk.w;
                    saL += sl[4 * q] * nk.x; saL += sl[4 * q + 1] * nk.y; saL += sl[4 * q + 2] * nk.z; saL += sl[4 * q + 3] * nk.w;
                    if ((q & 3) == 3) __builtin_amdgcn_sched_barrier(0); }
                const float vj = wl[st * 384 + 320 + lane];
                float yP = 0.f, yL = 0.f;
                f32x4 w = base[16], b = base[32], r = base[48], kv = base[64];
#pragma unroll
                for (int q = 0; q < 16; ++q) { f32x4 wn = w, bn = b, rn = r, kn = kv;
                    if (q < 15) { wn = base[16 + q + 1]; bn = base[32 + q + 1]; rn = base[48 + q + 1]; kn = base[64 + q + 1]; }
#pragma unroll
                    for (int e = 0; e < 4; ++e) { const int k = 4 * q + e;
                        sp[k] = sp[k] * w[e] + saP * b[e]; sl[k] = sl[k] * w[e] + saL * b[e] + vj * kv[e];
                        yP += sp[k] * r[e]; yL += sl[k] * r[e]; }
                    __builtin_amdgcn_sched_barrier(0);
                    w = wn; b = bn; r = rn; kv = kn; }
                const size_t oi = ((size_t)(bh * SEQ + ck * CH + sb * 8 + st)) * 64 + lane;
                QH[oi] = yP; YL[oi] = yL; }
        }
        float* gp = GC + ((size_t)(bh * NCH + ck) * 64 + lane) * 64; float* hp = HC + ((size_t)(bh * NCH + ck) * 64 + lane) * 64;
#pragma unroll
        for (int q = 0; q < 16; ++q) { *(f32x4*)(gp + 4 * q) = (f32x4){sp[4 * q], sp[4 * q + 1], sp[4 * q + 2], sp[4 * q + 3]}; *(f32x4*)(hp + 4 * q) = (f32x4){sl[4 * q], sl[4 * q + 1], sl[4 * q + 2], sl[4 * q + 3]}; }
    }
}
__device__ __forceinline__ void p_s5_chain(KArgs& A, const Frame& F, int l) {
    const int gt = F.bid * NTHREADS + F.tid; if (gt >= NB * 16 * 64) return;
    const int b = gt >> 10, g = (gt >> 6) & 15, p = gt & 63;
    const float dt = expf(kin(A, I_S5_LOGDT)[l * 16 + g]); const float are = kin(A, I_S5_ARE)[(l * 16 + g) * 64 + p], aim = kin(A, I_S5_AIM)[(l * 16 + g) * 64 + p];
    const float mag = expf(are * dt * 64.0f); float sn, cs; sincosf(aim * dt * 64.0f, &sn, &cs); const float ar = mag * cs, ai = mag * sn;
    bf16* AO = (bf16*)(F.ws + WS_AOUT); const float* XL = (const float*)(F.ws + WS_XLOC);
    float xr = 0.f, xi = 0.f;
#pragma unroll 8
    for (int c = 0; c < NCH; ++c) { const size_t row = (size_t)g * NCHT + b * NCH + c;
        *(unsigned*)(AO + row * S5K + 1024 + 2 * p) = pk2(xr, xi);
        const f32x2 xl = *(const f32x2*)(XL + row * 128 + 2 * p);
        const float nr = ar * xr - ai * xi + xl.x, ni = ar * xi + ai * xr + xl.y; xr = nr; xi = ni; }
}
constexpr int CB = 8, NBLK = NCH / CB;
__device__ __forceinline__ void chain_load_g(const float* G, float (&ga)[64], int fr, int fq) {
#pragma unroll
    for (int jr = 0; jr < 16; ++jr)
#pragma unroll
        for (int mt = 0; mt < 4; ++mt) ga[jr * 4 + mt] = G[(size_t)((jr >> 2) * 16 + 4 * fq + (jr & 3)) * 64 + 16 * mt + fr];
}
__device__ __forceinline__ void chain_step(f32x4 (&acc)[4], const float (&ga)[64], const f32x4 (&ci)[4]) {
    f32x4 na[4] = {ci[0], ci[1], ci[2], ci[3]};
#pragma unroll
    for (int jr = 0; jr < 16; ++jr)
#pragma unroll
        for (int mt = 0; mt < 4; ++mt) na[mt] = __builtin_amdgcn_mfma_f32_16x16x4f32(ga[jr * 4 + mt], acc[jr >> 2][jr & 3], na[mt], 0, 0, 0);
#pragma unroll
    for (int mt = 0; mt < 4; ++mt) acc[mt] = na[mt];
}
__device__ __forceinline__ void chain_load_tile(const float* M, int rb, f32x4 (&t)[4], int fr, int fq) {
#pragma unroll
    for (int jt = 0; jt < 4; ++jt) t[jt] = *(const f32x4*)(M + (size_t)(16 * rb + fr) * 64 + 16 * jt + 4 * fq);
}
__device__ __forceinline__ void chain_store_tile(float* M, int rb, const f32x4 (&t)[4], int fr, int fq) {
#pragma unroll
    for (int jt = 0; jt < 4; ++jt) *(f32x4*)(M + (size_t)(16 * rb + fr) * 64 + 16 * jt + 4 * fq) = t[jt];
}
__device__ __forceinline__ void p_chain_compose(const Frame& F) {
    const int gw = F.bid * NWAVES + F.wave, NGW = F.G * NWAVES, fr = F.lane & 15, fq = F.lane >> 4;
    const float* GC = (const float*)(F.ws + WS_GC); const float* HC = (const float*)(F.ws + WS_HC); float* GB = (float*)(F.ws + WS_GB); float* HB = (float*)(F.ws + WS_HB);
    for (int task = gw; task < 16 * NBLK * 8; task += NGW) { const int cb = task & 7, bb = task >> 3, rb = cb & 3; const bool isH = cb >= 4;
        const size_t c0 = (size_t)bb * CB;
        f32x4 acc[4]; chain_load_tile((isH ? HC : GC) + c0 * 4096, rb, acc, fr, fq);
        float ga[64]; chain_load_g(GC + (c0 + 1) * 4096, ga, fr, fq);
#pragma unroll 1
        for (int i = 1; i < CB; ++i) { f32x4 ci[4] = {{0, 0, 0, 0}, {0, 0, 0, 0}, {0, 0, 0, 0}, {0, 0, 0, 0}};
            if (isH) chain_load_tile(HC + (c0 + i) * 4096, rb, ci, fr, fq);
            float gn[64];
            if (i + 1 < CB) chain_load_g(GC + (c0 + i + 1) * 4096, gn, fr, fq);
            chain_step(acc, ga, ci);
            if (i + 1 < CB) {
#pragma unroll
                for (int k = 0; k < 64; ++k) ga[k] = gn[k]; } }
        chain_store_tile((isH ? HB : GB) + (size_t)bb * 4096, rb, acc, fr, fq);
    }
}
__device__ __forceinline__ void p_chain_blocks(const Frame& F, int gw, int NGW) {
    const int fr = F.lane & 15, fq = F.lane >> 4;
    const float* GB = (const float*)(F.ws + WS_GB); const float* HB = (const float*)(F.ws + WS_HB); float* SB = (float*)(F.ws + WS_SB);
    for (int task = gw; task < 16 * 4; task += NGW) { const int vb = task & 3, bh = task >> 2;
        f32x4 acc[4] = {{0, 0, 0, 0}, {0, 0, 0, 0}, {0, 0, 0, 0}, {0, 0, 0, 0}};
        float ga[64]; chain_load_g(GB + (size_t)bh * NBLK * 4096, ga, fr, fq);
#pragma unroll 1
        for (int blk = 0; blk < NBLK; ++blk) { const size_t bb = (size_t)bh * NBLK + blk;
            chain_store_tile(SB + bb * 4096, vb, acc, fr, fq);
            if (blk + 1 == NBLK) break;
            f32x4 ci[4]; chain_load_tile(HB + bb * 4096, vb, ci, fr, fq);
            float gn[64]; chain_load_g(GB + (bb + 1) * 4096, gn, fr, fq);
            chain_step(acc, ga, ci);
#pragma unroll
            for (int k = 0; k < 64; ++k) ga[k] = gn[k]; }
    }
}
__device__ __forceinline__ void chain_inblock(const Frame& F, int bb, int vb) {
    const int fr = F.lane & 15, fq = F.lane >> 4;
    const float* GC = (const float*)(F.ws + WS_GC); const float* HC = (const float*)(F.ws + WS_HC); const float* SB = (const float*)(F.ws + WS_SB); float* SC = (float*)(F.ws + WS_SC);
    const size_t c0 = (size_t)bb * CB;
    f32x4 acc[4]; chain_load_tile(SB + (size_t)bb * 4096, vb, acc, fr, fq);
    float ga[64]; chain_load_g(GC + c0 * 4096, ga, fr, fq);
#pragma unroll 1
    for (int i = 0; i < CB; ++i) {
        chain_store_tile(SC + (c0 + i) * 4096, vb, acc, fr, fq);
        if (i + 1 == CB) break;
        f32x4 ci[4]; chain_load_tile(HC + (c0 + i) * 4096, vb, ci, fr, fq);
        float gn[64]; chain_load_g(GC + (c0 + i + 1) * 4096, gn, fr, fq);
        chain_step(acc, ga, ci);
#pragma unroll
        for (int k = 0; k < 64; ++k) ga[k] = gn[k]; }
}
__device__ __forceinline__ void rw_out_task(KArgs& A, const Frame& F, int l, int task) {
    const int lane = F.lane;
    const float* RWOP = (const float*)(F.ws + WS_RWOP); const float* QH = (const float*)(F.ws + WS_QH); const float* YL = (const float*)(F.ws + WS_YL); const float* SC = (const float*)(F.ws + WS_SC);
    const float* RWG = (const float*)(F.ws + WS_RWG); const float* RK = (const float*)(F.ws + WS_RK); bf16* O16 = (bf16*)(F.ws + WS_O16);
    LAS float* Qw = (LAS float*)(F.lds + F.wave * 16384);
    { const int bh = task / NCH, ck = task % NCH, b = bh >> 2, head = bh & 3;
        const size_t ti0 = (size_t)(bh * SEQ + ck * CH); const int t0g = b * SEQ + ck * CH;
        { const f32x4* qsrc = (const f32x4*)(QH + ti0 * 64) + lane; LAS f32x4* qdst = (LAS f32x4*)Qw + lane;
#pragma unroll
          for (int i = 0; i < 16; ++i) qdst[i * 64] = qsrc[i * 64]; }
        float srow[64];
        { const f32x4* ssrc = (const f32x4*)(SC + (size_t)(bh * NCH + ck) * 4096 + lane * 64);
#pragma unroll
          for (int i = 0; i < 16; ++i) { const f32x4 x = ssrc[i]; srow[4 * i] = x.x; srow[4 * i + 1] = x.y; srow[4 * i + 2] = x.z; srow[4 * i + 3] = x.w; } }
        const float lgv = kin(A, I_RW_LNG)[l * 256 + head * 64 + lane], lbv = kin(A, I_RW_LNB)[l * 256 + head * 64 + lane];
        LDS_WAIT();
#pragma unroll 1
        for (int tb = 0; tb < CH; tb += 4) { float y[4], s1[4], s2[4];
#pragma unroll
            for (int u = 0; u < 4; ++u) { const int t = tb + u; float a = YL[(ti0 + t) * 64 + lane]; const LAS f32x4* qp = (const LAS f32x4*)(Qw + t * 64);
#pragma unroll
                for (int i = 0; i < 16; ++i) { const f32x4 qv = qp[i]; a += srow[4 * i] * qv.x; a += srow[4 * i + 1] * qv.y; a += srow[4 * i + 2] * qv.z; a += srow[4 * i + 3] * qv.w; }
                y[u] = a; s1[u] = a; s2[u] = a * a; }
#pragma unroll
            for (int o = 1; o < 64; o <<= 1) {
#pragma unroll
                for (int u = 0; u < 4; ++u) { s1[u] += shfl_xor_l(s1[u], o, lane); s2[u] += shfl_xor_l(s2[u], o, lane); } }
#pragma unroll
            for (int u = 0; u < 4; ++u) { const int t = tb + u; const float m = s1[u] * (1.f / 64), var = fmaxf(s2[u] * (1.f / 64) - m * m, 0.f); const float rstd = 1.0f / sqrtf(var + RW_LN_EPS);
                const float rk = RK[(size_t)(t0g + t) * 4 + head]; const float vv = RWOP[(ti0 + t) * 384 + 320 + lane]; const float gg = RWG[(size_t)(t0g + t) * 256 + head * 64 + lane];
                const float o = ((y[u] - m) * rstd * lgv + lbv + rk * vv) * gg;
                O16[(size_t)(t0g + t) * D + 512 + head * 64 + lane] = (bf16)f2bf(o); }
        }
        LDS_WAIT();
    }
}
template <int LSTRIDE> __device__ __forceinline__ void attn_stage(LAS unsigned char* lds, const bf16* src, size_t row_stride, int tid) {
    const int r0 = tid >> 5, c = tid & 31; const bf16* sp = src + (size_t)r0 * row_stride + c * 8; LAS unsigned char* dp = lds + r0 * LSTRIDE + c * 16;
#pragma unroll 4
    for (int i = 0; i < 16; ++i) { const v4u v = *(const v4u*)(sp + (size_t)(16 * i) * row_stride); *(LAS v4u*)(dp + 16 * i * LSTRIDE) = v; }
}
constexpr int KSTR = 544, VSTR = 528;
__device__ __forceinline__ void p_attn(const Frame& F) {
    const int lane = F.lane, fr = lane & 15, fq = lane >> 4;
    const bf16* Q = (const bf16*)(F.ws + WS_Q16); const bf16* KM = (const bf16*)(F.ws + WS_KM16); const bf16* VT = (const bf16*)(F.ws + WS_VMT16); bf16* AO = (bf16*)(F.ws + WS_AO16);
    for (int item = F.bid; item < NB * 4 * (SEQ / 256); item += F.G) {
        const int qg = item % (SEQ / 256), bhd = item / (SEQ / 256), head = bhd & 3, b = bhd >> 2;
        attn_stage<KSTR>(F.lds, KM + (size_t)(b * NMEM) * D + head * 256, D, F.tid);
        __syncthreads();
        v4u pf[2][8]; float inv[2];
#pragma unroll
        for (int u = 0; u < 2; ++u) { const int q0 = b * SEQ + qg * 256 + u * 128 + F.wave * 16;
            bf16x8 qf[8];
#pragma unroll
            for (int ks = 0; ks < 8; ++ks) qf[ks] = *(const bf16x8*)(Q + (size_t)(q0 + fr) * D + head * 256 + ks * 32 + fq * 8);
            f32x4 sT[16];
            const LAS unsigned char* kbase = F.lds + fr * KSTR + fq * 16;
#pragma unroll
            for (int kt = 0; kt < 16; ++kt) { f32x4 a = {0, 0, 0, 0}; const LAS unsigned char* kp = kbase + kt * 16 * KSTR;
#pragma unroll
                for (int ks = 0; ks < 8; ++ks) { const bf16x8 kf = *(const LAS bf16x8*)(kp + ks * 64); a = __builtin_amdgcn_mfma_f32_16x16x32_bf16(kf, qf[ks], a, 0, 0, 0); }
                sT[kt] = a; if (kt & 1) __builtin_amdgcn_sched_barrier(0); }
            float mx = -3.0e38f;
#pragma unroll
            for (int kt = 0; kt < 16; ++kt) mx = fmaxf(fmaxf(fmaxf(mx, sT[kt].x), fmaxf(sT[kt].y, sT[kt].z)), sT[kt].w);
            mx = fmaxf(mx, shfl_xor_l(mx, 16, lane)); mx = fmaxf(mx, shfl_xor_l(mx, 32, lane));
            float sum = 0.f;
#pragma unroll
            for (int kt = 0; kt < 16; ++kt) { sT[kt].x = __expf(sT[kt].x - mx); sT[kt].y = __expf(sT[kt].y - mx); sT[kt].z = __expf(sT[kt].z - mx); sT[kt].w = __expf(sT[kt].w - mx); sum += (sT[kt].x + sT[kt].y) + (sT[kt].z + sT[kt].w); }
            sum += shfl_xor_l(sum, 16, lane); sum += shfl_xor_l(sum, 32, lane);
            inv[u] = 1.0f / sum;
#pragma unroll
            for (int kp = 0; kp < 8; ++kp) { v4u w; w.x = pk2(sT[2 * kp].x, sT[2 * kp].y); w.y = pk2(sT[2 * kp].z, sT[2 * kp].w); w.z = pk2(sT[2 * kp + 1].x, sT[2 * kp + 1].y); w.w = pk2(sT[2 * kp + 1].z, sT[2 * kp + 1].w); pf[u][kp] = w; }
            __builtin_amdgcn_sched_barrier(0);
        }
        __syncthreads();
        attn_stage<VSTR>(F.lds, VT + (size_t)(b * D + head * 256) * NMEM, NMEM, F.tid);
        __syncthreads();
#pragma unroll
        for (int u = 0; u < 2; ++u) { const int q0 = b * SEQ + qg * 256 + u * 128 + F.wave * 16;
#pragma unroll 2
            for (int dt = 0; dt < 16; ++dt) { f32x4 o = {0, 0, 0, 0}; const LAS unsigned char* vp = F.lds + (dt * 16 + fr) * VSTR + fq * 8;
#pragma unroll
                for (int kp = 0; kp < 8; ++kp) {
                    const v2u lo = *(const LAS v2u*)(vp + 64 * kp), hi = *(const LAS v2u*)(vp + 64 * kp + 32); v4u w; w.x = lo.x; w.y = lo.y; w.z = hi.x; w.w = hi.y;
                    o = __builtin_amdgcn_mfma_f32_16x16x32_bf16(__builtin_bit_cast(bf16x8, w), __builtin_bit_cast(bf16x8, pf[u][kp]), o, 0, 0, 0); }
                v2u w; w.x = pk2(o.x * inv[u], o.y * inv[u]); w.y = pk2(o.z * inv[u], o.w * inv[u]);
                *(v2u*)(AO + (size_t)(q0 + fr) * D + head * 256 + dt * 16 + 4 * fq) = w; __builtin_amdgcn_sched_barrier(0); } }
        __syncthreads();
    }
}

__device__ __forceinline__ void p_ln(const Frame& F, const float* g, const float* b) {
    const int gw = F.bid * NWAVES + F.wave, NGW = F.G * NWAVES, lane = F.lane; float* H = (float*)(F.ws + WS_H32); bf16* H16 = (bf16*)(F.ws + WS_H16);
    for (int r = gw; r < T; r += NGW) { f32x4 v[4];
#pragma unroll
        for (int j = 0; j < 4; ++j) v[j] = *(const f32x4*)(H + (size_t)r * D + 256 * j + 4 * lane);
        float mean, rstd; ln_stats(v, mean, rstd); ln_apply_store(v, mean, rstd, g, b, H + (size_t)r * D, H16 + (size_t)r * D, lane); }
}
__device__ __forceinline__ void p_ln_router(KArgs& A, const Frame& F, int l) {
    const int gw = F.bid * NWAVES + F.wave, NGW = F.G * NWAVES, lane = F.lane, tid = F.tid;
    float* H = (float*)(F.ws + WS_H32); bf16* H16 = (bf16*)(F.ws + WS_H16); int* TOKE = (int*)(F.ws + WS_TOKE); float* TOKW = (float*)(F.ws + WS_TOKW);
    LAS float* RW = (LAS float*)F.lds;
    volatile LAS unsigned* hist = F.MISC + MI_HIST;
    const float* rw = kin(A, I_ROUTER_W) + (size_t)l * D * NE; const float* rb = kin(A, I_ROUTER_B) + l * NE; const float* g = kin(A, I_LN2_G) + l * D; const float* bb = kin(A, I_LN2_B) + l * D;
    for (int i = tid; i < D * NE / 4; i += NTHREADS) { const int d = i >> 3, e4 = (i & 7) * 4; *(LAS f32x4*)(RW + d * 36 + e4) = *(const f32x4*)(rw + d * NE + e4); }
    if (tid < NE) hist[tid] = 0u;
    __syncthreads();
    for (int r = gw; r < T; r += NGW) { float v[16]; float s = 0.f;
#pragma unroll
        for (int jj = 0; jj < 16; ++jj) { v[jj] = H[(size_t)r * D + 64 * jj + lane]; s += v[jj]; }
        const float mean = wave_sum(s) * (1.f / D); float s2 = 0.f;
#pragma unroll
        for (int jj = 0; jj < 16; ++jj) { v[jj] -= mean; s2 += v[jj] * v[jj]; }
        const float rstd = 1.0f / sqrtf(wave_sum(s2) * (1.f / D) + LN_EPS);
        float lg[NE];
#pragma unroll
        for (int e = 0; e < NE; ++e) lg[e] = 0.f;
#pragma unroll
        for (int jj = 0; jj < 16; ++jj) { const int d = 64 * jj + lane; const float y = v[jj] * rstd * g[d] + bb[d]; H[(size_t)r * D + d] = y; H16[(size_t)r * D + d] = (bf16)f2bf(y);
            const LAS f32x4* wp = (const LAS f32x4*)(RW + d * 36);
#pragma unroll
            for (int e4 = 0; e4 < 8; ++e4) { const f32x4 w = wp[e4]; lg[4 * e4] += y * w.x; lg[4 * e4 + 1] += y * w.y; lg[4 * e4 + 2] += y * w.z; lg[4 * e4 + 3] += y * w.w; } }
#pragma unroll
        for (int e = 0; e < NE; ++e) { lg[e] = wave_sum(lg[e]) + rb[e]; }
        int i0 = -1, i1 = -1, i2 = -1, i3 = -1; float v0 = -3.0e38f, v1 = -3.0e38f, v2 = -3.0e38f, v3 = -3.0e38f;
#pragma unroll
        for (int e = 0; e < NE; ++e) if (lg[e] > v0) { v0 = lg[e]; i0 = e; }
#pragma unroll
        for (int e = 0; e < NE; ++e) if (e != i0 && lg[e] > v1) { v1 = lg[e]; i1 = e; }
#pragma unroll
        for (int e = 0; e < NE; ++e) if (e != i0 && e != i1 && lg[e] > v2) { v2 = lg[e]; i2 = e; }
#pragma unroll
        for (int e = 0; e < NE; ++e) if (e != i0 && e != i1 && e != i2 && lg[e] > v3) { v3 = lg[e]; i3 = e; }
        const float e1 = __expf(v1 - v0), e2 = __expf(v2 - v0), e3 = __expf(v3 - v0), inv = 1.0f / (1.0f + e1 + e2 + e3);
        if (lane == 0) { *(int4*)(TOKE + (size_t)r * 4) = make_int4(i0, i1, i2, i3); *(f32x4*)(TOKW + (size_t)r * 4) = (f32x4){inv, e1 * inv, e2 * inv, e3 * inv};
            __hip_atomic_fetch_add((LAS unsigned*)&hist[i0], 1u, __ATOMIC_RELAXED, __HIP_MEMORY_SCOPE_WORKGROUP); __hip_atomic_fetch_add((LAS unsigned*)&hist[i1], 1u, __ATOMIC_RELAXED, __HIP_MEMORY_SCOPE_WORKGROUP);
            __hip_atomic_fetch_add((LAS unsigned*)&hist[i2], 1u, __ATOMIC_RELAXED, __HIP_MEMORY_SCOPE_WORKGROUP); __hip_atomic_fetch_add((LAS unsigned*)&hist[i3], 1u, __ATOMIC_RELAXED, __HIP_MEMORY_SCOPE_WORKGROUP); }
    }
    __syncthreads();
    if (tid < NE) { const unsigned c = hist[tid]; if (c) atomicAdd(F.ctl + CW_CNT + l * NE + tid, c); }
}
__device__ __forceinline__ void moe_offsets(const Frame& F, int l) {
    if (F.tid == 0) { int acc = 0;
        for (int e = 0; e < NE; ++e) { F.MISC[MI_TOFF + e] = (unsigned)acc; const unsigned c = __hip_atomic_load(F.ctl + CW_CNT + l * NE + e, __ATOMIC_RELAXED, __HIP_MEMORY_SCOPE_AGENT); acc += (int)((c + 255u) >> 8); }
        F.MISC[MI_TOFF + NE] = (unsigned)acc; }
    __syncthreads();
}
__device__ __forceinline__ void p_moe_slots(const Frame& F, int l) {
    const int gw = F.bid * NWAVES + F.wave, NGW = F.G * NWAVES, lane = F.lane;
    moe_offsets(F, l);
    const int* TOKE = (const int*)(F.ws + WS_TOKE); const float* TOKW = (const float*)(F.ws + WS_TOKW); int* TOKS = (int*)(F.ws + WS_TOKS); float* SLOTW = (float*)(F.ws + WS_SLOTW);
    const bf16* H16 = (const bf16*)(F.ws + WS_H16); bf16* XG = (bf16*)(F.ws + WS_XG);
    for (int r = gw; r < T; r += NGW) { int slot = 0;
        if (lane < 4) { const int e = TOKE[(size_t)r * 4 + lane]; const unsigned pos = atomicAdd(F.ctl + CW_CUR + l * NE + e, 1u); slot = (int)F.MISC[MI_TOFF + e] * 256 + (int)pos;
            TOKS[(size_t)r * 4 + lane] = slot; SLOTW[slot] = TOKW[(size_t)r * 4 + lane]; }
        const v4u a = *(const v4u*)(H16 + (size_t)r * D + 8 * lane), b = *(const v4u*)(H16 + (size_t)r * D + 512 + 8 * lane);
#pragma unroll
        for (int k = 0; k < 4; ++k) { const int sk = shfl_idx_l(slot, k); *(v4u*)(XG + (size_t)sk * D + 8 * lane) = a; *(v4u*)(XG + (size_t)sk * D + 512 + 8 * lane) = b; } }
}
__device__ __forceinline__ void p_moe_combine(KArgs& A, const Frame& F, int l) {
    const int gw = F.bid * NWAVES + F.wave, NGW = F.G * NWAVES, lane = F.lane;
    float* H = (float*)(F.ws + WS_H32); bf16* H16 = (bf16*)(F.ws + WS_H16); const int* TOKS = (const int*)(F.ws + WS_TOKS); const bf16* YS = (const bf16*)(F.ws + WS_YS);
    const bool last = (l == NL - 1);
    for (int r = gw; r < T; r += NGW) { f32x4 v[4]; const int4 sl = *(const int4*)(TOKS + (size_t)r * 4);
#pragma unroll
        for (int j = 0; j < 4; ++j) { v[j] = *(const f32x4*)(H + (size_t)r * D + 256 * j + 4 * lane) * DN_ALPHA;
            const v2u y0 = *(const v2u*)(YS + (size_t)sl.x * D + 256 * j + 4 * lane), y1 = *(const v2u*)(YS + (size_t)sl.y * D + 256 * j + 4 * lane), y2 = *(const v2u*)(YS + (size_t)sl.z * D + 256 * j + 4 * lane), y3 = *(const v2u*)(YS + (size_t)sl.w * D + 256 * j + 4 * lane);
            v[j].x += (bf2f(y0.x & 0xffffu) + bf2f(y1.x & 0xffffu)) + (bf2f(y2.x & 0xffffu) + bf2f(y3.x & 0xffffu));
            v[j].y += (bf2f(y0.x >> 16) + bf2f(y1.x >> 16)) + (bf2f(y2.x >> 16) + bf2f(y3.x >> 16));
            v[j].z += (bf2f(y0.y & 0xffffu) + bf2f(y1.y & 0xffffu)) + (bf2f(y2.y & 0xffffu) + bf2f(y3.y & 0xffffu));
            v[j].w += (bf2f(y0.y >> 16) + bf2f(y1.y >> 16)) + (bf2f(y2.y >> 16) + bf2f(y3.y >> 16)); }
        float mean, rstd; ln_stats(v, mean, rstd);
        if (last) ln_apply_store(v, mean, rstd, kin(A, I_LN3_G) + l * D, kin(A, I_LN3_B) + l * D, kout(A) + (size_t)r * D, (bf16*)nullptr, lane);
        else ln_apply_store(v, mean, rstd, kin(A, I_LN3_G) + l * D, kin(A, I_LN3_B) + l * D, H + (size_t)r * D, H16 + (size_t)r * D, lane); }
}

constexpr int NPL = 18;
constexpr int NPHASES = 1 + NL * NPL;
#ifndef ONLY
#define ONLY -1
#endif
#define EN(j) (ONLY < 0 || ONLY == (j))
#define REPS(j) for (int rep_ = 0; rep_ < ((PROBE_PHASE == (j)) ? PROBE_REPS : 1); ++rep_, __syncthreads())
__global__ void __launch_bounds__(NTHREADS, 2) fwd_kernel(Args args) {
    extern __shared__ __attribute__((aligned(16))) unsigned char lds_raw[];
    Frame F;
    F.lds = (LAS unsigned char*)lds_raw; F.MISC = (volatile LAS unsigned*)(F.lds + MISC_OFF);
    F.tid = threadIdx.x; F.lane = F.tid & 63; F.wave = __builtin_amdgcn_readfirstlane(F.tid >> 6); F.G = gridDim.x; F.bid = blockIdx.x;
    F.ws = (unsigned char*)(GAS unsigned char*)args.ws; F.ctl = (unsigned*)(F.ws + WS_CTL);
    for (int u = F.tid; u < (LDS_BYTES - MISC_OFF) / 4; u += NTHREADS) F.MISC[u] = 0u;
    __syncthreads();
    XcdBarrier bar; bar.bar = F.ctl + CW_BAR; bar.x = 0; bar.st = nullptr;
    const int lo = args.ph_lo, hi = args.ph_hi;
    if (hi - lo > 1) bar = xcd_barrier_post(F.ctl + CW_BAR, F.MISC + 8);
#define IN(k) (launder_i(lo) <= (k) && (k) < launder_i(hi))
#define SEAM(k) do { if (IN(k) && IN((k) + 1)) xcd_barrier(bar); } while (0)
#define PH_BEGIN KArgs& KA = *kargs(); unsigned char* ws = launder_p(args.ws); F.ws = ws; (void)KA; (void)ws; { int ln_; asm volatile("v_mbcnt_lo_u32_b32 %0, -1, 0\n\tv_mbcnt_hi_u32_b32 %0, -1, %0" : "=v"(ln_)); F.lane = ln_; } F.tid = F.wave * 64 + F.lane; F.bid = launder_i((int)blockIdx.x); F.G = launder_i((int)gridDim.x);

    if (EN(100) && IN(0)) REPS(100) { PH_BEGIN p_prologue(KA, F); } SEAM(0);

#pragma unroll 1
    for (int l_ = 0; l_ < NL; ++l_) {
        const int l = launder_i(l_); const int p0 = 1 + l * NPL;
        if (EN(0) && IN(p0 + 0)) REPS(0) { PH_BEGIN
            pg8::Gemm g{D, D, D}; pg8::StaticOrder S{(const bf16*)(ws + WS_H16), (const bf16*)(ws + WS_WINT) + (size_t)l * N_IN * D, D, D, T / 256, N_IN / 256, F.G, F.bid};
            EpiIn E{l};
            pg8::gemm_phase(F.lds, F.tid, g, S, E);
        } SEAM(p0 + 0);
        if (EN(1) && IN(p0 + 1)) REPS(1) { PH_BEGIN p_mix1(KA, F, l); } SEAM(p0 + 1);
        if (EN(2) && IN(p0 + 2)) REPS(2) { PH_BEGIN
            { pg8::Gemm g{S5K, 1024, 1024}; pg8::BatchOrder S{(const bf16*)(ws + WS_AOUT), (const bf16*)(ws + WS_S5BC) + (size_t)l * 16 * 256 * 1024, S5K, 1024, NCHT / 256, 1, 16, F.G, F.bid, (size_t)NCHT * S5K, (size_t)256 * 1024};
              EpiXloc E{0}; pg8::gemm_phase(F.lds, F.tid, g, S, E); }
            __syncthreads();
            { pg8::Gemm g{D, D, D}; pg8::StaticOrder S{(const bf16*)(ws + WS_MEM16), (const bf16*)(ws + WS_WKT) + (size_t)l * D * D, D, D, NB * NMEM / 256, D / 256, F.G, F.bid};
              EpiBf16 E{(unsigned)(WS_KM16 / MiB), 1.0f}; pg8::gemm_phase(F.lds, F.tid, g, S, E); }
            __syncthreads();
            { pg8::Gemm g{D, D, D}; pg8::StaticOrder S{(const bf16*)(ws + WS_MEM16), (const bf16*)(ws + WS_WVT) + (size_t)l * D * D, D, D, NB * NMEM / 256, D / 256, F.G, F.bid};
              EpiVT E{0}; pg8::gemm_phase(F.lds, F.tid, g, S, E); }
        } SEAM(p0 + 2);
        if (EN(3) && IN(p0 + 3)) REPS(3) { PH_BEGIN p_s5_chain(KA, F, l); p_rw_chunks(F); } SEAM(p0 + 3);
        if (EN(4) && IN(p0 + 4)) REPS(4) { PH_BEGIN
            p_chain_compose(F);
            pg8::Gemm g{S5K, S5K, S5K}; pg8::BatchOrder S{(const bf16*)(ws + WS_AOUT), (const bf16*)(ws + WS_S5BT) + (size_t)l * 16 * 1024 * S5K, S5K, S5K, NCHT / 256, 1024 / 256, 16, F.G, F.bid, (size_t)NCHT * S5K, (size_t)1024 * S5K};
            EpiS5Y E{l}; pg8::gemm_phase(F.lds, F.tid, g, S, E);
        } SEAM(p0 + 4);
        if (EN(5) && IN(p0 + 5)) REPS(5) { PH_BEGIN
            const int nchain = (F.G >= 16) ? 8 : 0;
            if (F.bid < nchain) { p_chain_blocks(F, F.bid * NWAVES + F.wave, nchain * NWAVES); }
            else {
                if (nchain == 0) { p_chain_blocks(F, F.bid * NWAVES + F.wave, F.G * NWAVES); __syncthreads(); }
                pg8::Gemm g{256, 256, 256}; pg8::StaticOrder S{(const bf16*)(ws + WS_YD16), (const bf16*)(ws + WS_GLUT) + (size_t)l * 256 * 256, 256, 256, T / 256, 1, F.G - nchain, F.bid - nchain};
                EpiGlu E{l}; pg8::gemm_phase(F.lds, F.tid, g, S, E);
            }
        } SEAM(p0 + 5);
        if (EN(6) && IN(p0 + 6)) REPS(6) { PH_BEGIN
            for (int bb = F.bid; bb < 16 * NBLK; bb += F.G) {
                if (F.wave < 4) chain_inblock(F, bb, F.wave);
                VM_WAIT(); __syncthreads();
                rw_out_task(KA, F, l, bb * CB + F.wave);
                __syncthreads();
            }
        } SEAM(p0 + 6);
        if (EN(7) && IN(p0 + 7)) REPS(7) { PH_BEGIN
#pragma unroll 1
            for (int br = 0; br < 4; ++br) {
                pg8::Gemm g{D, 256, 256}; pg8::StaticOrder S{(const bf16*)(ws + WS_O16) + br * 256, (const bf16*)(ws + WS_BRT) + (size_t)(l * 4 + br) * D * 256, D, 256, T / 256, D / 256, F.G, F.bid};
                EpiBranch E{br}; pg8::gemm_phase(F.lds, F.tid, g, S, E);
                VM_WAIT(); __syncthreads();
            }
        } SEAM(p0 + 7);
        if (EN(8) && IN(p0 + 8)) REPS(8) { PH_BEGIN
            pg8::Gemm g{D, D, D}; pg8::StaticOrder S{(const bf16*)(ws + WS_MG16), (const bf16*)(ws + WS_WOUTT) + (size_t)l * D * D, D, D, T / 256, D / 256, F.G, F.bid};
            EpiResid E{0}; pg8::gemm_phase(F.lds, F.tid, g, S, E);
        } SEAM(p0 + 8);
        if (EN(9) && IN(p0 + 9)) REPS(9) { PH_BEGIN p_ln(F, kin(KA, I_LN1_G) + l * D, kin(KA, I_LN1_B) + l * D); } SEAM(p0 + 9);
        if (EN(10) && IN(p0 + 10)) REPS(10) { PH_BEGIN
            pg8::Gemm g{D, D, D}; pg8::StaticOrder S{(const bf16*)(ws + WS_H16), (const bf16*)(ws + WS_WQT) + (size_t)l * D * D, D, D, T / 256, D / 256, F.G, F.bid};
            EpiBf16 E{(unsigned)(WS_Q16 / MiB), 0.0625f}; pg8::gemm_phase(F.lds, F.tid, g, S, E);
        } SEAM(p0 + 10);
        if (EN(11) && IN(p0 + 11)) REPS(11) { PH_BEGIN p_attn(F); } SEAM(p0 + 11);
        if (EN(12) && IN(p0 + 12)) REPS(12) { PH_BEGIN
            pg8::Gemm g{D, D, D}; pg8::StaticOrder S{(const bf16*)(ws + WS_AO16), (const bf16*)(ws + WS_WOT) + (size_t)l * D * D, D, D, T / 256, D / 256, F.G, F.bid};
            EpiResid E{0}; pg8::gemm_phase(F.lds, F.tid, g, S, E);
        } SEAM(p0 + 12);
        if (EN(13) && IN(p0 + 13)) REPS(13) { PH_BEGIN p_ln_router(KA, F, l); } SEAM(p0 + 13);
        if (EN(14) && IN(p0 + 14)) REPS(14) { PH_BEGIN p_moe_slots(F, l); } SEAM(p0 + 14);
        if (EN(15) && IN(p0 + 15)) REPS(15) { PH_BEGIN
            moe_offsets(F, l);
            pg8::Gemm g{D, D, D}; pg8::MoeOrder S{(const bf16*)(ws + WS_XG), (const bf16*)(ws + WS_W1T) + (size_t)l * NE * 2048 * D, D, D, 2048 / 256, F.G, F.bid, (size_t)2048 * D, (const LAS int*)(F.MISC + MI_TOFF)};
            EpiSwiglu E{l}; pg8::gemm_phase(F.lds, F.tid, g, S, E);
        } SEAM(p0 + 15);
        if (EN(16) && IN(p0 + 16)) REPS(16) { PH_BEGIN
            moe_offsets(F, l);
            pg8::Gemm g{DFF, DFF, DFF}; pg8::MoeOrder S{(const bf16*)(ws + WS_ACT), (const bf16*)(ws + WS_W2T) + (size_t)l * NE * D * DFF, DFF, DFF, D / 256, F.G, F.bid, (size_t)D * DFF, (const LAS int*)(F.MISC + MI_TOFF)};
            EpiMoeOut E{l}; pg8::gemm_phase(F.lds, F.tid, g, S, E);
        } SEAM(p0 + 16);
        if (EN(17) && IN(p0 + 17)) REPS(17) { PH_BEGIN p_moe_combine(KA, F, l); } SEAM(p0 + 17);
    }
#undef IN
#undef SEAM
}

extern "C" void kernel_launch(void* const* d_in, const int* in_sizes, int n_in, void* d_out, int out_size, void* d_ws, size_t ws_size, hipStream_t stream) {
    static int grid = 0;
    if (grid == 0) {
        if (n_in != 50 || ws_size < WS_END) { fprintf(stderr, "kernel_launch: unexpected n_in %d / ws_size %zu\n", n_in, ws_size); grid = -1; return; }
        int dev = 0, cus = 0, per_cu = 0;
        if (hipGetDevice(&dev) != hipSuccess || hipDeviceGetAttribute(&cus, hipDeviceAttributeMultiprocessorCount, dev) != hipSuccess) { grid = -1; return; }
        if (hipFuncSetAttribute((const void*)fwd_kernel, hipFuncAttributeMaxDynamicSharedMemorySize, LDS_BYTES) != hipSuccess) { fprintf(stderr, "kernel_launch: hipFuncSetAttribute failed\n"); grid = -1; return; }
        if (hipOccupancyMaxActiveBlocksPerMultiprocessor(&per_cu, (const void*)fwd_kernel, NTHREADS, LDS_BYTES) != hipSuccess || per_cu < 1) { fprintf(stderr, "kernel_launch: occupancy query says %d\n", per_cu); }
        (void)hipGetLastError();
        grid = cus;
    }
    if (grid < 0) return;
    (void)hipMemsetAsync((char*)d_ws + WS_CTL, 0, CTL_ZERO_BYTES, stream);
    Args a{};
    for (int i = 0; i < 50; ++i) a.in[i] = (const float*)d_in[i];
    a.out = (float*)d_out; a.ws = (unsigned char*)d_ws;
#if N_LAUNCHES == 1
    a.ph_lo = 0; a.ph_hi = NPHASES;
    hipLaunchKernelGGL(fwd_kernel, dim3(grid), dim3(NTHREADS), LDS_BYTES, stream, a);
#else
    for (int p = 0; p < NPHASES; ++p) { a.ph_lo = p; a.ph_hi = p + 1; hipLaunchKernelGGL(fwd_kernel, dim3(grid), dim3(NTHREADS), LDS_BYTES, stream, a); }
#endif
}
```

```cpp
#include <hip/hip_runtime.h>
#include <cstdio>
#include <cstdint>

#ifndef N_LAUNCHES
#define N_LAUNCHES 1
#endif

#ifndef PROBE_PHASE
#define PROBE_PHASE -1
#endif
#ifndef PROBE_REPS
#define PROBE_REPS 3
#endif
#define GAS __attribute__((address_space(1)))
#define LAS __attribute__((address_space(3)))
typedef unsigned short bf16;
typedef unsigned v4u __attribute__((ext_vector_type(4)));
typedef unsigned v2u __attribute__((ext_vector_type(2)));
typedef float f32x4 __attribute__((ext_vector_type(4)));
typedef float f32x2 __attribute__((ext_vector_type(2)));
typedef short bf16x8 __attribute__((ext_vector_type(8)));
typedef short bf16x4 __attribute__((ext_vector_type(4)));

constexpr int NL = 2, NB = 4, SEQ = 8192, T = NB * SEQ, D = 1024;
constexpr int NMEM = 256;
constexpr int OFF_B = 768, OFF_C = 1280, OFF_D = 2304, OFF_G = 2560, N_IN = 6656, ZLD = 2560;
constexpr int NE = 32, TOPK = 4, DFF = 1024;
constexpr int CH = 64;
constexpr int NCH = SEQ / CH;
constexpr int NCHT = T / CH;
constexpr int S5K = 1152;
constexpr int SLOT_ROWS = T * TOPK + NE * 256;
constexpr float LN_EPS = 1e-5f, RW_LN_EPS = 64e-5f;
constexpr float DN_ALPHA = 1.41421356237309515f;

constexpr size_t MiB = 1u << 20;
constexpr size_t WS_CTL = 0, CTL_ZERO_BYTES = 1 * MiB;
constexpr size_t WS_W1T = 2 * MiB;
constexpr size_t WS_W2T = 258 * MiB;
constexpr size_t WS_WINT = 386 * MiB;
constexpr size_t WS_BRT = 412 * MiB;
constexpr size_t WS_WOUTT = 416 * MiB, WS_WQT = 420 * MiB, WS_WKT = 424 * MiB, WS_WVT = 428 * MiB, WS_WOT = 432 * MiB;
constexpr size_t WS_GLUT = 436 * MiB;
constexpr size_t WS_MEM16 = 437 * MiB;
constexpr size_t WS_S5BT = 440 * MiB;
constexpr size_t WS_S5BC = 512 * MiB;
constexpr size_t WS_H32 = 528 * MiB;
constexpr size_t WS_H16 = 656 * MiB;
constexpr size_t WS_Z = 720 * MiB;
constexpr size_t WS_XG = 720 * MiB;
constexpr size_t WS_SG = 1040 * MiB;
constexpr size_t WS_YS = 1040 * MiB;
constexpr size_t WS_O16 = 1312 * MiB, WS_MG16 = 1376 * MiB, WS_Q16 = 1440 * MiB, WS_AO16 = 1504 * MiB;
constexpr size_t WS_RWOP = 1568 * MiB;
constexpr size_t WS_ACT = 1568 * MiB;
constexpr size_t WS_QH = 1760 * MiB, WS_YL = 1792 * MiB, WS_GC = 1824 * MiB, WS_HC = 1856 * MiB, WS_SC = 1888 * MiB, WS_RWG = 1920 * MiB;
constexpr size_t WS_RK = 1952 * MiB;
constexpr size_t WS_AOUT = 1954 * MiB;
constexpr size_t WS_XLOC = 1972 * MiB;
constexpr size_t WS_YD16 = 1976 * MiB;
constexpr size_t WS_KM16 = 1992 * MiB, WS_VMT16 = 1994 * MiB;
constexpr size_t WS_TOKE = 1996 * MiB, WS_TOKW = 1997 * MiB, WS_TOKS = 1998 * MiB, WS_SLOTW = 1999 * MiB;
constexpr size_t WS_GB = 2000 * MiB, WS_HB = 2004 * MiB, WS_SB = 2008 * MiB;
constexpr size_t WS_END = 2012 * MiB;
static_assert(WS_XG + (size_t)SLOT_ROWS * D * 2 <= WS_SG && WS_YS + (size_t)SLOT_ROWS * D * 2 <= WS_O16 && WS_ACT + (size_t)SLOT_ROWS * D * 2 <= WS_RK, "overlays");
constexpr int CW_BAR = 4096;
constexpr int CW_CNT = 16384;
constexpr int CW_CUR = 16384 + 128;
constexpr int CW_WGH = 65536;

constexpr int LDS_BYTES = 163840;
constexpr int MISC_OFF = LDS_BYTES - 1024;
constexpr int RING_BYTES = 131072;
constexpr int NWAVES = 8, NTHREADS = 512;

#define LDS_WAIT() asm volatile("s_waitcnt lgkmcnt(0)" ::: "memory")
#define VM_WAIT() asm volatile("s_waitcnt vmcnt(0)" ::: "memory")
__device__ __forceinline__ unsigned f2bf(float f) { unsigned u = __float_as_uint(f); return (u + 0x7fffu + ((u >> 16) & 1u)) >> 16; }
__device__ __forceinline__ unsigned pk2(float lo, float hi) { return f2bf(lo) | (f2bf(hi) << 16); }
__device__ __forceinline__ float bf2f(unsigned h) { return __uint_as_float(h << 16); }
__device__ __forceinline__ float sigmoidf_(float x) { return 1.0f / (1.0f + __expf(-x)); }
__device__ __forceinline__ int my_lane() { int l; asm volatile("v_mbcnt_lo_u32_b32 %0, -1, 0\n\tv_mbcnt_hi_u32_b32 %0, -1, %0" : "=v"(l)); return l; }
__device__ __forceinline__ float shfl_xor_l(float v, int o, int lane) { return __builtin_bit_cast(float, __builtin_amdgcn_ds_bpermute((lane ^ o) << 2, __builtin_bit_cast(int, v))); }
__device__ __forceinline__ int shfl_idx_l(int v, int src) { return __builtin_amdgcn_ds_bpermute(src << 2, v); }
__device__ __forceinline__ float wave_sum(float v) {
    const int ln = my_lane();
#pragma unroll
    for (int o = 1; o < 64; o <<= 1) v += shfl_xor_l(v, o, ln);
    return v;
}

#define XB_TMO      128
#define XB_XCNT(j)  (256  + 64 * (j))
#define XB_XSUB(j)  (1280 + 64 * (j))
#define XB_XGEN(j)  (2304 + 64 * (j))
#define XB_TOP      3328
#define XB_TOPGEN   3392
#define XCD_BAR_WORDS 3456
#define XB_SPIN_CAP (1u << 24)
__device__ __forceinline__ unsigned xb_ld(unsigned* p)              { return __hip_atomic_load(p, __ATOMIC_RELAXED, __HIP_MEMORY_SCOPE_AGENT); }
__device__ __forceinline__ unsigned xb_add(unsigned* p, unsigned v) { return __hip_atomic_fetch_add(p, v, __ATOMIC_RELAXED, __HIP_MEMORY_SCOPE_AGENT); }
__device__ __forceinline__ unsigned xb_xcc_id() { return (unsigned)__builtin_amdgcn_s_getreg((3 << 11) | 20) & 0xFu; }
#define XB_SPIN(cond, bar) do { unsigned _sp = 0; while (cond) { __builtin_amdgcn_s_sleep(1); \
    if ((++_sp & 255u) == 0u) { if (xb_ld(&(bar)[XB_TMO])) break; if (_sp > XB_SPIN_CAP) { atomicAdd(&(bar)[XB_TMO], 1u); break; } } } } while (0)
struct XcdBarrier { unsigned* bar; unsigned x; volatile LAS unsigned* st; };
__device__ __forceinline__ XcdBarrier xcd_barrier_post(unsigned* bar, volatile LAS unsigned* st) {
    XcdBarrier b; b.bar = bar; b.x = xb_xcc_id(); b.st = st;
    if (threadIdx.x == 0) (void)xb_add(&bar[XB_XCNT(b.x)], 1u);
    return b;
}
__device__ __forceinline__ void xcd_barrier_complete(unsigned* bar, unsigned x, unsigned& nloc, unsigned& nx) {
    const unsigned G = gridDim.x * gridDim.y * gridDim.z;
    unsigned sum, cnt, mine, sp = 0u;
    for (;;) {
        sum = 0u; cnt = 0u; mine = 0u;
#pragma unroll
        for (unsigned j = 0; j < 16; ++j) { const unsigned c = xb_ld(&bar[XB_XCNT(j)]); sum += c; cnt += (c > 0u) ? 1u : 0u; mine = (j == x) ? c : mine; }
        if (sum == G) break;
        __builtin_amdgcn_s_sleep(1);
        if ((++sp & 255u) == 0u) { if (xb_ld(&bar[XB_TMO])) break; if (sp > XB_SPIN_CAP) { atomicAdd(&bar[XB_TMO], 1u); break; } }
    }
    nloc = mine > 0u ? mine : 1u; nx = cnt > 0u ? cnt : 1u;
}
__device__ __forceinline__ void xcd_barrier(const XcdBarrier& b) {
    asm volatile("s_waitcnt vmcnt(0)" ::: "memory");
    __syncthreads();
    if (threadIdx.x == 0) {
        unsigned* bar = b.bar; unsigned bx = b.x;
        asm volatile("" : "+s"(bar), "+s"(bx));
        __builtin_amdgcn_s_waitcnt(0);
        unsigned nloc = b.st[0], nx = b.st[1];
        if (nloc == 0u) { xcd_barrier_complete(bar, bx, nloc, nx); b.st[0] = nloc; b.st[1] = nx; }
        const unsigned old = xb_add(&bar[XB_XSUB(bx)], 1u);
        const unsigned gen = old / nloc;
        if (old + 1u == (gen + 1u) * nloc) {
            __builtin_amdgcn_fence(__ATOMIC_RELEASE, "agent");
            asm volatile("s_waitcnt vmcnt(0)" ::: "memory");
            const unsigned og = xb_add(&bar[XB_TOP], 1u);
            const unsigned tg = og / nx;
            if (og + 1u == (tg + 1u) * nx) xb_add(&bar[XB_TOPGEN], 1u);
            else XB_SPIN(xb_ld(&bar[XB_TOPGEN]) == tg, bar);
            __builtin_amdgcn_fence(__ATOMIC_ACQUIRE, "agent");
            xb_add(&bar[XB_XGEN(bx)], 1u);
            asm volatile("s_waitcnt vmcnt(0)" ::: "memory");
        } else {
            XB_SPIN(xb_ld(&bar[XB_XGEN(bx)]) == gen, bar);
            __builtin_amdgcn_fence(__ATOMIC_ACQUIRE, "agent");
            asm volatile("s_waitcnt vmcnt(0)" ::: "memory");
        }
    }
    __syncthreads();
}

namespace pg8 {
constexpr int BM = 256, BK = 64, HALF = 128, HTB = HALF * BK * 2, STAGE_BYTES = 8 * HTB, NXCD = 8, WGM = 8;
__host__ __device__ __forceinline__ int lds_byte(int r, int c) { const int st = (r >> 4) * 2 + (c >> 5), rr = r & 15, cc = c & 31, ob = rr * 64 + cc * 2; return st * 1024 + (ob ^ (((ob >> 9) & 1) << 5)); }
__host__ __device__ __forceinline__ void stage_rc(int b, int& R, int& C) { const int st = b / 1024, sb = b % 1024, swz = sb ^ (((sb >> 9) & 1) << 5); R = (st >> 1) * 16 + swz / 64; C = (st & 1) * 32 + (swz % 64) / 2; }
struct Unit { int pm, pn, e; };
struct Gemm { int lda, ldb, K; };

__device__ __forceinline__ bool static_tile(int i, int G, int c, int nM, int nN, int& pm, int& pn) {
    const int nwg = nM * nN; const long L = (long)i * G + c; if (L >= nwg) return false;
    int wgid = (int)L; { const int q = nwg / NXCD, r = nwg % NXCD, xcd = wgid % NXCD, off = wgid / NXCD; wgid = (xcd < r ? xcd * (q + 1) : r * (q + 1) + (xcd - r) * q) + off; }
    const int nig = WGM * nN, gid = wgid / nig, fm = gid * WGM, gsz = (nM - fm) < WGM ? (nM - fm) : WGM;
    pm = fm + ((wgid % nig) % gsz); pn = (wgid % nig) / gsz; return true;
}
struct StaticOrder {
    const bf16* A; const bf16* Bt; int lda, ldb, nM, nN, G, c;
    __device__ __forceinline__ bool next(int i, Unit& u) const { u.e = 0; return static_tile(i, G, c, nM, nN, u.pm, u.pn); }
    __device__ __forceinline__ const char* a_base(const Unit& u) const { return (const char*)(A + (size_t)u.pm * BM * lda); }
    __device__ __forceinline__ const char* b_base(const Unit& u) const { return (const char*)(Bt + (size_t)u.pn * BM * ldb); }
};
struct BatchOrder {
    const bf16* A; const bf16* Bt; int lda, ldb, nM, nN, nb, G, c; size_t sA, sB;
    __device__ __forceinline__ bool next(int i, Unit& u) const {
        const long L = (long)i * G + c; const int per = nM * nN; if (L >= (long)per * nb) return false;
        u.e = (int)(L / per); const int r = (int)(L % per); u.pn = r / nM; u.pm = r % nM; return true; }
    __device__ __forceinline__ const char* a_base(const Unit& u) const { return (const char*)(A + (size_t)u.e * sA + (size_t)u.pm * BM * lda); }
    __device__ __forceinline__ const char* b_base(const Unit& u) const { return (const char*)(Bt + (size_t)u.e * sB + (size_t)u.pn * BM * ldb); }
};
struct MoeOrder {
    const bf16* A; const bf16* Bt; int lda, ldb, nN, G, c; size_t sB; const LAS int* toff;
    __device__ __forceinline__ bool next(int i, Unit& u) const {
        const long L = (long)i * G + c; const int nt = toff[NE]; if (L >= (long)nt * nN) return false;
        const int mt = (int)(L / nN); u.pn = (int)(L % nN); u.pm = mt; int e = 0;
#pragma unroll 1
        for (int k = 1; k < NE; ++k) e += (toff[k] <= mt) ? 1 : 0;
        u.e = e; return true; }
    __device__ __forceinline__ const char* a_base(const Unit& u) const { return (const char*)(A + (size_t)u.pm * BM * lda); }
    __device__ __forceinline__ const char* b_base(const Unit& u) const { return (const char*)(Bt + (size_t)u.e * sB + (size_t)u.pn * BM * ldb); }
};

template <class F> __device__ __forceinline__ void epi_foreach(const f32x4 (&acc)[2][2][4][2], const Unit& u, int wr, int wc, int fr, int fq, const F& f) {
#pragma unroll
    for (int ai = 0; ai < 2; ++ai)
#pragma unroll
        for (int m = 0; m < 4; ++m) { const int row = u.pm * BM + ai * HALF + wr * 64 + m * 16 + fr;
#pragma unroll
            for (int bj = 0; bj < 2; ++bj)
#pragma unroll
                for (int n = 0; n < 2; ++n) f(row, u.pn * BM + bj * HALF + wc * 32 + n * 16 + 4 * fq, acc[ai][bj][m][n]);
            __builtin_amdgcn_sched_barrier(0); }
}

template <class Epi, class Sched, bool ALIGN_EPI = true, bool SP2 = true>
__device__ __forceinline__ void gemm_phase(LAS unsigned char* lds, const int tid, const Gemm g, const Sched& S, const Epi& E) {
    const int wid = __builtin_amdgcn_readfirstlane(tid >> 6), lane = tid & 63, wr = wid >> 2, wc = wid & 3, fr = lane & 15, fq = lane >> 4;
    const int K = g.K, nt = K / BK;
    unsigned voffA[2], voffB[2];
#pragma unroll
    for (int i = 0; i < 2; ++i) { int R, C; stage_rc(tid * 16 + i * 8192, R, C);
        voffA[i] = (unsigned)(R * g.lda + C) * 2u; voffB[i] = (unsigned)(R * g.ldb + C) * 2u; }
    const size_t kstep = (size_t)(BK * 2);
    const size_t hstepA = (size_t)HALF * g.lda * 2, hstepB = (size_t)HALF * g.ldb * 2;
    const unsigned ldsw = (unsigned)wid * 1024u;
    const int aoff = lds_byte(wr * 64 + fr, fq * 8), boff = lds_byte(wc * 32 + fr, fq * 8);
#define PG8_SA(b, h) (((b) * 2 + (h)) * HTB)
#define PG8_SB(b, h) ((4 + (b) * 2 + (h)) * HTB)
#define PG8_STAGE(bufoff, gbase, voff) do { _Pragma("unroll") for (int _i = 0; _i < 2; ++_i) \
        __builtin_amdgcn_global_load_lds((const unsigned*)((const char*)(gbase) + (voff)[_i]), (LAS unsigned*)(lds + (bufoff) + ldsw + _i * 8192), 16, 0, 0); } while (0)
#define PG8_LDA(dst, b, h) do { _Pragma("unroll") for (int m = 0; m < 4; ++m) _Pragma("unroll") for (int k = 0; k < 2; ++k) dst[m][k] = *(const LAS bf16x8*)(lds + PG8_SA(b, h) + aoff + m * 2048 + k * 1024); } while (0)
#define PG8_LDB(dst, b, h) do { _Pragma("unroll") for (int n = 0; n < 2; ++n) _Pragma("unroll") for (int k = 0; k < 2; ++k) dst[n][k] = *(const LAS bf16x8*)(lds + PG8_SB(b, h) + boff + n * 2048 + k * 1024); } while (0)
#define PG8_MMA(ai, bj, At, Bt) do { __builtin_amdgcn_s_setprio(1); _Pragma("unroll") for (int m = 0; m < 4; ++m) _Pragma("unroll") for (int n = 0; n < 2; ++n) _Pragma("unroll") for (int k = 0; k < 2; ++k) \
        acc[ai][bj][m][n] = __builtin_amdgcn_mfma_f32_16x16x32_bf16(Bt[n][k], At[m][k], acc[ai][bj][m][n], 0, 0, 0); __builtin_amdgcn_s_setprio(0); } while (0)
#define PG8_WAIT_V(n) asm volatile("s_waitcnt vmcnt(" #n ")" ::: "memory")
#define PG8_WAIT_L(n) asm volatile("s_waitcnt lgkmcnt(" #n ")" ::: "memory")
#define PG8_BAR __builtin_amdgcn_s_barrier()
#define PG8_SCHED __builtin_amdgcn_sched_barrier(0)
    Unit cur, nxt; int ui = 0;
    if (!S.next(0, cur)) return;
    f32x4 acc[2][2][4][2];
#pragma unroll
    for (int a = 0; a < 2; ++a)
#pragma unroll
        for (int b = 0; b < 2; ++b)
#pragma unroll
            for (int m = 0; m < 4; ++m)
#pragma unroll
                for (int n = 0; n < 2; ++n) acc[a][b][m][n] = (f32x4){0.f, 0.f, 0.f, 0.f};
    bf16x8 At[4][2], B0[2][2], B1[2][2];
    const char* cA = S.a_base(cur); const char* cB = S.b_base(cur);
    if constexpr (SP2) {
        PG8_STAGE(PG8_SB(0, 0), cB, voffB); PG8_STAGE(PG8_SB(0, 1), cB + hstepB, voffB); PG8_STAGE(PG8_SA(0, 0), cA, voffA); PG8_STAGE(PG8_SA(0, 1), cA + hstepA, voffA);
        if (wr == 1) PG8_BAR;
        PG8_WAIT_V(2); PG8_BAR;
        PG8_STAGE(PG8_SB(1, 0), cB + kstep, voffB); PG8_STAGE(PG8_SA(1, 0), cA + kstep, voffA); PG8_STAGE(PG8_SB(1, 1), cB + hstepB + kstep, voffB);
        PG8_WAIT_V(6); PG8_BAR;
    } else {
        PG8_STAGE(PG8_SB(0, 0), cB, voffB); PG8_STAGE(PG8_SA(0, 0), cA, voffA); PG8_STAGE(PG8_SB(0, 1), cB + hstepB, voffB); PG8_STAGE(PG8_SA(0, 1), cA + hstepA, voffA);
        if (wr == 1) PG8_BAR;
        PG8_WAIT_V(4); PG8_BAR;
        PG8_STAGE(PG8_SB(1, 0), cB + kstep, voffB); PG8_STAGE(PG8_SA(1, 0), cA + kstep, voffA); PG8_STAGE(PG8_SB(1, 1), cB + hstepB + kstep, voffB);
        PG8_WAIT_V(6); PG8_BAR;
    }
    for (;;) {
        const bool has_next = S.next(ui + 1, nxt);
        const char* nA = has_next ? S.a_base(nxt) : cA; const char* nB = has_next ? S.b_base(nxt) : cB;
        for (int t = 0; t < nt; t += 2) {
            const bool last = (t == nt - 2);
            const char* a1 = cA + (size_t)(t + 1) * kstep;
            const char* a2 = last ? nA : cA + (size_t)(t + 2) * kstep; const char* b2 = last ? nB : cB + (size_t)(t + 2) * kstep;
            const char* a3 = a2 + kstep; const char* b3 = b2 + kstep;
            if constexpr (SP2) {
            PG8_LDB(B0, 0, 0); PG8_LDB(B1, 0, 1); PG8_SCHED; PG8_LDA(At, 0, 0); PG8_STAGE(PG8_SA(1, 1), a1 + hstepA, voffA);
            PG8_WAIT_V(8); PG8_WAIT_L(0); PG8_BAR; PG8_MMA(0, 0, At, B0); PG8_MMA(0, 1, At, B1); PG8_BAR; PG8_SCHED;
            PG8_LDA(At, 0, 1); PG8_STAGE(PG8_SB(0, 0), b2, voffB); PG8_STAGE(PG8_SB(0, 1), b2 + hstepB, voffB); PG8_STAGE(PG8_SA(0, 0), a2, voffA);
            PG8_WAIT_V(8); PG8_WAIT_L(0); PG8_BAR; PG8_MMA(1, 0, At, B0); PG8_MMA(1, 1, At, B1); PG8_BAR; PG8_SCHED;
            PG8_LDB(B0, 1, 0); PG8_LDB(B1, 1, 1); PG8_SCHED; PG8_LDA(At, 1, 0); PG8_STAGE(PG8_SA(0, 1), a2 + hstepA, voffA);
            PG8_WAIT_V(8); PG8_WAIT_L(0); PG8_BAR; PG8_MMA(0, 0, At, B0); PG8_MMA(0, 1, At, B1); PG8_BAR; PG8_SCHED;
            PG8_LDA(At, 1, 1); PG8_STAGE(PG8_SB(1, 0), b3, voffB); PG8_STAGE(PG8_SB(1, 1), b3 + hstepB, voffB); PG8_STAGE(PG8_SA(1, 0), a3, voffA);
            PG8_WAIT_V(8); PG8_WAIT_L(0); PG8_BAR; PG8_MMA(1, 0, At, B0); PG8_MMA(1, 1, At, B1); PG8_BAR; PG8_SCHED;
            } else {
            PG8_LDB(B0, 0, 0); PG8_SCHED; PG8_LDA(At, 0, 0); PG8_STAGE(PG8_SA(1, 1), a1 + hstepA, voffA);
            PG8_WAIT_L(8); PG8_BAR; PG8_WAIT_L(0); PG8_MMA(0, 0, At, B0); PG8_BAR; PG8_SCHED;
            PG8_LDB(B1, 0, 1); PG8_STAGE(PG8_SB(0, 0), b2, voffB);
            PG8_BAR; PG8_WAIT_L(0); PG8_MMA(0, 1, At, B1); PG8_BAR;
            PG8_LDA(At, 0, 1); PG8_STAGE(PG8_SA(0, 0), a2, voffA);
            PG8_BAR; PG8_WAIT_L(0); PG8_MMA(1, 0, At, B0); PG8_BAR; PG8_SCHED;
            PG8_STAGE(PG8_SB(0, 1), b2 + hstepB, voffB);
            PG8_WAIT_V(6); PG8_BAR; PG8_MMA(1, 1, At, B1); PG8_BAR;
            PG8_LDB(B0, 1, 0); PG8_SCHED; PG8_LDA(At, 1, 0); PG8_STAGE(PG8_SA(0, 1), a2 + hstepA, voffA);
            PG8_WAIT_L(8); PG8_BAR; PG8_WAIT_L(0); PG8_MMA(0, 0, At, B0); PG8_BAR; PG8_SCHED;
            PG8_LDB(B1, 1, 1); PG8_STAGE(PG8_SB(1, 0), b3, voffB);
            PG8_BAR; PG8_WAIT_L(0); PG8_MMA(0, 1, At, B1); PG8_BAR;
            PG8_LDA(At, 1, 1); PG8_STAGE(PG8_SA(1, 0), a3, voffA);
            PG8_BAR; PG8_WAIT_L(0); PG8_MMA(1, 0, At, B0); PG8_BAR; PG8_SCHED;
            PG8_STAGE(PG8_SB(1, 1), b3 + hstepB, voffB);
            PG8_WAIT_V(6); PG8_BAR; PG8_MMA(1, 1, At, B1); PG8_BAR;
            }
        }
        if constexpr (ALIGN_EPI) { if (wr == 0) PG8_BAR; }
        { int tz = tid; asm volatile("" : "+v"(tz));
          const int wid2 = __builtin_amdgcn_readfirstlane(tz >> 6), lane2 = tz & 63;
          E(acc, cur, wid2 >> 2, wid2 & 3, lane2 & 15, lane2 >> 4); }
        if (!has_next) break;
#pragma unroll
        for (int a = 0; a < 2; ++a)
#pragma unroll
            for (int b = 0; b < 2; ++b)
#pragma unroll
                for (int m = 0; m < 4; ++m)
#pragma unroll
                    for (int n = 0; n < 2; ++n) acc[a][b][m][n] = (f32x4){0.f, 0.f, 0.f, 0.f};
        cur = nxt; cA = nA; cB = nB; ++ui;
        if constexpr (ALIGN_EPI) { if (wr == 1) PG8_BAR; }
    }
    PG8_WAIT_V(0);
    if constexpr (!ALIGN_EPI) { if (wr == 0) PG8_BAR; }
    PG8_BAR;
#undef PG8_SA
#undef PG8_SB
#undef PG8_STAGE
#undef PG8_LDA
#undef PG8_LDB
#undef PG8_MMA
#undef PG8_WAIT_V
#undef PG8_WAIT_L
#undef PG8_BAR
#undef PG8_SCHED
}
}
using pg8::Unit;

struct Args { const float* in[50]; float* out; unsigned char* ws; int ph_lo, ph_hi; };
typedef const __attribute__((address_space(4))) Args KArgs;
__device__ __forceinline__ KArgs* kargs() { KArgs* p = (KArgs*)__builtin_amdgcn_kernarg_segment_ptr(); asm volatile("" : "+s"(p)); return p; }
__device__ __forceinline__ unsigned char* launder_p(unsigned char* p) { asm volatile("" : "+s"(p)); return (unsigned char*)(GAS unsigned char*)p; }
__device__ __forceinline__ const float* kin(KArgs& A, int i) { return (const float*)(const GAS float*)A.in[i]; }
__device__ __forceinline__ float* kout(KArgs& A) { return (float*)(GAS float*)A.out; }
__device__ __forceinline__ unsigned char* kws(KArgs& A) { return (unsigned char*)(GAS unsigned char*)A.ws; }
__device__ __forceinline__ int launder_i(int v) { asm volatile("" : "+s"(v)); return v; }
__device__ __forceinline__ int launder_v(int v) { asm volatile("" : "+v"(v)); return v; }
enum { I_X = 0, I_MEM, I_LN_IN_G, I_LN_IN_B, I_W_IN, I_CONV_W, I_SG_NG, I_SG_NB, I_SG_W, I_SG_B, I_RW_MU, I_RW_W0, I_RW_WUP, I_RW_A0, I_RW_AUP, I_RW_GUP,
       I_RW_KK, I_RW_KA, I_RW_RK, I_RW_LNG, I_RW_LNB, I_S5_ARE, I_S5_AIM, I_S5_BRE, I_S5_BIM, I_S5_CRE, I_S5_CIM, I_S5_D, I_S5_LOGDT, I_S5_GLUW, I_S5_GLUB,
       I_BR_PROJ, I_GATE_B, I_W_OUT, I_LN1_G, I_LN1_B, I_XA_WQ, I_XA_WK, I_XA_WV, I_XA_WO, I_LN2_G, I_LN2_B, I_ROUTER_W, I_ROUTER_B, I_EX_W1, I_EX_B1, I_EX_W2, I_EX_B2,
       I_LN3_G, I_LN3_B };
struct Frame { LAS unsigned char* lds; volatile LAS unsigned* MISC; unsigned* ctl; unsigned char* ws; int tid, lane, wave, G, bid; };
constexpr int MI_TOFF = 16, MI_HIST = 64, MI_LBASE = 96, MI_LCUR = 128;

__device__ __forceinline__ void ln_stats(const f32x4 (&v)[4], float& mean, float& rstd) {
    float s = 0.f;
#pragma unroll
    for (int j = 0; j < 4; ++j) s += (v[j].x + v[j].y) + (v[j].z + v[j].w);
    mean = wave_sum(s) * (1.f / D); float s2 = 0.f;
#pragma unroll
    for (int j = 0; j < 4; ++j) { const f32x4 d = v[j] - mean; s2 += (d.x * d.x + d.y * d.y) + (d.z * d.z + d.w * d.w); }
    rstd = 1.0f / sqrtf(wave_sum(s2) * (1.f / D) + LN_EPS);
}
__device__ __forceinline__ void ln_apply_store(const f32x4 (&v)[4], float mean, float rstd, const float* g, const float* b, float* o32, bf16* o16, int lane) {
#pragma unroll
    for (int j = 0; j < 4; ++j) {
        const f32x4 gg = *(const f32x4*)(g + 256 * j + 4 * lane), bb = *(const f32x4*)(b + 256 * j + 4 * lane);
        const f32x4 y = (v[j] - mean) * rstd * gg + bb;
        if (o32) *(f32x4*)(o32 + 256 * j + 4 * lane) = y;
        if (o16) { v2u w; w.x = pk2(y.x, y.y); w.y = pk2(y.z, y.w); *(v2u*)(o16 + 256 * j + 4 * lane) = w; }
    }
}

__device__ __forceinline__ void transpose_item(const float* W, int K, int N, bf16* WT, int mode, LAS float* scr, int item, int lane) {
    const int nblk = N / 32, kb = item / nblk, nb = item % nblk, k0 = 64 * kb, n0 = 32 * nb;
#pragma unroll 8
    for (int i = 0; i < 32; ++i) { const int kk = 2 * i + (lane >> 5); scr[kk * 33 + (lane & 31)] = W[(size_t)(k0 + kk) * N + n0 + (lane & 31)]; }
    LDS_WAIT();
    const int c = lane & 7;
#pragma unroll
    for (int j = 0; j < 4; ++j) { const int n = (lane >> 3) + 8 * j; const LAS float* s = scr + (8 * c) * 33 + n;
        v4u o; o.x = pk2(s[0 * 33], s[1 * 33]); o.y = pk2(s[2 * 33], s[3 * 33]); o.z = pk2(s[4 * 33], s[5 * 33]); o.w = pk2(s[6 * 33], s[7 * 33]);
        const int nn = n0 + n; const int jj = nn >> 1;
        const int row = mode ? ((jj >> 7) * 256 + (nn & 1) * 128 + (jj & 127)) : nn;
        *(v4u*)(WT + (size_t)row * K + k0 + 8 * c) = o; }
    LDS_WAIT();
}
__device__ __forceinline__ void s5_setup_item(KArgs& A, const Frame& F, int item) {
    const int l = item >> 4, g = item & 15, tid = F.tid;
    LAS float* Kt = (LAS float*)F.lds;
    LAS float* Pw = (LAS float*)(F.lds + 65536);
    LAS float* Bb = (LAS float*)(F.lds + 65536 + 33280);
    LAS float* Cc = Bb + 2048;
    const float* a_re = kin(A, I_S5_ARE) + (l * 16 + g) * 64; const float* a_im = kin(A, I_S5_AIM) + (l * 16 + g) * 64;
    const float* b_re = kin(A, I_S5_BRE) + (size_t)(l * 16 + g) * 1024; const float* b_im = kin(A, I_S5_BIM) + (size_t)(l * 16 + g) * 1024;
    const float* c_re = kin(A, I_S5_CRE) + (size_t)(l * 16 + g) * 1024; const float* c_im = kin(A, I_S5_CIM) + (size_t)(l * 16 + g) * 1024;
    const float dt = expf(kin(A, I_S5_LOGDT)[l * 16 + g]);
    for (int o = tid; o < 65 * 64; o += NTHREADS) { const int n = o >> 6, p = o & 63; const float mag = expf(a_re[p] * dt * (float)n); float sn, cs; sincosf(a_im[p] * dt * (float)n, &sn, &cs);
        Pw[o * 2] = mag * cs; Pw[o * 2 + 1] = mag * sn; }
    for (int o = tid; o < 1024; o += NTHREADS) { const int p = o >> 4;
        const float are = a_re[p], aim = a_im[p], mag = expf(are * dt); float sn, cs; sincosf(aim * dt, &sn, &cs); const float abr = mag * cs, abi = mag * sn;
        const float den = are * are + aim * aim, nr = abr - 1.0f, cr = (nr * are + abi * aim) / den, ci = (abi * are - nr * aim) / den;
        const float br = b_re[o], bi = b_im[o]; Bb[o * 2] = cr * br - ci * bi; Bb[o * 2 + 1] = cr * bi + ci * br; }
    for (int o = tid; o < 1024; o += NTHREADS) { Cc[o * 2] = c_re[o]; Cc[o * 2 + 1] = c_im[o]; }
    __syncthreads();
    for (int o = tid; o < 16384; o += NTHREADS) { const int tau = o >> 8, c = (o >> 4) & 15, cp = o & 15; float acc = 0.f;
        for (int p = 0; p < 64; ++p) { const float cr = Cc[(c * 64 + p) * 2], ci = Cc[(c * 64 + p) * 2 + 1], pr = Pw[(tau * 64 + p) * 2], pi = Pw[(tau * 64 + p) * 2 + 1];
            const float er = cr * pr - ci * pi, ei = cr * pi + ci * pr; acc += er * Bb[(p * 16 + cp) * 2] - ei * Bb[(p * 16 + cp) * 2 + 1]; }
        Kt[o] = acc; }
    __syncthreads();
    bf16* Bt = (bf16*)(F.ws + WS_S5BT) + (size_t)(l * 16 + g) * 1024 * S5K;
    for (int o = tid; o < 1024 * 128; o += NTHREADS) { const int rr = o >> 7, q = o & 127, t = rr >> 4, c = rr & 15, s = q >> 1, cp0 = (q & 1) * 8;
        v4u w = {0u, 0u, 0u, 0u};
        if (s <= t) { const LAS float* k = Kt + ((t - s) * 16 + c) * 16 + cp0; w.x = pk2(k[0], k[1]); w.y = pk2(k[2], k[3]); w.z = pk2(k[4], k[5]); w.w = pk2(k[6], k[7]); }
        *(v4u*)(Bt + (size_t)rr * S5K + q * 8) = w; }
    for (int o = tid; o < 1024 * 16; o += NTHREADS) { const int rr = o >> 4, q = o & 15, t = rr >> 4, c = rr & 15; float vals[8];
#pragma unroll
        for (int j = 0; j < 4; ++j) { const int p = 4 * q + j; const float cr = Cc[(c * 64 + p) * 2], ci = Cc[(c * 64 + p) * 2 + 1], pr = Pw[((t + 1) * 64 + p) * 2], pi = Pw[((t + 1) * 64 + p) * 2 + 1];
            vals[2 * j] = cr * pr - ci * pi; vals[2 * j + 1] = -(cr * pi + ci * pr); }
        v4u w; w.x = pk2(vals[0], vals[1]); w.y = pk2(vals[2], vals[3]); w.z = pk2(vals[4], vals[5]); w.w = pk2(vals[6], vals[7]);
        *(v4u*)(Bt + (size_t)rr * S5K + 1024 + q * 8) = w; }
    bf16* Bc = (bf16*)(F.ws + WS_S5BC) + (size_t)(l * 16 + g) * 256 * 1024;
    for (int o = tid; o < 128 * 128; o += NTHREADS) { const int row = o >> 7, q = o & 127, p = row >> 1, im = row & 1, s = q >> 1, cp0 = (q & 1) * 8;
        const float pr = Pw[((63 - s) * 64 + p) * 2], pi = Pw[((63 - s) * 64 + p) * 2 + 1]; float vals[8];
#pragma unroll
        for (int j = 0; j < 8; ++j) { const float br = Bb[(p * 16 + cp0 + j) * 2], bi = Bb[(p * 16 + cp0 + j) * 2 + 1]; vals[j] = im ? (pr * bi + pi * br) : (pr * br - pi * bi); }
        v4u w; w.x = pk2(vals[0], vals[1]); w.y = pk2(vals[2], vals[3]); w.z = pk2(vals[4], vals[5]); w.w = pk2(vals[6], vals[7]);
        *(v4u*)(Bc + (size_t)row * 1024 + q * 8) = w;
        *(v4u*)(Bc + (size_t)(128 + row) * 1024 + q * 8) = (v4u){0u, 0u, 0u, 0u}; }
    __syncthreads();
}
__device__ __forceinline__ void p_prologue(KArgs& A, const Frame& F) {
    const int gw = F.bid * NWAVES + F.wave, NGW = F.G * NWAVES, lane = F.lane;
    for (int item = F.bid; item < NL * 16; item += F.G) s5_setup_item(A, F, item);
    LAS float* scr = (LAS float*)(F.lds + F.wave * 16384);
#pragma unroll 1
    for (int d = 0; d < 10; ++d) {
        const float* src; bf16* dst; int K, N, batch, mode = 0;
        switch (d) {
            case 0: src = kin(A, I_EX_W1); dst = (bf16*)(F.ws + WS_W1T); K = 1024; N = 2048; batch = NL * NE; mode = 1; break;
            case 1: src = kin(A, I_EX_W2); dst = (bf16*)(F.ws + WS_W2T); K = 1024; N = 1024; batch = NL * NE; break;
            case 2: src = kin(A, I_W_IN); dst = (bf16*)(F.ws + WS_WINT); K = 1024; N = N_IN; batch = NL; break;
            case 3: src = kin(A, I_BR_PROJ); dst = (bf16*)(F.ws + WS_BRT); K = 256; N = 1024; batch = NL * 4; break;
            case 4: src = kin(A, I_W_OUT); dst = (bf16*)(F.ws + WS_WOUTT); K = 1024; N = 1024; batch = NL; break;
            case 5: src = kin(A, I_XA_WQ); dst = (bf16*)(F.ws + WS_WQT); K = 1024; N = 1024; batch = NL; break;
            case 6: src = kin(A, I_XA_WK); dst = (bf16*)(F.ws + WS_WKT); K = 1024; N = 1024; batch = NL; break;
            case 7: src = kin(A, I_XA_WV); dst = (bf16*)(F.ws + WS_WVT); K = 1024; N = 1024; batch = NL; break;
            case 8: src = kin(A, I_XA_WO); dst = (bf16*)(F.ws + WS_WOT); K = 1024; N = 1024; batch = NL; break;
            default: src = kin(A, I_S5_GLUW); dst = (bf16*)(F.ws + WS_GLUT); K = 256; N = 256; batch = NL; break;
        }
        const int per = (K / 64) * (N / 32), nitems = per * batch;
        for (int it = gw; it < nitems; it += NGW) { const int b = it / per, r = it - b * per;
            transpose_item(src + (size_t)b * K * N, K, N, dst + (size_t)b * K * N, mode, scr, r, lane); }
    }
    { const float* mem = kin(A, I_MEM); bf16* m16 = (bf16*)(F.ws + WS_MEM16);
      for (int r = gw; r < NB * NMEM; r += NGW) {
#pragma unroll
          for (int j = 0; j < 4; ++j) { const f32x4 v = *(const f32x4*)(mem + (size_t)r * D + 256 * j + 4 * lane); v2u w; w.x = pk2(v.x, v.y); w.y = pk2(v.z, v.w); *(v2u*)(m16 + (size_t)r * D + 256 * j + 4 * lane) = w; } } }
    { const float* x = kin(A, I_X); float* h32 = (float*)(F.ws + WS_H32); bf16* h16 = (bf16*)(F.ws + WS_H16);
      for (int r = gw; r < T; r += NGW) { f32x4 v[4];
#pragma unroll
          for (int j = 0; j < 4; ++j) v[j] = *(const f32x4*)(x + (size_t)r * D + 256 * j + 4 * lane);
          float mean, rstd; ln_stats(v, mean, rstd);
          ln_apply_store(v, mean, rstd, kin(A, I_LN_IN_G), kin(A, I_LN_IN_B), h32 + (size_t)r * D, h16 + (size_t)r * D, lane); } }
}

typedef f32x4 AccT[2][2][4][2];
#define EPI_BASES KArgs& KA = *kargs(); unsigned char* ws = kws(KA); (void)ws;
struct EpiIn { int l;
    __device__ __forceinline__ void operator()(const AccT& acc, const Unit& u, int wr, int wc, int fr, int fq) const { EPI_BASES
        float* Z = (float*)(ws + WS_Z); bf16* SG = (bf16*)(ws + WS_SG); bf16* AOUT = (bf16*)(ws + WS_AOUT); const float* gate_b = kin(KA, I_GATE_B) + (size_t)l * 4096;
        if (u.pn < 10) {
            pg8::epi_foreach(acc, u, wr, wc, fr, fq, [&](int row, int col, f32x4 v) {
                *(f32x4*)(Z + (size_t)row * ZLD + col) = v;
                if (u.pn == 9) { const int cc = col - OFF_D, g = cc >> 4, c0 = cc & 15, chunk = row >> 6, s = row & 63;
                    v2u w; w.x = pk2(v.x, v.y); w.y = pk2(v.z, v.w); *(v2u*)(AOUT + ((size_t)(g * NCHT + chunk)) * S5K + s * 16 + c0) = w; } });
        } else {
            pg8::epi_foreach(acc, u, wr, wc, fr, fq, [&](int row, int col, f32x4 v) {
                const int gc = col - OFF_G; const f32x4 gb = *(const f32x4*)(gate_b + gc);
                v2u w; w.x = pk2(sigmoidf_(v.x + gb.x), sigmoidf_(v.y + gb.y)); w.y = pk2(sigmoidf_(v.z + gb.z), sigmoidf_(v.w + gb.w));
                *(v2u*)(SG + (size_t)row * 4096 + gc) = w; });
        }
    } };
struct EpiBranch { int br;
    __device__ __forceinline__ void operator()(const AccT& acc, const Unit& u, int wr, int wc, int fr, int fq) const { EPI_BASES
        bf16* MG = (bf16*)(ws + WS_MG16); const bf16* SG = (const bf16*)(ws + WS_SG);
        pg8::epi_foreach(acc, u, wr, wc, fr, fq, [&](int row, int col, f32x4 v) {
            const v2u s = *(const v2u*)(SG + (size_t)row * 4096 + br * 1024 + col);
            f32x4 r; r.x = v.x * bf2f(s.x & 0xffffu); r.y = v.y * bf2f(s.x >> 16); r.z = v.z * bf2f(s.y & 0xffffu); r.w = v.w * bf2f(s.y >> 16);
            bf16* p = MG + (size_t)row * D + col;
            if (br > 0) { const v2u m = *(const v2u*)p; r.x += bf2f(m.x & 0xffffu); r.y += bf2f(m.x >> 16); r.z += bf2f(m.y & 0xffffu); r.w += bf2f(m.y >> 16); }
            v2u w; w.x = pk2(r.x, r.y); w.y = pk2(r.z, r.w); *(v2u*)p = w; });
    } };
struct EpiResid { int dummy;
    __device__ __forceinline__ void operator()(const AccT& acc, const Unit& u, int wr, int wc, int fr, int fq) const { EPI_BASES
        float* H = (float*)(ws + WS_H32);
        pg8::epi_foreach(acc, u, wr, wc, fr, fq, [&](int row, int col, f32x4 v) { float* p = H + (size_t)row * D + col; const f32x4 h = *(const f32x4*)p; *(f32x4*)p = h * DN_ALPHA + v; });
    } };
struct EpiBf16 { unsigned off_mib; float scale;
    __device__ __forceinline__ void operator()(const AccT& acc, const Unit& u, int wr, int wc, int fr, int fq) const { EPI_BASES
        bf16* O = (bf16*)(ws + (size_t)off_mib * MiB);
        pg8::epi_foreach(acc, u, wr, wc, fr, fq, [&](int row, int col, f32x4 v) { v2u w; w.x = pk2(v.x * scale, v.y * scale); w.y = pk2(v.z * scale, v.w * scale); *(v2u*)(O + (size_t)row * D + col) = w; });
    } };
struct EpiVT { int dummy;
    __device__ __forceinline__ void operator()(const AccT& acc, const Unit& u, int wr, int wc, int fr, int fq) const { EPI_BASES
        bf16* VT = (bf16*)(ws + WS_VMT16);
        pg8::epi_foreach(acc, u, wr, wc, fr, fq, [&](int row, int col, f32x4 v) { const int b = row >> 8, m = row & 255; bf16* p = VT + ((size_t)(b * D + col)) * NMEM + m;
            p[0] = (bf16)f2bf(v.x); p[NMEM] = (bf16)f2bf(v.y); p[2 * NMEM] = (bf16)f2bf(v.z); p[3 * NMEM] = (bf16)f2bf(v.w); });
    } };
struct EpiXloc { int dummy;
    __device__ __forceinline__ void operator()(const AccT& acc, const Unit& u, int wr, int wc, int fr, int fq) const { EPI_BASES
        float* X = (float*)(ws + WS_XLOC);
        pg8::epi_foreach(acc, u, wr, wc, fr, fq, [&](int row, int col, f32x4 v) { if (col < 128) *(f32x4*)(X + ((size_t)(u.e * NCHT + row)) * 128 + col) = v; });
    } };
__device__ __forceinline__ float gelu_tanh(float x) { const float u = 0.7978845608028654f * (x + 0.044715f * x * x * x); const float e = __expf(2.0f * u); const float th = 1.0f - 2.0f / (e + 1.0f); return 0.5f * x * (1.0f + th); }
struct EpiS5Y { int l;
    __device__ __forceinline__ void operator()(const AccT& acc, const Unit& u, int wr, int wc, int fr, int fq) const { EPI_BASES
        bf16* YD = (bf16*)(ws + WS_YD16); const float* Z = (const float*)(ws + WS_Z); const float* dvec = kin(KA, I_S5_D) + l * 256;
        pg8::epi_foreach(acc, u, wr, wc, fr, fq, [&](int row, int col, f32x4 v) { const int tok = row * CH + (col >> 4), ch = u.e * 16 + (col & 15);
            const f32x4 uu = *(const f32x4*)(Z + (size_t)tok * ZLD + OFF_D + ch), dd = *(const f32x4*)(dvec + ch);
            v2u w; w.x = pk2(gelu_tanh(v.x + dd.x * uu.x), gelu_tanh(v.y + dd.y * uu.y)); w.y = pk2(gelu_tanh(v.z + dd.z * uu.z), gelu_tanh(v.w + dd.w * uu.w));
            *(v2u*)(YD + (size_t)tok * 256 + ch) = w; });
    } };
struct EpiGlu { int l;
    __device__ __forceinline__ void operator()(const AccT& acc, const Unit& u, int wr, int wc, int fr, int fq) const { EPI_BASES
        bf16* O = (bf16*)(ws + WS_O16); const bf16* YD = (const bf16*)(ws + WS_YD16); const float* gb = kin(KA, I_S5_GLUB) + l * 256;
        pg8::epi_foreach(acc, u, wr, wc, fr, fq, [&](int row, int col, f32x4 v) { const v2u y = *(const v2u*)(YD + (size_t)row * 256 + col); const f32x4 b = *(const f32x4*)(gb + col);
            v2u w; w.x = pk2(bf2f(y.x & 0xffffu) * sigmoidf_(v.x + b.x), bf2f(y.x >> 16) * sigmoidf_(v.y + b.y)); w.y = pk2(bf2f(y.y & 0xffffu) * sigmoidf_(v.z + b.z), bf2f(y.y >> 16) * sigmoidf_(v.w + b.w));
            *(v2u*)(O + (size_t)row * D + 768 + col) = w; });
    } };
__device__ __forceinline__ float swiglu(float g, float u) { g = fminf(g, 7.0f); u = fminf(fmaxf(u, -7.0f), 7.0f); return (u + 1.0f) * g * sigmoidf_(1.702f * g); }
struct EpiSwiglu { int l;
    __device__ __forceinline__ void operator()(const AccT& acc, const Unit& u, int wr, int wc, int fr, int fq) const { EPI_BASES
        bf16* ACT = (bf16*)(ws + WS_ACT); const float* bb = kin(KA, I_EX_B1) + (size_t)(l * NE + u.e) * 2048;
#pragma unroll
        for (int ai = 0; ai < 2; ++ai)
#pragma unroll
            for (int m = 0; m < 4; ++m) { const int row = u.pm * 256 + ai * 128 + wr * 64 + m * 16 + fr;
#pragma unroll
                for (int n = 0; n < 2; ++n) { const int j = u.pn * 128 + wc * 32 + n * 16 + 4 * fq;
                    const f32x4 b0 = *(const f32x4*)(bb + 2 * j), b1v = *(const f32x4*)(bb + 2 * j + 4);
                    const f32x4 g = acc[ai][0][m][n], uu = acc[ai][1][m][n];
                    v2u w; w.x = pk2(swiglu(g.x + b0.x, uu.x + b0.y), swiglu(g.y + b0.z, uu.y + b0.w)); w.y = pk2(swiglu(g.z + b1v.x, uu.z + b1v.y), swiglu(g.w + b1v.z, uu.w + b1v.w));
                    *(v2u*)(ACT + (size_t)row * DFF + j) = w; } }
    } };
struct EpiMoeOut { int l;
    __device__ __forceinline__ void operator()(const AccT& acc, const Unit& u, int wr, int wc, int fr, int fq) const { EPI_BASES
        bf16* YS = (bf16*)(ws + WS_YS); const float* SLOTW = (const float*)(ws + WS_SLOTW); const float* bb = kin(KA, I_EX_B2) + (size_t)(l * NE + u.e) * D;
        pg8::epi_foreach(acc, u, wr, wc, fr, fq, [&](int row, int col, f32x4 v) { const float sw = SLOTW[row]; const f32x4 b = *(const f32x4*)(bb + col);
            v2u w; w.x = pk2((v.x + b.x) * sw, (v.y + b.y) * sw); w.y = pk2((v.z + b.z) * sw, (v.w + b.w) * sw); *(v2u*)(YS + (size_t)row * D + col) = w; });
    } };

__device__ __forceinline__ void p_mix1(KArgs& A, const Frame& F, int l) {
    const int gw = F.bid * NWAVES + F.wave, NGW = F.G * NWAVES, lane = F.lane, tid = F.tid;
    const float* Z = (const float*)(F.ws + WS_Z); bf16* O16 = (bf16*)(F.ws + WS_O16);
    for (int rp_ = 0; rp_ < ((PROBE_PHASE == 101) ? PROBE_REPS : 1); ++rp_) { const float* cw = kin(A, I_CONV_W) + l * 3 * 256; const f32x4 w0 = *(const f32x4*)(cw + 4 * lane), w1 = *(const f32x4*)(cw + 256 + 4 * lane), w2 = *(const f32x4*)(cw + 512 + 4 * lane);
      for (int t = gw; t < T; t += NGW) { const int s = t & (SEQ - 1); const float* zr = Z + (size_t)t * ZLD + 4 * lane;
          const f32x4 bg = *(const f32x4*)zr; f32x4 y = w2 * (*(const f32x4*)(zr + 256) * *(const f32x4*)(zr + 512));
          if (s >= 1) y += w1 * (*(const f32x4*)(zr - ZLD + 256) * *(const f32x4*)(zr - ZLD + 512));
          if (s >= 2) y += w0 * (*(const f32x4*)(zr - 2 * ZLD + 256) * *(const f32x4*)(zr - 2 * ZLD + 512));
          y = y * bg; v2u w; w.x = pk2(y.x, y.y); w.y = pk2(y.z, y.w); *(v2u*)(O16 + (size_t)t * D + 4 * lane) = w; } }
    for (int rp_ = 0; rp_ < ((PROBE_PHASE == 102) ? PROBE_REPS : 1); ++rp_) { LAS float* VN = (LAS float*)F.lds;
      const float* ng = kin(A, I_SG_NG) + l * 256; const float* nb = kin(A, I_SG_NB) + l * 256;
      for (int blk = F.bid; blk < T / 128; blk += F.G) {
          const f32x4 gg = *(const f32x4*)(ng + 4 * lane), bb = *(const f32x4*)(nb + 4 * lane);
          for (int r = F.wave; r < 128; r += NWAVES) { const int t = blk * 128 + r; const f32x4 v = *(const f32x4*)(Z + (size_t)t * ZLD + OFF_B + 256 + 4 * lane);
              const float mean = wave_sum((v.x + v.y) + (v.z + v.w)) * (1.f / 256); const f32x4 d = v - mean;
              const float var = wave_sum((d.x * d.x + d.y * d.y) + (d.z * d.z + d.w * d.w)) * (1.f / 256); const float rstd = 1.0f / sqrtf(var + LN_EPS);
              *(LAS f32x4*)(VN + r * 256 + 4 * lane) = d * rstd * gg + bb; }
          __syncthreads();
          const int i = tid >> 2, cq = tid & 3, t = blk * 128 + i, jmax = (i < 64) ? 64 : 128;
#pragma unroll 1
          for (int g = 0; g < 4; ++g) { f32x4 a0 = {0, 0, 0, 0}, a1 = a0, a2 = a0, a3 = a0;
              const float* wrow = kin(A, I_SG_W) + ((size_t)((l * 4 + g) * 128 + i)) * 128; const LAS float* vb = VN + g * 64 + cq * 16;
              for (int j = 0; j < jmax; j += 4) { const f32x4 w4 = *(const f32x4*)(wrow + j);
#pragma unroll
                  for (int jj = 0; jj < 4; ++jj) { const LAS f32x4* vp = (const LAS f32x4*)(vb + (j + jj) * 256); const float w = w4[jj];
                      a0 += vp[0] * w; a1 += vp[1] * w; a2 += vp[2] * w; a3 += vp[3] * w; } }
              const float bias = kin(A, I_SG_B)[(l * 4 + g) * 128 + i]; const float* up = Z + (size_t)t * ZLD + OFF_B + g * 64 + cq * 16;
              const f32x4 o0 = *(const f32x4*)(up) * (a0 + bias), o1 = *(const f32x4*)(up + 4) * (a1 + bias), o2 = *(const f32x4*)(up + 8) * (a2 + bias), o3 = *(const f32x4*)(up + 12) * (a3 + bias);
              v4u wa, wb; wa.x = pk2(o0.x, o0.y); wa.y = pk2(o0.z, o0.w); wa.z = pk2(o1.x, o1.y); wa.w = pk2(o1.z, o1.w); wb.x = pk2(o2.x, o2.y); wb.y = pk2(o2.z, o2.w); wb.z = pk2(o3.x, o3.y); wb.w = pk2(o3.z, o3.w);
              bf16* op = O16 + (size_t)t * D + 256 + g * 64 + cq * 16; *(v4u*)op = wa; *(v4u*)(op + 8) = wb; }
          __syncthreads();
      } }
    for (int rp_ = 0; rp_ < ((PROBE_PHASE == 103) ? PROBE_REPS : 1); ++rp_) { LAS float* xin = (LAS float*)(F.lds + F.wave * 8192);
      float* RWOP = (float*)(F.ws + WS_RWOP); float* RWG = (float*)(F.ws + WS_RWG); float* RK = (float*)(F.ws + WS_RK);
      const float* mu = kin(A, I_RW_MU) + l * 1024; const float* wup = kin(A, I_RW_WUP) + (size_t)l * 64 * 256; const float* aup = kin(A, I_RW_AUP) + (size_t)l * 64 * 256; const float* gup = kin(A, I_RW_GUP) + (size_t)l * 128 * 256;
      const int c4 = 4 * lane, head = lane >> 4;
      const f32x4 w0v = *(const f32x4*)(kin(A, I_RW_W0) + l * 256 + c4), a0v = *(const f32x4*)(kin(A, I_RW_A0) + l * 256 + c4), kkv = *(const f32x4*)(kin(A, I_RW_KK) + l * 256 + c4),
                  kav = *(const f32x4*)(kin(A, I_RW_KA) + l * 256 + c4), rkv = *(const f32x4*)(kin(A, I_RW_RK) + l * 256 + c4);
      const f32x4 mul = *(const f32x4*)(mu + 768 + c4), mur = *(const f32x4*)(mu + c4), muk = *(const f32x4*)(mu + 256 + c4), muv = *(const f32x4*)(mu + 512 + c4);
      for (int grp = gw; grp < T / 8; grp += NGW) { const int t0 = grp * 8;
#pragma unroll
          for (int tk = 0; tk < 8; ++tk) { const int t = t0 + tk, s = t & (SEQ - 1); const float* zr = Z + (size_t)t * ZLD + OFF_C + 768 + c4;
              f32x4 x = *(const f32x4*)zr; f32x4 pv = {0, 0, 0, 0}; if (s > 0) pv = *(const f32x4*)(zr - ZLD); x = x + (pv - x) * mul;
              if (lane < 16) { x.x = tanhf(x.x); x.y = tanhf(x.y); x.z = tanhf(x.z); x.w = tanhf(x.w); }
              else if (lane >= 32) { x.x = sigmoidf_(x.x); x.y = sigmoidf_(x.y); x.z = sigmoidf_(x.z); x.w = sigmoidf_(x.w); }
              *(LAS f32x4*)(xin + tk * 256 + c4) = x; }
          LDS_WAIT();
          f32x4 dec[8], av[8];
          { f32x4 acc[8];
#pragma unroll
            for (int tk = 0; tk < 8; ++tk) acc[tk] = (f32x4){0, 0, 0, 0};
#pragma unroll 2
            for (int i = 0; i < 64; i += 4) { const f32x4 wa = *(const f32x4*)(wup + (size_t)(i + 0) * 256 + c4), wb = *(const f32x4*)(wup + (size_t)(i + 1) * 256 + c4), wc = *(const f32x4*)(wup + (size_t)(i + 2) * 256 + c4), wd = *(const f32x4*)(wup + (size_t)(i + 3) * 256 + c4);
#pragma unroll
                for (int tk = 0; tk < 8; ++tk) { const f32x4 xi = *(const LAS f32x4*)(xin + tk * 256 + i); acc[tk] += wa * xi.x + wb * xi.y + wc * xi.z + wd * xi.w; } }
#pragma unroll
            for (int tk = 0; tk < 8; ++tk) { const f32x4 wp = w0v + acc[tk];
#pragma unroll
                for (int e = 0; e < 4; ++e) { const float sp = log1pf(__expf(-wp[e])); const float w = -sp - 0.5f; dec[tk][e] = __expf(-__expf(w)); } } }
          { f32x4 acc[8];
#pragma unroll
            for (int tk = 0; tk < 8; ++tk) acc[tk] = (f32x4){0, 0, 0, 0};
#pragma unroll 2
            for (int i = 0; i < 64; i += 4) { const f32x4 wa = *(const f32x4*)(aup + (size_t)(i + 0) * 256 + c4), wb = *(const f32x4*)(aup + (size_t)(i + 1) * 256 + c4), wc = *(const f32x4*)(aup + (size_t)(i + 2) * 256 + c4), wd = *(const f32x4*)(aup + (size_t)(i + 3) * 256 + c4);
#pragma unroll
                for (int tk = 0; tk < 8; ++tk) { const f32x4 xi = *(const LAS f32x4*)(xin + tk * 256 + 64 + i); acc[tk] += wa * xi.x + wb * xi.y + wc * xi.z + wd * xi.w; } }
#pragma unroll
            for (int tk = 0; tk < 8; ++tk) { const f32x4 ap = a0v + acc[tk]; av[tk] = (f32x4){sigmoidf_(ap.x), sigmoidf_(ap.y), sigmoidf_(ap.z), sigmoidf_(ap.w)}; } }
          { f32x4 acc[8];
#pragma unroll
            for (int tk = 0; tk < 8; ++tk) acc[tk] = (f32x4){0, 0, 0, 0};
#pragma unroll 2
            for (int i = 0; i < 128; i += 4) { const f32x4 wa = *(const f32x4*)(gup + (size_t)(i + 0) * 256 + c4), wb = *(const f32x4*)(gup + (size_t)(i + 1) * 256 + c4), wc = *(const f32x4*)(gup + (size_t)(i + 2) * 256 + c4), wd = *(const f32x4*)(gup + (size_t)(i + 3) * 256 + c4);
#pragma unroll
                for (int tk = 0; tk < 8; ++tk) { const f32x4 xi = *(const LAS f32x4*)(xin + tk * 256 + 128 + i); acc[tk] += wa * xi.x + wb * xi.y + wc * xi.z + wd * xi.w; } }
#pragma unroll
            for (int tk = 0; tk < 8; ++tk) *(f32x4*)(RWG + (size_t)(t0 + tk) * 256 + c4) = acc[tk]; }
#pragma unroll
          for (int tk = 0; tk < 8; ++tk) { const int t = t0 + tk, s = t & (SEQ - 1), b = t >> 13; const float* zr = Z + (size_t)t * ZLD + OFF_C + c4;
              f32x4 r = *(const f32x4*)zr, k = *(const f32x4*)(zr + 256), v = *(const f32x4*)(zr + 512);
              f32x4 pr = {0, 0, 0, 0}, pk = pr, pvv = pr; if (s > 0) { pr = *(const f32x4*)(zr - ZLD); pk = *(const f32x4*)(zr - ZLD + 256); pvv = *(const f32x4*)(zr - ZLD + 512); }
              r = r + (pr - r) * mur; k = k + (pk - k) * muk; v = v + (pvv - v) * muv;
              const f32x4 a = av[tk]; f32x4 kk = k * kkv; const f32x4 k2 = k * (1.0f + (a - 1.0f) * kav);
              float ss = (kk.x * kk.x + kk.y * kk.y) + (kk.z * kk.z + kk.w * kk.w); float rk = (r.x * k2.x * rkv.x + r.y * k2.y * rkv.y) + (r.z * k2.z * rkv.z + r.w * k2.w * rkv.w);
#pragma unroll
              for (int o = 1; o < 16; o <<= 1) { ss += shfl_xor_l(ss, o, lane); rk += shfl_xor_l(rk, o, lane); }
              const float inv = 1.0f / fmaxf(sqrtf(ss), 1e-12f); kk = kk * inv;
              float* op = RWOP + ((size_t)((b * 4 + head) * SEQ + s)) * 384 + (lane & 15) * 4;
              *(f32x4*)(op) = -kk; *(f32x4*)(op + 64) = dec[tk]; *(f32x4*)(op + 128) = kk * a; *(f32x4*)(op + 192) = r; *(f32x4*)(op + 256) = k2; *(f32x4*)(op + 320) = v;
              if ((lane & 15) == 0) RK[(size_t)t * 4 + head] = rk; }
          LDS_WAIT();
      } }
}

__device__ __forceinline__ void p_rw_chunks(const Frame& F) {
    const int gw = F.bid * NWAVES + F.wave, NGW = F.G * NWAVES, lane = F.lane;
    const float* RWOP = (const float*)(F.ws + WS_RWOP); float* QH = (float*)(F.ws + WS_QH); float* YL = (float*)(F.ws + WS_YL); float* GC = (float*)(F.ws + WS_GC); float* HC = (float*)(F.ws + WS_HC);
    LAS float* wl = (LAS float*)(F.lds + F.wave * 16384);
    for (int task = gw; task < 16 * NCH; task += NGW) { const int bh = task / NCH, ck = task % NCH;
        float sp[64], sl[64];
        { const int ln = launder_v(lane);
#pragma unroll
          for (int k = 0; k < 64; ++k) { sp[k] = (k == ln) ? 1.0f : 0.0f; sl[k] = 0.0f; } }
        const float* src = RWOP + ((size_t)(bh * SEQ + ck * CH)) * 384;
#pragma unroll 1
        for (int sb = 0; sb < CH / 8; ++sb) {
            const f32x4* gsrc = (const f32x4*)(src + (size_t)sb * 8 * 384) + lane; LAS f32x4* ldst = (LAS f32x4*)wl + lane;
#pragma unroll
            for (int i = 0; i < 12; ++i) ldst[i * 64] = gsrc[i * 64];
            LDS_WAIT();
#pragma unroll 1
            for (int st = 0; st < 8; ++st) { const LAS f32x4* base = (const LAS f32x4*)(wl + st * 384);
                float saP = 0.f, saL = 0.f;
#pragma unroll
                for (int q = 0; q < 16; ++q) { const f32x4 nk = base[q];
                    saP += sp[4 * q] * nk.x; saP += sp[4 * q + 1] * nk.y; saP += sp[4 * q + 2] * nk.z; saP += sp[4 * q + 3] * nk.w;
                    saL += sl[4 * q] * nk.x; saL += sl[4 * q + 1] * nk.y; saL += sl[4 * q + 2] * nk.z; saL += sl[4 * q + 3] * nk.w;
                    if ((q & 3) == 3) __builtin_amdgcn_sched_barrier(0); }
                const float vj = wl[st * 384 + 320 + lane];
                float yP = 0.f, yL = 0.f;
                f32x4 w = base[16], b = base[32], r = base[48], kv = base[64];
#pragma unroll
                for (int q = 0; q < 16; ++q) { f32x4 wn = w, bn = b, rn = r, kn = kv;
                    if (q < 15) { wn = base[16 + q + 1]; bn = base[32 + q + 1]; rn = base[48 + q + 1]; kn = base[64 + q + 1]; }
#pragma unroll
                    for (int e = 0; e < 4; ++e) { const int k = 4 * q + e;
                        sp[k] = sp[k] * w[e] + saP * b[e]; sl[k] = sl[k] * w[e] + saL * b[e] + vj * kv[e];
                        yP += sp[k] * r[e]; yL += sl[k] * r[e]; }
                    __builtin_amdgcn_sched_barrier(0);
                    w = wn; b = bn; r = rn; kv = kn; }
                const size_t oi = ((size_t)(bh * SEQ + ck * CH + sb * 8 + st)) * 64 + lane;
                QH[oi] = yP; YL[oi] = yL; }
        }
        float* gp = GC + ((size_t)(bh * NCH + ck) * 64 + lane) * 64; float* hp = HC + ((size_t)(bh * NCH + ck) * 64 + lane) * 64;
#pragma unroll
        for (int q = 0; q < 16; ++q) { *(f32x4*)(gp + 4 * q) = (f32x4){sp[4 * q], sp[4 * q + 1], sp[4 * q + 2], sp[4 * q + 3]}; *(f32x4*)(hp + 4 * q) = (f32x4){sl[4 * q], sl[4 * q + 1], sl[4 * q + 2], sl[4 * q + 3]}; }
    }
}
__device__ __forceinline__ void p_s5_chain(KArgs& A, const Frame& F, int l) {
    const int gt = F.bid * NTHREADS + F.tid; if (gt >= NB * 16 * 64) return;
    const int b = gt >> 10, g = (gt >> 6) & 15, p = gt & 63;
    const float dt = expf(kin(A, I_S5_LOGDT)[l * 16 + g]); const float are = kin(A, I_S5_ARE)[(l * 16 + g) * 64 + p], aim = kin(A, I_S5_AIM)[(l * 16 + g) * 64 + p];
    const float mag = expf(are * dt * 64.0f); float sn, cs; sincosf(aim * dt * 64.0f, &sn, &cs); const float ar = mag * cs, ai = mag * sn;
    bf16* AO = (bf16*)(F.ws + WS_AOUT); const float* XL = (const float*)(F.ws + WS_XLOC);
    float xr = 0.f, xi = 0.f;
#pragma unroll 8
    for (int c = 0; c < NCH; ++c) { const size_t row = (size_t)g * NCHT + b * NCH + c;
        *(unsigned*)(AO + row * S5K + 1024 + 2 * p) = pk2(xr, xi);
        const f32x2 xl = *(const f32x2*)(XL + row * 128 + 2 * p);
        const float nr = ar * xr - ai * xi + xl.x, ni = ar * xi + ai * xr + xl.y; xr = nr; xi = ni; }
}
constexpr int CB = 8, NBLK = NCH / CB;
__device__ __forceinline__ void chain_load_g(const float* G, float (&ga)[64], int fr, int fq) {
#pragma unroll
    for (int jr = 0; jr < 16; ++jr)
#pragma unroll
        for (int mt = 0; mt < 4; ++mt) ga[jr * 4 + mt] = G[(size_t)((jr >> 2) * 16 + 4 * fq + (jr & 3)) * 64 + 16 * mt + fr];
}
__device__ __forceinline__ void chain_step(f32x4 (&acc)[4], const float (&ga)[64], const f32x4 (&ci)[4]) {
    f32x4 na[4] = {ci[0], ci[1], ci[2], ci[3]};
#pragma unroll
    for (int jr = 0; jr < 16; ++jr)
#pragma unroll
        for (int mt = 0; mt < 4; ++mt) na[mt] = __builtin_amdgcn_mfma_f32_16x16x4f32(ga[jr * 4 + mt], acc[jr >> 2][jr & 3], na[mt], 0, 0, 0);
#pragma unroll
    for (int mt = 0; mt < 4; ++mt) acc[mt] = na[mt];
}
__device__ __forceinline__ void chain_load_tile(const float* M, int rb, f32x4 (&t)[4], int fr, int fq) {
#pragma unroll
    for (int jt = 0; jt < 4; ++jt) t[jt] = *(const f32x4*)(M + (size_t)(16 * rb + fr) * 64 + 16 * jt + 4 * fq);
}
__device__ __forceinline__ void chain_store_tile(float* M, int rb, const f32x4 (&t)[4], int fr, int fq) {
#pragma unroll
    for (int jt = 0; jt < 4; ++jt) *(f32x4*)(M + (size_t)(16 * rb + fr) * 64 + 16 * jt + 4 * fq) = t[jt];
}
__device__ __forceinline__ void p_chain_compose(const Frame& F) {
    const int gw = F.bid * NWAVES + F.wave, NGW = F.G * NWAVES, fr = F.lane & 15, fq = F.lane >> 4;
    const float* GC = (const float*)(F.ws + WS_GC); const float* HC = (const float*)(F.ws + WS_HC); float* GB = (float*)(F.ws + WS_GB); float* HB = (float*)(F.ws + WS_HB);
    for (int task = gw; task < 16 * NBLK * 8; task += NGW) { const int cb = task & 7, bb = task >> 3, rb = cb & 3; const bool isH = cb >= 4;
        const size_t c0 = (size_t)bb * CB;
        f32x4 acc[4]; chain_load_tile((isH ? HC : GC) + c0 * 4096, rb, acc, fr, fq);
        float ga[64]; chain_load_g(GC + (c0 + 1) * 4096, ga, fr, fq);
#pragma unroll 1
        for (int i = 1; i < CB; ++i) { f32x4 ci[4] = {{0, 0, 0, 0}, {0, 0, 0, 0}, {0, 0, 0, 0}, {0, 0, 0, 0}};
            if (isH) chain_load_tile(HC + (c0 + i) * 4096, rb, ci, fr, fq);
            float gn[64];
            if (i + 1 < CB) chain_load_g(GC + (c0 + i + 1) * 4096, gn, fr, fq);
            chain_step(acc, ga, ci);
            if (i + 1 < CB) {
#pragma unroll
                for (int k = 0; k < 64; ++k) ga[k] = gn[k]; } }
        chain_store_tile((isH ? HB : GB) + (size_t)bb * 4096, rb, acc, fr, fq);
    }
}
__device__ __forceinline__ void p_chain_blocks(const Frame& F, int gw, int NGW) {
    const int fr = F.lane & 15, fq = F.lane >> 4;
    const float* GB = (const float*)(F.ws + WS_GB); const float* HB = (const float*)(F.ws + WS_HB); float* SB = (float*)(F.ws + WS_SB);
    for (int task = gw; task < 16 * 4; task += NGW) { const int vb = task & 3, bh = task >> 2;
        f32x4 acc[4] = {{0, 0, 0, 0}, {0, 0, 0, 0}, {0, 0, 0, 0}, {0, 0, 0, 0}};
        float ga[64]; chain_load_g(GB + (size_t)bh * NBLK * 4096, ga, fr, fq);
#pragma unroll 1
        for (int blk = 0; blk < NBLK; ++blk) { const size_t bb = (size_t)bh * NBLK + blk;
            chain_store_tile(SB + bb * 4096, vb, acc, fr, fq);
            if (blk + 1 == NBLK) break;
            f32x4 ci[4]; chain_load_tile(HB + bb * 4096, vb, ci, fr, fq);
            float gn[64]; chain_load_g(GB + (bb + 1) * 4096, gn, fr, fq);
            chain_step(acc, ga, ci);
#pragma unroll
            for (int k = 0; k < 64; ++k) ga[k] = gn[k]; }
    }
}
__device__ __forceinline__ void chain_inblock(const Frame& F, int bb, int vb) {
    const int fr = F.lane & 15, fq = F.lane >> 4;
    const float* GC = (const float*)(F.ws + WS_GC); const float* HC = (const float*)(F.ws + WS_HC); const float* SB = (const float*)(F.ws + WS_SB); float* SC = (float*)(F.ws + WS_SC);
    const size_t c0 = (size_t)bb * CB;
    f32x4 acc[4]; chain_load_tile(SB + (size_t)bb * 4096, vb, acc, fr, fq);
    float ga[64]; chain_load_g(GC + c0 * 4096, ga, fr, fq);
#pragma unroll 1
    for (int i = 0; i < CB; ++i) {
        chain_store_tile(SC + (c0 + i) * 4096, vb, acc, fr, fq);
        if (i + 1 == CB) break;
        f32x4 ci[4]; chain_load_tile(HC + (c0 + i) * 4096, vb, ci, fr, fq);
        float gn[64]; chain_load_g(GC + (c0 + i + 1) * 4096, gn, fr, fq);
        chain_step(acc, ga, ci);
#pragma unroll
        for (int k = 0; k < 64; ++k) ga[k] = gn[k]; }
}
__device__ __forceinline__ void rw_out_task(KArgs& A, const Frame& F, int l, int task) {
    const int lane = F.lane;
    const float* RWOP = (const float*)(F.ws + WS_RWOP); const float* QH = (const float*)(F.ws + WS_QH); const float* YL = (const float*)(F.ws + WS_YL); const float* SC = (const float*)(F.ws + WS_SC);
    const float* RWG = (const float*)(F.ws + WS_RWG); const float* RK = (const float*)(F.ws + WS_RK); bf16* O16 = (bf16*)(F.ws + WS_O16);
    LAS float* Qw = (LAS float*)(F.lds + F.wave * 16384);
    { const int bh = task / NCH, ck = task % NCH, b = bh >> 2, head = bh & 3;
        const size_t ti0 = (size_t)(bh * SEQ + ck * CH); const int t0g = b * SEQ + ck * CH;
        { const f32x4* qsrc = (const f32x4*)(QH + ti0 * 64) + lane; LAS f32x4* qdst = (LAS f32x4*)Qw + lane;
#pragma unroll
          for (int i = 0; i < 16; ++i) qdst[i * 64] = qsrc[i * 64]; }
        float srow[64];
        { const f32x4* ssrc = (const f32x4*)(SC + (size_t)(bh * NCH + ck) * 4096 + lane * 64);
#pragma unroll
          for (int i = 0; i < 16; ++i) { const f32x4 x = ssrc[i]; srow[4 * i] = x.x; srow[4 * i + 1] = x.y; srow[4 * i + 2] = x.z; srow[4 * i + 3] = x.w; } }
        const float lgv = kin(A, I_RW_LNG)[l * 256 + head * 64 + lane], lbv = kin(A, I_RW_LNB)[l * 256 + head * 64 + lane];
        LDS_WAIT();
#pragma unroll 1
        for (int tb = 0; tb < CH; tb += 4) { float y[4], s1[4], s2[4];
#pragma unroll
            for (int u = 0; u < 4; ++u) { const int t = tb + u; float a = YL[(ti0 + t) * 64 + lane]; const LAS f32x4* qp = (const LAS f32x4*)(Qw + t * 64);
#pragma unroll
                for (int i = 0; i < 16; ++i) { const f32x4 qv = qp[i]; a += srow[4 * i] * qv.x; a += srow[4 * i + 1] * qv.y; a += srow[4 * i + 2] * qv.z; a += srow[4 * i + 3] * qv.w; }
                y[u] = a; s1[u] = a; s2[u] = a * a; }
#pragma unroll
            for (int o = 1; o < 64; o <<= 1) {
#pragma unroll
                for (int u = 0; u < 4; ++u) { s1[u] += shfl_xor_l(s1[u], o, lane); s2[u] += shfl_xor_l(s2[u], o, lane); } }
#pragma unroll
            for (int u = 0; u < 4; ++u) { const int t = tb + u; const float m = s1[u] * (1.f / 64), var = fmaxf(s2[u] * (1.f / 64) - m * m, 0.f); const float rstd = 1.0f / sqrtf(var + RW_LN_EPS);
                const float rk = RK[(size_t)(t0g + t) * 4 + head]; const float vv = RWOP[(ti0 + t) * 384 + 320 + lane]; const float gg = RWG[(size_t)(t0g + t) * 256 + head * 64 + lane];
                const float o = ((y[u] - m) * rstd * lgv + lbv + rk * vv) * gg;
                O16[(size_t)(t0g + t) * D + 512 + head * 64 + lane] = (bf16)f2bf(o); }
        }
        LDS_WAIT();
    }
}
template <int LSTRIDE> __device__ __forceinline__ void attn_stage(LAS unsigned char* lds, const bf16* src, size_t row_stride, int tid) {
    const int r0 = tid >> 5, c = tid & 31; const bf16* sp = src + (size_t)r0 * row_stride + c * 8; LAS unsigned char* dp = lds + r0 * LSTRIDE + c * 16;
#pragma unroll 4
    for (int i = 0; i < 16; ++i) { const v4u v = *(const v4u*)(sp + (size_t)(16 * i) * row_stride); *(LAS v4u*)(dp + 16 * i * LSTRIDE) = v; }
}
constexpr int KSTR = 544, VSTR = 528;
__device__ __forceinline__ void p_attn(const Frame& F) {
    const int lane = F.lane, fr = lane & 15, fq = lane >> 4;
    const bf16* Q = (const bf16*)(F.ws + WS_Q16); const bf16* KM = (const bf16*)(F.ws + WS_KM16); const bf16* VT = (const bf16*)(F.ws + WS_VMT16); bf16* AO = (bf16*)(F.ws + WS_AO16);
    for (int item = F.bid; item < NB * 4 * (SEQ / 256); item += F.G) {
        const int qg = item % (SEQ / 256), bhd = item / (SEQ / 256), head = bhd & 3, b = bhd >> 2;
        attn_stage<KSTR>(F.lds, KM + (size_t)(b * NMEM) * D + head * 256, D, F.tid);
        __syncthreads();
        v4u pf[2][8]; float inv[2];
#pragma unroll
        for (int u = 0; u < 2; ++u) { const int q0 = b * SEQ + qg * 256 + u * 128 + F.wave * 16;
            bf16x8 qf[8];
#pragma unroll
            for (int ks = 0; ks < 8; ++ks) qf[ks] = *(const bf16x8*)(Q + (size_t)(q0 + fr) * D + head * 256 + ks * 32 + fq * 8);
            f32x4 sT[16];
            const LAS unsigned char* kbase = F.lds + fr * KSTR + fq * 16;
#pragma unroll
            for (int kt = 0; kt < 16; ++kt) { f32x4 a = {0, 0, 0, 0}; const LAS unsigned char* kp = kbase + kt * 16 * KSTR;
#pragma unroll
                for (int ks = 0; ks < 8; ++ks) { const bf16x8 kf = *(const LAS bf16x8*)(kp + ks * 64); a = __builtin_amdgcn_mfma_f32_16x16x32_bf16(kf, qf[ks], a, 0, 0, 0); }
                sT[kt] = a; if (kt & 1) __builtin_amdgcn_sched_barrier(0); }
            float mx = -3.0e38f;
#pragma unroll
            for (int kt = 0; kt < 16; ++kt) mx = fmaxf(fmaxf(fmaxf(mx, sT[kt].x), fmaxf(sT[kt].y, sT[kt].z)), sT[kt].w);
            mx = fmaxf(mx, shfl_xor_l(mx, 16, lane)); mx = fmaxf(mx, shfl_xor_l(mx, 32, lane));
            float sum = 0.f;
#pragma unroll
            for (int kt = 0; kt < 16; ++kt) { sT[kt].x = __expf(sT[kt].x - mx); sT[kt].y = __expf(sT[kt].y - mx); sT[kt].z = __expf(sT[kt].z - mx); sT[kt].w = __expf(sT[kt].w - mx); sum += (sT[kt].x + sT[kt].y) + (sT[kt].z + sT[kt].w); }
            sum += shfl_xor_l(sum, 16, lane); sum += shfl_xor_l(sum, 32, lane);
            inv[u] = 1.0f / sum;
#pragma unroll
            for (int kp = 0; kp < 8; ++kp) { v4u w; w.x = pk2(sT[2 * kp].x, sT[2 * kp].y); w.y = pk2(sT[2 * kp].z, sT[2 * kp].w); w.z = pk2(sT[2 * kp + 1].x, sT[2 * kp + 1].y); w.w = pk2(sT[2 * kp + 1].z, sT[2 * kp + 1].w); pf[u][kp] = w; }
            __builtin_amdgcn_sched_barrier(0);
        }
        __syncthreads();
        attn_stage<VSTR>(F.lds, VT + (size_t)(b * D + head * 256) * NMEM, NMEM, F.tid);
        __syncthreads();
#pragma unroll
        for (int u = 0; u < 2; ++u) { const int q0 = b * SEQ + qg * 256 + u * 128 + F.wave * 16;
#pragma unroll 2
            for (int dt = 0; dt < 16; ++dt) { f32x4 o = {0, 0, 0, 0}; const LAS unsigned char* vp = F.lds + (dt * 16 + fr) * VSTR + fq * 8;
#pragma unroll
                for (int kp = 0; kp < 8; ++kp) {
                    const v2u lo = *(const LAS v2u*)(vp + 64 * kp), hi = *(const LAS v2u*)(vp + 64 * kp + 32); v4u w; w.x = lo.x; w.y = lo.y; w.z = hi.x; w.w = hi.y;
                    o = __builtin_amdgcn_mfma_f32_16x16x32_bf16(__builtin_bit_cast(bf16x8, w), __builtin_bit_cast(bf16x8, pf[u][kp]), o, 0, 0, 0); }
                v2u w; w.x = pk2(o.x * inv[u], o.y * inv[u]); w.y = pk2(o.z * inv[u], o.w * inv[u]);
                *(v2u*)(AO + (size_t)(q0 + fr) * D + head * 256 + dt * 16 + 4 * fq) = w; __builtin_amdgcn_sched_barrier(0); } }
        __syncthreads();
    }
}

__device__ __forceinline__ void p_ln(const Frame& F, const float* g, const float* b, bool dummy) {
    const int gw = F.bid * NWAVES + F.wave, NGW = F.G * NWAVES, lane = F.lane; const float* H = (const float*)(F.ws + WS_H32); float* Ho = (float*)(F.ws + (dummy ? WS_Z : WS_H32)); bf16* H16 = (bf16*)(F.ws + (dummy ? WS_Z + 128 * MiB : WS_H16));
    for (int r = gw; r < T; r += NGW) { f32x4 v[4];
#pragma unroll
        for (int j = 0; j < 4; ++j) v[j] = *(const f32x4*)(H + (size_t)r * D + 256 * j + 4 * lane);
        float mean, rstd; ln_stats(v, mean, rstd); ln_apply_store(v, mean, rstd, g, b, Ho + (size_t)r * D, H16 + (size_t)r * D, lane); }
}
__device__ __forceinline__ void p_ln_router(KArgs& A, const Frame& F, int l, bool dummy) {
    const int gw = F.bid * NWAVES + F.wave, NGW = F.G * NWAVES, lane = F.lane, tid = F.tid;
    const float* H = (const float*)(F.ws + WS_H32); float* Ho = (float*)(F.ws + (dummy ? WS_Z : WS_H32)); bf16* H16 = (bf16*)(F.ws + (dummy ? WS_Z + 128 * MiB : WS_H16)); int* TOKE = (int*)(F.ws + (dummy ? WS_Z + 200 * MiB : WS_TOKE)); float* TOKW = (float*)(F.ws + (dummy ? WS_Z + 201 * MiB : WS_TOKW));
    LAS float* RW = (LAS float*)F.lds;
    volatile LAS unsigned* hist = F.MISC + MI_HIST;
    const float* rw = kin(A, I_ROUTER_W) + (size_t)l * D * NE; const float* rb = kin(A, I_ROUTER_B) + l * NE; const float* g = kin(A, I_LN2_G) + l * D; const float* bb = kin(A, I_LN2_B) + l * D;
    for (int i = tid; i < D * NE / 4; i += NTHREADS) { const int d = i >> 3, e4 = (i & 7) * 4; *(LAS f32x4*)(RW + d * 36 + e4) = *(const f32x4*)(rw + d * NE + e4); }
    if (tid < NE) hist[tid] = 0u;
    __syncthreads();
    for (int r = gw; r < T; r += NGW) { float v[16]; float s = 0.f;
#pragma unroll
        for (int jj = 0; jj < 16; ++jj) { v[jj] = H[(size_t)r * D + 64 * jj + lane]; s += v[jj]; }
        const float mean = wave_sum(s) * (1.f / D); float s2 = 0.f;
#pragma unroll
        for (int jj = 0; jj < 16; ++jj) { v[jj] -= mean; s2 += v[jj] * v[jj]; }
        const float rstd = 1.0f / sqrtf(wave_sum(s2) * (1.f / D) + LN_EPS);
        float lg[NE];
#pragma unroll
        for (int e = 0; e < NE; ++e) lg[e] = 0.f;
#pragma unroll
        for (int jj = 0; jj < 16; ++jj) { const int d = 64 * jj + lane; const float y = v[jj] * rstd * g[d] + bb[d]; Ho[(size_t)r * D + d] = y; H16[(size_t)r * D + d] = (bf16)f2bf(y);
            const LAS f32x4* wp = (const LAS f32x4*)(RW + d * 36);
#pragma unroll
            for (int e4 = 0; e4 < 8; ++e4) { const f32x4 w = wp[e4]; lg[4 * e4] += y * w.x; lg[4 * e4 + 1] += y * w.y; lg[4 * e4 + 2] += y * w.z; lg[4 * e4 + 3] += y * w.w; } }
#pragma unroll
        for (int e = 0; e < NE; ++e) { lg[e] = wave_sum(lg[e]) + rb[e]; }
        int i0 = -1, i1 = -1, i2 = -1, i3 = -1; float v0 = -3.0e38f, v1 = -3.0e38f, v2 = -3.0e38f, v3 = -3.0e38f;
#pragma unroll
        for (int e = 0; e < NE; ++e) if (lg[e] > v0) { v0 = lg[e]; i0 = e; }
#pragma unroll
        for (int e = 0; e < NE; ++e) if (e != i0 && lg[e] > v1) { v1 = lg[e]; i1 = e; }
#pragma unroll
        for (int e = 0; e < NE; ++e) if (e != i0 && e != i1 && lg[e] > v2) { v2 = lg[e]; i2 = e; }
#pragma unroll
        for (int e = 0; e < NE; ++e) if (e != i0 && e != i1 && e != i2 && lg[e] > v3) { v3 = lg[e]; i3 = e; }
        const float e1 = __expf(v1 - v0), e2 = __expf(v2 - v0), e3 = __expf(v3 - v0), inv = 1.0f / (1.0f + e1 + e2 + e3);
        if (lane == 0) { *(int4*)(TOKE + (size_t)r * 4) = make_int4(i0, i1, i2, i3); *(f32x4*)(TOKW + (size_t)r * 4) = (f32x4){inv, e1 * inv, e2 * inv, e3 * inv};
            __hip_atomic_fetch_add((LAS unsigned*)&hist[i0], 1u, __ATOMIC_RELAXED, __HIP_MEMORY_SCOPE_WORKGROUP); __hip_atomic_fetch_add((LAS unsigned*)&hist[i1], 1u, __ATOMIC_RELAXED, __HIP_MEMORY_SCOPE_WORKGROUP);
            __hip_atomic_fetch_add((LAS unsigned*)&hist[i2], 1u, __ATOMIC_RELAXED, __HIP_MEMORY_SCOPE_WORKGROUP); __hip_atomic_fetch_add((LAS unsigned*)&hist[i3], 1u, __ATOMIC_RELAXED, __HIP_MEMORY_SCOPE_WORKGROUP); }
    }
    __syncthreads();
    if (tid < NE && !dummy) { const unsigned c = hist[tid]; if (c) atomicAdd(F.ctl + CW_CNT + l * NE + tid, c); F.ctl[CW_WGH + (l * 512 + F.bid) * NE + tid] = c; }
}
__device__ __forceinline__ void moe_offsets(const Frame& F, int l) {
    if (F.tid == 0) { int acc = 0;
        for (int e = 0; e < NE; ++e) { F.MISC[MI_TOFF + e] = (unsigned)acc; const unsigned c = __hip_atomic_load(F.ctl + CW_CNT + l * NE + e, __ATOMIC_RELAXED, __HIP_MEMORY_SCOPE_AGENT); acc += (int)((c + 255u) >> 8); }
        F.MISC[MI_TOFF + NE] = (unsigned)acc; }
    __syncthreads();
}
__device__ __forceinline__ void p_moe_slots(const Frame& F, int l, int dummy) {
    const int gw = F.bid * NWAVES + F.wave, NGW = F.G * NWAVES, lane = F.lane;
    moe_offsets(F, l);
    const int* TOKE = (const int*)(F.ws + WS_TOKE); const float* TOKW = (const float*)(F.ws + WS_TOKW); int* TOKS = (int*)(F.ws + (dummy ? WS_END : WS_TOKS)); float* SLOTW = (float*)(F.ws + (dummy ? WS_END + 1 * MiB : WS_SLOTW));
    const bf16* H16 = (const bf16*)(F.ws + WS_H16); bf16* XG = (bf16*)(F.ws + (dummy ? WS_ACT : WS_XG)); unsigned* CUR = F.ctl + CW_CUR + l * NE + dummy * 256;
    if (F.tid < NE) { const unsigned c = F.ctl[CW_WGH + (l * 512 + F.bid) * NE + F.tid]; const unsigned base = c ? atomicAdd(CUR + F.tid, c) : 0u;
        F.MISC[MI_LBASE + F.tid] = F.MISC[MI_TOFF + F.tid] * 256u + base; F.MISC[MI_LCUR + F.tid] = 0u; }
    __syncthreads();
    for (int r = gw; r < T; r += NGW) { int slot = 0;
        if (lane < 4) { const int e = TOKE[(size_t)r * 4 + lane]; const unsigned pos = __hip_atomic_fetch_add((LAS unsigned*)&F.MISC[MI_LCUR + e], 1u, __ATOMIC_RELAXED, __HIP_MEMORY_SCOPE_WORKGROUP); slot = (int)(F.MISC[MI_LBASE + e] + pos);
            TOKS[(size_t)r * 4 + lane] = slot; SLOTW[slot] = TOKW[(size_t)r * 4 + lane]; }
        const v4u a = *(const v4u*)(H16 + (size_t)r * D + 8 * lane), b = *(const v4u*)(H16 + (size_t)r * D + 512 + 8 * lane);
#pragma unroll
        for (int k = 0; k < 4; ++k) { const int sk = shfl_idx_l(slot, k); *(v4u*)(XG + (size_t)sk * D + 8 * lane) = a; *(v4u*)(XG + (size_t)sk * D + 512 + 8 * lane) = b; } }
}
__device__ __forceinline__ void p_moe_combine(KArgs& A, const Frame& F, int l, bool dummy) {
    const int gw = F.bid * NWAVES + F.wave, NGW = F.G * NWAVES, lane = F.lane;
    const float* H = (const float*)(F.ws + WS_H32); float* Ho = (float*)(F.ws + (dummy ? WS_Z : WS_H32)); bf16* H16 = (bf16*)(F.ws + (dummy ? WS_Z + 128 * MiB : WS_H16)); const int* TOKS = (const int*)(F.ws + WS_TOKS); const bf16* YS = (const bf16*)(F.ws + WS_YS);
    const bool last = (l == NL - 1) && !dummy;
    for (int r = gw; r < T; r += NGW) { f32x4 v[4]; const int4 sl = *(const int4*)(TOKS + (size_t)r * 4);
#pragma unroll
        for (int j = 0; j < 4; ++j) { v[j] = *(const f32x4*)(H + (size_t)r * D + 256 * j + 4 * lane) * DN_ALPHA;
            const v2u y0 = *(const v2u*)(YS + (size_t)sl.x * D + 256 * j + 4 * lane), y1 = *(const v2u*)(YS + (size_t)sl.y * D + 256 * j + 4 * lane), y2 = *(const v2u*)(YS + (size_t)sl.z * D + 256 * j + 4 * lane), y3 = *(const v2u*)(YS + (size_t)sl.w * D + 256 * j + 4 * lane);
            v[j].x += (bf2f(y0.x & 0xffffu) + bf2f(y1.x & 0xffffu)) + (bf2f(y2.x & 0xffffu) + bf2f(y3.x & 0xffffu));
            v[j].y += (bf2f(y0.x >> 16) + bf2f(y1.x >> 16)) + (bf2f(y2.x >> 16) + bf2f(y3.x >> 16));
            v[j].z += (bf2f(y0.y & 0xffffu) + bf2f(y1.y & 0xffffu)) + (bf2f(y2.y & 0xffffu) + bf2f(y3.y & 0xffffu));
            v[j].w += (bf2f(y0.y >> 16) + bf2f(y1.y >> 16)) + (bf2f(y2.y >> 16) + bf2f(y3.y >> 16)); }
        float mean, rstd; ln_stats(v, mean, rstd);
        if (last) ln_apply_store(v, mean, rstd, kin(A, I_LN3_G) + l * D, kin(A, I_LN3_B) + l * D, kout(A) + (size_t)r * D, (bf16*)nullptr, lane);
        else ln_apply_store(v, mean, rstd, kin(A, I_LN3_G) + l * D, kin(A, I_LN3_B) + l * D, Ho + (size_t)r * D, H16 + (size_t)r * D, lane); }
}

constexpr int NPL = 18;
constexpr int NPHASES = 1 + NL * NPL;
#ifndef ONLY
#define ONLY -1
#endif
#define EN(j) (ONLY < 0 || ONLY == (j))
#define DUMMY(j) ((PROBE_PHASE == (j)) && (rep_ + 1 < PROBE_REPS))
#define REPS(j) for (int rep_ = 0; rep_ < ((PROBE_PHASE == (j)) ? PROBE_REPS : 1); ++rep_, __syncthreads())
__global__ void __launch_bounds__(NTHREADS, 2) fwd_kernel(Args args) {
    extern __shared__ __attribute__((aligned(16))) unsigned char lds_raw[];
    Frame F;
    F.lds = (LAS unsigned char*)lds_raw; F.MISC = (volatile LAS unsigned*)(F.lds + MISC_OFF);
    F.tid = threadIdx.x; F.lane = F.tid & 63; F.wave = __builtin_amdgcn_readfirstlane(F.tid >> 6); F.G = gridDim.x; F.bid = blockIdx.x;
    F.ws = (unsigned char*)(GAS unsigned char*)args.ws; F.ctl = (unsigned*)(F.ws + WS_CTL);
    for (int u = F.tid; u < (LDS_BYTES - MISC_OFF) / 4; u += NTHREADS) F.MISC[u] = 0u;
    __syncthreads();
    XcdBarrier bar; bar.bar = F.ctl + CW_BAR; bar.x = 0; bar.st = nullptr;
    const int lo = args.ph_lo, hi = args.ph_hi;
    if (hi - lo > 1) bar = xcd_barrier_post(F.ctl + CW_BAR, F.MISC + 8);
#define IN(k) (launder_i(lo) <= (k) && (k) < launder_i(hi))
#define SEAM(k) do { if (IN(k) && IN((k) + 1)) xcd_barrier(bar); } while (0)
#define PH_BEGIN KArgs& KA = *kargs(); unsigned char* ws = launder_p(args.ws); F.ws = ws; (void)KA; (void)ws; { int ln_; asm volatile("v_mbcnt_lo_u32_b32 %0, -1, 0\n\tv_mbcnt_hi_u32_b32 %0, -1, %0" : "=v"(ln_)); F.lane = ln_; } F.tid = F.wave * 64 + F.lane; F.bid = launder_i((int)blockIdx.x); F.G = launder_i((int)gridDim.x);

    if (EN(100) && IN(0)) REPS(100) { PH_BEGIN p_prologue(KA, F); } SEAM(0);

#pragma unroll 1
    for (int l_ = 0; l_ < NL; ++l_) {
        const int l = launder_i(l_); const int p0 = 1 + l * NPL;
        if (EN(0) && IN(p0 + 0)) REPS(0) { PH_BEGIN
            pg8::Gemm g{D, D, D}; pg8::StaticOrder S{(const bf16*)(ws + WS_H16), (const bf16*)(ws + WS_WINT) + (size_t)l * N_IN * D, D, D, T / 256, N_IN / 256, F.G, F.bid};
            EpiIn E{l};
            pg8::gemm_phase(F.lds, F.tid, g, S, E);
        } SEAM(p0 + 0);
        if (EN(1) && IN(p0 + 1)) REPS(1) { PH_BEGIN p_mix1(KA, F, l); } SEAM(p0 + 1);
        if (EN(2) && IN(p0 + 2)) REPS(2) { PH_BEGIN
            { pg8::Gemm g{S5K, 1024, 1024}; pg8::BatchOrder S{(const bf16*)(ws + WS_AOUT), (const bf16*)(ws + WS_S5BC) + (size_t)l * 16 * 256 * 1024, S5K, 1024, NCHT / 256, 1, 16, F.G, F.bid, (size_t)NCHT * S5K, (size_t)256 * 1024};
              EpiXloc E{0}; pg8::gemm_phase(F.lds, F.tid, g, S, E); }
            __syncthreads();
            { pg8::Gemm g{D, D, D}; pg8::StaticOrder S{(const bf16*)(ws + WS_MEM16), (const bf16*)(ws + WS_WKT) + (size_t)l * D * D, D, D, NB * NMEM / 256, D / 256, F.G, F.bid};
              EpiBf16 E{(unsigned)(WS_KM16 / MiB), 1.0f}; pg8::gemm_phase(F.lds, F.tid, g, S, E); }
            __syncthreads();
            { pg8::Gemm g{D, D, D}; pg8::StaticOrder S{(const bf16*)(ws + WS_MEM16), (const bf16*)(ws + WS_WVT) + (size_t)l * D * D, D, D, NB * NMEM / 256, D / 256, F.G, F.bid};
              EpiVT E{0}; pg8::gemm_phase(F.lds, F.tid, g, S, E); }
        } SEAM(p0 + 2);
        if (EN(3) && IN(p0 + 3)) REPS(3) { PH_BEGIN p_s5_chain(KA, F, l); p_rw_chunks(F); } SEAM(p0 + 3);
        if (EN(4) && IN(p0 + 4)) REPS(4) { PH_BEGIN
            p_chain_compose(F);
            pg8::Gemm g{S5K, S5K, S5K}; pg8::BatchOrder S{(const bf16*)(ws + WS_AOUT), (const bf16*)(ws + WS_S5BT) + (size_t)l * 16 * 1024 * S5K, S5K, S5K, NCHT / 256, 1024 / 256, 16, F.G, F.bid, (size_t)NCHT * S5K, (size_t)1024 * S5K};
            EpiS5Y E{l}; pg8::gemm_phase(F.lds, F.tid, g, S, E);
        } SEAM(p0 + 4);
        if (EN(5) && IN(p0 + 5)) REPS(5) { PH_BEGIN
            const int nchain = (F.G >= 16) ? 8 : 0;
            if (F.bid < nchain) { p_chain_blocks(F, F.bid * NWAVES + F.wave, nchain * NWAVES); }
            else {
                if (nchain == 0) { p_chain_blocks(F, F.bid * NWAVES + F.wave, F.G * NWAVES); __syncthreads(); }
                pg8::Gemm g{256, 256, 256}; pg8::StaticOrder S{(const bf16*)(ws + WS_YD16), (const bf16*)(ws + WS_GLUT) + (size_t)l * 256 * 256, 256, 256, T / 256, 1, F.G - nchain, F.bid - nchain};
                EpiGlu E{l}; pg8::gemm_phase(F.lds, F.tid, g, S, E);
            }
        } SEAM(p0 + 5);
        if (EN(6) && IN(p0 + 6)) REPS(6) { PH_BEGIN
            for (int bb = F.bid; bb < 16 * NBLK; bb += F.G) {
                if (F.wave < 4) chain_inblock(F, bb, F.wave);
                VM_WAIT(); __syncthreads();
                rw_out_task(KA, F, l, bb * CB + F.wave);
                __syncthreads();
            }
        } SEAM(p0 + 6);
        if (EN(7) && IN(p0 + 7)) REPS(7) { PH_BEGIN
#pragma unroll 1
            for (int br = 0; br < 4; ++br) {
                pg8::Gemm g{D, 256, 256}; pg8::StaticOrder S{(const bf16*)(ws + WS_O16) + br * 256, (const bf16*)(ws + WS_BRT) + (size_t)(l * 4 + br) * D * 256, D, 256, T / 256, D / 256, F.G, F.bid};
                EpiBranch E{br}; pg8::gemm_phase(F.lds, F.tid, g, S, E);
                VM_WAIT(); __syncthreads();
            }
        } SEAM(p0 + 7);
        if (EN(8) && IN(p0 + 8)) REPS(8) { PH_BEGIN
            pg8::Gemm g{D, D, D}; pg8::StaticOrder S{(const bf16*)(ws + WS_MG16), (const bf16*)(ws + WS_WOUTT) + (size_t)l * D * D, D, D, T / 256, D / 256, F.G, F.bid};
            EpiResid E{0}; pg8::gemm_phase(F.lds, F.tid, g, S, E);
        } SEAM(p0 + 8);
        if (EN(9) && IN(p0 + 9)) REPS(9) { PH_BEGIN p_ln(F, kin(KA, I_LN1_G) + l * D, kin(KA, I_LN1_B) + l * D, DUMMY(9)); } SEAM(p0 + 9);
        if (EN(10) && IN(p0 + 10)) REPS(10) { PH_BEGIN
            pg8::Gemm g{D, D, D}; pg8::StaticOrder S{(const bf16*)(ws + WS_H16), (const bf16*)(ws + WS_WQT) + (size_t)l * D * D, D, D, T / 256, D / 256, F.G, F.bid};
            EpiBf16 E{(unsigned)(WS_Q16 / MiB), 0.0625f}; pg8::gemm_phase(F.lds, F.tid, g, S, E);
        } SEAM(p0 + 10);
        if (EN(11) && IN(p0 + 11)) REPS(11) { PH_BEGIN p_attn(F); } SEAM(p0 + 11);
        if (EN(12) && IN(p0 + 12)) REPS(12) { PH_BEGIN
            pg8::Gemm g{D, D, D}; pg8::StaticOrder S{(const bf16*)(ws + WS_AO16), (const bf16*)(ws + WS_WOT) + (size_t)l * D * D, D, D, T / 256, D / 256, F.G, F.bid};
            EpiResid E{0}; pg8::gemm_phase(F.lds, F.tid, g, S, E);
        } SEAM(p0 + 12);
        if (EN(13) && IN(p0 + 13)) REPS(13) { PH_BEGIN p_ln_router(KA, F, l, DUMMY(13)); } SEAM(p0 + 13);
        if (EN(14) && IN(p0 + 14)) REPS(14) { PH_BEGIN p_moe_slots(F, l, DUMMY(14) ? (rep_ + 1) : 0); } SEAM(p0 + 14);
        if (EN(15) && IN(p0 + 15)) REPS(15) { PH_BEGIN
            moe_offsets(F, l);
            pg8::Gemm g{D, D, D}; pg8::MoeOrder S{(const bf16*)(ws + WS_XG), (const bf16*)(ws + WS_W1T) + (size_t)l * NE * 2048 * D, D, D, 2048 / 256, F.G, F.bid, (size_t)2048 * D, (const LAS int*)(F.MISC + MI_TOFF)};
            EpiSwiglu E{l}; pg8::gemm_phase(F.lds, F.tid, g, S, E);
        } SEAM(p0 + 15);
        if (EN(16) && IN(p0 + 16)) REPS(16) { PH_BEGIN
            moe_offsets(F, l);
            pg8::Gemm g{DFF, DFF, DFF}; pg8::MoeOrder S{(const bf16*)(ws + WS_ACT), (const bf16*)(ws + WS_W2T) + (size_t)l * NE * D * DFF, DFF, DFF, D / 256, F.G, F.bid, (size_t)D * DFF, (const LAS int*)(F.MISC + MI_TOFF)};
            EpiMoeOut E{l}; pg8::gemm_phase(F.lds, F.tid, g, S, E);
        } SEAM(p0 + 16);
        if (EN(17) && IN(p0 + 17)) REPS(17) { PH_BEGIN p_moe_combine(KA, F, l, DUMMY(17)); } SEAM(p0 + 17);
    }
#undef IN
#undef SEAM
}

extern "C" void kernel_launch(void* const* d_in, const int* in_sizes, int n_in, void* d_out, int out_size, void* d_ws, size_t ws_size, hipStream_t stream) {
    static int grid = 0;
    if (grid == 0) {
        if (n_in != 50 || ws_size < WS_END) { fprintf(stderr, "kernel_launch: unexpected n_in %d / ws_size %zu\n", n_in, ws_size); grid = -1; return; }
        int dev = 0, cus = 0, per_cu = 0;
        if (hipGetDevice(&dev) != hipSuccess || hipDeviceGetAttribute(&cus, hipDeviceAttributeMultiprocessorCount, dev) != hipSuccess) { grid = -1; return; }
        if (hipFuncSetAttribute((const void*)fwd_kernel, hipFuncAttributeMaxDynamicSharedMemorySize, LDS_BYTES) != hipSuccess) { fprintf(stderr, "kernel_launch: hipFuncSetAttribute failed\n"); grid = -1; return; }
        if (hipOccupancyMaxActiveBlocksPerMultiprocessor(&per_cu, (const void*)fwd_kernel, NTHREADS, LDS_BYTES) != hipSuccess || per_cu < 1) { fprintf(stderr, "kernel_launch: occupancy query says %d\n", per_cu); }
        (void)hipGetLastError();
        grid = cus;
    }
    if (grid < 0) return;
    (void)hipMemsetAsync((char*)d_ws + WS_CTL, 0, CTL_ZERO_BYTES, stream);
    Args a{};
    for (int i = 0; i < 50; ++i) a.in[i] = (const float*)d_in[i];
    a.out = (float*)d_out; a.ws = (unsigned char*)d_ws;
#if N_LAUNCHES == 1
    a.ph_lo = 0; a.ph_hi = NPHASES;
    hipLaunchKernelGGL(fwd_kernel, dim3(grid), dim3(NTHREADS), LDS_BYTES, stream, a);
#else
    for (int p = 0; p < NPHASES; ++p) { a.ph_lo = p; a.ph_hi = p + 1; hipLaunchKernelGGL(fwd_kernel, dim3(grid), dim3(NTHREADS), LDS_BYTES, stream, a); }
#endif
}
```

```cpp
#include <hip/hip_runtime.h>
#include <cstdio>
#include <cstdint>

#ifndef N_LAUNCHES
#define N_LAUNCHES 1
#endif

#ifndef PROBE_PHASE
#define PROBE_PHASE -1
#endif
#ifndef PROBE_REPS
#define PROBE_REPS 3
#endif
#define GAS __attribute__((address_space(1)))
#define LAS __attribute__((address_space(3)))
typedef unsigned short bf16;
typedef unsigned v4u __attribute__((ext_vector_type(4)));
typedef unsigned v2u __attribute__((ext_vector_type(2)));
typedef float f32x4 __attribute__((ext_vector_type(4)));
typedef float f32x2 __attribute__((ext_vector_type(2)));
typedef short bf16x8 __attribute__((ext_vector_type(8)));
typedef short bf16x4 __attribute__((ext_vector_type(4)));

constexpr int NL = 2, NB = 4, SEQ = 8192, T = NB * SEQ, D = 1024;
constexpr int NMEM = 256;
constexpr int OFF_B = 768, OFF_C = 1280, OFF_D = 2304, OFF_G = 2560, N_IN = 6656, ZLD = 2560;
constexpr int NE = 32, TOPK = 4, DFF = 1024;
constexpr int CH = 64;
constexpr int NCH = SEQ / CH;
constexpr int NCHT = T / CH;
constexpr int S5K = 1152;
constexpr int SLOT_ROWS = T * TOPK + NE * 256;
constexpr float LN_EPS = 1e-5f, RW_LN_EPS = 64e-5f;
constexpr float DN_ALPHA = 1.41421356237309515f;

constexpr size_t MiB = 1u << 20;
constexpr size_t WS_CTL = 0, CTL_ZERO_BYTES = 1 * MiB;
constexpr size_t WS_W1T = 2 * MiB;
constexpr size_t WS_W2T = 258 * MiB;
constexpr size_t WS_WINT = 386 * MiB;
constexpr size_t WS_BRT = 412 * MiB;
constexpr size_t WS_WOUTT = 416 * MiB, WS_WQT = 420 * MiB, WS_WKT = 424 * MiB, WS_WVT = 428 * MiB, WS_WOT = 432 * MiB;
constexpr size_t WS_GLUT = 436 * MiB;
constexpr size_t WS_MEM16 = 437 * MiB;
constexpr size_t WS_S5BT = 440 * MiB;
constexpr size_t WS_S5BC = 512 * MiB;
constexpr size_t WS_H32 = 528 * MiB;
constexpr size_t WS_H16 = 656 * MiB;
constexpr size_t WS_Z = 720 * MiB;
constexpr size_t WS_XG = 720 * MiB;
constexpr size_t WS_SG = 1040 * MiB;
constexpr size_t WS_YS = 1040 * MiB;
constexpr size_t WS_O16 = 1312 * MiB, WS_MG16 = 1376 * MiB, WS_Q16 = 1440 * MiB, WS_AO16 = 1504 * MiB;
constexpr size_t WS_RWOP = 1568 * MiB;
constexpr size_t WS_ACT = 1568 * MiB;
constexpr size_t WS_QH = 1760 * MiB, WS_YL = 1792 * MiB, WS_GC = 1824 * MiB, WS_HC = 1856 * MiB, WS_SC = 1888 * MiB, WS_RWG = 1920 * MiB;
constexpr size_t WS_RK = 1952 * MiB;
constexpr size_t WS_AOUT = 1954 * MiB;
constexpr size_t WS_XLOC = 1972 * MiB;
constexpr size_t WS_YD16 = 1976 * MiB;
constexpr size_t WS_KM16 = 1992 * MiB, WS_VMT16 = 1994 * MiB;
constexpr size_t WS_TOKE = 1996 * MiB, WS_TOKW = 1997 * MiB, WS_TOKS = 1998 * MiB, WS_SLOTW = 1999 * MiB;
constexpr size_t WS_GB = 2000 * MiB, WS_HB = 2004 * MiB, WS_SB = 2008 * MiB;
constexpr size_t WS_END = 2012 * MiB;
static_assert(WS_XG + (size_t)SLOT_ROWS * D * 2 <= WS_SG && WS_YS + (size_t)SLOT_ROWS * D * 2 <= WS_O16 && WS_ACT + (size_t)SLOT_ROWS * D * 2 <= WS_RK, "overlays");
constexpr int CW_BAR = 4096;
constexpr int CW_CNT = 16384;
constexpr int CW_CUR = 16384 + 128;
constexpr int CW_WGH = 65536;

constexpr int LDS_BYTES = 163840;
constexpr int MISC_OFF = LDS_BYTES - 1024;
constexpr int RING_BYTES = 131072;
constexpr int NWAVES = 8, NTHREADS = 512;

#define LDS_WAIT() asm volatile("s_waitcnt lgkmcnt(0)" ::: "memory")
#define VM_WAIT() asm volatile("s_waitcnt vmcnt(0)" ::: "memory")
__device__ __forceinline__ unsigned f2bf(float f) { unsigned u = __float_as_uint(f); return (u + 0x7fffu + ((u >> 16) & 1u)) >> 16; }
__device__ __forceinline__ unsigned pk2(float lo, float hi) { return f2bf(lo) | (f2bf(hi) << 16); }
__device__ __forceinline__ float bf2f(unsigned h) { return __uint_as_float(h << 16); }
__device__ __forceinline__ float sigmoidf_(float x) { return 1.0f / (1.0f + __expf(-x)); }
__device__ __forceinline__ int my_lane() { int l; asm volatile("v_mbcnt_lo_u32_b32 %0, -1, 0\n\tv_mbcnt_hi_u32_b32 %0, -1, %0" : "=v"(l)); return l; }
__device__ __forceinline__ float shfl_xor_l(float v, int o, int lane) { return __builtin_bit_cast(float, __builtin_amdgcn_ds_bpermute((lane ^ o) << 2, __builtin_bit_cast(int, v))); }
__device__ __forceinline__ int shfl_idx_l(int v, int src) { return __builtin_amdgcn_ds_bpermute(src << 2, v); }
__device__ __forceinline__ float wave_sum(float v) {
    const int ln = my_lane();
#pragma unroll
    for (int o = 1; o < 64; o <<= 1) v += shfl_xor_l(v, o, ln);
    return v;
}

#define XB_TMO      128
#define XB_XCNT(j)  (256  + 64 * (j))
#define XB_XSUB(j)  (1280 + 64 * (j))
#define XB_XGEN(j)  (2304 + 64 * (j))
#define XB_TOP      3328
#define XB_TOPGEN   3392
#define XCD_BAR_WORDS 3456
#define XB_SPIN_CAP (1u << 24)
__device__ __forceinline__ unsigned xb_ld(unsigned* p)              { return __hip_atomic_load(p, __ATOMIC_RELAXED, __HIP_MEMORY_SCOPE_AGENT); }
__device__ __forceinline__ unsigned xb_add(unsigned* p, unsigned v) { return __hip_atomic_fetch_add(p, v, __ATOMIC_RELAXED, __HIP_MEMORY_SCOPE_AGENT); }
__device__ __forceinline__ unsigned xb_xcc_id() { return (unsigned)__builtin_amdgcn_s_getreg((3 << 11) | 20) & 0xFu; }
#define XB_SPIN(cond, bar) do { unsigned _sp = 0; while (cond) { __builtin_amdgcn_s_sleep(1); \
    if ((++_sp & 255u) == 0u) { if (xb_ld(&(bar)[XB_TMO])) break; if (_sp > XB_SPIN_CAP) { atomicAdd(&(bar)[XB_TMO], 1u); break; } } } } while (0)
struct XcdBarrier { unsigned* bar; unsigned x; volatile LAS unsigned* st; };
__device__ __forceinline__ XcdBarrier xcd_barrier_post(unsigned* bar, volatile LAS unsigned* st) {
    XcdBarrier b; b.bar = bar; b.x = xb_xcc_id(); b.st = st;
    if (threadIdx.x == 0) (void)xb_add(&bar[XB_XCNT(b.x)], 1u);
    return b;
}
__device__ __forceinline__ void xcd_barrier_complete(unsigned* bar, unsigned x, unsigned& nloc, unsigned& nx) {
    const unsigned G = gridDim.x * gridDim.y * gridDim.z;
    unsigned sum, cnt, mine, sp = 0u;
    for (;;) {
        sum = 0u; cnt = 0u; mine = 0u;
#pragma unroll
        for (unsigned j = 0; j < 16; ++j) { const unsigned c = xb_ld(&bar[XB_XCNT(j)]); sum += c; cnt += (c > 0u) ? 1u : 0u; mine = (j == x) ? c : mine; }
        if (sum == G) break;
        __builtin_amdgcn_s_sleep(1);
        if ((++sp & 255u) == 0u) { if (xb_ld(&bar[XB_TMO])) break; if (sp > XB_SPIN_CAP) { atomicAdd(&bar[XB_TMO], 1u); break; } }
    }
    nloc = mine > 0u ? mine : 1u; nx = cnt > 0u ? cnt : 1u;
}
__device__ __forceinline__ void xcd_barrier(const XcdBarrier& b) {
    asm volatile("s_waitcnt vmcnt(0)" ::: "memory");
    __syncthreads();
    if (threadIdx.x == 0) {
        unsigned* bar = b.bar; unsigned bx = b.x;
        asm volatile("" : "+s"(bar), "+s"(bx));
        __builtin_amdgcn_s_waitcnt(0);
        unsigned nloc = b.st[0], nx = b.st[1];
        if (nloc == 0u) { xcd_barrier_complete(bar, bx, nloc, nx); b.st[0] = nloc; b.st[1] = nx; }
        const unsigned old = xb_add(&bar[XB_XSUB(bx)], 1u);
        const unsigned gen = old / nloc;
        if (old + 1u == (gen + 1u) * nloc) {
            __builtin_amdgcn_fence(__ATOMIC_RELEASE, "agent");
            asm volatile("s_waitcnt vmcnt(0)" ::: "memory");
            const unsigned og = xb_add(&bar[XB_TOP], 1u);
            const unsigned tg = og / nx;
            if (og + 1u == (tg + 1u) * nx) xb_add(&bar[XB_TOPGEN], 1u);
            else XB_SPIN(xb_ld(&bar[XB_TOPGEN]) == tg, bar);
            __builtin_amdgcn_fence(__ATOMIC_ACQUIRE, "agent");
            xb_add(&bar[XB_XGEN(bx)], 1u);
            asm volatile("s_waitcnt vmcnt(0)" ::: "memory");
        } else {
            XB_SPIN(xb_ld(&bar[XB_XGEN(bx)]) == gen, bar);
            __builtin_amdgcn_fence(__ATOMIC_ACQUIRE, "agent");
            asm volatile("s_waitcnt vmcnt(0)" ::: "memory");
        }
    }
    __syncthreads();
}

namespace pg8 {
constexpr int BM = 256, BK = 64, HALF = 128, HTB = HALF * BK * 2, STAGE_BYTES = 8 * HTB, NXCD = 8, WGM = 8;
__host__ __device__ __forceinline__ int lds_byte(int r, int c) { const int st = (r >> 4) * 2 + (c >> 5), rr = r & 15, cc = c & 31, ob = rr * 64 + cc * 2; return st * 1024 + (ob ^ (((ob >> 9) & 1) << 5)); }
__host__ __device__ __forceinline__ int perm32(int rho) { const int n = rho >> 4, i = rho & 15; return 8 * (i >> 2) + 4 * n + (i & 3); }
__host__ __device__ __forceinline__ void stage_rc(int b, int& R, int& C) { const int st = b / 1024, sb = b % 1024, swz = sb ^ (((sb >> 9) & 1) << 5); R = (st >> 1) * 16 + swz / 64; C = (st & 1) * 32 + (swz % 64) / 2; }
struct Unit { int pm, pn, e; };
struct Gemm { int lda, ldb, K; };

__device__ __forceinline__ bool static_tile(int i, int G, int c, int nM, int nN, int& pm, int& pn) {
    const int nwg = nM * nN; const long L = (long)i * G + c; if (L >= nwg) return false;
    int wgid = (int)L; { const int q = nwg / NXCD, r = nwg % NXCD, xcd = wgid % NXCD, off = wgid / NXCD; wgid = (xcd < r ? xcd * (q + 1) : r * (q + 1) + (xcd - r) * q) + off; }
    const int nig = WGM * nN, gid = wgid / nig, fm = gid * WGM, gsz = (nM - fm) < WGM ? (nM - fm) : WGM;
    pm = fm + ((wgid % nig) % gsz); pn = (wgid % nig) / gsz; return true;
}
struct StaticOrder {
    const bf16* A; const bf16* Bt; int lda, ldb, nM, nN, G, c;
    __device__ __forceinline__ bool next(int i, Unit& u) const { u.e = 0; return static_tile(i, G, c, nM, nN, u.pm, u.pn); }
    __device__ __forceinline__ const char* a_base(const Unit& u) const { return (const char*)(A + (size_t)u.pm * BM * lda); }
    __device__ __forceinline__ const char* b_base(const Unit& u) const { return (const char*)(Bt + (size_t)u.pn * BM * ldb); }
};
struct BatchOrder {
    const bf16* A; const bf16* Bt; int lda, ldb, nM, nN, nb, G, c; size_t sA, sB;
    __device__ __forceinline__ bool next(int i, Unit& u) const {
        const long L = (long)i * G + c; const int per = nM * nN; if (L >= (long)per * nb) return false;
        u.e = (int)(L / per); const int r = (int)(L % per); u.pn = r / nM; u.pm = r % nM; return true; }
    __device__ __forceinline__ const char* a_base(const Unit& u) const { return (const char*)(A + (size_t)u.e * sA + (size_t)u.pm * BM * lda); }
    __device__ __forceinline__ const char* b_base(const Unit& u) const { return (const char*)(Bt + (size_t)u.e * sB + (size_t)u.pn * BM * ldb); }
};
struct MoeOrder {
    const bf16* A; const bf16* Bt; int lda, ldb, nN, G, c; size_t sB; const LAS int* toff;
    __device__ __forceinline__ bool next(int i, Unit& u) const {
        const int nt = toff[NE]; int mt;
        const int Gx = G >> 3;
        if ((G & 7) == 0 && (Gx % nN) == 0) {
            const int per = Gx / nN, x = c & 7, y = c >> 3;
            mt = i * 8 * per + x * per + y / nN; u.pn = y % nN; if (mt >= nt) return false;
        } else { const long L = (long)i * G + c; if (L >= (long)nt * nN) return false; mt = (int)(L / nN); u.pn = (int)(L % nN); }
        u.pm = mt; int e = 0;
#pragma unroll 1
        for (int k = 1; k < NE; ++k) e += (toff[k] <= mt) ? 1 : 0;
        u.e = e; return true; }
    __device__ __forceinline__ const char* a_base(const Unit& u) const { return (const char*)(A + (size_t)u.pm * BM * lda); }
    __device__ __forceinline__ const char* b_base(const Unit& u) const { return (const char*)(Bt + (size_t)u.e * sB + (size_t)u.pn * BM * ldb); }
};

template <class F> __device__ __forceinline__ void epi_foreach(const f32x4 (&acc)[2][2][4][2], const Unit& u, int wr, int wc, int fr, int fq, const F& f) {
#pragma unroll
    for (int ai = 0; ai < 2; ++ai)
#pragma unroll
        for (int m = 0; m < 4; ++m) { const int row = u.pm * BM + ai * HALF + wr * 64 + m * 16 + fr;
#pragma unroll
            for (int bj = 0; bj < 2; ++bj)
#pragma unroll
                for (int n = 0; n < 2; ++n) f(row, u.pn * BM + bj * HALF + wc * 32 + n * 16 + 4 * fq, acc[ai][bj][m][n]);
            if (m == 3) __builtin_amdgcn_sched_barrier(0); }
}

template <class F> __device__ __forceinline__ void epi_foreach8(const f32x4 (&acc)[2][2][4][2], const Unit& u, int wr, int wc, int fr, int fq, const F& f) {
#pragma unroll
    for (int ai = 0; ai < 2; ++ai)
#pragma unroll
        for (int m = 0; m < 4; ++m) { const int row = u.pm * BM + ai * HALF + wr * 64 + m * 16 + fr;
#pragma unroll
            for (int bj = 0; bj < 2; ++bj) f(row, u.pn * BM + bj * HALF + wc * 32 + 8 * fq, acc[ai][bj][m][0], acc[ai][bj][m][1]);
            if (m == 3) __builtin_amdgcn_sched_barrier(0); }
}
template <class Epi, class Sched, bool ALIGN_EPI = true, bool SP2 = true>
__device__ __forceinline__ void gemm_phase(LAS unsigned char* lds, const int tid, const Gemm g, const Sched& S, const Epi& E) {
    const int wid = __builtin_amdgcn_readfirstlane(tid >> 6), lane = tid & 63, wr = wid >> 2, wc = wid & 3, fr = lane & 15, fq = lane >> 4;
    const int K = g.K, nt = K / BK;
    unsigned voffA[2], voffB[2];
#pragma unroll
    for (int i = 0; i < 2; ++i) { int R, C; stage_rc(tid * 16 + i * 8192, R, C);
        const int Rb = Epi::PERM ? ((R & ~31) + perm32(R & 31)) : R;
        voffA[i] = (unsigned)(R * g.lda + C) * 2u; voffB[i] = (unsigned)(Rb * g.ldb + C) * 2u; }
    const size_t kstep = (size_t)(BK * 2);
    const size_t hstepA = (size_t)HALF * g.lda * 2, hstepB = (size_t)HALF * g.ldb * 2;
    const unsigned ldsw = (unsigned)wid * 1024u;
    const int aoff = lds_byte(wr * 64 + fr, fq * 8), boff = lds_byte(wc * 32 + fr, fq * 8);
#define PG8_SA(b, h) (((b) * 2 + (h)) * HTB)
#define PG8_SB(b, h) ((4 + (b) * 2 + (h)) * HTB)
#define PG8_STAGE(bufoff, gbase, voff) do { _Pragma("unroll") for (int _i = 0; _i < 2; ++_i) \
        __builtin_amdgcn_global_load_lds((const unsigned*)((const char*)(gbase) + (voff)[_i]), (LAS unsigned*)(lds + (bufoff) + ldsw + _i * 8192), 16, 0, 0); } while (0)
#define PG8_LDA(dst, b, h) do { _Pragma("unroll") for (int m = 0; m < 4; ++m) _Pragma("unroll") for (int k = 0; k < 2; ++k) dst[m][k] = *(const LAS bf16x8*)(lds + PG8_SA(b, h) + aoff + m * 2048 + k * 1024); } while (0)
#define PG8_LDB(dst, b, h) do { _Pragma("unroll") for (int n = 0; n < 2; ++n) _Pragma("unroll") for (int k = 0; k < 2; ++k) dst[n][k] = *(const LAS bf16x8*)(lds + PG8_SB(b, h) + boff + n * 2048 + k * 1024); } while (0)
#define PG8_MMA(ai, bj, At, Bt) do { __builtin_amdgcn_s_setprio(1); _Pragma("unroll") for (int m = 0; m < 4; ++m) _Pragma("unroll") for (int n = 0; n < 2; ++n) _Pragma("unroll") for (int k = 0; k < 2; ++k) \
        acc[ai][bj][m][n] = __builtin_amdgcn_mfma_f32_16x16x32_bf16(Bt[n][k], At[m][k], acc[ai][bj][m][n], 0, 0, 0); __builtin_amdgcn_s_setprio(0); } while (0)
#define PG8_WAIT_V(n) asm volatile("s_waitcnt vmcnt(" #n ")" ::: "memory")
#define PG8_WAIT_L(n) asm volatile("s_waitcnt lgkmcnt(" #n ")" ::: "memory")
#define PG8_BAR __builtin_amdgcn_s_barrier()
#define PG8_SCHED __builtin_amdgcn_sched_barrier(0)
    Unit cur, nxt; int ui = 0;
    if (!S.next(0, cur)) return;
    f32x4 acc[2][2][4][2];
#pragma unroll
    for (int a = 0; a < 2; ++a)
#pragma unroll
        for (int b = 0; b < 2; ++b)
#pragma unroll
            for (int m = 0; m < 4; ++m)
#pragma unroll
                for (int n = 0; n < 2; ++n) acc[a][b][m][n] = (f32x4){0.f, 0.f, 0.f, 0.f};
    bf16x8 At[4][2], B0[2][2], B1[2][2];
    const char* cA = S.a_base(cur); const char* cB = S.b_base(cur);
    if constexpr (SP2) {
        PG8_STAGE(PG8_SB(0, 0), cB, voffB); PG8_STAGE(PG8_SB(0, 1), cB + hstepB, voffB); PG8_STAGE(PG8_SA(0, 0), cA, voffA); PG8_STAGE(PG8_SA(0, 1), cA + hstepA, voffA);
        if (wr == 1) PG8_BAR;
        PG8_WAIT_V(2); PG8_BAR;
        PG8_STAGE(PG8_SB(1, 0), cB + kstep, voffB); PG8_STAGE(PG8_SA(1, 0), cA + kstep, voffA); PG8_STAGE(PG8_SB(1, 1), cB + hstepB + kstep, voffB);
        PG8_WAIT_V(6); PG8_BAR;
    } else {
        PG8_STAGE(PG8_SB(0, 0), cB, voffB); PG8_STAGE(PG8_SA(0, 0), cA, voffA); PG8_STAGE(PG8_SB(0, 1), cB + hstepB, voffB); PG8_STAGE(PG8_SA(0, 1), cA + hstepA, voffA);
        if (wr == 1) PG8_BAR;
        PG8_WAIT_V(4); PG8_BAR;
        PG8_STAGE(PG8_SB(1, 0), cB + kstep, voffB); PG8_STAGE(PG8_SA(1, 0), cA + kstep, voffA); PG8_STAGE(PG8_SB(1, 1), cB + hstepB + kstep, voffB);
        PG8_WAIT_V(6); PG8_BAR;
    }
    for (;;) {
        const bool has_next = S.next(ui + 1, nxt);
        const char* nA = has_next ? S.a_base(nxt) : cA; const char* nB = has_next ? S.b_base(nxt) : cB;
        for (int t = 0; t < nt; t += 2) {
            const bool last = (t == nt - 2);
            const char* a1 = cA + (size_t)(t + 1) * kstep;
            const char* a2 = last ? nA : cA + (size_t)(t + 2) * kstep; const char* b2 = last ? nB : cB + (size_t)(t + 2) * kstep;
            const char* a3 = a2 + kstep; const char* b3 = b2 + kstep;
            if constexpr (SP2) {
            PG8_LDB(B0, 0, 0); PG8_LDB(B1, 0, 1); PG8_SCHED; PG8_LDA(At, 0, 0); PG8_STAGE(PG8_SA(1, 1), a1 + hstepA, voffA);
            PG8_WAIT_V(8); PG8_WAIT_L(0); PG8_BAR; PG8_MMA(0, 0, At, B0); PG8_MMA(0, 1, At, B1); PG8_BAR; PG8_SCHED;
            PG8_LDA(At, 0, 1); PG8_STAGE(PG8_SB(0, 0), b2, voffB); PG8_STAGE(PG8_SB(0, 1), b2 + hstepB, voffB); PG8_STAGE(PG8_SA(0, 0), a2, voffA);
            PG8_WAIT_V(8); PG8_WAIT_L(0); PG8_BAR; PG8_MMA(1, 0, At, B0); PG8_MMA(1, 1, At, B1); PG8_BAR; PG8_SCHED;
            PG8_LDB(B0, 1, 0); PG8_LDB(B1, 1, 1); PG8_SCHED; PG8_LDA(At, 1, 0); PG8_STAGE(PG8_SA(0, 1), a2 + hstepA, voffA);
            PG8_WAIT_V(8); PG8_WAIT_L(0); PG8_BAR; PG8_MMA(0, 0, At, B0); PG8_MMA(0, 1, At, B1); PG8_BAR; PG8_SCHED;
            PG8_LDA(At, 1, 1); PG8_STAGE(PG8_SB(1, 0), b3, voffB); PG8_STAGE(PG8_SB(1, 1), b3 + hstepB, voffB); PG8_STAGE(PG8_SA(1, 0), a3, voffA);
            PG8_WAIT_V(8); PG8_WAIT_L(0); PG8_BAR; PG8_MMA(1, 0, At, B0); PG8_MMA(1, 1, At, B1); PG8_BAR; PG8_SCHED;
            } else {
            PG8_LDB(B0, 0, 0); PG8_SCHED; PG8_LDA(At, 0, 0); PG8_STAGE(PG8_SA(1, 1), a1 + hstepA, voffA);
            PG8_WAIT_L(8); PG8_BAR; PG8_WAIT_L(0); PG8_MMA(0, 0, At, B0); PG8_BAR; PG8_SCHED;
            PG8_LDB(B1, 0, 1); PG8_STAGE(PG8_SB(0, 0), b2, voffB);
            PG8_BAR; PG8_WAIT_L(0); PG8_MMA(0, 1, At, B1); PG8_BAR;
            PG8_LDA(At, 0, 1); PG8_STAGE(PG8_SA(0, 0), a2, voffA);
            PG8_BAR; PG8_WAIT_L(0); PG8_MMA(1, 0, At, B0); PG8_BAR; PG8_SCHED;
            PG8_STAGE(PG8_SB(0, 1), b2 + hstepB, voffB);
            PG8_WAIT_V(6); PG8_BAR; PG8_MMA(1, 1, At, B1); PG8_BAR;
            PG8_LDB(B0, 1, 0); PG8_SCHED; PG8_LDA(At, 1, 0); PG8_STAGE(PG8_SA(0, 1), a2 + hstepA, voffA);
            PG8_WAIT_L(8); PG8_BAR; PG8_WAIT_L(0); PG8_MMA(0, 0, At, B0); PG8_BAR; PG8_SCHED;
            PG8_LDB(B1, 1, 1); PG8_STAGE(PG8_SB(1, 0), b3, voffB);
            PG8_BAR; PG8_WAIT_L(0); PG8_MMA(0, 1, At, B1); PG8_BAR;
            PG8_LDA(At, 1, 1); PG8_STAGE(PG8_SA(1, 0), a3, voffA);
            PG8_BAR; PG8_WAIT_L(0); PG8_MMA(1, 0, At, B0); PG8_BAR; PG8_SCHED;
            PG8_STAGE(PG8_SB(1, 1), b3 + hstepB, voffB);
            PG8_WAIT_V(6); PG8_BAR; PG8_MMA(1, 1, At, B1); PG8_BAR;
            }
        }
        if constexpr (ALIGN_EPI) { if (wr == 0) PG8_BAR; }
        { const int lane2 = my_lane();
          E(acc, cur, wid >> 2, wid & 3, lane2 & 15, lane2 >> 4); }
        if (!has_next) break;
#pragma unroll
        for (int a = 0; a < 2; ++a)
#pragma unroll
            for (int b = 0; b < 2; ++b)
#pragma unroll
                for (int m = 0; m < 4; ++m)
#pragma unroll
                    for (int n = 0; n < 2; ++n) acc[a][b][m][n] = (f32x4){0.f, 0.f, 0.f, 0.f};
        cur = nxt; cA = nA; cB = nB; ++ui;
        if constexpr (ALIGN_EPI) { if (wr == 1) PG8_BAR; }
    }
    PG8_WAIT_V(0);
    if constexpr (!ALIGN_EPI) { if (wr == 0) PG8_BAR; }
    PG8_BAR;
#undef PG8_SA
#undef PG8_SB
#undef PG8_STAGE
#undef PG8_LDA
#undef PG8_LDB
#undef PG8_MMA
#undef PG8_WAIT_V
#undef PG8_WAIT_L
#undef PG8_BAR
#undef PG8_SCHED
}
}
using pg8::Unit;

struct Args { const float* in[50]; float* out; unsigned char* ws; int ph_lo, ph_hi; };
typedef const __attribute__((address_space(4))) Args KArgs;
__device__ __forceinline__ KArgs* kargs() { KArgs* p = (KArgs*)__builtin_amdgcn_kernarg_segment_ptr(); asm volatile("" : "+s"(p)); return p; }
__device__ __forceinline__ unsigned char* launder_p(unsigned char* p) { asm volatile("" : "+s"(p)); return (unsigned char*)(GAS unsigned char*)p; }
__device__ __forceinline__ const float* kin(KArgs& A, int i) { return (const float*)(const GAS float*)A.in[i]; }
__device__ __forceinline__ float* kout(KArgs& A) { return (float*)(GAS float*)A.out; }
__device__ __forceinline__ unsigned char* kws(KArgs& A) { return (unsigned char*)(GAS unsigned char*)A.ws; }
__device__ __forceinline__ int launder_i(int v) { asm volatile("" : "+s"(v)); return v; }
__device__ __forceinline__ int launder_v(int v) { asm volatile("" : "+v"(v)); return v; }
enum { I_X = 0, I_MEM, I_LN_IN_G, I_LN_IN_B, I_W_IN, I_CONV_W, I_SG_NG, I_SG_NB, I_SG_W, I_SG_B, I_RW_MU, I_RW_W0, I_RW_WUP, I_RW_A0, I_RW_AUP, I_RW_GUP,
       I_RW_KK, I_RW_KA, I_RW_RK, I_RW_LNG, I_RW_LNB, I_S5_ARE, I_S5_AIM, I_S5_BRE, I_S5_BIM, I_S5_CRE, I_S5_CIM, I_S5_D, I_S5_LOGDT, I_S5_GLUW, I_S5_GLUB,
       I_BR_PROJ, I_GATE_B, I_W_OUT, I_LN1_G, I_LN1_B, I_XA_WQ, I_XA_WK, I_XA_WV, I_XA_WO, I_LN2_G, I_LN2_B, I_ROUTER_W, I_ROUTER_B, I_EX_W1, I_EX_B1, I_EX_W2, I_EX_B2,
       I_LN3_G, I_LN3_B };
struct Frame { LAS unsigned char* lds; volatile LAS unsigned* MISC; unsigned* ctl; unsigned char* ws; int tid, lane, wave, G, bid; };
constexpr int MI_TOFF = 16, MI_HIST = 64, MI_LBASE = 96, MI_LCUR = 128;

__device__ __forceinline__ void ln_stats(const f32x4 (&v)[4], float& mean, float& rstd) {
    float s = 0.f;
#pragma unroll
    for (int j = 0; j < 4; ++j) s += (v[j].x + v[j].y) + (v[j].z + v[j].w);
    mean = wave_sum(s) * (1.f / D); float s2 = 0.f;
#pragma unroll
    for (int j = 0; j < 4; ++j) { const f32x4 d = v[j] - mean; s2 += (d.x * d.x + d.y * d.y) + (d.z * d.z + d.w * d.w); }
    rstd = 1.0f / sqrtf(wave_sum(s2) * (1.f / D) + LN_EPS);
}
__device__ __forceinline__ void ln_apply_store(const f32x4 (&v)[4], float mean, float rstd, const float* g, const float* b, float* o32, bf16* o16, int lane) {
#pragma unroll
    for (int j = 0; j < 4; ++j) {
        const f32x4 gg = *(const f32x4*)(g + 256 * j + 4 * lane), bb = *(const f32x4*)(b + 256 * j + 4 * lane);
        const f32x4 y = (v[j] - mean) * rstd * gg + bb;
        if (o32) *(f32x4*)(o32 + 256 * j + 4 * lane) = y;
        if (o16) { v2u w; w.x = pk2(y.x, y.y); w.y = pk2(y.z, y.w); *(v2u*)(o16 + 256 * j + 4 * lane) = w; }
    }
}

__device__ __forceinline__ void transpose_item(const float* W, int K, int N, bf16* WT, int mode, LAS float* scr, int item, int lane) {
    const int nblk = N / 32, kb = item / nblk, nb = item % nblk, k0 = 64 * kb, n0 = 32 * nb;
#pragma unroll 8
    for (int i = 0; i < 32; ++i) { const int kk = 2 * i + (lane >> 5); scr[kk * 33 + (lane & 31)] = W[(size_t)(k0 + kk) * N + n0 + (lane & 31)]; }
    LDS_WAIT();
    const int c = lane & 7;
#pragma unroll
    for (int j = 0; j < 4; ++j) { const int n = (lane >> 3) + 8 * j; const LAS float* s = scr + (8 * c) * 33 + n;
        v4u o; o.x = pk2(s[0 * 33], s[1 * 33]); o.y = pk2(s[2 * 33], s[3 * 33]); o.z = pk2(s[4 * 33], s[5 * 33]); o.w = pk2(s[6 * 33], s[7 * 33]);
        const int nn = n0 + n; const int jj = nn >> 1;
        const int row = mode ? ((jj >> 7) * 256 + (nn & 1) * 128 + (jj & 127)) : nn;
        *(v4u*)(WT + (size_t)row * K + k0 + 8 * c) = o; }
    LDS_WAIT();
}
__device__ __forceinline__ void s5_setup_item(KArgs& A, const Frame& F, int item) {
    const int l = item >> 4, g = item & 15, tid = F.tid;
    LAS float* Kt = (LAS float*)F.lds;
    LAS float* Pw = (LAS float*)(F.lds + 65536);
    LAS float* Bb = (LAS float*)(F.lds + 65536 + 33280);
    LAS float* Cc = Bb + 2048;
    const float* a_re = kin(A, I_S5_ARE) + (l * 16 + g) * 64; const float* a_im = kin(A, I_S5_AIM) + (l * 16 + g) * 64;
    const float* b_re = kin(A, I_S5_BRE) + (size_t)(l * 16 + g) * 1024; const float* b_im = kin(A, I_S5_BIM) + (size_t)(l * 16 + g) * 1024;
    const float* c_re = kin(A, I_S5_CRE) + (size_t)(l * 16 + g) * 1024; const float* c_im = kin(A, I_S5_CIM) + (size_t)(l * 16 + g) * 1024;
    const float dt = expf(kin(A, I_S5_LOGDT)[l * 16 + g]);
    for (int o = tid; o < 65 * 64; o += NTHREADS) { const int n = o >> 6, p = o & 63; const float mag = expf(a_re[p] * dt * (float)n); float sn, cs; sincosf(a_im[p] * dt * (float)n, &sn, &cs);
        Pw[o * 2] = mag * cs; Pw[o * 2 + 1] = mag * sn; }
    for (int o = tid; o < 1024; o += NTHREADS) { const int p = o >> 4;
        const float are = a_re[p], aim = a_im[p], mag = expf(are * dt); float sn, cs; sincosf(aim * dt, &sn, &cs); const float abr = mag * cs, abi = mag * sn;
        const float den = are * are + aim * aim, nr = abr - 1.0f, cr = (nr * are + abi * aim) / den, ci = (abi * are - nr * aim) / den;
        const float br = b_re[o], bi = b_im[o]; Bb[o * 2] = cr * br - ci * bi; Bb[o * 2 + 1] = cr * bi + ci * br; }
    for (int o = tid; o < 1024; o += NTHREADS) { Cc[o * 2] = c_re[o]; Cc[o * 2 + 1] = c_im[o]; }
    __syncthreads();
    for (int o = tid; o < 16384; o += NTHREADS) { const int tau = o >> 8, c = (o >> 4) & 15, cp = o & 15; float acc = 0.f;
        for (int p = 0; p < 64; ++p) { const float cr = Cc[(c * 64 + p) * 2], ci = Cc[(c * 64 + p) * 2 + 1], pr = Pw[(tau * 64 + p) * 2], pi = Pw[(tau * 64 + p) * 2 + 1];
            const float er = cr * pr - ci * pi, ei = cr * pi + ci * pr; acc += er * Bb[(p * 16 + cp) * 2] - ei * Bb[(p * 16 + cp) * 2 + 1]; }
        Kt[o] = acc; }
    __syncthreads();
    bf16* Bt = (bf16*)(F.ws + WS_S5BT) + (size_t)(l * 16 + g) * 1024 * S5K;
    for (int o = tid; o < 1024 * 128; o += NTHREADS) { const int rr = o >> 7, q = o & 127, t = rr >> 4, c = rr & 15, s = q >> 1, cp0 = (q & 1) * 8;
        v4u w = {0u, 0u, 0u, 0u};
        if (s <= t) { const LAS float* k = Kt + ((t - s) * 16 + c) * 16 + cp0; w.x = pk2(k[0], k[1]); w.y = pk2(k[2], k[3]); w.z = pk2(k[4], k[5]); w.w = pk2(k[6], k[7]); }
        *(v4u*)(Bt + (size_t)rr * S5K + q * 8) = w; }
    for (int o = tid; o < 1024 * 16; o += NTHREADS) { const int rr = o >> 4, q = o & 15, t = rr >> 4, c = rr & 15; float vals[8];
#pragma unroll
        for (int j = 0; j < 4; ++j) { const int p = 4 * q + j; const float cr = Cc[(c * 64 + p) * 2], ci = Cc[(c * 64 + p) * 2 + 1], pr = Pw[((t + 1) * 64 + p) * 2], pi = Pw[((t + 1) * 64 + p) * 2 + 1];
            vals[2 * j] = cr * pr - ci * pi; vals[2 * j + 1] = -(cr * pi + ci * pr); }
        v4u w; w.x = pk2(vals[0], vals[1]); w.y = pk2(vals[2], vals[3]); w.z = pk2(vals[4], vals[5]); w.w = pk2(vals[6], vals[7]);
        *(v4u*)(Bt + (size_t)rr * S5K + 1024 + q * 8) = w; }
    bf16* Bc = (bf16*)(F.ws + WS_S5BC) + (size_t)(l * 16 + g) * 256 * 1024;
    for (int o = tid; o < 128 * 128; o += NTHREADS) { const int row = o >> 7, q = o & 127, p = row >> 1, im = row & 1, s = q >> 1, cp0 = (q & 1) * 8;
        const float pr = Pw[((63 - s) * 64 + p) * 2], pi = Pw[((63 - s) * 64 + p) * 2 + 1]; float vals[8];
#pragma unroll
        for (int j = 0; j < 8; ++j) { const float br = Bb[(p * 16 + cp0 + j) * 2], bi = Bb[(p * 16 + cp0 + j) * 2 + 1]; vals[j] = im ? (pr * bi + pi * br) : (pr * br - pi * bi); }
        v4u w; w.x = pk2(vals[0], vals[1]); w.y = pk2(vals[2], vals[3]); w.z = pk2(vals[4], vals[5]); w.w = pk2(vals[6], vals[7]);
        *(v4u*)(Bc + (size_t)row * 1024 + q * 8) = w;
        *(v4u*)(Bc + (size_t)(128 + row) * 1024 + q * 8) = (v4u){0u, 0u, 0u, 0u}; }
    __syncthreads();
}
__device__ __forceinline__ void p_prologue(KArgs& A, const Frame& F) {
    const int gw = F.bid * NWAVES + F.wave, NGW = F.G * NWAVES, lane = F.lane;
    for (int item = F.bid; item < NL * 16; item += F.G) s5_setup_item(A, F, item);
    LAS float* scr = (LAS float*)(F.lds + F.wave * 16384);
#pragma unroll 1
    for (int d = 0; d < 10; ++d) {
        const float* src; bf16* dst; int K, N, batch, mode = 0;
        switch (d) {
            case 0: src = kin(A, I_EX_W1); dst = (bf16*)(F.ws + WS_W1T); K = 1024; N = 2048; batch = NL * NE; mode = 1; break;
            case 1: src = kin(A, I_EX_W2); dst = (bf16*)(F.ws + WS_W2T); K = 1024; N = 1024; batch = NL * NE; break;
            case 2: src = kin(A, I_W_IN); dst = (bf16*)(F.ws + WS_WINT); K = 1024; N = N_IN; batch = NL; break;
            case 3: src = kin(A, I_BR_PROJ); dst = (bf16*)(F.ws + WS_BRT); K = 256; N = 1024; batch = NL * 4; break;
            case 4: src = kin(A, I_W_OUT); dst = (bf16*)(F.ws + WS_WOUTT); K = 1024; N = 1024; batch = NL; break;
            case 5: src = kin(A, I_XA_WQ); dst = (bf16*)(F.ws + WS_WQT); K = 1024; N = 1024; batch = NL; break;
            case 6: src = kin(A, I_XA_WK); dst = (bf16*)(F.ws + WS_WKT); K = 1024; N = 1024; batch = NL; break;
            case 7: src = kin(A, I_XA_WV); dst = (bf16*)(F.ws + WS_WVT); K = 1024; N = 1024; batch = NL; break;
            case 8: src = kin(A, I_XA_WO); dst = (bf16*)(F.ws + WS_WOT); K = 1024; N = 1024; batch = NL; break;
            default: src = kin(A, I_S5_GLUW); dst = (bf16*)(F.ws + WS_GLUT); K = 256; N = 256; batch = NL; break;
        }
        const int per = (K / 64) * (N / 32), nitems = per * batch;
        for (int it = gw; it < nitems; it += NGW) { const int b = it / per, r = it - b * per;
            transpose_item(src + (size_t)b * K * N, K, N, dst + (size_t)b * K * N, mode, scr, r, lane); }
    }
    { const float* mem = kin(A, I_MEM); bf16* m16 = (bf16*)(F.ws + WS_MEM16);
      for (int r = gw; r < NB * NMEM; r += NGW) {
#pragma unroll
          for (int j = 0; j < 4; ++j) { const f32x4 v = *(const f32x4*)(mem + (size_t)r * D + 256 * j + 4 * lane); v2u w; w.x = pk2(v.x, v.y); w.y = pk2(v.z, v.w); *(v2u*)(m16 + (size_t)r * D + 256 * j + 4 * lane) = w; } } }
    { const float* x = kin(A, I_X); float* h32 = (float*)(F.ws + WS_H32); bf16* h16 = (bf16*)(F.ws + WS_H16);
      for (int r = gw; r < T; r += NGW) { f32x4 v[4];
#pragma unroll
          for (int j = 0; j < 4; ++j) v[j] = *(const f32x4*)(x + (size_t)r * D + 256 * j + 4 * lane);
          float mean, rstd; ln_stats(v, mean, rstd);
          ln_apply_store(v, mean, rstd, kin(A, I_LN_IN_G), kin(A, I_LN_IN_B), h32 + (size_t)r * D, h16 + (size_t)r * D, lane); } }
}

typedef f32x4 AccT[2][2][4][2];
#define EPI_BASES KArgs& KA = *kargs(); unsigned char* ws = kws(KA); (void)ws;
__device__ __forceinline__ v4u pk8(const f32x4 a, const f32x4 b) { v4u w; w.x = pk2(a.x, a.y); w.y = pk2(a.z, a.w); w.z = pk2(b.x, b.y); w.w = pk2(b.z, b.w); return w; }
__device__ __forceinline__ void unpk8(const v4u w, f32x4& a, f32x4& b) { a.x = bf2f(w.x & 0xffffu); a.y = bf2f(w.x >> 16); a.z = bf2f(w.y & 0xffffu); a.w = bf2f(w.y >> 16); b.x = bf2f(w.z & 0xffffu); b.y = bf2f(w.z >> 16); b.z = bf2f(w.w & 0xffffu); b.w = bf2f(w.w >> 16); }
__device__ __forceinline__ f32x4 ld4bf(const bf16* p) { const v2u w = *(const v2u*)p; f32x4 a; a.x = bf2f(w.x & 0xffffu); a.y = bf2f(w.x >> 16); a.z = bf2f(w.y & 0xffffu); a.w = bf2f(w.y >> 16); return a; }
__device__ __forceinline__ f32x4 sig4(const f32x4 v) { return (f32x4){sigmoidf_(v.x), sigmoidf_(v.y), sigmoidf_(v.z), sigmoidf_(v.w)}; }
struct EpiNull { static constexpr bool PERM = false; int dummy;
    __device__ __forceinline__ void operator()(const AccT& acc, const Unit& u, int wr, int wc, int fr, int fq) const { if (u.pm < 0) { EPI_BASES *(f32x4*)(ws + WS_Z) = acc[0][0][0][0]; } } };
struct EpiIn { static constexpr bool PERM = true; int l;
    __device__ __forceinline__ void operator()(const AccT& acc, const Unit& u, int wr, int wc, int fr, int fq) const { EPI_BASES
        bf16* Z = (bf16*)(ws + WS_Z); bf16* SG = (bf16*)(ws + WS_SG); bf16* AOUT = (bf16*)(ws + WS_AOUT); const float* gate_b = kin(KA, I_GATE_B) + (size_t)l * 4096;
        if (u.pn < 10) {
            pg8::epi_foreach8(acc, u, wr, wc, fr, fq, [&](int row, int col, f32x4 v0, f32x4 v1) { const v4u w = pk8(v0, v1);
                *(v4u*)(Z + (size_t)row * ZLD + col) = w;
                if (u.pn == 9) { const int cc = col - OFF_D, g = cc >> 4, c0 = cc & 15, chunk = row >> 6, s = row & 63; *(v4u*)(AOUT + ((size_t)(g * NCHT + chunk)) * S5K + s * 16 + c0) = w; } });
        } else {
            pg8::epi_foreach8(acc, u, wr, wc, fr, fq, [&](int row, int col, f32x4 v0, f32x4 v1) {
                const int gc = col - OFF_G; const f32x4 g0 = *(const f32x4*)(gate_b + gc), g1 = *(const f32x4*)(gate_b + gc + 4);
                *(v4u*)(SG + (size_t)row * 4096 + gc) = pk8(sig4(v0 + g0), sig4(v1 + g1)); });
        }
    } };
struct EpiBranch { static constexpr bool PERM = true; int br;
    __device__ __forceinline__ void operator()(const AccT& acc, const Unit& u, int wr, int wc, int fr, int fq) const { EPI_BASES
        bf16* MG = (bf16*)(ws + WS_MG16); const bf16* SG = (const bf16*)(ws + WS_SG);
        pg8::epi_foreach8(acc, u, wr, wc, fr, fq, [&](int row, int col, f32x4 v0, f32x4 v1) {
            f32x4 s0, s1; unpk8(*(const v4u*)(SG + (size_t)row * 4096 + br * 1024 + col), s0, s1);
            f32x4 r0 = v0 * s0, r1 = v1 * s1; bf16* p = MG + (size_t)row * D + col;
            if (br > 0) { f32x4 m0, m1; unpk8(*(const v4u*)p, m0, m1); r0 += m0; r1 += m1; }
            *(v4u*)p = pk8(r0, r1); });
    } };
struct EpiResid { static constexpr bool PERM = false; int dummy;
    __device__ __forceinline__ void operator()(const AccT& acc, const Unit& u, int wr, int wc, int fr, int fq) const { EPI_BASES
        float* H = (float*)(ws + WS_H32);
        pg8::epi_foreach(acc, u, wr, wc, fr, fq, [&](int row, int col, f32x4 v) { float* p = H + (size_t)row * D + col; const f32x4 h = *(const f32x4*)p; *(f32x4*)p = h * DN_ALPHA + v; });
    } };
struct EpiBf16 { static constexpr bool PERM = true; unsigned off_mib; float scale;
    __device__ __forceinline__ void operator()(const AccT& acc, const Unit& u, int wr, int wc, int fr, int fq) const { EPI_BASES
        bf16* O = (bf16*)(ws + (size_t)off_mib * MiB);
        pg8::epi_foreach8(acc, u, wr, wc, fr, fq, [&](int row, int col, f32x4 v0, f32x4 v1) { *(v4u*)(O + (size_t)row * D + col) = pk8(v0 * scale, v1 * scale); });
    } };
struct EpiVT { static constexpr bool PERM = false; int dummy;
    __device__ __forceinline__ void operator()(const AccT& acc, const Unit& u, int wr, int wc, int fr, int fq) const { EPI_BASES
        bf16* VT = (bf16*)(ws + WS_VMT16);
        pg8::epi_foreach(acc, u, wr, wc, fr, fq, [&](int row, int col, f32x4 v) { const int b = row >> 8, m = row & 255; bf16* p = VT + ((size_t)(b * D + col)) * NMEM + m;
            p[0] = (bf16)f2bf(v.x); p[NMEM] = (bf16)f2bf(v.y); p[2 * NMEM] = (bf16)f2bf(v.z); p[3 * NMEM] = (bf16)f2bf(v.w); });
    } };
struct EpiXloc { static constexpr bool PERM = false; int dummy;
    __device__ __forceinline__ void operator()(const AccT& acc, const Unit& u, int wr, int wc, int fr, int fq) const { EPI_BASES
        float* X = (float*)(ws + WS_XLOC);
        pg8::epi_foreach(acc, u, wr, wc, fr, fq, [&](int row, int col, f32x4 v) { if (col < 128) *(f32x4*)(X + ((size_t)(u.e * NCHT + row)) * 128 + col) = v; });
    } };
__device__ __forceinline__ float gelu_tanh(float x) { const float u = 0.7978845608028654f * (x + 0.044715f * x * x * x); const float e = __expf(2.0f * u); const float th = 1.0f - 2.0f / (e + 1.0f); return 0.5f * x * (1.0f + th); }
__device__ __forceinline__ f32x4 gelu4(const f32x4 v) { return (f32x4){gelu_tanh(v.x), gelu_tanh(v.y), gelu_tanh(v.z), gelu_tanh(v.w)}; }
struct EpiS5Y { static constexpr bool PERM = true; int l;
    __device__ __forceinline__ void operator()(const AccT& acc, const Unit& u, int wr, int wc, int fr, int fq) const { EPI_BASES
        bf16* YD = (bf16*)(ws + WS_YD16); const bf16* AOUT = (const bf16*)(ws + WS_AOUT); const float* dvec = kin(KA, I_S5_D) + l * 256;
        pg8::epi_foreach8(acc, u, wr, wc, fr, fq, [&](int row, int col, f32x4 v0, f32x4 v1) { const int t = col >> 4, c0 = col & 15, tok = row * CH + t, ch = u.e * 16 + c0;
            f32x4 u0, u1; unpk8(*(const v4u*)(AOUT + ((size_t)(u.e * NCHT + row)) * S5K + t * 16 + c0), u0, u1);
            const f32x4 d0 = *(const f32x4*)(dvec + ch), d1 = *(const f32x4*)(dvec + ch + 4);
            *(v4u*)(YD + (size_t)tok * 256 + ch) = pk8(gelu4(v0 + d0 * u0), gelu4(v1 + d1 * u1)); });
    } };
struct EpiGlu { static constexpr bool PERM = true; int l;
    __device__ __forceinline__ void operator()(const AccT& acc, const Unit& u, int wr, int wc, int fr, int fq) const { EPI_BASES
        bf16* O = (bf16*)(ws + WS_O16); const bf16* YD = (const bf16*)(ws + WS_YD16); const float* gb = kin(KA, I_S5_GLUB) + l * 256;
        pg8::epi_foreach8(acc, u, wr, wc, fr, fq, [&](int row, int col, f32x4 v0, f32x4 v1) { f32x4 y0, y1; unpk8(*(const v4u*)(YD + (size_t)row * 256 + col), y0, y1);
            const f32x4 b0 = *(const f32x4*)(gb + col), b1 = *(const f32x4*)(gb + col + 4);
            *(v4u*)(O + (size_t)row * D + 768 + col) = pk8(y0 * sig4(v0 + b0), y1 * sig4(v1 + b1)); });
    } };
__device__ __forceinline__ float swiglu(float g, float u) { g = fminf(g, 7.0f); u = fminf(fmaxf(u, -7.0f), 7.0f); return (u + 1.0f) * g * sigmoidf_(1.702f * g); }
struct EpiSwiglu { static constexpr bool PERM = true; int l;
    __device__ __forceinline__ void operator()(const AccT& acc, const Unit& u, int wr, int wc, int fr, int fq) const { EPI_BASES
        bf16* ACT = (bf16*)(ws + WS_ACT); const float* bb = kin(KA, I_EX_B1) + (size_t)(l * NE + u.e) * 2048;
#pragma unroll
        for (int ai = 0; ai < 2; ++ai)
#pragma unroll
            for (int m = 0; m < 4; ++m) { const int row = u.pm * 256 + ai * 128 + wr * 64 + m * 16 + fr; const int j = u.pn * 128 + wc * 32 + 8 * fq;
                f32x4 o[2];
#pragma unroll
                for (int n = 0; n < 2; ++n) { const f32x4 b0 = *(const f32x4*)(bb + 2 * (j + 4 * n)), b1v = *(const f32x4*)(bb + 2 * (j + 4 * n) + 4);
                    const f32x4 g = acc[ai][0][m][n], uu = acc[ai][1][m][n];
                    o[n] = (f32x4){swiglu(g.x + b0.x, uu.x + b0.y), swiglu(g.y + b0.z, uu.y + b0.w), swiglu(g.z + b1v.x, uu.z + b1v.y), swiglu(g.w + b1v.z, uu.w + b1v.w)}; }
                *(v4u*)(ACT + (size_t)row * DFF + j) = pk8(o[0], o[1]);
                if (m == 3) __builtin_amdgcn_sched_barrier(0); }
    } };
struct EpiMoeOut { static constexpr bool PERM = true; int l;
    __device__ __forceinline__ void operator()(const AccT& acc, const Unit& u, int wr, int wc, int fr, int fq) const { EPI_BASES
        bf16* YS = (bf16*)(ws + WS_YS); const float* SLOTW = (const float*)(ws + WS_SLOTW); const float* bb = kin(KA, I_EX_B2) + (size_t)(l * NE + u.e) * D;
        pg8::epi_foreach8(acc, u, wr, wc, fr, fq, [&](int row, int col, f32x4 v0, f32x4 v1) { const float sw = SLOTW[row]; const f32x4 b0 = *(const f32x4*)(bb + col), b1 = *(const f32x4*)(bb + col + 4);
            *(v4u*)(YS + (size_t)row * D + col) = pk8((v0 + b0) * sw, (v1 + b1) * sw); });
    } };

__device__ __forceinline__ void p_mix1(KArgs& A, const Frame& F, int l) {
    const int gw = F.bid * NWAVES + F.wave, NGW = F.G * NWAVES, lane = F.lane, tid = F.tid;
    const bf16* Z = (const bf16*)(F.ws + WS_Z); bf16* O16 = (bf16*)(F.ws + WS_O16);
    for (int rp_ = 0; rp_ < ((PROBE_PHASE == 101) ? PROBE_REPS : 1); ++rp_) { const float* cw = kin(A, I_CONV_W) + l * 3 * 256; const f32x4 w0 = *(const f32x4*)(cw + 4 * lane), w1 = *(const f32x4*)(cw + 256 + 4 * lane), w2 = *(const f32x4*)(cw + 512 + 4 * lane);
      for (int t = gw; t < T; t += NGW) { const int s = t & (SEQ - 1); const bf16* zr = Z + (size_t)t * ZLD + 4 * lane;
          const f32x4 bg = ld4bf(zr); f32x4 y = w2 * (ld4bf(zr + 256) * ld4bf(zr + 512));
          if (s >= 1) y += w1 * (ld4bf(zr - ZLD + 256) * ld4bf(zr - ZLD + 512));
          if (s >= 2) y += w0 * (ld4bf(zr - 2 * ZLD + 256) * ld4bf(zr - 2 * ZLD + 512));
          y = y * bg; v2u w; w.x = pk2(y.x, y.y); w.y = pk2(y.z, y.w); *(v2u*)(O16 + (size_t)t * D + 4 * lane) = w; } }
    for (int rp_ = 0; rp_ < ((PROBE_PHASE == 102) ? PROBE_REPS : 1); ++rp_) { LAS float* VN = (LAS float*)F.lds;
      const float* ng = kin(A, I_SG_NG) + l * 256; const float* nb = kin(A, I_SG_NB) + l * 256;
      for (int blk = F.bid; blk < T / 128; blk += F.G) {
          const f32x4 gg = *(const f32x4*)(ng + 4 * lane), bb = *(const f32x4*)(nb + 4 * lane);
          for (int r = F.wave; r < 128; r += NWAVES) { const int t = blk * 128 + r; const f32x4 v = ld4bf(Z + (size_t)t * ZLD + OFF_B + 256 + 4 * lane);
              const float mean = wave_sum((v.x + v.y) + (v.z + v.w)) * (1.f / 256); const f32x4 d = v - mean;
              const float var = wave_sum((d.x * d.x + d.y * d.y) + (d.z * d.z + d.w * d.w)) * (1.f / 256); const float rstd = 1.0f / sqrtf(var + LN_EPS);
              *(LAS f32x4*)(VN + r * 256 + 4 * lane) = d * rstd * gg + bb; }
          __syncthreads();
          const int i = tid >> 2, cq = tid & 3, t = blk * 128 + i, jmax = (i < 64) ? 64 : 128;
#pragma unroll 1
          for (int g = 0; g < 4; ++g) { f32x4 a0 = {0, 0, 0, 0}, a1 = a0, a2 = a0, a3 = a0;
              const float* wrow = kin(A, I_SG_W) + ((size_t)((l * 4 + g) * 128 + i)) * 128; const LAS float* vb = VN + g * 64 + cq * 16;
              for (int j = 0; j < jmax; j += 4) { const f32x4 w4 = *(const f32x4*)(wrow + j);
#pragma unroll
                  for (int jj = 0; jj < 4; ++jj) { const LAS f32x4* vp = (const LAS f32x4*)(vb + (j + jj) * 256); const float w = w4[jj];
                      a0 += vp[0] * w; a1 += vp[1] * w; a2 += vp[2] * w; a3 += vp[3] * w; } }
              const float bias = kin(A, I_SG_B)[(l * 4 + g) * 128 + i]; const bf16* up = Z + (size_t)t * ZLD + OFF_B + g * 64 + cq * 16;
              const f32x4 o0 = ld4bf(up) * (a0 + bias), o1 = ld4bf(up + 4) * (a1 + bias), o2 = ld4bf(up + 8) * (a2 + bias), o3 = ld4bf(up + 12) * (a3 + bias);
              v4u wa, wb; wa.x = pk2(o0.x, o0.y); wa.y = pk2(o0.z, o0.w); wa.z = pk2(o1.x, o1.y); wa.w = pk2(o1.z, o1.w); wb.x = pk2(o2.x, o2.y); wb.y = pk2(o2.z, o2.w); wb.z = pk2(o3.x, o3.y); wb.w = pk2(o3.z, o3.w);
              bf16* op = O16 + (size_t)t * D + 256 + g * 64 + cq * 16; *(v4u*)op = wa; *(v4u*)(op + 8) = wb; }
          __syncthreads();
      } }
    for (int rp_ = 0; rp_ < ((PROBE_PHASE == 103) ? PROBE_REPS : 1); ++rp_) { LAS float* xin = (LAS float*)(F.lds + F.wave * 8192);
      float* RWOP = (float*)(F.ws + WS_RWOP); float* RWG = (float*)(F.ws + WS_RWG); float* RK = (float*)(F.ws + WS_RK);
      const float* mu = kin(A, I_RW_MU) + l * 1024; const float* wup = kin(A, I_RW_WUP) + (size_t)l * 64 * 256; const float* aup = kin(A, I_RW_AUP) + (size_t)l * 64 * 256; const float* gup = kin(A, I_RW_GUP) + (size_t)l * 128 * 256;
      const int c4 = 4 * lane, head = lane >> 4;
      const f32x4 w0v = *(const f32x4*)(kin(A, I_RW_W0) + l * 256 + c4), a0v = *(const f32x4*)(kin(A, I_RW_A0) + l * 256 + c4), kkv = *(const f32x4*)(kin(A, I_RW_KK) + l * 256 + c4),
                  kav = *(const f32x4*)(kin(A, I_RW_KA) + l * 256 + c4), rkv = *(const f32x4*)(kin(A, I_RW_RK) + l * 256 + c4);
      const f32x4 mul = *(const f32x4*)(mu + 768 + c4), mur = *(const f32x4*)(mu + c4), muk = *(const f32x4*)(mu + 256 + c4), muv = *(const f32x4*)(mu + 512 + c4);
      for (int grp = gw; grp < T / 8; grp += NGW) { const int t0 = grp * 8;
#pragma unroll
          for (int tk = 0; tk < 8; ++tk) { const int t = t0 + tk, s = t & (SEQ - 1); const bf16* zr = Z + (size_t)t * ZLD + OFF_C + 768 + c4;
              f32x4 x = ld4bf(zr); f32x4 pv = {0, 0, 0, 0}; if (s > 0) pv = ld4bf(zr - ZLD); x = x + (pv - x) * mul;
              if (lane < 16) { x.x = tanhf(x.x); x.y = tanhf(x.y); x.z = tanhf(x.z); x.w = tanhf(x.w); }
              else if (lane >= 32) { x.x = sigmoidf_(x.x); x.y = sigmoidf_(x.y); x.z = sigmoidf_(x.z); x.w = sigmoidf_(x.w); }
              *(LAS f32x4*)(xin + tk * 256 + c4) = x; }
          LDS_WAIT();
          f32x4 dec[8], av[8];
          { f32x4 acc[8];
#pragma unroll
            for (int tk = 0; tk < 8; ++tk) acc[tk] = (f32x4){0, 0, 0, 0};
#pragma unroll 2
            for (int i = 0; i < 64; i += 4) { const f32x4 wa = *(const f32x4*)(wup + (size_t)(i + 0) * 256 + c4), wb = *(const f32x4*)(wup + (size_t)(i + 1) * 256 + c4), wc = *(const f32x4*)(wup + (size_t)(i + 2) * 256 + c4), wd = *(const f32x4*)(wup + (size_t)(i + 3) * 256 + c4);
#pragma unroll
                for (int tk = 0; tk < 8; ++tk) { const f32x4 xi = *(const LAS f32x4*)(xin + tk * 256 + i); acc[tk] += wa * xi.x + wb * xi.y + wc * xi.z + wd * xi.w; } }
#pragma unroll
            for (int tk = 0; tk < 8; ++tk) { const f32x4 wp = w0v + acc[tk];
#pragma unroll
                for (int e = 0; e < 4; ++e) { const float sp = log1pf(__expf(-wp[e])); const float w = -sp - 0.5f; dec[tk][e] = __expf(-__expf(w)); } } }
          { f32x4 acc[8];
#pragma unroll
            for (int tk = 0; tk < 8; ++tk) acc[tk] = (f32x4){0, 0, 0, 0};
#pragma unroll 2
            for (int i = 0; i < 64; i += 4) { const f32x4 wa = *(const f32x4*)(aup + (size_t)(i + 0) * 256 + c4), wb = *(const f32x4*)(aup + (size_t)(i + 1) * 256 + c4), wc = *(const f32x4*)(aup + (size_t)(i + 2) * 256 + c4), wd = *(const f32x4*)(aup + (size_t)(i + 3) * 256 + c4);
#pragma unroll
                for (int tk = 0; tk < 8; ++tk) { const f32x4 xi = *(const LAS f32x4*)(xin + tk * 256 + 64 + i); acc[tk] += wa * xi.x + wb * xi.y + wc * xi.z + wd * xi.w; } }
#pragma unroll
            for (int tk = 0; tk < 8; ++tk) { const f32x4 ap = a0v + acc[tk]; av[tk] = (f32x4){sigmoidf_(ap.x), sigmoidf_(ap.y), sigmoidf_(ap.z), sigmoidf_(ap.w)}; } }
          { f32x4 acc[8];
#pragma unroll
            for (int tk = 0; tk < 8; ++tk) acc[tk] = (f32x4){0, 0, 0, 0};
#pragma unroll 2
            for (int i = 0; i < 128; i += 4) { const f32x4 wa = *(const f32x4*)(gup + (size_t)(i + 0) * 256 + c4), wb = *(const f32x4*)(gup + (size_t)(i + 1) * 256 + c4), wc = *(const f32x4*)(gup + (size_t)(i + 2) * 256 + c4), wd = *(const f32x4*)(gup + (size_t)(i + 3) * 256 + c4);
#pragma unroll
                for (int tk = 0; tk < 8; ++tk) { const f32x4 xi = *(const LAS f32x4*)(xin + tk * 256 + 128 + i); acc[tk] += wa * xi.x + wb * xi.y + wc * xi.z + wd * xi.w; } }
#pragma unroll
            for (int tk = 0; tk < 8; ++tk) *(f32x4*)(RWG + (size_t)(t0 + tk) * 256 + c4) = acc[tk]; }
#pragma unroll
          for (int tk = 0; tk < 8; ++tk) { const int t = t0 + tk, s = t & (SEQ - 1), b = t >> 13; const bf16* zr = Z + (size_t)t * ZLD + OFF_C + c4;
              f32x4 r = ld4bf(zr), k = ld4bf(zr + 256), v = ld4bf(zr + 512);
              f32x4 pr = {0, 0, 0, 0}, pk = pr, pvv = pr; if (s > 0) { pr = ld4bf(zr - ZLD); pk = ld4bf(zr - ZLD + 256); pvv = ld4bf(zr - ZLD + 512); }
              r = r + (pr - r) * mur; k = k + (pk - k) * muk; v = v + (pvv - v) * muv;
              const f32x4 a = av[tk]; f32x4 kk = k * kkv; const f32x4 k2 = k * (1.0f + (a - 1.0f) * kav);
              float ss = (kk.x * kk.x + kk.y * kk.y) + (kk.z * kk.z + kk.w * kk.w); float rk = (r.x * k2.x * rkv.x + r.y * k2.y * rkv.y) + (r.z * k2.z * rkv.z + r.w * k2.w * rkv.w);
#pragma unroll
              for (int o = 1; o < 16; o <<= 1) { ss += shfl_xor_l(ss, o, lane); rk += shfl_xor_l(rk, o, lane); }
              const float inv = 1.0f / fmaxf(sqrtf(ss), 1e-12f); kk = kk * inv;
              float* op = RWOP + ((size_t)((b * 4 + head) * SEQ + s)) * 384 + (lane & 15) * 4;
              *(f32x4*)(op) = -kk; *(f32x4*)(op + 64) = dec[tk]; *(f32x4*)(op + 128) = kk * a; *(f32x4*)(op + 192) = r; *(f32x4*)(op + 256) = k2; *(f32x4*)(op + 320) = v;
              if ((lane & 15) == 0) RK[(size_t)t * 4 + head] = rk; }
          LDS_WAIT();
      } }
}

__device__ __forceinline__ void p_rw_chunks(const Frame& F) {
    const int gw = F.bid * NWAVES + F.wave, NGW = F.G * NWAVES, lane = F.lane;
    const float* RWOP = (const float*)(F.ws + WS_RWOP); float* QH = (float*)(F.ws + WS_QH); float* YL = (float*)(F.ws + WS_YL); float* GC = (float*)(F.ws + WS_GC); float* HC = (float*)(F.ws + WS_HC);
    LAS float* wl = (LAS float*)(F.lds + F.wave * 16384);
    for (int task = gw; task < 16 * NCH; task += NGW) { const int bh = task / NCH, ck = task % NCH;
        float sp[64], sl[64];
        { const int ln = launder_v(lane);
#pragma unroll
          for (int k = 0; k < 64; ++k) { sp[k] = (k == ln) ? 1.0f : 0.0f; sl[k] = 0.0f; } }
        const float* src = RWOP + ((size_t)(bh * SEQ + ck * CH)) * 384;
#pragma unroll 1
        for (int sb = 0; sb < CH / 8; ++sb) {
            const f32x4* gsrc = (const f32x4*)(src + (size_t)sb * 8 * 384) + lane; LAS f32x4* ldst = (LAS f32x4*)wl + lane;
#pragma unroll
            for (int i = 0; i < 12; ++i) ldst[i * 64] = gsrc[i * 64];
            LDS_WAIT();
#pragma unroll 1
            for (int st = 0; st < 8; ++st) { const LAS f32x4* base = (const LAS f32x4*)(wl + st * 384);
                float saP = 0.f, saL = 0.f;
#pragma unroll
                for (int q = 0; q < 16; ++q) { const f32x4 nk = base[q];
                    saP += sp[4 * q] * nk.x; saP += sp[4 * q + 1] * nk.y; saP += sp[4 * q + 2] * nk.z; saP += sp[4 * q + 3] * nk.w;
                    saL += sl[4 * q] * nk.x; saL += sl[4 * q + 1] * nk.y; saL += sl[4 * q + 2] * nk.z; saL += sl[4 * q + 3] * nk.w;
                    if ((q & 3) == 3) __builtin_amdgcn_sched_barrier(0); }
                const float vj = wl[st * 384 + 320 + lane];
                float yP = 0.f, yL = 0.f;
                f32x4 w = base[16], b = base[32], r = base[48], kv = base[64];
#pragma unroll
                for (int q = 0; q < 16; ++q) { f32x4 wn = w, bn = b, rn = r, kn = kv;
                    if (q < 15) { wn = base[16 + q + 1]; bn = base[32 + q + 1]; rn = base[48 + q + 1]; kn = base[64 + q + 1]; }
#pragma unroll
                    for (int e = 0; e < 4; ++e) { const int k = 4 * q + e;
                        sp[k] = sp[k] * w[e] + saP * b[e]; sl[k] = sl[k] * w[e] + saL * b[e] + vj * kv[e];
                        yP += sp[k] * r[e]; yL += sl[k] * r[e]; }
                    __builtin_amdgcn_sched_barrier(0);
                    w = wn; b = bn; r = rn; kv = kn; }
                const size_t oi = ((size_t)(bh * SEQ + ck * CH + sb * 8 + st)) * 64 + lane;
                QH[oi] = yP; YL[oi] = yL; }
        }
        float* gp = GC + ((size_t)(bh * NCH + ck) * 64 + lane) * 64; float* hp = HC + ((size_t)(bh * NCH + ck) * 64 + lane) * 64;
#pragma unroll
        for (int q = 0; q < 16; ++q) { *(f32x4*)(gp + 4 * q) = (f32x4){sp[4 * q], sp[4 * q + 1], sp[4 * q + 2], sp[4 * q + 3]}; *(f32x4*)(hp + 4 * q) = (f32x4){sl[4 * q], sl[4 * q + 1], sl[4 * q + 2], sl[4 * q + 3]}; }
    }
}
__device__ __forceinline__ void p_s5_chain(KArgs& A, const Frame& F, int l) {
    const int gt = F.bid * NTHREADS + F.tid; if (gt >= NB * 16 * 64) return;
    const int b = gt >> 10, g = (gt >> 6) & 15, p = gt & 63;
    const float dt = expf(kin(A, I_S5_LOGDT)[l * 16 + g]); const float are = kin(A, I_S5_ARE)[(l * 16 + g) * 64 + p], aim = kin(A, I_S5_AIM)[(l * 16 + g) * 64 + p];
    const float mag = expf(are * dt * 64.0f); float sn, cs; sincosf(aim * dt * 64.0f, &sn, &cs); const float ar = mag * cs, ai = mag * sn;
    bf16* AO = (bf16*)(F.ws + WS_AOUT); const float* XL = (const float*)(F.ws + WS_XLOC);
    float xr = 0.f, xi = 0.f;
#pragma unroll 8
    for (int c = 0; c < NCH; ++c) { const size_t row = (size_t)g * NCHT + b * NCH + c;
        *(unsigned*)(AO + row * S5K + 1024 + 2 * p) = pk2(xr, xi);
        const f32x2 xl = *(const f32x2*)(XL + row * 128 + 2 * p);
        const float nr = ar * xr - ai * xi + xl.x, ni = ar * xi + ai * xr + xl.y; xr = nr; xi = ni; }
}
constexpr int CB = 8, NBLK = NCH / CB;
__device__ __forceinline__ void chain_load_g(const float* G, float (&ga)[64], int fr, int fq) {
#pragma unroll
    for (int jr = 0; jr < 16; ++jr)
#pragma unroll
        for (int mt = 0; mt < 4; ++mt) ga[jr * 4 + mt] = G[(size_t)((jr >> 2) * 16 + 4 * fq + (jr & 3)) * 64 + 16 * mt + fr];
}
__device__ __forceinline__ void chain_step(f32x4 (&acc)[4], const float (&ga)[64], const f32x4 (&ci)[4]) {
    f32x4 na[4] = {ci[0], ci[1], ci[2], ci[3]};
#pragma unroll
    for (int jr = 0; jr < 16; ++jr)
#pragma unroll
        for (int mt = 0; mt < 4; ++mt) na[mt] = __builtin_amdgcn_mfma_f32_16x16x4f32(ga[jr * 4 + mt], acc[jr >> 2][jr & 3], na[mt], 0, 0, 0);
#pragma unroll
    for (int mt = 0; mt < 4; ++mt) acc[mt] = na[mt];
}
__device__ __forceinline__ void chain_load_tile(const float* M, int rb, f32x4 (&t)[4], int fr, int fq) {
#pragma unroll
    for (int jt = 0; jt < 4; ++jt) t[jt] = *(const f32x4*)(M + (size_t)(16 * rb + fr) * 64 + 16 * jt + 4 * fq);
}
__device__ __forceinline__ void chain_store_tile(float* M, int rb, const f32x4 (&t)[4], int fr, int fq) {
#pragma unroll
    for (int jt = 0; jt < 4; ++jt) *(f32x4*)(M + (size_t)(16 * rb + fr) * 64 + 16 * jt + 4 * fq) = t[jt];
}
__device__ __forceinline__ void p_chain_compose(const Frame& F) {
    const int gw = F.bid * NWAVES + F.wave, NGW = F.G * NWAVES, ln_ = my_lane(), fr = ln_ & 15, fq = ln_ >> 4;
    const float* GC = (const float*)(F.ws + WS_GC); const float* HC = (const float*)(F.ws + WS_HC); float* GB = (float*)(F.ws + WS_GB); float* HB = (float*)(F.ws + WS_HB);
    for (int task = gw; task < 16 * NBLK * 8; task += NGW) { const int cb = task & 7, bb = task >> 3, rb = cb & 3; const bool isH = cb >= 4;
        const size_t c0 = (size_t)bb * CB;
        f32x4 acc[4]; chain_load_tile((isH ? HC : GC) + c0 * 4096, rb, acc, fr, fq);
        float ga[64]; chain_load_g(GC + (c0 + 1) * 4096, ga, fr, fq);
#pragma unroll 1
        for (int i = 1; i < CB; ++i) { f32x4 ci[4] = {{0, 0, 0, 0}, {0, 0, 0, 0}, {0, 0, 0, 0}, {0, 0, 0, 0}};
            if (isH) chain_load_tile(HC + (c0 + i) * 4096, rb, ci, fr, fq);
            float gn[64];
            if (i + 1 < CB) chain_load_g(GC + (c0 + i + 1) * 4096, gn, fr, fq);
            chain_step(acc, ga, ci);
            if (i + 1 < CB) {
#pragma unroll
                for (int k = 0; k < 64; ++k) ga[k] = gn[k]; } }
        chain_store_tile((isH ? HB : GB) + (size_t)bb * 4096, rb, acc, fr, fq);
    }
}
__device__ __forceinline__ void p_chain_blocks(const Frame& F, int gw, int NGW) {
    const int ln_ = my_lane(), fr = ln_ & 15, fq = ln_ >> 4;
    const float* GB = (const float*)(F.ws + WS_GB); const float* HB = (const float*)(F.ws + WS_HB); float* SB = (float*)(F.ws + WS_SB);
    for (int task = gw; task < 16 * 4; task += NGW) { const int vb = task & 3, bh = task >> 2;
        f32x4 acc[4] = {{0, 0, 0, 0}, {0, 0, 0, 0}, {0, 0, 0, 0}, {0, 0, 0, 0}};
        float ga[64]; chain_load_g(GB + (size_t)bh * NBLK * 4096, ga, fr, fq);
#pragma unroll 1
        for (int blk = 0; blk < NBLK; ++blk) { const size_t bb = (size_t)bh * NBLK + blk;
            chain_store_tile(SB + bb * 4096, vb, acc, fr, fq);
            if (blk + 1 == NBLK) break;
            f32x4 ci[4]; chain_load_tile(HB + bb * 4096, vb, ci, fr, fq);
            float gn[64]; chain_load_g(GB + (bb + 1) * 4096, gn, fr, fq);
            chain_step(acc, ga, ci);
#pragma unroll
            for (int k = 0; k < 64; ++k) ga[k] = gn[k]; }
    }
}
__device__ __forceinline__ void chain_inblock(const Frame& F, int bb, int vb) {
    const int ln_ = my_lane(), fr = ln_ & 15, fq = ln_ >> 4;
    const float* GC = (const float*)(F.ws + WS_GC); const float* HC = (const float*)(F.ws + WS_HC); const float* SB = (const float*)(F.ws + WS_SB); float* SC = (float*)(F.ws + WS_SC);
    const size_t c0 = (size_t)bb * CB;
    f32x4 acc[4]; chain_load_tile(SB + (size_t)bb * 4096, vb, acc, fr, fq);
    float ga[64]; chain_load_g(GC + c0 * 4096, ga, fr, fq);
#pragma unroll 1
    for (int i = 0; i < CB; ++i) {
        chain_store_tile(SC + (c0 + i) * 4096, vb, acc, fr, fq);
        if (i + 1 == CB) break;
        f32x4 ci[4]; chain_load_tile(HC + (c0 + i) * 4096, vb, ci, fr, fq);
        float gn[64]; chain_load_g(GC + (c0 + i + 1) * 4096, gn, fr, fq);
        chain_step(acc, ga, ci);
#pragma unroll
        for (int k = 0; k < 64; ++k) ga[k] = gn[k]; }
}
__device__ __forceinline__ void rw_out_task(KArgs& A, const Frame& F, int l, int task) {
    const int lane = F.lane;
    const float* RWOP = (const float*)(F.ws + WS_RWOP); const float* QH = (const float*)(F.ws + WS_QH); const float* YL = (const float*)(F.ws + WS_YL); const float* SC = (const float*)(F.ws + WS_SC);
    const float* RWG = (const float*)(F.ws + WS_RWG); const float* RK = (const float*)(F.ws + WS_RK); bf16* O16 = (bf16*)(F.ws + WS_O16);
    LAS float* Qw = (LAS float*)(F.lds + F.wave * 16384);
    { const int bh = task / NCH, ck = task % NCH, b = bh >> 2, head = bh & 3;
        const size_t ti0 = (size_t)(bh * SEQ + ck * CH); const int t0g = b * SEQ + ck * CH;
        { const f32x4* qsrc = (const f32x4*)(QH + ti0 * 64) + lane; LAS f32x4* qdst = (LAS f32x4*)Qw + lane;
#pragma unroll
          for (int i = 0; i < 16; ++i) qdst[i * 64] = qsrc[i * 64]; }
        float srow[64];
        { const f32x4* ssrc = (const f32x4*)(SC + (size_t)(bh * NCH + ck) * 4096 + lane * 64);
#pragma unroll
          for (int i = 0; i < 16; ++i) { const f32x4 x = ssrc[i]; srow[4 * i] = x.x; srow[4 * i + 1] = x.y; srow[4 * i + 2] = x.z; srow[4 * i + 3] = x.w; } }
        const float lgv = kin(A, I_RW_LNG)[l * 256 + head * 64 + lane], lbv = kin(A, I_RW_LNB)[l * 256 + head * 64 + lane];
        LDS_WAIT();
#pragma unroll 1
        for (int tb = 0; tb < CH; tb += 4) { float y[4], s1[4], s2[4];
#pragma unroll
            for (int u = 0; u < 4; ++u) { const int t = tb + u; float a = YL[(ti0 + t) * 64 + lane]; const LAS f32x4* qp = (const LAS f32x4*)(Qw + t * 64);
#pragma unroll
                for (int i = 0; i < 16; ++i) { const f32x4 qv = qp[i]; a += srow[4 * i] * qv.x; a += srow[4 * i + 1] * qv.y; a += srow[4 * i + 2] * qv.z; a += srow[4 * i + 3] * qv.w; }
                y[u] = a; s1[u] = a; s2[u] = a * a; }
#pragma unroll
            for (int o = 1; o < 64; o <<= 1) {
#pragma unroll
                for (int u = 0; u < 4; ++u) { s1[u] += shfl_xor_l(s1[u], o, lane); s2[u] += shfl_xor_l(s2[u], o, lane); } }
#pragma unroll
            for (int u = 0; u < 4; ++u) { const int t = tb + u; const float m = s1[u] * (1.f / 64), var = fmaxf(s2[u] * (1.f / 64) - m * m, 0.f); const float rstd = 1.0f / sqrtf(var + RW_LN_EPS);
                const float rk = RK[(size_t)(t0g + t) * 4 + head]; const float vv = RWOP[(ti0 + t) * 384 + 320 + lane]; const float gg = RWG[(size_t)(t0g + t) * 256 + head * 64 + lane];
                const float o = ((y[u] - m) * rstd * lgv + lbv + rk * vv) * gg;
                O16[(size_t)(t0g + t) * D + 512 + head * 64 + lane] = (bf16)f2bf(o); }
        }
        LDS_WAIT();
    }
}
template <int LSTRIDE> __device__ __forceinline__ void attn_stage(LAS unsigned char* lds, const bf16* src, size_t row_stride, int tid) {
    const int r0 = tid >> 5, c = tid & 31; const bf16* sp = src + (size_t)r0 * row_stride + c * 8; LAS unsigned char* dp = lds + r0 * LSTRIDE + c * 16;
#pragma unroll 4
    for (int i = 0; i < 16; ++i) { const v4u v = *(const v4u*)(sp + (size_t)(16 * i) * row_stride); *(LAS v4u*)(dp + 16 * i * LSTRIDE) = v; }
}
constexpr int KSTR = 544, VSTR = 528;
__device__ __forceinline__ void p_attn(const Frame& F) {
    const int lane = F.lane, fr = lane & 15, fq = lane >> 4;
    const bf16* Q = (const bf16*)(F.ws + WS_Q16); const bf16* KM = (const bf16*)(F.ws + WS_KM16); const bf16* VT = (const bf16*)(F.ws + WS_VMT16); bf16* AO = (bf16*)(F.ws + WS_AO16);
    for (int item = F.bid; item < NB * 4 * (SEQ / 256); item += F.G) {
        const int qg = item % (SEQ / 256), bhd = item / (SEQ / 256), head = bhd & 3, b = bhd >> 2;
        attn_stage<KSTR>(F.lds, KM + (size_t)(b * NMEM) * D + head * 256, D, F.tid);
        __syncthreads();
        v4u pf[2][8]; float inv[2];
#pragma unroll
        for (int u = 0; u < 2; ++u) { const int q0 = b * SEQ + qg * 256 + u * 128 + F.wave * 16;
            bf16x8 qf[8];
#pragma unroll
            for (int ks = 0; ks < 8; ++ks) qf[ks] = *(const bf16x8*)(Q + (size_t)(q0 + fr) * D + head * 256 + ks * 32 + fq * 8);
            f32x4 sT[16];
            const LAS unsigned char* kbase = F.lds + fr * KSTR + fq * 16;
#pragma unroll
            for (int kt = 0; kt < 16; ++kt) { f32x4 a = {0, 0, 0, 0}; const LAS unsigned char* kp = kbase + kt * 16 * KSTR;
#pragma unroll
                for (int ks = 0; ks < 8; ++ks) { const bf16x8 kf = *(const LAS bf16x8*)(kp + ks * 64); a = __builtin_amdgcn_mfma_f32_16x16x32_bf16(kf, qf[ks], a, 0, 0, 0); }
                sT[kt] = a; if (kt & 1) __builtin_amdgcn_sched_barrier(0); }
            float mx = -3.0e38f;
#pragma unroll
            for (int kt = 0; kt < 16; ++kt) mx = fmaxf(fmaxf(fmaxf(mx, sT[kt].x), fmaxf(sT[kt].y, sT[kt].z)), sT[kt].w);
            mx = fmaxf(mx, shfl_xor_l(mx, 16, lane)); mx = fmaxf(mx, shfl_xor_l(mx, 32, lane));
            float sum = 0.f;
#pragma unroll
            for (int kt = 0; kt < 16; ++kt) { sT[kt].x = __expf(sT[kt].x - mx); sT[kt].y = __expf(sT[kt].y - mx); sT[kt].z = __expf(sT[kt].z - mx); sT[kt].w = __expf(sT[kt].w - mx); sum += (sT[kt].x + sT[kt].y) + (sT[kt].z + sT[kt].w); }
            sum += shfl_xor_l(sum, 16, lane); sum += shfl_xor_l(sum, 32, lane);
            inv[u] = 1.0f / sum;
#pragma unroll
            for (int kp = 0; kp < 8; ++kp) { v4u w; w.x = pk2(sT[2 * kp].x, sT[2 * kp].y); w.y = pk2(sT[2 * kp].z, sT[2 * kp].w); w.z = pk2(sT[2 * kp + 1].x, sT[2 * kp + 1].y); w.w = pk2(sT[2 * kp + 1].z, sT[2 * kp + 1].w); pf[u][kp] = w; }
            __builtin_amdgcn_sched_barrier(0);
        }
        __syncthreads();
        attn_stage<VSTR>(F.lds, VT + (size_t)(b * D + head * 256) * NMEM, NMEM, F.tid);
        __syncthreads();
#pragma unroll
        for (int u = 0; u < 2; ++u) { const int q0 = b * SEQ + qg * 256 + u * 128 + F.wave * 16;
#pragma unroll 2
            for (int dt = 0; dt < 16; ++dt) { f32x4 o = {0, 0, 0, 0}; const LAS unsigned char* vp = F.lds + (dt * 16 + fr) * VSTR + fq * 8;
#pragma unroll
                for (int kp = 0; kp < 8; ++kp) {
                    const v2u lo = *(const LAS v2u*)(vp + 64 * kp), hi = *(const LAS v2u*)(vp + 64 * kp + 32); v4u w; w.x = lo.x; w.y = lo.y; w.z = hi.x; w.w = hi.y;
                    o = __builtin_amdgcn_mfma_f32_16x16x32_bf16(__builtin_bit_cast(bf16x8, w), __builtin_bit_cast(bf16x8, pf[u][kp]), o, 0, 0, 0); }
                v2u w; w.x = pk2(o.x * inv[u], o.y * inv[u]); w.y = pk2(o.z * inv[u], o.w * inv[u]);
                *(v2u*)(AO + (size_t)(q0 + fr) * D + head * 256 + dt * 16 + 4 * fq) = w; __builtin_amdgcn_sched_barrier(0); } }
        __syncthreads();
    }
}

__device__ __forceinline__ void p_ln(const Frame& F, const float* g, const float* b, bool dummy) {
    const int gw = F.bid * NWAVES + F.wave, NGW = F.G * NWAVES, lane = F.lane; const float* H = (const float*)(F.ws + WS_H32); float* Ho = (float*)(F.ws + (dummy ? WS_Z : WS_H32)); bf16* H16 = (bf16*)(F.ws + (dummy ? WS_Z + 128 * MiB : WS_H16));
    for (int r = gw; r < T; r += NGW) { f32x4 v[4];
#pragma unroll
        for (int j = 0; j < 4; ++j) v[j] = *(const f32x4*)(H + (size_t)r * D + 256 * j + 4 * lane);
        float mean, rstd; ln_stats(v, mean, rstd); ln_apply_store(v, mean, rstd, g, b, Ho + (size_t)r * D, H16 + (size_t)r * D, lane); }
}
__device__ __forceinline__ void p_ln_router(KArgs& A, const Frame& F, int l, bool dummy) {
    const int gw = F.bid * NWAVES + F.wave, NGW = F.G * NWAVES, lane = F.lane, tid = F.tid, fr = lane & 15, fq = lane >> 4;
    const float* H = (const float*)(F.ws + WS_H32); float* Ho = (float*)(F.ws + (dummy ? WS_Z : WS_H32)); bf16* H16 = (bf16*)(F.ws + (dummy ? WS_Z + 128 * MiB : WS_H16)); int* TOKE = (int*)(F.ws + (dummy ? WS_Z + 200 * MiB : WS_TOKE)); float* TOKW = (float*)(F.ws + (dummy ? WS_Z + 201 * MiB : WS_TOKW));
    LAS v4u* TB = (LAS v4u*)F.lds;
    LAS float* PS = (LAS float*)(F.lds + 131072);
    volatile LAS unsigned* hist = F.MISC + MI_HIST;
    const float* rw = kin(A, I_ROUTER_W) + (size_t)l * D * NE; const float* rb = kin(A, I_ROUTER_B) + l * NE; const float* g = kin(A, I_LN2_G) + l * D; const float* bb = kin(A, I_LN2_B) + l * D;
    for (int en = tid; en < 32 * 2 * 64; en += NTHREADS) { const int ln = en & 63, et = (en >> 6) & 1, ks = en >> 7, efr = ln & 15, efq = ln >> 4; float hi[8], lo[8];
#pragma unroll
        for (int j = 0; j < 8; ++j) { const int d = 32 * ks + 8 * efq + j; const float v = g[d] * rw[d * NE + et * 16 + efr]; const float h = bf2f(f2bf(v)); hi[j] = h; lo[j] = v - h; }
        v4u wh, wl; wh.x = pk2(hi[0], hi[1]); wh.y = pk2(hi[2], hi[3]); wh.z = pk2(hi[4], hi[5]); wh.w = pk2(hi[6], hi[7]); wl.x = pk2(lo[0], lo[1]); wl.y = pk2(lo[2], lo[3]); wl.z = pk2(lo[4], lo[5]); wl.w = pk2(lo[6], lo[7]);
        TB[((ks * 2 + et) * 2 + 0) * 64 + ln] = wh; TB[((ks * 2 + et) * 2 + 1) * 64 + ln] = wl; }
    { const int e = tid & 31, part = tid >> 5; float sg = 0.f, sb = 0.f;
      for (int d = part * 64; d < part * 64 + 64; ++d) { const float w = rw[d * NE + e]; sg += g[d] * w; sb += bb[d] * w; }
      PS[part * 32 + e] = sg; PS[512 + part * 32 + e] = sb; }
    if (tid < NE) hist[tid] = 0u;
    __syncthreads();
    if (tid < NE) { float sg = 0.f, sb = 0.f;
#pragma unroll
        for (int p = 0; p < 16; ++p) { sg += PS[p * 32 + tid]; sb += PS[512 + p * 32 + tid]; }
        PS[1024 + tid] = sg; PS[1056 + tid] = sb + rb[tid]; }
    __syncthreads();
    const float cg0 = PS[1024 + fr], cg1 = PS[1024 + 16 + fr], cb0 = PS[1056 + fr], cb1 = PS[1056 + 16 + fr];
    for (int grp = gw; grp < T / 16; grp += NGW) { const int r0 = grp * 16; const float* xrow = H + (size_t)(r0 + fr) * D + 8 * fq;
        f32x4 acc0 = {0, 0, 0, 0}, acc1 = {0, 0, 0, 0}; float sum = 0.f, sq = 0.f;
#pragma unroll 2
        for (int ks = 0; ks < 32; ++ks) { const f32x4 xa = *(const f32x4*)(xrow + 32 * ks), xb = *(const f32x4*)(xrow + 32 * ks + 4);
            sum += (xa.x + xa.y) + (xa.z + xa.w) + (xb.x + xb.y) + (xb.z + xb.w);
            sq += (xa.x * xa.x + xa.y * xa.y) + (xa.z * xa.z + xa.w * xa.w) + (xb.x * xb.x + xb.y * xb.y) + (xb.z * xb.z + xb.w * xb.w);
            v4u ah, al; { const unsigned h0 = f2bf(xa.x), h1 = f2bf(xa.y), h2 = f2bf(xa.z), h3 = f2bf(xa.w), h4 = f2bf(xb.x), h5 = f2bf(xb.y), h6 = f2bf(xb.z), h7 = f2bf(xb.w);
                ah.x = h0 | (h1 << 16); ah.y = h2 | (h3 << 16); ah.z = h4 | (h5 << 16); ah.w = h6 | (h7 << 16);
                al.x = pk2(xa.x - bf2f(h0), xa.y - bf2f(h1)); al.y = pk2(xa.z - bf2f(h2), xa.w - bf2f(h3)); al.z = pk2(xb.x - bf2f(h4), xb.y - bf2f(h5)); al.w = pk2(xb.z - bf2f(h6), xb.w - bf2f(h7)); }
            const LAS v4u* tb = TB + (ks * 4) * 64 + lane; const v4u b0h = tb[0], b0l = tb[64], b1h = tb[128], b1l = tb[192];
            const bf16x8 Ah = __builtin_bit_cast(bf16x8, ah), Al = __builtin_bit_cast(bf16x8, al);
            acc0 = __builtin_amdgcn_mfma_f32_16x16x32_bf16(Ah, __builtin_bit_cast(bf16x8, b0h), acc0, 0, 0, 0); acc0 = __builtin_amdgcn_mfma_f32_16x16x32_bf16(Ah, __builtin_bit_cast(bf16x8, b0l), acc0, 0, 0, 0); acc0 = __builtin_amdgcn_mfma_f32_16x16x32_bf16(Al, __builtin_bit_cast(bf16x8, b0h), acc0, 0, 0, 0);
            acc1 = __builtin_amdgcn_mfma_f32_16x16x32_bf16(Ah, __builtin_bit_cast(bf16x8, b1h), acc1, 0, 0, 0); acc1 = __builtin_amdgcn_mfma_f32_16x16x32_bf16(Ah, __builtin_bit_cast(bf16x8, b1l), acc1, 0, 0, 0); acc1 = __builtin_amdgcn_mfma_f32_16x16x32_bf16(Al, __builtin_bit_cast(bf16x8, b1h), acc1, 0, 0, 0); }
        sum += shfl_xor_l(sum, 16, lane); sum += shfl_xor_l(sum, 32, lane); sq += shfl_xor_l(sq, 16, lane); sq += shfl_xor_l(sq, 32, lane);
        const float mean = sum * (1.f / D), rstd = 1.0f / sqrtf(fmaxf(sq * (1.f / D) - mean * mean, 0.f) + LN_EPS);
        float v0[4], v1[4];
#pragma unroll
        for (int reg = 0; reg < 4; ++reg) { const float rs = __builtin_bit_cast(float, shfl_idx_l(__builtin_bit_cast(int, rstd), 4 * fq + reg)), mn = __builtin_bit_cast(float, shfl_idx_l(__builtin_bit_cast(int, mean), 4 * fq + reg));
            v0[reg] = rs * acc0[reg] - rs * mn * cg0 + cb0; v1[reg] = rs * acc1[reg] - rs * mn * cg1 + cb1; }
        float wv[4][4]; int wi[4][4];
#pragma unroll
        for (int k = 0; k < 4; ++k) {
#pragma unroll
            for (int reg = 0; reg < 4; ++reg) { float bv = v0[reg]; int bi = fr; if (v1[reg] > bv) { bv = v1[reg]; bi = 16 + fr; }
#pragma unroll
                for (int o = 1; o < 16; o <<= 1) { const float ov = shfl_xor_l(bv, o, lane); const int oi = shfl_idx_l(bi, lane ^ o); if (ov > bv || (ov == bv && oi < bi)) { bv = ov; bi = oi; } }
                wv[k][reg] = bv; wi[k][reg] = bi; if (bi == fr) v0[reg] = -3.0e38f; if (bi == 16 + fr) v1[reg] = -3.0e38f; } }
        if (fr == 0) {
#pragma unroll
            for (int reg = 0; reg < 4; ++reg) { const int t = r0 + 4 * fq + reg; const float e1 = __expf(wv[1][reg] - wv[0][reg]), e2 = __expf(wv[2][reg] - wv[0][reg]), e3 = __expf(wv[3][reg] - wv[0][reg]), inv = 1.0f / (1.0f + e1 + e2 + e3);
                *(int4*)(TOKE + (size_t)t * 4) = make_int4(wi[0][reg], wi[1][reg], wi[2][reg], wi[3][reg]); *(f32x4*)(TOKW + (size_t)t * 4) = (f32x4){inv, e1 * inv, e2 * inv, e3 * inv};
#pragma unroll
                for (int k = 0; k < 4; ++k) __hip_atomic_fetch_add((LAS unsigned*)&hist[wi[k][reg]], 1u, __ATOMIC_RELAXED, __HIP_MEMORY_SCOPE_WORKGROUP); } }
        float* orow = Ho + (size_t)(r0 + fr) * D + 8 * fq; bf16* o16 = H16 + (size_t)(r0 + fr) * D + 8 * fq;
#pragma unroll 2
        for (int ks = 0; ks < 32; ++ks) { const f32x4 xa = *(const f32x4*)(xrow + 32 * ks), xb = *(const f32x4*)(xrow + 32 * ks + 4);
            const f32x4 ga = *(const f32x4*)(g + 32 * ks + 8 * fq), gb = *(const f32x4*)(g + 32 * ks + 8 * fq + 4), ba = *(const f32x4*)(bb + 32 * ks + 8 * fq), bc = *(const f32x4*)(bb + 32 * ks + 8 * fq + 4);
            const f32x4 ya = (xa - mean) * rstd * ga + ba, yb = (xb - mean) * rstd * gb + bc;
            *(f32x4*)(orow + 32 * ks) = ya; *(f32x4*)(orow + 32 * ks + 4) = yb;
            v4u w; w.x = pk2(ya.x, ya.y); w.y = pk2(ya.z, ya.w); w.z = pk2(yb.x, yb.y); w.w = pk2(yb.z, yb.w); *(v4u*)(o16 + 32 * ks) = w; }
    }
    __syncthreads();
    if (tid < NE && !dummy) { const unsigned c = hist[tid]; if (c) atomicAdd(F.ctl + CW_CNT + l * NE + tid, c); F.ctl[CW_WGH + (l * 512 + F.bid) * NE + tid] = c; }
}
__device__ __forceinline__ void moe_offsets(const Frame& F, int l) {
    if (F.tid == 0) { int acc = 0;
        for (int e = 0; e < NE; ++e) { F.MISC[MI_TOFF + e] = (unsigned)acc; const unsigned c = __hip_atomic_load(F.ctl + CW_CNT + l * NE + e, __ATOMIC_RELAXED, __HIP_MEMORY_SCOPE_AGENT); acc += (int)((c + 255u) >> 8); }
        F.MISC[MI_TOFF + NE] = (unsigned)acc; }
    __syncthreads();
}
__device__ __forceinline__ void p_moe_slots(const Frame& F, int l, int dummy) {
    const int gw = F.bid * NWAVES + F.wave, NGW = F.G * NWAVES, lane = F.lane;
    moe_offsets(F, l);
    const int* TOKE = (const int*)(F.ws + WS_TOKE); const float* TOKW = (const float*)(F.ws + WS_TOKW); int* TOKS = (int*)(F.ws + (dummy ? WS_END : WS_TOKS)); float* SLOTW = (float*)(F.ws + (dummy ? WS_END + 1 * MiB : WS_SLOTW));
    const bf16* H16 = (const bf16*)(F.ws + WS_H16); bf16* XG = (bf16*)(F.ws + (dummy ? WS_ACT : WS_XG)); unsigned* CUR = F.ctl + CW_CUR + l * NE + dummy * 256;
    if (F.tid < NE) { const unsigned c = F.ctl[CW_WGH + (l * 512 + F.bid) * NE + F.tid]; const unsigned base = c ? atomicAdd(CUR + F.tid, c) : 0u;
        F.MISC[MI_LBASE + F.tid] = F.MISC[MI_TOFF + F.tid] * 256u + base; F.MISC[MI_LCUR + F.tid] = 0u; }
    __syncthreads();
    for (int grp = gw; grp < T / 16; grp += NGW)
    for (int r = grp * 16; r < grp * 16 + 16; ++r) { int slot = 0;
        if (lane < 4) { const int e = TOKE[(size_t)r * 4 + lane]; const unsigned pos = __hip_atomic_fetch_add((LAS unsigned*)&F.MISC[MI_LCUR + e], 1u, __ATOMIC_RELAXED, __HIP_MEMORY_SCOPE_WORKGROUP); slot = (int)(F.MISC[MI_LBASE + e] + pos);
            TOKS[(size_t)r * 4 + lane] = slot; SLOTW[slot] = TOKW[(size_t)r * 4 + lane]; }
        const v4u a = *(const v4u*)(H16 + (size_t)r * D + 8 * lane), b = *(const v4u*)(H16 + (size_t)r * D + 512 + 8 * lane);
#pragma unroll
        for (int k = 0; k < 4; ++k) { const int sk = shfl_idx_l(slot, k); *(v4u*)(XG + (size_t)sk * D + 8 * lane) = a; *(v4u*)(XG + (size_t)sk * D + 512 + 8 * lane) = b; } }
}
__device__ __forceinline__ void p_moe_combine(KArgs& A, const Frame& F, int l, bool dummy) {
    const int gw = F.bid * NWAVES + F.wave, NGW = F.G * NWAVES, lane = F.lane;
    const float* H = (const float*)(F.ws + WS_H32); float* Ho = (float*)(F.ws + (dummy ? WS_Z : WS_H32)); bf16* H16 = (bf16*)(F.ws + (dummy ? WS_Z + 128 * MiB : WS_H16)); const int* TOKS = (const int*)(F.ws + WS_TOKS); const bf16* YS = (const bf16*)(F.ws + WS_YS);
    const bool last = (l == NL - 1) && !dummy;
    for (int r = gw; r < T; r += NGW) { f32x4 v[4]; const int4 sl = *(const int4*)(TOKS + (size_t)r * 4);
#pragma unroll
        for (int j = 0; j < 4; ++j) { v[j] = *(const f32x4*)(H + (size_t)r * D + 256 * j + 4 * lane) * DN_ALPHA;
            const v2u y0 = *(const v2u*)(YS + (size_t)sl.x * D + 256 * j + 4 * lane), y1 = *(const v2u*)(YS + (size_t)sl.y * D + 256 * j + 4 * lane), y2 = *(const v2u*)(YS + (size_t)sl.z * D + 256 * j + 4 * lane), y3 = *(const v2u*)(YS + (size_t)sl.w * D + 256 * j + 4 * lane);
            v[j].x += (bf2f(y0.x & 0xffffu) + bf2f(y1.x & 0xffffu)) + (bf2f(y2.x & 0xffffu) + bf2f(y3.x & 0xffffu));
            v[j].y += (bf2f(y0.x >> 16) + bf2f(y1.x >> 16)) + (bf2f(y2.x >> 16) + bf2f(y3.x >> 16));
            v[j].z += (bf2f(y0.y & 0xffffu) + bf2f(y1.y & 0xffffu)) + (bf2f(y2.y & 0xffffu) + bf2f(y3.y & 0xffffu));
            v[j].w += (bf2f(y0.y >> 16) + bf2f(y1.y >> 16)) + (bf2f(y2.y >> 16) + bf2f(y3.y >> 16)); }
        float mean, rstd; ln_stats(v, mean, rstd);
        if (last) ln_apply_store(v, mean, rstd, kin(A, I_LN3_G) + l * D, kin(A, I_LN3_B) + l * D, kout(A) + (size_t)r * D, (bf16*)nullptr, lane);
        else ln_apply_store(v, mean, rstd, kin(A, I_LN3_G) + l * D, kin(A, I_LN3_B) + l * D, Ho + (size_t)r * D, H16 + (size_t)r * D, lane); }
}

constexpr int NPL = 18;
constexpr int NPHASES = 1 + NL * NPL;
#ifndef ONLY
#define ONLY -1
#endif
#define EN(j) (ONLY < 0 || ONLY == (j))
#define DUMMY(j) ((PROBE_PHASE == (j)) && (rep_ + 1 < PROBE_REPS))
#define REPS(j) for (int rep_ = 0; rep_ < ((PROBE_PHASE == (j)) ? PROBE_REPS : 1); ++rep_, __syncthreads())
__global__ void __launch_bounds__(NTHREADS, 2) fwd_kernel(Args args) {
    extern __shared__ __attribute__((aligned(16))) unsigned char lds_raw[];
    Frame F;
    F.lds = (LAS unsigned char*)lds_raw; F.MISC = (volatile LAS unsigned*)(F.lds + MISC_OFF);
    F.tid = threadIdx.x; F.lane = F.tid & 63; F.wave = __builtin_amdgcn_readfirstlane(F.tid >> 6); F.G = gridDim.x; F.bid = blockIdx.x;
    F.ws = (unsigned char*)(GAS unsigned char*)args.ws; F.ctl = (unsigned*)(F.ws + WS_CTL);
    for (int u = F.tid; u < (LDS_BYTES - MISC_OFF) / 4; u += NTHREADS) F.MISC[u] = 0u;
    __syncthreads();
    XcdBarrier bar; bar.bar = F.ctl + CW_BAR; bar.x = 0; bar.st = nullptr;
    const int lo = args.ph_lo, hi = args.ph_hi;
    if (hi - lo > 1) bar = xcd_barrier_post(F.ctl + CW_BAR, F.MISC + 8);
#define IN(k) (launder_i(lo) <= (k) && (k) < launder_i(hi))
#define SEAM(k) do { if (IN(k) && IN((k) + 1)) xcd_barrier(bar); } while (0)
#define PH_BEGIN KArgs& KA = *kargs(); unsigned char* ws = launder_p(args.ws); F.ws = ws; (void)KA; (void)ws; { int ln_; asm volatile("v_mbcnt_lo_u32_b32 %0, -1, 0\n\tv_mbcnt_hi_u32_b32 %0, -1, %0" : "=v"(ln_)); F.lane = ln_; } F.tid = F.wave * 64 + F.lane; F.bid = launder_i((int)blockIdx.x); F.G = launder_i((int)gridDim.x);

    if (EN(100) && IN(0)) REPS(100) { PH_BEGIN p_prologue(KA, F); } SEAM(0);

#pragma unroll 1
    for (int l_ = 0; l_ < NL; ++l_) {
        const int l = launder_i(l_); const int p0 = 1 + l * NPL;
        if (EN(0) && IN(p0 + 0)) REPS(0) { PH_BEGIN
            pg8::Gemm g{D, D, D}; pg8::StaticOrder S{(const bf16*)(ws + WS_H16), (const bf16*)(ws + WS_WINT) + (size_t)l * N_IN * D, D, D, T / 256, N_IN / 256, F.G, F.bid};
            if (PROBE_PHASE == 200) { for (int q_ = 0; q_ < PROBE_REPS - 1; ++q_) { EpiNull E0{0}; pg8::gemm_phase(F.lds, F.wave * 64 + my_lane(), g, S, E0); __syncthreads(); } }
            EpiIn E{l};
            pg8::gemm_phase(F.lds, F.wave * 64 + my_lane(), g, S, E);
        } SEAM(p0 + 0);
        if (EN(1) && IN(p0 + 1)) REPS(1) { PH_BEGIN p_mix1(KA, F, l); } SEAM(p0 + 1);
        if (EN(2) && IN(p0 + 2)) REPS(2) { PH_BEGIN
            { pg8::Gemm g{S5K, 1024, 1024}; pg8::BatchOrder S{(const bf16*)(ws + WS_AOUT), (const bf16*)(ws + WS_S5BC) + (size_t)l * 16 * 256 * 1024, S5K, 1024, NCHT / 256, 1, 16, F.G, F.bid, (size_t)NCHT * S5K, (size_t)256 * 1024};
              EpiXloc E{0}; pg8::gemm_phase(F.lds, F.wave * 64 + my_lane(), g, S, E); }
            __syncthreads();
            { pg8::Gemm g{D, D, D}; pg8::StaticOrder S{(const bf16*)(ws + WS_MEM16), (const bf16*)(ws + WS_WKT) + (size_t)l * D * D, D, D, NB * NMEM / 256, D / 256, F.G, F.bid};
              EpiBf16 E{(unsigned)(WS_KM16 / MiB), 1.0f}; pg8::gemm_phase(F.lds, F.wave * 64 + my_lane(), g, S, E); }
            __syncthreads();
            { pg8::Gemm g{D, D, D}; pg8::StaticOrder S{(const bf16*)(ws + WS_MEM16), (const bf16*)(ws + WS_WVT) + (size_t)l * D * D, D, D, NB * NMEM / 256, D / 256, F.G, F.bid};
              EpiVT E{0}; pg8::gemm_phase(F.lds, F.wave * 64 + my_lane(), g, S, E); }
        } SEAM(p0 + 2);
        if (EN(3) && IN(p0 + 3)) REPS(3) { PH_BEGIN p_s5_chain(KA, F, l); p_rw_chunks(F); } SEAM(p0 + 3);
        if (EN(4) && IN(p0 + 4)) REPS(4) { PH_BEGIN
            p_chain_compose(F);
            pg8::Gemm g{S5K, S5K, S5K}; pg8::BatchOrder S{(const bf16*)(ws + WS_AOUT), (const bf16*)(ws + WS_S5BT) + (size_t)l * 16 * 1024 * S5K, S5K, S5K, NCHT / 256, 1024 / 256, 16, F.G, F.bid, (size_t)NCHT * S5K, (size_t)1024 * S5K};
            EpiS5Y E{l}; pg8::gemm_phase(F.lds, F.wave * 64 + my_lane(), g, S, E);
        } SEAM(p0 + 4);
        if (EN(5) && IN(p0 + 5)) REPS(5) { PH_BEGIN
            const int nchain = (F.G >= 16) ? 8 : 0;
            if (F.bid < nchain) { p_chain_blocks(F, F.bid * NWAVES + F.wave, nchain * NWAVES); }
            else {
                if (nchain == 0) { p_chain_blocks(F, F.bid * NWAVES + F.wave, F.G * NWAVES); __syncthreads(); }
                pg8::Gemm g{256, 256, 256}; pg8::StaticOrder S{(const bf16*)(ws + WS_YD16), (const bf16*)(ws + WS_GLUT) + (size_t)l * 256 * 256, 256, 256, T / 256, 1, F.G - nchain, F.bid - nchain};
                EpiGlu E{l}; pg8::gemm_phase(F.lds, F.wave * 64 + my_lane(), g, S, E);
            }
        } SEAM(p0 + 5);
        if (EN(6) && IN(p0 + 6)) REPS(6) { PH_BEGIN
            for (int bb = F.bid; bb < 16 * NBLK; bb += F.G) {
                if (F.wave < 4) chain_inblock(F, bb, F.wave);
                VM_WAIT(); __syncthreads();
                rw_out_task(KA, F, l, bb * CB + F.wave);
                __syncthreads();
            }
        } SEAM(p0 + 6);
        if (EN(7) && IN(p0 + 7)) REPS(7) { PH_BEGIN
#pragma unroll 1
            for (int br = 0; br < 4; ++br) {
                pg8::Gemm g{D, 256, 256}; pg8::StaticOrder S{(const bf16*)(ws + WS_O16) + br * 256, (const bf16*)(ws + WS_BRT) + (size_t)(l * 4 + br) * D * 256, D, 256, T / 256, D / 256, F.G, F.bid};
                EpiBranch E{br}; pg8::gemm_phase(F.lds, F.wave * 64 + my_lane(), g, S, E);
                VM_WAIT(); __syncthreads();
            }
        } SEAM(p0 + 7);
        if (EN(8) && IN(p0 + 8)) REPS(8) { PH_BEGIN
            pg8::Gemm g{D, D, D}; pg8::StaticOrder S{(const bf16*)(ws + WS_MG16), (const bf16*)(ws + WS_WOUTT) + (size_t)l * D * D, D, D, T / 256, D / 256, F.G, F.bid};
            EpiResid E{0}; pg8::gemm_phase(F.lds, F.wave * 64 + my_lane(), g, S, E);
        } SEAM(p0 + 8);
        if (EN(9) && IN(p0 + 9)) REPS(9) { PH_BEGIN p_ln(F, kin(KA, I_LN1_G) + l * D, kin(KA, I_LN1_B) + l * D, DUMMY(9)); } SEAM(p0 + 9);
        if (EN(10) && IN(p0 + 10)) REPS(10) { PH_BEGIN
            pg8::Gemm g{D, D, D}; pg8::StaticOrder S{(const bf16*)(ws + WS_H16), (const bf16*)(ws + WS_WQT) + (size_t)l * D * D, D, D, T / 256, D / 256, F.G, F.bid};
            EpiBf16 E{(unsigned)(WS_Q16 / MiB), 0.0625f}; pg8::gemm_phase(F.lds, F.wave * 64 + my_lane(), g, S, E);
        } SEAM(p0 + 10);
        if (EN(11) && IN(p0 + 11)) REPS(11) { PH_BEGIN p_attn(F); } SEAM(p0 + 11);
        if (EN(12) && IN(p0 + 12)) REPS(12) { PH_BEGIN
            pg8::Gemm g{D, D, D}; pg8::StaticOrder S{(const bf16*)(ws + WS_AO16), (const bf16*)(ws + WS_WOT) + (size_t)l * D * D, D, D, T / 256, D / 256, F.G, F.bid};
            EpiResid E{0}; pg8::gemm_phase(F.lds, F.wave * 64 + my_lane(), g, S, E);
        } SEAM(p0 + 12);
        if (EN(13) && IN(p0 + 13)) REPS(13) { PH_BEGIN p_ln_router(KA, F, l, DUMMY(13)); } SEAM(p0 + 13);
        if (EN(14) && IN(p0 + 14)) REPS(14) { PH_BEGIN p_moe_slots(F, l, DUMMY(14) ? (rep_ + 1) : 0); } SEAM(p0 + 14);
        if (EN(15) && IN(p0 + 15)) REPS(15) { PH_BEGIN
            moe_offsets(F, l);
            pg8::Gemm g{D, D, D}; pg8::MoeOrder S{(const bf16*)(ws + WS_XG), (const bf16*)(ws + WS_W1T) + (size_t)l * NE * 2048 * D, D, D, 2048 / 256, F.G, F.bid, (size_t)2048 * D, (const LAS int*)(F.MISC + MI_TOFF)};
            if (PROBE_PHASE == 201) { for (int q_ = 0; q_ < PROBE_REPS - 1; ++q_) { EpiNull E0{0}; pg8::gemm_phase(F.lds, F.wave * 64 + my_lane(), g, S, E0); __syncthreads(); } }
            EpiSwiglu E{l}; pg8::gemm_phase(F.lds, F.wave * 64 + my_lane(), g, S, E);
        } SEAM(p0 + 15);
        if (EN(16) && IN(p0 + 16)) REPS(16) { PH_BEGIN
            moe_offsets(F, l);
            pg8::Gemm g{DFF, DFF, DFF}; pg8::MoeOrder S{(const bf16*)(ws + WS_ACT), (const bf16*)(ws + WS_W2T) + (size_t)l * NE * D * DFF, DFF, DFF, D / 256, F.G, F.bid, (size_t)D * DFF, (const LAS int*)(F.MISC + MI_TOFF)};
            EpiMoeOut E{l}; pg8::gemm_phase(F.lds, F.wave * 64 + my_lane(), g, S, E);
        } SEAM(p0 + 16);
        if (EN(17) && IN(p0 + 17)) REPS(17) { PH_BEGIN p_moe_combine(KA, F, l, DUMMY(17)); } SEAM(p0 + 17);
    }
#undef IN
#undef SEAM
}

extern "C" void kernel_launch(void* const* d_in, const int* in_sizes, int n_in, void* d_out, int out_size, void* d_ws, size_t ws_size, hipStream_t stream) {
    static int grid = 0;
    if (grid == 0) {
        if (n_in != 50 || ws_size < WS_END) { fprintf(stderr, "kernel_launch: unexpected n_in %d / ws_size %zu\n", n_in, ws_size); grid = -1; return; }
        int dev = 0, cus = 0, per_cu = 0;
        if (hipGetDevice(&dev) != hipSuccess || hipDeviceGetAttribute(&cus, hipDeviceAttributeMultiprocessorCount, dev) != hipSuccess) { grid = -1; return; }
        if (hipFuncSetAttribute((const void*)fwd_kernel, hipFuncAttributeMaxDynamicSharedMemorySize, LDS_BYTES) != hipSuccess) { fprintf(stderr, "kernel_launch: hipFuncSetAttribute failed\n"); grid = -1; return; }
        if (hipOccupancyMaxActiveBlocksPerMultiprocessor(&per_cu, (const void*)fwd_kernel, NTHREADS, LDS_BYTES) != hipSuccess || per_cu < 1) { fprintf(stderr, "kernel_launch: occupancy query says %d\n", per_cu); }
        (void)hipGetLastError();
        grid = cus;
    }
    if (grid < 0) return;
    (void)hipMemsetAsync((char*)d_ws + WS_CTL, 0, CTL_ZERO_BYTES, stream);
    Args a{};
    for (int i = 0; i < 50; ++i) a.in[i] = (const float*)d_in[i];
    a.out = (float*)d_out; a.ws = (unsigned char*)d_ws;
#if N_LAUNCHES == 1
    a.ph_lo = 0; a.ph_hi = NPHASES;
    hipLaunchKernelGGL(fwd_kernel, dim3(grid), dim3(NTHREADS), LDS_BYTES, stream, a);
#else
    for (int p = 0; p < NPHASES; ++p) { a.ph_lo = p; a.ph_hi = p + 1; hipLaunchKernelGGL(fwd_kernel, dim3(grid), dim3(NTHREADS), LDS_BYTES, stream, a); }
#endif
}
```

```cpp
#include <hip/hip_runtime.h>
#include <cstdio>
#include <cstdint>

#ifndef N_LAUNCHES
#define N_LAUNCHES 1
#endif

#ifndef PROBE_PHASE
#define PROBE_PHASE -1
#endif
#ifndef PROBE_REPS
#define PROBE_REPS 3
#endif
#define GAS __attribute__((address_space(1)))
#define LAS __attribute__((address_space(3)))
typedef unsigned short bf16;
typedef unsigned v4u __attribute__((ext_vector_type(4)));
typedef unsigned v2u __attribute__((ext_vector_type(2)));
typedef float f32x4 __attribute__((ext_vector_type(4)));
typedef float f32x2 __attribute__((ext_vector_type(2)));
typedef short bf16x8 __attribute__((ext_vector_type(8)));
typedef short bf16x4 __attribute__((ext_vector_type(4)));

constexpr int NL = 2, NB = 4, SEQ = 8192, T = NB * SEQ, D = 1024;
constexpr int NMEM = 256;
constexpr int OFF_B = 768, OFF_C = 1280, OFF_D = 2304, OFF_G = 2560, N_IN = 6656, ZLD = 2560;
constexpr int NE = 32, TOPK = 4, DFF = 1024;
constexpr int CH = 64;
constexpr int NCH = SEQ / CH;
constexpr int NCHT = T / CH;
constexpr int S5K = 1152;
constexpr int SLOT_ROWS = T * TOPK + NE * 256;
constexpr float LN_EPS = 1e-5f, RW_LN_EPS = 64e-5f;
constexpr float DN_ALPHA = 1.41421356237309515f;

constexpr size_t MiB = 1u << 20;
constexpr size_t WS_CTL = 0, CTL_ZERO_BYTES = 1 * MiB;
constexpr size_t WS_W1T = 2 * MiB;
constexpr size_t WS_W2T = 258 * MiB;
constexpr size_t WS_WINT = 386 * MiB;
constexpr size_t WS_BRT = 412 * MiB;
constexpr size_t WS_WOUTT = 416 * MiB, WS_WQT = 420 * MiB, WS_WKT = 424 * MiB, WS_WVT = 428 * MiB, WS_WOT = 432 * MiB;
constexpr size_t WS_GLUT = 436 * MiB;
constexpr size_t WS_MEM16 = 437 * MiB;
constexpr size_t WS_S5BT = 440 * MiB;
constexpr size_t WS_S5BC = 512 * MiB;
constexpr size_t WS_H32 = 528 * MiB;
constexpr size_t WS_H16 = 656 * MiB;
constexpr size_t WS_Z = 720 * MiB;
constexpr size_t WS_XG = 720 * MiB;
constexpr size_t WS_SG = 1040 * MiB;
constexpr size_t WS_YS = 1040 * MiB;
constexpr size_t WS_O16 = 1312 * MiB, WS_MG16 = 1376 * MiB, WS_Q16 = 1440 * MiB, WS_AO16 = 1504 * MiB;
constexpr size_t WS_LA16 = 1568 * MiB;
constexpr size_t WS_DEC = 1584 * MiB, WS_AV = 1616 * MiB;
constexpr size_t WS_LWT = 2012 * MiB;
constexpr size_t WS_ACT = 1568 * MiB;
constexpr size_t WS_QH = 1760 * MiB, WS_YL = 1792 * MiB, WS_GC = 1824 * MiB, WS_HC = 1856 * MiB, WS_SC = 1888 * MiB, WS_RWG = 1920 * MiB;
constexpr size_t WS_RK = 1952 * MiB;
constexpr size_t WS_AOUT = 1954 * MiB;
constexpr size_t WS_XLOC = 1972 * MiB;
constexpr size_t WS_YD16 = 1976 * MiB;
constexpr size_t WS_KM16 = 1992 * MiB, WS_VMT16 = 1994 * MiB;
constexpr size_t WS_TOKE = 1996 * MiB, WS_TOKW = 1997 * MiB, WS_TOKS = 1998 * MiB, WS_SLOTW = 1999 * MiB;
constexpr size_t WS_GB = 2000 * MiB, WS_HB = 2004 * MiB, WS_SB = 2008 * MiB;
constexpr size_t WS_END = 2014 * MiB;
static_assert(WS_XG + (size_t)SLOT_ROWS * D * 2 <= WS_SG && WS_YS + (size_t)SLOT_ROWS * D * 2 <= WS_O16 && WS_ACT + (size_t)SLOT_ROWS * D * 2 <= WS_RK, "overlays");
constexpr int CW_BAR = 4096;
constexpr int CW_CNT = 16384;
constexpr int CW_CUR = 16384 + 128;
constexpr int CW_WGH = 65536;

constexpr int LDS_BYTES = 163840;
constexpr int MISC_OFF = LDS_BYTES - 1024;
constexpr int RING_BYTES = 131072;
constexpr int NWAVES = 8, NTHREADS = 512;

#define LDS_WAIT() asm volatile("s_waitcnt lgkmcnt(0)" ::: "memory")
#define VM_WAIT() asm volatile("s_waitcnt vmcnt(0)" ::: "memory")
__device__ __forceinline__ unsigned f2bf(float f) { unsigned u = __float_as_uint(f); return (u + 0x7fffu + ((u >> 16) & 1u)) >> 16; }
__device__ __forceinline__ unsigned pk2(float lo, float hi) { unsigned r; asm("v_cvt_pk_bf16_f32 %0, %1, %2" : "=v"(r) : "v"(lo), "v"(hi)); return r; }
__device__ __forceinline__ float bf2f(unsigned h) { return __uint_as_float(h << 16); }
__device__ __forceinline__ float sigmoidf_(float x) { return __builtin_amdgcn_rcpf(1.0f + __expf(-x)); }
__device__ __forceinline__ int my_lane() { int l; asm volatile("v_mbcnt_lo_u32_b32 %0, -1, 0\n\tv_mbcnt_hi_u32_b32 %0, -1, %0" : "=v"(l)); return l; }
__device__ __forceinline__ float shfl_xor_l(float v, int o, int lane) { return __builtin_bit_cast(float, __builtin_amdgcn_ds_bpermute((lane ^ o) << 2, __builtin_bit_cast(int, v))); }
__device__ __forceinline__ int shfl_idx_l(int v, int src) { return __builtin_amdgcn_ds_bpermute(src << 2, v); }
__device__ __forceinline__ float wave_sum(float v) {
    const int ln = my_lane();
#pragma unroll
    for (int o = 1; o < 64; o <<= 1) v += shfl_xor_l(v, o, ln);
    return v;
}

#define XB_TMO      128
#define XB_XCNT(j)  (256  + 64 * (j))
#define XB_XSUB(j)  (1280 + 64 * (j))
#define XB_XGEN(j)  (2304 + 64 * (j))
#define XB_TOP      3328
#define XB_TOPGEN   3392
#define XCD_BAR_WORDS 3456
#define XB_SPIN_CAP (1u << 24)
__device__ __forceinline__ unsigned xb_ld(unsigned* p)              { return __hip_atomic_load(p, __ATOMIC_RELAXED, __HIP_MEMORY_SCOPE_AGENT); }
__device__ __forceinline__ unsigned xb_add(unsigned* p, unsigned v) { return __hip_atomic_fetch_add(p, v, __ATOMIC_RELAXED, __HIP_MEMORY_SCOPE_AGENT); }
__device__ __forceinline__ unsigned xb_xcc_id() { return (unsigned)__builtin_amdgcn_s_getreg((3 << 11) | 20) & 0xFu; }
#define XB_SPIN(cond, bar) do { unsigned _sp = 0; while (cond) { __builtin_amdgcn_s_sleep(1); \
    if ((++_sp & 255u) == 0u) { if (xb_ld(&(bar)[XB_TMO])) break; if (_sp > XB_SPIN_CAP) { atomicAdd(&(bar)[XB_TMO], 1u); break; } } } } while (0)
struct XcdBarrier { unsigned* bar; unsigned x; volatile LAS unsigned* st; };
__device__ __forceinline__ XcdBarrier xcd_barrier_post(unsigned* bar, volatile LAS unsigned* st) {
    XcdBarrier b; b.bar = bar; b.x = xb_xcc_id(); b.st = st;
    if (threadIdx.x == 0) (void)xb_add(&bar[XB_XCNT(b.x)], 1u);
    return b;
}
__device__ __forceinline__ void xcd_barrier_complete(unsigned* bar, unsigned x, unsigned& nloc, unsigned& nx) {
    const unsigned G = gridDim.x * gridDim.y * gridDim.z;
    unsigned sum, cnt, mine, sp = 0u;
    for (;;) {
        sum = 0u; cnt = 0u; mine = 0u;
#pragma unroll
        for (unsigned j = 0; j < 16; ++j) { const unsigned c = xb_ld(&bar[XB_XCNT(j)]); sum += c; cnt += (c > 0u) ? 1u : 0u; mine = (j == x) ? c : mine; }
        if (sum == G) break;
        __builtin_amdgcn_s_sleep(1);
        if ((++sp & 255u) == 0u) { if (xb_ld(&bar[XB_TMO])) break; if (sp > XB_SPIN_CAP) { atomicAdd(&bar[XB_TMO], 1u); break; } }
    }
    nloc = mine > 0u ? mine : 1u; nx = cnt > 0u ? cnt : 1u;
}
__device__ __forceinline__ void xcd_barrier(const XcdBarrier& b) {
    asm volatile("s_waitcnt vmcnt(0)" ::: "memory");
    __syncthreads();
    if (threadIdx.x == 0) {
        unsigned* bar = b.bar; unsigned bx = b.x;
        asm volatile("" : "+s"(bar), "+s"(bx));
        __builtin_amdgcn_s_waitcnt(0);
        unsigned nloc = b.st[0], nx = b.st[1];
        if (nloc == 0u) { xcd_barrier_complete(bar, bx, nloc, nx); b.st[0] = nloc; b.st[1] = nx; }
        const unsigned old = xb_add(&bar[XB_XSUB(bx)], 1u);
        const unsigned gen = old / nloc;
        if (old + 1u == (gen + 1u) * nloc) {
            __builtin_amdgcn_fence(__ATOMIC_RELEASE, "agent");
            asm volatile("s_waitcnt vmcnt(0)" ::: "memory");
            const unsigned og = xb_add(&bar[XB_TOP], 1u);
            const unsigned tg = og / nx;
            if (og + 1u == (tg + 1u) * nx) xb_add(&bar[XB_TOPGEN], 1u);
            else XB_SPIN(xb_ld(&bar[XB_TOPGEN]) == tg, bar);
            __builtin_amdgcn_fence(__ATOMIC_ACQUIRE, "agent");
            xb_add(&bar[XB_XGEN(bx)], 1u);
            asm volatile("s_waitcnt vmcnt(0)" ::: "memory");
        } else {
            XB_SPIN(xb_ld(&bar[XB_XGEN(bx)]) == gen, bar);
            __builtin_amdgcn_fence(__ATOMIC_ACQUIRE, "agent");
            asm volatile("s_waitcnt vmcnt(0)" ::: "memory");
        }
    }
    __syncthreads();
}

namespace pg8 {
constexpr int BM = 256, BK = 64, HALF = 128, HTB = HALF * BK * 2, STAGE_BYTES = 8 * HTB, NXCD = 8, WGM = 8;
__host__ __device__ __forceinline__ int lds_byte(int r, int c) { const int st = (r >> 4) * 2 + (c >> 5), rr = r & 15, cc = c & 31, ob = rr * 64 + cc * 2; return st * 1024 + (ob ^ (((ob >> 9) & 1) << 5)); }
__host__ __device__ __forceinline__ int perm32(int rho) { const int n = rho >> 4, i = rho & 15; return 8 * (i >> 2) + 4 * n + (i & 3); }
__host__ __device__ __forceinline__ void stage_rc(int b, int& R, int& C) { const int st = b / 1024, sb = b % 1024, swz = sb ^ (((sb >> 9) & 1) << 5); R = (st >> 1) * 16 + swz / 64; C = (st & 1) * 32 + (swz % 64) / 2; }
struct Unit { int pm, pn, e; };
struct Gemm { int lda, ldb, K; };

__device__ __forceinline__ bool static_tile(int i, int G, int c, int nM, int nN, int& pm, int& pn) {
    const int nwg = nM * nN; const long L = (long)i * G + c; if (L >= nwg) return false;
    int wgid = (int)L; { const int q = nwg / NXCD, r = nwg % NXCD, xcd = wgid % NXCD, off = wgid / NXCD; wgid = (xcd < r ? xcd * (q + 1) : r * (q + 1) + (xcd - r) * q) + off; }
    const int nig = WGM * nN, gid = wgid / nig, fm = gid * WGM, gsz = (nM - fm) < WGM ? (nM - fm) : WGM;
    pm = fm + ((wgid % nig) % gsz); pn = (wgid % nig) / gsz; return true;
}
struct StaticOrder {
    const bf16* A; const bf16* Bt; int lda, ldb, nM, nN, G, c;
    __device__ __forceinline__ bool next(int i, Unit& u) const { u.e = 0; return static_tile(i, G, c, nM, nN, u.pm, u.pn); }
    __device__ __forceinline__ const char* a_base(const Unit& u) const { return (const char*)(A + (size_t)u.pm * BM * lda); }
    __device__ __forceinline__ const char* b_base(const Unit& u) const { return (const char*)(Bt + (size_t)u.pn * BM * ldb); }
};
struct BatchOrder {
    const bf16* A; const bf16* Bt; int lda, ldb, nM, nN, nb, G, c; size_t sA, sB;
    __device__ __forceinline__ bool next(int i, Unit& u) const {
        const long L = (long)i * G + c; const int per = nM * nN; if (L >= (long)per * nb) return false;
        u.e = (int)(L / per); const int r = (int)(L % per); u.pn = r / nM; u.pm = r % nM; return true; }
    __device__ __forceinline__ const char* a_base(const Unit& u) const { return (const char*)(A + (size_t)u.e * sA + (size_t)u.pm * BM * lda); }
    __device__ __forceinline__ const char* b_base(const Unit& u) const { return (const char*)(Bt + (size_t)u.e * sB + (size_t)u.pn * BM * ldb); }
};
struct BranchOrder {
    const bf16* A; const bf16* Bt; int nM, nN, G, c;
    __device__ __forceinline__ bool next(int i, Unit& u) const { u.e = i & 3; return static_tile(i >> 2, G, c, nM, nN, u.pm, u.pn); }
    __device__ __forceinline__ const char* a_base(const Unit& u) const { return (const char*)(A + (size_t)u.pm * BM * D + u.e * 256); }
    __device__ __forceinline__ const char* b_base(const Unit& u) const { return (const char*)(Bt + (size_t)u.e * D * 256 + (size_t)u.pn * BM * 256); }
};
struct MoeOrder {
    const bf16* A; const bf16* Bt; int lda, ldb, nN, G, c; size_t sB; const LAS int* toff;
    __device__ __forceinline__ bool next(int i, Unit& u) const {
        const int nt = toff[NE]; int mt;
        const int Gx = G >> 3;
        if ((G & 7) == 0 && (Gx % nN) == 0) {
            const int per = Gx / nN, x = c & 7, y = c >> 3;
            mt = i * 8 * per + x * per + y / nN; u.pn = y % nN; if (mt >= nt) return false;
        } else { const long L = (long)i * G + c; if (L >= (long)nt * nN) return false; mt = (int)(L / nN); u.pn = (int)(L % nN); }
        u.pm = mt; int e = 0;
#pragma unroll 1
        for (int k = 1; k < NE; ++k) e += (toff[k] <= mt) ? 1 : 0;
        u.e = e; return true; }
    __device__ __forceinline__ const char* a_base(const Unit& u) const { return (const char*)(A + (size_t)u.pm * BM * lda); }
    __device__ __forceinline__ const char* b_base(const Unit& u) const { return (const char*)(Bt + (size_t)u.e * sB + (size_t)u.pn * BM * ldb); }
};

template <class F> __device__ __forceinline__ void epi_foreach(const f32x4 (&acc)[2][2][4][2], const Unit& u, int wr, int wc, int fr, int fq, const F& f) {
#pragma unroll
    for (int ai = 0; ai < 2; ++ai)
#pragma unroll
        for (int m = 0; m < 4; ++m) { const int row = u.pm * BM + ai * HALF + wr * 64 + m * 16 + fr;
#pragma unroll
            for (int bj = 0; bj < 2; ++bj)
#pragma unroll
                for (int n = 0; n < 2; ++n) f(row, u.pn * BM + bj * HALF + wc * 32 + n * 16 + 4 * fq, acc[ai][bj][m][n]);
            if (m == 3) __builtin_amdgcn_sched_barrier(0); }
}

template <class F> __device__ __forceinline__ void epi_foreach8(const f32x4 (&acc)[2][2][4][2], const Unit& u, int wr, int wc, int fr, int fq, const F& f) {
#pragma unroll
    for (int ai = 0; ai < 2; ++ai)
#pragma unroll
        for (int m = 0; m < 4; ++m) { const int row = u.pm * BM + ai * HALF + wr * 64 + m * 16 + fr;
#pragma unroll
            for (int bj = 0; bj < 2; ++bj) f(row, u.pn * BM + bj * HALF + wc * 32 + 8 * fq, acc[ai][bj][m][0], acc[ai][bj][m][1]);
            if (m == 3) __builtin_amdgcn_sched_barrier(0); }
}
template <class Epi, class Sched, bool ALIGN_EPI = true, bool SP2 = true>
__device__ __forceinline__ void gemm_phase(LAS unsigned char* lds, const int tid, const Gemm g, const Sched& S, const Epi& E) {
    const int wid = __builtin_amdgcn_readfirstlane(tid >> 6), lane = tid & 63, wr = wid >> 2, wc = wid & 3, fr = lane & 15, fq = lane >> 4;
    const int K = g.K, nt = K / BK;
    unsigned voffA[2], voffB[2];
#pragma unroll
    for (int i = 0; i < 2; ++i) { int R, C; stage_rc(tid * 16 + i * 8192, R, C);
        const int Rb = Epi::PERM ? ((R & ~31) + perm32(R & 31)) : R;
        voffA[i] = (unsigned)(R * g.lda + C) * 2u; voffB[i] = (unsigned)(Rb * g.ldb + C) * 2u; }
    const size_t kstep = (size_t)(BK * 2);
    const size_t hstepA = (size_t)HALF * g.lda * 2, hstepB = (size_t)HALF * g.ldb * 2;
    const unsigned ldsw = (unsigned)wid * 1024u;
    const int aoff = lds_byte(wr * 64 + fr, fq * 8), boff = lds_byte(wc * 32 + fr, fq * 8);
#define PG8_SA(b, h) (((b) * 2 + (h)) * HTB)
#define PG8_SB(b, h) ((4 + (b) * 2 + (h)) * HTB)
#define PG8_STAGE(bufoff, gbase, voff) do { _Pragma("unroll") for (int _i = 0; _i < 2; ++_i) \
        __builtin_amdgcn_global_load_lds((const unsigned*)((const char*)(gbase) + (voff)[_i]), (LAS unsigned*)(lds + (bufoff) + ldsw + _i * 8192), 16, 0, 0); } while (0)
#define PG8_LDA(dst, b, h) do { _Pragma("unroll") for (int m = 0; m < 4; ++m) _Pragma("unroll") for (int k = 0; k < 2; ++k) dst[m][k] = *(const LAS bf16x8*)(lds + PG8_SA(b, h) + aoff + m * 2048 + k * 1024); } while (0)
#define PG8_LDB(dst, b, h) do { _Pragma("unroll") for (int n = 0; n < 2; ++n) _Pragma("unroll") for (int k = 0; k < 2; ++k) dst[n][k] = *(const LAS bf16x8*)(lds + PG8_SB(b, h) + boff + n * 2048 + k * 1024); } while (0)
#define PG8_MMA(ai, bj, At, Bt) do { __builtin_amdgcn_s_setprio(1); _Pragma("unroll") for (int m = 0; m < 4; ++m) _Pragma("unroll") for (int n = 0; n < 2; ++n) _Pragma("unroll") for (int k = 0; k < 2; ++k) \
        acc[ai][bj][m][n] = __builtin_amdgcn_mfma_f32_16x16x32_bf16(Bt[n][k], At[m][k], acc[ai][bj][m][n], 0, 0, 0); __builtin_amdgcn_s_setprio(0); } while (0)
#define PG8_WAIT_V(n) asm volatile("s_waitcnt vmcnt(" #n ")" ::: "memory")
#define PG8_WAIT_L(n) asm volatile("s_waitcnt lgkmcnt(" #n ")" ::: "memory")
#define PG8_BAR __builtin_amdgcn_s_barrier()
#define PG8_SCHED __builtin_amdgcn_sched_barrier(0)
    Unit cur, nxt; int ui = 0;
    if (!S.next(0, cur)) return;
    f32x4 acc[2][2][4][2];
#pragma unroll
    for (int a = 0; a < 2; ++a)
#pragma unroll
        for (int b = 0; b < 2; ++b)
#pragma unroll
            for (int m = 0; m < 4; ++m)
#pragma unroll
                for (int n = 0; n < 2; ++n) acc[a][b][m][n] = (f32x4){0.f, 0.f, 0.f, 0.f};
    bf16x8 At[4][2], B0[2][2], B1[2][2];
    const char* cA = S.a_base(cur); const char* cB = S.b_base(cur);
    if constexpr (SP2) {
        PG8_STAGE(PG8_SB(0, 0), cB, voffB); PG8_STAGE(PG8_SB(0, 1), cB + hstepB, voffB); PG8_STAGE(PG8_SA(0, 0), cA, voffA); PG8_STAGE(PG8_SA(0, 1), cA + hstepA, voffA);
        if (wr == 1) PG8_BAR;
        PG8_WAIT_V(2); PG8_BAR;
        PG8_STAGE(PG8_SB(1, 0), cB + kstep, voffB); PG8_STAGE(PG8_SA(1, 0), cA + kstep, voffA); PG8_STAGE(PG8_SB(1, 1), cB + hstepB + kstep, voffB);
        PG8_WAIT_V(6); PG8_BAR;
    } else {
        PG8_STAGE(PG8_SB(0, 0), cB, voffB); PG8_STAGE(PG8_SA(0, 0), cA, voffA); PG8_STAGE(PG8_SB(0, 1), cB + hstepB, voffB); PG8_STAGE(PG8_SA(0, 1), cA + hstepA, voffA);
        if (wr == 1) PG8_BAR;
        PG8_WAIT_V(4); PG8_BAR;
        PG8_STAGE(PG8_SB(1, 0), cB + kstep, voffB); PG8_STAGE(PG8_SA(1, 0), cA + kstep, voffA); PG8_STAGE(PG8_SB(1, 1), cB + hstepB + kstep, voffB);
        PG8_WAIT_V(6); PG8_BAR;
    }
    for (;;) {
        const bool has_next = S.next(ui + 1, nxt);
        const char* nA = has_next ? S.a_base(nxt) : cA; const char* nB = has_next ? S.b_base(nxt) : cB;
        for (int t = 0; t < nt; t += 2) {
            const bool last = (t == nt - 2);
            const char* a1 = cA + (size_t)(t + 1) * kstep;
            const char* a2 = last ? nA : cA + (size_t)(t + 2) * kstep; const char* b2 = last ? nB : cB + (size_t)(t + 2) * kstep;
            const char* a3 = a2 + kstep; const char* b3 = b2 + kstep;
            if constexpr (SP2) {
            PG8_LDB(B0, 0, 0); PG8_LDB(B1, 0, 1); PG8_SCHED; PG8_LDA(At, 0, 0); PG8_STAGE(PG8_SA(1, 1), a1 + hstepA, voffA);
            PG8_WAIT_V(8); PG8_WAIT_L(0); PG8_BAR; PG8_MMA(0, 0, At, B0); PG8_MMA(0, 1, At, B1); PG8_BAR; PG8_SCHED;
            PG8_LDA(At, 0, 1); PG8_STAGE(PG8_SB(0, 0), b2, voffB); PG8_STAGE(PG8_SB(0, 1), b2 + hstepB, voffB); PG8_STAGE(PG8_SA(0, 0), a2, voffA);
            PG8_WAIT_V(8); PG8_WAIT_L(0); PG8_BAR; PG8_MMA(1, 0, At, B0); PG8_MMA(1, 1, At, B1); PG8_BAR; PG8_SCHED;
            PG8_LDB(B0, 1, 0); PG8_LDB(B1, 1, 1); PG8_SCHED; PG8_LDA(At, 1, 0); PG8_STAGE(PG8_SA(0, 1), a2 + hstepA, voffA);
            PG8_WAIT_V(8); PG8_WAIT_L(0); PG8_BAR; PG8_MMA(0, 0, At, B0); PG8_MMA(0, 1, At, B1); PG8_BAR; PG8_SCHED;
            PG8_LDA(At, 1, 1); PG8_STAGE(PG8_SB(1, 0), b3, voffB); PG8_STAGE(PG8_SB(1, 1), b3 + hstepB, voffB); PG8_STAGE(PG8_SA(1, 0), a3, voffA);
            PG8_WAIT_V(8); PG8_WAIT_L(0); PG8_BAR; PG8_MMA(1, 0, At, B0); PG8_MMA(1, 1, At, B1); PG8_BAR; PG8_SCHED;
            } else {
            PG8_LDB(B0, 0, 0); PG8_SCHED; PG8_LDA(At, 0, 0); PG8_STAGE(PG8_SA(1, 1), a1 + hstepA, voffA);
            PG8_WAIT_L(8); PG8_BAR; PG8_WAIT_L(0); PG8_MMA(0, 0, At, B0); PG8_BAR; PG8_SCHED;
            PG8_LDB(B1, 0, 1); PG8_STAGE(PG8_SB(0, 0), b2, voffB);
            PG8_BAR; PG8_WAIT_L(0); PG8_MMA(0, 1, At, B1); PG8_BAR;
            PG8_LDA(At, 0, 1); PG8_STAGE(PG8_SA(0, 0), a2, voffA);
            PG8_BAR; PG8_WAIT_L(0); PG8_MMA(1, 0, At, B0); PG8_BAR; PG8_SCHED;
            PG8_STAGE(PG8_SB(0, 1), b2 + hstepB, voffB);
            PG8_WAIT_V(6); PG8_BAR; PG8_MMA(1, 1, At, B1); PG8_BAR;
            PG8_LDB(B0, 1, 0); PG8_SCHED; PG8_LDA(At, 1, 0); PG8_STAGE(PG8_SA(0, 1), a2 + hstepA, voffA);
            PG8_WAIT_L(8); PG8_BAR; PG8_WAIT_L(0); PG8_MMA(0, 0, At, B0); PG8_BAR; PG8_SCHED;
            PG8_LDB(B1, 1, 1); PG8_STAGE(PG8_SB(1, 0), b3, voffB);
            PG8_BAR; PG8_WAIT_L(0); PG8_MMA(0, 1, At, B1); PG8_BAR;
            PG8_LDA(At, 1, 1); PG8_STAGE(PG8_SA(1, 0), a3, voffA);
            PG8_BAR; PG8_WAIT_L(0); PG8_MMA(1, 0, At, B0); PG8_BAR; PG8_SCHED;
            PG8_STAGE(PG8_SB(1, 1), b3 + hstepB, voffB);
            PG8_WAIT_V(6); PG8_BAR; PG8_MMA(1, 1, At, B1); PG8_BAR;
            }
        }
        if constexpr (ALIGN_EPI) { if (wr == 0) PG8_BAR; }
        { const int lane2 = my_lane();
          E(acc, cur, wid >> 2, wid & 3, lane2 & 15, lane2 >> 4); }
        if (!has_next) break;
#pragma unroll
        for (int a = 0; a < 2; ++a)
#pragma unroll
            for (int b = 0; b < 2; ++b)
#pragma unroll
                for (int m = 0; m < 4; ++m)
#pragma unroll
                    for (int n = 0; n < 2; ++n) acc[a][b][m][n] = (f32x4){0.f, 0.f, 0.f, 0.f};
        cur = nxt; cA = nA; cB = nB; ++ui;
        if constexpr (ALIGN_EPI) { if (wr == 1) PG8_BAR; }
    }
    PG8_WAIT_V(0);
    if constexpr (!ALIGN_EPI) { if (wr == 0) PG8_BAR; }
    PG8_BAR;
#undef PG8_SA
#undef PG8_SB
#undef PG8_STAGE
#undef PG8_LDA
#undef PG8_LDB
#undef PG8_MMA
#undef PG8_WAIT_V
#undef PG8_WAIT_L
#undef PG8_BAR
#undef PG8_SCHED
}
}
using pg8::Unit;

struct Args { const float* in[50]; float* out; unsigned char* ws; int ph_lo, ph_hi; };
typedef const __attribute__((address_space(4))) Args KArgs;
__device__ __forceinline__ KArgs* kargs() { KArgs* p = (KArgs*)__builtin_amdgcn_kernarg_segment_ptr(); asm volatile("" : "+s"(p)); return p; }
__device__ __forceinline__ unsigned char* launder_p(unsigned char* p) { asm volatile("" : "+s"(p)); return (unsigned char*)(GAS unsigned char*)p; }
__device__ __forceinline__ const float* kin(KArgs& A, int i) { return (const float*)(const GAS float*)A.in[i]; }
__device__ __forceinline__ float* kout(KArgs& A) { return (float*)(GAS float*)A.out; }
__device__ __forceinline__ unsigned char* kws(KArgs& A) { return (unsigned char*)(GAS unsigned char*)A.ws; }
__device__ __forceinline__ int launder_i(int v) { asm volatile("" : "+s"(v)); return v; }
__device__ __forceinline__ int launder_v(int v) { asm volatile("" : "+v"(v)); return v; }
enum { I_X = 0, I_MEM, I_LN_IN_G, I_LN_IN_B, I_W_IN, I_CONV_W, I_SG_NG, I_SG_NB, I_SG_W, I_SG_B, I_RW_MU, I_RW_W0, I_RW_WUP, I_RW_A0, I_RW_AUP, I_RW_GUP,
       I_RW_KK, I_RW_KA, I_RW_RK, I_RW_LNG, I_RW_LNB, I_S5_ARE, I_S5_AIM, I_S5_BRE, I_S5_BIM, I_S5_CRE, I_S5_CIM, I_S5_D, I_S5_LOGDT, I_S5_GLUW, I_S5_GLUB,
       I_BR_PROJ, I_GATE_B, I_W_OUT, I_LN1_G, I_LN1_B, I_XA_WQ, I_XA_WK, I_XA_WV, I_XA_WO, I_LN2_G, I_LN2_B, I_ROUTER_W, I_ROUTER_B, I_EX_W1, I_EX_B1, I_EX_W2, I_EX_B2,
       I_LN3_G, I_LN3_B };
struct Frame { LAS unsigned char* lds; volatile LAS unsigned* MISC; unsigned* ctl; unsigned char* ws; int tid, lane, wave, G, bid; };
constexpr int MI_TOFF = 16, MI_HIST = 64, MI_LBASE = 96, MI_LCUR = 128;

__device__ __forceinline__ void ln_stats(const f32x4 (&v)[4], float& mean, float& rstd) {
    float s = 0.f;
#pragma unroll
    for (int j = 0; j < 4; ++j) s += (v[j].x + v[j].y) + (v[j].z + v[j].w);
    mean = wave_sum(s) * (1.f / D); float s2 = 0.f;
#pragma unroll
    for (int j = 0; j < 4; ++j) { const f32x4 d = v[j] - mean; s2 += (d.x * d.x + d.y * d.y) + (d.z * d.z + d.w * d.w); }
    rstd = 1.0f / sqrtf(wave_sum(s2) * (1.f / D) + LN_EPS);
}
__device__ __forceinline__ void ln_apply_store(const f32x4 (&v)[4], float mean, float rstd, const float* g, const float* b, float* o32, bf16* o16, int lane) {
#pragma unroll
    for (int j = 0; j < 4; ++j) {
        const f32x4 gg = *(const f32x4*)(g + 256 * j + 4 * lane), bb = *(const f32x4*)(b + 256 * j + 4 * lane);
        const f32x4 y = (v[j] - mean) * rstd * gg + bb;
        if (o32) *(f32x4*)(o32 + 256 * j + 4 * lane) = y;
        if (o16) { v2u w; w.x = pk2(y.x, y.y); w.y = pk2(y.z, y.w); *(v2u*)(o16 + 256 * j + 4 * lane) = w; }
    }
}

__device__ __forceinline__ void transpose_item(const float* W, int K, int N, bf16* WT, int mode, LAS float* scr, int item, int lane) {
    const int nblk = N / 32, kb = item / nblk, nb = item % nblk, k0 = 64 * kb, n0 = 32 * nb;
#pragma unroll 8
    for (int i = 0; i < 32; ++i) { const int kk = 2 * i + (lane >> 5); scr[kk * 33 + (lane & 31)] = W[(size_t)(k0 + kk) * N + n0 + (lane & 31)]; }
    LDS_WAIT();
    const int c = lane & 7;
#pragma unroll
    for (int j = 0; j < 4; ++j) { const int n = (lane >> 3) + 8 * j; const LAS float* s = scr + (8 * c) * 33 + n;
        v4u o; o.x = pk2(s[0 * 33], s[1 * 33]); o.y = pk2(s[2 * 33], s[3 * 33]); o.z = pk2(s[4 * 33], s[5 * 33]); o.w = pk2(s[6 * 33], s[7 * 33]);
        const int nn = n0 + n; const int jj = nn >> 1;
        const int row = mode ? ((jj >> 7) * 256 + (nn & 1) * 128 + (jj & 127)) : nn;
        *(v4u*)(WT + (size_t)row * K + k0 + 8 * c) = o; }
    LDS_WAIT();
}
__device__ __forceinline__ void s5_setup_item(KArgs& A, const Frame& F, int item) {
    const int l = item >> 4, g = item & 15, tid = F.tid;
    LAS float* Kt = (LAS float*)F.lds;
    LAS float* Pw = (LAS float*)(F.lds + 65536);
    LAS float* Bb = (LAS float*)(F.lds + 65536 + 33280);
    LAS float* Cc = Bb + 2048;
    const float* a_re = kin(A, I_S5_ARE) + (l * 16 + g) * 64; const float* a_im = kin(A, I_S5_AIM) + (l * 16 + g) * 64;
    const float* b_re = kin(A, I_S5_BRE) + (size_t)(l * 16 + g) * 1024; const float* b_im = kin(A, I_S5_BIM) + (size_t)(l * 16 + g) * 1024;
    const float* c_re = kin(A, I_S5_CRE) + (size_t)(l * 16 + g) * 1024; const float* c_im = kin(A, I_S5_CIM) + (size_t)(l * 16 + g) * 1024;
    const float dt = expf(kin(A, I_S5_LOGDT)[l * 16 + g]);
    for (int o = tid; o < 65 * 64; o += NTHREADS) { const int n = o >> 6, p = o & 63; const float mag = expf(a_re[p] * dt * (float)n); float sn, cs; sincosf(a_im[p] * dt * (float)n, &sn, &cs);
        Pw[o * 2] = mag * cs; Pw[o * 2 + 1] = mag * sn; }
    for (int o = tid; o < 1024; o += NTHREADS) { const int p = o >> 4;
        const float are = a_re[p], aim = a_im[p], mag = expf(are * dt); float sn, cs; sincosf(aim * dt, &sn, &cs); const float abr = mag * cs, abi = mag * sn;
        const float den = are * are + aim * aim, nr = abr - 1.0f, cr = (nr * are + abi * aim) / den, ci = (abi * are - nr * aim) / den;
        const float br = b_re[o], bi = b_im[o]; Bb[o * 2] = cr * br - ci * bi; Bb[o * 2 + 1] = cr * bi + ci * br; }
    for (int o = tid; o < 1024; o += NTHREADS) { Cc[o * 2] = c_re[o]; Cc[o * 2 + 1] = c_im[o]; }
    __syncthreads();
    for (int o = tid; o < 16384; o += NTHREADS) { const int tau = o >> 8, c = (o >> 4) & 15, cp = o & 15; float acc = 0.f;
        for (int p = 0; p < 64; ++p) { const float cr = Cc[(c * 64 + p) * 2], ci = Cc[(c * 64 + p) * 2 + 1], pr = Pw[(tau * 64 + p) * 2], pi = Pw[(tau * 64 + p) * 2 + 1];
            const float er = cr * pr - ci * pi, ei = cr * pi + ci * pr; acc += er * Bb[(p * 16 + cp) * 2] - ei * Bb[(p * 16 + cp) * 2 + 1]; }
        Kt[o] = acc; }
    __syncthreads();
    bf16* Bt = (bf16*)(F.ws + WS_S5BT) + (size_t)(l * 16 + g) * 1024 * S5K;
    for (int o = tid; o < 1024 * 128; o += NTHREADS) { const int rr = o >> 7, q = o & 127, t = rr >> 4, c = rr & 15, s = q >> 1, cp0 = (q & 1) * 8;
        v4u w = {0u, 0u, 0u, 0u};
        if (s <= t) { const LAS float* k = Kt + ((t - s) * 16 + c) * 16 + cp0; w.x = pk2(k[0], k[1]); w.y = pk2(k[2], k[3]); w.z = pk2(k[4], k[5]); w.w = pk2(k[6], k[7]); }
        *(v4u*)(Bt + (size_t)rr * S5K + q * 8) = w; }
    for (int o = tid; o < 1024 * 16; o += NTHREADS) { const int rr = o >> 4, q = o & 15, t = rr >> 4, c = rr & 15; float vals[8];
#pragma unroll
        for (int j = 0; j < 4; ++j) { const int p = 4 * q + j; const float cr = Cc[(c * 64 + p) * 2], ci = Cc[(c * 64 + p) * 2 + 1], pr = Pw[((t + 1) * 64 + p) * 2], pi = Pw[((t + 1) * 64 + p) * 2 + 1];
            vals[2 * j] = cr * pr - ci * pi; vals[2 * j + 1] = -(cr * pi + ci * pr); }
        v4u w; w.x = pk2(vals[0], vals[1]); w.y = pk2(vals[2], vals[3]); w.z = pk2(vals[4], vals[5]); w.w = pk2(vals[6], vals[7]);
        *(v4u*)(Bt + (size_t)rr * S5K + 1024 + q * 8) = w; }
    bf16* Bc = (bf16*)(F.ws + WS_S5BC) + (size_t)(l * 16 + g) * 256 * 1024;
    for (int o = tid; o < 128 * 128; o += NTHREADS) { const int row = o >> 7, q = o & 127, p = row >> 1, im = row & 1, s = q >> 1, cp0 = (q & 1) * 8;
        const float pr = Pw[((63 - s) * 64 + p) * 2], pi = Pw[((63 - s) * 64 + p) * 2 + 1]; float vals[8];
#pragma unroll
        for (int j = 0; j < 8; ++j) { const float br = Bb[(p * 16 + cp0 + j) * 2], bi = Bb[(p * 16 + cp0 + j) * 2 + 1]; vals[j] = im ? (pr * bi + pi * br) : (pr * br - pi * bi); }
        v4u w; w.x = pk2(vals[0], vals[1]); w.y = pk2(vals[2], vals[3]); w.z = pk2(vals[4], vals[5]); w.w = pk2(vals[6], vals[7]);
        *(v4u*)(Bc + (size_t)row * 1024 + q * 8) = w;
        *(v4u*)(Bc + (size_t)(128 + row) * 1024 + q * 8) = (v4u){0u, 0u, 0u, 0u}; }
    __syncthreads();
}
__device__ __forceinline__ void p_prologue(KArgs& A, const Frame& F) {
    const int gw = F.bid * NWAVES + F.wave, NGW = F.G * NWAVES, lane = F.lane;
    for (int item = F.bid; item < NL * 16; item += F.G) s5_setup_item(A, F, item);
    LAS float* scr = (LAS float*)(F.lds + F.wave * 16384);
#pragma unroll 1
    for (int d = 0; d < 10; ++d) {
        const float* src; bf16* dst; int K, N, batch, mode = 0;
        switch (d) {
            case 0: src = kin(A, I_EX_W1); dst = (bf16*)(F.ws + WS_W1T); K = 1024; N = 2048; batch = NL * NE; mode = 1; break;
            case 1: src = kin(A, I_EX_W2); dst = (bf16*)(F.ws + WS_W2T); K = 1024; N = 1024; batch = NL * NE; break;
            case 2: src = kin(A, I_W_IN); dst = (bf16*)(F.ws + WS_WINT); K = 1024; N = N_IN; batch = NL; break;
            case 3: src = kin(A, I_BR_PROJ); dst = (bf16*)(F.ws + WS_BRT); K = 256; N = 1024; batch = NL * 4; break;
            case 4: src = kin(A, I_W_OUT); dst = (bf16*)(F.ws + WS_WOUTT); K = 1024; N = 1024; batch = NL; break;
            case 5: src = kin(A, I_XA_WQ); dst = (bf16*)(F.ws + WS_WQT); K = 1024; N = 1024; batch = NL; break;
            case 6: src = kin(A, I_XA_WK); dst = (bf16*)(F.ws + WS_WKT); K = 1024; N = 1024; batch = NL; break;
            case 7: src = kin(A, I_XA_WV); dst = (bf16*)(F.ws + WS_WVT); K = 1024; N = 1024; batch = NL; break;
            case 8: src = kin(A, I_XA_WO); dst = (bf16*)(F.ws + WS_WOT); K = 1024; N = 1024; batch = NL; break;
            default: src = kin(A, I_S5_GLUW); dst = (bf16*)(F.ws + WS_GLUT); K = 256; N = 256; batch = NL; break;
        }
        const int per = (K / 64) * (N / 32), nitems = per * batch;
        for (int it = gw; it < nitems; it += NGW) { const int b = it / per, r = it - b * per;
            transpose_item(src + (size_t)b * K * N, K, N, dst + (size_t)b * K * N, mode, scr, r, lane); }
    }
    { bf16* lwt = (bf16*)(F.ws + WS_LWT);
      for (int it = gw * 64 + lane; it < NL * 768 * 32; it += NGW * 64) { const int kc = it & 31, row = (it >> 5) % 768, ll = it / (768 * 32), blk = row >> 8, c = row & 255, k0 = kc * 8; float v[8];
#pragma unroll
          for (int j = 0; j < 8; ++j) { const int k = k0 + j; float x = 0.f;
              if (blk == 0 && k < 64) x = kin(A, I_RW_WUP)[((size_t)ll * 64 + k) * 256 + c];
              else if (blk == 1 && k >= 64 && k < 128) x = kin(A, I_RW_AUP)[((size_t)ll * 64 + (k - 64)) * 256 + c];
              else if (blk == 2 && k >= 128) x = kin(A, I_RW_GUP)[((size_t)ll * 128 + (k - 128)) * 256 + c];
              v[j] = x; }
          v4u w; w.x = pk2(v[0], v[1]); w.y = pk2(v[2], v[3]); w.z = pk2(v[4], v[5]); w.w = pk2(v[6], v[7]);
          *(v4u*)(lwt + ((size_t)ll * 768 + row) * 256 + k0) = w; } }
    { const float* mem = kin(A, I_MEM); bf16* m16 = (bf16*)(F.ws + WS_MEM16);
      for (int r = gw; r < NB * NMEM; r += NGW) {
#pragma unroll
          for (int j = 0; j < 4; ++j) { const f32x4 v = *(const f32x4*)(mem + (size_t)r * D + 256 * j + 4 * lane); v2u w; w.x = pk2(v.x, v.y); w.y = pk2(v.z, v.w); *(v2u*)(m16 + (size_t)r * D + 256 * j + 4 * lane) = w; } } }
    { const float* x = kin(A, I_X); float* h32 = (float*)(F.ws + WS_H32); bf16* h16 = (bf16*)(F.ws + WS_H16);
      for (int r = gw; r < T; r += NGW) { f32x4 v[4];
#pragma unroll
          for (int j = 0; j < 4; ++j) v[j] = *(const f32x4*)(x + (size_t)r * D + 256 * j + 4 * lane);
          float mean, rstd; ln_stats(v, mean, rstd);
          ln_apply_store(v, mean, rstd, kin(A, I_LN_IN_G), kin(A, I_LN_IN_B), h32 + (size_t)r * D, h16 + (size_t)r * D, lane); } }
}

typedef f32x4 AccT[2][2][4][2];
#define EPI_BASES KArgs& KA = *kargs(); unsigned char* ws = kws(KA); (void)ws;
__device__ __forceinline__ v4u pk8(const f32x4 a, const f32x4 b) { v4u w; w.x = pk2(a.x, a.y); w.y = pk2(a.z, a.w); w.z = pk2(b.x, b.y); w.w = pk2(b.z, b.w); return w; }
__device__ __forceinline__ void unpk8(const v4u w, f32x4& a, f32x4& b) { a.x = bf2f(w.x & 0xffffu); a.y = bf2f(w.x >> 16); a.z = bf2f(w.y & 0xffffu); a.w = bf2f(w.y >> 16); b.x = bf2f(w.z & 0xffffu); b.y = bf2f(w.z >> 16); b.z = bf2f(w.w & 0xffffu); b.w = bf2f(w.w >> 16); }
__device__ __forceinline__ f32x4 ld4bf(const bf16* p) { const v2u w = *(const v2u*)p; f32x4 a; a.x = bf2f(w.x & 0xffffu); a.y = bf2f(w.x >> 16); a.z = bf2f(w.y & 0xffffu); a.w = bf2f(w.y >> 16); return a; }
__device__ __forceinline__ f32x4 sig4(const f32x4 v) { return (f32x4){sigmoidf_(v.x), sigmoidf_(v.y), sigmoidf_(v.z), sigmoidf_(v.w)}; }
struct EpiNull { static constexpr bool PERM = false; int dummy;
    __device__ __forceinline__ void operator()(const AccT& acc, const Unit& u, int wr, int wc, int fr, int fq) const { f32x4 t = {0, 0, 0, 0};
#pragma unroll
        for (int a = 0; a < 2; ++a)
#pragma unroll
            for (int b = 0; b < 2; ++b)
#pragma unroll
                for (int m = 0; m < 4; ++m) { t += acc[a][b][m][0]; t += acc[a][b][m][1]; }
        if (t.x + t.y + t.z + t.w == 1234.5f) { EPI_BASES *(f32x4*)(ws + WS_END) = t; } } };
struct EpiIn { static constexpr bool PERM = true; int l;
    __device__ __forceinline__ void operator()(const AccT& acc, const Unit& u, int wr, int wc, int fr, int fq) const { EPI_BASES
        bf16* Z = (bf16*)(ws + WS_Z); bf16* SG = (bf16*)(ws + WS_SG); bf16* AOUT = (bf16*)(ws + WS_AOUT); const float* gate_b = kin(KA, I_GATE_B) + (size_t)l * 4096;
        if (u.pn < 10) {
            pg8::epi_foreach8(acc, u, wr, wc, fr, fq, [&](int row, int col, f32x4 v0, f32x4 v1) { const v4u w = pk8(v0, v1);
                *(v4u*)(Z + (size_t)row * ZLD + col) = w;
                if (u.pn == 9) { const int cc = col - OFF_D, g = cc >> 4, c0 = cc & 15, chunk = row >> 6, s = row & 63; *(v4u*)(AOUT + ((size_t)(g * NCHT + chunk)) * S5K + s * 16 + c0) = w; } });
        } else {
            pg8::epi_foreach8(acc, u, wr, wc, fr, fq, [&](int row, int col, f32x4 v0, f32x4 v1) {
                const int gc = col - OFF_G; const f32x4 g0 = *(const f32x4*)(gate_b + gc), g1 = *(const f32x4*)(gate_b + gc + 4);
                *(v4u*)(SG + (size_t)row * 4096 + gc) = pk8(sig4(v0 + g0), sig4(v1 + g1)); });
        }
    } };
struct EpiBranch { static constexpr bool PERM = true; int dummy;
    __device__ __forceinline__ void operator()(const AccT& acc, const Unit& u, int wr, int wc, int fr, int fq) const { EPI_BASES const int br = u.e;
        bf16* MG = (bf16*)(ws + WS_MG16); const bf16* SG = (const bf16*)(ws + WS_SG);
        pg8::epi_foreach8(acc, u, wr, wc, fr, fq, [&](int row, int col, f32x4 v0, f32x4 v1) {
            f32x4 s0, s1; unpk8(*(const v4u*)(SG + (size_t)row * 4096 + br * 1024 + col), s0, s1);
            f32x4 r0 = v0 * s0, r1 = v1 * s1; bf16* p = MG + (size_t)row * D + col;
            if (br > 0) { f32x4 m0, m1; unpk8(*(const v4u*)p, m0, m1); r0 += m0; r1 += m1; }
            *(v4u*)p = pk8(r0, r1); });
    } };
struct EpiResid { static constexpr bool PERM = false; int dummy;
    __device__ __forceinline__ void operator()(const AccT& acc, const Unit& u, int wr, int wc, int fr, int fq) const { EPI_BASES
        float* H = (float*)(ws + WS_H32);
        pg8::epi_foreach(acc, u, wr, wc, fr, fq, [&](int row, int col, f32x4 v) { float* p = H + (size_t)row * D + col; const f32x4 h = *(const f32x4*)p; *(f32x4*)p = h * DN_ALPHA + v; });
    } };
struct EpiBf16 { static constexpr bool PERM = true; unsigned off_mib; float scale;
    __device__ __forceinline__ void operator()(const AccT& acc, const Unit& u, int wr, int wc, int fr, int fq) const { EPI_BASES
        bf16* O = (bf16*)(ws + (size_t)off_mib * MiB);
        pg8::epi_foreach8(acc, u, wr, wc, fr, fq, [&](int row, int col, f32x4 v0, f32x4 v1) { *(v4u*)(O + (size_t)row * D + col) = pk8(v0 * scale, v1 * scale); });
    } };
struct EpiVT { static constexpr bool PERM = false; int dummy;
    __device__ __forceinline__ void operator()(const AccT& acc, const Unit& u, int wr, int wc, int fr, int fq) const { EPI_BASES
        bf16* VT = (bf16*)(ws + WS_VMT16);
        pg8::epi_foreach(acc, u, wr, wc, fr, fq, [&](int row, int col, f32x4 v) { const int b = row >> 8, m = row & 255; bf16* p = VT + ((size_t)(b * D + col)) * NMEM + m;
            p[0] = (bf16)f2bf(v.x); p[NMEM] = (bf16)f2bf(v.y); p[2 * NMEM] = (bf16)f2bf(v.z); p[3 * NMEM] = (bf16)f2bf(v.w); });
    } };
struct EpiXloc { static constexpr bool PERM = false; int dummy;
    __device__ __forceinline__ void operator()(const AccT& acc, const Unit& u, int wr, int wc, int fr, int fq) const { EPI_BASES
        float* X = (float*)(ws + WS_XLOC);
        pg8::epi_foreach(acc, u, wr, wc, fr, fq, [&](int row, int col, f32x4 v) { if (col < 128) *(f32x4*)(X + ((size_t)(u.e * NCHT + row)) * 128 + col) = v; });
    } };
struct EpiLora { static constexpr bool PERM = false; int l;
    __device__ __forceinline__ void operator()(const AccT& acc, const Unit& u, int wr, int wc, int fr, int fq) const { EPI_BASES
        if (u.pn == 0) { float* DEC = (float*)(ws + WS_DEC); const float* w0 = kin(KA, I_RW_W0) + l * 256;
            pg8::epi_foreach(acc, u, wr, wc, fr, fq, [&](int row, int col, f32x4 v) { const f32x4 wp = v + *(const f32x4*)(w0 + col); f32x4 o;
#pragma unroll
                for (int e = 0; e < 4; ++e) { const float sp = log1pf(__expf(-wp[e])); o[e] = __expf(-__expf(-sp - 0.5f)); }
                *(f32x4*)(DEC + (size_t)row * 256 + col) = o; });
        } else if (u.pn == 1) { float* AV = (float*)(ws + WS_AV); const float* a0 = kin(KA, I_RW_A0) + l * 256;
            pg8::epi_foreach(acc, u, wr, wc, fr, fq, [&](int row, int col, f32x4 v) { const int c = col - 256; *(f32x4*)(AV + (size_t)row * 256 + c) = sig4(v + *(const f32x4*)(a0 + c)); });
        } else { float* G = (float*)(ws + WS_RWG);
            pg8::epi_foreach(acc, u, wr, wc, fr, fq, [&](int row, int col, f32x4 v) { *(f32x4*)(G + (size_t)row * 256 + col - 512) = v; });
        }
    } };
__device__ __forceinline__ float gelu_tanh(float x) { const float u = 0.7978845608028654f * (x + 0.044715f * x * x * x); const float e = __expf(2.0f * u); const float th = 1.0f - 2.0f * __builtin_amdgcn_rcpf(e + 1.0f); return 0.5f * x * (1.0f + th); }
__device__ __forceinline__ f32x4 gelu4(const f32x4 v) { return (f32x4){gelu_tanh(v.x), gelu_tanh(v.y), gelu_tanh(v.z), gelu_tanh(v.w)}; }
struct EpiS5Y { static constexpr bool PERM = true; int l;
    __device__ __forceinline__ void operator()(const AccT& acc, const Unit& u, int wr, int wc, int fr, int fq) const { EPI_BASES
        bf16* YD = (bf16*)(ws + WS_YD16); const bf16* AOUT = (const bf16*)(ws + WS_AOUT); const float* dvec = kin(KA, I_S5_D) + l * 256;
        pg8::epi_foreach8(acc, u, wr, wc, fr, fq, [&](int row, int col, f32x4 v0, f32x4 v1) { const int t = col >> 4, c0 = col & 15, tok = row * CH + t, ch = u.e * 16 + c0;
            f32x4 u0, u1; unpk8(*(const v4u*)(AOUT + ((size_t)(u.e * NCHT + row)) * S5K + t * 16 + c0), u0, u1);
            const f32x4 d0 = *(const f32x4*)(dvec + ch), d1 = *(const f32x4*)(dvec + ch + 4);
            *(v4u*)(YD + (size_t)tok * 256 + ch) = pk8(gelu4(v0 + d0 * u0), gelu4(v1 + d1 * u1)); });
    } };
struct EpiGlu { static constexpr bool PERM = true; int l;
    __device__ __forceinline__ void operator()(const AccT& acc, const Unit& u, int wr, int wc, int fr, int fq) const { EPI_BASES
        bf16* O = (bf16*)(ws + WS_O16); const bf16* YD = (const bf16*)(ws + WS_YD16); const float* gb = kin(KA, I_S5_GLUB) + l * 256;
        pg8::epi_foreach8(acc, u, wr, wc, fr, fq, [&](int row, int col, f32x4 v0, f32x4 v1) { f32x4 y0, y1; unpk8(*(const v4u*)(YD + (size_t)row * 256 + col), y0, y1);
            const f32x4 b0 = *(const f32x4*)(gb + col), b1 = *(const f32x4*)(gb + col + 4);
            *(v4u*)(O + (size_t)row * D + 768 + col) = pk8(y0 * sig4(v0 + b0), y1 * sig4(v1 + b1)); });
    } };
__device__ __forceinline__ float swiglu(float g, float u) { g = fminf(g, 7.0f); u = fminf(fmaxf(u, -7.0f), 7.0f); return (u + 1.0f) * g * sigmoidf_(1.702f * g); }
struct EpiSwiglu { static constexpr bool PERM = true; int l;
    __device__ __forceinline__ void operator()(const AccT& acc, const Unit& u, int wr, int wc, int fr, int fq) const { EPI_BASES
        bf16* ACT = (bf16*)(ws + WS_ACT); const float* bb = kin(KA, I_EX_B1) + (size_t)(l * NE + u.e) * 2048;
#pragma unroll
        for (int ai = 0; ai < 2; ++ai)
#pragma unroll
            for (int m = 0; m < 4; ++m) { const int row = u.pm * 256 + ai * 128 + wr * 64 + m * 16 + fr; const int j = u.pn * 128 + wc * 32 + 8 * fq;
                f32x4 o[2];
#pragma unroll
                for (int n = 0; n < 2; ++n) { const f32x4 b0 = *(const f32x4*)(bb + 2 * (j + 4 * n)), b1v = *(const f32x4*)(bb + 2 * (j + 4 * n) + 4);
                    const f32x4 g = acc[ai][0][m][n], uu = acc[ai][1][m][n];
                    o[n] = (f32x4){swiglu(g.x + b0.x, uu.x + b0.y), swiglu(g.y + b0.z, uu.y + b0.w), swiglu(g.z + b1v.x, uu.z + b1v.y), swiglu(g.w + b1v.z, uu.w + b1v.w)}; }
                *(v4u*)(ACT + (size_t)row * DFF + j) = pk8(o[0], o[1]);
                if (m == 3) __builtin_amdgcn_sched_barrier(0); }
    } };
struct EpiMoeOut { static constexpr bool PERM = true; int l;
    __device__ __forceinline__ void operator()(const AccT& acc, const Unit& u, int wr, int wc, int fr, int fq) const { EPI_BASES
        bf16* YS = (bf16*)(ws + WS_YS); const float* SLOTW = (const float*)(ws + WS_SLOTW); const float* bb = kin(KA, I_EX_B2) + (size_t)(l * NE + u.e) * D;
        pg8::epi_foreach8(acc, u, wr, wc, fr, fq, [&](int row, int col, f32x4 v0, f32x4 v1) { const float sw = SLOTW[row]; const f32x4 b0 = *(const f32x4*)(bb + col), b1 = *(const f32x4*)(bb + col + 4);
            *(v4u*)(YS + (size_t)row * D + col) = pk8((v0 + b0) * sw, (v1 + b1) * sw); });
    } };

__device__ __forceinline__ void p_mix1(KArgs& A, const Frame& F, int l) {
    const int gw = F.bid * NWAVES + F.wave, NGW = F.G * NWAVES, lane = F.lane, tid = F.tid;
    const bf16* Z = (const bf16*)(F.ws + WS_Z); bf16* O16 = (bf16*)(F.ws + WS_O16);
    for (int rp_ = 0; rp_ < ((PROBE_PHASE == 101) ? PROBE_REPS : 1); ++rp_) { const float* cw = kin(A, I_CONV_W) + l * 3 * 256; const f32x4 w0 = *(const f32x4*)(cw + 4 * lane), w1 = *(const f32x4*)(cw + 256 + 4 * lane), w2 = *(const f32x4*)(cw + 512 + 4 * lane);
      for (int t = gw; t < T; t += NGW) { const int s = t & (SEQ - 1); const bf16* zr = Z + (size_t)t * ZLD + 4 * lane;
          const f32x4 bg = ld4bf(zr); f32x4 y = w2 * (ld4bf(zr + 256) * ld4bf(zr + 512));
          if (s >= 1) y += w1 * (ld4bf(zr - ZLD + 256) * ld4bf(zr - ZLD + 512));
          if (s >= 2) y += w0 * (ld4bf(zr - 2 * ZLD + 256) * ld4bf(zr - 2 * ZLD + 512));
          y = y * bg; v2u w; w.x = pk2(y.x, y.y); w.y = pk2(y.z, y.w); *(v2u*)(O16 + (size_t)t * D + 4 * lane) = w; } }
    for (int rp_ = 0; rp_ < ((PROBE_PHASE == 102) ? PROBE_REPS : 1); ++rp_) { LAS float* VN = (LAS float*)F.lds;
      const float* ng = kin(A, I_SG_NG) + l * 256; const float* nb = kin(A, I_SG_NB) + l * 256;
      for (int blk = F.bid; blk < T / 128; blk += F.G) {
          const f32x4 gg = *(const f32x4*)(ng + 4 * lane), bb = *(const f32x4*)(nb + 4 * lane);
          for (int r = F.wave; r < 128; r += NWAVES) { const int t = blk * 128 + r; const f32x4 v = ld4bf(Z + (size_t)t * ZLD + OFF_B + 256 + 4 * lane);
              const float mean = wave_sum((v.x + v.y) + (v.z + v.w)) * (1.f / 256); const f32x4 d = v - mean;
              const float var = wave_sum((d.x * d.x + d.y * d.y) + (d.z * d.z + d.w * d.w)) * (1.f / 256); const float rstd = 1.0f / sqrtf(var + LN_EPS);
              *(LAS f32x4*)(VN + r * 256 + 4 * lane) = d * rstd * gg + bb; }
          __syncthreads();
          const int i = tid >> 2, cq = tid & 3, t = blk * 128 + i, jmax = (i < 64) ? 64 : 128;
#pragma unroll 1
          for (int g = 0; g < 4; ++g) { f32x4 a0 = {0, 0, 0, 0}, a1 = a0, a2 = a0, a3 = a0;
              const float* wrow = kin(A, I_SG_W) + ((size_t)((l * 4 + g) * 128 + i)) * 128; const LAS float* vb = VN + g * 64 + cq * 16;
              for (int j = 0; j < jmax; j += 4) { const f32x4 w4 = *(const f32x4*)(wrow + j);
#pragma unroll
                  for (int jj = 0; jj < 4; ++jj) { const LAS f32x4* vp = (const LAS f32x4*)(vb + (j + jj) * 256); const float w = w4[jj];
                      a0 += vp[0] * w; a1 += vp[1] * w; a2 += vp[2] * w; a3 += vp[3] * w; } }
              const float bias = kin(A, I_SG_B)[(l * 4 + g) * 128 + i]; const bf16* up = Z + (size_t)t * ZLD + OFF_B + g * 64 + cq * 16;
              const f32x4 o0 = ld4bf(up) * (a0 + bias), o1 = ld4bf(up + 4) * (a1 + bias), o2 = ld4bf(up + 8) * (a2 + bias), o3 = ld4bf(up + 12) * (a3 + bias);
              v4u wa, wb; wa.x = pk2(o0.x, o0.y); wa.y = pk2(o0.z, o0.w); wa.z = pk2(o1.x, o1.y); wa.w = pk2(o1.z, o1.w); wb.x = pk2(o2.x, o2.y); wb.y = pk2(o2.z, o2.w); wb.z = pk2(o3.x, o3.y); wb.w = pk2(o3.z, o3.w);
              bf16* op = O16 + (size_t)t * D + 256 + g * 64 + cq * 16; *(v4u*)op = wa; *(v4u*)(op + 8) = wb; }
          __syncthreads();
      } }
    for (int rp_ = 0; rp_ < ((PROBE_PHASE == 103) ? PROBE_REPS : 1); ++rp_) {
      bf16* LA = (bf16*)(F.ws + WS_LA16); const f32x4 mul = *(const f32x4*)(kin(A, I_RW_MU) + l * 1024 + 768 + 4 * lane);
      for (int t = gw; t < T; t += NGW) { const int s = t & (SEQ - 1); const bf16* zr = Z + (size_t)t * ZLD + OFF_C + 768 + 4 * lane;
          f32x4 x = ld4bf(zr); f32x4 pv = {0, 0, 0, 0}; if (s > 0) pv = ld4bf(zr - ZLD); x = x + (pv - x) * mul;
          if (lane < 16) { x.x = tanhf(x.x); x.y = tanhf(x.y); x.z = tanhf(x.z); x.w = tanhf(x.w); }
          else if (lane >= 32) x = sig4(x);
          v2u w; w.x = pk2(x.x, x.y); w.y = pk2(x.z, x.w); *(v2u*)(LA + (size_t)t * 256 + 4 * lane) = w; } }
}

__device__ __forceinline__ void p_rw_chunks(KArgs& A, const Frame& F, int l) {
    const int gw = F.bid * NWAVES + F.wave, NGW = F.G * NWAVES, lane = F.lane;
    const bf16* Z = (const bf16*)(F.ws + WS_Z); const float* DEC = (const float*)(F.ws + WS_DEC); const float* AV = (const float*)(F.ws + WS_AV);
    float* QH = (float*)(F.ws + WS_QH); float* YL = (float*)(F.ws + WS_YL); float* GC = (float*)(F.ws + WS_GC); float* HC = (float*)(F.ws + WS_HC); float* RK = (float*)(F.ws + WS_RK);
    LAS float* wl = (LAS float*)(F.lds + F.wave * 16384);
    for (int task = gw; task < 16 * NCH; task += NGW) { const int bh = task / NCH, ck = task % NCH, b = bh >> 2, head = bh & 3, c = head * 64 + lane;
        const float mu_r = kin(A, I_RW_MU)[l * 1024 + c], mu_k = kin(A, I_RW_MU)[l * 1024 + 256 + c], mu_v = kin(A, I_RW_MU)[l * 1024 + 512 + c];
        const float kkc = kin(A, I_RW_KK)[l * 256 + c], kac = kin(A, I_RW_KA)[l * 256 + c], rkc = kin(A, I_RW_RK)[l * 256 + c];
        float sp[64], sl[64];
        { const int ln = launder_v(lane);
#pragma unroll
          for (int k = 0; k < 64; ++k) { sp[k] = (k == ln) ? 1.0f : 0.0f; sl[k] = 0.0f; } }
        const int tg0 = b * SEQ + ck * CH;
        float pr = 0.f, pk = 0.f, pv = 0.f;
        if (ck > 0) { const bf16* zp = Z + (size_t)(tg0 - 1) * ZLD + OFF_C + c; pr = bf2f(zp[0]); pk = bf2f(zp[256]); pv = bf2f(zp[512]); }
#pragma unroll 1
        for (int sb = 0; sb < CH / 8; ++sb) {
#pragma unroll 1
            for (int hb = 0; hb < 2; ++hb) {
                float kk[4], dc[4], av[4], rs[4], k2[4], vs[4], ss[4], rkp[4];
#pragma unroll
                for (int i = 0; i < 4; ++i) { const int t = tg0 + sb * 8 + hb * 4 + i; const bf16* zr = Z + (size_t)t * ZLD + OFF_C + c;
                    const float r = bf2f(zr[0]), k = bf2f(zr[256]), v = bf2f(zr[512]); dc[i] = DEC[(size_t)t * 256 + c]; av[i] = AV[(size_t)t * 256 + c];
                    rs[i] = r + (pr - r) * mu_r; const float ks = k + (pk - k) * mu_k; vs[i] = v + (pv - v) * mu_v; pr = r; pk = k; pv = v;
                    kk[i] = ks * kkc; k2[i] = ks * (1.0f + (av[i] - 1.0f) * kac); ss[i] = kk[i] * kk[i]; rkp[i] = rs[i] * k2[i] * rkc; }
#pragma unroll
                for (int o = 1; o < 64; o <<= 1) {
#pragma unroll
                    for (int i = 0; i < 4; ++i) { ss[i] += shfl_xor_l(ss[i], o, lane); rkp[i] += shfl_xor_l(rkp[i], o, lane); } }
#pragma unroll
                for (int i = 0; i < 4; ++i) { const float inv = 1.0f / fmaxf(sqrtf(ss[i]), 1e-12f), kn = kk[i] * inv; LAS float* w = wl + (hb * 4 + i) * 384 + lane;
                    w[0] = -kn; w[64] = dc[i]; w[128] = kn * av[i]; w[192] = rs[i]; w[256] = k2[i]; w[320] = vs[i];
                    if (lane == 0) RK[(size_t)(tg0 + sb * 8 + hb * 4 + i) * 4 + head] = rkp[i]; }
            }
            LDS_WAIT();
#pragma unroll 1
            for (int st = 0; st < 8; ++st) { const LAS f32x4* base = (const LAS f32x4*)(wl + st * 384);
                float saP = 0.f, saL = 0.f;
#pragma unroll
                for (int q = 0; q < 16; ++q) { const f32x4 nk = base[q];
                    saP += sp[4 * q] * nk.x; saP += sp[4 * q + 1] * nk.y; saP += sp[4 * q + 2] * nk.z; saP += sp[4 * q + 3] * nk.w;
                    saL += sl[4 * q] * nk.x; saL += sl[4 * q + 1] * nk.y; saL += sl[4 * q + 2] * nk.z; saL += sl[4 * q + 3] * nk.w;
                    if ((q & 3) == 3) __builtin_amdgcn_sched_barrier(0); }
                const float vj = wl[st * 384 + 320 + lane];
                float yP = 0.f, yL = 0.f;
                f32x4 w = base[16], bq = base[32], r = base[48], kv = base[64];
#pragma unroll
                for (int q = 0; q < 16; ++q) { f32x4 wn = w, bn = bq, rn = r, kn = kv;
                    if (q < 15) { wn = base[16 + q + 1]; bn = base[32 + q + 1]; rn = base[48 + q + 1]; kn = base[64 + q + 1]; }
#pragma unroll
                    for (int e = 0; e < 4; ++e) { const int k = 4 * q + e;
                        sp[k] = sp[k] * w[e] + saP * bq[e]; sl[k] = sl[k] * w[e] + saL * bq[e] + vj * kv[e];
                        yP += sp[k] * r[e]; yL += sl[k] * r[e]; }
                    __builtin_amdgcn_sched_barrier(0);
                    w = wn; bq = bn; r = rn; kv = kn; }
                const size_t oi = ((size_t)(bh * SEQ + ck * CH + sb * 8 + st)) * 64 + lane;
                QH[oi] = yP; YL[oi] = yL; }
        }
        float* gp = GC + ((size_t)(bh * NCH + ck) * 64 + lane) * 64; float* hp = HC + ((size_t)(bh * NCH + ck) * 64 + lane) * 64;
#pragma unroll
        for (int q = 0; q < 16; ++q) { *(f32x4*)(gp + 4 * q) = (f32x4){sp[4 * q], sp[4 * q + 1], sp[4 * q + 2], sp[4 * q + 3]}; *(f32x4*)(hp + 4 * q) = (f32x4){sl[4 * q], sl[4 * q + 1], sl[4 * q + 2], sl[4 * q + 3]}; }
    }
}
__device__ __forceinline__ void p_s5_chain(KArgs& A, const Frame& F, int l) {
    const int gt = F.bid * NTHREADS + F.tid; if (gt >= NB * 16 * 64) return;
    const int b = gt >> 10, g = (gt >> 6) & 15, p = gt & 63;
    const float dt = expf(kin(A, I_S5_LOGDT)[l * 16 + g]); const float are = kin(A, I_S5_ARE)[(l * 16 + g) * 64 + p], aim = kin(A, I_S5_AIM)[(l * 16 + g) * 64 + p];
    const float mag = expf(are * dt * 64.0f); float sn, cs; sincosf(aim * dt * 64.0f, &sn, &cs); const float ar = mag * cs, ai = mag * sn;
    bf16* AO = (bf16*)(F.ws + WS_AOUT); const float* XL = (const float*)(F.ws + WS_XLOC);
    float xr = 0.f, xi = 0.f;
#pragma unroll 8
    for (int c = 0; c < NCH; ++c) { const size_t row = (size_t)g * NCHT + b * NCH + c;
        *(unsigned*)(AO + row * S5K + 1024 + 2 * p) = pk2(xr, xi);
        const f32x2 xl = *(const f32x2*)(XL + row * 128 + 2 * p);
        const float nr = ar * xr - ai * xi + xl.x, ni = ar * xi + ai * xr + xl.y; xr = nr; xi = ni; }
}
constexpr int CB = 8, NBLK = NCH / CB;
__device__ __forceinline__ void chain_load_g(const float* G, float (&ga)[64], int fr, int fq) {
#pragma unroll
    for (int jr = 0; jr < 16; ++jr)
#pragma unroll
        for (int mt = 0; mt < 4; ++mt) ga[jr * 4 + mt] = G[(size_t)((jr >> 2) * 16 + 4 * fq + (jr & 3)) * 64 + 16 * mt + fr];
}
__device__ __forceinline__ void chain_step(f32x4 (&acc)[4], const float (&ga)[64], const f32x4 (&ci)[4]) {
    f32x4 na[4] = {ci[0], ci[1], ci[2], ci[3]};
#pragma unroll
    for (int jr = 0; jr < 16; ++jr)
#pragma unroll
        for (int mt = 0; mt < 4; ++mt) na[mt] = __builtin_amdgcn_mfma_f32_16x16x4f32(ga[jr * 4 + mt], acc[jr >> 2][jr & 3], na[mt], 0, 0, 0);
#pragma unroll
    for (int mt = 0; mt < 4; ++mt) acc[mt] = na[mt];
}
__device__ __forceinline__ void chain_load_tile(const float* M, int rb, f32x4 (&t)[4], int fr, int fq) {
#pragma unroll
    for (int jt = 0; jt < 4; ++jt) t[jt] = *(const f32x4*)(M + (size_t)(16 * rb + fr) * 64 + 16 * jt + 4 * fq);
}
__device__ __forceinline__ void chain_store_tile(float* M, int rb, const f32x4 (&t)[4], int fr, int fq) {
#pragma unroll
    for (int jt = 0; jt < 4; ++jt) *(f32x4*)(M + (size_t)(16 * rb + fr) * 64 + 16 * jt + 4 * fq) = t[jt];
}
__device__ __forceinline__ void p_chain_compose(const Frame& F) {
    const int gw = F.bid * NWAVES + F.wave, NGW = F.G * NWAVES, ln_ = my_lane(), fr = ln_ & 15, fq = ln_ >> 4;
    const float* GC = (const float*)(F.ws + WS_GC); const float* HC = (const float*)(F.ws + WS_HC); float* GB = (float*)(F.ws + WS_GB); float* HB = (float*)(F.ws + WS_HB);
    for (int task = gw; task < 16 * NBLK * 8; task += NGW) { const int cb = task & 7, bb = task >> 3, rb = cb & 3; const bool isH = cb >= 4;
        const size_t c0 = (size_t)bb * CB;
        f32x4 acc[4]; chain_load_tile((isH ? HC : GC) + c0 * 4096, rb, acc, fr, fq);
        float ga[64]; chain_load_g(GC + (c0 + 1) * 4096, ga, fr, fq);
#pragma unroll 1
        for (int i = 1; i < CB; ++i) { f32x4 ci[4] = {{0, 0, 0, 0}, {0, 0, 0, 0}, {0, 0, 0, 0}, {0, 0, 0, 0}};
            if (isH) chain_load_tile(HC + (c0 + i) * 4096, rb, ci, fr, fq);
            float gn[64];
            if (i + 1 < CB) chain_load_g(GC + (c0 + i + 1) * 4096, gn, fr, fq);
            chain_step(acc, ga, ci);
            if (i + 1 < CB) {
#pragma unroll
                for (int k = 0; k < 64; ++k) ga[k] = gn[k]; } }
        chain_store_tile((isH ? HB : GB) + (size_t)bb * 4096, rb, acc, fr, fq);
    }
}
__device__ __forceinline__ void p_chain_blocks(const Frame& F, int gw, int NGW) {
    const int ln_ = my_lane(), fr = ln_ & 15, fq = ln_ >> 4;
    const float* GB = (const float*)(F.ws + WS_GB); const float* HB = (const float*)(F.ws + WS_HB); float* SB = (float*)(F.ws + WS_SB);
    for (int task = gw; task < 16 * 4; task += NGW) { const int vb = task & 3, bh = task >> 2;
        f32x4 acc[4] = {{0, 0, 0, 0}, {0, 0, 0, 0}, {0, 0, 0, 0}, {0, 0, 0, 0}};
        float ga[64]; chain_load_g(GB + (size_t)bh * NBLK * 4096, ga, fr, fq);
#pragma unroll 1
        for (int blk = 0; blk < NBLK; ++blk) { const size_t bb = (size_t)bh * NBLK + blk;
            chain_store_tile(SB + bb * 4096, vb, acc, fr, fq);
            if (blk + 1 == NBLK) break;
            f32x4 ci[4]; chain_load_tile(HB + bb * 4096, vb, ci, fr, fq);
            float gn[64]; chain_load_g(GB + (bb + 1) * 4096, gn, fr, fq);
            chain_step(acc, ga, ci);
#pragma unroll
            for (int k = 0; k < 64; ++k) ga[k] = gn[k]; }
    }
}
__device__ __forceinline__ void chain_inblock(const Frame& F, int bb, int vb) {
    const int ln_ = my_lane(), fr = ln_ & 15, fq = ln_ >> 4;
    const float* GC = (const float*)(F.ws + WS_GC); const float* HC = (const float*)(F.ws + WS_HC); const float* SB = (const float*)(F.ws + WS_SB); float* SC = (float*)(F.ws + WS_SC);
    const size_t c0 = (size_t)bb * CB;
    f32x4 acc[4]; chain_load_tile(SB + (size_t)bb * 4096, vb, acc, fr, fq);
    float ga[64]; chain_load_g(GC + c0 * 4096, ga, fr, fq);
#pragma unroll 1
    for (int i = 0; i < CB; ++i) {
        chain_store_tile(SC + (c0 + i) * 4096, vb, acc, fr, fq);
        if (i + 1 == CB) break;
        f32x4 ci[4]; chain_load_tile(HC + (c0 + i) * 4096, vb, ci, fr, fq);
        float gn[64]; chain_load_g(GC + (c0 + i + 1) * 4096, gn, fr, fq);
        chain_step(acc, ga, ci);
#pragma unroll
        for (int k = 0; k < 64; ++k) ga[k] = gn[k]; }
}
__device__ __forceinline__ void rw_out_task(KArgs& A, const Frame& F, int l, int task) {
    const int lane = F.lane;
    const bf16* Z = (const bf16*)(F.ws + WS_Z); const float* QH = (const float*)(F.ws + WS_QH); const float* YL = (const float*)(F.ws + WS_YL); const float* SC = (const float*)(F.ws + WS_SC);
    const float* RWG = (const float*)(F.ws + WS_RWG); const float* RK = (const float*)(F.ws + WS_RK); bf16* O16 = (bf16*)(F.ws + WS_O16);
    LAS float* Qw = (LAS float*)(F.lds + F.wave * 16384);
    { const int bh = task / NCH, ck = task % NCH, b = bh >> 2, head = bh & 3;
        const size_t ti0 = (size_t)(bh * SEQ + ck * CH); const int t0g = b * SEQ + ck * CH;
        { const f32x4* qsrc = (const f32x4*)(QH + ti0 * 64) + lane; LAS f32x4* qdst = (LAS f32x4*)Qw + lane;
#pragma unroll
          for (int i = 0; i < 16; ++i) qdst[i * 64] = qsrc[i * 64]; }
        float srow[64];
        { const f32x4* ssrc = (const f32x4*)(SC + (size_t)(bh * NCH + ck) * 4096 + lane * 64);
#pragma unroll
          for (int i = 0; i < 16; ++i) { const f32x4 x = ssrc[i]; srow[4 * i] = x.x; srow[4 * i + 1] = x.y; srow[4 * i + 2] = x.z; srow[4 * i + 3] = x.w; } }
        const float lgv = kin(A, I_RW_LNG)[l * 256 + head * 64 + lane], lbv = kin(A, I_RW_LNB)[l * 256 + head * 64 + lane], mu_v = kin(A, I_RW_MU)[l * 1024 + 512 + head * 64 + lane];
        LDS_WAIT();
#pragma unroll 1
        for (int tb = 0; tb < CH; tb += 4) { float y[4], s1[4], s2[4];
#pragma unroll
            for (int u = 0; u < 4; ++u) { const int t = tb + u; float a = YL[(ti0 + t) * 64 + lane]; const LAS f32x4* qp = (const LAS f32x4*)(Qw + t * 64);
#pragma unroll
                for (int i = 0; i < 16; ++i) { const f32x4 qv = qp[i]; a += srow[4 * i] * qv.x; a += srow[4 * i + 1] * qv.y; a += srow[4 * i + 2] * qv.z; a += srow[4 * i + 3] * qv.w; }
                y[u] = a; s1[u] = a; s2[u] = a * a; }
#pragma unroll
            for (int o = 1; o < 64; o <<= 1) {
#pragma unroll
                for (int u = 0; u < 4; ++u) { s1[u] += shfl_xor_l(s1[u], o, lane); s2[u] += shfl_xor_l(s2[u], o, lane); } }
#pragma unroll
            for (int u = 0; u < 4; ++u) { const int t = tb + u; const float m = s1[u] * (1.f / 64), var = fmaxf(s2[u] * (1.f / 64) - m * m, 0.f); const float rstd = 1.0f / sqrtf(var + RW_LN_EPS);
                const float rk = RK[(size_t)(t0g + t) * 4 + head]; const bf16* zv = Z + (size_t)(t0g + t) * ZLD + OFF_C + 512 + head * 64 + lane; const float v1 = bf2f(zv[0]), v0 = (ck * CH + t > 0) ? bf2f(*(zv - ZLD)) : 0.f; const float vv = v1 + (v0 - v1) * mu_v; const float gg = RWG[(size_t)(t0g + t) * 256 + head * 64 + lane];
                const float o = ((y[u] - m) * rstd * lgv + lbv + rk * vv) * gg;
                O16[(size_t)(t0g + t) * D + 512 + head * 64 + lane] = (bf16)f2bf(o); }
        }
        LDS_WAIT();
    }
}
template <int LSTRIDE> __device__ __forceinline__ void attn_stage(LAS unsigned char* lds, const bf16* src, size_t row_stride, int tid) {
    const int r0 = tid >> 5, c = tid & 31; const bf16* sp = src + (size_t)r0 * row_stride + c * 8; LAS unsigned char* dp = lds + r0 * LSTRIDE + c * 16;
#pragma unroll 4
    for (int i = 0; i < 16; ++i) { const v4u v = *(const v4u*)(sp + (size_t)(16 * i) * row_stride); *(LAS v4u*)(dp + 16 * i * LSTRIDE) = v; }
}
constexpr int KSTR = 544, VSTR = 528;
__device__ __forceinline__ void p_attn(const Frame& F) {
    const int lane = F.lane, fr = lane & 15, fq = lane >> 4;
    const bf16* Q = (const bf16*)(F.ws + WS_Q16); const bf16* KM = (const bf16*)(F.ws + WS_KM16); const bf16* VT = (const bf16*)(F.ws + WS_VMT16); bf16* AO = (bf16*)(F.ws + WS_AO16);
    for (int item = F.bid; item < NB * 4 * (SEQ / 256); item += F.G) {
        const int qg = item % (SEQ / 256), bhd = item / (SEQ / 256), head = bhd & 3, b = bhd >> 2;
        attn_stage<KSTR>(F.lds, KM + (size_t)(b * NMEM) * D + head * 256, D, F.tid);
        __syncthreads();
        v4u pf[2][8]; float inv[2];
#pragma unroll
        for (int u = 0; u < 2; ++u) { const int q0 = b * SEQ + qg * 256 + u * 128 + F.wave * 16;
            bf16x8 qf[8];
#pragma unroll
            for (int ks = 0; ks < 8; ++ks) qf[ks] = *(const bf16x8*)(Q + (size_t)(q0 + fr) * D + head * 256 + ks * 32 + fq * 8);
            f32x4 sT[16];
            const LAS unsigned char* kbase = F.lds + fr * KSTR + fq * 16;
#pragma unroll
            for (int kt = 0; kt < 16; ++kt) { f32x4 a = {0, 0, 0, 0}; const LAS unsigned char* kp = kbase + kt * 16 * KSTR;
#pragma unroll
                for (int ks = 0; ks < 8; ++ks) { const bf16x8 kf = *(const LAS bf16x8*)(kp + ks * 64); a = __builtin_amdgcn_mfma_f32_16x16x32_bf16(kf, qf[ks], a, 0, 0, 0); }
                sT[kt] = a; if (kt & 1) __builtin_amdgcn_sched_barrier(0); }
            float mx = -3.0e38f;
#pragma unroll
            for (int kt = 0; kt < 16; ++kt) mx = fmaxf(fmaxf(fmaxf(mx, sT[kt].x), fmaxf(sT[kt].y, sT[kt].z)), sT[kt].w);
            mx = fmaxf(mx, shfl_xor_l(mx, 16, lane)); mx = fmaxf(mx, shfl_xor_l(mx, 32, lane));
            float sum = 0.f;
#pragma unroll
            for (int kt = 0; kt < 16; ++kt) { sT[kt].x = __expf(sT[kt].x - mx); sT[kt].y = __expf(sT[kt].y - mx); sT[kt].z = __expf(sT[kt].z - mx); sT[kt].w = __expf(sT[kt].w - mx); sum += (sT[kt].x + sT[kt].y) + (sT[kt].z + sT[kt].w); }
            sum += shfl_xor_l(sum, 16, lane); sum += shfl_xor_l(sum, 32, lane);
            inv[u] = 1.0f / sum;
#pragma unroll
            for (int kp = 0; kp < 8; ++kp) { v4u w; w.x = pk2(sT[2 * kp].x, sT[2 * kp].y); w.y = pk2(sT[2 * kp].z, sT[2 * kp].w); w.z = pk2(sT[2 * kp + 1].x, sT[2 * kp + 1].y); w.w = pk2(sT[2 * kp + 1].z, sT[2 * kp + 1].w); pf[u][kp] = w; }
            __builtin_amdgcn_sched_barrier(0);
        }
        __syncthreads();
        attn_stage<VSTR>(F.lds, VT + (size_t)(b * D + head * 256) * NMEM, NMEM, F.tid);
        __syncthreads();
#pragma unroll
        for (int u = 0; u < 2; ++u) { const int q0 = b * SEQ + qg * 256 + u * 128 + F.wave * 16;
#pragma unroll 2
            for (int dt = 0; dt < 16; ++dt) { f32x4 o = {0, 0, 0, 0}; const LAS unsigned char* vp = F.lds + (dt * 16 + fr) * VSTR + fq * 8;
#pragma unroll
                for (int kp = 0; kp < 8; ++kp) {
                    const v2u lo = *(const LAS v2u*)(vp + 64 * kp), hi = *(const LAS v2u*)(vp + 64 * kp + 32); v4u w; w.x = lo.x; w.y = lo.y; w.z = hi.x; w.w = hi.y;
                    o = __builtin_amdgcn_mfma_f32_16x16x32_bf16(__builtin_bit_cast(bf16x8, w), __builtin_bit_cast(bf16x8, pf[u][kp]), o, 0, 0, 0); }
                v2u w; w.x = pk2(o.x * inv[u], o.y * inv[u]); w.y = pk2(o.z * inv[u], o.w * inv[u]);
                *(v2u*)(AO + (size_t)(q0 + fr) * D + head * 256 + dt * 16 + 4 * fq) = w; __builtin_amdgcn_sched_barrier(0); } }
        __syncthreads();
    }
}

__device__ __forceinline__ void p_ln(const Frame& F, const float* g, const float* b, bool dummy) {
    const int gw = F.bid * NWAVES + F.wave, NGW = F.G * NWAVES, lane = F.lane; const float* H = (const float*)(F.ws + WS_H32); float* Ho = (float*)(F.ws + (dummy ? WS_Z : WS_H32)); bf16* H16 = (bf16*)(F.ws + (dummy ? WS_Z + 128 * MiB : WS_H16));
    for (int r = gw; r < T; r += NGW) { f32x4 v[4];
#pragma unroll
        for (int j = 0; j < 4; ++j) v[j] = *(const f32x4*)(H + (size_t)r * D + 256 * j + 4 * lane);
        float mean, rstd; ln_stats(v, mean, rstd); ln_apply_store(v, mean, rstd, g, b, Ho + (size_t)r * D, H16 + (size_t)r * D, lane); }
}
__device__ __forceinline__ void p_ln_router(KArgs& A, const Frame& F, int l, bool dummy) {
    const int gw = F.bid * NWAVES + F.wave, NGW = F.G * NWAVES, lane = F.lane, tid = F.tid, fr = lane & 15, fq = lane >> 4;
    const float* H = (const float*)(F.ws + WS_H32); float* Ho = (float*)(F.ws + (dummy ? WS_Z : WS_H32)); bf16* H16 = (bf16*)(F.ws + (dummy ? WS_Z + 128 * MiB : WS_H16)); int* TOKE = (int*)(F.ws + (dummy ? WS_Z + 200 * MiB : WS_TOKE)); float* TOKW = (float*)(F.ws + (dummy ? WS_Z + 201 * MiB : WS_TOKW));
    LAS v4u* TB = (LAS v4u*)F.lds;
    LAS float* PS = (LAS float*)(F.lds + 131072);
    volatile LAS unsigned* hist = F.MISC + MI_HIST;
    const float* rw = kin(A, I_ROUTER_W) + (size_t)l * D * NE; const float* rb = kin(A, I_ROUTER_B) + l * NE; const float* g = kin(A, I_LN2_G) + l * D; const float* bb = kin(A, I_LN2_B) + l * D;
    for (int en = tid; en < 32 * 2 * 64; en += NTHREADS) { const int ln = en & 63, et = (en >> 6) & 1, ks = en >> 7, efr = ln & 15, efq = ln >> 4; float hi[8], lo[8];
#pragma unroll
        for (int j = 0; j < 8; ++j) { const int d = 32 * ks + 8 * efq + j; const float v = g[d] * rw[d * NE + et * 16 + efr]; const float h = bf2f(f2bf(v)); hi[j] = h; lo[j] = v - h; }
        v4u wh, wl; wh.x = pk2(hi[0], hi[1]); wh.y = pk2(hi[2], hi[3]); wh.z = pk2(hi[4], hi[5]); wh.w = pk2(hi[6], hi[7]); wl.x = pk2(lo[0], lo[1]); wl.y = pk2(lo[2], lo[3]); wl.z = pk2(lo[4], lo[5]); wl.w = pk2(lo[6], lo[7]);
        TB[((ks * 2 + et) * 2 + 0) * 64 + ln] = wh; TB[((ks * 2 + et) * 2 + 1) * 64 + ln] = wl; }
    { const int e = tid & 31, part = tid >> 5; float sg = 0.f, sb = 0.f;
      for (int d = part * 64; d < part * 64 + 64; ++d) { const float w = rw[d * NE + e]; sg += g[d] * w; sb += bb[d] * w; }
      PS[part * 32 + e] = sg; PS[512 + part * 32 + e] = sb; }
    if (tid < NE) hist[tid] = 0u;
    __syncthreads();
    if (tid < NE) { float sg = 0.f, sb = 0.f;
#pragma unroll
        for (int p = 0; p < 16; ++p) { sg += PS[p * 32 + tid]; sb += PS[512 + p * 32 + tid]; }
        PS[1024 + tid] = sg; PS[1056 + tid] = sb + rb[tid]; }
    __syncthreads();
    const float cg0 = PS[1024 + fr], cg1 = PS[1024 + 16 + fr], cb0 = PS[1056 + fr], cb1 = PS[1056 + 16 + fr];
    for (int grp = gw; grp < T / 16; grp += NGW) { const int r0 = grp * 16; const float* xrow = H + (size_t)(r0 + fr) * D + 8 * fq;
        f32x4 acc0 = {0, 0, 0, 0}, acc1 = {0, 0, 0, 0}; float sum = 0.f, sq = 0.f;
#pragma unroll 2
        for (int ks = 0; ks < 32; ++ks) { const f32x4 xa = *(const f32x4*)(xrow + 32 * ks), xb = *(const f32x4*)(xrow + 32 * ks + 4);
            sum += (xa.x + xa.y) + (xa.z + xa.w) + (xb.x + xb.y) + (xb.z + xb.w);
            sq += (xa.x * xa.x + xa.y * xa.y) + (xa.z * xa.z + xa.w * xa.w) + (xb.x * xb.x + xb.y * xb.y) + (xb.z * xb.z + xb.w * xb.w);
            v4u ah, al; { const unsigned h0 = f2bf(xa.x), h1 = f2bf(xa.y), h2 = f2bf(xa.z), h3 = f2bf(xa.w), h4 = f2bf(xb.x), h5 = f2bf(xb.y), h6 = f2bf(xb.z), h7 = f2bf(xb.w);
                ah.x = h0 | (h1 << 16); ah.y = h2 | (h3 << 16); ah.z = h4 | (h5 << 16); ah.w = h6 | (h7 << 16);
                al.x = pk2(xa.x - bf2f(h0), xa.y - bf2f(h1)); al.y = pk2(xa.z - bf2f(h2), xa.w - bf2f(h3)); al.z = pk2(xb.x - bf2f(h4), xb.y - bf2f(h5)); al.w = pk2(xb.z - bf2f(h6), xb.w - bf2f(h7)); }
            const LAS v4u* tb = TB + (ks * 4) * 64 + lane; const v4u b0h = tb[0], b0l = tb[64], b1h = tb[128], b1l = tb[192];
            const bf16x8 Ah = __builtin_bit_cast(bf16x8, ah), Al = __builtin_bit_cast(bf16x8, al);
            acc0 = __builtin_amdgcn_mfma_f32_16x16x32_bf16(Ah, __builtin_bit_cast(bf16x8, b0h), acc0, 0, 0, 0); acc0 = __builtin_amdgcn_mfma_f32_16x16x32_bf16(Ah, __builtin_bit_cast(bf16x8, b0l), acc0, 0, 0, 0); acc0 = __builtin_amdgcn_mfma_f32_16x16x32_bf16(Al, __builtin_bit_cast(bf16x8, b0h), acc0, 0, 0, 0);
            acc1 = __builtin_amdgcn_mfma_f32_16x16x32_bf16(Ah, __builtin_bit_cast(bf16x8, b1h), acc1, 0, 0, 0); acc1 = __builtin_amdgcn_mfma_f32_16x16x32_bf16(Ah, __builtin_bit_cast(bf16x8, b1l), acc1, 0, 0, 0); acc1 = __builtin_amdgcn_mfma_f32_16x16x32_bf16(Al, __builtin_bit_cast(bf16x8, b1h), acc1, 0, 0, 0); }
        sum += shfl_xor_l(sum, 16, lane); sum += shfl_xor_l(sum, 32, lane); sq += shfl_xor_l(sq, 16, lane); sq += shfl_xor_l(sq, 32, lane);
        const float mean = sum * (1.f / D), rstd = 1.0f / sqrtf(fmaxf(sq * (1.f / D) - mean * mean, 0.f) + LN_EPS);
        float v0[4], v1[4];
#pragma unroll
        for (int reg = 0; reg < 4; ++reg) { const float rs = __builtin_bit_cast(float, shfl_idx_l(__builtin_bit_cast(int, rstd), 4 * fq + reg)), mn = __builtin_bit_cast(float, shfl_idx_l(__builtin_bit_cast(int, mean), 4 * fq + reg));
            v0[reg] = rs * acc0[reg] - rs * mn * cg0 + cb0; v1[reg] = rs * acc1[reg] - rs * mn * cg1 + cb1; }
        float wv[4][4]; int wi[4][4];
#pragma unroll
        for (int k = 0; k < 4; ++k) {
#pragma unroll
            for (int reg = 0; reg < 4; ++reg) { float bv = v0[reg]; int bi = fr; if (v1[reg] > bv) { bv = v1[reg]; bi = 16 + fr; }
#pragma unroll
                for (int o = 1; o < 16; o <<= 1) { const float ov = shfl_xor_l(bv, o, lane); const int oi = shfl_idx_l(bi, lane ^ o); if (ov > bv || (ov == bv && oi < bi)) { bv = ov; bi = oi; } }
                wv[k][reg] = bv; wi[k][reg] = bi; if (bi == fr) v0[reg] = -3.0e38f; if (bi == 16 + fr) v1[reg] = -3.0e38f; } }
        if (fr == 0) {
#pragma unroll
            for (int reg = 0; reg < 4; ++reg) { const int t = r0 + 4 * fq + reg; const float e1 = __expf(wv[1][reg] - wv[0][reg]), e2 = __expf(wv[2][reg] - wv[0][reg]), e3 = __expf(wv[3][reg] - wv[0][reg]), inv = 1.0f / (1.0f + e1 + e2 + e3);
                *(int4*)(TOKE + (size_t)t * 4) = make_int4(wi[0][reg], wi[1][reg], wi[2][reg], wi[3][reg]); *(f32x4*)(TOKW + (size_t)t * 4) = (f32x4){inv, e1 * inv, e2 * inv, e3 * inv};
#pragma unroll
                for (int k = 0; k < 4; ++k) __hip_atomic_fetch_add((LAS unsigned*)&hist[wi[k][reg]], 1u, __ATOMIC_RELAXED, __HIP_MEMORY_SCOPE_WORKGROUP); } }
        float* orow = Ho + (size_t)(r0 + fr) * D + 8 * fq; bf16* o16 = H16 + (size_t)(r0 + fr) * D + 8 * fq;
#pragma unroll 2
        for (int ks = 0; ks < 32; ++ks) { const f32x4 xa = *(const f32x4*)(xrow + 32 * ks), xb = *(const f32x4*)(xrow + 32 * ks + 4);
            const f32x4 ga = *(const f32x4*)(g + 32 * ks + 8 * fq), gb = *(const f32x4*)(g + 32 * ks + 8 * fq + 4), ba = *(const f32x4*)(bb + 32 * ks + 8 * fq), bc = *(const f32x4*)(bb + 32 * ks + 8 * fq + 4);
            const f32x4 ya = (xa - mean) * rstd * ga + ba, yb = (xb - mean) * rstd * gb + bc;
            *(f32x4*)(orow + 32 * ks) = ya; *(f32x4*)(orow + 32 * ks + 4) = yb;
            v4u w; w.x = pk2(ya.x, ya.y); w.y = pk2(ya.z, ya.w); w.z = pk2(yb.x, yb.y); w.w = pk2(yb.z, yb.w); *(v4u*)(o16 + 32 * ks) = w; }
    }
    __syncthreads();
    if (tid < NE && !dummy) { const unsigned c = hist[tid]; if (c) atomicAdd(F.ctl + CW_CNT + l * NE + tid, c); F.ctl[CW_WGH + (l * 512 + F.bid) * NE + tid] = c; }
}
__device__ __forceinline__ void moe_offsets(const Frame& F, int l) {
    if (F.tid == 0) { int acc = 0;
        for (int e = 0; e < NE; ++e) { F.MISC[MI_TOFF + e] = (unsigned)acc; const unsigned c = __hip_atomic_load(F.ctl + CW_CNT + l * NE + e, __ATOMIC_RELAXED, __HIP_MEMORY_SCOPE_AGENT); acc += (int)((c + 255u) >> 8); }
        F.MISC[MI_TOFF + NE] = (unsigned)acc; }
    __syncthreads();
}
__device__ __forceinline__ void p_moe_slots(const Frame& F, int l, int dummy) {
    const int gw = F.bid * NWAVES + F.wave, NGW = F.G * NWAVES, lane = F.lane;
    moe_offsets(F, l);
    const int* TOKE = (const int*)(F.ws + WS_TOKE); const float* TOKW = (const float*)(F.ws + WS_TOKW); int* TOKS = (int*)(F.ws + (dummy ? WS_END : WS_TOKS)); float* SLOTW = (float*)(F.ws + (dummy ? WS_END + 1 * MiB : WS_SLOTW));
    const bf16* H16 = (const bf16*)(F.ws + WS_H16); bf16* XG = (bf16*)(F.ws + (dummy ? WS_ACT : WS_XG)); unsigned* CUR = F.ctl + CW_CUR + l * NE + dummy * 256;
    if (F.tid < NE) { const unsigned c = F.ctl[CW_WGH + (l * 512 + F.bid) * NE + F.tid]; const unsigned base = c ? atomicAdd(CUR + F.tid, c) : 0u;
        F.MISC[MI_LBASE + F.tid] = F.MISC[MI_TOFF + F.tid] * 256u + base; F.MISC[MI_LCUR + F.tid] = 0u; }
    __syncthreads();
    for (int grp = gw; grp < T / 16; grp += NGW)
    for (int r = grp * 16; r < grp * 16 + 16; ++r) { int slot = 0;
        if (lane < 4) { const int e = TOKE[(size_t)r * 4 + lane]; const unsigned pos = __hip_atomic_fetch_add((LAS unsigned*)&F.MISC[MI_LCUR + e], 1u, __ATOMIC_RELAXED, __HIP_MEMORY_SCOPE_WORKGROUP); slot = (int)(F.MISC[MI_LBASE + e] + pos);
            TOKS[(size_t)r * 4 + lane] = slot; SLOTW[slot] = TOKW[(size_t)r * 4 + lane]; }
        const v4u a = *(const v4u*)(H16 + (size_t)r * D + 8 * lane), b = *(const v4u*)(H16 + (size_t)r * D + 512 + 8 * lane);
#pragma unroll
        for (int k = 0; k < 4; ++k) { const int sk = shfl_idx_l(slot, k); *(v4u*)(XG + (size_t)sk * D + 8 * lane) = a; *(v4u*)(XG + (size_t)sk * D + 512 + 8 * lane) = b; } }
}
__device__ __forceinline__ void p_moe_combine(KArgs& A, const Frame& F, int l, bool dummy) {
    const int gw = F.bid * NWAVES + F.wave, NGW = F.G * NWAVES, lane = F.lane;
    const float* H = (const float*)(F.ws + WS_H32); float* Ho = (float*)(F.ws + (dummy ? WS_Z : WS_H32)); bf16* H16 = (bf16*)(F.ws + (dummy ? WS_Z + 128 * MiB : WS_H16)); const int* TOKS = (const int*)(F.ws + WS_TOKS); const bf16* YS = (const bf16*)(F.ws + WS_YS);
    const bool last = (l == NL - 1) && !dummy;
    for (int r = gw; r < T; r += NGW) { f32x4 v[4]; const int4 sl = *(const int4*)(TOKS + (size_t)r * 4);
#pragma unroll
        for (int j = 0; j < 4; ++j) { v[j] = *(const f32x4*)(H + (size_t)r * D + 256 * j + 4 * lane) * DN_ALPHA;
            const v2u y0 = *(const v2u*)(YS + (size_t)sl.x * D + 256 * j + 4 * lane), y1 = *(const v2u*)(YS + (size_t)sl.y * D + 256 * j + 4 * lane), y2 = *(const v2u*)(YS + (size_t)sl.z * D + 256 * j + 4 * lane), y3 = *(const v2u*)(YS + (size_t)sl.w * D + 256 * j + 4 * lane);
            v[j].x += (bf2f(y0.x & 0xffffu) + bf2f(y1.x & 0xffffu)) + (bf2f(y2.x & 0xffffu) + bf2f(y3.x & 0xffffu));
            v[j].y += (bf2f(y0.x >> 16) + bf2f(y1.x >> 16)) + (bf2f(y2.x >> 16) + bf2f(y3.x >> 16));
            v[j].z += (bf2f(y0.y & 0xffffu) + bf2f(y1.y & 0xffffu)) + (bf2f(y2.y & 0xffffu) + bf2f(y3.y & 0xffffu));
            v[j].w += (bf2f(y0.y >> 16) + bf2f(y1.y >> 16)) + (bf2f(y2.y >> 16) + bf2f(y3.y >> 16)); }
        float mean, rstd; ln_stats(v, mean, rstd);
        if (last) ln_apply_store(v, mean, rstd, kin(A, I_LN3_G) + l * D, kin(A, I_LN3_B) + l * D, kout(A) + (size_t)r * D, (bf16*)nullptr, lane);
        else ln_apply_store(v, mean, rstd, kin(A, I_LN3_G) + l * D, kin(A, I_LN3_B) + l * D, Ho + (size_t)r * D, H16 + (size_t)r * D, lane); }
}

constexpr int NPL = 18;
constexpr int NPHASES = 1 + NL * NPL;
#ifndef ONLY
#define ONLY -1
#endif
#define EN(j) (ONLY < 0 || ONLY == (j))
#define DUMMY(j) ((PROBE_PHASE == (j)) && (rep_ + 1 < PROBE_REPS))
#define REPS(j) for (int rep_ = 0; rep_ < ((PROBE_PHASE == (j)) ? PROBE_REPS : 1); ++rep_, __syncthreads())
__global__ void __launch_bounds__(NTHREADS, 2) fwd_kernel(Args args) {
    extern __shared__ __attribute__((aligned(16))) unsigned char lds_raw[];
    Frame F;
    F.lds = (LAS unsigned char*)lds_raw; F.MISC = (volatile LAS unsigned*)(F.lds + MISC_OFF);
    F.tid = threadIdx.x; F.lane = F.tid & 63; F.wave = __builtin_amdgcn_readfirstlane(F.tid >> 6); F.G = gridDim.x; F.bid = blockIdx.x;
    F.ws = (unsigned char*)(GAS unsigned char*)args.ws; F.ctl = (unsigned*)(F.ws + WS_CTL);
    for (int u = F.tid; u < (LDS_BYTES - MISC_OFF) / 4; u += NTHREADS) F.MISC[u] = 0u;
    __syncthreads();
    XcdBarrier bar; bar.bar = F.ctl + CW_BAR; bar.x = 0; bar.st = nullptr;
    const int lo = args.ph_lo, hi = args.ph_hi;
    if (hi - lo > 1) bar = xcd_barrier_post(F.ctl + CW_BAR, F.MISC + 8);
#define IN(k) (launder_i(lo) <= (k) && (k) < launder_i(hi))
#define SEAM(k) do { if (IN(k) && IN((k) + 1)) xcd_barrier(bar); } while (0)
#define PH_BEGIN KArgs& KA = *kargs(); unsigned char* ws = launder_p(args.ws); F.ws = ws; (void)KA; (void)ws; { int ln_; asm volatile("v_mbcnt_lo_u32_b32 %0, -1, 0\n\tv_mbcnt_hi_u32_b32 %0, -1, %0" : "=v"(ln_)); F.lane = ln_; } F.tid = F.wave * 64 + F.lane; F.bid = launder_i((int)blockIdx.x); F.G = launder_i((int)gridDim.x);

    if (EN(100) && IN(0)) REPS(100) { PH_BEGIN p_prologue(KA, F); } SEAM(0);

#pragma unroll 1
    for (int l_ = 0; l_ < NL; ++l_) {
        const int l = launder_i(l_); const int p0 = 1 + l * NPL;
        if (EN(0) && IN(p0 + 0)) REPS(0) { PH_BEGIN
            pg8::Gemm g{D, D, D}; pg8::StaticOrder S{(const bf16*)(ws + WS_H16), (const bf16*)(ws + WS_WINT) + (size_t)l * N_IN * D, D, D, T / 256, N_IN / 256, F.G, F.bid};
            if (PROBE_PHASE == 200) { for (int q_ = 0; q_ < PROBE_REPS - 1; ++q_) { EpiNull E0{0}; pg8::gemm_phase(F.lds, F.wave * 64 + my_lane(), g, S, E0); __syncthreads(); } }
            EpiIn E{l};
            pg8::gemm_phase(F.lds, F.wave * 64 + my_lane(), g, S, E);
        } SEAM(p0 + 0);
        if (EN(1) && IN(p0 + 1)) REPS(1) { PH_BEGIN p_mix1(KA, F, l); } SEAM(p0 + 1);
        if (EN(2) && IN(p0 + 2)) REPS(2) { PH_BEGIN
            { pg8::Gemm g{S5K, 1024, 1024}; pg8::BatchOrder S{(const bf16*)(ws + WS_AOUT), (const bf16*)(ws + WS_S5BC) + (size_t)l * 16 * 256 * 1024, S5K, 1024, NCHT / 256, 1, 16, F.G, F.bid, (size_t)NCHT * S5K, (size_t)256 * 1024};
              EpiXloc E{0}; pg8::gemm_phase(F.lds, F.wave * 64 + my_lane(), g, S, E); }
            __syncthreads();
            { pg8::Gemm g{D, D, D}; pg8::StaticOrder S{(const bf16*)(ws + WS_MEM16), (const bf16*)(ws + WS_WKT) + (size_t)l * D * D, D, D, NB * NMEM / 256, D / 256, F.G, F.bid};
              EpiBf16 E{(unsigned)(WS_KM16 / MiB), 1.0f}; pg8::gemm_phase(F.lds, F.wave * 64 + my_lane(), g, S, E); }
            __syncthreads();
            { pg8::Gemm g{D, D, D}; pg8::StaticOrder S{(const bf16*)(ws + WS_MEM16), (const bf16*)(ws + WS_WVT) + (size_t)l * D * D, D, D, NB * NMEM / 256, D / 256, F.G, F.bid};
              EpiVT E{0}; pg8::gemm_phase(F.lds, F.wave * 64 + my_lane(), g, S, E); }
            __syncthreads();
            { pg8::Gemm g{256, 256, 256}; pg8::StaticOrder S{(const bf16*)(ws + WS_LA16), (const bf16*)(ws + WS_LWT) + (size_t)l * 768 * 256, 256, 256, T / 256, 3, F.G, F.bid};
              EpiLora E{l}; pg8::gemm_phase(F.lds, F.wave * 64 + my_lane(), g, S, E); }
        } SEAM(p0 + 2);
        if (EN(3) && IN(p0 + 3)) REPS(3) { PH_BEGIN p_s5_chain(KA, F, l); p_rw_chunks(KA, F, l); } SEAM(p0 + 3);
        if (EN(4) && IN(p0 + 4)) REPS(4) { PH_BEGIN
            p_chain_compose(F);
            pg8::Gemm g{S5K, S5K, S5K}; pg8::BatchOrder S{(const bf16*)(ws + WS_AOUT), (const bf16*)(ws + WS_S5BT) + (size_t)l * 16 * 1024 * S5K, S5K, S5K, NCHT / 256, 1024 / 256, 16, F.G, F.bid, (size_t)NCHT * S5K, (size_t)1024 * S5K};
            EpiS5Y E{l}; pg8::gemm_phase(F.lds, F.wave * 64 + my_lane(), g, S, E);
        } SEAM(p0 + 4);
        if (EN(5) && IN(p0 + 5)) REPS(5) { PH_BEGIN
            const int nchain = (F.G >= 16) ? 8 : 0;
            if (F.bid < nchain) { p_chain_blocks(F, F.bid * NWAVES + F.wave, nchain * NWAVES); }
            else {
                if (nchain == 0) { p_chain_blocks(F, F.bid * NWAVES + F.wave, F.G * NWAVES); __syncthreads(); }
                pg8::Gemm g{256, 256, 256}; pg8::StaticOrder S{(const bf16*)(ws + WS_YD16), (const bf16*)(ws + WS_GLUT) + (size_t)l * 256 * 256, 256, 256, T / 256, 1, F.G - nchain, F.bid - nchain};
                EpiGlu E{l}; pg8::gemm_phase(F.lds, F.wave * 64 + my_lane(), g, S, E);
            }
        } SEAM(p0 + 5);
        if (EN(6) && IN(p0 + 6)) REPS(6) { PH_BEGIN
            for (int bb = F.bid; bb < 16 * NBLK; bb += F.G) {
                if (F.wave < 4) chain_inblock(F, bb, F.wave);
                VM_WAIT(); __syncthreads();
                rw_out_task(KA, F, l, bb * CB + F.wave);
                __syncthreads();
            }
        } SEAM(p0 + 6);
        if (EN(7) && IN(p0 + 7)) REPS(7) { PH_BEGIN
            pg8::Gemm g{D, 256, 256}; pg8::BranchOrder S{(const bf16*)(ws + WS_O16), (const bf16*)(ws + WS_BRT) + (size_t)l * 4 * D * 256, T / 256, D / 256, F.G, F.bid};
            EpiBranch E{0}; pg8::gemm_phase(F.lds, F.wave * 64 + my_lane(), g, S, E);
        } SEAM(p0 + 7);
        if (EN(8) && IN(p0 + 8)) REPS(8) { PH_BEGIN
            pg8::Gemm g{D, D, D}; pg8::StaticOrder S{(const bf16*)(ws + WS_MG16), (const bf16*)(ws + WS_WOUTT) + (size_t)l * D * D, D, D, T / 256, D / 256, F.G, F.bid};
            EpiResid E{0}; pg8::gemm_phase(F.lds, F.wave * 64 + my_lane(), g, S, E);
        } SEAM(p0 + 8);
        if (EN(9) && IN(p0 + 9)) REPS(9) { PH_BEGIN p_ln(F, kin(KA, I_LN1_G) + l * D, kin(KA, I_LN1_B) + l * D, DUMMY(9)); } SEAM(p0 + 9);
        if (EN(10) && IN(p0 + 10)) REPS(10) { PH_BEGIN
            pg8::Gemm g{D, D, D}; pg8::StaticOrder S{(const bf16*)(ws + WS_H16), (const bf16*)(ws + WS_WQT) + (size_t)l * D * D, D, D, T / 256, D / 256, F.G, F.bid};
            EpiBf16 E{(unsigned)(WS_Q16 / MiB), 0.0625f}; pg8::gemm_phase(F.lds, F.wave * 64 + my_lane(), g, S, E);
        } SEAM(p0 + 10);
        if (EN(11) && IN(p0 + 11)) REPS(11) { PH_BEGIN p_attn(F); } SEAM(p0 + 11);
        if (EN(12) && IN(p0 + 12)) REPS(12) { PH_BEGIN
            pg8::Gemm g{D, D, D}; pg8::StaticOrder S{(const bf16*)(ws + WS_AO16), (const bf16*)(ws + WS_WOT) + (size_t)l * D * D, D, D, T / 256, D / 256, F.G, F.bid};
            EpiResid E{0}; pg8::gemm_phase(F.lds, F.wave * 64 + my_lane(), g, S, E);
        } SEAM(p0 + 12);
        if (EN(13) && IN(p0 + 13)) REPS(13) { PH_BEGIN p_ln_router(KA, F, l, DUMMY(13)); } SEAM(p0 + 13);
        if (EN(14) && IN(p0 + 14)) REPS(14) { PH_BEGIN p_moe_slots(F, l, DUMMY(14) ? (rep_ + 1) : 0); } SEAM(p0 + 14);
        if (EN(15) && IN(p0 + 15)) REPS(15) { PH_BEGIN
            moe_offsets(F, l);
            pg8::Gemm g{D, D, D}; pg8::MoeOrder S{(const bf16*)(ws + WS_XG), (const bf16*)(ws + WS_W1T) + (size_t)l * NE * 2048 * D, D, D, 2048 / 256, F.G, F.bid, (size_t)2048 * D, (const LAS int*)(F.MISC + MI_TOFF)};
            if (PROBE_PHASE == 201) { for (int q_ = 0; q_ < PROBE_REPS - 1; ++q_) { EpiNull E0{0}; pg8::gemm_phase(F.lds, F.wave * 64 + my_lane(), g, S, E0); __syncthreads(); } }
            EpiSwiglu E{l}; pg8::gemm_phase(F.lds, F.wave * 64 + my_lane(), g, S, E);
        } SEAM(p0 + 15);
        if (EN(16) && IN(p0 + 16)) REPS(16) { PH_BEGIN
            moe_offsets(F, l);
            pg8::Gemm g{DFF, DFF, DFF}; pg8::MoeOrder S{(const bf16*)(ws + WS_ACT), (const bf16*)(ws + WS_W2T) + (size_t)l * NE * D * DFF, DFF, DFF, D / 256, F.G, F.bid, (size_t)D * DFF, (const LAS int*)(F.MISC + MI_TOFF)};
            EpiMoeOut E{l}; pg8::gemm_phase(F.lds, F.wave * 64 + my_lane(), g, S, E);
        } SEAM(p0 + 16);
        if (EN(17) && IN(p0 + 17)) REPS(17) { PH_BEGIN p_moe_combine(KA, F, l, DUMMY(17)); } SEAM(p0 + 17);
    }
#undef IN
#undef SEAM
}

extern "C" void kernel_launch(void* const* d_in, const int* in_sizes, int n_in, void* d_out, int out_size, void* d_ws, size_t ws_size, hipStream_t stream) {
    static int grid = 0;
    if (grid == 0) {
        if (n_in != 50 || ws_size < WS_END) { fprintf(stderr, "kernel_launch: unexpected n_in %d / ws_size %zu\n", n_in, ws_size); grid = -1; return; }
        int dev = 0, cus = 0, per_cu = 0;
        if (hipGetDevice(&dev) != hipSuccess || hipDeviceGetAttribute(&cus, hipDeviceAttributeMultiprocessorCount, dev) != hipSuccess) { grid = -1; return; }
        if (hipFuncSetAttribute((const void*)fwd_kernel, hipFuncAttributeMaxDynamicSharedMemorySize, LDS_BYTES) != hipSuccess) { fprintf(stderr, "kernel_launch: hipFuncSetAttribute failed\n"); grid = -1; return; }
        if (hipOccupancyMaxActiveBlocksPerMultiprocessor(&per_cu, (const void*)fwd_kernel, NTHREADS, LDS_BYTES) != hipSuccess || per_cu < 1) { fprintf(stderr, "kernel_launch: occupancy query says %d\n", per_cu); }
        (void)hipGetLastError();
        grid = cus;
    }
    if (grid < 0) return;
    (void)hipMemsetAsync((char*)d_ws + WS_CTL, 0, CTL_ZERO_BYTES, stream);
    Args a{};
    for (int i = 0; i < 50; ++i) a.in[i] = (const float*)d_in[i];
    a.out = (float*)d_out; a.ws = (unsigned char*)d_ws;
#if N_LAUNCHES == 1
    a.ph_lo = 0; a.ph_hi = NPHASES;
    hipLaunchKernelGGL(fwd_kernel, dim3(grid), dim3(NTHREADS), LDS_BYTES, stream, a);
#else
    for (int p = 0; p < NPHASES; ++p) { a.ph_lo = p; a.ph_hi = p + 1; hipLaunchKernelGGL(fwd_kernel, dim3(grid), dim3(NTHREADS), LDS_BYTES, stream, a); }
#endif
}
```

```cpp
#include <hip/hip_runtime.h>
#include <cstdio>
#include <cstdint>

#ifndef N_LAUNCHES
#define N_LAUNCHES 1
#endif

#ifndef PROBE_PHASE
#define PROBE_PHASE -1
#endif
#ifndef PROBE_REPS
#define PROBE_REPS 3
#endif
#define GAS __attribute__((address_space(1)))
#define LAS __attribute__((address_space(3)))
typedef unsigned short bf16;
typedef unsigned v4u __attribute__((ext_vector_type(4)));
typedef unsigned v2u __attribute__((ext_vector_type(2)));
typedef float f32x4 __attribute__((ext_vector_type(4)));
typedef float f32x2 __attribute__((ext_vector_type(2)));
typedef short bf16x8 __attribute__((ext_vector_type(8)));
typedef short bf16x4 __attribute__((ext_vector_type(4)));

constexpr int NL = 2, NB = 4, SEQ = 8192, T = NB * SEQ, D = 1024;
constexpr int NMEM = 256;
constexpr int OFF_B = 768, OFF_C = 1280, OFF_D = 2304, OFF_G = 2560, N_IN = 6656, ZLD = 2560;
constexpr int NE = 32, TOPK = 4, DFF = 1024;
constexpr int CH = 64;
constexpr int NCH = SEQ / CH;
constexpr int NCHT = T / CH;
constexpr int S5K = 1152;
constexpr int SLOT_ROWS = T * TOPK + NE * 256;
constexpr float LN_EPS = 1e-5f, RW_LN_EPS = 64e-5f;
constexpr float DN_ALPHA = 1.41421356237309515f;

constexpr size_t MiB = 1u << 20;
constexpr size_t WS_CTL = 0, CTL_ZERO_BYTES = 1 * MiB;
constexpr size_t WS_W1T = 2 * MiB;
constexpr size_t WS_W2T = 258 * MiB;
constexpr size_t WS_WINT = 386 * MiB;
constexpr size_t WS_BRT = 412 * MiB;
constexpr size_t WS_WOUTT = 416 * MiB, WS_WQT = 420 * MiB, WS_WKT = 424 * MiB, WS_WVT = 428 * MiB, WS_WOT = 432 * MiB;
constexpr size_t WS_GLUT = 436 * MiB;
constexpr size_t WS_MEM16 = 437 * MiB;
constexpr size_t WS_S5BT = 440 * MiB;
constexpr size_t WS_S5BC = 512 * MiB;
constexpr size_t WS_PRE16 = 528 * MiB;
constexpr size_t WS_H16 = 656 * MiB;
constexpr size_t WS_Z = 720 * MiB;
constexpr size_t WS_XG = 720 * MiB;
constexpr size_t WS_SG = 1040 * MiB;
constexpr size_t WS_YS = 1040 * MiB;
constexpr size_t WS_O16 = 1312 * MiB, WS_MG16 = 1376 * MiB, WS_Q16 = 1440 * MiB, WS_AO16 = 1504 * MiB;
constexpr size_t WS_LA16 = 1568 * MiB;
constexpr size_t WS_DEC = 1584 * MiB, WS_AV = 1616 * MiB;
constexpr size_t WS_LWT = 2012 * MiB;
constexpr size_t WS_ACT = 1568 * MiB;
constexpr size_t WS_QH = 1760 * MiB, WS_YL = 1792 * MiB, WS_GC = 1824 * MiB, WS_HC = 1856 * MiB, WS_SC = 1888 * MiB, WS_RWG = 1920 * MiB;
constexpr size_t WS_RK = 1952 * MiB;
constexpr size_t WS_AOUT = 1954 * MiB;
constexpr size_t WS_XLOC = 1972 * MiB;
constexpr size_t WS_YD16 = 1976 * MiB;
constexpr size_t WS_KM16 = 1992 * MiB, WS_VMT16 = 1994 * MiB;
constexpr size_t WS_TOKE = 1996 * MiB, WS_TOKW = 1997 * MiB, WS_TOKS = 1998 * MiB, WS_SLOTW = 1999 * MiB;
constexpr size_t WS_GB = 2000 * MiB, WS_HB = 2004 * MiB, WS_SB = 2008 * MiB;
constexpr size_t WS_END = 2014 * MiB;
static_assert(WS_XG + (size_t)SLOT_ROWS * D * 2 <= WS_SG && WS_YS + (size_t)SLOT_ROWS * D * 2 <= WS_O16 && WS_ACT + (size_t)SLOT_ROWS * D * 2 <= WS_RK, "overlays");
constexpr int CW_BAR = 4096;
constexpr int CW_CNT = 16384;
constexpr int CW_CUR = 16384 + 128;
constexpr int CW_WGH = 65536;

constexpr int LDS_BYTES = 163840;
constexpr int MISC_OFF = LDS_BYTES - 1024;
constexpr int RING_BYTES = 131072;
constexpr int NWAVES = 8, NTHREADS = 512;

#define LDS_WAIT() asm volatile("s_waitcnt lgkmcnt(0)" ::: "memory")
#define VM_WAIT() asm volatile("s_waitcnt vmcnt(0)" ::: "memory")
__device__ __forceinline__ unsigned f2bf(float f) { unsigned u = __float_as_uint(f); return (u + 0x7fffu + ((u >> 16) & 1u)) >> 16; }
__device__ __forceinline__ unsigned pk2(float lo, float hi) { unsigned r; asm("v_cvt_pk_bf16_f32 %0, %1, %2" : "=v"(r) : "v"(lo), "v"(hi)); return r; }
__device__ __forceinline__ float bf2f(unsigned h) { return __uint_as_float(h << 16); }
__device__ __forceinline__ float sigmoidf_(float x) { return __builtin_amdgcn_rcpf(1.0f + __expf(-x)); }
__device__ __forceinline__ int my_lane() { int l; asm volatile("v_mbcnt_lo_u32_b32 %0, -1, 0\n\tv_mbcnt_hi_u32_b32 %0, -1, %0" : "=v"(l)); return l; }
__device__ __forceinline__ float shfl_xor_l(float v, int o, int lane) { return __builtin_bit_cast(float, __builtin_amdgcn_ds_bpermute((lane ^ o) << 2, __builtin_bit_cast(int, v))); }
__device__ __forceinline__ int shfl_idx_l(int v, int src) { return __builtin_amdgcn_ds_bpermute(src << 2, v); }
__device__ __forceinline__ float wave_sum(float v) {
    const int ln = my_lane();
#pragma unroll
    for (int o = 1; o < 64; o <<= 1) v += shfl_xor_l(v, o, ln);
    return v;
}

#define XB_TMO      128
#define XB_XCNT(j)  (256  + 64 * (j))
#define XB_XSUB(j)  (1280 + 64 * (j))
#define XB_XGEN(j)  (2304 + 64 * (j))
#define XB_TOP      3328
#define XB_TOPGEN   3392
#define XCD_BAR_WORDS 3456
#define XB_SPIN_CAP (1u << 24)
__device__ __forceinline__ unsigned xb_ld(unsigned* p)              { return __hip_atomic_load(p, __ATOMIC_RELAXED, __HIP_MEMORY_SCOPE_AGENT); }
__device__ __forceinline__ unsigned xb_add(unsigned* p, unsigned v) { return __hip_atomic_fetch_add(p, v, __ATOMIC_RELAXED, __HIP_MEMORY_SCOPE_AGENT); }
__device__ __forceinline__ unsigned xb_xcc_id() { return (unsigned)__builtin_amdgcn_s_getreg((3 << 11) | 20) & 0xFu; }
#define XB_SPIN(cond, bar) do { unsigned _sp = 0; while (cond) { __builtin_amdgcn_s_sleep(1); \
    if ((++_sp & 255u) == 0u) { if (xb_ld(&(bar)[XB_TMO])) break; if (_sp > XB_SPIN_CAP) { atomicAdd(&(bar)[XB_TMO], 1u); break; } } } } while (0)
struct XcdBarrier { unsigned* bar; unsigned x; volatile LAS unsigned* st; };
__device__ __forceinline__ XcdBarrier xcd_barrier_post(unsigned* bar, volatile LAS unsigned* st) {
    XcdBarrier b; b.bar = bar; b.x = xb_xcc_id(); b.st = st;
    if (threadIdx.x == 0) (void)xb_add(&bar[XB_XCNT(b.x)], 1u);
    return b;
}
__device__ __forceinline__ void xcd_barrier_complete(unsigned* bar, unsigned x, unsigned& nloc, unsigned& nx) {
    const unsigned G = gridDim.x * gridDim.y * gridDim.z;
    unsigned sum, cnt, mine, sp = 0u;
    for (;;) {
        sum = 0u; cnt = 0u; mine = 0u;
#pragma unroll
        for (unsigned j = 0; j < 16; ++j) { const unsigned c = xb_ld(&bar[XB_XCNT(j)]); sum += c; cnt += (c > 0u) ? 1u : 0u; mine = (j == x) ? c : mine; }
        if (sum == G) break;
        __builtin_amdgcn_s_sleep(1);
        if ((++sp & 255u) == 0u) { if (xb_ld(&bar[XB_TMO])) break; if (sp > XB_SPIN_CAP) { atomicAdd(&bar[XB_TMO], 1u); break; } }
    }
    nloc = mine > 0u ? mine : 1u; nx = cnt > 0u ? cnt : 1u;
}
__device__ __forceinline__ void xcd_barrier(const XcdBarrier& b) {
    asm volatile("s_waitcnt vmcnt(0)" ::: "memory");
    __syncthreads();
    if (threadIdx.x == 0) {
        unsigned* bar = b.bar; unsigned bx = b.x;
        asm volatile("" : "+s"(bar), "+s"(bx));
        __builtin_amdgcn_s_waitcnt(0);
        unsigned nloc = b.st[0], nx = b.st[1];
        if (nloc == 0u) { xcd_barrier_complete(bar, bx, nloc, nx); b.st[0] = nloc; b.st[1] = nx; }
        const unsigned old = xb_add(&bar[XB_XSUB(bx)], 1u);
        const unsigned gen = old / nloc;
        if (old + 1u == (gen + 1u) * nloc) {
            __builtin_amdgcn_fence(__ATOMIC_RELEASE, "agent");
            asm volatile("s_waitcnt vmcnt(0)" ::: "memory");
            const unsigned og = xb_add(&bar[XB_TOP], 1u);
            const unsigned tg = og / nx;
            if (og + 1u == (tg + 1u) * nx) xb_add(&bar[XB_TOPGEN], 1u);
            else XB_SPIN(xb_ld(&bar[XB_TOPGEN]) == tg, bar);
            __builtin_amdgcn_fence(__ATOMIC_ACQUIRE, "agent");
            xb_add(&bar[XB_XGEN(bx)], 1u);
            asm volatile("s_waitcnt vmcnt(0)" ::: "memory");
        } else {
            XB_SPIN(xb_ld(&bar[XB_XGEN(bx)]) == gen, bar);
            __builtin_amdgcn_fence(__ATOMIC_ACQUIRE, "agent");
            asm volatile("s_waitcnt vmcnt(0)" ::: "memory");
        }
    }
    __syncthreads();
}

namespace pg8 {
constexpr int BM = 256, BK = 64, HALF = 128, HTB = HALF * BK * 2, STAGE_BYTES = 8 * HTB, NXCD = 8, WGM = 8;
__host__ __device__ __forceinline__ int lds_byte(int r, int c) { const int st = (r >> 4) * 2 + (c >> 5), rr = r & 15, cc = c & 31, ob = rr * 64 + cc * 2; return st * 1024 + (ob ^ (((ob >> 9) & 1) << 5)); }
__host__ __device__ __forceinline__ int perm32(int rho) { const int n = rho >> 4, i = rho & 15; return 8 * (i >> 2) + 4 * n + (i & 3); }
__host__ __device__ __forceinline__ void stage_rc(int b, int& R, int& C) { const int st = b / 1024, sb = b % 1024, swz = sb ^ (((sb >> 9) & 1) << 5); R = (st >> 1) * 16 + swz / 64; C = (st & 1) * 32 + (swz % 64) / 2; }
struct Unit { int pm, pn, e; };
struct Gemm { int lda, ldb, K; };

__device__ __forceinline__ bool static_tile(int i, int G, int c, int nM, int nN, int& pm, int& pn) {
    const int nwg = nM * nN; const long L = (long)i * G + c; if (L >= nwg) return false;
    int wgid = (int)L; { const int q = nwg / NXCD, r = nwg % NXCD, xcd = wgid % NXCD, off = wgid / NXCD; wgid = (xcd < r ? xcd * (q + 1) : r * (q + 1) + (xcd - r) * q) + off; }
    const int nig = WGM * nN, gid = wgid / nig, fm = gid * WGM, gsz = (nM - fm) < WGM ? (nM - fm) : WGM;
    pm = fm + ((wgid % nig) % gsz); pn = (wgid % nig) / gsz; return true;
}
struct StaticOrder {
    const bf16* A; const bf16* Bt; int lda, ldb, nM, nN, G, c;
    __device__ __forceinline__ bool next(int i, Unit& u) const { u.e = 0; return static_tile(i, G, c, nM, nN, u.pm, u.pn); }
    __device__ __forceinline__ const char* a_base(const Unit& u) const { return (const char*)(A + (size_t)u.pm * BM * lda); }
    __device__ __forceinline__ const char* b_base(const Unit& u) const { return (const char*)(Bt + (size_t)u.pn * BM * ldb); }
};
struct BatchOrder {
    const bf16* A; const bf16* Bt; int lda, ldb, nM, nN, nb, G, c; size_t sA, sB;
    __device__ __forceinline__ bool next(int i, Unit& u) const {
        const long L = (long)i * G + c; const int per = nM * nN; if (L >= (long)per * nb) return false;
        u.e = (int)(L / per); const int r = (int)(L % per); u.pn = r / nM; u.pm = r % nM; return true; }
    __device__ __forceinline__ const char* a_base(const Unit& u) const { return (const char*)(A + (size_t)u.e * sA + (size_t)u.pm * BM * lda); }
    __device__ __forceinline__ const char* b_base(const Unit& u) const { return (const char*)(Bt + (size_t)u.e * sB + (size_t)u.pn * BM * ldb); }
};
struct BranchOrder {
    const bf16* A; const bf16* Bt; int nM, nN, G, c;
    __device__ __forceinline__ bool next(int i, Unit& u) const { u.e = i & 3; return static_tile(i >> 2, G, c, nM, nN, u.pm, u.pn); }
    __device__ __forceinline__ const char* a_base(const Unit& u) const { return (const char*)(A + (size_t)u.pm * BM * D + u.e * 256); }
    __device__ __forceinline__ const char* b_base(const Unit& u) const { return (const char*)(Bt + (size_t)u.e * D * 256 + (size_t)u.pn * BM * 256); }
};
struct MoeOrder {
    const bf16* A; const bf16* Bt; int lda, ldb, nN, G, c; size_t sB; const LAS int* toff;
    __device__ __forceinline__ bool next(int i, Unit& u) const {
        const int nt = toff[NE]; int mt;
        const int Gx = G >> 3;
        if ((G & 7) == 0 && (Gx % nN) == 0) {
            const int per = Gx / nN, x = c & 7, y = c >> 3;
            mt = i * 8 * per + x * per + y / nN; u.pn = y % nN; if (mt >= nt) return false;
        } else { const long L = (long)i * G + c; if (L >= (long)nt * nN) return false; mt = (int)(L / nN); u.pn = (int)(L % nN); }
        u.pm = mt; int e = 0;
#pragma unroll 1
        for (int k = 1; k < NE; ++k) e += (toff[k] <= mt) ? 1 : 0;
        u.e = e; return true; }
    __device__ __forceinline__ const char* a_base(const Unit& u) const { return (const char*)(A + (size_t)u.pm * BM * lda); }
    __device__ __forceinline__ const char* b_base(const Unit& u) const { return (const char*)(Bt + (size_t)u.e * sB + (size_t)u.pn * BM * ldb); }
};

template <class F> __device__ __forceinline__ void epi_foreach(const f32x4 (&acc)[2][2][4][2], const Unit& u, int wr, int wc, int fr, int fq, const F& f) {
#pragma unroll
    for (int ai = 0; ai < 2; ++ai)
#pragma unroll
        for (int m = 0; m < 4; ++m) { const int row = u.pm * BM + ai * HALF + wr * 64 + m * 16 + fr;
#pragma unroll
            for (int bj = 0; bj < 2; ++bj)
#pragma unroll
                for (int n = 0; n < 2; ++n) f(row, u.pn * BM + bj * HALF + wc * 32 + n * 16 + 4 * fq, acc[ai][bj][m][n]);
            if (m == 3) __builtin_amdgcn_sched_barrier(0); }
}

template <class F> __device__ __forceinline__ void epi_foreach8(const f32x4 (&acc)[2][2][4][2], const Unit& u, int wr, int wc, int fr, int fq, const F& f) {
#pragma unroll
    for (int ai = 0; ai < 2; ++ai)
#pragma unroll
        for (int m = 0; m < 4; ++m) { const int row = u.pm * BM + ai * HALF + wr * 64 + m * 16 + fr;
#pragma unroll
            for (int bj = 0; bj < 2; ++bj) f(row, u.pn * BM + bj * HALF + wc * 32 + 8 * fq, acc[ai][bj][m][0], acc[ai][bj][m][1]);
            if (m == 3) __builtin_amdgcn_sched_barrier(0); }
}
template <class Epi, class Sched, bool ALIGN_EPI = true, bool SP2 = true>
__device__ __forceinline__ void gemm_phase(LAS unsigned char* lds, const int tid, const Gemm g, const Sched& S, const Epi& E) {
    const int wid = __builtin_amdgcn_readfirstlane(tid >> 6), lane = tid & 63, wr = wid >> 2, wc = wid & 3, fr = lane & 15, fq = lane >> 4;
    const int K = g.K, nt = K / BK;
    unsigned voffA[2], voffB[2];
#pragma unroll
    for (int i = 0; i < 2; ++i) { int R, C; stage_rc(tid * 16 + i * 8192, R, C);
        const int Rb = Epi::PERM ? ((R & ~31) + perm32(R & 31)) : R;
        voffA[i] = (unsigned)(R * g.lda + C) * 2u; voffB[i] = (unsigned)(Rb * g.ldb + C) * 2u; }
    const size_t kstep = (size_t)(BK * 2);
    const size_t hstepA = (size_t)HALF * g.lda * 2, hstepB = (size_t)HALF * g.ldb * 2;
    const unsigned ldsw = (unsigned)wid * 1024u;
    const int aoff = lds_byte(wr * 64 + fr, fq * 8), boff = lds_byte(wc * 32 + fr, fq * 8);
#define PG8_SA(b, h) (((b) * 2 + (h)) * HTB)
#define PG8_SB(b, h) ((4 + (b) * 2 + (h)) * HTB)
#define PG8_STAGE(bufoff, gbase, voff) do { _Pragma("unroll") for (int _i = 0; _i < 2; ++_i) \
        __builtin_amdgcn_global_load_lds((const unsigned*)((const char*)(gbase) + (voff)[_i]), (LAS unsigned*)(lds + (bufoff) + ldsw + _i * 8192), 16, 0, 0); } while (0)
#define PG8_LDA(dst, b, h) do { _Pragma("unroll") for (int m = 0; m < 4; ++m) _Pragma("unroll") for (int k = 0; k < 2; ++k) dst[m][k] = *(const LAS bf16x8*)(lds + PG8_SA(b, h) + aoff + m * 2048 + k * 1024); } while (0)
#define PG8_LDB(dst, b, h) do { _Pragma("unroll") for (int n = 0; n < 2; ++n) _Pragma("unroll") for (int k = 0; k < 2; ++k) dst[n][k] = *(const LAS bf16x8*)(lds + PG8_SB(b, h) + boff + n * 2048 + k * 1024); } while (0)
#define PG8_MMA(ai, bj, At, Bt) do { __builtin_amdgcn_s_setprio(1); _Pragma("unroll") for (int m = 0; m < 4; ++m) _Pragma("unroll") for (int n = 0; n < 2; ++n) _Pragma("unroll") for (int k = 0; k < 2; ++k) \
        acc[ai][bj][m][n] = __builtin_amdgcn_mfma_f32_16x16x32_bf16(Bt[n][k], At[m][k], acc[ai][bj][m][n], 0, 0, 0); __builtin_amdgcn_s_setprio(0); } while (0)
#define PG8_WAIT_V(n) asm volatile("s_waitcnt vmcnt(" #n ")" ::: "memory")
#define PG8_WAIT_L(n) asm volatile("s_waitcnt lgkmcnt(" #n ")" ::: "memory")
#define PG8_BAR __builtin_amdgcn_s_barrier()
#define PG8_SCHED __builtin_amdgcn_sched_barrier(0)
    Unit cur, nxt; int ui = 0;
    if (!S.next(0, cur)) return;
    f32x4 acc[2][2][4][2];
#pragma unroll
    for (int a = 0; a < 2; ++a)
#pragma unroll
        for (int b = 0; b < 2; ++b)
#pragma unroll
            for (int m = 0; m < 4; ++m)
#pragma unroll
                for (int n = 0; n < 2; ++n) acc[a][b][m][n] = (f32x4){0.f, 0.f, 0.f, 0.f};
    bf16x8 At[4][2], B0[2][2], B1[2][2];
    const char* cA = S.a_base(cur); const char* cB = S.b_base(cur);
    if constexpr (SP2) {
        PG8_STAGE(PG8_SB(0, 0), cB, voffB); PG8_STAGE(PG8_SB(0, 1), cB + hstepB, voffB); PG8_STAGE(PG8_SA(0, 0), cA, voffA); PG8_STAGE(PG8_SA(0, 1), cA + hstepA, voffA);
        if (wr == 1) PG8_BAR;
        PG8_WAIT_V(2); PG8_BAR;
        PG8_STAGE(PG8_SB(1, 0), cB + kstep, voffB); PG8_STAGE(PG8_SA(1, 0), cA + kstep, voffA); PG8_STAGE(PG8_SB(1, 1), cB + hstepB + kstep, voffB);
        PG8_WAIT_V(6); PG8_BAR;
    } else {
        PG8_STAGE(PG8_SB(0, 0), cB, voffB); PG8_STAGE(PG8_SA(0, 0), cA, voffA); PG8_STAGE(PG8_SB(0, 1), cB + hstepB, voffB); PG8_STAGE(PG8_SA(0, 1), cA + hstepA, voffA);
        if (wr == 1) PG8_BAR;
        PG8_WAIT_V(4); PG8_BAR;
        PG8_STAGE(PG8_SB(1, 0), cB + kstep, voffB); PG8_STAGE(PG8_SA(1, 0), cA + kstep, voffA); PG8_STAGE(PG8_SB(1, 1), cB + hstepB + kstep, voffB);
        PG8_WAIT_V(6); PG8_BAR;
    }
    for (;;) {
        const bool has_next = S.next(ui + 1, nxt);
        const char* nA = has_next ? S.a_base(nxt) : cA; const char* nB = has_next ? S.b_base(nxt) : cB;
        for (int t = 0; t < nt; t += 2) {
            const bool last = (t == nt - 2);
            const char* a1 = cA + (size_t)(t + 1) * kstep;
            const char* a2 = last ? nA : cA + (size_t)(t + 2) * kstep; const char* b2 = last ? nB : cB + (size_t)(t + 2) * kstep;
            const char* a3 = a2 + kstep; const char* b3 = b2 + kstep;
            if constexpr (SP2) {
            PG8_LDB(B0, 0, 0); PG8_LDB(B1, 0, 1); PG8_SCHED; PG8_LDA(At, 0, 0); PG8_STAGE(PG8_SA(1, 1), a1 + hstepA, voffA);
            PG8_WAIT_V(8); PG8_WAIT_L(0); PG8_BAR; PG8_MMA(0, 0, At, B0); PG8_MMA(0, 1, At, B1); PG8_BAR; PG8_SCHED;
            PG8_LDA(At, 0, 1); PG8_STAGE(PG8_SB(0, 0), b2, voffB); PG8_STAGE(PG8_SB(0, 1), b2 + hstepB, voffB); PG8_STAGE(PG8_SA(0, 0), a2, voffA);
            PG8_WAIT_V(8); PG8_WAIT_L(0); PG8_BAR; PG8_MMA(1, 0, At, B0); PG8_MMA(1, 1, At, B1); PG8_BAR; PG8_SCHED;
            PG8_LDB(B0, 1, 0); PG8_LDB(B1, 1, 1); PG8_SCHED; PG8_LDA(At, 1, 0); PG8_STAGE(PG8_SA(0, 1), a2 + hstepA, voffA);
            PG8_WAIT_V(8); PG8_WAIT_L(0); PG8_BAR; PG8_MMA(0, 0, At, B0); PG8_MMA(0, 1, At, B1); PG8_BAR; PG8_SCHED;
            PG8_LDA(At, 1, 1); PG8_STAGE(PG8_SB(1, 0), b3, voffB); PG8_STAGE(PG8_SB(1, 1), b3 + hstepB, voffB); PG8_STAGE(PG8_SA(1, 0), a3, voffA);
            PG8_WAIT_V(8); PG8_WAIT_L(0); PG8_BAR; PG8_MMA(1, 0, At, B0); PG8_MMA(1, 1, At, B1); PG8_BAR; PG8_SCHED;
            } else {
            PG8_LDB(B0, 0, 0); PG8_SCHED; PG8_LDA(At, 0, 0); PG8_STAGE(PG8_SA(1, 1), a1 + hstepA, voffA);
            PG8_WAIT_L(8); PG8_BAR; PG8_WAIT_L(0); PG8_MMA(0, 0, At, B0); PG8_BAR; PG8_SCHED;
            PG8_LDB(B1, 0, 1); PG8_STAGE(PG8_SB(0, 0), b2, voffB);
            PG8_BAR; PG8_WAIT_L(0); PG8_MMA(0, 1, At, B1); PG8_BAR;
            PG8_LDA(At, 0, 1); PG8_STAGE(PG8_SA(0, 0), a2, voffA);
            PG8_BAR; PG8_WAIT_L(0); PG8_MMA(1, 0, At, B0); PG8_BAR; PG8_SCHED;
            PG8_STAGE(PG8_SB(0, 1), b2 + hstepB, voffB);
            PG8_WAIT_V(6); PG8_BAR; PG8_MMA(1, 1, At, B1); PG8_BAR;
            PG8_LDB(B0, 1, 0); PG8_SCHED; PG8_LDA(At, 1, 0); PG8_STAGE(PG8_SA(0, 1), a2 + hstepA, voffA);
            PG8_WAIT_L(8); PG8_BAR; PG8_WAIT_L(0); PG8_MMA(0, 0, At, B0); PG8_BAR; PG8_SCHED;
            PG8_LDB(B1, 1, 1); PG8_STAGE(PG8_SB(1, 0), b3, voffB);
            PG8_BAR; PG8_WAIT_L(0); PG8_MMA(0, 1, At, B1); PG8_BAR;
            PG8_LDA(At, 1, 1); PG8_STAGE(PG8_SA(1, 0), a3, voffA);
            PG8_BAR; PG8_WAIT_L(0); PG8_MMA(1, 0, At, B0); PG8_BAR; PG8_SCHED;
            PG8_STAGE(PG8_SB(1, 1), b3 + hstepB, voffB);
            PG8_WAIT_V(6); PG8_BAR; PG8_MMA(1, 1, At, B1); PG8_BAR;
            }
        }
        if constexpr (ALIGN_EPI) { if (wr == 0) PG8_BAR; }
        { const int lane2 = my_lane();
          E(acc, cur, wid >> 2, wid & 3, lane2 & 15, lane2 >> 4); }
        if (!has_next) break;
#pragma unroll
        for (int a = 0; a < 2; ++a)
#pragma unroll
            for (int b = 0; b < 2; ++b)
#pragma unroll
                for (int m = 0; m < 4; ++m)
#pragma unroll
                    for (int n = 0; n < 2; ++n) acc[a][b][m][n] = (f32x4){0.f, 0.f, 0.f, 0.f};
        cur = nxt; cA = nA; cB = nB; ++ui;
        if constexpr (ALIGN_EPI) { if (wr == 1) PG8_BAR; }
    }
    PG8_WAIT_V(0);
    if constexpr (!ALIGN_EPI) { if (wr == 0) PG8_BAR; }
    PG8_BAR;
#undef PG8_SA
#undef PG8_SB
#undef PG8_STAGE
#undef PG8_LDA
#undef PG8_LDB
#undef PG8_MMA
#undef PG8_WAIT_V
#undef PG8_WAIT_L
#undef PG8_BAR
#undef PG8_SCHED
}
}
using pg8::Unit;

struct Args { const float* in[50]; float* out; unsigned char* ws; int ph_lo, ph_hi; };
typedef const __attribute__((address_space(4))) Args KArgs;
__device__ __forceinline__ KArgs* kargs() { KArgs* p = (KArgs*)__builtin_amdgcn_kernarg_segment_ptr(); asm volatile("" : "+s"(p)); return p; }
__device__ __forceinline__ unsigned char* launder_p(unsigned char* p) { asm volatile("" : "+s"(p)); return (unsigned char*)(GAS unsigned char*)p; }
__device__ __forceinline__ const float* kin(KArgs& A, int i) { return (const float*)(const GAS float*)A.in[i]; }
__device__ __forceinline__ float* kout(KArgs& A) { return (float*)(GAS float*)A.out; }
__device__ __forceinline__ unsigned char* kws(KArgs& A) { return (unsigned char*)(GAS unsigned char*)A.ws; }
__device__ __forceinline__ int launder_i(int v) { asm volatile("" : "+s"(v)); return v; }
__device__ __forceinline__ int launder_v(int v) { asm volatile("" : "+v"(v)); return v; }
enum { I_X = 0, I_MEM, I_LN_IN_G, I_LN_IN_B, I_W_IN, I_CONV_W, I_SG_NG, I_SG_NB, I_SG_W, I_SG_B, I_RW_MU, I_RW_W0, I_RW_WUP, I_RW_A0, I_RW_AUP, I_RW_GUP,
       I_RW_KK, I_RW_KA, I_RW_RK, I_RW_LNG, I_RW_LNB, I_S5_ARE, I_S5_AIM, I_S5_BRE, I_S5_BIM, I_S5_CRE, I_S5_CIM, I_S5_D, I_S5_LOGDT, I_S5_GLUW, I_S5_GLUB,
       I_BR_PROJ, I_GATE_B, I_W_OUT, I_LN1_G, I_LN1_B, I_XA_WQ, I_XA_WK, I_XA_WV, I_XA_WO, I_LN2_G, I_LN2_B, I_ROUTER_W, I_ROUTER_B, I_EX_W1, I_EX_B1, I_EX_W2, I_EX_B2,
       I_LN3_G, I_LN3_B };
struct Frame { LAS unsigned char* lds; volatile LAS unsigned* MISC; unsigned* ctl; unsigned char* ws; int tid, lane, wave, G, bid; };
constexpr int MI_TOFF = 16, MI_HIST = 64, MI_LBASE = 96, MI_LCUR = 128;

__device__ __forceinline__ void ln_stats(const f32x4 (&v)[4], float& mean, float& rstd) {
    float s = 0.f;
#pragma unroll
    for (int j = 0; j < 4; ++j) s += (v[j].x + v[j].y) + (v[j].z + v[j].w);
    mean = wave_sum(s) * (1.f / D); float s2 = 0.f;
#pragma unroll
    for (int j = 0; j < 4; ++j) { const f32x4 d = v[j] - mean; s2 += (d.x * d.x + d.y * d.y) + (d.z * d.z + d.w * d.w); }
    rstd = 1.0f / sqrtf(wave_sum(s2) * (1.f / D) + LN_EPS);
}
__device__ __forceinline__ void ln_apply_store(const f32x4 (&v)[4], float mean, float rstd, const float* g, const float* b, float* o32, bf16* o16, int lane) {
#pragma unroll
    for (int j = 0; j < 4; ++j) {
        const f32x4 gg = *(const f32x4*)(g + 256 * j + 4 * lane), bb = *(const f32x4*)(b + 256 * j + 4 * lane);
        const f32x4 y = (v[j] - mean) * rstd * gg + bb;
        if (o32) *(f32x4*)(o32 + 256 * j + 4 * lane) = y;
        if (o16) { v2u w; w.x = pk2(y.x, y.y); w.y = pk2(y.z, y.w); *(v2u*)(o16 + 256 * j + 4 * lane) = w; }
    }
}

__device__ __forceinline__ void transpose_item(const float* W, int K, int N, bf16* WT, int mode, LAS float* scr, int item, int lane) {
    const int nblk = N / 32, kb = item / nblk, nb = item % nblk, k0 = 64 * kb, n0 = 32 * nb;
#pragma unroll 8
    for (int i = 0; i < 32; ++i) { const int kk = 2 * i + (lane >> 5); scr[kk * 33 + (lane & 31)] = W[(size_t)(k0 + kk) * N + n0 + (lane & 31)]; }
    LDS_WAIT();
    const int c = lane & 7;
#pragma unroll
    for (int j = 0; j < 4; ++j) { const int n = (lane >> 3) + 8 * j; const LAS float* s = scr + (8 * c) * 33 + n;
        v4u o; o.x = pk2(s[0 * 33], s[1 * 33]); o.y = pk2(s[2 * 33], s[3 * 33]); o.z = pk2(s[4 * 33], s[5 * 33]); o.w = pk2(s[6 * 33], s[7 * 33]);
        const int nn = n0 + n; const int jj = nn >> 1;
        const int row = mode ? ((jj >> 7) * 256 + (nn & 1) * 128 + (jj & 127)) : nn;
        *(v4u*)(WT + (size_t)row * K + k0 + 8 * c) = o; }
    LDS_WAIT();
}
__device__ __forceinline__ void s5_setup_item(KArgs& A, const Frame& F, int item) {
    const int l = item >> 4, g = item & 15, tid = F.tid;
    LAS float* Kt = (LAS float*)F.lds;
    LAS float* Pw = (LAS float*)(F.lds + 65536);
    LAS float* Bb = (LAS float*)(F.lds + 65536 + 33280);
    LAS float* Cc = Bb + 2048;
    const float* a_re = kin(A, I_S5_ARE) + (l * 16 + g) * 64; const float* a_im = kin(A, I_S5_AIM) + (l * 16 + g) * 64;
    const float* b_re = kin(A, I_S5_BRE) + (size_t)(l * 16 + g) * 1024; const float* b_im = kin(A, I_S5_BIM) + (size_t)(l * 16 + g) * 1024;
    const float* c_re = kin(A, I_S5_CRE) + (size_t)(l * 16 + g) * 1024; const float* c_im = kin(A, I_S5_CIM) + (size_t)(l * 16 + g) * 1024;
    const float dt = expf(kin(A, I_S5_LOGDT)[l * 16 + g]);
    for (int o = tid; o < 65 * 64; o += NTHREADS) { const int n = o >> 6, p = o & 63; const float mag = expf(a_re[p] * dt * (float)n); float sn, cs; sincosf(a_im[p] * dt * (float)n, &sn, &cs);
        Pw[o * 2] = mag * cs; Pw[o * 2 + 1] = mag * sn; }
    for (int o = tid; o < 1024; o += NTHREADS) { const int p = o >> 4;
        const float are = a_re[p], aim = a_im[p], mag = expf(are * dt); float sn, cs; sincosf(aim * dt, &sn, &cs); const float abr = mag * cs, abi = mag * sn;
        const float den = are * are + aim * aim, nr = abr - 1.0f, cr = (nr * are + abi * aim) / den, ci = (abi * are - nr * aim) / den;
        const float br = b_re[o], bi = b_im[o]; Bb[o * 2] = cr * br - ci * bi; Bb[o * 2 + 1] = cr * bi + ci * br; }
    for (int o = tid; o < 1024; o += NTHREADS) { Cc[o * 2] = c_re[o]; Cc[o * 2 + 1] = c_im[o]; }
    __syncthreads();
    for (int o = tid; o < 16384; o += NTHREADS) { const int tau = o >> 8, c = (o >> 4) & 15, cp = o & 15; float acc = 0.f;
        for (int p = 0; p < 64; ++p) { const float cr = Cc[(c * 64 + p) * 2], ci = Cc[(c * 64 + p) * 2 + 1], pr = Pw[(tau * 64 + p) * 2], pi = Pw[(tau * 64 + p) * 2 + 1];
            const float er = cr * pr - ci * pi, ei = cr * pi + ci * pr; acc += er * Bb[(p * 16 + cp) * 2] - ei * Bb[(p * 16 + cp) * 2 + 1]; }
        Kt[o] = acc; }
    __syncthreads();
    bf16* Bt = (bf16*)(F.ws + WS_S5BT) + (size_t)(l * 16 + g) * 1024 * S5K;
    for (int o = tid; o < 1024 * 128; o += NTHREADS) { const int rr = o >> 7, q = o & 127, t = rr >> 4, c = rr & 15, s = q >> 1, cp0 = (q & 1) * 8;
        v4u w = {0u, 0u, 0u, 0u};
        if (s <= t) { const LAS float* k = Kt + ((t - s) * 16 + c) * 16 + cp0; w.x = pk2(k[0], k[1]); w.y = pk2(k[2], k[3]); w.z = pk2(k[4], k[5]); w.w = pk2(k[6], k[7]); }
        *(v4u*)(Bt + (size_t)rr * S5K + q * 8) = w; }
    for (int o = tid; o < 1024 * 16; o += NTHREADS) { const int rr = o >> 4, q = o & 15, t = rr >> 4, c = rr & 15; float vals[8];
#pragma unroll
        for (int j = 0; j < 4; ++j) { const int p = 4 * q + j; const float cr = Cc[(c * 64 + p) * 2], ci = Cc[(c * 64 + p) * 2 + 1], pr = Pw[((t + 1) * 64 + p) * 2], pi = Pw[((t + 1) * 64 + p) * 2 + 1];
            vals[2 * j] = cr * pr - ci * pi; vals[2 * j + 1] = -(cr * pi + ci * pr); }
        v4u w; w.x = pk2(vals[0], vals[1]); w.y = pk2(vals[2], vals[3]); w.z = pk2(vals[4], vals[5]); w.w = pk2(vals[6], vals[7]);
        *(v4u*)(Bt + (size_t)rr * S5K + 1024 + q * 8) = w; }
    bf16* Bc = (bf16*)(F.ws + WS_S5BC) + (size_t)(l * 16 + g) * 256 * 1024;
    for (int o = tid; o < 128 * 128; o += NTHREADS) { const int row = o >> 7, q = o & 127, p = row >> 1, im = row & 1, s = q >> 1, cp0 = (q & 1) * 8;
        const float pr = Pw[((63 - s) * 64 + p) * 2], pi = Pw[((63 - s) * 64 + p) * 2 + 1]; float vals[8];
#pragma unroll
        for (int j = 0; j < 8; ++j) { const float br = Bb[(p * 16 + cp0 + j) * 2], bi = Bb[(p * 16 + cp0 + j) * 2 + 1]; vals[j] = im ? (pr * bi + pi * br) : (pr * br - pi * bi); }
        v4u w; w.x = pk2(vals[0], vals[1]); w.y = pk2(vals[2], vals[3]); w.z = pk2(vals[4], vals[5]); w.w = pk2(vals[6], vals[7]);
        *(v4u*)(Bc + (size_t)row * 1024 + q * 8) = w;
        *(v4u*)(Bc + (size_t)(128 + row) * 1024 + q * 8) = (v4u){0u, 0u, 0u, 0u}; }
    __syncthreads();
}
__device__ __forceinline__ void p_prologue(KArgs& A, const Frame& F) {
    const int gw = F.bid * NWAVES + F.wave, NGW = F.G * NWAVES, lane = F.lane;
    for (int item = F.bid; item < NL * 16; item += F.G) s5_setup_item(A, F, item);
    LAS float* scr = (LAS float*)(F.lds + F.wave * 16384);
#pragma unroll 1
    for (int d = 0; d < 10; ++d) {
        const float* src; bf16* dst; int K, N, batch, mode = 0;
        switch (d) {
            case 0: src = kin(A, I_EX_W1); dst = (bf16*)(F.ws + WS_W1T); K = 1024; N = 2048; batch = NL * NE; mode = 1; break;
            case 1: src = kin(A, I_EX_W2); dst = (bf16*)(F.ws + WS_W2T); K = 1024; N = 1024; batch = NL * NE; break;
            case 2: src = kin(A, I_W_IN); dst = (bf16*)(F.ws + WS_WINT); K = 1024; N = N_IN; batch = NL; break;
            case 3: src = kin(A, I_BR_PROJ); dst = (bf16*)(F.ws + WS_BRT); K = 256; N = 1024; batch = NL * 4; break;
            case 4: src = kin(A, I_W_OUT); dst = (bf16*)(F.ws + WS_WOUTT); K = 1024; N = 1024; batch = NL; break;
            case 5: src = kin(A, I_XA_WQ); dst = (bf16*)(F.ws + WS_WQT); K = 1024; N = 1024; batch = NL; break;
            case 6: src = kin(A, I_XA_WK); dst = (bf16*)(F.ws + WS_WKT); K = 1024; N = 1024; batch = NL; break;
            case 7: src = kin(A, I_XA_WV); dst = (bf16*)(F.ws + WS_WVT); K = 1024; N = 1024; batch = NL; break;
            case 8: src = kin(A, I_XA_WO); dst = (bf16*)(F.ws + WS_WOT); K = 1024; N = 1024; batch = NL; break;
            default: src = kin(A, I_S5_GLUW); dst = (bf16*)(F.ws + WS_GLUT); K = 256; N = 256; batch = NL; break;
        }
        const int per = (K / 64) * (N / 32), nitems = per * batch;
        for (int it = gw; it < nitems; it += NGW) { const int b = it / per, r = it - b * per;
            transpose_item(src + (size_t)b * K * N, K, N, dst + (size_t)b * K * N, mode, scr, r, lane); }
    }
    { bf16* lwt = (bf16*)(F.ws + WS_LWT);
      for (int it = gw * 64 + lane; it < NL * 768 * 32; it += NGW * 64) { const int kc = it & 31, row = (it >> 5) % 768, ll = it / (768 * 32), blk = row >> 8, c = row & 255, k0 = kc * 8; float v[8];
#pragma unroll
          for (int j = 0; j < 8; ++j) { const int k = k0 + j; float x = 0.f;
              if (blk == 0 && k < 64) x = kin(A, I_RW_WUP)[((size_t)ll * 64 + k) * 256 + c];
              else if (blk == 1 && k >= 64 && k < 128) x = kin(A, I_RW_AUP)[((size_t)ll * 64 + (k - 64)) * 256 + c];
              else if (blk == 2 && k >= 128) x = kin(A, I_RW_GUP)[((size_t)ll * 128 + (k - 128)) * 256 + c];
              v[j] = x; }
          v4u w; w.x = pk2(v[0], v[1]); w.y = pk2(v[2], v[3]); w.z = pk2(v[4], v[5]); w.w = pk2(v[6], v[7]);
          *(v4u*)(lwt + ((size_t)ll * 768 + row) * 256 + k0) = w; } }
    { const float* mem = kin(A, I_MEM); bf16* m16 = (bf16*)(F.ws + WS_MEM16);
      for (int r = gw; r < NB * NMEM; r += NGW) {
#pragma unroll
          for (int j = 0; j < 4; ++j) { const f32x4 v = *(const f32x4*)(mem + (size_t)r * D + 256 * j + 4 * lane); v2u w; w.x = pk2(v.x, v.y); w.y = pk2(v.z, v.w); *(v2u*)(m16 + (size_t)r * D + 256 * j + 4 * lane) = w; } } }
    { const float* x = kin(A, I_X); float* h32 = nullptr; bf16* h16 = (bf16*)(F.ws + WS_H16);
      for (int r = gw; r < T; r += NGW) { f32x4 v[4];
#pragma unroll
          for (int j = 0; j < 4; ++j) v[j] = *(const f32x4*)(x + (size_t)r * D + 256 * j + 4 * lane);
          float mean, rstd; ln_stats(v, mean, rstd);
          ln_apply_store(v, mean, rstd, kin(A, I_LN_IN_G), kin(A, I_LN_IN_B), h32, h16 + (size_t)r * D, lane); } }
}

typedef f32x4 AccT[2][2][4][2];
#define EPI_BASES KArgs& KA = *kargs(); unsigned char* ws = kws(KA); (void)ws;
__device__ __forceinline__ v4u pk8(const f32x4 a, const f32x4 b) { v4u w; w.x = pk2(a.x, a.y); w.y = pk2(a.z, a.w); w.z = pk2(b.x, b.y); w.w = pk2(b.z, b.w); return w; }
__device__ __forceinline__ void unpk8(const v4u w, f32x4& a, f32x4& b) { a.x = bf2f(w.x & 0xffffu); a.y = bf2f(w.x >> 16); a.z = bf2f(w.y & 0xffffu); a.w = bf2f(w.y >> 16); b.x = bf2f(w.z & 0xffffu); b.y = bf2f(w.z >> 16); b.z = bf2f(w.w & 0xffffu); b.w = bf2f(w.w >> 16); }
__device__ __forceinline__ f32x4 ld4bf(const bf16* p) { const v2u w = *(const v2u*)p; f32x4 a; a.x = bf2f(w.x & 0xffffu); a.y = bf2f(w.x >> 16); a.z = bf2f(w.y & 0xffffu); a.w = bf2f(w.y >> 16); return a; }
__device__ __forceinline__ f32x4 sig4(const f32x4 v) { return (f32x4){sigmoidf_(v.x), sigmoidf_(v.y), sigmoidf_(v.z), sigmoidf_(v.w)}; }
struct EpiNull { static constexpr bool PERM = false; int dummy;
    __device__ __forceinline__ void operator()(const AccT& acc, const Unit& u, int wr, int wc, int fr, int fq) const { f32x4 t = {0, 0, 0, 0};
#pragma unroll
        for (int a = 0; a < 2; ++a)
#pragma unroll
            for (int b = 0; b < 2; ++b)
#pragma unroll
                for (int m = 0; m < 4; ++m) { t += acc[a][b][m][0]; t += acc[a][b][m][1]; }
        if (t.x + t.y + t.z + t.w == 1234.5f) { EPI_BASES *(f32x4*)(ws + WS_END) = t; } } };
struct EpiIn { static constexpr bool PERM = true; int l;
    __device__ __forceinline__ void operator()(const AccT& acc, const Unit& u, int wr, int wc, int fr, int fq) const { EPI_BASES
        bf16* Z = (bf16*)(ws + WS_Z); bf16* SG = (bf16*)(ws + WS_SG); bf16* AOUT = (bf16*)(ws + WS_AOUT); const float* gate_b = kin(KA, I_GATE_B) + (size_t)l * 4096;
        if (u.pn < 10) {
            pg8::epi_foreach8(acc, u, wr, wc, fr, fq, [&](int row, int col, f32x4 v0, f32x4 v1) { const v4u w = pk8(v0, v1);
                *(v4u*)(Z + (size_t)row * ZLD + col) = w;
                if (u.pn == 9) { const int cc = col - OFF_D, g = cc >> 4, c0 = cc & 15, chunk = row >> 6, s = row & 63; *(v4u*)(AOUT + ((size_t)(g * NCHT + chunk)) * S5K + s * 16 + c0) = w; } });
        } else {
            pg8::epi_foreach8(acc, u, wr, wc, fr, fq, [&](int row, int col, f32x4 v0, f32x4 v1) {
                const int gc = col - OFF_G; const f32x4 g0 = *(const f32x4*)(gate_b + gc), g1 = *(const f32x4*)(gate_b + gc + 4);
                *(v4u*)(SG + (size_t)row * 4096 + gc) = pk8(sig4(v0 + g0), sig4(v1 + g1)); });
        }
    } };
struct EpiBranch { static constexpr bool PERM = true; int dummy;
    __device__ __forceinline__ void operator()(const AccT& acc, const Unit& u, int wr, int wc, int fr, int fq) const { EPI_BASES const int br = u.e;
        bf16* MG = (bf16*)(ws + WS_MG16); const bf16* SG = (const bf16*)(ws + WS_SG);
        pg8::epi_foreach8(acc, u, wr, wc, fr, fq, [&](int row, int col, f32x4 v0, f32x4 v1) {
            f32x4 s0, s1; unpk8(*(const v4u*)(SG + (size_t)row * 4096 + br * 1024 + col), s0, s1);
            f32x4 r0 = v0 * s0, r1 = v1 * s1; bf16* p = MG + (size_t)row * D + col;
            if (br > 0) { f32x4 m0, m1; unpk8(*(const v4u*)p, m0, m1); r0 += m0; r1 += m1; }
            *(v4u*)p = pk8(r0, r1); });
    } };
struct EpiResid { static constexpr bool PERM = true; int dummy;
    __device__ __forceinline__ void operator()(const AccT& acc, const Unit& u, int wr, int wc, int fr, int fq) const { EPI_BASES
        const bf16* H = (const bf16*)(ws + WS_H16); bf16* P = (bf16*)(ws + WS_PRE16);
        pg8::epi_foreach8(acc, u, wr, wc, fr, fq, [&](int row, int col, f32x4 v0, f32x4 v1) { f32x4 h0, h1; unpk8(*(const v4u*)(H + (size_t)row * D + col), h0, h1);
            *(v4u*)(P + (size_t)row * D + col) = pk8(h0 * DN_ALPHA + v0, h1 * DN_ALPHA + v1); });
    } };
struct EpiBf16 { static constexpr bool PERM = true; unsigned off_mib; float scale;
    __device__ __forceinline__ void operator()(const AccT& acc, const Unit& u, int wr, int wc, int fr, int fq) const { EPI_BASES
        bf16* O = (bf16*)(ws + (size_t)off_mib * MiB);
        pg8::epi_foreach8(acc, u, wr, wc, fr, fq, [&](int row, int col, f32x4 v0, f32x4 v1) { *(v4u*)(O + (size_t)row * D + col) = pk8(v0 * scale, v1 * scale); });
    } };
struct EpiVT { static constexpr bool PERM = false; int dummy;
    __device__ __forceinline__ void operator()(const AccT& acc, const Unit& u, int wr, int wc, int fr, int fq) const { EPI_BASES
        bf16* VT = (bf16*)(ws + WS_VMT16);
        pg8::epi_foreach(acc, u, wr, wc, fr, fq, [&](int row, int col, f32x4 v) { const int b = row >> 8, m = row & 255; bf16* p = VT + ((size_t)(b * D + col)) * NMEM + m;
            p[0] = (bf16)f2bf(v.x); p[NMEM] = (bf16)f2bf(v.y); p[2 * NMEM] = (bf16)f2bf(v.z); p[3 * NMEM] = (bf16)f2bf(v.w); });
    } };
struct EpiXloc { static constexpr bool PERM = false; int dummy;
    __device__ __forceinline__ void operator()(const AccT& acc, const Unit& u, int wr, int wc, int fr, int fq) const { EPI_BASES
        float* X = (float*)(ws + WS_XLOC);
        pg8::epi_foreach(acc, u, wr, wc, fr, fq, [&](int row, int col, f32x4 v) { if (col < 128) *(f32x4*)(X + ((size_t)(u.e * NCHT + row)) * 128 + col) = v; });
    } };
struct EpiLora { static constexpr bool PERM = false; int l;
    __device__ __forceinline__ void operator()(const AccT& acc, const Unit& u, int wr, int wc, int fr, int fq) const { EPI_BASES
        if (u.pn == 0) { float* DEC = (float*)(ws + WS_DEC); const float* w0 = kin(KA, I_RW_W0) + l * 256;
            pg8::epi_foreach(acc, u, wr, wc, fr, fq, [&](int row, int col, f32x4 v) { const f32x4 wp = v + *(const f32x4*)(w0 + col); f32x4 o;
#pragma unroll
                for (int e = 0; e < 4; ++e) { const float sp = log1pf(__expf(-wp[e])); o[e] = __expf(-__expf(-sp - 0.5f)); }
                *(f32x4*)(DEC + (size_t)row * 256 + col) = o; });
        } else if (u.pn == 1) { float* AV = (float*)(ws + WS_AV); const float* a0 = kin(KA, I_RW_A0) + l * 256;
            pg8::epi_foreach(acc, u, wr, wc, fr, fq, [&](int row, int col, f32x4 v) { const int c = col - 256; *(f32x4*)(AV + (size_t)row * 256 + c) = sig4(v + *(const f32x4*)(a0 + c)); });
        } else { float* G = (float*)(ws + WS_RWG);
            pg8::epi_foreach(acc, u, wr, wc, fr, fq, [&](int row, int col, f32x4 v) { *(f32x4*)(G + (size_t)row * 256 + col - 512) = v; });
        }
    } };
__device__ __forceinline__ float gelu_tanh(float x) { const float u = 0.7978845608028654f * (x + 0.044715f * x * x * x); const float e = __expf(2.0f * u); const float th = 1.0f - 2.0f * __builtin_amdgcn_rcpf(e + 1.0f); return 0.5f * x * (1.0f + th); }
__device__ __forceinline__ f32x4 gelu4(const f32x4 v) { return (f32x4){gelu_tanh(v.x), gelu_tanh(v.y), gelu_tanh(v.z), gelu_tanh(v.w)}; }
struct EpiS5Y { static constexpr bool PERM = true; int l;
    __device__ __forceinline__ void operator()(const AccT& acc, const Unit& u, int wr, int wc, int fr, int fq) const { EPI_BASES
        bf16* YD = (bf16*)(ws + WS_YD16); const bf16* AOUT = (const bf16*)(ws + WS_AOUT); const float* dvec = kin(KA, I_S5_D) + l * 256;
        pg8::epi_foreach8(acc, u, wr, wc, fr, fq, [&](int row, int col, f32x4 v0, f32x4 v1) { const int t = col >> 4, c0 = col & 15, tok = row * CH + t, ch = u.e * 16 + c0;
            f32x4 u0, u1; unpk8(*(const v4u*)(AOUT + ((size_t)(u.e * NCHT + row)) * S5K + t * 16 + c0), u0, u1);
            const f32x4 d0 = *(const f32x4*)(dvec + ch), d1 = *(const f32x4*)(dvec + ch + 4);
            *(v4u*)(YD + (size_t)tok * 256 + ch) = pk8(gelu4(v0 + d0 * u0), gelu4(v1 + d1 * u1)); });
    } };
struct EpiGlu { static constexpr bool PERM = true; int l;
    __device__ __forceinline__ void operator()(const AccT& acc, const Unit& u, int wr, int wc, int fr, int fq) const { EPI_BASES
        bf16* O = (bf16*)(ws + WS_O16); const bf16* YD = (const bf16*)(ws + WS_YD16); const float* gb = kin(KA, I_S5_GLUB) + l * 256;
        pg8::epi_foreach8(acc, u, wr, wc, fr, fq, [&](int row, int col, f32x4 v0, f32x4 v1) { f32x4 y0, y1; unpk8(*(const v4u*)(YD + (size_t)row * 256 + col), y0, y1);
            const f32x4 b0 = *(const f32x4*)(gb + col), b1 = *(const f32x4*)(gb + col + 4);
            *(v4u*)(O + (size_t)row * D + 768 + col) = pk8(y0 * sig4(v0 + b0), y1 * sig4(v1 + b1)); });
    } };
__device__ __forceinline__ float swiglu(float g, float u) { g = fminf(g, 7.0f); u = fminf(fmaxf(u, -7.0f), 7.0f); return (u + 1.0f) * g * sigmoidf_(1.702f * g); }
struct EpiSwiglu { static constexpr bool PERM = true; int l;
    __device__ __forceinline__ void operator()(const AccT& acc, const Unit& u, int wr, int wc, int fr, int fq) const { EPI_BASES
        bf16* ACT = (bf16*)(ws + WS_ACT); const float* bb = kin(KA, I_EX_B1) + (size_t)(l * NE + u.e) * 2048;
#pragma unroll
        for (int ai = 0; ai < 2; ++ai)
#pragma unroll
            for (int m = 0; m < 4; ++m) { const int row = u.pm * 256 + ai * 128 + wr * 64 + m * 16 + fr; const int j = u.pn * 128 + wc * 32 + 8 * fq;
                f32x4 o[2];
#pragma unroll
                for (int n = 0; n < 2; ++n) { const f32x4 b0 = *(const f32x4*)(bb + 2 * (j + 4 * n)), b1v = *(const f32x4*)(bb + 2 * (j + 4 * n) + 4);
                    const f32x4 g = acc[ai][0][m][n], uu = acc[ai][1][m][n];
                    o[n] = (f32x4){swiglu(g.x + b0.x, uu.x + b0.y), swiglu(g.y + b0.z, uu.y + b0.w), swiglu(g.z + b1v.x, uu.z + b1v.y), swiglu(g.w + b1v.z, uu.w + b1v.w)}; }
                *(v4u*)(ACT + (size_t)row * DFF + j) = pk8(o[0], o[1]);
                if (m == 3) __builtin_amdgcn_sched_barrier(0); }
    } };
struct EpiMoeOut { static constexpr bool PERM = true; int l;
    __device__ __forceinline__ void operator()(const AccT& acc, const Unit& u, int wr, int wc, int fr, int fq) const { EPI_BASES
        bf16* YS = (bf16*)(ws + WS_YS); const float* SLOTW = (const float*)(ws + WS_SLOTW); const float* bb = kin(KA, I_EX_B2) + (size_t)(l * NE + u.e) * D;
        pg8::epi_foreach8(acc, u, wr, wc, fr, fq, [&](int row, int col, f32x4 v0, f32x4 v1) { const float sw = SLOTW[row]; const f32x4 b0 = *(const f32x4*)(bb + col), b1 = *(const f32x4*)(bb + col + 4);
            *(v4u*)(YS + (size_t)row * D + col) = pk8((v0 + b0) * sw, (v1 + b1) * sw); });
    } };

__device__ __forceinline__ void p_mix1(KArgs& A, const Frame& F, int l) {
    const int gw = F.bid * NWAVES + F.wave, NGW = F.G * NWAVES, lane = F.lane, tid = F.tid;
    const bf16* Z = (const bf16*)(F.ws + WS_Z); bf16* O16 = (bf16*)(F.ws + WS_O16);
    for (int rp_ = 0; rp_ < ((PROBE_PHASE == 101) ? PROBE_REPS : 1); ++rp_) { const float* cw = kin(A, I_CONV_W) + l * 3 * 256; const f32x4 w0 = *(const f32x4*)(cw + 4 * lane), w1 = *(const f32x4*)(cw + 256 + 4 * lane), w2 = *(const f32x4*)(cw + 512 + 4 * lane);
      for (int t = gw; t < T; t += NGW) { const int s = t & (SEQ - 1); const bf16* zr = Z + (size_t)t * ZLD + 4 * lane;
          const f32x4 bg = ld4bf(zr); f32x4 y = w2 * (ld4bf(zr + 256) * ld4bf(zr + 512));
          if (s >= 1) y += w1 * (ld4bf(zr - ZLD + 256) * ld4bf(zr - ZLD + 512));
          if (s >= 2) y += w0 * (ld4bf(zr - 2 * ZLD + 256) * ld4bf(zr - 2 * ZLD + 512));
          y = y * bg; v2u w; w.x = pk2(y.x, y.y); w.y = pk2(y.z, y.w); *(v2u*)(O16 + (size_t)t * D + 4 * lane) = w; } }
    for (int rp_ = 0; rp_ < ((PROBE_PHASE == 102) ? PROBE_REPS : 1); ++rp_) { LAS float* VN = (LAS float*)F.lds;
      const float* ng = kin(A, I_SG_NG) + l * 256; const float* nb = kin(A, I_SG_NB) + l * 256;
      for (int blk = F.bid; blk < T / 128; blk += F.G) {
          const f32x4 gg = *(const f32x4*)(ng + 4 * lane), bb = *(const f32x4*)(nb + 4 * lane);
          for (int r = F.wave; r < 128; r += NWAVES) { const int t = blk * 128 + r; const f32x4 v = ld4bf(Z + (size_t)t * ZLD + OFF_B + 256 + 4 * lane);
              const float mean = wave_sum((v.x + v.y) + (v.z + v.w)) * (1.f / 256); const f32x4 d = v - mean;
              const float var = wave_sum((d.x * d.x + d.y * d.y) + (d.z * d.z + d.w * d.w)) * (1.f / 256); const float rstd = 1.0f / sqrtf(var + LN_EPS);
              *(LAS f32x4*)(VN + r * 256 + 4 * lane) = d * rstd * gg + bb; }
          __syncthreads();
          const int i = tid >> 2, cq = tid & 3, t = blk * 128 + i, jmax = (i < 64) ? 64 : 128;
#pragma unroll 1
          for (int g = 0; g < 4; ++g) { f32x4 a0 = {0, 0, 0, 0}, a1 = a0, a2 = a0, a3 = a0;
              const float* wrow = kin(A, I_SG_W) + ((size_t)((l * 4 + g) * 128 + i)) * 128; const LAS float* vb = VN + g * 64 + cq * 16;
              for (int j = 0; j < jmax; j += 4) { const f32x4 w4 = *(const f32x4*)(wrow + j);
#pragma unroll
                  for (int jj = 0; jj < 4; ++jj) { const LAS f32x4* vp = (const LAS f32x4*)(vb + (j + jj) * 256); const float w = w4[jj];
                      a0 += vp[0] * w; a1 += vp[1] * w; a2 += vp[2] * w; a3 += vp[3] * w; } }
              const float bias = kin(A, I_SG_B)[(l * 4 + g) * 128 + i]; const bf16* up = Z + (size_t)t * ZLD + OFF_B + g * 64 + cq * 16;
              const f32x4 o0 = ld4bf(up) * (a0 + bias), o1 = ld4bf(up + 4) * (a1 + bias), o2 = ld4bf(up + 8) * (a2 + bias), o3 = ld4bf(up + 12) * (a3 + bias);
              v4u wa, wb; wa.x = pk2(o0.x, o0.y); wa.y = pk2(o0.z, o0.w); wa.z = pk2(o1.x, o1.y); wa.w = pk2(o1.z, o1.w); wb.x = pk2(o2.x, o2.y); wb.y = pk2(o2.z, o2.w); wb.z = pk2(o3.x, o3.y); wb.w = pk2(o3.z, o3.w);
              bf16* op = O16 + (size_t)t * D + 256 + g * 64 + cq * 16; *(v4u*)op = wa; *(v4u*)(op + 8) = wb; }
          __syncthreads();
      } }
    for (int rp_ = 0; rp_ < ((PROBE_PHASE == 103) ? PROBE_REPS : 1); ++rp_) {
      bf16* LA = (bf16*)(F.ws + WS_LA16); const f32x4 mul = *(const f32x4*)(kin(A, I_RW_MU) + l * 1024 + 768 + 4 * lane);
      for (int t = gw; t < T; t += NGW) { const int s = t & (SEQ - 1); const bf16* zr = Z + (size_t)t * ZLD + OFF_C + 768 + 4 * lane;
          f32x4 x = ld4bf(zr); f32x4 pv = {0, 0, 0, 0}; if (s > 0) pv = ld4bf(zr - ZLD); x = x + (pv - x) * mul;
          if (lane < 16) x = sig4(x * 2.0f) * 2.0f - 1.0f;
          else if (lane >= 32) x = sig4(x);
          v2u w; w.x = pk2(x.x, x.y); w.y = pk2(x.z, x.w); *(v2u*)(LA + (size_t)t * 256 + 4 * lane) = w; } }
}

__device__ __forceinline__ void p_rw_chunks(KArgs& A, const Frame& F, int l) {
    const int gw = F.bid * NWAVES + F.wave, NGW = F.G * NWAVES, lane = F.lane;
    const bf16* Z = (const bf16*)(F.ws + WS_Z); const float* DEC = (const float*)(F.ws + WS_DEC); const float* AV = (const float*)(F.ws + WS_AV);
    float* QH = (float*)(F.ws + WS_QH); float* YL = (float*)(F.ws + WS_YL); float* GC = (float*)(F.ws + WS_GC); float* HC = (float*)(F.ws + WS_HC); float* RK = (float*)(F.ws + WS_RK);
    LAS float* wl = (LAS float*)(F.lds + F.wave * 16384);
    for (int task = gw; task < 16 * NCH; task += NGW) { const int bh = task / NCH, ck = task % NCH, b = bh >> 2, head = bh & 3, c = head * 64 + lane;
        const float mu_r = kin(A, I_RW_MU)[l * 1024 + c], mu_k = kin(A, I_RW_MU)[l * 1024 + 256 + c], mu_v = kin(A, I_RW_MU)[l * 1024 + 512 + c];
        const float kkc = kin(A, I_RW_KK)[l * 256 + c], kac = kin(A, I_RW_KA)[l * 256 + c], rkc = kin(A, I_RW_RK)[l * 256 + c];
        float sp[64], sl[64];
        { const int ln = launder_v(lane);
#pragma unroll
          for (int k = 0; k < 64; ++k) { sp[k] = (k == ln) ? 1.0f : 0.0f; sl[k] = 0.0f; } }
        const int tg0 = b * SEQ + ck * CH;
        float pr = 0.f, pk = 0.f, pv = 0.f;
        if (ck > 0) { const bf16* zp = Z + (size_t)(tg0 - 1) * ZLD + OFF_C + c; pr = bf2f(zp[0]); pk = bf2f(zp[256]); pv = bf2f(zp[512]); }
#pragma unroll 1
        for (int sb = 0; sb < CH / 8; ++sb) {
#pragma unroll 1
            for (int hb = 0; hb < 2; ++hb) {
                float kk[4], dc[4], av[4], rs[4], k2[4], vs[4], ss[4], rkp[4];
#pragma unroll
                for (int i = 0; i < 4; ++i) { const int t = tg0 + sb * 8 + hb * 4 + i; const bf16* zr = Z + (size_t)t * ZLD + OFF_C + c;
                    const float r = bf2f(zr[0]), k = bf2f(zr[256]), v = bf2f(zr[512]); dc[i] = DEC[(size_t)t * 256 + c]; av[i] = AV[(size_t)t * 256 + c];
                    rs[i] = r + (pr - r) * mu_r; const float ks = k + (pk - k) * mu_k; vs[i] = v + (pv - v) * mu_v; pr = r; pk = k; pv = v;
                    kk[i] = ks * kkc; k2[i] = ks * (1.0f + (av[i] - 1.0f) * kac); ss[i] = kk[i] * kk[i]; rkp[i] = rs[i] * k2[i] * rkc; }
#pragma unroll
                for (int o = 1; o < 64; o <<= 1) {
#pragma unroll
                    for (int i = 0; i < 4; ++i) { ss[i] += shfl_xor_l(ss[i], o, lane); rkp[i] += shfl_xor_l(rkp[i], o, lane); } }
#pragma unroll
                for (int i = 0; i < 4; ++i) { const float inv = 1.0f / fmaxf(sqrtf(ss[i]), 1e-12f), kn = kk[i] * inv; LAS float* w = wl + (hb * 4 + i) * 384 + lane;
                    w[0] = -kn; w[64] = dc[i]; w[128] = kn * av[i]; w[192] = rs[i]; w[256] = k2[i]; w[320] = vs[i];
                    if (lane == 0) RK[(size_t)(tg0 + sb * 8 + hb * 4 + i) * 4 + head] = rkp[i]; }
            }
            LDS_WAIT();
#pragma unroll 1
            for (int st = 0; st < 8; ++st) { const LAS f32x4* base = (const LAS f32x4*)(wl + st * 384);
                float saP = 0.f, saL = 0.f;
#pragma unroll
                for (int q = 0; q < 16; ++q) { const f32x4 nk = base[q];
                    saP += sp[4 * q] * nk.x; saP += sp[4 * q + 1] * nk.y; saP += sp[4 * q + 2] * nk.z; saP += sp[4 * q + 3] * nk.w;
                    saL += sl[4 * q] * nk.x; saL += sl[4 * q + 1] * nk.y; saL += sl[4 * q + 2] * nk.z; saL += sl[4 * q + 3] * nk.w;
                    if ((q & 3) == 3) __builtin_amdgcn_sched_barrier(0); }
                const float vj = wl[st * 384 + 320 + lane];
                float yP = 0.f, yL = 0.f;
                f32x4 w = base[16], bq = base[32], r = base[48], kv = base[64];
#pragma unroll
                for (int q = 0; q < 16; ++q) { f32x4 wn = w, bn = bq, rn = r, kn = kv;
                    if (q < 15) { wn = base[16 + q + 1]; bn = base[32 + q + 1]; rn = base[48 + q + 1]; kn = base[64 + q + 1]; }
#pragma unroll
                    for (int e = 0; e < 4; ++e) { const int k = 4 * q + e;
                        sp[k] = sp[k] * w[e] + saP * bq[e]; sl[k] = sl[k] * w[e] + saL * bq[e] + vj * kv[e];
                        yP += sp[k] * r[e]; yL += sl[k] * r[e]; }
                    __builtin_amdgcn_sched_barrier(0);
                    w = wn; bq = bn; r = rn; kv = kn; }
                const size_t oi = ((size_t)(bh * SEQ + ck * CH + sb * 8 + st)) * 64 + lane;
                QH[oi] = yP; YL[oi] = yL; }
        }
        float* gp = GC + ((size_t)(bh * NCH + ck) * 64 + lane) * 64; float* hp = HC + ((size_t)(bh * NCH + ck) * 64 + lane) * 64;
#pragma unroll
        for (int q = 0; q < 16; ++q) { *(f32x4*)(gp + 4 * q) = (f32x4){sp[4 * q], sp[4 * q + 1], sp[4 * q + 2], sp[4 * q + 3]}; *(f32x4*)(hp + 4 * q) = (f32x4){sl[4 * q], sl[4 * q + 1], sl[4 * q + 2], sl[4 * q + 3]}; }
    }
}
__device__ __forceinline__ void p_s5_chain(KArgs& A, const Frame& F, int l) {
    const int gt = F.bid * NTHREADS + F.tid; if (gt >= NB * 16 * 64) return;
    const int b = gt >> 10, g = (gt >> 6) & 15, p = gt & 63;
    const float dt = expf(kin(A, I_S5_LOGDT)[l * 16 + g]); const float are = kin(A, I_S5_ARE)[(l * 16 + g) * 64 + p], aim = kin(A, I_S5_AIM)[(l * 16 + g) * 64 + p];
    const float mag = expf(are * dt * 64.0f); float sn, cs; sincosf(aim * dt * 64.0f, &sn, &cs); const float ar = mag * cs, ai = mag * sn;
    bf16* AO = (bf16*)(F.ws + WS_AOUT); const float* XL = (const float*)(F.ws + WS_XLOC);
    float xr = 0.f, xi = 0.f;
#pragma unroll 8
    for (int c = 0; c < NCH; ++c) { const size_t row = (size_t)g * NCHT + b * NCH + c;
        *(unsigned*)(AO + row * S5K + 1024 + 2 * p) = pk2(xr, xi);
        const f32x2 xl = *(const f32x2*)(XL + row * 128 + 2 * p);
        const float nr = ar * xr - ai * xi + xl.x, ni = ar * xi + ai * xr + xl.y; xr = nr; xi = ni; }
}
constexpr int CB = 8, NBLK = NCH / CB;
__device__ __forceinline__ void chain_load_g(const float* G, float (&ga)[64], int fr, int fq) {
#pragma unroll
    for (int jr = 0; jr < 16; ++jr)
#pragma unroll
        for (int mt = 0; mt < 4; ++mt) ga[jr * 4 + mt] = G[(size_t)((jr >> 2) * 16 + 4 * fq + (jr & 3)) * 64 + 16 * mt + fr];
}
__device__ __forceinline__ void chain_step(f32x4 (&acc)[4], const float (&ga)[64], const f32x4 (&ci)[4]) {
    f32x4 na[4] = {ci[0], ci[1], ci[2], ci[3]};
#pragma unroll
    for (int jr = 0; jr < 16; ++jr)
#pragma unroll
        for (int mt = 0; mt < 4; ++mt) na[mt] = __builtin_amdgcn_mfma_f32_16x16x4f32(ga[jr * 4 + mt], acc[jr >> 2][jr & 3], na[mt], 0, 0, 0);
#pragma unroll
    for (int mt = 0; mt < 4; ++mt) acc[mt] = na[mt];
}
__device__ __forceinline__ void chain_load_tile(const float* M, int rb, f32x4 (&t)[4], int fr, int fq) {
#pragma unroll
    for (int jt = 0; jt < 4; ++jt) t[jt] = *(const f32x4*)(M + (size_t)(16 * rb + fr) * 64 + 16 * jt + 4 * fq);
}
__device__ __forceinline__ void chain_store_tile(float* M, int rb, const f32x4 (&t)[4], int fr, int fq) {
#pragma unroll
    for (int jt = 0; jt < 4; ++jt) *(f32x4*)(M + (size_t)(16 * rb + fr) * 64 + 16 * jt + 4 * fq) = t[jt];
}
__device__ __forceinline__ void p_chain_compose(const Frame& F) {
    const int gw = F.bid * NWAVES + F.wave, NGW = F.G * NWAVES, ln_ = my_lane(), fr = ln_ & 15, fq = ln_ >> 4;
    const float* GC = (const float*)(F.ws + WS_GC); const float* HC = (const float*)(F.ws + WS_HC); float* GB = (float*)(F.ws + WS_GB); float* HB = (float*)(F.ws + WS_HB);
    for (int task = gw; task < 16 * NBLK * 8; task += NGW) { const int cb = task & 7, bb = task >> 3, rb = cb & 3; const bool isH = cb >= 4;
        const size_t c0 = (size_t)bb * CB;
        f32x4 acc[4]; chain_load_tile((isH ? HC : GC) + c0 * 4096, rb, acc, fr, fq);
        float ga[64]; chain_load_g(GC + (c0 + 1) * 4096, ga, fr, fq);
        f32x4 ci[4] = {{0, 0, 0, 0}, {0, 0, 0, 0}, {0, 0, 0, 0}, {0, 0, 0, 0}};
        if (isH) chain_load_tile(HC + (c0 + 1) * 4096, rb, ci, fr, fq);
#pragma unroll 1
        for (int i = 1; i < CB; ++i) { const int nx = (i + 1 < CB) ? i + 1 : i;
            f32x4 cn[4] = {{0, 0, 0, 0}, {0, 0, 0, 0}, {0, 0, 0, 0}, {0, 0, 0, 0}};
            if (isH) chain_load_tile(HC + (c0 + nx) * 4096, rb, cn, fr, fq);
            float gn[64]; chain_load_g(GC + (c0 + nx) * 4096, gn, fr, fq);
            chain_step(acc, ga, ci);
#pragma unroll
            for (int k = 0; k < 64; ++k) ga[k] = gn[k];
#pragma unroll
            for (int k = 0; k < 4; ++k) ci[k] = cn[k]; }
        chain_store_tile((isH ? HB : GB) + (size_t)bb * 4096, rb, acc, fr, fq);
    }
}
__device__ __forceinline__ void p_chain_blocks(const Frame& F, int gw, int NGW) {
    const int ln_ = my_lane(), fr = ln_ & 15, fq = ln_ >> 4;
    const float* GB = (const float*)(F.ws + WS_GB); const float* HB = (const float*)(F.ws + WS_HB); float* SB = (float*)(F.ws + WS_SB);
    for (int task = gw; task < 16 * 4; task += NGW) { const int vb = task & 3, bh = task >> 2;
        f32x4 acc[4] = {{0, 0, 0, 0}, {0, 0, 0, 0}, {0, 0, 0, 0}, {0, 0, 0, 0}};
        float ga[64]; chain_load_g(GB + (size_t)bh * NBLK * 4096, ga, fr, fq);
        f32x4 ci[4]; chain_load_tile(HB + (size_t)bh * NBLK * 4096, vb, ci, fr, fq);
#pragma unroll 1
        for (int blk = 0; blk < NBLK; ++blk) { const size_t bb = (size_t)bh * NBLK + blk;
            chain_store_tile(SB + bb * 4096, vb, acc, fr, fq);
            if (blk + 1 == NBLK) break;
            f32x4 cn[4]; chain_load_tile(HB + (bb + 1) * 4096, vb, cn, fr, fq);
            float gn[64]; chain_load_g(GB + (bb + 1) * 4096, gn, fr, fq);
            chain_step(acc, ga, ci);
#pragma unroll
            for (int k = 0; k < 64; ++k) ga[k] = gn[k];
#pragma unroll
            for (int k = 0; k < 4; ++k) ci[k] = cn[k]; }
    }
}
__device__ __forceinline__ void chain_inblock(const Frame& F, int bb, int vb) {
    const int ln_ = my_lane(), fr = ln_ & 15, fq = ln_ >> 4;
    const float* GC = (const float*)(F.ws + WS_GC); const float* HC = (const float*)(F.ws + WS_HC); const float* SB = (const float*)(F.ws + WS_SB); float* SC = (float*)(F.ws + WS_SC);
    const size_t c0 = (size_t)bb * CB;
    f32x4 acc[4]; chain_load_tile(SB + (size_t)bb * 4096, vb, acc, fr, fq);
    float ga[64]; chain_load_g(GC + c0 * 4096, ga, fr, fq);
    f32x4 ci[4]; chain_load_tile(HC + c0 * 4096, vb, ci, fr, fq);
#pragma unroll 1
    for (int i = 0; i < CB; ++i) {
        chain_store_tile(SC + (c0 + i) * 4096, vb, acc, fr, fq);
        if (i + 1 == CB) break;
        f32x4 cn[4]; chain_load_tile(HC + (c0 + i + 1) * 4096, vb, cn, fr, fq);
        float gn[64]; chain_load_g(GC + (c0 + i + 1) * 4096, gn, fr, fq);
        chain_step(acc, ga, ci);
#pragma unroll
        for (int k = 0; k < 64; ++k) ga[k] = gn[k];
#pragma unroll
        for (int k = 0; k < 4; ++k) ci[k] = cn[k]; }
}
__device__ __forceinline__ void rw_out_task(KArgs& A, const Frame& F, int l, int task) {
    const int lane = F.lane;
    const bf16* Z = (const bf16*)(F.ws + WS_Z); const float* QH = (const float*)(F.ws + WS_QH); const float* YL = (const float*)(F.ws + WS_YL); const float* SC = (const float*)(F.ws + WS_SC);
    const float* RWG = (const float*)(F.ws + WS_RWG); const float* RK = (const float*)(F.ws + WS_RK); bf16* O16 = (bf16*)(F.ws + WS_O16);
    LAS float* Qw = (LAS float*)(F.lds + F.wave * 16384);
    { const int bh = task / NCH, ck = task % NCH, b = bh >> 2, head = bh & 3;
        const size_t ti0 = (size_t)(bh * SEQ + ck * CH); const int t0g = b * SEQ + ck * CH;
        { const f32x4* qsrc = (const f32x4*)(QH + ti0 * 64) + lane; LAS f32x4* qdst = (LAS f32x4*)Qw + lane;
#pragma unroll
          for (int i = 0; i < 16; ++i) qdst[i * 64] = qsrc[i * 64]; }
        float srow[64];
        { const f32x4* ssrc = (const f32x4*)(SC + (size_t)(bh * NCH + ck) * 4096 + lane * 64);
#pragma unroll
          for (int i = 0; i < 16; ++i) { const f32x4 x = ssrc[i]; srow[4 * i] = x.x; srow[4 * i + 1] = x.y; srow[4 * i + 2] = x.z; srow[4 * i + 3] = x.w; } }
        const float lgv = kin(A, I_RW_LNG)[l * 256 + head * 64 + lane], lbv = kin(A, I_RW_LNB)[l * 256 + head * 64 + lane], mu_v = kin(A, I_RW_MU)[l * 1024 + 512 + head * 64 + lane];
        LDS_WAIT();
#pragma unroll 1
        for (int tb = 0; tb < CH; tb += 4) { float y[4], s1[4], s2[4];
#pragma unroll
            for (int u = 0; u < 4; ++u) { const int t = tb + u; float a = YL[(ti0 + t) * 64 + lane]; const LAS f32x4* qp = (const LAS f32x4*)(Qw + t * 64);
#pragma unroll
                for (int i = 0; i < 16; ++i) { const f32x4 qv = qp[i]; a += srow[4 * i] * qv.x; a += srow[4 * i + 1] * qv.y; a += srow[4 * i + 2] * qv.z; a += srow[4 * i + 3] * qv.w; }
                y[u] = a; s1[u] = a; s2[u] = a * a; }
#pragma unroll
            for (int o = 1; o < 64; o <<= 1) {
#pragma unroll
                for (int u = 0; u < 4; ++u) { s1[u] += shfl_xor_l(s1[u], o, lane); s2[u] += shfl_xor_l(s2[u], o, lane); } }
#pragma unroll
            for (int u = 0; u < 4; ++u) { const int t = tb + u; const float m = s1[u] * (1.f / 64), var = fmaxf(s2[u] * (1.f / 64) - m * m, 0.f); const float rstd = 1.0f / sqrtf(var + RW_LN_EPS);
                const float rk = RK[(size_t)(t0g + t) * 4 + head]; const bf16* zv = Z + (size_t)(t0g + t) * ZLD + OFF_C + 512 + head * 64 + lane; const float v1 = bf2f(zv[0]), v0 = (ck * CH + t > 0) ? bf2f(*(zv - ZLD)) : 0.f; const float vv = v1 + (v0 - v1) * mu_v; const float gg = RWG[(size_t)(t0g + t) * 256 + head * 64 + lane];
                const float o = ((y[u] - m) * rstd * lgv + lbv + rk * vv) * gg;
                O16[(size_t)(t0g + t) * D + 512 + head * 64 + lane] = (bf16)f2bf(o); }
        }
        LDS_WAIT();
    }
}
template <int LSTRIDE> __device__ __forceinline__ void attn_stage(LAS unsigned char* lds, const bf16* src, size_t row_stride, int tid) {
    const int r0 = tid >> 5, c = tid & 31; const bf16* sp = src + (size_t)r0 * row_stride + c * 8; LAS unsigned char* dp = lds + r0 * LSTRIDE + c * 16;
#pragma unroll 4
    for (int i = 0; i < 16; ++i) { const v4u v = *(const v4u*)(sp + (size_t)(16 * i) * row_stride); *(LAS v4u*)(dp + 16 * i * LSTRIDE) = v; }
}
constexpr int KSTR = 544, VSTR = 528;
__device__ __forceinline__ void p_attn(const Frame& F) {
    const int lane = F.lane, fr = lane & 15, fq = lane >> 4;
    const bf16* Q = (const bf16*)(F.ws + WS_Q16); const bf16* KM = (const bf16*)(F.ws + WS_KM16); const bf16* VT = (const bf16*)(F.ws + WS_VMT16); bf16* AO = (bf16*)(F.ws + WS_AO16);
    for (int item = F.bid; item < NB * 4 * (SEQ / 256); item += F.G) {
        const int qg = item % (SEQ / 256), bhd = item / (SEQ / 256), head = bhd & 3, b = bhd >> 2;
        attn_stage<KSTR>(F.lds, KM + (size_t)(b * NMEM) * D + head * 256, D, F.tid);
        __syncthreads();
        v4u pf[2][8]; float inv[2];
#pragma unroll
        for (int u = 0; u < 2; ++u) { const int q0 = b * SEQ + qg * 256 + u * 128 + F.wave * 16;
            bf16x8 qf[8];
#pragma unroll
            for (int ks = 0; ks < 8; ++ks) qf[ks] = *(const bf16x8*)(Q + (size_t)(q0 + fr) * D + head * 256 + ks * 32 + fq * 8);
            f32x4 sT[16];
            const LAS unsigned char* kbase = F.lds + fr * KSTR + fq * 16;
#pragma unroll
            for (int kt = 0; kt < 16; ++kt) { f32x4 a = {0, 0, 0, 0}; const LAS unsigned char* kp = kbase + kt * 16 * KSTR;
#pragma unroll
                for (int ks = 0; ks < 8; ++ks) { const bf16x8 kf = *(const LAS bf16x8*)(kp + ks * 64); a = __builtin_amdgcn_mfma_f32_16x16x32_bf16(kf, qf[ks], a, 0, 0, 0); }
                sT[kt] = a; if (kt & 1) __builtin_amdgcn_sched_barrier(0); }
            float mx = -3.0e38f;
#pragma unroll
            for (int kt = 0; kt < 16; ++kt) mx = fmaxf(fmaxf(fmaxf(mx, sT[kt].x), fmaxf(sT[kt].y, sT[kt].z)), sT[kt].w);
            mx = fmaxf(mx, shfl_xor_l(mx, 16, lane)); mx = fmaxf(mx, shfl_xor_l(mx, 32, lane));
            float sum = 0.f;
#pragma unroll
            for (int kt = 0; kt < 16; ++kt) { sT[kt].x = __expf(sT[kt].x - mx); sT[kt].y = __expf(sT[kt].y - mx); sT[kt].z = __expf(sT[kt].z - mx); sT[kt].w = __expf(sT[kt].w - mx); sum += (sT[kt].x + sT[kt].y) + (sT[kt].z + sT[kt].w); }
            sum += shfl_xor_l(sum, 16, lane); sum += shfl_xor_l(sum, 32, lane);
            inv[u] = 1.0f / sum;
#pragma unroll
            for (int kp = 0; kp < 8; ++kp) { v4u w; w.x = pk2(sT[2 * kp].x, sT[2 * kp].y); w.y = pk2(sT[2 * kp].z, sT[2 * kp].w); w.z = pk2(sT[2 * kp + 1].x, sT[2 * kp + 1].y); w.w = pk2(sT[2 * kp + 1].z, sT[2 * kp + 1].w); pf[u][kp] = w; }
            __builtin_amdgcn_sched_barrier(0);
        }
        __syncthreads();
        attn_stage<VSTR>(F.lds, VT + (size_t)(b * D + head * 256) * NMEM, NMEM, F.tid);
        __syncthreads();
#pragma unroll
        for (int u = 0; u < 2; ++u) { const int q0 = b * SEQ + qg * 256 + u * 128 + F.wave * 16;
#pragma unroll 2
            for (int dt = 0; dt < 16; ++dt) { f32x4 o = {0, 0, 0, 0}; const LAS unsigned char* vp = F.lds + (dt * 16 + fr) * VSTR + fq * 8;
#pragma unroll
                for (int kp = 0; kp < 8; ++kp) {
                    const v2u lo = *(const LAS v2u*)(vp + 64 * kp), hi = *(const LAS v2u*)(vp + 64 * kp + 32); v4u w; w.x = lo.x; w.y = lo.y; w.z = hi.x; w.w = hi.y;
                    o = __builtin_amdgcn_mfma_f32_16x16x32_bf16(__builtin_bit_cast(bf16x8, w), __builtin_bit_cast(bf16x8, pf[u][kp]), o, 0, 0, 0); }
                v2u w; w.x = pk2(o.x * inv[u], o.y * inv[u]); w.y = pk2(o.z * inv[u], o.w * inv[u]);
                *(v2u*)(AO + (size_t)(q0 + fr) * D + head * 256 + dt * 16 + 4 * fq) = w; __builtin_amdgcn_sched_barrier(0); } }
        __syncthreads();
    }
}

__device__ __forceinline__ void p_ln(const Frame& F, const float* g, const float* b, bool dummy) {
    const int gw = F.bid * NWAVES + F.wave, NGW = F.G * NWAVES, lane = F.lane; const bf16* P = (const bf16*)(F.ws + WS_PRE16); bf16* H16 = (bf16*)(F.ws + (dummy ? WS_Z + 128 * MiB : WS_H16));
    for (int r = gw; r < T; r += NGW) { f32x4 v[4];
#pragma unroll
        for (int j = 0; j < 4; ++j) v[j] = ld4bf(P + (size_t)r * D + 256 * j + 4 * lane);
        float mean, rstd; ln_stats(v, mean, rstd); ln_apply_store(v, mean, rstd, g, b, (float*)nullptr, H16 + (size_t)r * D, lane); }
}
__device__ __forceinline__ void p_ln_router(KArgs& A, const Frame& F, int l, bool dummy) {
    const int gw = F.bid * NWAVES + F.wave, NGW = F.G * NWAVES, lane = F.lane, tid = F.tid, fr = lane & 15, fq = lane >> 4;
    const bf16* H = (const bf16*)(F.ws + WS_PRE16); bf16* H16 = (bf16*)(F.ws + (dummy ? WS_Z + 128 * MiB : WS_H16)); int* TOKE = (int*)(F.ws + (dummy ? WS_Z + 200 * MiB : WS_TOKE)); float* TOKW = (float*)(F.ws + (dummy ? WS_Z + 201 * MiB : WS_TOKW));
    LAS v4u* TB = (LAS v4u*)F.lds;
    LAS float* PS = (LAS float*)(F.lds + 131072);
    volatile LAS unsigned* hist = F.MISC + MI_HIST;
    const float* rw = kin(A, I_ROUTER_W) + (size_t)l * D * NE; const float* rb = kin(A, I_ROUTER_B) + l * NE; const float* g = kin(A, I_LN2_G) + l * D; const float* bb = kin(A, I_LN2_B) + l * D;
    for (int en = tid; en < 32 * 2 * 64; en += NTHREADS) { const int ln = en & 63, et = (en >> 6) & 1, ks = en >> 7, efr = ln & 15, efq = ln >> 4; float hi[8], lo[8];
#pragma unroll
        for (int j = 0; j < 8; ++j) { const int d = 32 * ks + 8 * efq + j; const float v = g[d] * rw[d * NE + et * 16 + efr]; const float h = bf2f(f2bf(v)); hi[j] = h; lo[j] = v - h; }
        v4u wh, wl; wh.x = pk2(hi[0], hi[1]); wh.y = pk2(hi[2], hi[3]); wh.z = pk2(hi[4], hi[5]); wh.w = pk2(hi[6], hi[7]); wl.x = pk2(lo[0], lo[1]); wl.y = pk2(lo[2], lo[3]); wl.z = pk2(lo[4], lo[5]); wl.w = pk2(lo[6], lo[7]);
        TB[((ks * 2 + et) * 2 + 0) * 64 + ln] = wh; TB[((ks * 2 + et) * 2 + 1) * 64 + ln] = wl; }
    { const int e = tid & 31, part = tid >> 5; float sg = 0.f, sb = 0.f;
      for (int d = part * 64; d < part * 64 + 64; ++d) { const float w = rw[d * NE + e]; sg += g[d] * w; sb += bb[d] * w; }
      PS[part * 32 + e] = sg; PS[512 + part * 32 + e] = sb; }
    if (tid < NE) hist[tid] = 0u;
    __syncthreads();
    if (tid < NE) { float sg = 0.f, sb = 0.f;
#pragma unroll
        for (int p = 0; p < 16; ++p) { sg += PS[p * 32 + tid]; sb += PS[512 + p * 32 + tid]; }
        PS[1024 + tid] = sg; PS[1056 + tid] = sb + rb[tid]; }
    __syncthreads();
    const float cg0 = PS[1024 + fr], cg1 = PS[1024 + 16 + fr], cb0 = PS[1056 + fr], cb1 = PS[1056 + 16 + fr];
    for (int grp = gw; grp < T / 16; grp += NGW) { const int r0 = grp * 16; const bf16* xrow = H + (size_t)(r0 + fr) * D + 8 * fq;
        f32x4 acc0 = {0, 0, 0, 0}, acc1 = {0, 0, 0, 0}; float sum = 0.f, sq = 0.f;
#pragma unroll 2
        for (int ks = 0; ks < 32; ++ks) { const v4u xw = *(const v4u*)(xrow + 32 * ks); f32x4 xa, xb; unpk8(xw, xa, xb);
            sum += (xa.x + xa.y) + (xa.z + xa.w) + (xb.x + xb.y) + (xb.z + xb.w);
            sq += (xa.x * xa.x + xa.y * xa.y) + (xa.z * xa.z + xa.w * xa.w) + (xb.x * xb.x + xb.y * xb.y) + (xb.z * xb.z + xb.w * xb.w);
            const LAS v4u* tb = TB + (ks * 4) * 64 + lane; const v4u b0h = tb[0], b0l = tb[64], b1h = tb[128], b1l = tb[192];
            const bf16x8 Ah = __builtin_bit_cast(bf16x8, xw);
            acc0 = __builtin_amdgcn_mfma_f32_16x16x32_bf16(Ah, __builtin_bit_cast(bf16x8, b0h), acc0, 0, 0, 0); acc0 = __builtin_amdgcn_mfma_f32_16x16x32_bf16(Ah, __builtin_bit_cast(bf16x8, b0l), acc0, 0, 0, 0);
            acc1 = __builtin_amdgcn_mfma_f32_16x16x32_bf16(Ah, __builtin_bit_cast(bf16x8, b1h), acc1, 0, 0, 0); acc1 = __builtin_amdgcn_mfma_f32_16x16x32_bf16(Ah, __builtin_bit_cast(bf16x8, b1l), acc1, 0, 0, 0); }
        sum += shfl_xor_l(sum, 16, lane); sum += shfl_xor_l(sum, 32, lane); sq += shfl_xor_l(sq, 16, lane); sq += shfl_xor_l(sq, 32, lane);
        const float mean = sum * (1.f / D), rstd = 1.0f / sqrtf(fmaxf(sq * (1.f / D) - mean * mean, 0.f) + LN_EPS);
        float v0[4], v1[4];
#pragma unroll
        for (int reg = 0; reg < 4; ++reg) { const float rs = __builtin_bit_cast(float, shfl_idx_l(__builtin_bit_cast(int, rstd), 4 * fq + reg)), mn = __builtin_bit_cast(float, shfl_idx_l(__builtin_bit_cast(int, mean), 4 * fq + reg));
            v0[reg] = rs * acc0[reg] - rs * mn * cg0 + cb0; v1[reg] = rs * acc1[reg] - rs * mn * cg1 + cb1; }
        float wv[4][4]; int wi[4][4];
#pragma unroll
        for (int k = 0; k < 4; ++k) {
#pragma unroll
            for (int reg = 0; reg < 4; ++reg) { float bv = v0[reg]; int bi = fr; if (v1[reg] > bv) { bv = v1[reg]; bi = 16 + fr; }
#pragma unroll
                for (int o = 1; o < 16; o <<= 1) { const float ov = shfl_xor_l(bv, o, lane); const int oi = shfl_idx_l(bi, lane ^ o); if (ov > bv || (ov == bv && oi < bi)) { bv = ov; bi = oi; } }
                wv[k][reg] = bv; wi[k][reg] = bi; if (bi == fr) v0[reg] = -3.0e38f; if (bi == 16 + fr) v1[reg] = -3.0e38f; } }
        if (fr == 0) {
#pragma unroll
            for (int reg = 0; reg < 4; ++reg) { const int t = r0 + 4 * fq + reg; const float e1 = __expf(wv[1][reg] - wv[0][reg]), e2 = __expf(wv[2][reg] - wv[0][reg]), e3 = __expf(wv[3][reg] - wv[0][reg]), inv = 1.0f / (1.0f + e1 + e2 + e3);
                *(int4*)(TOKE + (size_t)t * 4) = make_int4(wi[0][reg], wi[1][reg], wi[2][reg], wi[3][reg]); *(f32x4*)(TOKW + (size_t)t * 4) = (f32x4){inv, e1 * inv, e2 * inv, e3 * inv};
#pragma unroll
                for (int k = 0; k < 4; ++k) __hip_atomic_fetch_add((LAS unsigned*)&hist[wi[k][reg]], 1u, __ATOMIC_RELAXED, __HIP_MEMORY_SCOPE_WORKGROUP); } }
        bf16* o16 = H16 + (size_t)(r0 + fr) * D + 8 * fq;
#pragma unroll 2
        for (int ks = 0; ks < 32; ++ks) { f32x4 xa, xb; unpk8(*(const v4u*)(xrow + 32 * ks), xa, xb);
            const f32x4 ga = *(const f32x4*)(g + 32 * ks + 8 * fq), gb = *(const f32x4*)(g + 32 * ks + 8 * fq + 4), ba = *(const f32x4*)(bb + 32 * ks + 8 * fq), bc = *(const f32x4*)(bb + 32 * ks + 8 * fq + 4);
            *(v4u*)(o16 + 32 * ks) = pk8((xa - mean) * rstd * ga + ba, (xb - mean) * rstd * gb + bc); }
    }
    __syncthreads();
    if (tid < NE && !dummy) { const unsigned c = hist[tid]; if (c) atomicAdd(F.ctl + CW_CNT + l * NE + tid, c); F.ctl[CW_WGH + (l * 512 + F.bid) * NE + tid] = c; }
}
__device__ __forceinline__ void moe_offsets(const Frame& F, int l) {
    if (F.tid == 0) { int acc = 0;
        for (int e = 0; e < NE; ++e) { F.MISC[MI_TOFF + e] = (unsigned)acc; const unsigned c = __hip_atomic_load(F.ctl + CW_CNT + l * NE + e, __ATOMIC_RELAXED, __HIP_MEMORY_SCOPE_AGENT); acc += (int)((c + 255u) >> 8); }
        F.MISC[MI_TOFF + NE] = (unsigned)acc; }
    __syncthreads();
}
__device__ __forceinline__ void p_moe_slots(const Frame& F, int l, int dummy) {
    const int gw = F.bid * NWAVES + F.wave, NGW = F.G * NWAVES, lane = F.lane;
    moe_offsets(F, l);
    const int* TOKE = (const int*)(F.ws + WS_TOKE); const float* TOKW = (const float*)(F.ws + WS_TOKW); int* TOKS = (int*)(F.ws + (dummy ? WS_END : WS_TOKS)); float* SLOTW = (float*)(F.ws + (dummy ? WS_END + 1 * MiB : WS_SLOTW));
    const bf16* H16 = (const bf16*)(F.ws + WS_H16); bf16* XG = (bf16*)(F.ws + (dummy ? WS_ACT : WS_XG)); unsigned* CUR = F.ctl + CW_CUR + l * NE + dummy * 256;
    if (F.tid < NE) { const unsigned c = F.ctl[CW_WGH + (l * 512 + F.bid) * NE + F.tid]; const unsigned base = c ? atomicAdd(CUR + F.tid, c) : 0u;
        F.MISC[MI_LBASE + F.tid] = F.MISC[MI_TOFF + F.tid] * 256u + base; F.MISC[MI_LCUR + F.tid] = 0u; }
    __syncthreads();
    for (int grp = gw; grp < T / 16; grp += NGW)
    for (int r = grp * 16; r < grp * 16 + 16; ++r) { int slot = 0;
        if (lane < 4) { const int e = TOKE[(size_t)r * 4 + lane]; const unsigned pos = __hip_atomic_fetch_add((LAS unsigned*)&F.MISC[MI_LCUR + e], 1u, __ATOMIC_RELAXED, __HIP_MEMORY_SCOPE_WORKGROUP); slot = (int)(F.MISC[MI_LBASE + e] + pos);
            TOKS[(size_t)r * 4 + lane] = slot; SLOTW[slot] = TOKW[(size_t)r * 4 + lane]; }
        const v4u a = *(const v4u*)(H16 + (size_t)r * D + 8 * lane), b = *(const v4u*)(H16 + (size_t)r * D + 512 + 8 * lane);
#pragma unroll
        for (int k = 0; k < 4; ++k) { const int sk = shfl_idx_l(slot, k); *(v4u*)(XG + (size_t)sk * D + 8 * lane) = a; *(v4u*)(XG + (size_t)sk * D + 512 + 8 * lane) = b; } }
}
__device__ __forceinline__ void p_moe_combine(KArgs& A, const Frame& F, int l, bool dummy) {
    const int gw = F.bid * NWAVES + F.wave, NGW = F.G * NWAVES, lane = F.lane;
    const bf16* H = (const bf16*)(F.ws + WS_H16); bf16* H16 = (bf16*)(F.ws + (dummy ? WS_Z + 128 * MiB : WS_H16)); const int* TOKS = (const int*)(F.ws + WS_TOKS); const bf16* YS = (const bf16*)(F.ws + WS_YS);
    const bool last = (l == NL - 1) && !dummy;
    for (int r = gw; r < T; r += NGW) { f32x4 v[4]; const int4 sl = *(const int4*)(TOKS + (size_t)r * 4);
#pragma unroll
        for (int j = 0; j < 4; ++j) { v[j] = ld4bf(H + (size_t)r * D + 256 * j + 4 * lane) * DN_ALPHA;
            const v2u y0 = *(const v2u*)(YS + (size_t)sl.x * D + 256 * j + 4 * lane), y1 = *(const v2u*)(YS + (size_t)sl.y * D + 256 * j + 4 * lane), y2 = *(const v2u*)(YS + (size_t)sl.z * D + 256 * j + 4 * lane), y3 = *(const v2u*)(YS + (size_t)sl.w * D + 256 * j + 4 * lane);
            v[j].x += (bf2f(y0.x & 0xffffu) + bf2f(y1.x & 0xffffu)) + (bf2f(y2.x & 0xffffu) + bf2f(y3.x & 0xffffu));
            v[j].y += (bf2f(y0.x >> 16) + bf2f(y1.x >> 16)) + (bf2f(y2.x >> 16) + bf2f(y3.x >> 16));
            v[j].z += (bf2f(y0.y & 0xffffu) + bf2f(y1.y & 0xffffu)) + (bf2f(y2.y & 0xffffu) + bf2f(y3.y & 0xffffu));
            v[j].w += (bf2f(y0.y >> 16) + bf2f(y1.y >> 16)) + (bf2f(y2.y >> 16) + bf2f(y3.y >> 16)); }
        float mean, rstd; ln_stats(v, mean, rstd);
        if (last) ln_apply_store(v, mean, rstd, kin(A, I_LN3_G) + l * D, kin(A, I_LN3_B) + l * D, kout(A) + (size_t)r * D, (bf16*)nullptr, lane);
        else ln_apply_store(v, mean, rstd, kin(A, I_LN3_G) + l * D, kin(A, I_LN3_B) + l * D, (float*)nullptr, H16 + (size_t)r * D, lane); }
}

constexpr int NPL = 18;
constexpr int NPHASES = 1 + NL * NPL;
#ifndef ONLY
#define ONLY -1
#endif
#define EN(j) (ONLY < 0 || ONLY == (j))
#define DUMMY(j) ((PROBE_PHASE == (j)) && (rep_ + 1 < PROBE_REPS))
#define REPS(j) for (int rep_ = 0; rep_ < ((PROBE_PHASE == (j)) ? PROBE_REPS : 1); ++rep_, __syncthreads())
__global__ void __launch_bounds__(NTHREADS, 2) fwd_kernel(Args args) {
    extern __shared__ __attribute__((aligned(16))) unsigned char lds_raw[];
    Frame F;
    F.lds = (LAS unsigned char*)lds_raw; F.MISC = (volatile LAS unsigned*)(F.lds + MISC_OFF);
    F.tid = threadIdx.x; F.lane = F.tid & 63; F.wave = __builtin_amdgcn_readfirstlane(F.tid >> 6); F.G = gridDim.x; F.bid = blockIdx.x;
    F.ws = (unsigned char*)(GAS unsigned char*)args.ws; F.ctl = (unsigned*)(F.ws + WS_CTL);
    for (int u = F.tid; u < (LDS_BYTES - MISC_OFF) / 4; u += NTHREADS) F.MISC[u] = 0u;
    __syncthreads();
    XcdBarrier bar; bar.bar = F.ctl + CW_BAR; bar.x = 0; bar.st = nullptr;
    const int lo = args.ph_lo, hi = args.ph_hi;
    if (hi - lo > 1) bar = xcd_barrier_post(F.ctl + CW_BAR, F.MISC + 8);
#define IN(k) (launder_i(lo) <= (k) && (k) < launder_i(hi))
#define SEAM(k) do { if (IN(k) && IN((k) + 1)) xcd_barrier(bar); } while (0)
#define PH_BEGIN KArgs& KA = *kargs(); unsigned char* ws = launder_p(args.ws); F.ws = ws; (void)KA; (void)ws; { int ln_; asm volatile("v_mbcnt_lo_u32_b32 %0, -1, 0\n\tv_mbcnt_hi_u32_b32 %0, -1, %0" : "=v"(ln_)); F.lane = ln_; } F.tid = F.wave * 64 + F.lane; F.bid = launder_i((int)blockIdx.x); F.G = launder_i((int)gridDim.x);

    if (EN(100) && IN(0)) REPS(100) { PH_BEGIN p_prologue(KA, F); } SEAM(0);
    if (PROBE_PHASE == 300) { for (int q_ = 0; q_ < 20; ++q_) xcd_barrier(bar); }

#pragma unroll 1
    for (int l_ = 0; l_ < NL; ++l_) {
        const int l = launder_i(l_); const int p0 = 1 + l * NPL;
        if (EN(0) && IN(p0 + 0)) REPS(0) { PH_BEGIN
            pg8::Gemm g{D, D, D}; pg8::StaticOrder S{(const bf16*)(ws + WS_H16), (const bf16*)(ws + WS_WINT) + (size_t)l * N_IN * D, D, D, T / 256, N_IN / 256, F.G, F.bid};
            if (PROBE_PHASE == 200) { for (int q_ = 0; q_ < PROBE_REPS - 1; ++q_) { EpiNull E0{0}; pg8::gemm_phase(F.lds, F.wave * 64 + my_lane(), g, S, E0); __syncthreads(); } }
            EpiIn E{l};
            pg8::gemm_phase(F.lds, F.wave * 64 + my_lane(), g, S, E);
        } SEAM(p0 + 0);
        if (EN(1) && IN(p0 + 1)) REPS(1) { PH_BEGIN p_mix1(KA, F, l); } SEAM(p0 + 1);
        if (EN(2) && IN(p0 + 2)) REPS(2) { PH_BEGIN
            { pg8::Gemm g{S5K, 1024, 1024}; pg8::BatchOrder S{(const bf16*)(ws + WS_AOUT), (const bf16*)(ws + WS_S5BC) + (size_t)l * 16 * 256 * 1024, S5K, 1024, NCHT / 256, 1, 16, F.G, F.bid, (size_t)NCHT * S5K, (size_t)256 * 1024};
              EpiXloc E{0}; pg8::gemm_phase(F.lds, F.wave * 64 + my_lane(), g, S, E); }
            __syncthreads();
            { pg8::Gemm g{D, D, D}; pg8::StaticOrder S{(const bf16*)(ws + WS_MEM16), (const bf16*)(ws + WS_WKT) + (size_t)l * D * D, D, D, NB * NMEM / 256, D / 256, F.G, F.bid};
              EpiBf16 E{(unsigned)(WS_KM16 / MiB), 1.0f}; pg8::gemm_phase(F.lds, F.wave * 64 + my_lane(), g, S, E); }
            __syncthreads();
            { pg8::Gemm g{D, D, D}; pg8::StaticOrder S{(const bf16*)(ws + WS_MEM16), (const bf16*)(ws + WS_WVT) + (size_t)l * D * D, D, D, NB * NMEM / 256, D / 256, F.G, F.bid};
              EpiVT E{0}; pg8::gemm_phase(F.lds, F.wave * 64 + my_lane(), g, S, E); }
            __syncthreads();
            { pg8::Gemm g{256, 256, 256}; pg8::StaticOrder S{(const bf16*)(ws + WS_LA16), (const bf16*)(ws + WS_LWT) + (size_t)l * 768 * 256, 256, 256, T / 256, 3, F.G, F.bid};
              EpiLora E{l}; pg8::gemm_phase(F.lds, F.wave * 64 + my_lane(), g, S, E); }
        } SEAM(p0 + 2);
        if (EN(3) && IN(p0 + 3)) REPS(3) { PH_BEGIN p_s5_chain(KA, F, l); p_rw_chunks(KA, F, l); } SEAM(p0 + 3);
        if (EN(4) && IN(p0 + 4)) REPS(4) { PH_BEGIN
            p_chain_compose(F);
            pg8::Gemm g{S5K, S5K, S5K}; pg8::BatchOrder S{(const bf16*)(ws + WS_AOUT), (const bf16*)(ws + WS_S5BT) + (size_t)l * 16 * 1024 * S5K, S5K, S5K, NCHT / 256, 1024 / 256, 16, F.G, F.bid, (size_t)NCHT * S5K, (size_t)1024 * S5K};
            EpiS5Y E{l}; pg8::gemm_phase(F.lds, F.wave * 64 + my_lane(), g, S, E);
        } SEAM(p0 + 4);
        if (EN(5) && IN(p0 + 5)) REPS(5) { PH_BEGIN
            const int nchain = (F.G >= 16) ? 8 : 0;
            if (F.bid < nchain) { p_chain_blocks(F, F.bid * NWAVES + F.wave, nchain * NWAVES); }
            else {
                if (nchain == 0) { p_chain_blocks(F, F.bid * NWAVES + F.wave, F.G * NWAVES); __syncthreads(); }
                pg8::Gemm g{256, 256, 256}; pg8::StaticOrder S{(const bf16*)(ws + WS_YD16), (const bf16*)(ws + WS_GLUT) + (size_t)l * 256 * 256, 256, 256, T / 256, 1, F.G - nchain, F.bid - nchain};
                EpiGlu E{l}; pg8::gemm_phase(F.lds, F.wave * 64 + my_lane(), g, S, E);
            }
        } SEAM(p0 + 5);
        if (EN(6) && IN(p0 + 6)) REPS(6) { PH_BEGIN
            for (int bb = F.bid; bb < 16 * NBLK; bb += F.G) {
                if (F.wave < 4) chain_inblock(F, bb, F.wave);
                VM_WAIT(); __syncthreads();
                rw_out_task(KA, F, l, bb * CB + F.wave);
                __syncthreads();
            }
        } SEAM(p0 + 6);
        if (EN(7) && IN(p0 + 7)) REPS(7) { PH_BEGIN
            pg8::Gemm g{D, 256, 256}; pg8::BranchOrder S{(const bf16*)(ws + WS_O16), (const bf16*)(ws + WS_BRT) + (size_t)l * 4 * D * 256, T / 256, D / 256, F.G, F.bid};
            EpiBranch E{0}; pg8::gemm_phase(F.lds, F.wave * 64 + my_lane(), g, S, E);
        } SEAM(p0 + 7);
        if (EN(8) && IN(p0 + 8)) REPS(8) { PH_BEGIN
            pg8::Gemm g{D, D, D}; pg8::StaticOrder S{(const bf16*)(ws + WS_MG16), (const bf16*)(ws + WS_WOUTT) + (size_t)l * D * D, D, D, T / 256, D / 256, F.G, F.bid};
            EpiResid E{0}; pg8::gemm_phase(F.lds, F.wave * 64 + my_lane(), g, S, E);
        } SEAM(p0 + 8);
        if (EN(9) && IN(p0 + 9)) REPS(9) { PH_BEGIN p_ln(F, kin(KA, I_LN1_G) + l * D, kin(KA, I_LN1_B) + l * D, DUMMY(9)); } SEAM(p0 + 9);
        if (EN(10) && IN(p0 + 10)) REPS(10) { PH_BEGIN
            pg8::Gemm g{D, D, D}; pg8::StaticOrder S{(const bf16*)(ws + WS_H16), (const bf16*)(ws + WS_WQT) + (size_t)l * D * D, D, D, T / 256, D / 256, F.G, F.bid};
            EpiBf16 E{(unsigned)(WS_Q16 / MiB), 0.0625f}; pg8::gemm_phase(F.lds, F.wave * 64 + my_lane(), g, S, E);
        } SEAM(p0 + 10);
        if (EN(11) && IN(p0 + 11)) REPS(11) { PH_BEGIN p_attn(F); } SEAM(p0 + 11);
        if (EN(12) && IN(p0 + 12)) REPS(12) { PH_BEGIN
            pg8::Gemm g{D, D, D}; pg8::StaticOrder S{(const bf16*)(ws + WS_AO16), (const bf16*)(ws + WS_WOT) + (size_t)l * D * D, D, D, T / 256, D / 256, F.G, F.bid};
            EpiResid E{0}; pg8::gemm_phase(F.lds, F.wave * 64 + my_lane(), g, S, E);
        } SEAM(p0 + 12);
        if (EN(13) && IN(p0 + 13)) REPS(13) { PH_BEGIN p_ln_router(KA, F, l, DUMMY(13)); } SEAM(p0 + 13);
        if (EN(14) && IN(p0 + 14)) REPS(14) { PH_BEGIN p_moe_slots(F, l, DUMMY(14) ? (rep_ + 1) : 0); } SEAM(p0 + 14);
        if (EN(15) && IN(p0 + 15)) REPS(15) { PH_BEGIN
            moe_offsets(F, l);
            pg8::Gemm g{D, D, D}; pg8::MoeOrder S{(const bf16*)(ws + WS_XG), (const bf16*)(ws + WS_W1T) + (size_t)l * NE * 2048 * D, D, D, 2048 / 256, F.G, F.bid, (size_t)2048 * D, (const LAS int*)(F.MISC + MI_TOFF)};
            if (PROBE_PHASE == 201) { for (int q_ = 0; q_ < PROBE_REPS - 1; ++q_) { EpiNull E0{0}; pg8::gemm_phase(F.lds, F.wave * 64 + my_lane(), g, S, E0); __syncthreads(); } }
            EpiSwiglu E{l}; pg8::gemm_phase(F.lds, F.wave * 64 + my_lane(), g, S, E);
        } SEAM(p0 + 15);
        if (EN(16) && IN(p0 + 16)) REPS(16) { PH_BEGIN
            moe_offsets(F, l);
            pg8::Gemm g{DFF, DFF, DFF}; pg8::MoeOrder S{(const bf16*)(ws + WS_ACT), (const bf16*)(ws + WS_W2T) + (size_t)l * NE * D * DFF, DFF, DFF, D / 256, F.G, F.bid, (size_t)D * DFF, (const LAS int*)(F.MISC + MI_TOFF)};
            EpiMoeOut E{l}; pg8::gemm_phase(F.lds, F.wave * 64 + my_lane(), g, S, E);
        } SEAM(p0 + 16);
        if (EN(17) && IN(p0 + 17)) REPS(17) { PH_BEGIN p_moe_combine(KA, F, l, DUMMY(17)); } SEAM(p0 + 17);
    }
#undef IN
#undef SEAM
}

extern "C" void kernel_launch(void* const* d_in, const int* in_sizes, int n_in, void* d_out, int out_size, void* d_ws, size_t ws_size, hipStream_t stream) {
    static int grid = 0;
    if (grid == 0) {
        if (n_in != 50 || ws_size < WS_END) { fprintf(stderr, "kernel_launch: unexpected n_in %d / ws_size %zu\n", n_in, ws_size); grid = -1; return; }
        int dev = 0, cus = 0, per_cu = 0;
        if (hipGetDevice(&dev) != hipSuccess || hipDeviceGetAttribute(&cus, hipDeviceAttributeMultiprocessorCount, dev) != hipSuccess) { grid = -1; return; }
        if (hipFuncSetAttribute((const void*)fwd_kernel, hipFuncAttributeMaxDynamicSharedMemorySize, LDS_BYTES) != hipSuccess) { fprintf(stderr, "kernel_launch: hipFuncSetAttribute failed\n"); grid = -1; return; }
        if (hipOccupancyMaxActiveBlocksPerMultiprocessor(&per_cu, (const void*)fwd_kernel, NTHREADS, LDS_BYTES) != hipSuccess || per_cu < 1) { fprintf(stderr, "kernel_launch: occupancy query says %d\n", per_cu); }
        (void)hipGetLastError();
        grid = cus;
    }
    if (grid < 0) return;
    (void)hipMemsetAsync((char*)d_ws + WS_CTL, 0, CTL_ZERO_BYTES, stream);
    Args a{};
    for (int i = 0; i < 50; ++i) a.in[i] = (const float*)d_in[i];
    a.out = (float*)d_out; a.ws = (unsigned char*)d_ws;
#if N_LAUNCHES == 1
    a.ph_lo = 0; a.ph_hi = NPHASES;
    hipLaunchKernelGGL(fwd_kernel, dim3(grid), dim3(NTHREADS), LDS_BYTES, stream, a);
#else
    for (int p = 0; p < NPHASES; ++p) { a.ph_lo = p; a.ph_hi = p + 1; hipLaunchKernelGGL(fwd_kernel, dim3(grid), dim3(NTHREADS), LDS_BYTES, stream, a); }
#endif
}
```

```cpp
#include <hip/hip_runtime.h>
#include <cstdio>
#include <cstdint>

#ifndef N_LAUNCHES
#define N_LAUNCHES 1
#endif

#ifndef PROBE_PHASE
#define PROBE_PHASE -1
#endif
#ifndef PROBE_REPS
#define PROBE_REPS 3
#endif
#define GAS __attribute__((address_space(1)))
#define LAS __attribute__((address_space(3)))
typedef unsigned short bf16;
typedef unsigned v4u __attribute__((ext_vector_type(4)));
typedef unsigned v2u __attribute__((ext_vector_type(2)));
typedef float f32x4 __attribute__((ext_vector_type(4)));
typedef float f32x2 __attribute__((ext_vector_type(2)));
typedef short bf16x8 __attribute__((ext_vector_type(8)));
typedef short bf16x4 __attribute__((ext_vector_type(4)));

constexpr int NL = 2, NB = 4, SEQ = 8192, T = NB * SEQ, D = 1024;
constexpr int NMEM = 256;
constexpr int OFF_B = 768, OFF_C = 1280, OFF_D = 2304, OFF_G = 2560, N_IN = 6656, ZLD = 2560;
constexpr int NE = 32, TOPK = 4, DFF = 1024;
constexpr int CH = 64;
constexpr int NCH = SEQ / CH;
constexpr int NCHT = T / CH;
constexpr int S5K = 1152;
constexpr int SLOT_ROWS = T * TOPK + NE * 256;
constexpr float LN_EPS = 1e-5f, RW_LN_EPS = 64e-5f;
constexpr float DN_ALPHA = 1.41421356237309515f;

constexpr size_t MiB = 1u << 20;
constexpr size_t WS_CTL = 0, CTL_ZERO_BYTES = 1 * MiB;
constexpr size_t WS_W1T = 2 * MiB;
constexpr size_t WS_W2T = 258 * MiB;
constexpr size_t WS_WINT = 386 * MiB;
constexpr size_t WS_BRT = 412 * MiB;
constexpr size_t WS_WOUTT = 416 * MiB, WS_WQT = 420 * MiB, WS_WKT = 424 * MiB, WS_WVT = 428 * MiB, WS_WOT = 432 * MiB;
constexpr size_t WS_GLUT = 436 * MiB;
constexpr size_t WS_MEM16 = 437 * MiB;
constexpr size_t WS_S5BT = 440 * MiB;
constexpr size_t WS_S5BC = 512 * MiB;
constexpr size_t WS_PRE16 = 528 * MiB;
constexpr size_t WS_H16 = 656 * MiB;
constexpr size_t WS_Z = 720 * MiB;
constexpr size_t WS_XG = 720 * MiB;
constexpr size_t WS_SG = 1040 * MiB;
constexpr size_t WS_YS = 1040 * MiB;
constexpr size_t WS_O16 = 1312 * MiB, WS_MG16 = 1376 * MiB, WS_Q16 = 1440 * MiB, WS_AO16 = 1504 * MiB;
constexpr size_t WS_LA16 = 1568 * MiB;
constexpr size_t WS_DEC = 1584 * MiB, WS_AV = 1616 * MiB;
constexpr size_t WS_LWT = 2012 * MiB;
constexpr size_t WS_ACT = 1568 * MiB;
constexpr size_t WS_QH = 1760 * MiB, WS_YL = 1792 * MiB, WS_GC = 1824 * MiB, WS_HC = 1856 * MiB, WS_SC = 1888 * MiB, WS_RWG = 1920 * MiB;
constexpr size_t WS_RK = 1952 * MiB;
constexpr size_t WS_AOUT = 1954 * MiB;
constexpr size_t WS_XLOC = 1972 * MiB;
constexpr size_t WS_YD16 = 1976 * MiB;
constexpr size_t WS_KM16 = 1992 * MiB, WS_VMT16 = 1994 * MiB;
constexpr size_t WS_TOKE = 1996 * MiB, WS_TOKW = 1997 * MiB, WS_TOKS = 1998 * MiB, WS_SLOTW = 1999 * MiB;
constexpr size_t WS_GB = 2000 * MiB, WS_HB = 2004 * MiB, WS_SB = 2008 * MiB;
constexpr size_t WS_END = 2014 * MiB;
static_assert(WS_XG + (size_t)SLOT_ROWS * D * 2 <= WS_SG && WS_YS + (size_t)SLOT_ROWS * D * 2 <= WS_O16 && WS_ACT + (size_t)SLOT_ROWS * D * 2 <= WS_RK, "overlays");
constexpr int CW_BAR = 4096;
constexpr int CW_CNT = 16384;
constexpr int CW_CUR = 16384 + 128;
constexpr int CW_WGH = 65536;

constexpr int LDS_BYTES = 163840;
constexpr int MISC_OFF = LDS_BYTES - 1024;
constexpr int RING_BYTES = 131072;
constexpr int NWAVES = 8, NTHREADS = 512;

#define LDS_WAIT() asm volatile("s_waitcnt lgkmcnt(0)" ::: "memory")
#define VM_WAIT() asm volatile("s_waitcnt vmcnt(0)" ::: "memory")
__device__ __forceinline__ unsigned f2bf(float f) { unsigned u = __float_as_uint(f); return (u + 0x7fffu + ((u >> 16) & 1u)) >> 16; }
__device__ __forceinline__ unsigned pk2(float lo, float hi) { unsigned r; asm("v_cvt_pk_bf16_f32 %0, %1, %2" : "=v"(r) : "v"(lo), "v"(hi)); return r; }
__device__ __forceinline__ float bf2f(unsigned h) { return __uint_as_float(h << 16); }
__device__ __forceinline__ float sigmoidf_(float x) { return __builtin_amdgcn_rcpf(1.0f + __expf(-x)); }
__device__ __forceinline__ int my_lane() { int l; asm volatile("v_mbcnt_lo_u32_b32 %0, -1, 0\n\tv_mbcnt_hi_u32_b32 %0, -1, %0" : "=v"(l)); return l; }
__device__ __forceinline__ float shfl_xor_l(float v, int o, int lane) { return __builtin_bit_cast(float, __builtin_amdgcn_ds_bpermute((lane ^ o) << 2, __builtin_bit_cast(int, v))); }
__device__ __forceinline__ int shfl_idx_l(int v, int src) { return __builtin_amdgcn_ds_bpermute(src << 2, v); }
__device__ __forceinline__ float wave_sum(float v) {
    const int ln = my_lane();
#pragma unroll
    for (int o = 1; o < 64; o <<= 1) v += shfl_xor_l(v, o, ln);
    return v;
}

#define XB_TMO      128
#define XB_XCNT(j)  (256  + 64 * (j))
#define XB_XSUB(j)  (1280 + 64 * (j))
#define XB_XGEN(j)  (2304 + 64 * (j))
#define XB_TOP      3328
#define XB_TOPGEN   3392
#define XCD_BAR_WORDS 3456
#define XB_SPIN_CAP (1u << 24)
__device__ __forceinline__ unsigned xb_ld(unsigned* p)              { return __hip_atomic_load(p, __ATOMIC_RELAXED, __HIP_MEMORY_SCOPE_AGENT); }
__device__ __forceinline__ unsigned xb_add(unsigned* p, unsigned v) { return __hip_atomic_fetch_add(p, v, __ATOMIC_RELAXED, __HIP_MEMORY_SCOPE_AGENT); }
__device__ __forceinline__ unsigned xb_xcc_id() { return (unsigned)__builtin_amdgcn_s_getreg((3 << 11) | 20) & 0xFu; }
#define XB_SPIN(cond, bar) do { unsigned _sp = 0; while (cond) { __builtin_amdgcn_s_sleep(1); \
    if ((++_sp & 255u) == 0u) { if (xb_ld(&(bar)[XB_TMO])) break; if (_sp > XB_SPIN_CAP) { atomicAdd(&(bar)[XB_TMO], 1u); break; } } } } while (0)
struct XcdBarrier { unsigned* bar; unsigned x; volatile LAS unsigned* st; };
__device__ __forceinline__ XcdBarrier xcd_barrier_post(unsigned* bar, volatile LAS unsigned* st) {
    XcdBarrier b; b.bar = bar; b.x = xb_xcc_id(); b.st = st;
    if (threadIdx.x == 0) (void)xb_add(&bar[XB_XCNT(b.x)], 1u);
    return b;
}
__device__ __forceinline__ void xcd_barrier_complete(unsigned* bar, unsigned x, unsigned& nloc, unsigned& nx) {
    const unsigned G = gridDim.x * gridDim.y * gridDim.z;
    unsigned sum, cnt, mine, sp = 0u;
    for (;;) {
        sum = 0u; cnt = 0u; mine = 0u;
#pragma unroll
        for (unsigned j = 0; j < 16; ++j) { const unsigned c = xb_ld(&bar[XB_XCNT(j)]); sum += c; cnt += (c > 0u) ? 1u : 0u; mine = (j == x) ? c : mine; }
        if (sum == G) break;
        __builtin_amdgcn_s_sleep(1);
        if ((++sp & 255u) == 0u) { if (xb_ld(&bar[XB_TMO])) break; if (sp > XB_SPIN_CAP) { atomicAdd(&bar[XB_TMO], 1u); break; } }
    }
    nloc = mine > 0u ? mine : 1u; nx = cnt > 0u ? cnt : 1u;
}
__device__ __forceinline__ void xcd_barrier(const XcdBarrier& b) {
    asm volatile("s_waitcnt vmcnt(0)" ::: "memory");
    __syncthreads();
    if (threadIdx.x == 0) {
        unsigned* bar = b.bar; unsigned bx = b.x;
        asm volatile("" : "+s"(bar), "+s"(bx));
        __builtin_amdgcn_s_waitcnt(0);
        unsigned nloc = b.st[0], nx = b.st[1];
        if (nloc == 0u) { xcd_barrier_complete(bar, bx, nloc, nx); b.st[0] = nloc; b.st[1] = nx; }
        const unsigned old = xb_add(&bar[XB_XSUB(bx)], 1u);
        const unsigned gen = old / nloc;
        if (old + 1u == (gen + 1u) * nloc) {
            __builtin_amdgcn_fence(__ATOMIC_RELEASE, "agent");
            asm volatile("s_waitcnt vmcnt(0)" ::: "memory");
            const unsigned og = xb_add(&bar[XB_TOP], 1u);
            const unsigned tg = og / nx;
            if (og + 1u == (tg + 1u) * nx) xb_add(&bar[XB_TOPGEN], 1u);
            else XB_SPIN(xb_ld(&bar[XB_TOPGEN]) == tg, bar);
            __builtin_amdgcn_fence(__ATOMIC_ACQUIRE, "agent");
            xb_add(&bar[XB_XGEN(bx)], 1u);
            asm volatile("s_waitcnt vmcnt(0)" ::: "memory");
        } else {
            XB_SPIN(xb_ld(&bar[XB_XGEN(bx)]) == gen, bar);
            __builtin_amdgcn_fence(__ATOMIC_ACQUIRE, "agent");
            asm volatile("s_waitcnt vmcnt(0)" ::: "memory");
        }
    }
    __syncthreads();
}

namespace pg8 {
constexpr int BM = 256, BK = 64, HALF = 128, HTB = HALF * BK * 2, STAGE_BYTES = 8 * HTB, NXCD = 8, WGM = 8;
__host__ __device__ __forceinline__ int lds_byte(int r, int c) { const int st = (r >> 4) * 2 + (c >> 5), rr = r & 15, cc = c & 31, ob = rr * 64 + cc * 2; return st * 1024 + (ob ^ (((ob >> 9) & 1) << 5)); }
__host__ __device__ __forceinline__ int perm32(int rho) { const int n = rho >> 4, i = rho & 15; return 8 * (i >> 2) + 4 * n + (i & 3); }
__host__ __device__ __forceinline__ void stage_rc(int b, int& R, int& C) { const int st = b / 1024, sb = b % 1024, swz = sb ^ (((sb >> 9) & 1) << 5); R = (st >> 1) * 16 + swz / 64; C = (st & 1) * 32 + (swz % 64) / 2; }
struct Unit { int pm, pn, e; };
struct Gemm { int lda, ldb, K; };

__device__ __forceinline__ bool static_tile(int i, int G, int c, int nM, int nN, int& pm, int& pn) {
    const int nwg = nM * nN; const long L = (long)i * G + c; if (L >= nwg) return false;
    int wgid = (int)L; { const int q = nwg / NXCD, r = nwg % NXCD, xcd = wgid % NXCD, off = wgid / NXCD; wgid = (xcd < r ? xcd * (q + 1) : r * (q + 1) + (xcd - r) * q) + off; }
    const int nig = WGM * nN, gid = wgid / nig, fm = gid * WGM, gsz = (nM - fm) < WGM ? (nM - fm) : WGM;
    pm = fm + ((wgid % nig) % gsz); pn = (wgid % nig) / gsz; return true;
}
struct StaticOrder {
    const bf16* A; const bf16* Bt; int lda, ldb, nM, nN, G, c;
    __device__ __forceinline__ bool next(int i, Unit& u) const { u.e = 0; return static_tile(i, G, c, nM, nN, u.pm, u.pn); }
    __device__ __forceinline__ const char* a_base(const Unit& u) const { return (const char*)(A + (size_t)u.pm * BM * lda); }
    __device__ __forceinline__ const char* b_base(const Unit& u) const { return (const char*)(Bt + (size_t)u.pn * BM * ldb); }
};
struct BatchOrder {
    const bf16* A; const bf16* Bt; int lda, ldb, nM, nN, nb, G, c; size_t sA, sB;
    __device__ __forceinline__ bool next(int i, Unit& u) const {
        const long L = (long)i * G + c; const int per = nM * nN; if (L >= (long)per * nb) return false;
        u.e = (int)(L / per); const int r = (int)(L % per); u.pn = r / nM; u.pm = r % nM; return true; }
    __device__ __forceinline__ const char* a_base(const Unit& u) const { return (const char*)(A + (size_t)u.e * sA + (size_t)u.pm * BM * lda); }
    __device__ __forceinline__ const char* b_base(const Unit& u) const { return (const char*)(Bt + (size_t)u.e * sB + (size_t)u.pn * BM * ldb); }
};
struct BranchOrder {
    const bf16* A; const bf16* Bt; int nM, nN, G, c;
    __device__ __forceinline__ bool next(int i, Unit& u) const { u.e = i & 3; return static_tile(i >> 2, G, c, nM, nN, u.pm, u.pn); }
    __device__ __forceinline__ const char* a_base(const Unit& u) const { return (const char*)(A + (size_t)u.pm * BM * D + u.e * 256); }
    __device__ __forceinline__ const char* b_base(const Unit& u) const { return (const char*)(Bt + (size_t)u.e * D * 256 + (size_t)u.pn * BM * 256); }
};
struct MoeOrder {
    const bf16* A; const bf16* Bt; int lda, ldb, nN, G, c; size_t sB; const LAS int* toff;
    __device__ __forceinline__ bool next(int i, Unit& u) const {
        const int nt = toff[NE]; int mt;
        const int Gx = G >> 3;
        if ((G & 7) == 0 && (Gx % nN) == 0) {
            const int per = Gx / nN, x = c & 7, y = c >> 3;
            mt = i * 8 * per + x * per + y / nN; u.pn = y % nN; if (mt >= nt) return false;
        } else { const long L = (long)i * G + c; if (L >= (long)nt * nN) return false; mt = (int)(L / nN); u.pn = (int)(L % nN); }
        u.pm = mt; int e = 0;
#pragma unroll 1
        for (int k = 1; k < NE; ++k) e += (toff[k] <= mt) ? 1 : 0;
        u.e = e; return true; }
    __device__ __forceinline__ const char* a_base(const Unit& u) const { return (const char*)(A + (size_t)u.pm * BM * lda); }
    __device__ __forceinline__ const char* b_base(const Unit& u) const { return (const char*)(Bt + (size_t)u.e * sB + (size_t)u.pn * BM * ldb); }
};

template <class F> __device__ __forceinline__ void epi_foreach(const f32x4 (&acc)[2][2][4][2], const Unit& u, int wr, int wc, int fr, int fq, const F& f) {
#pragma unroll
    for (int ai = 0; ai < 2; ++ai)
#pragma unroll
        for (int m = 0; m < 4; ++m) { const int row = u.pm * BM + ai * HALF + wr * 64 + m * 16 + fr;
#pragma unroll
            for (int bj = 0; bj < 2; ++bj)
#pragma unroll
                for (int n = 0; n < 2; ++n) f(row, u.pn * BM + bj * HALF + wc * 32 + n * 16 + 4 * fq, acc[ai][bj][m][n]);
            if (m == 3) __builtin_amdgcn_sched_barrier(0); }
}

template <class F> __device__ __forceinline__ void epi_foreach8(const f32x4 (&acc)[2][2][4][2], const Unit& u, int wr, int wc, int fr, int fq, const F& f) {
#pragma unroll
    for (int ai = 0; ai < 2; ++ai)
#pragma unroll
        for (int m = 0; m < 4; ++m) { const int row = u.pm * BM + ai * HALF + wr * 64 + m * 16 + fr;
#pragma unroll
            for (int bj = 0; bj < 2; ++bj) f(row, u.pn * BM + bj * HALF + wc * 32 + 8 * fq, acc[ai][bj][m][0], acc[ai][bj][m][1]);
            if (m == 3) __builtin_amdgcn_sched_barrier(0); }
}
template <class Epi, class Sched, bool ALIGN_EPI = true, bool SP2 = true>
__device__ __forceinline__ void gemm_phase(LAS unsigned char* lds, const int tid, const Gemm g, const Sched& S, const Epi& E) {
    const int wid = __builtin_amdgcn_readfirstlane(tid >> 6), lane = tid & 63, wr = wid >> 2, wc = wid & 3, fr = lane & 15, fq = lane >> 4;
    const int K = g.K, nt = K / BK;
    unsigned voffA[2], voffB[2];
#pragma unroll
    for (int i = 0; i < 2; ++i) { int R, C; stage_rc(tid * 16 + i * 8192, R, C);
        const int Rb = Epi::PERM ? ((R & ~31) + perm32(R & 31)) : R;
        voffA[i] = (unsigned)(R * g.lda + C) * 2u; voffB[i] = (unsigned)(Rb * g.ldb + C) * 2u; }
    const size_t kstep = (size_t)(BK * 2);
    const size_t hstepA = (size_t)HALF * g.lda * 2, hstepB = (size_t)HALF * g.ldb * 2;
    const unsigned ldsw = (unsigned)wid * 1024u;
    const int aoff = lds_byte(wr * 64 + fr, fq * 8), boff = lds_byte(wc * 32 + fr, fq * 8);
#define PG8_SA(b, h) (((b) * 2 + (h)) * HTB)
#define PG8_SB(b, h) ((4 + (b) * 2 + (h)) * HTB)
#define PG8_STAGE(bufoff, gbase, voff) do { _Pragma("unroll") for (int _i = 0; _i < 2; ++_i) \
        __builtin_amdgcn_global_load_lds((const unsigned*)((const char*)(gbase) + (voff)[_i]), (LAS unsigned*)(lds + (bufoff) + ldsw + _i * 8192), 16, 0, 0); } while (0)
#define PG8_LDA(dst, b, h) do { _Pragma("unroll") for (int m = 0; m < 4; ++m) _Pragma("unroll") for (int k = 0; k < 2; ++k) dst[m][k] = *(const LAS bf16x8*)(lds + PG8_SA(b, h) + aoff + m * 2048 + k * 1024); } while (0)
#define PG8_LDB(dst, b, h) do { _Pragma("unroll") for (int n = 0; n < 2; ++n) _Pragma("unroll") for (int k = 0; k < 2; ++k) dst[n][k] = *(const LAS bf16x8*)(lds + PG8_SB(b, h) + boff + n * 2048 + k * 1024); } while (0)
#define PG8_MMA(ai, bj, At, Bt) do { __builtin_amdgcn_s_setprio(1); _Pragma("unroll") for (int m = 0; m < 4; ++m) _Pragma("unroll") for (int n = 0; n < 2; ++n) _Pragma("unroll") for (int k = 0; k < 2; ++k) \
        acc[ai][bj][m][n] = __builtin_amdgcn_mfma_f32_16x16x32_bf16(Bt[n][k], At[m][k], acc[ai][bj][m][n], 0, 0, 0); __builtin_amdgcn_s_setprio(0); } while (0)
#define PG8_WAIT_V(n) asm volatile("s_waitcnt vmcnt(" #n ")" ::: "memory")
#define PG8_WAIT_L(n) asm volatile("s_waitcnt lgkmcnt(" #n ")" ::: "memory")
#define PG8_BAR __builtin_amdgcn_s_barrier()
#define PG8_SCHED __builtin_amdgcn_sched_barrier(0)
    Unit cur, nxt; int ui = 0;
    if (!S.next(0, cur)) return;
    f32x4 acc[2][2][4][2];
#pragma unroll
    for (int a = 0; a < 2; ++a)
#pragma unroll
        for (int b = 0; b < 2; ++b)
#pragma unroll
            for (int m = 0; m < 4; ++m)
#pragma unroll
                for (int n = 0; n < 2; ++n) acc[a][b][m][n] = (f32x4){0.f, 0.f, 0.f, 0.f};
    bf16x8 At[4][2], B0[2][2], B1[2][2];
    const char* cA = S.a_base(cur); const char* cB = S.b_base(cur);
    if constexpr (SP2) {
        PG8_STAGE(PG8_SB(0, 0), cB, voffB); PG8_STAGE(PG8_SB(0, 1), cB + hstepB, voffB); PG8_STAGE(PG8_SA(0, 0), cA, voffA); PG8_STAGE(PG8_SA(0, 1), cA + hstepA, voffA);
        if (wr == 1) PG8_BAR;
        PG8_WAIT_V(2); PG8_BAR;
        PG8_STAGE(PG8_SB(1, 0), cB + kstep, voffB); PG8_STAGE(PG8_SA(1, 0), cA + kstep, voffA); PG8_STAGE(PG8_SB(1, 1), cB + hstepB + kstep, voffB);
        PG8_WAIT_V(6); PG8_BAR;
    } else {
        PG8_STAGE(PG8_SB(0, 0), cB, voffB); PG8_STAGE(PG8_SA(0, 0), cA, voffA); PG8_STAGE(PG8_SB(0, 1), cB + hstepB, voffB); PG8_STAGE(PG8_SA(0, 1), cA + hstepA, voffA);
        if (wr == 1) PG8_BAR;
        PG8_WAIT_V(4); PG8_BAR;
        PG8_STAGE(PG8_SB(1, 0), cB + kstep, voffB); PG8_STAGE(PG8_SA(1, 0), cA + kstep, voffA); PG8_STAGE(PG8_SB(1, 1), cB + hstepB + kstep, voffB);
        PG8_WAIT_V(6); PG8_BAR;
    }
    for (;;) {
        const bool has_next = S.next(ui + 1, nxt);
        const char* nA = has_next ? S.a_base(nxt) : cA; const char* nB = has_next ? S.b_base(nxt) : cB;
        for (int t = 0; t < nt; t += 2) {
            const bool last = (t == nt - 2);
            const char* a1 = cA + (size_t)(t + 1) * kstep;
            const char* a2 = last ? nA : cA + (size_t)(t + 2) * kstep; const char* b2 = last ? nB : cB + (size_t)(t + 2) * kstep;
            const char* a3 = a2 + kstep; const char* b3 = b2 + kstep;
            if constexpr (SP2) {
            PG8_LDB(B0, 0, 0); PG8_LDB(B1, 0, 1); PG8_SCHED; PG8_LDA(At, 0, 0); PG8_STAGE(PG8_SA(1, 1), a1 + hstepA, voffA);
            PG8_WAIT_V(8); PG8_WAIT_L(0); PG8_BAR; PG8_MMA(0, 0, At, B0); PG8_MMA(0, 1, At, B1); PG8_BAR; PG8_SCHED;
            PG8_LDA(At, 0, 1); PG8_STAGE(PG8_SB(0, 0), b2, voffB); PG8_STAGE(PG8_SB(0, 1), b2 + hstepB, voffB); PG8_STAGE(PG8_SA(0, 0), a2, voffA);
            PG8_WAIT_V(8); PG8_WAIT_L(0); PG8_BAR; PG8_MMA(1, 0, At, B0); PG8_MMA(1, 1, At, B1); PG8_BAR; PG8_SCHED;
            PG8_LDB(B0, 1, 0); PG8_LDB(B1, 1, 1); PG8_SCHED; PG8_LDA(At, 1, 0); PG8_STAGE(PG8_SA(0, 1), a2 + hstepA, voffA);
            PG8_WAIT_V(8); PG8_WAIT_L(0); PG8_BAR; PG8_MMA(0, 0, At, B0); PG8_MMA(0, 1, At, B1); PG8_BAR; PG8_SCHED;
            PG8_LDA(At, 1, 1); PG8_STAGE(PG8_SB(1, 0), b3, voffB); PG8_STAGE(PG8_SB(1, 1), b3 + hstepB, voffB); PG8_STAGE(PG8_SA(1, 0), a3, voffA);
            PG8_WAIT_V(8); PG8_WAIT_L(0); PG8_BAR; PG8_MMA(1, 0, At, B0); PG8_MMA(1, 1, At, B1); PG8_BAR; PG8_SCHED;
            } else {
            PG8_LDB(B0, 0, 0); PG8_SCHED; PG8_LDA(At, 0, 0); PG8_STAGE(PG8_SA(1, 1), a1 + hstepA, voffA);
            PG8_WAIT_L(8); PG8_BAR; PG8_WAIT_L(0); PG8_MMA(0, 0, At, B0); PG8_BAR; PG8_SCHED;
            PG8_LDB(B1, 0, 1); PG8_STAGE(PG8_SB(0, 0), b2, voffB);
            PG8_BAR; PG8_WAIT_L(0); PG8_MMA(0, 1, At, B1); PG8_BAR;
            PG8_LDA(At, 0, 1); PG8_STAGE(PG8_SA(0, 0), a2, voffA);
            PG8_BAR; PG8_WAIT_L(0); PG8_MMA(1, 0, At, B0); PG8_BAR; PG8_SCHED;
            PG8_STAGE(PG8_SB(0, 1), b2 + hstepB, voffB);
            PG8_WAIT_V(6); PG8_BAR; PG8_MMA(1, 1, At, B1); PG8_BAR;
            PG8_LDB(B0, 1, 0); PG8_SCHED; PG8_LDA(At, 1, 0); PG8_STAGE(PG8_SA(0, 1), a2 + hstepA, voffA);
            PG8_WAIT_L(8); PG8_BAR; PG8_WAIT_L(0); PG8_MMA(0, 0, At, B0); PG8_BAR; PG8_SCHED;
            PG8_LDB(B1, 1, 1); PG8_STAGE(PG8_SB(1, 0), b3, voffB);
            PG8_BAR; PG8_WAIT_L(0); PG8_MMA(0, 1, At, B1); PG8_BAR;
            PG8_LDA(At, 1, 1); PG8_STAGE(PG8_SA(1, 0), a3, voffA);
            PG8_BAR; PG8_WAIT_L(0); PG8_MMA(1, 0, At, B0); PG8_BAR; PG8_SCHED;
            PG8_STAGE(PG8_SB(1, 1), b3 + hstepB, voffB);
            PG8_WAIT_V(6); PG8_BAR; PG8_MMA(1, 1, At, B1); PG8_BAR;
            }
        }
        if constexpr (ALIGN_EPI) { if (wr == 0) PG8_BAR; }
        { const int lane2 = my_lane();
          E(acc, cur, wid >> 2, wid & 3, lane2 & 15, lane2 >> 4); }
        if (!has_next) break;
#pragma unroll
        for (int a = 0; a < 2; ++a)
#pragma unroll
            for (int b = 0; b < 2; ++b)
#pragma unroll
                for (int m = 0; m < 4; ++m)
#pragma unroll
                    for (int n = 0; n < 2; ++n) acc[a][b][m][n] = (f32x4){0.f, 0.f, 0.f, 0.f};
        cur = nxt; cA = nA; cB = nB; ++ui;
        if constexpr (ALIGN_EPI) { if (wr == 1) PG8_BAR; }
    }
    PG8_WAIT_V(0);
    if constexpr (!ALIGN_EPI) { if (wr == 0) PG8_BAR; }
    PG8_BAR;
#undef PG8_SA
#undef PG8_SB
#undef PG8_STAGE
#undef PG8_LDA
#undef PG8_LDB
#undef PG8_MMA
#undef PG8_WAIT_V
#undef PG8_WAIT_L
#undef PG8_BAR
#undef PG8_SCHED
}
}
using pg8::Unit;

struct Args { const float* in[50]; float* out; unsigned char* ws; int ph_lo, ph_hi; };
typedef const __attribute__((address_space(4))) Args KArgs;
__device__ __forceinline__ KArgs* kargs() { KArgs* p = (KArgs*)__builtin_amdgcn_kernarg_segment_ptr(); asm volatile("" : "+s"(p)); return p; }
__device__ __forceinline__ unsigned char* launder_p(unsigned char* p) { asm volatile("" : "+s"(p)); return (unsigned char*)(GAS unsigned char*)p; }
__device__ __forceinline__ const float* kin(KArgs& A, int i) { return (const float*)(const GAS float*)A.in[i]; }
__device__ __forceinline__ float* kout(KArgs& A) { return (float*)(GAS float*)A.out; }
__device__ __forceinline__ unsigned char* kws(KArgs& A) { return (unsigned char*)(GAS unsigned char*)A.ws; }
__device__ __forceinline__ int launder_i(int v) { asm volatile("" : "+s"(v)); return v; }
__device__ __forceinline__ int launder_v(int v) { asm volatile("" : "+v"(v)); return v; }
enum { I_X = 0, I_MEM, I_LN_IN_G, I_LN_IN_B, I_W_IN, I_CONV_W, I_SG_NG, I_SG_NB, I_SG_W, I_SG_B, I_RW_MU, I_RW_W0, I_RW_WUP, I_RW_A0, I_RW_AUP, I_RW_GUP,
       I_RW_KK, I_RW_KA, I_RW_RK, I_RW_LNG, I_RW_LNB, I_S5_ARE, I_S5_AIM, I_S5_BRE, I_S5_BIM, I_S5_CRE, I_S5_CIM, I_S5_D, I_S5_LOGDT, I_S5_GLUW, I_S5_GLUB,
       I_BR_PROJ, I_GATE_B, I_W_OUT, I_LN1_G, I_LN1_B, I_XA_WQ, I_XA_WK, I_XA_WV, I_XA_WO, I_LN2_G, I_LN2_B, I_ROUTER_W, I_ROUTER_B, I_EX_W1, I_EX_B1, I_EX_W2, I_EX_B2,
       I_LN3_G, I_LN3_B };
struct Frame { LAS unsigned char* lds; volatile LAS unsigned* MISC; unsigned* ctl; unsigned char* ws; int tid, lane, wave, G, bid; };
constexpr int MI_TOFF = 16, MI_HIST = 64, MI_LBASE = 96, MI_LCUR = 128;

__device__ __forceinline__ void ln_stats(const f32x4 (&v)[4], float& mean, float& rstd) {
    float s = 0.f;
#pragma unroll
    for (int j = 0; j < 4; ++j) s += (v[j].x + v[j].y) + (v[j].z + v[j].w);
    mean = wave_sum(s) * (1.f / D); float s2 = 0.f;
#pragma unroll
    for (int j = 0; j < 4; ++j) { const f32x4 d = v[j] - mean; s2 += (d.x * d.x + d.y * d.y) + (d.z * d.z + d.w * d.w); }
    rstd = 1.0f / sqrtf(wave_sum(s2) * (1.f / D) + LN_EPS);
}
__device__ __forceinline__ void ln_apply_store(const f32x4 (&v)[4], float mean, float rstd, const float* g, const float* b, float* o32, bf16* o16, int lane) {
#pragma unroll
    for (int j = 0; j < 4; ++j) {
        const f32x4 gg = *(const f32x4*)(g + 256 * j + 4 * lane), bb = *(const f32x4*)(b + 256 * j + 4 * lane);
        const f32x4 y = (v[j] - mean) * rstd * gg + bb;
        if (o32) *(f32x4*)(o32 + 256 * j + 4 * lane) = y;
        if (o16) { v2u w; w.x = pk2(y.x, y.y); w.y = pk2(y.z, y.w); *(v2u*)(o16 + 256 * j + 4 * lane) = w; }
    }
}

__device__ __forceinline__ void transpose_item(const float* W, int K, int N, bf16* WT, int mode, LAS float* scr, int item, int lane) {
    const int nblk = N / 32, kb = item / nblk, nb = item % nblk, k0 = 64 * kb, n0 = 32 * nb;
#pragma unroll 8
    for (int i = 0; i < 32; ++i) { const int kk = 2 * i + (lane >> 5); scr[kk * 33 + (lane & 31)] = W[(size_t)(k0 + kk) * N + n0 + (lane & 31)]; }
    LDS_WAIT();
    const int c = lane & 7;
#pragma unroll
    for (int j = 0; j < 4; ++j) { const int n = (lane >> 3) + 8 * j; const LAS float* s = scr + (8 * c) * 33 + n;
        v4u o; o.x = pk2(s[0 * 33], s[1 * 33]); o.y = pk2(s[2 * 33], s[3 * 33]); o.z = pk2(s[4 * 33], s[5 * 33]); o.w = pk2(s[6 * 33], s[7 * 33]);
        const int nn = n0 + n; const int jj = nn >> 1;
        const int row = mode ? ((jj >> 7) * 256 + (nn & 1) * 128 + (jj & 127)) : nn;
        *(v4u*)(WT + (size_t)row * K + k0 + 8 * c) = o; }
    LDS_WAIT();
}
__device__ __forceinline__ void s5_setup_item(KArgs& A, const Frame& F, int item) {
    const int l = item >> 4, g = item & 15, tid = F.tid;
    LAS float* Kt = (LAS float*)F.lds;
    LAS float* Pw = (LAS float*)(F.lds + 65536);
    LAS float* Bb = (LAS float*)(F.lds + 65536 + 33280);
    LAS float* Cc = Bb + 2048;
    const float* a_re = kin(A, I_S5_ARE) + (l * 16 + g) * 64; const float* a_im = kin(A, I_S5_AIM) + (l * 16 + g) * 64;
    const float* b_re = kin(A, I_S5_BRE) + (size_t)(l * 16 + g) * 1024; const float* b_im = kin(A, I_S5_BIM) + (size_t)(l * 16 + g) * 1024;
    const float* c_re = kin(A, I_S5_CRE) + (size_t)(l * 16 + g) * 1024; const float* c_im = kin(A, I_S5_CIM) + (size_t)(l * 16 + g) * 1024;
    const float dt = expf(kin(A, I_S5_LOGDT)[l * 16 + g]);
    for (int o = tid; o < 65 * 64; o += NTHREADS) { const int n = o >> 6, p = o & 63; const float mag = expf(a_re[p] * dt * (float)n); float sn, cs; sincosf(a_im[p] * dt * (float)n, &sn, &cs);
        Pw[o * 2] = mag * cs; Pw[o * 2 + 1] = mag * sn; }
    for (int o = tid; o < 1024; o += NTHREADS) { const int p = o >> 4;
        const float are = a_re[p], aim = a_im[p], mag = expf(are * dt); float sn, cs; sincosf(aim * dt, &sn, &cs); const float abr = mag * cs, abi = mag * sn;
        const float den = are * are + aim * aim, nr = abr - 1.0f, cr = (nr * are + abi * aim) / den, ci = (abi * are - nr * aim) / den;
        const float br = b_re[o], bi = b_im[o]; Bb[o * 2] = cr * br - ci * bi; Bb[o * 2 + 1] = cr * bi + ci * br; }
    for (int o = tid; o < 1024; o += NTHREADS) { Cc[o * 2] = c_re[o]; Cc[o * 2 + 1] = c_im[o]; }
    __syncthreads();
    for (int o = tid; o < 16384; o += NTHREADS) { const int tau = o >> 8, c = (o >> 4) & 15, cp = o & 15; float acc = 0.f;
        for (int p = 0; p < 64; ++p) { const float cr = Cc[(c * 64 + p) * 2], ci = Cc[(c * 64 + p) * 2 + 1], pr = Pw[(tau * 64 + p) * 2], pi = Pw[(tau * 64 + p) * 2 + 1];
            const float er = cr * pr - ci * pi, ei = cr * pi + ci * pr; acc += er * Bb[(p * 16 + cp) * 2] - ei * Bb[(p * 16 + cp) * 2 + 1]; }
        Kt[o] = acc; }
    __syncthreads();
    bf16* Bt = (bf16*)(F.ws + WS_S5BT) + (size_t)(l * 16 + g) * 1024 * S5K;
    for (int o = tid; o < 1024 * 128; o += NTHREADS) { const int rr = o >> 7, q = o & 127, t = rr >> 4, c = rr & 15, s = q >> 1, cp0 = (q & 1) * 8;
        v4u w = {0u, 0u, 0u, 0u};
        if (s <= t) { const LAS float* k = Kt + ((t - s) * 16 + c) * 16 + cp0; w.x = pk2(k[0], k[1]); w.y = pk2(k[2], k[3]); w.z = pk2(k[4], k[5]); w.w = pk2(k[6], k[7]); }
        *(v4u*)(Bt + (size_t)rr * S5K + q * 8) = w; }
    for (int o = tid; o < 1024 * 16; o += NTHREADS) { const int rr = o >> 4, q = o & 15, t = rr >> 4, c = rr & 15; float vals[8];
#pragma unroll
        for (int j = 0; j < 4; ++j) { const int p = 4 * q + j; const float cr = Cc[(c * 64 + p) * 2], ci = Cc[(c * 64 + p) * 2 + 1], pr = Pw[((t + 1) * 64 + p) * 2], pi = Pw[((t + 1) * 64 + p) * 2 + 1];
            vals[2 * j] = cr * pr - ci * pi; vals[2 * j + 1] = -(cr * pi + ci * pr); }
        v4u w; w.x = pk2(vals[0], vals[1]); w.y = pk2(vals[2], vals[3]); w.z = pk2(vals[4], vals[5]); w.w = pk2(vals[6], vals[7]);
        *(v4u*)(Bt + (size_t)rr * S5K + 1024 + q * 8) = w; }
    bf16* Bc = (bf16*)(F.ws + WS_S5BC) + (size_t)(l * 16 + g) * 256 * 1024;
    for (int o = tid; o < 128 * 128; o += NTHREADS) { const int row = o >> 7, q = o & 127, p = row >> 1, im = row & 1, s = q >> 1, cp0 = (q & 1) * 8;
        const float pr = Pw[((63 - s) * 64 + p) * 2], pi = Pw[((63 - s) * 64 + p) * 2 + 1]; float vals[8];
#pragma unroll
        for (int j = 0; j < 8; ++j) { const float br = Bb[(p * 16 + cp0 + j) * 2], bi = Bb[(p * 16 + cp0 + j) * 2 + 1]; vals[j] = im ? (pr * bi + pi * br) : (pr * br - pi * bi); }
        v4u w; w.x = pk2(vals[0], vals[1]); w.y = pk2(vals[2], vals[3]); w.z = pk2(vals[4], vals[5]); w.w = pk2(vals[6], vals[7]);
        *(v4u*)(Bc + (size_t)row * 1024 + q * 8) = w;
        *(v4u*)(Bc + (size_t)(128 + row) * 1024 + q * 8) = (v4u){0u, 0u, 0u, 0u}; }
    __syncthreads();
}
__device__ __forceinline__ void p_prologue(KArgs& A, const Frame& F) {
    const int gw = F.bid * NWAVES + F.wave, NGW = F.G * NWAVES, lane = F.lane;
    for (int item = F.bid; item < NL * 16; item += F.G) s5_setup_item(A, F, item);
    LAS float* scr = (LAS float*)(F.lds + F.wave * 16384);
#pragma unroll 1
    for (int d = 0; d < 10; ++d) {
        const float* src; bf16* dst; int K, N, batch, mode = 0;
        switch (d) {
            case 0: src = kin(A, I_EX_W1); dst = (bf16*)(F.ws + WS_W1T); K = 1024; N = 2048; batch = NL * NE; mode = 1; break;
            case 1: src = kin(A, I_EX_W2); dst = (bf16*)(F.ws + WS_W2T); K = 1024; N = 1024; batch = NL * NE; break;
            case 2: src = kin(A, I_W_IN); dst = (bf16*)(F.ws + WS_WINT); K = 1024; N = N_IN; batch = NL; break;
            case 3: src = kin(A, I_BR_PROJ); dst = (bf16*)(F.ws + WS_BRT); K = 256; N = 1024; batch = NL * 4; break;
            case 4: src = kin(A, I_W_OUT); dst = (bf16*)(F.ws + WS_WOUTT); K = 1024; N = 1024; batch = NL; break;
            case 5: src = kin(A, I_XA_WQ); dst = (bf16*)(F.ws + WS_WQT); K = 1024; N = 1024; batch = NL; break;
            case 6: src = kin(A, I_XA_WK); dst = (bf16*)(F.ws + WS_WKT); K = 1024; N = 1024; batch = NL; break;
            case 7: src = kin(A, I_XA_WV); dst = (bf16*)(F.ws + WS_WVT); K = 1024; N = 1024; batch = NL; break;
            case 8: src = kin(A, I_XA_WO); dst = (bf16*)(F.ws + WS_WOT); K = 1024; N = 1024; batch = NL; break;
            default: src = kin(A, I_S5_GLUW); dst = (bf16*)(F.ws + WS_GLUT); K = 256; N = 256; batch = NL; break;
        }
        const int per = (K / 64) * (N / 32), nitems = per * batch;
        for (int it = gw; it < nitems; it += NGW) { const int b = it / per, r = it - b * per;
            transpose_item(src + (size_t)b * K * N, K, N, dst + (size_t)b * K * N, mode, scr, r, lane); }
    }
    { bf16* lwt = (bf16*)(F.ws + WS_LWT);
      for (int it = gw * 64 + lane; it < NL * 768 * 32; it += NGW * 64) { const int kc = it & 31, row = (it >> 5) % 768, ll = it / (768 * 32), blk = row >> 8, c = row & 255, k0 = kc * 8; float v[8];
#pragma unroll
          for (int j = 0; j < 8; ++j) { const int k = k0 + j; float x = 0.f;
              if (blk == 0 && k < 64) x = kin(A, I_RW_WUP)[((size_t)ll * 64 + k) * 256 + c];
              else if (blk == 1 && k >= 64 && k < 128) x = kin(A, I_RW_AUP)[((size_t)ll * 64 + (k - 64)) * 256 + c];
              else if (blk == 2 && k >= 128) x = kin(A, I_RW_GUP)[((size_t)ll * 128 + (k - 128)) * 256 + c];
              v[j] = x; }
          v4u w; w.x = pk2(v[0], v[1]); w.y = pk2(v[2], v[3]); w.z = pk2(v[4], v[5]); w.w = pk2(v[6], v[7]);
          *(v4u*)(lwt + ((size_t)ll * 768 + row) * 256 + k0) = w; } }
    { const float* mem = kin(A, I_MEM); bf16* m16 = (bf16*)(F.ws + WS_MEM16);
      for (int r = gw; r < NB * NMEM; r += NGW) {
#pragma unroll
          for (int j = 0; j < 4; ++j) { const f32x4 v = *(const f32x4*)(mem + (size_t)r * D + 256 * j + 4 * lane); v2u w; w.x = pk2(v.x, v.y); w.y = pk2(v.z, v.w); *(v2u*)(m16 + (size_t)r * D + 256 * j + 4 * lane) = w; } } }
    { const float* x = kin(A, I_X); float* h32 = nullptr; bf16* h16 = (bf16*)(F.ws + WS_H16);
      for (int r = gw; r < T; r += NGW) { f32x4 v[4];
#pragma unroll
          for (int j = 0; j < 4; ++j) v[j] = *(const f32x4*)(x + (size_t)r * D + 256 * j + 4 * lane);
          float mean, rstd; ln_stats(v, mean, rstd);
          ln_apply_store(v, mean, rstd, kin(A, I_LN_IN_G), kin(A, I_LN_IN_B), h32, h16 + (size_t)r * D, lane); } }
}

typedef f32x4 AccT[2][2][4][2];
#define EPI_BASES KArgs& KA = *kargs(); unsigned char* ws = kws(KA); (void)ws;
__device__ __forceinline__ v4u pk8(const f32x4 a, const f32x4 b) { v4u w; w.x = pk2(a.x, a.y); w.y = pk2(a.z, a.w); w.z = pk2(b.x, b.y); w.w = pk2(b.z, b.w); return w; }
__device__ __forceinline__ void unpk8(const v4u w, f32x4& a, f32x4& b) { a.x = bf2f(w.x & 0xffffu); a.y = bf2f(w.x >> 16); a.z = bf2f(w.y & 0xffffu); a.w = bf2f(w.y >> 16); b.x = bf2f(w.z & 0xffffu); b.y = bf2f(w.z >> 16); b.z = bf2f(w.w & 0xffffu); b.w = bf2f(w.w >> 16); }
__device__ __forceinline__ f32x4 ld4bf(const bf16* p) { const v2u w = *(const v2u*)p; f32x4 a; a.x = bf2f(w.x & 0xffffu); a.y = bf2f(w.x >> 16); a.z = bf2f(w.y & 0xffffu); a.w = bf2f(w.y >> 16); return a; }
__device__ __forceinline__ f32x4 sig4(const f32x4 v) { return (f32x4){sigmoidf_(v.x), sigmoidf_(v.y), sigmoidf_(v.z), sigmoidf_(v.w)}; }
struct EpiNull { static constexpr bool PERM = false; int dummy;
    __device__ __forceinline__ void operator()(const AccT& acc, const Unit& u, int wr, int wc, int fr, int fq) const { f32x4 t = {0, 0, 0, 0};
#pragma unroll
        for (int a = 0; a < 2; ++a)
#pragma unroll
            for (int b = 0; b < 2; ++b)
#pragma unroll
                for (int m = 0; m < 4; ++m) { t += acc[a][b][m][0]; t += acc[a][b][m][1]; }
        if (t.x + t.y + t.z + t.w == 1234.5f) { EPI_BASES *(f32x4*)(ws + WS_END) = t; } } };
struct EpiIn { static constexpr bool PERM = true; int l;
    __device__ __forceinline__ void operator()(const AccT& acc, const Unit& u, int wr, int wc, int fr, int fq) const { EPI_BASES
        bf16* Z = (bf16*)(ws + WS_Z); bf16* SG = (bf16*)(ws + WS_SG); bf16* AOUT = (bf16*)(ws + WS_AOUT); const float* gate_b = kin(KA, I_GATE_B) + (size_t)l * 4096;
        if (u.pn < 10) {
            pg8::epi_foreach8(acc, u, wr, wc, fr, fq, [&](int row, int col, f32x4 v0, f32x4 v1) { const v4u w = pk8(v0, v1);
                *(v4u*)(Z + (size_t)row * ZLD + col) = w;
                if (u.pn == 9) { const int cc = col - OFF_D, g = cc >> 4, c0 = cc & 15, chunk = row >> 6, s = row & 63; *(v4u*)(AOUT + ((size_t)(g * NCHT + chunk)) * S5K + s * 16 + c0) = w; } });
        } else {
            pg8::epi_foreach8(acc, u, wr, wc, fr, fq, [&](int row, int col, f32x4 v0, f32x4 v1) {
                const int gc = col - OFF_G; const f32x4 g0 = *(const f32x4*)(gate_b + gc), g1 = *(const f32x4*)(gate_b + gc + 4);
                *(v4u*)(SG + (size_t)row * 4096 + gc) = pk8(sig4(v0 + g0), sig4(v1 + g1)); });
        }
    } };
struct EpiBranch { static constexpr bool PERM = true; int dummy;
    __device__ __forceinline__ void operator()(const AccT& acc, const Unit& u, int wr, int wc, int fr, int fq) const { EPI_BASES const int br = u.e;
        bf16* MG = (bf16*)(ws + WS_MG16); const bf16* SG = (const bf16*)(ws + WS_SG);
        pg8::epi_foreach8(acc, u, wr, wc, fr, fq, [&](int row, int col, f32x4 v0, f32x4 v1) {
            f32x4 s0, s1; unpk8(*(const v4u*)(SG + (size_t)row * 4096 + br * 1024 + col), s0, s1);
            f32x4 r0 = v0 * s0, r1 = v1 * s1; bf16* p = MG + (size_t)row * D + col;
            if (br > 0) { f32x4 m0, m1; unpk8(*(const v4u*)p, m0, m1); r0 += m0; r1 += m1; }
            *(v4u*)p = pk8(r0, r1); });
    } };
struct EpiResid { static constexpr bool PERM = true; int dummy;
    __device__ __forceinline__ void operator()(const AccT& acc, const Unit& u, int wr, int wc, int fr, int fq) const { EPI_BASES
        const bf16* H = (const bf16*)(ws + WS_H16); bf16* P = (bf16*)(ws + WS_PRE16);
        pg8::epi_foreach8(acc, u, wr, wc, fr, fq, [&](int row, int col, f32x4 v0, f32x4 v1) { f32x4 h0, h1; unpk8(*(const v4u*)(H + (size_t)row * D + col), h0, h1);
            *(v4u*)(P + (size_t)row * D + col) = pk8(h0 * DN_ALPHA + v0, h1 * DN_ALPHA + v1); });
    } };
struct EpiBf16 { static constexpr bool PERM = true; unsigned off_mib; float scale;
    __device__ __forceinline__ void operator()(const AccT& acc, const Unit& u, int wr, int wc, int fr, int fq) const { EPI_BASES
        bf16* O = (bf16*)(ws + (size_t)off_mib * MiB);
        pg8::epi_foreach8(acc, u, wr, wc, fr, fq, [&](int row, int col, f32x4 v0, f32x4 v1) { *(v4u*)(O + (size_t)row * D + col) = pk8(v0 * scale, v1 * scale); });
    } };
struct EpiVT { static constexpr bool PERM = false; int dummy;
    __device__ __forceinline__ void operator()(const AccT& acc, const Unit& u, int wr, int wc, int fr, int fq) const { EPI_BASES
        bf16* VT = (bf16*)(ws + WS_VMT16);
        pg8::epi_foreach(acc, u, wr, wc, fr, fq, [&](int row, int col, f32x4 v) { const int b = row >> 8, m = row & 255; bf16* p = VT + ((size_t)(b * D + col)) * NMEM + m;
            p[0] = (bf16)f2bf(v.x); p[NMEM] = (bf16)f2bf(v.y); p[2 * NMEM] = (bf16)f2bf(v.z); p[3 * NMEM] = (bf16)f2bf(v.w); });
    } };
struct EpiXloc { static constexpr bool PERM = false; int dummy;
    __device__ __forceinline__ void operator()(const AccT& acc, const Unit& u, int wr, int wc, int fr, int fq) const { EPI_BASES
        float* X = (float*)(ws + WS_XLOC);
        pg8::epi_foreach(acc, u, wr, wc, fr, fq, [&](int row, int col, f32x4 v) { if (col < 128) *(f32x4*)(X + ((size_t)(u.e * NCHT + row)) * 128 + col) = v; });
    } };
struct EpiLora { static constexpr bool PERM = false; int l;
    __device__ __forceinline__ void operator()(const AccT& acc, const Unit& u, int wr, int wc, int fr, int fq) const { EPI_BASES
        if (u.pn == 0) { float* DEC = (float*)(ws + WS_DEC); const float* w0 = kin(KA, I_RW_W0) + l * 256;
            pg8::epi_foreach(acc, u, wr, wc, fr, fq, [&](int row, int col, f32x4 v) { const f32x4 wp = v + *(const f32x4*)(w0 + col); f32x4 o;
#pragma unroll
                for (int e = 0; e < 4; ++e) { const float sp = log1pf(__expf(-wp[e])); o[e] = __expf(-__expf(-sp - 0.5f)); }
                *(f32x4*)(DEC + (size_t)row * 256 + col) = o; });
        } else if (u.pn == 1) { float* AV = (float*)(ws + WS_AV); const float* a0 = kin(KA, I_RW_A0) + l * 256;
            pg8::epi_foreach(acc, u, wr, wc, fr, fq, [&](int row, int col, f32x4 v) { const int c = col - 256; *(f32x4*)(AV + (size_t)row * 256 + c) = sig4(v + *(const f32x4*)(a0 + c)); });
        } else { float* G = (float*)(ws + WS_RWG);
            pg8::epi_foreach(acc, u, wr, wc, fr, fq, [&](int row, int col, f32x4 v) { *(f32x4*)(G + (size_t)row * 256 + col - 512) = v; });
        }
    } };
__device__ __forceinline__ float gelu_tanh(float x) { const float u = 0.7978845608028654f * (x + 0.044715f * x * x * x); const float e = __expf(2.0f * u); const float th = 1.0f - 2.0f * __builtin_amdgcn_rcpf(e + 1.0f); return 0.5f * x * (1.0f + th); }
__device__ __forceinline__ f32x4 gelu4(const f32x4 v) { return (f32x4){gelu_tanh(v.x), gelu_tanh(v.y), gelu_tanh(v.z), gelu_tanh(v.w)}; }
struct EpiS5Y { static constexpr bool PERM = true; int l;
    __device__ __forceinline__ void operator()(const AccT& acc, const Unit& u, int wr, int wc, int fr, int fq) const { EPI_BASES
        bf16* YD = (bf16*)(ws + WS_YD16); const bf16* AOUT = (const bf16*)(ws + WS_AOUT); const float* dvec = kin(KA, I_S5_D) + l * 256;
        pg8::epi_foreach8(acc, u, wr, wc, fr, fq, [&](int row, int col, f32x4 v0, f32x4 v1) { const int t = col >> 4, c0 = col & 15, tok = row * CH + t, ch = u.e * 16 + c0;
            f32x4 u0, u1; unpk8(*(const v4u*)(AOUT + ((size_t)(u.e * NCHT + row)) * S5K + t * 16 + c0), u0, u1);
            const f32x4 d0 = *(const f32x4*)(dvec + ch), d1 = *(const f32x4*)(dvec + ch + 4);
            *(v4u*)(YD + (size_t)tok * 256 + ch) = pk8(gelu4(v0 + d0 * u0), gelu4(v1 + d1 * u1)); });
    } };
struct EpiGlu { static constexpr bool PERM = true; int l;
    __device__ __forceinline__ void operator()(const AccT& acc, const Unit& u, int wr, int wc, int fr, int fq) const { EPI_BASES
        bf16* O = (bf16*)(ws + WS_O16); const bf16* YD = (const bf16*)(ws + WS_YD16); const float* gb = kin(KA, I_S5_GLUB) + l * 256;
        pg8::epi_foreach8(acc, u, wr, wc, fr, fq, [&](int row, int col, f32x4 v0, f32x4 v1) { f32x4 y0, y1; unpk8(*(const v4u*)(YD + (size_t)row * 256 + col), y0, y1);
            const f32x4 b0 = *(const f32x4*)(gb + col), b1 = *(const f32x4*)(gb + col + 4);
            *(v4u*)(O + (size_t)row * D + 768 + col) = pk8(y0 * sig4(v0 + b0), y1 * sig4(v1 + b1)); });
    } };
__device__ __forceinline__ float swiglu(float g, float u) { g = fminf(g, 7.0f); u = fminf(fmaxf(u, -7.0f), 7.0f); return (u + 1.0f) * g * sigmoidf_(1.702f * g); }
struct EpiSwiglu { static constexpr bool PERM = true; int l;
    __device__ __forceinline__ void operator()(const AccT& acc, const Unit& u, int wr, int wc, int fr, int fq) const { EPI_BASES
        bf16* ACT = (bf16*)(ws + WS_ACT); const float* bb = kin(KA, I_EX_B1) + (size_t)(l * NE + u.e) * 2048;
#pragma unroll
        for (int ai = 0; ai < 2; ++ai)
#pragma unroll
            for (int m = 0; m < 4; ++m) { const int row = u.pm * 256 + ai * 128 + wr * 64 + m * 16 + fr; const int j = u.pn * 128 + wc * 32 + 8 * fq;
                f32x4 o[2];
#pragma unroll
                for (int n = 0; n < 2; ++n) { const f32x4 b0 = *(const f32x4*)(bb + 2 * (j + 4 * n)), b1v = *(const f32x4*)(bb + 2 * (j + 4 * n) + 4);
                    const f32x4 g = acc[ai][0][m][n], uu = acc[ai][1][m][n];
                    o[n] = (f32x4){swiglu(g.x + b0.x, uu.x + b0.y), swiglu(g.y + b0.z, uu.y + b0.w), swiglu(g.z + b1v.x, uu.z + b1v.y), swiglu(g.w + b1v.z, uu.w + b1v.w)}; }
                *(v4u*)(ACT + (size_t)row * DFF + j) = pk8(o[0], o[1]);
                if (m == 3) __builtin_amdgcn_sched_barrier(0); }
    } };
struct EpiMoeOut { static constexpr bool PERM = true; int l;
    __device__ __forceinline__ void operator()(const AccT& acc, const Unit& u, int wr, int wc, int fr, int fq) const { EPI_BASES
        bf16* YS = (bf16*)(ws + WS_YS); const float* SLOTW = (const float*)(ws + WS_SLOTW); const float* bb = kin(KA, I_EX_B2) + (size_t)(l * NE + u.e) * D;
        pg8::epi_foreach8(acc, u, wr, wc, fr, fq, [&](int row, int col, f32x4 v0, f32x4 v1) { const float sw = SLOTW[row]; const f32x4 b0 = *(const f32x4*)(bb + col), b1 = *(const f32x4*)(bb + col + 4);
            *(v4u*)(YS + (size_t)row * D + col) = pk8((v0 + b0) * sw, (v1 + b1) * sw); });
    } };

__device__ __forceinline__ void p_mix1(KArgs& A, const Frame& F, int l) {
    const int gw = F.bid * NWAVES + F.wave, NGW = F.G * NWAVES, lane = F.lane, tid = F.tid;
    const bf16* Z = (const bf16*)(F.ws + WS_Z); bf16* O16 = (bf16*)(F.ws + WS_O16);
    for (int rp_ = 0; rp_ < ((PROBE_PHASE == 101) ? PROBE_REPS : 1); ++rp_) { const float* cw = kin(A, I_CONV_W) + l * 3 * 256; const f32x4 w0 = *(const f32x4*)(cw + 4 * lane), w1 = *(const f32x4*)(cw + 256 + 4 * lane), w2 = *(const f32x4*)(cw + 512 + 4 * lane);
      for (int t = gw; t < T; t += NGW) { const int s = t & (SEQ - 1); const bf16* zr = Z + (size_t)t * ZLD + 4 * lane;
          const f32x4 bg = ld4bf(zr); f32x4 y = w2 * (ld4bf(zr + 256) * ld4bf(zr + 512));
          if (s >= 1) y += w1 * (ld4bf(zr - ZLD + 256) * ld4bf(zr - ZLD + 512));
          if (s >= 2) y += w0 * (ld4bf(zr - 2 * ZLD + 256) * ld4bf(zr - 2 * ZLD + 512));
          y = y * bg; v2u w; w.x = pk2(y.x, y.y); w.y = pk2(y.z, y.w); *(v2u*)(O16 + (size_t)t * D + 4 * lane) = w; } }
    for (int rp_ = 0; rp_ < ((PROBE_PHASE == 102) ? PROBE_REPS : 1); ++rp_) { LAS float* VN = (LAS float*)F.lds;
      const float* ng = kin(A, I_SG_NG) + l * 256; const float* nb = kin(A, I_SG_NB) + l * 256;
      for (int blk = F.bid; blk < T / 128; blk += F.G) {
          const f32x4 gg = *(const f32x4*)(ng + 4 * lane), bb = *(const f32x4*)(nb + 4 * lane);
          for (int r = F.wave; r < 128; r += NWAVES) { const int t = blk * 128 + r; const f32x4 v = ld4bf(Z + (size_t)t * ZLD + OFF_B + 256 + 4 * lane);
              const float mean = wave_sum((v.x + v.y) + (v.z + v.w)) * (1.f / 256); const f32x4 d = v - mean;
              const float var = wave_sum((d.x * d.x + d.y * d.y) + (d.z * d.z + d.w * d.w)) * (1.f / 256); const float rstd = 1.0f / sqrtf(var + LN_EPS);
              *(LAS f32x4*)(VN + r * 256 + 4 * lane) = d * rstd * gg + bb; }
          __syncthreads();
          const int i = tid >> 2, cq = tid & 3, t = blk * 128 + i, jmax = (i < 64) ? 64 : 128;
#pragma unroll 1
          for (int g = 0; g < 4; ++g) { f32x4 a0 = {0, 0, 0, 0}, a1 = a0, a2 = a0, a3 = a0;
              const float* wrow = kin(A, I_SG_W) + ((size_t)((l * 4 + g) * 128 + i)) * 128; const LAS float* vb = VN + g * 64 + cq * 16;
              for (int j = 0; j < jmax; j += 4) { const f32x4 w4 = *(const f32x4*)(wrow + j);
#pragma unroll
                  for (int jj = 0; jj < 4; ++jj) { const LAS f32x4* vp = (const LAS f32x4*)(vb + (j + jj) * 256); const float w = w4[jj];
                      a0 += vp[0] * w; a1 += vp[1] * w; a2 += vp[2] * w; a3 += vp[3] * w; } }
              const float bias = kin(A, I_SG_B)[(l * 4 + g) * 128 + i]; const bf16* up = Z + (size_t)t * ZLD + OFF_B + g * 64 + cq * 16;
              const f32x4 o0 = ld4bf(up) * (a0 + bias), o1 = ld4bf(up + 4) * (a1 + bias), o2 = ld4bf(up + 8) * (a2 + bias), o3 = ld4bf(up + 12) * (a3 + bias);
              v4u wa, wb; wa.x = pk2(o0.x, o0.y); wa.y = pk2(o0.z, o0.w); wa.z = pk2(o1.x, o1.y); wa.w = pk2(o1.z, o1.w); wb.x = pk2(o2.x, o2.y); wb.y = pk2(o2.z, o2.w); wb.z = pk2(o3.x, o3.y); wb.w = pk2(o3.z, o3.w);
              bf16* op = O16 + (size_t)t * D + 256 + g * 64 + cq * 16; *(v4u*)op = wa; *(v4u*)(op + 8) = wb; }
          __syncthreads();
      } }
    for (int rp_ = 0; rp_ < ((PROBE_PHASE == 103) ? PROBE_REPS : 1); ++rp_) {
      bf16* LA = (bf16*)(F.ws + WS_LA16); const f32x4 mul = *(const f32x4*)(kin(A, I_RW_MU) + l * 1024 + 768 + 4 * lane);
      for (int t = gw; t < T; t += NGW) { const int s = t & (SEQ - 1); const bf16* zr = Z + (size_t)t * ZLD + OFF_C + 768 + 4 * lane;
          f32x4 x = ld4bf(zr); f32x4 pv = {0, 0, 0, 0}; if (s > 0) pv = ld4bf(zr - ZLD); x = x + (pv - x) * mul;
          if (lane < 16) x = sig4(x * 2.0f) * 2.0f - 1.0f;
          else if (lane >= 32) x = sig4(x);
          v2u w; w.x = pk2(x.x, x.y); w.y = pk2(x.z, x.w); *(v2u*)(LA + (size_t)t * 256 + 4 * lane) = w; } }
}

__device__ __forceinline__ void p_rw_chunks(KArgs& A, const Frame& F, int l) {
    const int gw = F.bid * NWAVES + F.wave, NGW = F.G * NWAVES, lane = F.lane;
    const bf16* Z = (const bf16*)(F.ws + WS_Z); const float* DEC = (const float*)(F.ws + WS_DEC); const float* AV = (const float*)(F.ws + WS_AV);
    float* QH = (float*)(F.ws + WS_QH); float* YL = (float*)(F.ws + WS_YL); float* GC = (float*)(F.ws + WS_GC); float* HC = (float*)(F.ws + WS_HC); float* RK = (float*)(F.ws + WS_RK);
    LAS float* wl = (LAS float*)(F.lds + F.wave * 16384);
    for (int task = gw; task < 16 * NCH; task += NGW) { const int bh = task / NCH, ck = task % NCH, b = bh >> 2, head = bh & 3, c = head * 64 + lane;
        const float mu_r = kin(A, I_RW_MU)[l * 1024 + c], mu_k = kin(A, I_RW_MU)[l * 1024 + 256 + c], mu_v = kin(A, I_RW_MU)[l * 1024 + 512 + c];
        const float kkc = kin(A, I_RW_KK)[l * 256 + c], kac = kin(A, I_RW_KA)[l * 256 + c], rkc = kin(A, I_RW_RK)[l * 256 + c];
        f32x2 st[64];
        { const int ln = launder_v(lane);
#pragma unroll
          for (int k = 0; k < 64; ++k) st[k] = (f32x2){(k == ln) ? 1.0f : 0.0f, 0.0f}; }
        wl[8 * 320 + lane] = 0.f;
        const int tg0 = b * SEQ + ck * CH;
        float pr = 0.f, pk = 0.f, pv = 0.f, gam = 1.0f;
        if (ck > 0) { const bf16* zp = Z + (size_t)(tg0 - 1) * ZLD + OFF_C + c; pr = bf2f(zp[0]); pk = bf2f(zp[256]); pv = bf2f(zp[512]); }
#pragma unroll 1
        for (int sb = 0; sb < CH / 8; ++sb) {
#pragma unroll 1
            for (int hb = 0; hb < 2; ++hb) {
                float kk[4], dc[4], av[4], rs[4], k2[4], vs[4], ss[4], rkp[4];
#pragma unroll
                for (int i = 0; i < 4; ++i) { const int t = tg0 + sb * 8 + hb * 4 + i; const bf16* zr = Z + (size_t)t * ZLD + OFF_C + c;
                    const float r = bf2f(zr[0]), k = bf2f(zr[256]), v = bf2f(zr[512]); dc[i] = DEC[(size_t)t * 256 + c]; av[i] = AV[(size_t)t * 256 + c];
                    rs[i] = r + (pr - r) * mu_r; const float ks = k + (pk - k) * mu_k; vs[i] = v + (pv - v) * mu_v; pr = r; pk = k; pv = v;
                    kk[i] = ks * kkc; k2[i] = ks * (1.0f + (av[i] - 1.0f) * kac); ss[i] = kk[i] * kk[i]; rkp[i] = rs[i] * k2[i] * rkc; }
#pragma unroll
                for (int o = 1; o < 64; o <<= 1) {
#pragma unroll
                    for (int i = 0; i < 4; ++i) { ss[i] += shfl_xor_l(ss[i], o, lane); rkp[i] += shfl_xor_l(rkp[i], o, lane); } }
#pragma unroll
                for (int i = 0; i < 4; ++i) { const float kn = kk[i] * __builtin_amdgcn_rcpf(fmaxf(sqrtf(ss[i]), 1e-12f)); LAS float* w = wl + (hb * 4 + i) * 320 + lane;
                    const float g1 = gam * dc[i], ig = __builtin_amdgcn_rcpf(g1);
                    w[0] = -kn * gam; w[64] = kn * av[i] * ig; w[128] = rs[i] * g1; w[192] = k2[i] * ig; w[256] = vs[i]; gam = g1;
                    if (lane == 0) RK[(size_t)(tg0 + sb * 8 + hb * 4 + i) * 4 + head] = rkp[i]; }
            }
            LDS_WAIT();
            f32x2 sa = {0.f, 0.f};
            { const LAS f32x4* a0 = (const LAS f32x4*)wl;
#pragma unroll
              for (int q = 0; q < 16; ++q) { const f32x4 an = a0[q];
#pragma unroll
                  for (int e = 0; e < 4; ++e) sa += st[4 * q + e] * (f32x2){an[e], an[e]}; } }
#pragma unroll 1
            for (int st_ = 0; st_ < 8; ++st_) { const LAS f32x4* base = (const LAS f32x4*)(wl + st_ * 320);
                const f32x2 vj2 = {0.f, wl[st_ * 320 + 256 + lane]};
                f32x2 y = {0.f, 0.f}, nx = {0.f, 0.f};
                f32x4 bq = base[16], r = base[32], kv = base[48], an = base[80];
#pragma unroll
                for (int q = 0; q < 16; ++q) { f32x4 bn = bq, rn = r, kn = kv, ann = an;
                    if (q < 15) { bn = base[16 + q + 1]; rn = base[32 + q + 1]; kn = base[48 + q + 1]; ann = base[80 + q + 1]; }
#pragma unroll
                    for (int e = 0; e < 4; ++e) { const int k = 4 * q + e;
                        st[k] += sa * (f32x2){bq[e], bq[e]}; st[k] += vj2 * (f32x2){kv[e], kv[e]};
                        y += st[k] * (f32x2){r[e], r[e]}; nx += st[k] * (f32x2){an[e], an[e]}; }
                    __builtin_amdgcn_sched_barrier(0);
                    bq = bn; r = rn; kv = kn; an = ann; }
                const size_t oi = ((size_t)(bh * SEQ + ck * CH + sb * 8 + st_)) * 64 + lane;
                QH[oi] = y.x; YL[oi] = y.y; sa = nx; }
        }
        wl[lane] = gam; LDS_WAIT();
        float* gp = GC + ((size_t)(bh * NCH + ck) * 64 + lane) * 64; float* hp = HC + ((size_t)(bh * NCH + ck) * 64 + lane) * 64;
#pragma unroll
        for (int q = 0; q < 16; ++q) { const f32x4 gq = *(const LAS f32x4*)(wl + 4 * q);
            *(f32x4*)(gp + 4 * q) = (f32x4){st[4 * q].x * gq.x, st[4 * q + 1].x * gq.y, st[4 * q + 2].x * gq.z, st[4 * q + 3].x * gq.w};
            *(f32x4*)(hp + 4 * q) = (f32x4){st[4 * q].y * gq.x, st[4 * q + 1].y * gq.y, st[4 * q + 2].y * gq.z, st[4 * q + 3].y * gq.w}; }
        LDS_WAIT();
    }
}
__device__ __forceinline__ void p_s5_chain(KArgs& A, const Frame& F, int l) {
    const int gt = F.bid * NTHREADS + F.tid; if (gt >= NB * 16 * 64) return;
    const int b = gt >> 10, g = (gt >> 6) & 15, p = gt & 63;
    const float dt = expf(kin(A, I_S5_LOGDT)[l * 16 + g]); const float are = kin(A, I_S5_ARE)[(l * 16 + g) * 64 + p], aim = kin(A, I_S5_AIM)[(l * 16 + g) * 64 + p];
    const float mag = expf(are * dt * 64.0f); float sn, cs; sincosf(aim * dt * 64.0f, &sn, &cs); const float ar = mag * cs, ai = mag * sn;
    bf16* AO = (bf16*)(F.ws + WS_AOUT); const float* XL = (const float*)(F.ws + WS_XLOC);
    float xr = 0.f, xi = 0.f;
#pragma unroll 8
    for (int c = 0; c < NCH; ++c) { const size_t row = (size_t)g * NCHT + b * NCH + c;
        *(unsigned*)(AO + row * S5K + 1024 + 2 * p) = pk2(xr, xi);
        const f32x2 xl = *(const f32x2*)(XL + row * 128 + 2 * p);
        const float nr = ar * xr - ai * xi + xl.x, ni = ar * xi + ai * xr + xl.y; xr = nr; xi = ni; }
}
constexpr int CB = 8, NBLK = NCH / CB;
__device__ __forceinline__ void chain_load_g(const float* G, float (&ga)[64], int fr, int fq) {
#pragma unroll
    for (int jr = 0; jr < 16; ++jr)
#pragma unroll
        for (int mt = 0; mt < 4; ++mt) ga[jr * 4 + mt] = G[(size_t)((jr >> 2) * 16 + 4 * fq + (jr & 3)) * 64 + 16 * mt + fr];
}
__device__ __forceinline__ void chain_step(f32x4 (&acc)[4], const float (&ga)[64], const f32x4 (&ci)[4]) {
    f32x4 na[4] = {ci[0], ci[1], ci[2], ci[3]};
#pragma unroll
    for (int jr = 0; jr < 16; ++jr)
#pragma unroll
        for (int mt = 0; mt < 4; ++mt) na[mt] = __builtin_amdgcn_mfma_f32_16x16x4f32(ga[jr * 4 + mt], acc[jr >> 2][jr & 3], na[mt], 0, 0, 0);
#pragma unroll
    for (int mt = 0; mt < 4; ++mt) acc[mt] = na[mt];
}
__device__ __forceinline__ void chain_load_tile(const float* M, int rb, f32x4 (&t)[4], int fr, int fq) {
#pragma unroll
    for (int jt = 0; jt < 4; ++jt) t[jt] = *(const f32x4*)(M + (size_t)(16 * rb + fr) * 64 + 16 * jt + 4 * fq);
}
__device__ __forceinline__ void chain_store_tile(float* M, int rb, const f32x4 (&t)[4], int fr, int fq) {
#pragma unroll
    for (int jt = 0; jt < 4; ++jt) *(f32x4*)(M + (size_t)(16 * rb + fr) * 64 + 16 * jt + 4 * fq) = t[jt];
}
__device__ __forceinline__ void p_chain_compose(const Frame& F) {
    const int gw = F.bid * NWAVES + F.wave, NGW = F.G * NWAVES, ln_ = my_lane(), fr = ln_ & 15, fq = ln_ >> 4;
    const float* GC = (const float*)(F.ws + WS_GC); const float* HC = (const float*)(F.ws + WS_HC); float* GB = (float*)(F.ws + WS_GB); float* HB = (float*)(F.ws + WS_HB);
    for (int task = gw; task < 16 * NBLK * 8; task += NGW) { const int cb = task & 7, bb = task >> 3, rb = cb & 3; const bool isH = cb >= 4;
        const size_t c0 = (size_t)bb * CB;
        f32x4 acc[4]; chain_load_tile((isH ? HC : GC) + c0 * 4096, rb, acc, fr, fq);
        float ga[64]; chain_load_g(GC + (c0 + 1) * 4096, ga, fr, fq);
        f32x4 ci[4] = {{0, 0, 0, 0}, {0, 0, 0, 0}, {0, 0, 0, 0}, {0, 0, 0, 0}};
        if (isH) chain_load_tile(HC + (c0 + 1) * 4096, rb, ci, fr, fq);
#pragma unroll 1
        for (int i = 1; i < CB; ++i) { const int nx = (i + 1 < CB) ? i + 1 : i;
            f32x4 cn[4] = {{0, 0, 0, 0}, {0, 0, 0, 0}, {0, 0, 0, 0}, {0, 0, 0, 0}};
            if (isH) chain_load_tile(HC + (c0 + nx) * 4096, rb, cn, fr, fq);
            float gn[64]; chain_load_g(GC + (c0 + nx) * 4096, gn, fr, fq);
            chain_step(acc, ga, ci);
#pragma unroll
            for (int k = 0; k < 64; ++k) ga[k] = gn[k];
#pragma unroll
            for (int k = 0; k < 4; ++k) ci[k] = cn[k]; }
        chain_store_tile((isH ? HB : GB) + (size_t)bb * 4096, rb, acc, fr, fq);
    }
}
__device__ __forceinline__ void p_chain_blocks(const Frame& F, int gw, int NGW) {
    const int ln_ = my_lane(), fr = ln_ & 15, fq = ln_ >> 4;
    const float* GB = (const float*)(F.ws + WS_GB); const float* HB = (const float*)(F.ws + WS_HB); float* SB = (float*)(F.ws + WS_SB);
    for (int task = gw; task < 16 * 4; task += NGW) { const int vb = task & 3, bh = task >> 2;
        f32x4 acc[4] = {{0, 0, 0, 0}, {0, 0, 0, 0}, {0, 0, 0, 0}, {0, 0, 0, 0}};
        float ga[64]; chain_load_g(GB + (size_t)bh * NBLK * 4096, ga, fr, fq);
        f32x4 ci[4]; chain_load_tile(HB + (size_t)bh * NBLK * 4096, vb, ci, fr, fq);
#pragma unroll 1
        for (int blk = 0; blk < NBLK; ++blk) { const size_t bb = (size_t)bh * NBLK + blk;
            chain_store_tile(SB + bb * 4096, vb, acc, fr, fq);
            if (blk + 1 == NBLK) break;
            f32x4 cn[4]; chain_load_tile(HB + (bb + 1) * 4096, vb, cn, fr, fq);
            float gn[64]; chain_load_g(GB + (bb + 1) * 4096, gn, fr, fq);
            chain_step(acc, ga, ci);
#pragma unroll
            for (int k = 0; k < 64; ++k) ga[k] = gn[k];
#pragma unroll
            for (int k = 0; k < 4; ++k) ci[k] = cn[k]; }
    }
}
__device__ __forceinline__ void chain_inblock(const Frame& F, int bb, int vb) {
    const int ln_ = my_lane(), fr = ln_ & 15, fq = ln_ >> 4;
    const float* GC = (const float*)(F.ws + WS_GC); const float* HC = (const float*)(F.ws + WS_HC); const float* SB = (const float*)(F.ws + WS_SB); float* SC = (float*)(F.ws + WS_SC);
    const size_t c0 = (size_t)bb * CB;
    f32x4 acc[4]; chain_load_tile(SB + (size_t)bb * 4096, vb, acc, fr, fq);
    float ga[64]; chain_load_g(GC + c0 * 4096, ga, fr, fq);
    f32x4 ci[4]; chain_load_tile(HC + c0 * 4096, vb, ci, fr, fq);
#pragma unroll 1
    for (int i = 0; i < CB; ++i) {
        chain_store_tile(SC + (c0 + i) * 4096, vb, acc, fr, fq);
        if (i + 1 == CB) break;
        f32x4 cn[4]; chain_load_tile(HC + (c0 + i + 1) * 4096, vb, cn, fr, fq);
        float gn[64]; chain_load_g(GC + (c0 + i + 1) * 4096, gn, fr, fq);
        chain_step(acc, ga, ci);
#pragma unroll
        for (int k = 0; k < 64; ++k) ga[k] = gn[k];
#pragma unroll
        for (int k = 0; k < 4; ++k) ci[k] = cn[k]; }
}
__device__ __forceinline__ void rw_out_task(KArgs& A, const Frame& F, int l, int task) {
    const int lane = F.lane, fr = lane & 15, fq = lane >> 4;
    const bf16* Z = (const bf16*)(F.ws + WS_Z); const float* QH = (const float*)(F.ws + WS_QH); const float* YL = (const float*)(F.ws + WS_YL); const float* SC = (const float*)(F.ws + WS_SC);
    const float* RWG = (const float*)(F.ws + WS_RWG); const float* RK = (const float*)(F.ws + WS_RK); bf16* O16 = (bf16*)(F.ws + WS_O16);
    const int bh = task / NCH, ck = task % NCH, b = bh >> 2, head = bh & 3;
    const size_t ti0 = (size_t)(bh * SEQ + ck * CH); const int t0g = b * SEQ + ck * CH;
    float sa[4][16];
    { const float* sp = SC + (size_t)(bh * NCH + ck) * 4096 + (size_t)fr * 64 + 16 * fq;
#pragma unroll
      for (int vt = 0; vt < 4; ++vt)
#pragma unroll
          for (int q = 0; q < 4; ++q) { const f32x4 x = *(const f32x4*)(sp + vt * 1024 + 4 * q); sa[vt][4 * q] = x.x; sa[vt][4 * q + 1] = x.y; sa[vt][4 * q + 2] = x.z; sa[vt][4 * q + 3] = x.w; } }
    const float* lgp = kin(A, I_RW_LNG) + l * 256 + head * 64 + 4 * fq; const float* lbp = kin(A, I_RW_LNB) + l * 256 + head * 64 + 4 * fq; const float* mup = kin(A, I_RW_MU) + l * 1024 + 512 + head * 64 + 4 * fq;
#pragma unroll 1
    for (int tt = 0; tt < 4; ++tt) { const int t = 16 * tt + fr;
        float qb[16];
        { const float* qp = QH + (ti0 + t) * 64 + 16 * fq;
#pragma unroll
          for (int q = 0; q < 4; ++q) { const f32x4 x = *(const f32x4*)(qp + 4 * q); qb[4 * q] = x.x; qb[4 * q + 1] = x.y; qb[4 * q + 2] = x.z; qb[4 * q + 3] = x.w; } }
        f32x4 y[4];
#pragma unroll
        for (int vt = 0; vt < 4; ++vt) y[vt] = *(const f32x4*)(YL + (ti0 + t) * 64 + 16 * vt + 4 * fq);
#pragma unroll
        for (int s_ = 0; s_ < 16; ++s_)
#pragma unroll
            for (int vt = 0; vt < 4; ++vt) y[vt] = __builtin_amdgcn_mfma_f32_16x16x4f32(sa[vt][s_], qb[s_], y[vt], 0, 0, 0);
        float s1 = 0.f, s2 = 0.f;
#pragma unroll
        for (int vt = 0; vt < 4; ++vt) { s1 += (y[vt].x + y[vt].y) + (y[vt].z + y[vt].w); s2 += (y[vt].x * y[vt].x + y[vt].y * y[vt].y) + (y[vt].z * y[vt].z + y[vt].w * y[vt].w); }
        s1 += shfl_xor_l(s1, 16, lane); s1 += shfl_xor_l(s1, 32, lane); s2 += shfl_xor_l(s2, 16, lane); s2 += shfl_xor_l(s2, 32, lane);
        const float m = s1 * (1.f / 64), var = fmaxf(s2 * (1.f / 64) - m * m, 0.f), rstd = __builtin_amdgcn_rsqf(var + RW_LN_EPS);
        const int tg = t0g + t; const float rk = RK[(size_t)tg * 4 + head]; const bool hasprev = (ck * CH + t) > 0;
        const bf16* zv = Z + (size_t)tg * ZLD + OFF_C + 512 + head * 64 + 4 * fq; const float* gp = RWG + (size_t)tg * 256 + head * 64 + 4 * fq; bf16* op = O16 + (size_t)tg * D + 512 + head * 64 + 4 * fq;
#pragma unroll
        for (int vt = 0; vt < 4; ++vt) { const f32x4 v1 = ld4bf(zv + 16 * vt); f32x4 v0 = {0, 0, 0, 0}; if (hasprev) v0 = ld4bf(zv - ZLD + 16 * vt);
            const f32x4 vv = v1 + (v0 - v1) * *(const f32x4*)(mup + 16 * vt), g4 = *(const f32x4*)(gp + 16 * vt), lg4 = *(const f32x4*)(lgp + 16 * vt), lb4 = *(const f32x4*)(lbp + 16 * vt);
            const f32x4 o = ((y[vt] - m) * rstd * lg4 + lb4 + vv * rk) * g4;
            v2u w; w.x = pk2(o.x, o.y); w.y = pk2(o.z, o.w); *(v2u*)(op + 16 * vt) = w; }
    }
}

template <int LSTRIDE> __device__ __forceinline__ void attn_stage(LAS unsigned char* lds, const bf16* src, size_t row_stride, int tid) {
    const int r0 = tid >> 5, c = tid & 31; const bf16* sp = src + (size_t)r0 * row_stride + c * 8; LAS unsigned char* dp = lds + r0 * LSTRIDE + c * 16;
#pragma unroll 4
    for (int i = 0; i < 16; ++i) { const v4u v = *(const v4u*)(sp + (size_t)(16 * i) * row_stride); *(LAS v4u*)(dp + 16 * i * LSTRIDE) = v; }
}
constexpr int KSTR = 544, VSTR = 528;
__device__ __forceinline__ void p_attn(const Frame& F) {
    const int lane = F.lane, fr = lane & 15, fq = lane >> 4;
    const bf16* Q = (const bf16*)(F.ws + WS_Q16); const bf16* KM = (const bf16*)(F.ws + WS_KM16); const bf16* VT = (const bf16*)(F.ws + WS_VMT16); bf16* AO = (bf16*)(F.ws + WS_AO16);
    for (int item = F.bid; item < NB * 4 * (SEQ / 256); item += F.G) {
        const int qg = item % (SEQ / 256), bhd = item / (SEQ / 256), head = bhd & 3, b = bhd >> 2;
        attn_stage<KSTR>(F.lds, KM + (size_t)(b * NMEM) * D + head * 256, D, F.tid);
        __syncthreads();
        v4u pf[2][8]; float inv[2];
#pragma unroll
        for (int u = 0; u < 2; ++u) { const int q0 = b * SEQ + qg * 256 + u * 128 + F.wave * 16;
            bf16x8 qf[8];
#pragma unroll
            for (int ks = 0; ks < 8; ++ks) qf[ks] = *(const bf16x8*)(Q + (size_t)(q0 + fr) * D + head * 256 + ks * 32 + fq * 8);
            f32x4 sT[16];
            const LAS unsigned char* kbase = F.lds + fr * KSTR + fq * 16;
#pragma unroll
            for (int kt = 0; kt < 16; ++kt) { f32x4 a = {0, 0, 0, 0}; const LAS unsigned char* kp = kbase + kt * 16 * KSTR;
#pragma unroll
                for (int ks = 0; ks < 8; ++ks) { const bf16x8 kf = *(const LAS bf16x8*)(kp + ks * 64); a = __builtin_amdgcn_mfma_f32_16x16x32_bf16(kf, qf[ks], a, 0, 0, 0); }
                sT[kt] = a; if (kt & 1) __builtin_amdgcn_sched_barrier(0); }
            float mx = -3.0e38f;
#pragma unroll
            for (int kt = 0; kt < 16; ++kt) mx = fmaxf(fmaxf(fmaxf(mx, sT[kt].x), fmaxf(sT[kt].y, sT[kt].z)), sT[kt].w);
            mx = fmaxf(mx, shfl_xor_l(mx, 16, lane)); mx = fmaxf(mx, shfl_xor_l(mx, 32, lane));
            float sum = 0.f;
#pragma unroll
            for (int kt = 0; kt < 16; ++kt) { sT[kt].x = __expf(sT[kt].x - mx); sT[kt].y = __expf(sT[kt].y - mx); sT[kt].z = __expf(sT[kt].z - mx); sT[kt].w = __expf(sT[kt].w - mx); sum += (sT[kt].x + sT[kt].y) + (sT[kt].z + sT[kt].w); }
            sum += shfl_xor_l(sum, 16, lane); sum += shfl_xor_l(sum, 32, lane);
            inv[u] = 1.0f / sum;
#pragma unroll
            for (int kp = 0; kp < 8; ++kp) { v4u w; w.x = pk2(sT[2 * kp].x, sT[2 * kp].y); w.y = pk2(sT[2 * kp].z, sT[2 * kp].w); w.z = pk2(sT[2 * kp + 1].x, sT[2 * kp + 1].y); w.w = pk2(sT[2 * kp + 1].z, sT[2 * kp + 1].w); pf[u][kp] = w; }
            __builtin_amdgcn_sched_barrier(0);
        }
        __syncthreads();
        attn_stage<VSTR>(F.lds, VT + (size_t)(b * D + head * 256) * NMEM, NMEM, F.tid);
        __syncthreads();
#pragma unroll
        for (int u = 0; u < 2; ++u) { const int q0 = b * SEQ + qg * 256 + u * 128 + F.wave * 16;
#pragma unroll 2
            for (int dt = 0; dt < 16; ++dt) { f32x4 o = {0, 0, 0, 0}; const LAS unsigned char* vp = F.lds + (dt * 16 + fr) * VSTR + fq * 8;
#pragma unroll
                for (int kp = 0; kp < 8; ++kp) {
                    const v2u lo = *(const LAS v2u*)(vp + 64 * kp), hi = *(const LAS v2u*)(vp + 64 * kp + 32); v4u w; w.x = lo.x; w.y = lo.y; w.z = hi.x; w.w = hi.y;
                    o = __builtin_amdgcn_mfma_f32_16x16x32_bf16(__builtin_bit_cast(bf16x8, w), __builtin_bit_cast(bf16x8, pf[u][kp]), o, 0, 0, 0); }
                v2u w; w.x = pk2(o.x * inv[u], o.y * inv[u]); w.y = pk2(o.z * inv[u], o.w * inv[u]);
                *(v2u*)(AO + (size_t)(q0 + fr) * D + head * 256 + dt * 16 + 4 * fq) = w; __builtin_amdgcn_sched_barrier(0); } }
        __syncthreads();
    }
}

__device__ __forceinline__ void p_ln(const Frame& F, const float* g, const float* b, bool dummy) {
    const int gw = F.bid * NWAVES + F.wave, NGW = F.G * NWAVES, lane = F.lane; const bf16* P = (const bf16*)(F.ws + WS_PRE16); bf16* H16 = (bf16*)(F.ws + (dummy ? WS_Z + 128 * MiB : WS_H16));
    for (int r = gw; r < T; r += NGW) { f32x4 v[4];
#pragma unroll
        for (int j = 0; j < 4; ++j) v[j] = ld4bf(P + (size_t)r * D + 256 * j + 4 * lane);
        float mean, rstd; ln_stats(v, mean, rstd); ln_apply_store(v, mean, rstd, g, b, (float*)nullptr, H16 + (size_t)r * D, lane); }
}
__device__ __forceinline__ void p_ln_router(KArgs& A, const Frame& F, int l, bool dummy) {
    const int gw = F.bid * NWAVES + F.wave, NGW = F.G * NWAVES, lane = F.lane, tid = F.tid, fr = lane & 15, fq = lane >> 4;
    const bf16* H = (const bf16*)(F.ws + WS_PRE16); bf16* H16 = (bf16*)(F.ws + (dummy ? WS_Z + 128 * MiB : WS_H16)); int* TOKE = (int*)(F.ws + (dummy ? WS_Z + 200 * MiB : WS_TOKE)); float* TOKW = (float*)(F.ws + (dummy ? WS_Z + 201 * MiB : WS_TOKW));
    LAS v4u* TB = (LAS v4u*)F.lds;
    LAS float* PS = (LAS float*)(F.lds + 131072);
    volatile LAS unsigned* hist = F.MISC + MI_HIST;
    const float* rw = kin(A, I_ROUTER_W) + (size_t)l * D * NE; const float* rb = kin(A, I_ROUTER_B) + l * NE; const float* g = kin(A, I_LN2_G) + l * D; const float* bb = kin(A, I_LN2_B) + l * D;
    for (int en = tid; en < 32 * 2 * 64; en += NTHREADS) { const int ln = en & 63, et = (en >> 6) & 1, ks = en >> 7, efr = ln & 15, efq = ln >> 4; float hi[8], lo[8];
#pragma unroll
        for (int j = 0; j < 8; ++j) { const int d = 32 * ks + 8 * efq + j; const float v = g[d] * rw[d * NE + et * 16 + efr]; const float h = bf2f(f2bf(v)); hi[j] = h; lo[j] = v - h; }
        v4u wh, wl; wh.x = pk2(hi[0], hi[1]); wh.y = pk2(hi[2], hi[3]); wh.z = pk2(hi[4], hi[5]); wh.w = pk2(hi[6], hi[7]); wl.x = pk2(lo[0], lo[1]); wl.y = pk2(lo[2], lo[3]); wl.z = pk2(lo[4], lo[5]); wl.w = pk2(lo[6], lo[7]);
        TB[((ks * 2 + et) * 2 + 0) * 64 + ln] = wh; TB[((ks * 2 + et) * 2 + 1) * 64 + ln] = wl; }
    { const int e = tid & 31, part = tid >> 5; float sg = 0.f, sb = 0.f;
      for (int d = part * 64; d < part * 64 + 64; ++d) { const float w = rw[d * NE + e]; sg += g[d] * w; sb += bb[d] * w; }
      PS[part * 32 + e] = sg; PS[512 + part * 32 + e] = sb; }
    if (tid < NE) hist[tid] = 0u;
    __syncthreads();
    if (tid < NE) { float sg = 0.f, sb = 0.f;
#pragma unroll
        for (int p = 0; p < 16; ++p) { sg += PS[p * 32 + tid]; sb += PS[512 + p * 32 + tid]; }
        PS[1024 + tid] = sg; PS[1056 + tid] = sb + rb[tid]; }
    __syncthreads();
    const float cg0 = PS[1024 + fr], cg1 = PS[1024 + 16 + fr], cb0 = PS[1056 + fr], cb1 = PS[1056 + 16 + fr];
    for (int grp = gw; grp < T / 16; grp += NGW) { const int r0 = grp * 16; const bf16* xrow = H + (size_t)(r0 + fr) * D + 8 * fq;
        f32x4 acc0 = {0, 0, 0, 0}, acc1 = {0, 0, 0, 0}; float sum = 0.f, sq = 0.f;
#pragma unroll 2
        for (int ks = 0; ks < 32; ++ks) { const v4u xw = *(const v4u*)(xrow + 32 * ks); f32x4 xa, xb; unpk8(xw, xa, xb);
            sum += (xa.x + xa.y) + (xa.z + xa.w) + (xb.x + xb.y) + (xb.z + xb.w);
            sq += (xa.x * xa.x + xa.y * xa.y) + (xa.z * xa.z + xa.w * xa.w) + (xb.x * xb.x + xb.y * xb.y) + (xb.z * xb.z + xb.w * xb.w);
            const LAS v4u* tb = TB + (ks * 4) * 64 + lane; const v4u b0h = tb[0], b0l = tb[64], b1h = tb[128], b1l = tb[192];
            const bf16x8 Ah = __builtin_bit_cast(bf16x8, xw);
            acc0 = __builtin_amdgcn_mfma_f32_16x16x32_bf16(Ah, __builtin_bit_cast(bf16x8, b0h), acc0, 0, 0, 0); acc0 = __builtin_amdgcn_mfma_f32_16x16x32_bf16(Ah, __builtin_bit_cast(bf16x8, b0l), acc0, 0, 0, 0);
            acc1 = __builtin_amdgcn_mfma_f32_16x16x32_bf16(Ah, __builtin_bit_cast(bf16x8, b1h), acc1, 0, 0, 0); acc1 = __builtin_amdgcn_mfma_f32_16x16x32_bf16(Ah, __builtin_bit_cast(bf16x8, b1l), acc1, 0, 0, 0); }
        sum += shfl_xor_l(sum, 16, lane); sum += shfl_xor_l(sum, 32, lane); sq += shfl_xor_l(sq, 16, lane); sq += shfl_xor_l(sq, 32, lane);
        const float mean = sum * (1.f / D), rstd = 1.0f / sqrtf(fmaxf(sq * (1.f / D) - mean * mean, 0.f) + LN_EPS);
        float v0[4], v1[4];
#pragma unroll
        for (int reg = 0; reg < 4; ++reg) { const float rs = __builtin_bit_cast(float, shfl_idx_l(__builtin_bit_cast(int, rstd), 4 * fq + reg)), mn = __builtin_bit_cast(float, shfl_idx_l(__builtin_bit_cast(int, mean), 4 * fq + reg));
            v0[reg] = rs * acc0[reg] - rs * mn * cg0 + cb0; v1[reg] = rs * acc1[reg] - rs * mn * cg1 + cb1; }
        float wv[4][4]; int wi[4][4];
#pragma unroll
        for (int k = 0; k < 4; ++k) {
#pragma unroll
            for (int reg = 0; reg < 4; ++reg) { float bv = v0[reg]; int bi = fr; if (v1[reg] > bv) { bv = v1[reg]; bi = 16 + fr; }
#pragma unroll
                for (int o = 1; o < 16; o <<= 1) { const float ov = shfl_xor_l(bv, o, lane); const int oi = shfl_idx_l(bi, lane ^ o); if (ov > bv || (ov == bv && oi < bi)) { bv = ov; bi = oi; } }
                wv[k][reg] = bv; wi[k][reg] = bi; if (bi == fr) v0[reg] = -3.0e38f; if (bi == 16 + fr) v1[reg] = -3.0e38f; } }
        if (fr == 0) {
#pragma unroll
            for (int reg = 0; reg < 4; ++reg) { const int t = r0 + 4 * fq + reg; const float e1 = __expf(wv[1][reg] - wv[0][reg]), e2 = __expf(wv[2][reg] - wv[0][reg]), e3 = __expf(wv[3][reg] - wv[0][reg]), inv = 1.0f / (1.0f + e1 + e2 + e3);
                *(int4*)(TOKE + (size_t)t * 4) = make_int4(wi[0][reg], wi[1][reg], wi[2][reg], wi[3][reg]); *(f32x4*)(TOKW + (size_t)t * 4) = (f32x4){inv, e1 * inv, e2 * inv, e3 * inv};
#pragma unroll
                for (int k = 0; k < 4; ++k) __hip_atomic_fetch_add((LAS unsigned*)&hist[wi[k][reg]], 1u, __ATOMIC_RELAXED, __HIP_MEMORY_SCOPE_WORKGROUP); } }
        bf16* o16 = H16 + (size_t)(r0 + fr) * D + 8 * fq;
#pragma unroll 2
        for (int ks = 0; ks < 32; ++ks) { f32x4 xa, xb; unpk8(*(const v4u*)(xrow + 32 * ks), xa, xb);
            const f32x4 ga = *(const f32x4*)(g + 32 * ks + 8 * fq), gb = *(const f32x4*)(g + 32 * ks + 8 * fq + 4), ba = *(const f32x4*)(bb + 32 * ks + 8 * fq), bc = *(const f32x4*)(bb + 32 * ks + 8 * fq + 4);
            *(v4u*)(o16 + 32 * ks) = pk8((xa - mean) * rstd * ga + ba, (xb - mean) * rstd * gb + bc); }
    }
    __syncthreads();
    if (tid < NE && !dummy) { const unsigned c = hist[tid]; if (c) atomicAdd(F.ctl + CW_CNT + l * NE + tid, c); F.ctl[CW_WGH + (l * 512 + F.bid) * NE + tid] = c; }
}
__device__ __forceinline__ void moe_offsets(const Frame& F, int l) {
    if (F.tid == 0) { int acc = 0;
        for (int e = 0; e < NE; ++e) { F.MISC[MI_TOFF + e] = (unsigned)acc; const unsigned c = __hip_atomic_load(F.ctl + CW_CNT + l * NE + e, __ATOMIC_RELAXED, __HIP_MEMORY_SCOPE_AGENT); acc += (int)((c + 255u) >> 8); }
        F.MISC[MI_TOFF + NE] = (unsigned)acc; }
    __syncthreads();
}
__device__ __forceinline__ void p_moe_slots(const Frame& F, int l, int dummy) {
    const int gw = F.bid * NWAVES + F.wave, NGW = F.G * NWAVES, lane = F.lane;
    moe_offsets(F, l);
    const int* TOKE = (const int*)(F.ws + WS_TOKE); const float* TOKW = (const float*)(F.ws + WS_TOKW); int* TOKS = (int*)(F.ws + (dummy ? WS_END : WS_TOKS)); float* SLOTW = (float*)(F.ws + (dummy ? WS_END + 1 * MiB : WS_SLOTW));
    const bf16* H16 = (const bf16*)(F.ws + WS_H16); bf16* XG = (bf16*)(F.ws + (dummy ? WS_ACT : WS_XG)); unsigned* CUR = F.ctl + CW_CUR + l * NE + dummy * 256;
    if (F.tid < NE) { const unsigned c = F.ctl[CW_WGH + (l * 512 + F.bid) * NE + F.tid]; const unsigned base = c ? atomicAdd(CUR + F.tid, c) : 0u;
        F.MISC[MI_LBASE + F.tid] = F.MISC[MI_TOFF + F.tid] * 256u + base; F.MISC[MI_LCUR + F.tid] = 0u; }
    __syncthreads();
    for (int grp = gw; grp < T / 16; grp += NGW)
    for (int r = grp * 16; r < grp * 16 + 16; ++r) { int slot = 0;
        if (lane < 4) { const int e = TOKE[(size_t)r * 4 + lane]; const unsigned pos = __hip_atomic_fetch_add((LAS unsigned*)&F.MISC[MI_LCUR + e], 1u, __ATOMIC_RELAXED, __HIP_MEMORY_SCOPE_WORKGROUP); slot = (int)(F.MISC[MI_LBASE + e] + pos);
            TOKS[(size_t)r * 4 + lane] = slot; SLOTW[slot] = TOKW[(size_t)r * 4 + lane]; }
        const v4u a = *(const v4u*)(H16 + (size_t)r * D + 8 * lane), b = *(const v4u*)(H16 + (size_t)r * D + 512 + 8 * lane);
#pragma unroll
        for (int k = 0; k < 4; ++k) { const int sk = shfl_idx_l(slot, k); *(v4u*)(XG + (size_t)sk * D + 8 * lane) = a; *(v4u*)(XG + (size_t)sk * D + 512 + 8 * lane) = b; } }
}
__device__ __forceinline__ void p_moe_combine(KArgs& A, const Frame& F, int l, bool dummy) {
    const int gw = F.bid * NWAVES + F.wave, NGW = F.G * NWAVES, lane = F.lane;
    const bf16* H = (const bf16*)(F.ws + WS_H16); bf16* H16 = (bf16*)(F.ws + (dummy ? WS_Z + 128 * MiB : WS_H16)); const int* TOKS = (const int*)(F.ws + WS_TOKS); const bf16* YS = (const bf16*)(F.ws + WS_YS);
    const bool last = (l == NL - 1) && !dummy;
    for (int r = gw; r < T; r += NGW) { f32x4 v[4]; const int4 sl = *(const int4*)(TOKS + (size_t)r * 4);
#pragma unroll
        for (int j = 0; j < 4; ++j) { v[j] = ld4bf(H + (size_t)r * D + 256 * j + 4 * lane) * DN_ALPHA;
            const v2u y0 = *(const v2u*)(YS + (size_t)sl.x * D + 256 * j + 4 * lane), y1 = *(const v2u*)(YS + (size_t)sl.y * D + 256 * j + 4 * lane), y2 = *(const v2u*)(YS + (size_t)sl.z * D + 256 * j + 4 * lane), y3 = *(const v2u*)(YS + (size_t)sl.w * D + 256 * j + 4 * lane);
            v[j].x += (bf2f(y0.x & 0xffffu) + bf2f(y1.x & 0xffffu)) + (bf2f(y2.x & 0xffffu) + bf2f(y3.x & 0xffffu));
            v[j].y += (bf2f(y0.x >> 16) + bf2f(y1.x >> 16)) + (bf2f(y2.x >> 16) + bf2f(y3.x >> 16));
            v[j].z += (bf2f(y0.y & 0xffffu) + bf2f(y1.y & 0xffffu)) + (bf2f(y2.y & 0xffffu) + bf2f(y3.y & 0xffffu));
            v[j].w += (bf2f(y0.y >> 16) + bf2f(y1.y >> 16)) + (bf2f(y2.y >> 16) + bf2f(y3.y >> 16)); }
        float mean, rstd; ln_stats(v, mean, rstd);
        if (last) ln_apply_store(v, mean, rstd, kin(A, I_LN3_G) + l * D, kin(A, I_LN3_B) + l * D, kout(A) + (size_t)r * D, (bf16*)nullptr, lane);
        else ln_apply_store(v, mean, rstd, kin(A, I_LN3_G) + l * D, kin(A, I_LN3_B) + l * D, (float*)nullptr, H16 + (size_t)r * D, lane); }
}

constexpr int NPL = 18;
constexpr int NPHASES = 1 + NL * NPL;
#ifndef ONLY
#define ONLY -1
#endif
#define EN(j) (ONLY < 0 || ONLY == (j))
#define DUMMY(j) ((PROBE_PHASE == (j)) && (rep_ + 1 < PROBE_REPS))
#define REPS(j) for (int rep_ = 0; rep_ < ((PROBE_PHASE == (j)) ? PROBE_REPS : 1); ++rep_, __syncthreads())
__global__ void __launch_bounds__(NTHREADS, 2) fwd_kernel(Args args) {
    extern __shared__ __attribute__((aligned(16))) unsigned char lds_raw[];
    Frame F;
    F.lds = (LAS unsigned char*)lds_raw; F.MISC = (volatile LAS unsigned*)(F.lds + MISC_OFF);
    F.tid = threadIdx.x; F.lane = F.tid & 63; F.wave = __builtin_amdgcn_readfirstlane(F.tid >> 6); F.G = gridDim.x; F.bid = blockIdx.x;
    F.ws = (unsigned char*)(GAS unsigned char*)args.ws; F.ctl = (unsigned*)(F.ws + WS_CTL);
    for (int u = F.tid; u < (LDS_BYTES - MISC_OFF) / 4; u += NTHREADS) F.MISC[u] = 0u;
    __syncthreads();
    XcdBarrier bar; bar.bar = F.ctl + CW_BAR; bar.x = 0; bar.st = nullptr;
    const int lo = args.ph_lo, hi = args.ph_hi;
    if (hi - lo > 1) bar = xcd_barrier_post(F.ctl + CW_BAR, F.MISC + 8);
#define IN(k) (launder_i(lo) <= (k) && (k) < launder_i(hi))
#define SEAM(k) do { if (IN(k) && IN((k) + 1)) xcd_barrier(bar); } while (0)
#define PH_BEGIN KArgs& KA = *kargs(); unsigned char* ws = launder_p(args.ws); F.ws = ws; (void)KA; (void)ws; { int ln_; asm volatile("v_mbcnt_lo_u32_b32 %0, -1, 0\n\tv_mbcnt_hi_u32_b32 %0, -1, %0" : "=v"(ln_)); F.lane = ln_; } F.tid = F.wave * 64 + F.lane; F.bid = launder_i((int)blockIdx.x); F.G = launder_i((int)gridDim.x);

    if (EN(100) && IN(0)) REPS(100) { PH_BEGIN p_prologue(KA, F); } SEAM(0);
    if (PROBE_PHASE == 300) { for (int q_ = 0; q_ < 20; ++q_) xcd_barrier(bar); }

#pragma unroll 1
    for (int l_ = 0; l_ < NL; ++l_) {
        const int l = launder_i(l_); const int p0 = 1 + l * NPL;
        if (EN(0) && IN(p0 + 0)) REPS(0) { PH_BEGIN
            pg8::Gemm g{D, D, D}; pg8::StaticOrder S{(const bf16*)(ws + WS_H16), (const bf16*)(ws + WS_WINT) + (size_t)l * N_IN * D, D, D, T / 256, N_IN / 256, F.G, F.bid};
            if (PROBE_PHASE == 200) { for (int q_ = 0; q_ < PROBE_REPS - 1; ++q_) { EpiNull E0{0}; pg8::gemm_phase(F.lds, F.wave * 64 + my_lane(), g, S, E0); __syncthreads(); } }
            EpiIn E{l};
            pg8::gemm_phase(F.lds, F.wave * 64 + my_lane(), g, S, E);
        } SEAM(p0 + 0);
        if (EN(1) && IN(p0 + 1)) REPS(1) { PH_BEGIN p_mix1(KA, F, l); } SEAM(p0 + 1);
        if (EN(2) && IN(p0 + 2)) REPS(2) { PH_BEGIN
            { pg8::Gemm g{S5K, 1024, 1024}; pg8::BatchOrder S{(const bf16*)(ws + WS_AOUT), (const bf16*)(ws + WS_S5BC) + (size_t)l * 16 * 256 * 1024, S5K, 1024, NCHT / 256, 1, 16, F.G, F.bid, (size_t)NCHT * S5K, (size_t)256 * 1024};
              EpiXloc E{0}; pg8::gemm_phase(F.lds, F.wave * 64 + my_lane(), g, S, E); }
            __syncthreads();
            { pg8::Gemm g{D, D, D}; pg8::StaticOrder S{(const bf16*)(ws + WS_MEM16), (const bf16*)(ws + WS_WKT) + (size_t)l * D * D, D, D, NB * NMEM / 256, D / 256, F.G, F.bid};
              EpiBf16 E{(unsigned)(WS_KM16 / MiB), 1.0f}; pg8::gemm_phase(F.lds, F.wave * 64 + my_lane(), g, S, E); }
            __syncthreads();
            { pg8::Gemm g{D, D, D}; pg8::StaticOrder S{(const bf16*)(ws + WS_MEM16), (const bf16*)(ws + WS_WVT) + (size_t)l * D * D, D, D, NB * NMEM / 256, D / 256, F.G, F.bid};
              EpiVT E{0}; pg8::gemm_phase(F.lds, F.wave * 64 + my_lane(), g, S, E); }
            __syncthreads();
            { pg8::Gemm g{256, 256, 256}; pg8::StaticOrder S{(const bf16*)(ws + WS_LA16), (const bf16*)(ws + WS_LWT) + (size_t)l * 768 * 256, 256, 256, T / 256, 3, F.G, F.bid};
              EpiLora E{l}; pg8::gemm_phase(F.lds, F.wave * 64 + my_lane(), g, S, E); }
        } SEAM(p0 + 2);
        if (EN(3) && IN(p0 + 3)) REPS(3) { PH_BEGIN p_s5_chain(KA, F, l); p_rw_chunks(KA, F, l); } SEAM(p0 + 3);
        if (EN(4) && IN(p0 + 4)) REPS(4) { PH_BEGIN
            p_chain_compose(F);
            pg8::Gemm g{S5K, S5K, S5K}; pg8::BatchOrder S{(const bf16*)(ws + WS_AOUT), (const bf16*)(ws + WS_S5BT) + (size_t)l * 16 * 1024 * S5K, S5K, S5K, NCHT / 256, 1024 / 256, 16, F.G, F.bid, (size_t)NCHT * S5K, (size_t)1024 * S5K};
            EpiS5Y E{l}; pg8::gemm_phase(F.lds, F.wave * 64 + my_lane(), g, S, E);
        } SEAM(p0 + 4);
        if (EN(5) && IN(p0 + 5)) REPS(5) { PH_BEGIN
            const int nchain = (F.G >= 16) ? 8 : 0;
            if (F.bid < nchain) { p_chain_blocks(F, F.bid * NWAVES + F.wave, nchain * NWAVES); }
            else {
                if (nchain == 0) { p_chain_blocks(F, F.bid * NWAVES + F.wave, F.G * NWAVES); __syncthreads(); }
                pg8::Gemm g{256, 256, 256}; pg8::StaticOrder S{(const bf16*)(ws + WS_YD16), (const bf16*)(ws + WS_GLUT) + (size_t)l * 256 * 256, 256, 256, T / 256, 1, F.G - nchain, F.bid - nchain};
                EpiGlu E{l}; pg8::gemm_phase(F.lds, F.wave * 64 + my_lane(), g, S, E);
            }
        } SEAM(p0 + 5);
        if (EN(6) && IN(p0 + 6)) REPS(6) { PH_BEGIN
            for (int bb = F.bid; bb < 16 * NBLK; bb += F.G) {
                if (F.wave < 4) chain_inblock(F, bb, F.wave);
                VM_WAIT(); __syncthreads();
                rw_out_task(KA, F, l, bb * CB + F.wave);
                __syncthreads();
            }
        } SEAM(p0 + 6);
        if (EN(7) && IN(p0 + 7)) REPS(7) { PH_BEGIN
            pg8::Gemm g{D, 256, 256}; pg8::BranchOrder S{(const bf16*)(ws + WS_O16), (const bf16*)(ws + WS_BRT) + (size_t)l * 4 * D * 256, T / 256, D / 256, F.G, F.bid};
            EpiBranch E{0}; pg8::gemm_phase(F.lds, F.wave * 64 + my_lane(), g, S, E);
        } SEAM(p0 + 7);
        if (EN(8) && IN(p0 + 8)) REPS(8) { PH_BEGIN
            pg8::Gemm g{D, D, D}; pg8::StaticOrder S{(const bf16*)(ws + WS_MG16), (const bf16*)(ws + WS_WOUTT) + (size_t)l * D * D, D, D, T / 256, D / 256, F.G, F.bid};
            EpiResid E{0}; pg8::gemm_phase(F.lds, F.wave * 64 + my_lane(), g, S, E);
        } SEAM(p0 + 8);
        if (EN(9) && IN(p0 + 9)) REPS(9) { PH_BEGIN p_ln(F, kin(KA, I_LN1_G) + l * D, kin(KA, I_LN1_B) + l * D, DUMMY(9)); } SEAM(p0 + 9);
        if (EN(10) && IN(p0 + 10)) REPS(10) { PH_BEGIN
            pg8::Gemm g{D, D, D}; pg8::StaticOrder S{(const bf16*)(ws + WS_H16), (const bf16*)(ws + WS_WQT) + (size_t)l * D * D, D, D, T / 256, D / 256, F.G, F.bid};
            EpiBf16 E{(unsigned)(WS_Q16 / MiB), 0.0625f}; pg8::gemm_phase(F.lds, F.wave * 64 + my_lane(), g, S, E);
        } SEAM(p0 + 10);
        if (EN(11) && IN(p0 + 11)) REPS(11) { PH_BEGIN p_attn(F); } SEAM(p0 + 11);
        if (EN(12) && IN(p0 + 12)) REPS(12) { PH_BEGIN
            pg8::Gemm g{D, D, D}; pg8::StaticOrder S{(const bf16*)(ws + WS_AO16), (const bf16*)(ws + WS_WOT) + (size_t)l * D * D, D, D, T / 256, D / 256, F.G, F.bid};
            EpiResid E{0}; pg8::gemm_phase(F.lds, F.wave * 64 + my_lane(), g, S, E);
        } SEAM(p0 + 12);
        if (EN(13) && IN(p0 + 13)) REPS(13) { PH_BEGIN p_ln_router(KA, F, l, DUMMY(13)); } SEAM(p0 + 13);
        if (EN(14) && IN(p0 + 14)) REPS(14) { PH_BEGIN p_moe_slots(F, l, DUMMY(14) ? (rep_ + 1) : 0); } SEAM(p0 + 14);
        if (EN(15) && IN(p0 + 15)) REPS(15) { PH_BEGIN
            moe_offsets(F, l);
            pg8::Gemm g{D, D, D}; pg8::MoeOrder S{(const bf16*)(ws + WS_XG), (const bf16*)(ws + WS_W1T) + (size_t)l * NE * 2048 * D, D, D, 2048 / 256, F.G, F.bid, (size_t)2048 * D, (const LAS int*)(F.MISC + MI_TOFF)};
            if (PROBE_PHASE == 201) { for (int q_ = 0; q_ < PROBE_REPS - 1; ++q_) { EpiNull E0{0}; pg8::gemm_phase(F.lds, F.wave * 64 + my_lane(), g, S, E0); __syncthreads(); } }
            EpiSwiglu E{l}; pg8::gemm_phase(F.lds, F.wave * 64 + my_lane(), g, S, E);
        } SEAM(p0 + 15);
        if (EN(16) && IN(p0 + 16)) REPS(16) { PH_BEGIN
            moe_offsets(F, l);
            pg8::Gemm g{DFF, DFF, DFF}; pg8::MoeOrder S{(const bf16*)(ws + WS_ACT), (const bf16*)(ws + WS_W2T) + (size_t)l * NE * D * DFF, DFF, DFF, D / 256, F.G, F.bid, (size_t)D * DFF, (const LAS int*)(F.MISC + MI_TOFF)};
            EpiMoeOut E{l}; pg8::gemm_phase(F.lds, F.wave * 64 + my_lane(), g, S, E);
        } SEAM(p0 + 16);
        if (EN(17) && IN(p0 + 17)) REPS(17) { PH_BEGIN p_moe_combine(KA, F, l, DUMMY(17)); } SEAM(p0 + 17);
    }
#undef IN
#undef SEAM
}

extern "C" void kernel_launch(void* const* d_in, const int* in_sizes, int n_in, void* d_out, int out_size, void* d_ws, size_t ws_size, hipStream_t stream) {
    static int grid = 0;
    if (grid == 0) {
        if (n_in != 50 || ws_size < WS_END) { fprintf(stderr, "kernel_launch: unexpected n_in %d / ws_size %zu\n", n_in, ws_size); grid = -1; return; }
        int dev = 0, cus = 0, per_cu = 0;
        if (hipGetDevice(&dev) != hipSuccess || hipDeviceGetAttribute(&cus, hipDeviceAttributeMultiprocessorCount, dev) != hipSuccess) { grid = -1; return; }
        if (hipFuncSetAttribute((const void*)fwd_kernel, hipFuncAttributeMaxDynamicSharedMemorySize, LDS_BYTES) != hipSuccess) { fprintf(stderr, "kernel_launch: hipFuncSetAttribute failed\n"); grid = -1; return; }
        if (hipOccupancyMaxActiveBlocksPerMultiprocessor(&per_cu, (const void*)fwd_kernel, NTHREADS, LDS_BYTES) != hipSuccess || per_cu < 1) { fprintf(stderr, "kernel_launch: occupancy query says %d\n", per_cu); }
        (void)hipGetLastError();
        grid = cus;
    }
    if (grid < 0) return;
    (void)hipMemsetAsync((char*)d_ws + WS_CTL, 0, CTL_ZERO_BYTES, stream);
    Args a{};
    for (int i = 0; i < 50; ++i) a.in[i] = (const float*)d_in[i];
    a.out = (float*)d_out; a.ws = (unsigned char*)d_ws;
#if N_LAUNCHES == 1
    a.ph_lo = 0; a.ph_hi = NPHASES;
    hipLaunchKernelGGL(fwd_kernel, dim3(grid), dim3(NTHREADS), LDS_BYTES, stream, a);
#else
    for (int p = 0; p < NPHASES; ++p) { a.ph_lo = p; a.ph_hi = p + 1; hipLaunchKernelGGL(fwd_kernel, dim3(grid), dim3(NTHREADS), LDS_BYTES, stream, a); }
#endif
}
```

```cpp
#include <hip/hip_runtime.h>
#include <cstdio>
#include <cstdint>

#ifndef N_LAUNCHES
#define N_LAUNCHES 1
#endif

#ifndef PROBE_PHASE
#define PROBE_PHASE -1
#endif
#ifndef PROBE_REPS
#define PROBE_REPS 3
#endif
#define GAS __attribute__((address_space(1)))
#define LAS __attribute__((address_space(3)))
typedef unsigned short bf16;
typedef unsigned v4u __attribute__((ext_vector_type(4)));
typedef unsigned v2u __attribute__((ext_vector_type(2)));
typedef float f32x4 __attribute__((ext_vector_type(4)));
typedef float f32x2 __attribute__((ext_vector_type(2)));
typedef short bf16x8 __attribute__((ext_vector_type(8)));
typedef short bf16x4 __attribute__((ext_vector_type(4)));

constexpr int NL = 2, NB = 4, SEQ = 8192, T = NB * SEQ, D = 1024;
constexpr int NMEM = 256;
constexpr int OFF_B = 768, OFF_C = 1280, OFF_D = 2304, OFF_G = 2560, N_IN = 6656, ZLD = 2560;
constexpr int NE = 32, TOPK = 4, DFF = 1024;
constexpr int CH = 64;
constexpr int NCH = SEQ / CH;
constexpr int NCHT = T / CH;
constexpr int S5K = 1152;
constexpr int SLOT_ROWS = T * TOPK + NE * 256;
constexpr float LN_EPS = 1e-5f, RW_LN_EPS = 64e-5f;
constexpr float DN_ALPHA = 1.41421356237309515f;

constexpr size_t MiB = 1u << 20;
constexpr size_t WS_CTL = 0, CTL_ZERO_BYTES = 1 * MiB;
constexpr size_t WS_W1T = 2 * MiB;
constexpr size_t WS_W2T = 258 * MiB;
constexpr size_t WS_WINT = 386 * MiB;
constexpr size_t WS_BRT = 412 * MiB;
constexpr size_t WS_WOUTT = 416 * MiB, WS_WQT = 420 * MiB, WS_WKT = 424 * MiB, WS_WVT = 428 * MiB, WS_WOT = 432 * MiB;
constexpr size_t WS_GLUT = 436 * MiB;
constexpr size_t WS_MEM16 = 437 * MiB;
constexpr size_t WS_S5BT = 440 * MiB;
constexpr size_t WS_S5BC = 512 * MiB;
constexpr size_t WS_PRE16 = 528 * MiB;
constexpr size_t WS_H16 = 656 * MiB;
constexpr size_t WS_Z = 720 * MiB;
constexpr size_t WS_XG = 720 * MiB;
constexpr size_t WS_SG = 1040 * MiB;
constexpr size_t WS_YS = 1040 * MiB;
constexpr size_t WS_O16 = 1312 * MiB, WS_MG16 = 1376 * MiB, WS_Q16 = 1440 * MiB, WS_AO16 = 1504 * MiB;
constexpr size_t WS_LA16 = 1568 * MiB;
constexpr size_t WS_DEC = 1584 * MiB, WS_AV = 1616 * MiB;
constexpr size_t WS_LWT = 2012 * MiB;
constexpr size_t WS_ACT = 1568 * MiB;
constexpr size_t WS_QH = 1760 * MiB, WS_YL = 1792 * MiB, WS_GC = 1824 * MiB, WS_HC = 1856 * MiB, WS_SC = 1888 * MiB, WS_RWG = 1920 * MiB;
constexpr size_t WS_RK = 1952 * MiB;
constexpr size_t WS_AOUT = 1954 * MiB;
constexpr size_t WS_XLOC = 1972 * MiB;
constexpr size_t WS_YD16 = 1976 * MiB;
constexpr size_t WS_KM16 = 1992 * MiB, WS_VMT16 = 1994 * MiB;
constexpr size_t WS_TOKE = 1996 * MiB, WS_TOKW = 1997 * MiB, WS_TOKS = 1998 * MiB, WS_SLOTW = 1999 * MiB;
constexpr size_t WS_GB = 2000 * MiB, WS_HB = 2004 * MiB, WS_SB = 2008 * MiB;
constexpr size_t WS_END = 2014 * MiB;
static_assert(WS_XG + (size_t)SLOT_ROWS * D * 2 <= WS_SG && WS_YS + (size_t)SLOT_ROWS * D * 2 <= WS_O16 && WS_ACT + (size_t)SLOT_ROWS * D * 2 <= WS_RK, "overlays");
constexpr int CW_BAR = 4096;
constexpr int CW_CNT = 16384;
constexpr int CW_CUR = 16384 + 128;
constexpr int CW_WGH = 65536;

constexpr int LDS_BYTES = 163840;
constexpr int MISC_OFF = LDS_BYTES - 1024;
constexpr int RING_BYTES = 131072;
constexpr int NWAVES = 8, NTHREADS = 512;

#define LDS_WAIT() asm volatile("s_waitcnt lgkmcnt(0)" ::: "memory")
#define VM_WAIT() asm volatile("s_waitcnt vmcnt(0)" ::: "memory")
__device__ __forceinline__ unsigned f2bf(float f) { unsigned u = __float_as_uint(f); return (u + 0x7fffu + ((u >> 16) & 1u)) >> 16; }
__device__ __forceinline__ unsigned pk2(float lo, float hi) { unsigned r; asm("v_cvt_pk_bf16_f32 %0, %1, %2" : "=v"(r) : "v"(lo), "v"(hi)); return r; }
__device__ __forceinline__ float bf2f(unsigned h) { return __uint_as_float(h << 16); }
__device__ __forceinline__ float sigmoidf_(float x) { return __builtin_amdgcn_rcpf(1.0f + __expf(-x)); }
__device__ __forceinline__ int my_lane() { int l; asm volatile("v_mbcnt_lo_u32_b32 %0, -1, 0\n\tv_mbcnt_hi_u32_b32 %0, -1, %0" : "=v"(l)); return l; }
__device__ __forceinline__ float shfl_xor_l(float v, int o, int lane) { return __builtin_bit_cast(float, __builtin_amdgcn_ds_bpermute((lane ^ o) << 2, __builtin_bit_cast(int, v))); }
__device__ __forceinline__ int shfl_idx_l(int v, int src) { return __builtin_amdgcn_ds_bpermute(src << 2, v); }
__device__ __forceinline__ void fmac_(float& c, float a, float b) { asm("v_fmac_f32 %0, %1, %2" : "+v"(c) : "v"(a), "v"(b)); }
template <int R> __device__ __forceinline__ void fmac_bc(float& c, float op, float x) { asm("v_fmac_f32_dpp %0, %1, %2 row_newbcast:%3 row_mask:0xf bank_mask:0xf" : "+v"(c) : "v"(op), "v"(x), "n"(R)); }
__device__ __forceinline__ float wave_sum(float v) {
    const int ln = my_lane();
#pragma unroll
    for (int o = 1; o < 64; o <<= 1) v += shfl_xor_l(v, o, ln);
    return v;
}

#define XB_TMO      128
#define XB_XCNT(j)  (256  + 64 * (j))
#define XB_XSUB(j)  (1280 + 64 * (j))
#define XB_XGEN(j)  (2304 + 64 * (j))
#define XB_TOP      3328
#define XB_TOPGEN   3392
#define XCD_BAR_WORDS 3456
#define XB_SPIN_CAP (1u << 24)
__device__ __forceinline__ unsigned xb_ld(unsigned* p)              { return __hip_atomic_load(p, __ATOMIC_RELAXED, __HIP_MEMORY_SCOPE_AGENT); }
__device__ __forceinline__ unsigned xb_add(unsigned* p, unsigned v) { return __hip_atomic_fetch_add(p, v, __ATOMIC_RELAXED, __HIP_MEMORY_SCOPE_AGENT); }
__device__ __forceinline__ unsigned xb_xcc_id() { return (unsigned)__builtin_amdgcn_s_getreg((3 << 11) | 20) & 0xFu; }
#define XB_SPIN(cond, bar) do { unsigned _sp = 0; while (cond) { __builtin_amdgcn_s_sleep(1); \
    if ((++_sp & 255u) == 0u) { if (xb_ld(&(bar)[XB_TMO])) break; if (_sp > XB_SPIN_CAP) { atomicAdd(&(bar)[XB_TMO], 1u); break; } } } } while (0)
struct XcdBarrier { unsigned* bar; unsigned x; volatile LAS unsigned* st; };
__device__ __forceinline__ XcdBarrier xcd_barrier_post(unsigned* bar, volatile LAS unsigned* st) {
    XcdBarrier b; b.bar = bar; b.x = xb_xcc_id(); b.st = st;
    if (threadIdx.x == 0) (void)xb_add(&bar[XB_XCNT(b.x)], 1u);
    return b;
}
__device__ __forceinline__ void xcd_barrier_complete(unsigned* bar, unsigned x, unsigned& nloc, unsigned& nx) {
    const unsigned G = gridDim.x * gridDim.y * gridDim.z;
    unsigned sum, cnt, mine, sp = 0u;
    for (;;) {
        sum = 0u; cnt = 0u; mine = 0u;
#pragma unroll
        for (unsigned j = 0; j < 16; ++j) { const unsigned c = xb_ld(&bar[XB_XCNT(j)]); sum += c; cnt += (c > 0u) ? 1u : 0u; mine = (j == x) ? c : mine; }
        if (sum == G) break;
        __builtin_amdgcn_s_sleep(1);
        if ((++sp & 255u) == 0u) { if (xb_ld(&bar[XB_TMO])) break; if (sp > XB_SPIN_CAP) { atomicAdd(&bar[XB_TMO], 1u); break; } }
    }
    nloc = mine > 0u ? mine : 1u; nx = cnt > 0u ? cnt : 1u;
}
__device__ __forceinline__ void xcd_barrier(const XcdBarrier& b) {
    asm volatile("s_waitcnt vmcnt(0)" ::: "memory");
    __syncthreads();
    if (threadIdx.x == 0) {
        unsigned* bar = b.bar; unsigned bx = b.x;
        asm volatile("" : "+s"(bar), "+s"(bx));
        __builtin_amdgcn_s_waitcnt(0);
        unsigned nloc = b.st[0], nx = b.st[1];
        if (nloc == 0u) { xcd_barrier_complete(bar, bx, nloc, nx); b.st[0] = nloc; b.st[1] = nx; }
        const unsigned old = xb_add(&bar[XB_XSUB(bx)], 1u);
        const unsigned gen = old / nloc;
        if (old + 1u == (gen + 1u) * nloc) {
            __builtin_amdgcn_fence(__ATOMIC_RELEASE, "agent");
            asm volatile("s_waitcnt vmcnt(0)" ::: "memory");
            const unsigned og = xb_add(&bar[XB_TOP], 1u);
            const unsigned tg = og / nx;
            if (og + 1u == (tg + 1u) * nx) xb_add(&bar[XB_TOPGEN], 1u);
            else XB_SPIN(xb_ld(&bar[XB_TOPGEN]) == tg, bar);
            __builtin_amdgcn_fence(__ATOMIC_ACQUIRE, "agent");
            xb_add(&bar[XB_XGEN(bx)], 1u);
            asm volatile("s_waitcnt vmcnt(0)" ::: "memory");
        } else {
            XB_SPIN(xb_ld(&bar[XB_XGEN(bx)]) == gen, bar);
            __builtin_amdgcn_fence(__ATOMIC_ACQUIRE, "agent");
            asm volatile("s_waitcnt vmcnt(0)" ::: "memory");
        }
    }
    __syncthreads();
}

namespace pg8 {
constexpr int BM = 256, BK = 64, HALF = 128, HTB = HALF * BK * 2, STAGE_BYTES = 8 * HTB, NXCD = 8, WGM = 8;
__host__ __device__ __forceinline__ int lds_byte(int r, int c) { const int st = (r >> 4) * 2 + (c >> 5), rr = r & 15, cc = c & 31, ob = rr * 64 + cc * 2; return st * 1024 + (ob ^ (((ob >> 9) & 1) << 5)); }
__host__ __device__ __forceinline__ int perm32(int rho) { const int n = rho >> 4, i = rho & 15; return 8 * (i >> 2) + 4 * n + (i & 3); }
__host__ __device__ __forceinline__ void stage_rc(int b, int& R, int& C) { const int st = b / 1024, sb = b % 1024, swz = sb ^ (((sb >> 9) & 1) << 5); R = (st >> 1) * 16 + swz / 64; C = (st & 1) * 32 + (swz % 64) / 2; }
struct Unit { int pm, pn, e; };
struct Gemm { int lda, ldb, K; };

__device__ __forceinline__ bool static_tile(int i, int G, int c, int nM, int nN, int& pm, int& pn) {
    const int nwg = nM * nN; const long L = (long)i * G + c; if (L >= nwg) return false;
    int wgid = (int)L; { const int q = nwg / NXCD, r = nwg % NXCD, xcd = wgid % NXCD, off = wgid / NXCD; wgid = (xcd < r ? xcd * (q + 1) : r * (q + 1) + (xcd - r) * q) + off; }
    const int nig = WGM * nN, gid = wgid / nig, fm = gid * WGM, gsz = (nM - fm) < WGM ? (nM - fm) : WGM;
    pm = fm + ((wgid % nig) % gsz); pn = (wgid % nig) / gsz; return true;
}
struct StaticOrder {
    const bf16* A; const bf16* Bt; int lda, ldb, nM, nN, G, c;
    __device__ __forceinline__ bool next(int i, Unit& u) const { u.e = 0; return static_tile(i, G, c, nM, nN, u.pm, u.pn); }
    __device__ __forceinline__ const char* a_base(const Unit& u) const { return (const char*)(A + (size_t)u.pm * BM * lda); }
    __device__ __forceinline__ const char* b_base(const Unit& u) const { return (const char*)(Bt + (size_t)u.pn * BM * ldb); }
};
struct BatchOrder {
    const bf16* A; const bf16* Bt; int lda, ldb, nM, nN, nb, G, c; size_t sA, sB;
    __device__ __forceinline__ bool next(int i, Unit& u) const {
        const long L = (long)i * G + c; const int per = nM * nN; if (L >= (long)per * nb) return false;
        u.e = (int)(L / per); const int r = (int)(L % per); u.pn = r / nM; u.pm = r % nM; return true; }
    __device__ __forceinline__ const char* a_base(const Unit& u) const { return (const char*)(A + (size_t)u.e * sA + (size_t)u.pm * BM * lda); }
    __device__ __forceinline__ const char* b_base(const Unit& u) const { return (const char*)(Bt + (size_t)u.e * sB + (size_t)u.pn * BM * ldb); }
};
struct BranchOrder {
    const bf16* A; const bf16* Bt; int nM, nN, G, c;
    __device__ __forceinline__ bool next(int i, Unit& u) const { u.e = i & 3; return static_tile(i >> 2, G, c, nM, nN, u.pm, u.pn); }
    __device__ __forceinline__ const char* a_base(const Unit& u) const { return (const char*)(A + (size_t)u.pm * BM * D + u.e * 256); }
    __device__ __forceinline__ const char* b_base(const Unit& u) const { return (const char*)(Bt + (size_t)u.e * D * 256 + (size_t)u.pn * BM * 256); }
};
struct MoeOrder {
    const bf16* A; const bf16* Bt; int lda, ldb, nN, G, c; size_t sB; const LAS int* toff;
    __device__ __forceinline__ bool next(int i, Unit& u) const {
        const int nt = toff[NE]; int mt;
        const int Gx = G >> 3;
        if ((G & 7) == 0 && (Gx % nN) == 0) {
            const int per = Gx / nN, x = c & 7, y = c >> 3;
            mt = i * 8 * per + x * per + y / nN; u.pn = y % nN; if (mt >= nt) return false;
        } else { const long L = (long)i * G + c; if (L >= (long)nt * nN) return false; mt = (int)(L / nN); u.pn = (int)(L % nN); }
        u.pm = mt; int e = 0;
#pragma unroll 1
        for (int k = 1; k < NE; ++k) e += (toff[k] <= mt) ? 1 : 0;
        u.e = e; return true; }
    __device__ __forceinline__ const char* a_base(const Unit& u) const { return (const char*)(A + (size_t)u.pm * BM * lda); }
    __device__ __forceinline__ const char* b_base(const Unit& u) const { return (const char*)(Bt + (size_t)u.e * sB + (size_t)u.pn * BM * ldb); }
};

template <class F> __device__ __forceinline__ void epi_foreach(const f32x4 (&acc)[2][2][4][2], const Unit& u, int wr, int wc, int fr, int fq, const F& f) {
#pragma unroll
    for (int ai = 0; ai < 2; ++ai)
#pragma unroll
        for (int m = 0; m < 4; ++m) { const int row = u.pm * BM + ai * HALF + wr * 64 + m * 16 + fr;
#pragma unroll
            for (int bj = 0; bj < 2; ++bj)
#pragma unroll
                for (int n = 0; n < 2; ++n) f(row, u.pn * BM + bj * HALF + wc * 32 + n * 16 + 4 * fq, acc[ai][bj][m][n]);
            if (m == 3) __builtin_amdgcn_sched_barrier(0); }
}

template <class F> __device__ __forceinline__ void epi_foreach8(const f32x4 (&acc)[2][2][4][2], const Unit& u, int wr, int wc, int fr, int fq, const F& f) {
#pragma unroll
    for (int ai = 0; ai < 2; ++ai)
#pragma unroll
        for (int m = 0; m < 4; ++m) { const int row = u.pm * BM + ai * HALF + wr * 64 + m * 16 + fr;
#pragma unroll
            for (int bj = 0; bj < 2; ++bj) f(row, u.pn * BM + bj * HALF + wc * 32 + 8 * fq, acc[ai][bj][m][0], acc[ai][bj][m][1]);
            if (m == 3) __builtin_amdgcn_sched_barrier(0); }
}
template <class Epi, class Sched, bool ALIGN_EPI = true, bool SP2 = true>
__device__ __forceinline__ void gemm_phase(LAS unsigned char* lds, const int tid, const Gemm g, const Sched& S, const Epi& E) {
    const int wid = __builtin_amdgcn_readfirstlane(tid >> 6), lane = tid & 63, wr = wid >> 2, wc = wid & 3, fr = lane & 15, fq = lane >> 4;
    const int K = g.K, nt = K / BK;
    unsigned voffA[2], voffB[2];
#pragma unroll
    for (int i = 0; i < 2; ++i) { int R, C; stage_rc(tid * 16 + i * 8192, R, C);
        const int Rb = Epi::PERM ? ((R & ~31) + perm32(R & 31)) : R;
        voffA[i] = (unsigned)(R * g.lda + C) * 2u; voffB[i] = (unsigned)(Rb * g.ldb + C) * 2u; }
    const size_t kstep = (size_t)(BK * 2);
    const size_t hstepA = (size_t)HALF * g.lda * 2, hstepB = (size_t)HALF * g.ldb * 2;
    const unsigned ldsw = (unsigned)wid * 1024u;
    const int aoff = lds_byte(wr * 64 + fr, fq * 8), boff = lds_byte(wc * 32 + fr, fq * 8);
#define PG8_SA(b, h) (((b) * 2 + (h)) * HTB)
#define PG8_SB(b, h) ((4 + (b) * 2 + (h)) * HTB)
#define PG8_STAGE(bufoff, gbase, voff) do { _Pragma("unroll") for (int _i = 0; _i < 2; ++_i) \
        __builtin_amdgcn_global_load_lds((const unsigned*)((const char*)(gbase) + (voff)[_i]), (LAS unsigned*)(lds + (bufoff) + ldsw + _i * 8192), 16, 0, 0); } while (0)
#define PG8_LDA(dst, b, h) do { _Pragma("unroll") for (int m = 0; m < 4; ++m) _Pragma("unroll") for (int k = 0; k < 2; ++k) dst[m][k] = *(const LAS bf16x8*)(lds + PG8_SA(b, h) + aoff + m * 2048 + k * 1024); } while (0)
#define PG8_LDB(dst, b, h) do { _Pragma("unroll") for (int n = 0; n < 2; ++n) _Pragma("unroll") for (int k = 0; k < 2; ++k) dst[n][k] = *(const LAS bf16x8*)(lds + PG8_SB(b, h) + boff + n * 2048 + k * 1024); } while (0)
#define PG8_MMA(ai, bj, At, Bt) do { __builtin_amdgcn_s_setprio(1); _Pragma("unroll") for (int m = 0; m < 4; ++m) _Pragma("unroll") for (int n = 0; n < 2; ++n) _Pragma("unroll") for (int k = 0; k < 2; ++k) \
        acc[ai][bj][m][n] = __builtin_amdgcn_mfma_f32_16x16x32_bf16(Bt[n][k], At[m][k], acc[ai][bj][m][n], 0, 0, 0); __builtin_amdgcn_s_setprio(0); } while (0)
#define PG8_WAIT_V(n) asm volatile("s_waitcnt vmcnt(" #n ")" ::: "memory")
#define PG8_WAIT_L(n) asm volatile("s_waitcnt lgkmcnt(" #n ")" ::: "memory")
#define PG8_BAR __builtin_amdgcn_s_barrier()
#define PG8_SCHED __builtin_amdgcn_sched_barrier(0)
    Unit cur, nxt; int ui = 0;
    if (!S.next(0, cur)) return;
    f32x4 acc[2][2][4][2];
#pragma unroll
    for (int a = 0; a < 2; ++a)
#pragma unroll
        for (int b = 0; b < 2; ++b)
#pragma unroll
            for (int m = 0; m < 4; ++m)
#pragma unroll
                for (int n = 0; n < 2; ++n) acc[a][b][m][n] = (f32x4){0.f, 0.f, 0.f, 0.f};
    bf16x8 At[4][2], B0[2][2], B1[2][2];
    const char* cA = S.a_base(cur); const char* cB = S.b_base(cur);
    if constexpr (SP2) {
        PG8_STAGE(PG8_SB(0, 0), cB, voffB); PG8_STAGE(PG8_SB(0, 1), cB + hstepB, voffB); PG8_STAGE(PG8_SA(0, 0), cA, voffA); PG8_STAGE(PG8_SA(0, 1), cA + hstepA, voffA);
        if (wr == 1) PG8_BAR;
        PG8_WAIT_V(2); PG8_BAR;
        PG8_STAGE(PG8_SB(1, 0), cB + kstep, voffB); PG8_STAGE(PG8_SA(1, 0), cA + kstep, voffA); PG8_STAGE(PG8_SB(1, 1), cB + hstepB + kstep, voffB);
        PG8_WAIT_V(6); PG8_BAR;
    } else {
        PG8_STAGE(PG8_SB(0, 0), cB, voffB); PG8_STAGE(PG8_SA(0, 0), cA, voffA); PG8_STAGE(PG8_SB(0, 1), cB + hstepB, voffB); PG8_STAGE(PG8_SA(0, 1), cA + hstepA, voffA);
        if (wr == 1) PG8_BAR;
        PG8_WAIT_V(4); PG8_BAR;
        PG8_STAGE(PG8_SB(1, 0), cB + kstep, voffB); PG8_STAGE(PG8_SA(1, 0), cA + kstep, voffA); PG8_STAGE(PG8_SB(1, 1), cB + hstepB + kstep, voffB);
        PG8_WAIT_V(6); PG8_BAR;
    }
    for (;;) {
        const bool has_next = S.next(ui + 1, nxt);
        const char* nA = has_next ? S.a_base(nxt) : cA; const char* nB = has_next ? S.b_base(nxt) : cB;
        for (int t = 0; t < nt; t += 2) {
            const bool last = (t == nt - 2);
            const char* a1 = cA + (size_t)(t + 1) * kstep;
            const char* a2 = last ? nA : cA + (size_t)(t + 2) * kstep; const char* b2 = last ? nB : cB + (size_t)(t + 2) * kstep;
            const char* a3 = a2 + kstep; const char* b3 = b2 + kstep;
            if constexpr (SP2) {
            PG8_LDB(B0, 0, 0); PG8_LDB(B1, 0, 1); PG8_SCHED; PG8_LDA(At, 0, 0); PG8_STAGE(PG8_SA(1, 1), a1 + hstepA, voffA);
            PG8_WAIT_V(8); PG8_WAIT_L(0); PG8_BAR; PG8_MMA(0, 0, At, B0); PG8_MMA(0, 1, At, B1); PG8_BAR; PG8_SCHED;
            PG8_LDA(At, 0, 1); PG8_STAGE(PG8_SB(0, 0), b2, voffB); PG8_STAGE(PG8_SB(0, 1), b2 + hstepB, voffB); PG8_STAGE(PG8_SA(0, 0), a2, voffA);
            PG8_WAIT_V(8); PG8_WAIT_L(0); PG8_BAR; PG8_MMA(1, 0, At, B0); PG8_MMA(1, 1, At, B1); PG8_BAR; PG8_SCHED;
            PG8_LDB(B0, 1, 0); PG8_LDB(B1, 1, 1); PG8_SCHED; PG8_LDA(At, 1, 0); PG8_STAGE(PG8_SA(0, 1), a2 + hstepA, voffA);
            PG8_WAIT_V(8); PG8_WAIT_L(0); PG8_BAR; PG8_MMA(0, 0, At, B0); PG8_MMA(0, 1, At, B1); PG8_BAR; PG8_SCHED;
            PG8_LDA(At, 1, 1); PG8_STAGE(PG8_SB(1, 0), b3, voffB); PG8_STAGE(PG8_SB(1, 1), b3 + hstepB, voffB); PG8_STAGE(PG8_SA(1, 0), a3, voffA);
            PG8_WAIT_V(8); PG8_WAIT_L(0); PG8_BAR; PG8_MMA(1, 0, At, B0); PG8_MMA(1, 1, At, B1); PG8_BAR; PG8_SCHED;
            } else {
            PG8_LDB(B0, 0, 0); PG8_SCHED; PG8_LDA(At, 0, 0); PG8_STAGE(PG8_SA(1, 1), a1 + hstepA, voffA);
            PG8_WAIT_L(8); PG8_BAR; PG8_WAIT_L(0); PG8_MMA(0, 0, At, B0); PG8_BAR; PG8_SCHED;
            PG8_LDB(B1, 0, 1); PG8_STAGE(PG8_SB(0, 0), b2, voffB);
            PG8_BAR; PG8_WAIT_L(0); PG8_MMA(0, 1, At, B1); PG8_BAR;
            PG8_LDA(At, 0, 1); PG8_STAGE(PG8_SA(0, 0), a2, voffA);
            PG8_BAR; PG8_WAIT_L(0); PG8_MMA(1, 0, At, B0); PG8_BAR; PG8_SCHED;
            PG8_STAGE(PG8_SB(0, 1), b2 + hstepB, voffB);
            PG8_WAIT_V(6); PG8_BAR; PG8_MMA(1, 1, At, B1); PG8_BAR;
            PG8_LDB(B0, 1, 0); PG8_SCHED; PG8_LDA(At, 1, 0); PG8_STAGE(PG8_SA(0, 1), a2 + hstepA, voffA);
            PG8_WAIT_L(8); PG8_BAR; PG8_WAIT_L(0); PG8_MMA(0, 0, At, B0); PG8_BAR; PG8_SCHED;
            PG8_LDB(B1, 1, 1); PG8_STAGE(PG8_SB(1, 0), b3, voffB);
            PG8_BAR; PG8_WAIT_L(0); PG8_MMA(0, 1, At, B1); PG8_BAR;
            PG8_LDA(At, 1, 1); PG8_STAGE(PG8_SA(1, 0), a3, voffA);
            PG8_BAR; PG8_WAIT_L(0); PG8_MMA(1, 0, At, B0); PG8_BAR; PG8_SCHED;
            PG8_STAGE(PG8_SB(1, 1), b3 + hstepB, voffB);
            PG8_WAIT_V(6); PG8_BAR; PG8_MMA(1, 1, At, B1); PG8_BAR;
            }
        }
        if constexpr (ALIGN_EPI) { if (wr == 0) PG8_BAR; }
        { const int lane2 = my_lane();
          E(acc, cur, wid >> 2, wid & 3, lane2 & 15, lane2 >> 4); }
        if (!has_next) break;
#pragma unroll
        for (int a = 0; a < 2; ++a)
#pragma unroll
            for (int b = 0; b < 2; ++b)
#pragma unroll
                for (int m = 0; m < 4; ++m)
#pragma unroll
                    for (int n = 0; n < 2; ++n) acc[a][b][m][n] = (f32x4){0.f, 0.f, 0.f, 0.f};
        cur = nxt; cA = nA; cB = nB; ++ui;
        if constexpr (ALIGN_EPI) { if (wr == 1) PG8_BAR; }
    }
    PG8_WAIT_V(0);
    if constexpr (!ALIGN_EPI) { if (wr == 0) PG8_BAR; }
    PG8_BAR;
#undef PG8_SA
#undef PG8_SB
#undef PG8_STAGE
#undef PG8_LDA
#undef PG8_LDB
#undef PG8_MMA
#undef PG8_WAIT_V
#undef PG8_WAIT_L
#undef PG8_BAR
#undef PG8_SCHED
}
}
using pg8::Unit;

struct Args { const float* in[50]; float* out; unsigned char* ws; int ph_lo, ph_hi; };
typedef const __attribute__((address_space(4))) Args KArgs;
__device__ __forceinline__ KArgs* kargs() { KArgs* p = (KArgs*)__builtin_amdgcn_kernarg_segment_ptr(); asm volatile("" : "+s"(p)); return p; }
__device__ __forceinline__ unsigned char* launder_p(unsigned char* p) { asm volatile("" : "+s"(p)); return (unsigned char*)(GAS unsigned char*)p; }
__device__ __forceinline__ const float* kin(KArgs& A, int i) { return (const float*)(const GAS float*)A.in[i]; }
__device__ __forceinline__ float* kout(KArgs& A) { return (float*)(GAS float*)A.out; }
__device__ __forceinline__ unsigned char* kws(KArgs& A) { return (unsigned char*)(GAS unsigned char*)A.ws; }
__device__ __forceinline__ int launder_i(int v) { asm volatile("" : "+s"(v)); return v; }
__device__ __forceinline__ int launder_v(int v) { asm volatile("" : "+v"(v)); return v; }
enum { I_X = 0, I_MEM, I_LN_IN_G, I_LN_IN_B, I_W_IN, I_CONV_W, I_SG_NG, I_SG_NB, I_SG_W, I_SG_B, I_RW_MU, I_RW_W0, I_RW_WUP, I_RW_A0, I_RW_AUP, I_RW_GUP,
       I_RW_KK, I_RW_KA, I_RW_RK, I_RW_LNG, I_RW_LNB, I_S5_ARE, I_S5_AIM, I_S5_BRE, I_S5_BIM, I_S5_CRE, I_S5_CIM, I_S5_D, I_S5_LOGDT, I_S5_GLUW, I_S5_GLUB,
       I_BR_PROJ, I_GATE_B, I_W_OUT, I_LN1_G, I_LN1_B, I_XA_WQ, I_XA_WK, I_XA_WV, I_XA_WO, I_LN2_G, I_LN2_B, I_ROUTER_W, I_ROUTER_B, I_EX_W1, I_EX_B1, I_EX_W2, I_EX_B2,
       I_LN3_G, I_LN3_B };
struct Frame { LAS unsigned char* lds; volatile LAS unsigned* MISC; unsigned* ctl; unsigned char* ws; int tid, lane, wave, G, bid; };
constexpr int MI_TOFF = 16, MI_HIST = 64, MI_LBASE = 96, MI_LCUR = 128;

__device__ __forceinline__ void ln_stats(const f32x4 (&v)[4], float& mean, float& rstd) {
    float s = 0.f;
#pragma unroll
    for (int j = 0; j < 4; ++j) s += (v[j].x + v[j].y) + (v[j].z + v[j].w);
    mean = wave_sum(s) * (1.f / D); float s2 = 0.f;
#pragma unroll
    for (int j = 0; j < 4; ++j) { const f32x4 d = v[j] - mean; s2 += (d.x * d.x + d.y * d.y) + (d.z * d.z + d.w * d.w); }
    rstd = 1.0f / sqrtf(wave_sum(s2) * (1.f / D) + LN_EPS);
}
__device__ __forceinline__ void ln_apply_store(const f32x4 (&v)[4], float mean, float rstd, const float* g, const float* b, float* o32, bf16* o16, int lane) {
#pragma unroll
    for (int j = 0; j < 4; ++j) {
        const f32x4 gg = *(const f32x4*)(g + 256 * j + 4 * lane), bb = *(const f32x4*)(b + 256 * j + 4 * lane);
        const f32x4 y = (v[j] - mean) * rstd * gg + bb;
        if (o32) *(f32x4*)(o32 + 256 * j + 4 * lane) = y;
        if (o16) { v2u w; w.x = pk2(y.x, y.y); w.y = pk2(y.z, y.w); *(v2u*)(o16 + 256 * j + 4 * lane) = w; }
    }
}

__device__ __forceinline__ void transpose_item(const float* W, int K, int N, bf16* WT, int mode, LAS float* scr, int item, int lane) {
    const int nblk = N / 32, kb = item / nblk, nb = item % nblk, k0 = 64 * kb, n0 = 32 * nb;
#pragma unroll 8
    for (int i = 0; i < 32; ++i) { const int kk = 2 * i + (lane >> 5); scr[kk * 33 + (lane & 31)] = W[(size_t)(k0 + kk) * N + n0 + (lane & 31)]; }
    LDS_WAIT();
    const int c = lane & 7;
#pragma unroll
    for (int j = 0; j < 4; ++j) { const int n = (lane >> 3) + 8 * j; const LAS float* s = scr + (8 * c) * 33 + n;
        v4u o; o.x = pk2(s[0 * 33], s[1 * 33]); o.y = pk2(s[2 * 33], s[3 * 33]); o.z = pk2(s[4 * 33], s[5 * 33]); o.w = pk2(s[6 * 33], s[7 * 33]);
        const int nn = n0 + n; const int jj = nn >> 1;
        const int row = mode ? ((jj >> 7) * 256 + (nn & 1) * 128 + (jj & 127)) : nn;
        *(v4u*)(WT + (size_t)row * K + k0 + 8 * c) = o; }
    LDS_WAIT();
}
__device__ __forceinline__ void s5_setup_item(KArgs& A, const Frame& F, int item) {
    const int l = item >> 4, g = item & 15, tid = F.tid;
    LAS float* Kt = (LAS float*)F.lds;
    LAS float* Pw = (LAS float*)(F.lds + 65536);
    LAS float* Bb = (LAS float*)(F.lds + 65536 + 33280);
    LAS float* Cc = Bb + 2048;
    const float* a_re = kin(A, I_S5_ARE) + (l * 16 + g) * 64; const float* a_im = kin(A, I_S5_AIM) + (l * 16 + g) * 64;
    const float* b_re = kin(A, I_S5_BRE) + (size_t)(l * 16 + g) * 1024; const float* b_im = kin(A, I_S5_BIM) + (size_t)(l * 16 + g) * 1024;
    const float* c_re = kin(A, I_S5_CRE) + (size_t)(l * 16 + g) * 1024; const float* c_im = kin(A, I_S5_CIM) + (size_t)(l * 16 + g) * 1024;
    const float dt = expf(kin(A, I_S5_LOGDT)[l * 16 + g]);
    for (int o = tid; o < 65 * 64; o += NTHREADS) { const int n = o >> 6, p = o & 63; const float mag = expf(a_re[p] * dt * (float)n); float sn, cs; sincosf(a_im[p] * dt * (float)n, &sn, &cs);
        Pw[o * 2] = mag * cs; Pw[o * 2 + 1] = mag * sn; }
    for (int o = tid; o < 1024; o += NTHREADS) { const int p = o >> 4;
        const float are = a_re[p], aim = a_im[p], mag = expf(are * dt); float sn, cs; sincosf(aim * dt, &sn, &cs); const float abr = mag * cs, abi = mag * sn;
        const float den = are * are + aim * aim, nr = abr - 1.0f, cr = (nr * are + abi * aim) / den, ci = (abi * are - nr * aim) / den;
        const float br = b_re[o], bi = b_im[o]; Bb[o * 2] = cr * br - ci * bi; Bb[o * 2 + 1] = cr * bi + ci * br; }
    for (int o = tid; o < 1024; o += NTHREADS) { Cc[o * 2] = c_re[o]; Cc[o * 2 + 1] = c_im[o]; }
    __syncthreads();
    for (int o = tid; o < 16384; o += NTHREADS) { const int tau = o >> 8, c = (o >> 4) & 15, cp = o & 15; float acc = 0.f;
        for (int p = 0; p < 64; ++p) { const float cr = Cc[(c * 64 + p) * 2], ci = Cc[(c * 64 + p) * 2 + 1], pr = Pw[(tau * 64 + p) * 2], pi = Pw[(tau * 64 + p) * 2 + 1];
            const float er = cr * pr - ci * pi, ei = cr * pi + ci * pr; acc += er * Bb[(p * 16 + cp) * 2] - ei * Bb[(p * 16 + cp) * 2 + 1]; }
        Kt[o] = acc; }
    __syncthreads();
    bf16* Bt = (bf16*)(F.ws + WS_S5BT) + (size_t)(l * 16 + g) * 1024 * S5K;
    for (int o = tid; o < 1024 * 128; o += NTHREADS) { const int rr = o >> 7, q = o & 127, t = rr >> 4, c = rr & 15, s = q >> 1, cp0 = (q & 1) * 8;
        v4u w = {0u, 0u, 0u, 0u};
        if (s <= t) { const LAS float* k = Kt + ((t - s) * 16 + c) * 16 + cp0; w.x = pk2(k[0], k[1]); w.y = pk2(k[2], k[3]); w.z = pk2(k[4], k[5]); w.w = pk2(k[6], k[7]); }
        *(v4u*)(Bt + (size_t)rr * S5K + q * 8) = w; }
    for (int o = tid; o < 1024 * 16; o += NTHREADS) { const int rr = o >> 4, q = o & 15, t = rr >> 4, c = rr & 15; float vals[8];
#pragma unroll
        for (int j = 0; j < 4; ++j) { const int p = 4 * q + j; const float cr = Cc[(c * 64 + p) * 2], ci = Cc[(c * 64 + p) * 2 + 1], pr = Pw[((t + 1) * 64 + p) * 2], pi = Pw[((t + 1) * 64 + p) * 2 + 1];
            vals[2 * j] = cr * pr - ci * pi; vals[2 * j + 1] = -(cr * pi + ci * pr); }
        v4u w; w.x = pk2(vals[0], vals[1]); w.y = pk2(vals[2], vals[3]); w.z = pk2(vals[4], vals[5]); w.w = pk2(vals[6], vals[7]);
        *(v4u*)(Bt + (size_t)rr * S5K + 1024 + q * 8) = w; }
    bf16* Bc = (bf16*)(F.ws + WS_S5BC) + (size_t)(l * 16 + g) * 256 * 1024;
    for (int o = tid; o < 128 * 128; o += NTHREADS) { const int row = o >> 7, q = o & 127, p = row >> 1, im = row & 1, s = q >> 1, cp0 = (q & 1) * 8;
        const float pr = Pw[((63 - s) * 64 + p) * 2], pi = Pw[((63 - s) * 64 + p) * 2 + 1]; float vals[8];
#pragma unroll
        for (int j = 0; j < 8; ++j) { const float br = Bb[(p * 16 + cp0 + j) * 2], bi = Bb[(p * 16 + cp0 + j) * 2 + 1]; vals[j] = im ? (pr * bi + pi * br) : (pr * br - pi * bi); }
        v4u w; w.x = pk2(vals[0], vals[1]); w.y = pk2(vals[2], vals[3]); w.z = pk2(vals[4], vals[5]); w.w = pk2(vals[6], vals[7]);
        *(v4u*)(Bc + (size_t)row * 1024 + q * 8) = w;
        *(v4u*)(Bc + (size_t)(128 + row) * 1024 + q * 8) = (v4u){0u, 0u, 0u, 0u}; }
    __syncthreads();
}
__device__ __forceinline__ void p_prologue(KArgs& A, const Frame& F) {
    const int gw = F.bid * NWAVES + F.wave, NGW = F.G * NWAVES, lane = F.lane;
    for (int item = F.bid; item < NL * 16; item += F.G) s5_setup_item(A, F, item);
    LAS float* scr = (LAS float*)(F.lds + F.wave * 16384);
#pragma unroll 1
    for (int d = 0; d < 10; ++d) {
        const float* src; bf16* dst; int K, N, batch, mode = 0;
        switch (d) {
            case 0: src = kin(A, I_EX_W1); dst = (bf16*)(F.ws + WS_W1T); K = 1024; N = 2048; batch = NL * NE; mode = 1; break;
            case 1: src = kin(A, I_EX_W2); dst = (bf16*)(F.ws + WS_W2T); K = 1024; N = 1024; batch = NL * NE; break;
            case 2: src = kin(A, I_W_IN); dst = (bf16*)(F.ws + WS_WINT); K = 1024; N = N_IN; batch = NL; break;
            case 3: src = kin(A, I_BR_PROJ); dst = (bf16*)(F.ws + WS_BRT); K = 256; N = 1024; batch = NL * 4; break;
            case 4: src = kin(A, I_W_OUT); dst = (bf16*)(F.ws + WS_WOUTT); K = 1024; N = 1024; batch = NL; break;
            case 5: src = kin(A, I_XA_WQ); dst = (bf16*)(F.ws + WS_WQT); K = 1024; N = 1024; batch = NL; break;
            case 6: src = kin(A, I_XA_WK); dst = (bf16*)(F.ws + WS_WKT); K = 1024; N = 1024; batch = NL; break;
            case 7: src = kin(A, I_XA_WV); dst = (bf16*)(F.ws + WS_WVT); K = 1024; N = 1024; batch = NL; break;
            case 8: src = kin(A, I_XA_WO); dst = (bf16*)(F.ws + WS_WOT); K = 1024; N = 1024; batch = NL; break;
            default: src = kin(A, I_S5_GLUW); dst = (bf16*)(F.ws + WS_GLUT); K = 256; N = 256; batch = NL; break;
        }
        const int per = (K / 64) * (N / 32), nitems = per * batch;
        for (int it = gw; it < nitems; it += NGW) { const int b = it / per, r = it - b * per;
            transpose_item(src + (size_t)b * K * N, K, N, dst + (size_t)b * K * N, mode, scr, r, lane); }
    }
    { bf16* lwt = (bf16*)(F.ws + WS_LWT);
      for (int it = gw * 64 + lane; it < NL * 768 * 32; it += NGW * 64) { const int kc = it & 31, row = (it >> 5) % 768, ll = it / (768 * 32), blk = row >> 8, c = row & 255, k0 = kc * 8; float v[8];
#pragma unroll
          for (int j = 0; j < 8; ++j) { const int k = k0 + j; float x = 0.f;
              if (blk == 0 && k < 64) x = kin(A, I_RW_WUP)[((size_t)ll * 64 + k) * 256 + c];
              else if (blk == 1 && k >= 64 && k < 128) x = kin(A, I_RW_AUP)[((size_t)ll * 64 + (k - 64)) * 256 + c];
              else if (blk == 2 && k >= 128) x = kin(A, I_RW_GUP)[((size_t)ll * 128 + (k - 128)) * 256 + c];
              v[j] = x; }
          v4u w; w.x = pk2(v[0], v[1]); w.y = pk2(v[2], v[3]); w.z = pk2(v[4], v[5]); w.w = pk2(v[6], v[7]);
          *(v4u*)(lwt + ((size_t)ll * 768 + row) * 256 + k0) = w; } }
    { const float* mem = kin(A, I_MEM); bf16* m16 = (bf16*)(F.ws + WS_MEM16);
      for (int r = gw; r < NB * NMEM; r += NGW) {
#pragma unroll
          for (int j = 0; j < 4; ++j) { const f32x4 v = *(const f32x4*)(mem + (size_t)r * D + 256 * j + 4 * lane); v2u w; w.x = pk2(v.x, v.y); w.y = pk2(v.z, v.w); *(v2u*)(m16 + (size_t)r * D + 256 * j + 4 * lane) = w; } } }
    { const float* x = kin(A, I_X); float* h32 = nullptr; bf16* h16 = (bf16*)(F.ws + WS_H16);
      for (int r = gw; r < T; r += NGW) { f32x4 v[4];
#pragma unroll
          for (int j = 0; j < 4; ++j) v[j] = *(const f32x4*)(x + (size_t)r * D + 256 * j + 4 * lane);
          float mean, rstd; ln_stats(v, mean, rstd);
          ln_apply_store(v, mean, rstd, kin(A, I_LN_IN_G), kin(A, I_LN_IN_B), h32, h16 + (size_t)r * D, lane); } }
}

typedef f32x4 AccT[2][2][4][2];
#define EPI_BASES KArgs& KA = *kargs(); unsigned char* ws = kws(KA); (void)ws;
__device__ __forceinline__ v4u pk8(const f32x4 a, const f32x4 b) { v4u w; w.x = pk2(a.x, a.y); w.y = pk2(a.z, a.w); w.z = pk2(b.x, b.y); w.w = pk2(b.z, b.w); return w; }
__device__ __forceinline__ void unpk8(const v4u w, f32x4& a, f32x4& b) { a.x = bf2f(w.x & 0xffffu); a.y = bf2f(w.x >> 16); a.z = bf2f(w.y & 0xffffu); a.w = bf2f(w.y >> 16); b.x = bf2f(w.z & 0xffffu); b.y = bf2f(w.z >> 16); b.z = bf2f(w.w & 0xffffu); b.w = bf2f(w.w >> 16); }
__device__ __forceinline__ f32x4 ld4bf(const bf16* p) { const v2u w = *(const v2u*)p; f32x4 a; a.x = bf2f(w.x & 0xffffu); a.y = bf2f(w.x >> 16); a.z = bf2f(w.y & 0xffffu); a.w = bf2f(w.y >> 16); return a; }
__device__ __forceinline__ f32x4 sig4(const f32x4 v) { return (f32x4){sigmoidf_(v.x), sigmoidf_(v.y), sigmoidf_(v.z), sigmoidf_(v.w)}; }
struct EpiNull { static constexpr bool PERM = false; int dummy;
    __device__ __forceinline__ void operator()(const AccT& acc, const Unit& u, int wr, int wc, int fr, int fq) const { f32x4 t = {0, 0, 0, 0};
#pragma unroll
        for (int a = 0; a < 2; ++a)
#pragma unroll
            for (int b = 0; b < 2; ++b)
#pragma unroll
                for (int m = 0; m < 4; ++m) { t += acc[a][b][m][0]; t += acc[a][b][m][1]; }
        if (t.x + t.y + t.z + t.w == 1234.5f) { EPI_BASES *(f32x4*)(ws + WS_END) = t; } } };
struct EpiIn { static constexpr bool PERM = true; int l;
    __device__ __forceinline__ void operator()(const AccT& acc, const Unit& u, int wr, int wc, int fr, int fq) const { EPI_BASES
        bf16* Z = (bf16*)(ws + WS_Z); bf16* SG = (bf16*)(ws + WS_SG); bf16* AOUT = (bf16*)(ws + WS_AOUT); const float* gate_b = kin(KA, I_GATE_B) + (size_t)l * 4096;
        if (u.pn < 10) {
            pg8::epi_foreach8(acc, u, wr, wc, fr, fq, [&](int row, int col, f32x4 v0, f32x4 v1) { const v4u w = pk8(v0, v1);
                *(v4u*)(Z + (size_t)row * ZLD + col) = w;
                if (u.pn == 9) { const int cc = col - OFF_D, g = cc >> 4, c0 = cc & 15, chunk = row >> 6, s = row & 63; *(v4u*)(AOUT + ((size_t)(g * NCHT + chunk)) * S5K + s * 16 + c0) = w; } });
        } else {
            pg8::epi_foreach8(acc, u, wr, wc, fr, fq, [&](int row, int col, f32x4 v0, f32x4 v1) {
                const int gc = col - OFF_G; const f32x4 g0 = *(const f32x4*)(gate_b + gc), g1 = *(const f32x4*)(gate_b + gc + 4);
                *(v4u*)(SG + (size_t)row * 4096 + gc) = pk8(sig4(v0 + g0), sig4(v1 + g1)); });
        }
    } };
struct EpiBranch { static constexpr bool PERM = true; int dummy;
    __device__ __forceinline__ void operator()(const AccT& acc, const Unit& u, int wr, int wc, int fr, int fq) const { EPI_BASES const int br = u.e;
        bf16* MG = (bf16*)(ws + WS_MG16); const bf16* SG = (const bf16*)(ws + WS_SG);
        pg8::epi_foreach8(acc, u, wr, wc, fr, fq, [&](int row, int col, f32x4 v0, f32x4 v1) {
            f32x4 s0, s1; unpk8(*(const v4u*)(SG + (size_t)row * 4096 + br * 1024 + col), s0, s1);
            f32x4 r0 = v0 * s0, r1 = v1 * s1; bf16* p = MG + (size_t)row * D + col;
            if (br > 0) { f32x4 m0, m1; unpk8(*(const v4u*)p, m0, m1); r0 += m0; r1 += m1; }
            *(v4u*)p = pk8(r0, r1); });
    } };
struct EpiResid { static constexpr bool PERM = true; int dummy;
    __device__ __forceinline__ void operator()(const AccT& acc, const Unit& u, int wr, int wc, int fr, int fq) const { EPI_BASES
        const bf16* H = (const bf16*)(ws + WS_H16); bf16* P = (bf16*)(ws + WS_PRE16);
        pg8::epi_foreach8(acc, u, wr, wc, fr, fq, [&](int row, int col, f32x4 v0, f32x4 v1) { f32x4 h0, h1; unpk8(*(const v4u*)(H + (size_t)row * D + col), h0, h1);
            *(v4u*)(P + (size_t)row * D + col) = pk8(h0 * DN_ALPHA + v0, h1 * DN_ALPHA + v1); });
    } };
struct EpiBf16 { static constexpr bool PERM = true; unsigned off_mib; float scale;
    __device__ __forceinline__ void operator()(const AccT& acc, const Unit& u, int wr, int wc, int fr, int fq) const { EPI_BASES
        bf16* O = (bf16*)(ws + (size_t)off_mib * MiB);
        pg8::epi_foreach8(acc, u, wr, wc, fr, fq, [&](int row, int col, f32x4 v0, f32x4 v1) { *(v4u*)(O + (size_t)row * D + col) = pk8(v0 * scale, v1 * scale); });
    } };
struct EpiVT { static constexpr bool PERM = false; int dummy;
    __device__ __forceinline__ void operator()(const AccT& acc, const Unit& u, int wr, int wc, int fr, int fq) const { EPI_BASES
        bf16* VT = (bf16*)(ws + WS_VMT16);
        pg8::epi_foreach(acc, u, wr, wc, fr, fq, [&](int row, int col, f32x4 v) { const int b = row >> 8, m = row & 255; bf16* p = VT + ((size_t)(b * D + col)) * NMEM + m;
            p[0] = (bf16)f2bf(v.x); p[NMEM] = (bf16)f2bf(v.y); p[2 * NMEM] = (bf16)f2bf(v.z); p[3 * NMEM] = (bf16)f2bf(v.w); });
    } };
struct EpiXloc { static constexpr bool PERM = false; int dummy;
    __device__ __forceinline__ void operator()(const AccT& acc, const Unit& u, int wr, int wc, int fr, int fq) const { EPI_BASES
        float* X = (float*)(ws + WS_XLOC);
        pg8::epi_foreach(acc, u, wr, wc, fr, fq, [&](int row, int col, f32x4 v) { if (col < 128) *(f32x4*)(X + ((size_t)(u.e * NCHT + row)) * 128 + col) = v; });
    } };
struct EpiLora { static constexpr bool PERM = false; int l;
    __device__ __forceinline__ void operator()(const AccT& acc, const Unit& u, int wr, int wc, int fr, int fq) const { EPI_BASES
        if (u.pn == 0) { float* DEC = (float*)(ws + WS_DEC); const float* w0 = kin(KA, I_RW_W0) + l * 256;
            pg8::epi_foreach(acc, u, wr, wc, fr, fq, [&](int row, int col, f32x4 v) { const f32x4 wp = v + *(const f32x4*)(w0 + col); f32x4 o;
#pragma unroll
                for (int e = 0; e < 4; ++e) { const float sp = log1pf(__expf(-wp[e])); o[e] = __expf(-__expf(-sp - 0.5f)); }
                *(f32x4*)(DEC + (size_t)row * 256 + col) = o; });
        } else if (u.pn == 1) { float* AV = (float*)(ws + WS_AV); const float* a0 = kin(KA, I_RW_A0) + l * 256;
            pg8::epi_foreach(acc, u, wr, wc, fr, fq, [&](int row, int col, f32x4 v) { const int c = col - 256; *(f32x4*)(AV + (size_t)row * 256 + c) = sig4(v + *(const f32x4*)(a0 + c)); });
        } else { float* G = (float*)(ws + WS_RWG);
            pg8::epi_foreach(acc, u, wr, wc, fr, fq, [&](int row, int col, f32x4 v) { *(f32x4*)(G + (size_t)row * 256 + col - 512) = v; });
        }
    } };
__device__ __forceinline__ float gelu_tanh(float x) { const float u = 0.7978845608028654f * (x + 0.044715f * x * x * x); const float e = __expf(2.0f * u); const float th = 1.0f - 2.0f * __builtin_amdgcn_rcpf(e + 1.0f); return 0.5f * x * (1.0f + th); }
__device__ __forceinline__ f32x4 gelu4(const f32x4 v) { return (f32x4){gelu_tanh(v.x), gelu_tanh(v.y), gelu_tanh(v.z), gelu_tanh(v.w)}; }
struct EpiS5Y { static constexpr bool PERM = true; int l;
    __device__ __forceinline__ void operator()(const AccT& acc, const Unit& u, int wr, int wc, int fr, int fq) const { EPI_BASES
        bf16* YD = (bf16*)(ws + WS_YD16); const bf16* AOUT = (const bf16*)(ws + WS_AOUT); const float* dvec = kin(KA, I_S5_D) + l * 256;
        pg8::epi_foreach8(acc, u, wr, wc, fr, fq, [&](int row, int col, f32x4 v0, f32x4 v1) { const int t = col >> 4, c0 = col & 15, tok = row * CH + t, ch = u.e * 16 + c0;
            f32x4 u0, u1; unpk8(*(const v4u*)(AOUT + ((size_t)(u.e * NCHT + row)) * S5K + t * 16 + c0), u0, u1);
            const f32x4 d0 = *(const f32x4*)(dvec + ch), d1 = *(const f32x4*)(dvec + ch + 4);
            *(v4u*)(YD + (size_t)tok * 256 + ch) = pk8(gelu4(v0 + d0 * u0), gelu4(v1 + d1 * u1)); });
    } };
struct EpiGlu { static constexpr bool PERM = true; int l;
    __device__ __forceinline__ void operator()(const AccT& acc, const Unit& u, int wr, int wc, int fr, int fq) const { EPI_BASES
        bf16* O = (bf16*)(ws + WS_O16); const bf16* YD = (const bf16*)(ws + WS_YD16); const float* gb = kin(KA, I_S5_GLUB) + l * 256;
        pg8::epi_foreach8(acc, u, wr, wc, fr, fq, [&](int row, int col, f32x4 v0, f32x4 v1) { f32x4 y0, y1; unpk8(*(const v4u*)(YD + (size_t)row * 256 + col), y0, y1);
            const f32x4 b0 = *(const f32x4*)(gb + col), b1 = *(const f32x4*)(gb + col + 4);
            *(v4u*)(O + (size_t)row * D + 768 + col) = pk8(y0 * sig4(v0 + b0), y1 * sig4(v1 + b1)); });
    } };
__device__ __forceinline__ float swiglu(float g, float u) { g = fminf(g, 7.0f); u = fminf(fmaxf(u, -7.0f), 7.0f); return (u + 1.0f) * g * sigmoidf_(1.702f * g); }
struct EpiSwiglu { static constexpr bool PERM = true; int l;
    __device__ __forceinline__ void operator()(const AccT& acc, const Unit& u, int wr, int wc, int fr, int fq) const { EPI_BASES
        bf16* ACT = (bf16*)(ws + WS_ACT); const float* bb = kin(KA, I_EX_B1) + (size_t)(l * NE + u.e) * 2048;
#pragma unroll
        for (int ai = 0; ai < 2; ++ai)
#pragma unroll
            for (int m = 0; m < 4; ++m) { const int row = u.pm * 256 + ai * 128 + wr * 64 + m * 16 + fr; const int j = u.pn * 128 + wc * 32 + 8 * fq;
                f32x4 o[2];
#pragma unroll
                for (int n = 0; n < 2; ++n) { const f32x4 b0 = *(const f32x4*)(bb + 2 * (j + 4 * n)), b1v = *(const f32x4*)(bb + 2 * (j + 4 * n) + 4);
                    const f32x4 g = acc[ai][0][m][n], uu = acc[ai][1][m][n];
                    o[n] = (f32x4){swiglu(g.x + b0.x, uu.x + b0.y), swiglu(g.y + b0.z, uu.y + b0.w), swiglu(g.z + b1v.x, uu.z + b1v.y), swiglu(g.w + b1v.z, uu.w + b1v.w)}; }
                *(v4u*)(ACT + (size_t)row * DFF + j) = pk8(o[0], o[1]);
                if (m == 3) __builtin_amdgcn_sched_barrier(0); }
    } };
struct EpiMoeOut { static constexpr bool PERM = true; int l;
    __device__ __forceinline__ void operator()(const AccT& acc, const Unit& u, int wr, int wc, int fr, int fq) const { EPI_BASES
        bf16* YS = (bf16*)(ws + WS_YS); const float* SLOTW = (const float*)(ws + WS_SLOTW); const float* bb = kin(KA, I_EX_B2) + (size_t)(l * NE + u.e) * D;
        pg8::epi_foreach8(acc, u, wr, wc, fr, fq, [&](int row, int col, f32x4 v0, f32x4 v1) { const float sw = SLOTW[row]; const f32x4 b0 = *(const f32x4*)(bb + col), b1 = *(const f32x4*)(bb + col + 4);
            *(v4u*)(YS + (size_t)row * D + col) = pk8((v0 + b0) * sw, (v1 + b1) * sw); });
    } };

__device__ __forceinline__ void p_mix1(KArgs& A, const Frame& F, int l) {
    const int gw = F.bid * NWAVES + F.wave, NGW = F.G * NWAVES, lane = F.lane, tid = F.tid;
    const bf16* Z = (const bf16*)(F.ws + WS_Z); bf16* O16 = (bf16*)(F.ws + WS_O16);
    for (int rp_ = 0; rp_ < ((PROBE_PHASE == 101) ? PROBE_REPS : 1); ++rp_) { const float* cw = kin(A, I_CONV_W) + l * 3 * 256; const f32x4 w0 = *(const f32x4*)(cw + 4 * lane), w1 = *(const f32x4*)(cw + 256 + 4 * lane), w2 = *(const f32x4*)(cw + 512 + 4 * lane);
      for (int t = gw; t < T; t += NGW) { const int s = t & (SEQ - 1); const bf16* zr = Z + (size_t)t * ZLD + 4 * lane;
          const f32x4 bg = ld4bf(zr); f32x4 y = w2 * (ld4bf(zr + 256) * ld4bf(zr + 512));
          if (s >= 1) y += w1 * (ld4bf(zr - ZLD + 256) * ld4bf(zr - ZLD + 512));
          if (s >= 2) y += w0 * (ld4bf(zr - 2 * ZLD + 256) * ld4bf(zr - 2 * ZLD + 512));
          y = y * bg; v2u w; w.x = pk2(y.x, y.y); w.y = pk2(y.z, y.w); *(v2u*)(O16 + (size_t)t * D + 4 * lane) = w; } }
    for (int rp_ = 0; rp_ < ((PROBE_PHASE == 102) ? PROBE_REPS : 1); ++rp_) { LAS float* VN = (LAS float*)F.lds;
      const float* ng = kin(A, I_SG_NG) + l * 256; const float* nb = kin(A, I_SG_NB) + l * 256;
      for (int blk = F.bid; blk < T / 128; blk += F.G) {
          const f32x4 gg = *(const f32x4*)(ng + 4 * lane), bb = *(const f32x4*)(nb + 4 * lane);
          for (int r = F.wave; r < 128; r += NWAVES) { const int t = blk * 128 + r; const f32x4 v = ld4bf(Z + (size_t)t * ZLD + OFF_B + 256 + 4 * lane);
              const float mean = wave_sum((v.x + v.y) + (v.z + v.w)) * (1.f / 256); const f32x4 d = v - mean;
              const float var = wave_sum((d.x * d.x + d.y * d.y) + (d.z * d.z + d.w * d.w)) * (1.f / 256); const float rstd = 1.0f / sqrtf(var + LN_EPS);
              *(LAS f32x4*)(VN + r * 256 + 4 * lane) = d * rstd * gg + bb; }
          __syncthreads();
          const int i = tid >> 2, cq = tid & 3, t = blk * 128 + i, jmax = (i < 64) ? 64 : 128;
#pragma unroll 1
          for (int g = 0; g < 4; ++g) { f32x4 a0 = {0, 0, 0, 0}, a1 = a0, a2 = a0, a3 = a0;
              const float* wrow = kin(A, I_SG_W) + ((size_t)((l * 4 + g) * 128 + i)) * 128; const LAS float* vb = VN + g * 64 + cq * 16;
              for (int j = 0; j < jmax; j += 4) { const f32x4 w4 = *(const f32x4*)(wrow + j);
#pragma unroll
                  for (int jj = 0; jj < 4; ++jj) { const LAS f32x4* vp = (const LAS f32x4*)(vb + (j + jj) * 256); const float w = w4[jj];
                      a0 += vp[0] * w; a1 += vp[1] * w; a2 += vp[2] * w; a3 += vp[3] * w; } }
              const float bias = kin(A, I_SG_B)[(l * 4 + g) * 128 + i]; const bf16* up = Z + (size_t)t * ZLD + OFF_B + g * 64 + cq * 16;
              const f32x4 o0 = ld4bf(up) * (a0 + bias), o1 = ld4bf(up + 4) * (a1 + bias), o2 = ld4bf(up + 8) * (a2 + bias), o3 = ld4bf(up + 12) * (a3 + bias);
              v4u wa, wb; wa.x = pk2(o0.x, o0.y); wa.y = pk2(o0.z, o0.w); wa.z = pk2(o1.x, o1.y); wa.w = pk2(o1.z, o1.w); wb.x = pk2(o2.x, o2.y); wb.y = pk2(o2.z, o2.w); wb.z = pk2(o3.x, o3.y); wb.w = pk2(o3.z, o3.w);
              bf16* op = O16 + (size_t)t * D + 256 + g * 64 + cq * 16; *(v4u*)op = wa; *(v4u*)(op + 8) = wb; }
          __syncthreads();
      } }
    for (int rp_ = 0; rp_ < ((PROBE_PHASE == 103) ? PROBE_REPS : 1); ++rp_) {
      bf16* LA = (bf16*)(F.ws + WS_LA16); const f32x4 mul = *(const f32x4*)(kin(A, I_RW_MU) + l * 1024 + 768 + 4 * lane);
      for (int t = gw; t < T; t += NGW) { const int s = t & (SEQ - 1); const bf16* zr = Z + (size_t)t * ZLD + OFF_C + 768 + 4 * lane;
          f32x4 x = ld4bf(zr); f32x4 pv = {0, 0, 0, 0}; if (s > 0) pv = ld4bf(zr - ZLD); x = x + (pv - x) * mul;
          if (lane < 16) x = sig4(x * 2.0f) * 2.0f - 1.0f;
          else if (lane >= 32) x = sig4(x);
          v2u w; w.x = pk2(x.x, x.y); w.y = pk2(x.z, x.w); *(v2u*)(LA + (size_t)t * 256 + 4 * lane) = w; } }
}

__device__ __forceinline__ void p_rw_chunks(KArgs& A, const Frame& F, int l) {
    const int gw = F.bid * NWAVES + F.wave, NGW = F.G * NWAVES, lane = F.lane;
    const bf16* Z = (const bf16*)(F.ws + WS_Z); const float* DEC = (const float*)(F.ws + WS_DEC); const float* AV = (const float*)(F.ws + WS_AV);
    float* QH = (float*)(F.ws + WS_QH); float* YL = (float*)(F.ws + WS_YL); float* GC = (float*)(F.ws + WS_GC); float* HC = (float*)(F.ws + WS_HC); float* RK = (float*)(F.ws + WS_RK);
    LAS float* wl = (LAS float*)(F.lds + F.wave * 16384);
    for (int task = gw; task < 16 * NCH; task += NGW) { const int bh = task / NCH, ck = task % NCH, b = bh >> 2, head = bh & 3, c = head * 64 + lane;
        const float mu_r = kin(A, I_RW_MU)[l * 1024 + c], mu_k = kin(A, I_RW_MU)[l * 1024 + 256 + c], mu_v = kin(A, I_RW_MU)[l * 1024 + 512 + c];
        const float kkc = kin(A, I_RW_KK)[l * 256 + c], kac = kin(A, I_RW_KA)[l * 256 + c], rkc = kin(A, I_RW_RK)[l * 256 + c];
        float sp[64], sl[64];
        { const int ln = launder_v(lane);
#pragma unroll
          for (int k = 0; k < 64; ++k) { sp[k] = (k == ln) ? 1.0f : 0.0f; sl[k] = 0.0f; } }
        wl[8 * 320 + lane] = 0.f;
        const int tg0 = b * SEQ + ck * CH;
        float pr = 0.f, pk = 0.f, pv = 0.f, gam = 1.0f;
        if (ck > 0) { const bf16* zp = Z + (size_t)(tg0 - 1) * ZLD + OFF_C + c; pr = bf2f(zp[0]); pk = bf2f(zp[256]); pv = bf2f(zp[512]); }
#pragma unroll 1
        for (int sb = 0; sb < CH / 8; ++sb) {
#pragma unroll 1
            for (int hb = 0; hb < 2; ++hb) {
                float kk[4], dc[4], av[4], rs[4], k2[4], vs[4], ss[4], rkp[4];
#pragma unroll
                for (int i = 0; i < 4; ++i) { const int t = tg0 + sb * 8 + hb * 4 + i; const bf16* zr = Z + (size_t)t * ZLD + OFF_C + c;
                    const float r = bf2f(zr[0]), k = bf2f(zr[256]), v = bf2f(zr[512]); dc[i] = DEC[(size_t)t * 256 + c]; av[i] = AV[(size_t)t * 256 + c];
                    rs[i] = r + (pr - r) * mu_r; const float ks = k + (pk - k) * mu_k; vs[i] = v + (pv - v) * mu_v; pr = r; pk = k; pv = v;
                    kk[i] = ks * kkc; k2[i] = ks * (1.0f + (av[i] - 1.0f) * kac); ss[i] = kk[i] * kk[i]; rkp[i] = rs[i] * k2[i] * rkc; }
#pragma unroll
                for (int o = 1; o < 64; o <<= 1) {
#pragma unroll
                    for (int i = 0; i < 4; ++i) { ss[i] += shfl_xor_l(ss[i], o, lane); rkp[i] += shfl_xor_l(rkp[i], o, lane); } }
#pragma unroll
                for (int i = 0; i < 4; ++i) { const float kn = kk[i] * __builtin_amdgcn_rcpf(fmaxf(sqrtf(ss[i]), 1e-12f)); LAS float* w = wl + (hb * 4 + i) * 320 + lane;
                    const float g1 = gam * dc[i], ig = __builtin_amdgcn_rcpf(g1);
                    w[0] = -kn * gam; w[64] = kn * av[i] * ig; w[128] = rs[i] * g1; w[192] = k2[i] * ig; w[256] = vs[i]; gam = g1;
                    if (lane == 0) RK[(size_t)(tg0 + sb * 8 + hb * 4 + i) * 4 + head] = rkp[i]; }
            }
            LDS_WAIT();
            const LAS float* wr16 = wl + (lane & 15);
            float saP = 0.f, saL = 0.f;
            { float A0[4];
#pragma unroll
              for (int J = 0; J < 4; ++J) A0[J] = wr16[16 * J];
#define RW_SA(k) { fmac_bc<(k) & 15>(saP, A0[(k) >> 4], sp[k]); fmac_bc<(k) & 15>(saL, A0[(k) >> 4], sl[k]); }
#define RW_REP16(M, o) M(o + 0) M(o + 1) M(o + 2) M(o + 3) M(o + 4) M(o + 5) M(o + 6) M(o + 7) M(o + 8) M(o + 9) M(o + 10) M(o + 11) M(o + 12) M(o + 13) M(o + 14) M(o + 15)
              RW_REP16(RW_SA, 0) RW_REP16(RW_SA, 16) RW_REP16(RW_SA, 32) RW_REP16(RW_SA, 48) }
            float Bv[4], Rv[4], Kv[4], Av[4], vj;
#pragma unroll
            for (int J = 0; J < 4; ++J) { Bv[J] = wr16[64 + 16 * J]; Rv[J] = wr16[128 + 16 * J]; Kv[J] = wr16[192 + 16 * J]; Av[J] = wr16[320 + 16 * J]; }
            vj = wl[256 + lane];
#pragma unroll 1
            for (int st_ = 0; st_ < 8; ++st_) {
                float Bn[4], Rn[4], Kn[4], An[4], vn;
                { const LAS float* nb = wr16 + (st_ + 1) * 320; const int lim = (st_ < 7) ? 0 : -320;
#pragma unroll
                  for (int J = 0; J < 4; ++J) { Bn[J] = nb[lim + 64 + 16 * J]; Rn[J] = nb[lim + 128 + 16 * J]; Kn[J] = nb[lim + 192 + 16 * J]; An[J] = nb[320 + 16 * J]; }
                  vn = wl[(st_ + 1) * 320 + lim + 256 + lane]; }
                float yP = 0.f, yL = 0.f, nP = 0.f, nL = 0.f;
#define RW_STEP(k) { fmac_bc<(k) & 15>(sp[k], Bv[(k) >> 4], saP); fmac_bc<(k) & 15>(sl[k], Bv[(k) >> 4], saL); fmac_bc<(k) & 15>(sl[k], Kv[(k) >> 4], vj); \
                     fmac_bc<(k) & 15>(yP, Rv[(k) >> 4], sp[k]); fmac_bc<(k) & 15>(yL, Rv[(k) >> 4], sl[k]); fmac_bc<(k) & 15>(nP, Av[(k) >> 4], sp[k]); fmac_bc<(k) & 15>(nL, Av[(k) >> 4], sl[k]); }
                RW_REP16(RW_STEP, 0) RW_REP16(RW_STEP, 16) RW_REP16(RW_STEP, 32) RW_REP16(RW_STEP, 48)
                const size_t oi = ((size_t)(bh * SEQ + ck * CH + sb * 8 + st_)) * 64 + lane;
                QH[oi] = yP; YL[oi] = yL; saP = nP; saL = nL;
#pragma unroll
                for (int J = 0; J < 4; ++J) { Bv[J] = Bn[J]; Rv[J] = Rn[J]; Kv[J] = Kn[J]; Av[J] = An[J]; }
                vj = vn; }
#undef RW_SA
#undef RW_STEP
#undef RW_REP16
        }
        wl[lane] = gam; LDS_WAIT();
        float* hp = HC + ((size_t)(bh * NCH + ck) * 64 + lane) * 64;
#pragma unroll
        for (int q = 0; q < 16; ++q) { const f32x4 gq = *(const LAS f32x4*)(wl + 4 * q);
            sp[4 * q] *= gq.x; sp[4 * q + 1] *= gq.y; sp[4 * q + 2] *= gq.z; sp[4 * q + 3] *= gq.w;
            *(f32x4*)(hp + 4 * q) = (f32x4){sl[4 * q] * gq.x, sl[4 * q + 1] * gq.y, sl[4 * q + 2] * gq.z, sl[4 * q + 3] * gq.w}; }
        { float* gp = GC + (size_t)(bh * NCH + ck) * 4096 + (size_t)(((lane >> 2) & 3) * 16) * 64 + ((lane >> 4) * 4 + (lane & 3)) * 4;
#pragma unroll
          for (int f = 0; f < 16; ++f) *(f32x4*)(gp + f * 64) = (f32x4){sp[f], sp[16 + f], sp[32 + f], sp[48 + f]}; }
        LDS_WAIT();
    }
}
__device__ __forceinline__ void p_s5_chain(KArgs& A, const Frame& F, int l) {
    const int gt = F.bid * NTHREADS + F.tid; if (gt >= NB * 16 * 64) return;
    const int b = gt >> 10, g = (gt >> 6) & 15, p = gt & 63;
    const float dt = expf(kin(A, I_S5_LOGDT)[l * 16 + g]); const float are = kin(A, I_S5_ARE)[(l * 16 + g) * 64 + p], aim = kin(A, I_S5_AIM)[(l * 16 + g) * 64 + p];
    const float mag = expf(are * dt * 64.0f); float sn, cs; sincosf(aim * dt * 64.0f, &sn, &cs); const float ar = mag * cs, ai = mag * sn;
    bf16* AO = (bf16*)(F.ws + WS_AOUT); const float* XL = (const float*)(F.ws + WS_XLOC);
    float xr = 0.f, xi = 0.f;
#pragma unroll 1
    for (int c0 = 0; c0 < NCH; c0 += 16) {
        f32x2 xl[16]; unsigned outw[16];
#pragma unroll
        for (int i = 0; i < 16; ++i) xl[i] = *(const f32x2*)(XL + ((size_t)g * NCHT + b * NCH + c0 + i) * 128 + 2 * p);
#pragma unroll
        for (int i = 0; i < 16; ++i) { outw[i] = pk2(xr, xi); const float nr = ar * xr - ai * xi + xl[i].x, ni = ar * xi + ai * xr + xl[i].y; xr = nr; xi = ni; }
#pragma unroll
        for (int i = 0; i < 16; ++i) *(unsigned*)(AO + ((size_t)g * NCHT + b * NCH + c0 + i) * S5K + 1024 + 2 * p) = outw[i];
    }
}
constexpr int CB = 8, NBLK = NCH / CB;
__device__ __forceinline__ void chain_load_g(const float* G, float (&ga)[64], int fr, int fq) {
    const f32x4* gp = (const f32x4*)(G + (size_t)(16 * fq + fr) * 64);
#pragma unroll
    for (int q = 0; q < 16; ++q) { const f32x4 x = gp[q]; ga[4 * q] = x.x; ga[4 * q + 1] = x.y; ga[4 * q + 2] = x.z; ga[4 * q + 3] = x.w; }
}
__device__ __forceinline__ void chain_store_g(float* G, int rb, const f32x4 (&t)[4], int fr, int fq) {
#pragma unroll
    for (int reg = 0; reg < 4; ++reg) *(f32x4*)(G + (size_t)((fr >> 2) * 16 + 4 * fq + reg) * 64 + (rb * 4 + (fr & 3)) * 4) = (f32x4){t[0][reg], t[1][reg], t[2][reg], t[3][reg]};
}
__device__ __forceinline__ void chain_step(f32x4 (&acc)[4], const float (&ga)[64], const f32x4 (&ci)[4]) {
    f32x4 na[4] = {ci[0], ci[1], ci[2], ci[3]};
#pragma unroll
    for (int jr = 0; jr < 16; ++jr)
#pragma unroll
        for (int mt = 0; mt < 4; ++mt) na[mt] = __builtin_amdgcn_mfma_f32_16x16x4f32(ga[jr * 4 + mt], acc[jr >> 2][jr & 3], na[mt], 0, 0, 0);
#pragma unroll
    for (int mt = 0; mt < 4; ++mt) acc[mt] = na[mt];
}
__device__ __forceinline__ void chain_load_tile(const float* M, int rb, f32x4 (&t)[4], int fr, int fq) {
#pragma unroll
    for (int jt = 0; jt < 4; ++jt) t[jt] = *(const f32x4*)(M + (size_t)(16 * rb + fr) * 64 + 16 * jt + 4 * fq);
}
__device__ __forceinline__ void chain_store_tile(float* M, int rb, const f32x4 (&t)[4], int fr, int fq) {
#pragma unroll
    for (int jt = 0; jt < 4; ++jt) *(f32x4*)(M + (size_t)(16 * rb + fr) * 64 + 16 * jt + 4 * fq) = t[jt];
}
__device__ __forceinline__ void p_chain_compose(const Frame& F) {
    const int gw = F.bid * NWAVES + F.wave, NGW = F.G * NWAVES, ln_ = my_lane(), fr = ln_ & 15, fq = ln_ >> 4;
    const float* GC = (const float*)(F.ws + WS_GC); const float* HC = (const float*)(F.ws + WS_HC); float* GB = (float*)(F.ws + WS_GB); float* HB = (float*)(F.ws + WS_HB);
    for (int task = gw; task < 16 * NBLK * 8; task += NGW) { const int cb = task & 7, bb = task >> 3, rb = cb & 3; const bool isH = cb >= 4;
        const size_t c0 = (size_t)bb * CB;
        f32x4 acc[4];
        if (isH) chain_load_tile(HC + c0 * 4096, rb, acc, fr, fq);
        else {
            const float* gq = GC + c0 * 4096 + (size_t)((fr >> 2) * 16 + 4 * fq) * 64 + (rb * 4 + (fr & 3)) * 4;
#pragma unroll
            for (int reg = 0; reg < 4; ++reg) { const f32x4 x = *(const f32x4*)(gq + reg * 64); acc[0][reg] = x.x; acc[1][reg] = x.y; acc[2][reg] = x.z; acc[3][reg] = x.w; } }
        float ga[64]; chain_load_g(GC + (c0 + 1) * 4096, ga, fr, fq);
        f32x4 ci[4] = {{0, 0, 0, 0}, {0, 0, 0, 0}, {0, 0, 0, 0}, {0, 0, 0, 0}};
        if (isH) chain_load_tile(HC + (c0 + 1) * 4096, rb, ci, fr, fq);
#pragma unroll 1
        for (int i = 1; i < CB; ++i) { const int nx = (i + 1 < CB) ? i + 1 : i;
            f32x4 cn[4] = {{0, 0, 0, 0}, {0, 0, 0, 0}, {0, 0, 0, 0}, {0, 0, 0, 0}};
            if (isH) chain_load_tile(HC + (c0 + nx) * 4096, rb, cn, fr, fq);
            float gn[64]; chain_load_g(GC + (c0 + nx) * 4096, gn, fr, fq);
            chain_step(acc, ga, ci);
#pragma unroll
            for (int k = 0; k < 64; ++k) ga[k] = gn[k];
#pragma unroll
            for (int k = 0; k < 4; ++k) ci[k] = cn[k]; }
        if (isH) chain_store_tile(HB + (size_t)bb * 4096, rb, acc, fr, fq); else chain_store_g(GB + (size_t)bb * 4096, rb, acc, fr, fq);
    }
}
__device__ __forceinline__ void p_chain_blocks(const Frame& F, int gw, int NGW) {
    const int ln_ = my_lane(), fr = ln_ & 15, fq = ln_ >> 4;
    const float* GB = (const float*)(F.ws + WS_GB); const float* HB = (const float*)(F.ws + WS_HB); float* SB = (float*)(F.ws + WS_SB);
    for (int task = gw; task < 16 * 4; task += NGW) { const int vb = task & 3, bh = task >> 2;
        f32x4 acc[4] = {{0, 0, 0, 0}, {0, 0, 0, 0}, {0, 0, 0, 0}, {0, 0, 0, 0}};
        float ga[64]; chain_load_g(GB + (size_t)bh * NBLK * 4096, ga, fr, fq);
        f32x4 ci[4]; chain_load_tile(HB + (size_t)bh * NBLK * 4096, vb, ci, fr, fq);
#pragma unroll 1
        for (int blk = 0; blk < NBLK; ++blk) { const size_t bb = (size_t)bh * NBLK + blk;
            chain_store_tile(SB + bb * 4096, vb, acc, fr, fq);
            if (blk + 1 == NBLK) break;
            f32x4 cn[4]; chain_load_tile(HB + (bb + 1) * 4096, vb, cn, fr, fq);
            float gn[64]; chain_load_g(GB + (bb + 1) * 4096, gn, fr, fq);
            chain_step(acc, ga, ci);
#pragma unroll
            for (int k = 0; k < 64; ++k) ga[k] = gn[k];
#pragma unroll
            for (int k = 0; k < 4; ++k) ci[k] = cn[k]; }
    }
}
__device__ __forceinline__ void chain_inblock(const Frame& F, int bb, int vb) {
    const int ln_ = my_lane(), fr = ln_ & 15, fq = ln_ >> 4;
    const float* GC = (const float*)(F.ws + WS_GC); const float* HC = (const float*)(F.ws + WS_HC); const float* SB = (const float*)(F.ws + WS_SB); float* SC = (float*)(F.ws + WS_SC);
    const size_t c0 = (size_t)bb * CB;
    f32x4 acc[4]; chain_load_tile(SB + (size_t)bb * 4096, vb, acc, fr, fq);
    float ga[64]; chain_load_g(GC + c0 * 4096, ga, fr, fq);
    f32x4 ci[4]; chain_load_tile(HC + c0 * 4096, vb, ci, fr, fq);
#pragma unroll 1
    for (int i = 0; i < CB; ++i) {
        chain_store_tile(SC + (c0 + i) * 4096, vb, acc, fr, fq);
        if (i + 1 == CB) break;
        f32x4 cn[4]; chain_load_tile(HC + (c0 + i + 1) * 4096, vb, cn, fr, fq);
        float gn[64]; chain_load_g(GC + (c0 + i + 1) * 4096, gn, fr, fq);
        chain_step(acc, ga, ci);
#pragma unroll
        for (int k = 0; k < 64; ++k) ga[k] = gn[k];
#pragma unroll
        for (int k = 0; k < 4; ++k) ci[k] = cn[k]; }
}
__device__ __forceinline__ void rw_out_task(KArgs& A, const Frame& F, int l, int task) {
    const int lane = F.lane, fr = lane & 15, fq = lane >> 4;
    const bf16* Z = (const bf16*)(F.ws + WS_Z); const float* QH = (const float*)(F.ws + WS_QH); const float* YL = (const float*)(F.ws + WS_YL); const float* SC = (const float*)(F.ws + WS_SC);
    const float* RWG = (const float*)(F.ws + WS_RWG); const float* RK = (const float*)(F.ws + WS_RK); bf16* O16 = (bf16*)(F.ws + WS_O16);
    const int bh = task / NCH, ck = task % NCH, b = bh >> 2, head = bh & 3;
    const size_t ti0 = (size_t)(bh * SEQ + ck * CH); const int t0g = b * SEQ + ck * CH;
    float sa[4][16];
    { const float* sp = SC + (size_t)(bh * NCH + ck) * 4096 + (size_t)fr * 64 + 16 * fq;
#pragma unroll
      for (int vt = 0; vt < 4; ++vt)
#pragma unroll
          for (int q = 0; q < 4; ++q) { const f32x4 x = *(const f32x4*)(sp + vt * 1024 + 4 * q); sa[vt][4 * q] = x.x; sa[vt][4 * q + 1] = x.y; sa[vt][4 * q + 2] = x.z; sa[vt][4 * q + 3] = x.w; } }
    const float* lgp = kin(A, I_RW_LNG) + l * 256 + head * 64 + 4 * fq; const float* lbp = kin(A, I_RW_LNB) + l * 256 + head * 64 + 4 * fq; const float* mup = kin(A, I_RW_MU) + l * 1024 + 512 + head * 64 + 4 * fq;
#pragma unroll 1
    for (int tt = 0; tt < 4; ++tt) { const int t = 16 * tt + fr;
        float qb[16];
        { const float* qp = QH + (ti0 + t) * 64 + 16 * fq;
#pragma unroll
          for (int q = 0; q < 4; ++q) { const f32x4 x = *(const f32x4*)(qp + 4 * q); qb[4 * q] = x.x; qb[4 * q + 1] = x.y; qb[4 * q + 2] = x.z; qb[4 * q + 3] = x.w; } }
        f32x4 y[4];
#pragma unroll
        for (int vt = 0; vt < 4; ++vt) y[vt] = *(const f32x4*)(YL + (ti0 + t) * 64 + 16 * vt + 4 * fq);
#pragma unroll
        for (int s_ = 0; s_ < 16; ++s_)
#pragma unroll
            for (int vt = 0; vt < 4; ++vt) y[vt] = __builtin_amdgcn_mfma_f32_16x16x4f32(sa[vt][s_], qb[s_], y[vt], 0, 0, 0);
        float s1 = 0.f, s2 = 0.f;
#pragma unroll
        for (int vt = 0; vt < 4; ++vt) { s1 += (y[vt].x + y[vt].y) + (y[vt].z + y[vt].w); s2 += (y[vt].x * y[vt].x + y[vt].y * y[vt].y) + (y[vt].z * y[vt].z + y[vt].w * y[vt].w); }
        s1 += shfl_xor_l(s1, 16, lane); s1 += shfl_xor_l(s1, 32, lane); s2 += shfl_xor_l(s2, 16, lane); s2 += shfl_xor_l(s2, 32, lane);
        const float m = s1 * (1.f / 64), var = fmaxf(s2 * (1.f / 64) - m * m, 0.f), rstd = __builtin_amdgcn_rsqf(var + RW_LN_EPS);
        const int tg = t0g + t; const float rk = RK[(size_t)tg * 4 + head]; const bool hasprev = (ck * CH + t) > 0;
        const bf16* zv = Z + (size_t)tg * ZLD + OFF_C + 512 + head * 64 + 4 * fq; const float* gp = RWG + (size_t)tg * 256 + head * 64 + 4 * fq; bf16* op = O16 + (size_t)tg * D + 512 + head * 64 + 4 * fq;
#pragma unroll
        for (int vt = 0; vt < 4; ++vt) { const f32x4 v1 = ld4bf(zv + 16 * vt); f32x4 v0 = {0, 0, 0, 0}; if (hasprev) v0 = ld4bf(zv - ZLD + 16 * vt);
            const f32x4 vv = v1 + (v0 - v1) * *(const f32x4*)(mup + 16 * vt), g4 = *(const f32x4*)(gp + 16 * vt), lg4 = *(const f32x4*)(lgp + 16 * vt), lb4 = *(const f32x4*)(lbp + 16 * vt);
            const f32x4 o = ((y[vt] - m) * rstd * lg4 + lb4 + vv * rk) * g4;
            v2u w; w.x = pk2(o.x, o.y); w.y = pk2(o.z, o.w); *(v2u*)(op + 16 * vt) = w; }
    }
}

template <int LSTRIDE> __device__ __forceinline__ void attn_stage(LAS unsigned char* lds, const bf16* src, size_t row_stride, int tid) {
    const int r0 = tid >> 5, c = tid & 31; const bf16* sp = src + (size_t)r0 * row_stride + c * 8; LAS unsigned char* dp = lds + r0 * LSTRIDE + c * 16;
#pragma unroll 4
    for (int i = 0; i < 16; ++i) { const v4u v = *(const v4u*)(sp + (size_t)(16 * i) * row_stride); *(LAS v4u*)(dp + 16 * i * LSTRIDE) = v; }
}
constexpr int KSTR = 544, VSTR = 528;
__device__ __forceinline__ void p_attn(const Frame& F) {
    const int lane = F.lane, fr = lane & 15, fq = lane >> 4;
    const bf16* Q = (const bf16*)(F.ws + WS_Q16); const bf16* KM = (const bf16*)(F.ws + WS_KM16); const bf16* VT = (const bf16*)(F.ws + WS_VMT16); bf16* AO = (bf16*)(F.ws + WS_AO16);
    for (int item = F.bid; item < NB * 4 * (SEQ / 256); item += F.G) {
        const int qg = item % (SEQ / 256), bhd = item / (SEQ / 256), head = bhd & 3, b = bhd >> 2;
        attn_stage<KSTR>(F.lds, KM + (size_t)(b * NMEM) * D + head * 256, D, F.tid);
        __syncthreads();
        v4u pf[2][8]; float inv[2];
#pragma unroll
        for (int u = 0; u < 2; ++u) { const int q0 = b * SEQ + qg * 256 + u * 128 + F.wave * 16;
            bf16x8 qf[8];
#pragma unroll
            for (int ks = 0; ks < 8; ++ks) qf[ks] = *(const bf16x8*)(Q + (size_t)(q0 + fr) * D + head * 256 + ks * 32 + fq * 8);
            f32x4 sT[16];
            const LAS unsigned char* kbase = F.lds + fr * KSTR + fq * 16;
#pragma unroll
            for (int kt = 0; kt < 16; ++kt) { f32x4 a = {0, 0, 0, 0}; const LAS unsigned char* kp = kbase + kt * 16 * KSTR;
#pragma unroll
                for (int ks = 0; ks < 8; ++ks) { const bf16x8 kf = *(const LAS bf16x8*)(kp + ks * 64); a = __builtin_amdgcn_mfma_f32_16x16x32_bf16(kf, qf[ks], a, 0, 0, 0); }
                sT[kt] = a; if (kt & 1) __builtin_amdgcn_sched_barrier(0); }
            float mx = -3.0e38f;
#pragma unroll
            for (int kt = 0; kt < 16; ++kt) mx = fmaxf(fmaxf(fmaxf(mx, sT[kt].x), fmaxf(sT[kt].y, sT[kt].z)), sT[kt].w);
            mx = fmaxf(mx, shfl_xor_l(mx, 16, lane)); mx = fmaxf(mx, shfl_xor_l(mx, 32, lane));
            float sum = 0.f;
#pragma unroll
            for (int kt = 0; kt < 16; ++kt) { sT[kt].x = __expf(sT[kt].x - mx); sT[kt].y = __expf(sT[kt].y - mx); sT[kt].z = __expf(sT[kt].z - mx); sT[kt].w = __expf(sT[kt].w - mx); sum += (sT[kt].x + sT[kt].y) + (sT[kt].z + sT[kt].w); }
            sum += shfl_xor_l(sum, 16, lane); sum += shfl_xor_l(sum, 32, lane);
            inv[u] = 1.0f / sum;
#pragma unroll
            for (int kp = 0; kp < 8; ++kp) { v4u w; w.x = pk2(sT[2 * kp].x, sT[2 * kp].y); w.y = pk2(sT[2 * kp].z, sT[2 * kp].w); w.z = pk2(sT[2 * kp + 1].x, sT[2 * kp + 1].y); w.w = pk2(sT[2 * kp + 1].z, sT[2 * kp + 1].w); pf[u][kp] = w; }
            __builtin_amdgcn_sched_barrier(0);
        }
        __syncthreads();
        attn_stage<VSTR>(F.lds, VT + (size_t)(b * D + head * 256) * NMEM, NMEM, F.tid);
        __syncthreads();
#pragma unroll
        for (int u = 0; u < 2; ++u) { const int q0 = b * SEQ + qg * 256 + u * 128 + F.wave * 16;
#pragma unroll 2
            for (int dt = 0; dt < 16; ++dt) { f32x4 o = {0, 0, 0, 0}; const LAS unsigned char* vp = F.lds + (dt * 16 + fr) * VSTR + fq * 8;
#pragma unroll
                for (int kp = 0; kp < 8; ++kp) {
                    const v2u lo = *(const LAS v2u*)(vp + 64 * kp), hi = *(const LAS v2u*)(vp + 64 * kp + 32); v4u w; w.x = lo.x; w.y = lo.y; w.z = hi.x; w.w = hi.y;
                    o = __builtin_amdgcn_mfma_f32_16x16x32_bf16(__builtin_bit_cast(bf16x8, w), __builtin_bit_cast(bf16x8, pf[u][kp]), o, 0, 0, 0); }
                v2u w; w.x = pk2(o.x * inv[u], o.y * inv[u]); w.y = pk2(o.z * inv[u], o.w * inv[u]);
                *(v2u*)(AO + (size_t)(q0 + fr) * D + head * 256 + dt * 16 + 4 * fq) = w; __builtin_amdgcn_sched_barrier(0); } }
        __syncthreads();
    }
}

__device__ __forceinline__ void p_ln(const Frame& F, const float* g, const float* b, bool dummy) {
    const int gw = F.bid * NWAVES + F.wave, NGW = F.G * NWAVES, lane = F.lane; const bf16* P = (const bf16*)(F.ws + WS_PRE16); bf16* H16 = (bf16*)(F.ws + (dummy ? WS_Z + 128 * MiB : WS_H16));
    for (int r = gw; r < T; r += NGW) { f32x4 v[4];
#pragma unroll
        for (int j = 0; j < 4; ++j) v[j] = ld4bf(P + (size_t)r * D + 256 * j + 4 * lane);
        float mean, rstd; ln_stats(v, mean, rstd); ln_apply_store(v, mean, rstd, g, b, (float*)nullptr, H16 + (size_t)r * D, lane); }
}
__device__ __forceinline__ void p_ln_router(KArgs& A, const Frame& F, int l, bool dummy) {
    const int gw = F.bid * NWAVES + F.wave, NGW = F.G * NWAVES, lane = F.lane, tid = F.tid, fr = lane & 15, fq = lane >> 4;
    const bf16* H = (const bf16*)(F.ws + WS_PRE16); bf16* H16 = (bf16*)(F.ws + (dummy ? WS_Z + 128 * MiB : WS_H16)); int* TOKE = (int*)(F.ws + (dummy ? WS_Z + 200 * MiB : WS_TOKE)); float* TOKW = (float*)(F.ws + (dummy ? WS_Z + 201 * MiB : WS_TOKW));
    LAS v4u* TB = (LAS v4u*)F.lds;
    LAS float* PS = (LAS float*)(F.lds + 131072);
    volatile LAS unsigned* hist = F.MISC + MI_HIST;
    const float* rw = kin(A, I_ROUTER_W) + (size_t)l * D * NE; const float* rb = kin(A, I_ROUTER_B) + l * NE; const float* g = kin(A, I_LN2_G) + l * D; const float* bb = kin(A, I_LN2_B) + l * D;
    for (int en = tid; en < 32 * 2 * 64; en += NTHREADS) { const int ln = en & 63, et = (en >> 6) & 1, ks = en >> 7, efr = ln & 15, efq = ln >> 4; float hi[8], lo[8];
#pragma unroll
        for (int j = 0; j < 8; ++j) { const int d = 32 * ks + 8 * efq + j; const float v = g[d] * rw[d * NE + et * 16 + efr]; const float h = bf2f(f2bf(v)); hi[j] = h; lo[j] = v - h; }
        v4u wh, wl; wh.x = pk2(hi[0], hi[1]); wh.y = pk2(hi[2], hi[3]); wh.z = pk2(hi[4], hi[5]); wh.w = pk2(hi[6], hi[7]); wl.x = pk2(lo[0], lo[1]); wl.y = pk2(lo[2], lo[3]); wl.z = pk2(lo[4], lo[5]); wl.w = pk2(lo[6], lo[7]);
        TB[((ks * 2 + et) * 2 + 0) * 64 + ln] = wh; TB[((ks * 2 + et) * 2 + 1) * 64 + ln] = wl; }
    { const int e = tid & 31, part = tid >> 5; float sg = 0.f, sb = 0.f;
      for (int d = part * 64; d < part * 64 + 64; ++d) { const float w = rw[d * NE + e]; sg += g[d] * w; sb += bb[d] * w; }
      PS[part * 32 + e] = sg; PS[512 + part * 32 + e] = sb; }
    if (tid < NE) hist[tid] = 0u;
    __syncthreads();
    if (tid < NE) { float sg = 0.f, sb = 0.f;
#pragma unroll
        for (int p = 0; p < 16; ++p) { sg += PS[p * 32 + tid]; sb += PS[512 + p * 32 + tid]; }
        PS[1024 + tid] = sg; PS[1056 + tid] = sb + rb[tid]; }
    __syncthreads();
    const float cg0 = PS[1024 + fr], cg1 = PS[1024 + 16 + fr], cb0 = PS[1056 + fr], cb1 = PS[1056 + 16 + fr];
    for (int grp = gw; grp < T / 16; grp += NGW) { const int r0 = grp * 16; const bf16* xrow = H + (size_t)(r0 + fr) * D + 8 * fq;
        f32x4 acc0 = {0, 0, 0, 0}, acc1 = {0, 0, 0, 0}; float sum = 0.f, sq = 0.f;
#pragma unroll 2
        for (int ks = 0; ks < 32; ++ks) { const v4u xw = *(const v4u*)(xrow + 32 * ks); f32x4 xa, xb; unpk8(xw, xa, xb);
            sum += (xa.x + xa.y) + (xa.z + xa.w) + (xb.x + xb.y) + (xb.z + xb.w);
            sq += (xa.x * xa.x + xa.y * xa.y) + (xa.z * xa.z + xa.w * xa.w) + (xb.x * xb.x + xb.y * xb.y) + (xb.z * xb.z + xb.w * xb.w);
            const LAS v4u* tb = TB + (ks * 4) * 64 + lane; const v4u b0h = tb[0], b0l = tb[64], b1h = tb[128], b1l = tb[192];
            const bf16x8 Ah = __builtin_bit_cast(bf16x8, xw);
            acc0 = __builtin_amdgcn_mfma_f32_16x16x32_bf16(Ah, __builtin_bit_cast(bf16x8, b0h), acc0, 0, 0, 0); acc0 = __builtin_amdgcn_mfma_f32_16x16x32_bf16(Ah, __builtin_bit_cast(bf16x8, b0l), acc0, 0, 0, 0);
            acc1 = __builtin_amdgcn_mfma_f32_16x16x32_bf16(Ah, __builtin_bit_cast(bf16x8, b1h), acc1, 0, 0, 0); acc1 = __builtin_amdgcn_mfma_f32_16x16x32_bf16(Ah, __builtin_bit_cast(bf16x8, b1l), acc1, 0, 0, 0); }
        sum += shfl_xor_l(sum, 16, lane); sum += shfl_xor_l(sum, 32, lane); sq += shfl_xor_l(sq, 16, lane); sq += shfl_xor_l(sq, 32, lane);
        const float mean = sum * (1.f / D), rstd = 1.0f / sqrtf(fmaxf(sq * (1.f / D) - mean * mean, 0.f) + LN_EPS);
        float v0[4], v1[4];
#pragma unroll
        for (int reg = 0; reg < 4; ++reg) { const float rs = __builtin_bit_cast(float, shfl_idx_l(__builtin_bit_cast(int, rstd), 4 * fq + reg)), mn = __builtin_bit_cast(float, shfl_idx_l(__builtin_bit_cast(int, mean), 4 * fq + reg));
            v0[reg] = rs * acc0[reg] - rs * mn * cg0 + cb0; v1[reg] = rs * acc1[reg] - rs * mn * cg1 + cb1; }
        float wv[4][4]; int wi[4][4];
#pragma unroll
        for (int k = 0; k < 4; ++k) {
#pragma unroll
            for (int reg = 0; reg < 4; ++reg) { float bv = v0[reg]; int bi = fr; if (v1[reg] > bv) { bv = v1[reg]; bi = 16 + fr; }
#pragma unroll
                for (int o = 1; o < 16; o <<= 1) { const float ov = shfl_xor_l(bv, o, lane); const int oi = shfl_idx_l(bi, lane ^ o); if (ov > bv || (ov == bv && oi < bi)) { bv = ov; bi = oi; } }
                wv[k][reg] = bv; wi[k][reg] = bi; if (bi == fr) v0[reg] = -3.0e38f; if (bi == 16 + fr) v1[reg] = -3.0e38f; } }
        if (fr == 0) {
#pragma unroll
            for (int reg = 0; reg < 4; ++reg) { const int t = r0 + 4 * fq + reg; const float e1 = __expf(wv[1][reg] - wv[0][reg]), e2 = __expf(wv[2][reg] - wv[0][reg]), e3 = __expf(wv[3][reg] - wv[0][reg]), inv = 1.0f / (1.0f + e1 + e2 + e3);
                *(int4*)(TOKE + (size_t)t * 4) = make_int4(wi[0][reg], wi[1][reg], wi[2][reg], wi[3][reg]); *(f32x4*)(TOKW + (size_t)t * 4) = (f32x4){inv, e1 * inv, e2 * inv, e3 * inv};
#pragma unroll
                for (int k = 0; k < 4; ++k) __hip_atomic_fetch_add((LAS unsigned*)&hist[wi[k][reg]], 1u, __ATOMIC_RELAXED, __HIP_MEMORY_SCOPE_WORKGROUP); } }
        bf16* o16 = H16 + (size_t)(r0 + fr) * D + 8 * fq;
#pragma unroll 2
        for (int ks = 0; ks < 32; ++ks) { f32x4 xa, xb; unpk8(*(const v4u*)(xrow + 32 * ks), xa, xb);
            const f32x4 ga = *(const f32x4*)(g + 32 * ks + 8 * fq), gb = *(const f32x4*)(g + 32 * ks + 8 * fq + 4), ba = *(const f32x4*)(bb + 32 * ks + 8 * fq), bc = *(const f32x4*)(bb + 32 * ks + 8 * fq + 4);
            *(v4u*)(o16 + 32 * ks) = pk8((xa - mean) * rstd * ga + ba, (xb - mean) * rstd * gb + bc); }
    }
    __syncthreads();
    if (tid < NE && !dummy) { const unsigned c = hist[tid]; if (c) atomicAdd(F.ctl + CW_CNT + l * NE + tid, c); F.ctl[CW_WGH + (l * 512 + F.bid) * NE + tid] = c; }
}
__device__ __forceinline__ void moe_offsets(const Frame& F, int l) {
    if (F.tid == 0) { int acc = 0;
        for (int e = 0; e < NE; ++e) { F.MISC[MI_TOFF + e] = (unsigned)acc; const unsigned c = __hip_atomic_load(F.ctl + CW_CNT + l * NE + e, __ATOMIC_RELAXED, __HIP_MEMORY_SCOPE_AGENT); acc += (int)((c + 255u) >> 8); }
        F.MISC[MI_TOFF + NE] = (unsigned)acc; }
    __syncthreads();
}
__device__ __forceinline__ void p_moe_slots(const Frame& F, int l, int dummy) {
    const int gw = F.bid * NWAVES + F.wave, NGW = F.G * NWAVES, lane = F.lane;
    moe_offsets(F, l);
    const int* TOKE = (const int*)(F.ws + WS_TOKE); const float* TOKW = (const float*)(F.ws + WS_TOKW); int* TOKS = (int*)(F.ws + (dummy ? WS_END : WS_TOKS)); float* SLOTW = (float*)(F.ws + (dummy ? WS_END + 1 * MiB : WS_SLOTW));
    const bf16* H16 = (const bf16*)(F.ws + WS_H16); bf16* XG = (bf16*)(F.ws + (dummy ? WS_ACT : WS_XG)); unsigned* CUR = F.ctl + CW_CUR + l * NE + dummy * 256;
    if (F.tid < NE) { const unsigned c = F.ctl[CW_WGH + (l * 512 + F.bid) * NE + F.tid]; const unsigned base = c ? atomicAdd(CUR + F.tid, c) : 0u;
        F.MISC[MI_LBASE + F.tid] = F.MISC[MI_TOFF + F.tid] * 256u + base; F.MISC[MI_LCUR + F.tid] = 0u; }
    __syncthreads();
    for (int grp = gw; grp < T / 16; grp += NGW)
    for (int r = grp * 16; r < grp * 16 + 16; ++r) { int slot = 0;
        if (lane < 4) { const int e = TOKE[(size_t)r * 4 + lane]; const unsigned pos = __hip_atomic_fetch_add((LAS unsigned*)&F.MISC[MI_LCUR + e], 1u, __ATOMIC_RELAXED, __HIP_MEMORY_SCOPE_WORKGROUP); slot = (int)(F.MISC[MI_LBASE + e] + pos);
            TOKS[(size_t)r * 4 + lane] = slot; SLOTW[slot] = TOKW[(size_t)r * 4 + lane]; }
        const v4u a = *(const v4u*)(H16 + (size_t)r * D + 8 * lane), b = *(const v4u*)(H16 + (size_t)r * D + 512 + 8 * lane);
#pragma unroll
        for (int k = 0; k < 4; ++k) { const int sk = shfl_idx_l(slot, k); *(v4u*)(XG + (size_t)sk * D + 8 * lane) = a; *(v4u*)(XG + (size_t)sk * D + 512 + 8 * lane) = b; } }
}
__device__ __forceinline__ void p_moe_combine(KArgs& A, const Frame& F, int l, bool dummy) {
    const int gw = F.bid * NWAVES + F.wave, NGW = F.G * NWAVES, lane = F.lane;
    const bf16* H = (const bf16*)(F.ws + WS_H16); bf16* H16 = (bf16*)(F.ws + (dummy ? WS_Z + 128 * MiB : WS_H16)); const int* TOKS = (const int*)(F.ws + WS_TOKS); const bf16* YS = (const bf16*)(F.ws + WS_YS);
    const bool last = (l == NL - 1) && !dummy;
    for (int r = gw; r < T; r += NGW) { f32x4 v[4]; const int4 sl = *(const int4*)(TOKS + (size_t)r * 4);
#pragma unroll
        for (int j = 0; j < 4; ++j) { v[j] = ld4bf(H + (size_t)r * D + 256 * j + 4 * lane) * DN_ALPHA;
            const v2u y0 = *(const v2u*)(YS + (size_t)sl.x * D + 256 * j + 4 * lane), y1 = *(const v2u*)(YS + (size_t)sl.y * D + 256 * j + 4 * lane), y2 = *(const v2u*)(YS + (size_t)sl.z * D + 256 * j + 4 * lane), y3 = *(const v2u*)(YS + (size_t)sl.w * D + 256 * j + 4 * lane);
            v[j].x += (bf2f(y0.x & 0xffffu) + bf2f(y1.x & 0xffffu)) + (bf2f(y2.x & 0xffffu) + bf2f(y3.x & 0xffffu));
            v[j].y += (bf2f(y0.x >> 16) + bf2f(y1.x >> 16)) + (bf2f(y2.x >> 16) + bf2f(y3.x >> 16));
            v[j].z += (bf2f(y0.y & 0xffffu) + bf2f(y1.y & 0xffffu)) + (bf2f(y2.y & 0xffffu) + bf2f(y3.y & 0xffffu));
            v[j].w += (bf2f(y0.y >> 16) + bf2f(y1.y >> 16)) + (bf2f(y2.y >> 16) + bf2f(y3.y >> 16)); }
        float mean, rstd; ln_stats(v, mean, rstd);
        if (last) ln_apply_store(v, mean, rstd, kin(A, I_LN3_G) + l * D, kin(A, I_LN3_B) + l * D, kout(A) + (size_t)r * D, (bf16*)nullptr, lane);
        else ln_apply_store(v, mean, rstd, kin(A, I_LN3_G) + l * D, kin(A, I_LN3_B) + l * D, (float*)nullptr, H16 + (size_t)r * D, lane); }
}

constexpr int NPL = 18;
constexpr int NPHASES = 1 + NL * NPL;
#ifndef ONLY
#define ONLY -1
#endif
#define EN(j) (ONLY < 0 || ONLY == (j))
#define DUMMY(j) ((PROBE_PHASE == (j)) && (rep_ + 1 < PROBE_REPS))
#define REPS(j) for (int rep_ = 0; rep_ < ((PROBE_PHASE == (j)) ? PROBE_REPS : 1); ++rep_, __syncthreads())
__global__ void __launch_bounds__(NTHREADS, 2) fwd_kernel(Args args) {
    extern __shared__ __attribute__((aligned(16))) unsigned char lds_raw[];
    Frame F;
    F.lds = (LAS unsigned char*)lds_raw; F.MISC = (volatile LAS unsigned*)(F.lds + MISC_OFF);
    F.tid = threadIdx.x; F.lane = F.tid & 63; F.wave = __builtin_amdgcn_readfirstlane(F.tid >> 6); F.G = gridDim.x; F.bid = blockIdx.x;
    F.ws = (unsigned char*)(GAS unsigned char*)args.ws; F.ctl = (unsigned*)(F.ws + WS_CTL);
    for (int u = F.tid; u < (LDS_BYTES - MISC_OFF) / 4; u += NTHREADS) F.MISC[u] = 0u;
    __syncthreads();
    XcdBarrier bar; bar.bar = F.ctl + CW_BAR; bar.x = 0; bar.st = nullptr;
    const int lo = args.ph_lo, hi = args.ph_hi;
    if (hi - lo > 1) bar = xcd_barrier_post(F.ctl + CW_BAR, F.MISC + 8);
#define IN(k) (launder_i(lo) <= (k) && (k) < launder_i(hi))
#define SEAM(k) do { if (IN(k) && IN((k) + 1)) xcd_barrier(bar); } while (0)
#define PH_BEGIN KArgs& KA = *kargs(); unsigned char* ws = launder_p(args.ws); F.ws = ws; (void)KA; (void)ws; { int ln_; asm volatile("v_mbcnt_lo_u32_b32 %0, -1, 0\n\tv_mbcnt_hi_u32_b32 %0, -1, %0" : "=v"(ln_)); F.lane = ln_; } F.tid = F.wave * 64 + F.lane; F.bid = launder_i((int)blockIdx.x); F.G = launder_i((int)gridDim.x);

    if (EN(100) && IN(0)) REPS(100) { PH_BEGIN p_prologue(KA, F); } SEAM(0);
    if (PROBE_PHASE == 300) { for (int q_ = 0; q_ < 20; ++q_) xcd_barrier(bar); }

#pragma unroll 1
    for (int l_ = 0; l_ < NL; ++l_) {
        const int l = launder_i(l_); const int p0 = 1 + l * NPL;
        if (EN(0) && IN(p0 + 0)) REPS(0) { PH_BEGIN
            pg8::Gemm g{D, D, D}; pg8::StaticOrder S{(const bf16*)(ws + WS_H16), (const bf16*)(ws + WS_WINT) + (size_t)l * N_IN * D, D, D, T / 256, N_IN / 256, F.G, F.bid};
            if (PROBE_PHASE == 200) { for (int q_ = 0; q_ < PROBE_REPS - 1; ++q_) { EpiNull E0{0}; pg8::gemm_phase(F.lds, F.wave * 64 + my_lane(), g, S, E0); __syncthreads(); } }
            EpiIn E{l};
            pg8::gemm_phase(F.lds, F.wave * 64 + my_lane(), g, S, E);
        } SEAM(p0 + 0);
        if (EN(1) && IN(p0 + 1)) REPS(1) { PH_BEGIN p_mix1(KA, F, l); } SEAM(p0 + 1);
        if (EN(2) && IN(p0 + 2)) REPS(2) { PH_BEGIN
            { pg8::Gemm g{S5K, 1024, 1024}; pg8::BatchOrder S{(const bf16*)(ws + WS_AOUT), (const bf16*)(ws + WS_S5BC) + (size_t)l * 16 * 256 * 1024, S5K, 1024, NCHT / 256, 1, 16, F.G, F.bid, (size_t)NCHT * S5K, (size_t)256 * 1024};
              EpiXloc E{0}; pg8::gemm_phase(F.lds, F.wave * 64 + my_lane(), g, S, E); }
            __syncthreads();
            { pg8::Gemm g{D, D, D}; pg8::StaticOrder S{(const bf16*)(ws + WS_MEM16), (const bf16*)(ws + WS_WKT) + (size_t)l * D * D, D, D, NB * NMEM / 256, D / 256, F.G, F.bid};
              EpiBf16 E{(unsigned)(WS_KM16 / MiB), 1.0f}; pg8::gemm_phase(F.lds, F.wave * 64 + my_lane(), g, S, E); }
            __syncthreads();
            { pg8::Gemm g{D, D, D}; pg8::StaticOrder S{(const bf16*)(ws + WS_MEM16), (const bf16*)(ws + WS_WVT) + (size_t)l * D * D, D, D, NB * NMEM / 256, D / 256, F.G, F.bid};
              EpiVT E{0}; pg8::gemm_phase(F.lds, F.wave * 64 + my_lane(), g, S, E); }
            __syncthreads();
            { pg8::Gemm g{256, 256, 256}; pg8::StaticOrder S{(const bf16*)(ws + WS_LA16), (const bf16*)(ws + WS_LWT) + (size_t)l * 768 * 256, 256, 256, T / 256, 3, F.G, F.bid};
              EpiLora E{l}; pg8::gemm_phase(F.lds, F.wave * 64 + my_lane(), g, S, E); }
        } SEAM(p0 + 2);
        if (EN(3) && IN(p0 + 3)) REPS(3) { PH_BEGIN
            for (int q_ = 0; q_ < ((PROBE_PHASE == 301) ? PROBE_REPS : 1); ++q_) p_s5_chain(KA, F, l);
            for (int q_ = 0; q_ < ((PROBE_PHASE == 302) ? PROBE_REPS : 1); ++q_) p_rw_chunks(KA, F, l); } SEAM(p0 + 3);
        if (EN(4) && IN(p0 + 4)) REPS(4) { PH_BEGIN
            p_chain_compose(F);
            pg8::Gemm g{S5K, S5K, S5K}; pg8::BatchOrder S{(const bf16*)(ws + WS_AOUT), (const bf16*)(ws + WS_S5BT) + (size_t)l * 16 * 1024 * S5K, S5K, S5K, NCHT / 256, 1024 / 256, 16, F.G, F.bid, (size_t)NCHT * S5K, (size_t)1024 * S5K};
            EpiS5Y E{l}; pg8::gemm_phase(F.lds, F.wave * 64 + my_lane(), g, S, E);
        } SEAM(p0 + 4);
        if (EN(5) && IN(p0 + 5)) REPS(5) { PH_BEGIN
            const int nchain = (F.G >= 128) ? 64 : 0;
            if (F.bid < nchain) { if (F.wave == 0) p_chain_blocks(F, F.bid, nchain); }
            else {
                if (nchain == 0) { p_chain_blocks(F, F.bid * NWAVES + F.wave, F.G * NWAVES); __syncthreads(); }
                pg8::Gemm g{256, 256, 256}; pg8::StaticOrder S{(const bf16*)(ws + WS_YD16), (const bf16*)(ws + WS_GLUT) + (size_t)l * 256 * 256, 256, 256, T / 256, 1, F.G - nchain, F.bid - nchain};
                EpiGlu E{l}; pg8::gemm_phase(F.lds, F.wave * 64 + my_lane(), g, S, E);
            }
        } SEAM(p0 + 5);
        if (EN(6) && IN(p0 + 6)) REPS(6) { PH_BEGIN
            for (int bb = F.bid; bb < 16 * NBLK; bb += F.G) {
                if (F.wave < 4) chain_inblock(F, bb, F.wave);
                VM_WAIT(); __syncthreads();
                rw_out_task(KA, F, l, bb * CB + F.wave);
                __syncthreads();
            }
        } SEAM(p0 + 6);
        if (EN(7) && IN(p0 + 7)) REPS(7) { PH_BEGIN
            pg8::Gemm g{D, 256, 256}; pg8::BranchOrder S{(const bf16*)(ws + WS_O16), (const bf16*)(ws + WS_BRT) + (size_t)l * 4 * D * 256, T / 256, D / 256, F.G, F.bid};
            EpiBranch E{0}; pg8::gemm_phase(F.lds, F.wave * 64 + my_lane(), g, S, E);
        } SEAM(p0 + 7);
        if (EN(8) && IN(p0 + 8)) REPS(8) { PH_BEGIN
            pg8::Gemm g{D, D, D}; pg8::StaticOrder S{(const bf16*)(ws + WS_MG16), (const bf16*)(ws + WS_WOUTT) + (size_t)l * D * D, D, D, T / 256, D / 256, F.G, F.bid};
            EpiResid E{0}; pg8::gemm_phase(F.lds, F.wave * 64 + my_lane(), g, S, E);
        } SEAM(p0 + 8);
        if (EN(9) && IN(p0 + 9)) REPS(9) { PH_BEGIN p_ln(F, kin(KA, I_LN1_G) + l * D, kin(KA, I_LN1_B) + l * D, DUMMY(9)); } SEAM(p0 + 9);
        if (EN(10) && IN(p0 + 10)) REPS(10) { PH_BEGIN
            pg8::Gemm g{D, D, D}; pg8::StaticOrder S{(const bf16*)(ws + WS_H16), (const bf16*)(ws + WS_WQT) + (size_t)l * D * D, D, D, T / 256, D / 256, F.G, F.bid};
            EpiBf16 E{(unsigned)(WS_Q16 / MiB), 0.0625f}; pg8::gemm_phase(F.lds, F.wave * 64 + my_lane(), g, S, E);
        } SEAM(p0 + 10);
        if (EN(11) && IN(p0 + 11)) REPS(11) { PH_BEGIN p_attn(F); } SEAM(p0 + 11);
        if (EN(12) && IN(p0 + 12)) REPS(12) { PH_BEGIN
            pg8::Gemm g{D, D, D}; pg8::StaticOrder S{(const bf16*)(ws + WS_AO16), (const bf16*)(ws + WS_WOT) + (size_t)l * D * D, D, D, T / 256, D / 256, F.G, F.bid};
            EpiResid E{0}; pg8::gemm_phase(F.lds, F.wave * 64 + my_lane(), g, S, E);
        } SEAM(p0 + 12);
        if (EN(13) && IN(p0 + 13)) REPS(13) { PH_BEGIN p_ln_router(KA, F, l, DUMMY(13)); } SEAM(p0 + 13);
        if (EN(14) && IN(p0 + 14)) REPS(14) { PH_BEGIN p_moe_slots(F, l, DUMMY(14) ? (rep_ + 1) : 0); } SEAM(p0 + 14);
        if (EN(15) && IN(p0 + 15)) REPS(15) { PH_BEGIN
            moe_offsets(F, l);
            pg8::Gemm g{D, D, D}; pg8::MoeOrder S{(const bf16*)(ws + WS_XG), (const bf16*)(ws + WS_W1T) + (size_t)l * NE * 2048 * D, D, D, 2048 / 256, F.G, F.bid, (size_t)2048 * D, (const LAS int*)(F.MISC + MI_TOFF)};
            if (PROBE_PHASE == 201) { for (int q_ = 0; q_ < PROBE_REPS - 1; ++q_) { EpiNull E0{0}; pg8::gemm_phase(F.lds, F.wave * 64 + my_lane(), g, S, E0); __syncthreads(); } }
            EpiSwiglu E{l}; pg8::gemm_phase(F.lds, F.wave * 64 + my_lane(), g, S, E);
        } SEAM(p0 + 15);
        if (EN(16) && IN(p0 + 16)) REPS(16) { PH_BEGIN
            moe_offsets(F, l);
            pg8::Gemm g{DFF, DFF, DFF}; pg8::MoeOrder S{(const bf16*)(ws + WS_ACT), (const bf16*)(ws + WS_W2T) + (size_t)l * NE * D * DFF, DFF, DFF, D / 256, F.G, F.bid, (size_t)D * DFF, (const LAS int*)(F.MISC + MI_TOFF)};
            EpiMoeOut E{l}; pg8::gemm_phase(F.lds, F.wave * 64 + my_lane(), g, S, E);
        } SEAM(p0 + 16);
        if (EN(17) && IN(p0 + 17)) REPS(17) { PH_BEGIN p_moe_combine(KA, F, l, DUMMY(17)); } SEAM(p0 + 17);
    }
#undef IN
#undef SEAM
}

extern "C" void kernel_launch(void* const* d_in, const int* in_sizes, int n_in, void* d_out, int out_size, void* d_ws, size_t ws_size, hipStream_t stream) {
    static int grid = 0;
    if (grid == 0) {
        if (n_in != 50 || ws_size < WS_END) { fprintf(stderr, "kernel_launch: unexpected n_in %d / ws_size %zu\n", n_in, ws_size); grid = -1; return; }
        int dev = 0, cus = 0, per_cu = 0;
        if (hipGetDevice(&dev) != hipSuccess || hipDeviceGetAttribute(&cus, hipDeviceAttributeMultiprocessorCount, dev) != hipSuccess) { grid = -1; return; }
        if (hipFuncSetAttribute((const void*)fwd_kernel, hipFuncAttributeMaxDynamicSharedMemorySize, LDS_BYTES) != hipSuccess) { fprintf(stderr, "kernel_launch: hipFuncSetAttribute failed\n"); grid = -1; return; }
        if (hipOccupancyMaxActiveBlocksPerMultiprocessor(&per_cu, (const void*)fwd_kernel, NTHREADS, LDS_BYTES) != hipSuccess || per_cu < 1) { fprintf(stderr, "kernel_launch: occupancy query says %d\n", per_cu); }
        (void)hipGetLastError();
        grid = cus;
    }
    if (grid < 0) return;
    (void)hipMemsetAsync((char*)d_ws + WS_CTL, 0, CTL_ZERO_BYTES, stream);
    Args a{};
    for (int i = 0; i < 50; ++i) a.in[i] = (const float*)d_in[i];
    a.out = (float*)d_out; a.ws = (unsigned char*)d_ws;
#if N_LAUNCHES == 1
    a.ph_lo = 0; a.ph_hi = NPHASES;
    hipLaunchKernelGGL(fwd_kernel, dim3(grid), dim3(NTHREADS), LDS_BYTES, stream, a);
#else
    for (int p = 0; p < NPHASES; ++p) { a.ph_lo = p; a.ph_hi = p + 1; hipLaunchKernelGGL(fwd_kernel, dim3(grid), dim3(NTHREADS), LDS_BYTES, stream, a); }
#endif
}
```

```cpp
#include <hip/hip_runtime.h>
#include <cstdio>
#include <cstdint>

#ifndef N_LAUNCHES
#define N_LAUNCHES 1
#endif

#ifndef PROBE_PHASE
#define PROBE_PHASE -1
#endif
#ifndef PROBE_REPS
#define PROBE_REPS 3
#endif
#define GAS __attribute__((address_space(1)))
#define LAS __attribute__((address_space(3)))
typedef unsigned short bf16;
typedef unsigned v4u __attribute__((ext_vector_type(4)));
typedef unsigned v2u __attribute__((ext_vector_type(2)));
typedef float f32x4 __attribute__((ext_vector_type(4)));
typedef float f32x2 __attribute__((ext_vector_type(2)));
typedef short bf16x8 __attribute__((ext_vector_type(8)));
typedef short bf16x4 __attribute__((ext_vector_type(4)));

constexpr int NL = 2, NB = 4, SEQ = 8192, T = NB * SEQ, D = 1024;
constexpr int NMEM = 256;
constexpr int OFF_B = 768, OFF_C = 1280, OFF_D = 2304, OFF_G = 2560, N_IN = 6656, ZLD = 2560;
constexpr int NE = 32, TOPK = 4, DFF = 1024;
constexpr int CH = 64;
constexpr int NCH = SEQ / CH;
constexpr int NCHT = T / CH;
constexpr int S5K = 1152;
constexpr int SLOT_ROWS = T * TOPK + NE * 256;
constexpr float LN_EPS = 1e-5f, RW_LN_EPS = 64e-5f;
constexpr float DN_ALPHA = 1.41421356237309515f;

constexpr size_t MiB = 1u << 20;
constexpr size_t WS_CTL = 0, CTL_ZERO_BYTES = 1 * MiB;
constexpr size_t WS_W1T = 2 * MiB;
constexpr size_t WS_W2T = 258 * MiB;
constexpr size_t WS_WINT = 386 * MiB;
constexpr size_t WS_BRT = 412 * MiB;
constexpr size_t WS_WOUTT = 416 * MiB, WS_WQT = 420 * MiB, WS_WKT = 424 * MiB, WS_WVT = 428 * MiB, WS_WOT = 432 * MiB;
constexpr size_t WS_GLUT = 436 * MiB;
constexpr size_t WS_MEM16 = 437 * MiB;
constexpr size_t WS_S5BT = 440 * MiB;
constexpr size_t WS_S5BC = 512 * MiB;
constexpr size_t WS_PRE16 = 528 * MiB;
constexpr size_t WS_H16 = 656 * MiB;
constexpr size_t WS_Z = 720 * MiB;
constexpr size_t WS_XG = 720 * MiB;
constexpr size_t WS_SG = 1040 * MiB;
constexpr size_t WS_YS = 1040 * MiB;
constexpr size_t WS_O16 = 1312 * MiB, WS_MG16 = 1376 * MiB, WS_Q16 = 1440 * MiB, WS_AO16 = 1504 * MiB;
constexpr size_t WS_LA16 = 1568 * MiB;
constexpr size_t WS_DEC = 1584 * MiB, WS_AV = 1616 * MiB;
constexpr size_t WS_LWT = 2012 * MiB;
constexpr size_t WS_ACT = 1568 * MiB;
constexpr size_t WS_QH = 1760 * MiB, WS_YL = 1792 * MiB, WS_GC = 1824 * MiB, WS_HC = 1856 * MiB, WS_SC = 1888 * MiB, WS_RWG = 1920 * MiB;
constexpr size_t WS_RK = 1952 * MiB;
constexpr size_t WS_AOUT = 1954 * MiB;
constexpr size_t WS_XLOC = 1972 * MiB;
constexpr size_t WS_YD16 = 1976 * MiB;
constexpr size_t WS_KM16 = 1992 * MiB, WS_VMT16 = 1994 * MiB;
constexpr size_t WS_TOKE = 1996 * MiB, WS_TOKW = 1997 * MiB, WS_TOKS = 1998 * MiB, WS_SLOTW = 1999 * MiB;
constexpr size_t WS_GB = 2000 * MiB, WS_HB = 2004 * MiB, WS_SB = 2008 * MiB;
constexpr size_t WS_END = 2014 * MiB;
static_assert(WS_XG + (size_t)SLOT_ROWS * D * 2 <= WS_SG && WS_YS + (size_t)SLOT_ROWS * D * 2 <= WS_O16 && WS_ACT + (size_t)SLOT_ROWS * D * 2 <= WS_RK, "overlays");
constexpr int CW_BAR = 4096;
constexpr int CW_CNT = 16384;
constexpr int CW_CUR = 16384 + 128;
constexpr int CW_WGH = 65536;

constexpr int LDS_BYTES = 163840;
constexpr int MISC_OFF = LDS_BYTES - 1024;
constexpr int RING_BYTES = 131072;
constexpr int NWAVES = 8, NTHREADS = 512;

#define LDS_WAIT() asm volatile("s_waitcnt lgkmcnt(0)" ::: "memory")
#define VM_WAIT() asm volatile("s_waitcnt vmcnt(0)" ::: "memory")
__device__ __forceinline__ unsigned f2bf(float f) { unsigned u = __float_as_uint(f); return (u + 0x7fffu + ((u >> 16) & 1u)) >> 16; }
__device__ __forceinline__ unsigned pk2(float lo, float hi) { unsigned r; asm("v_cvt_pk_bf16_f32 %0, %1, %2" : "=v"(r) : "v"(lo), "v"(hi)); return r; }
__device__ __forceinline__ float bf2f(unsigned h) { return __uint_as_float(h << 16); }
__device__ __forceinline__ float sigmoidf_(float x) { return __builtin_amdgcn_rcpf(1.0f + __expf(-x)); }
__device__ __forceinline__ int my_lane() { int l; asm volatile("v_mbcnt_lo_u32_b32 %0, -1, 0\n\tv_mbcnt_hi_u32_b32 %0, -1, %0" : "=v"(l)); return l; }
__device__ __forceinline__ float shfl_xor_l(float v, int o, int lane) { return __builtin_bit_cast(float, __builtin_amdgcn_ds_bpermute((lane ^ o) << 2, __builtin_bit_cast(int, v))); }
__device__ __forceinline__ int shfl_idx_l(int v, int src) { return __builtin_amdgcn_ds_bpermute(src << 2, v); }
__device__ __forceinline__ void fmac_(float& c, float a, float b) { asm("v_fmac_f32 %0, %1, %2" : "+v"(c) : "v"(a), "v"(b)); }
template <int R> __device__ __forceinline__ void fmac_bc(float& c, float op, float x) { asm("v_fmac_f32_dpp %0, %1, %2 row_newbcast:%3 row_mask:0xf bank_mask:0xf" : "+v"(c) : "v"(op), "v"(x), "n"(R)); }
__device__ __forceinline__ float wave_sum(float v) {
    const int ln = my_lane();
#pragma unroll
    for (int o = 1; o < 64; o <<= 1) v += shfl_xor_l(v, o, ln);
    return v;
}

#define XB_TMO      128
#define XB_XCNT(j)  (256  + 64 * (j))
#define XB_XSUB(j)  (1280 + 64 * (j))
#define XB_XGEN(j)  (2304 + 64 * (j))
#define XB_TOP      3328
#define XB_TOPGEN   3392
#define XCD_BAR_WORDS 3456
#define XB_SPIN_CAP (1u << 24)
__device__ __forceinline__ unsigned xb_ld(unsigned* p)              { return __hip_atomic_load(p, __ATOMIC_RELAXED, __HIP_MEMORY_SCOPE_AGENT); }
__device__ __forceinline__ unsigned xb_add(unsigned* p, unsigned v) { return __hip_atomic_fetch_add(p, v, __ATOMIC_RELAXED, __HIP_MEMORY_SCOPE_AGENT); }
__device__ __forceinline__ unsigned xb_xcc_id() { return (unsigned)__builtin_amdgcn_s_getreg((3 << 11) | 20) & 0xFu; }
#define XB_SPIN(cond, bar) do { unsigned _sp = 0; while (cond) { __builtin_amdgcn_s_sleep(1); \
    if ((++_sp & 255u) == 0u) { if (xb_ld(&(bar)[XB_TMO])) break; if (_sp > XB_SPIN_CAP) { atomicAdd(&(bar)[XB_TMO], 1u); break; } } } } while (0)
struct XcdBarrier { unsigned* bar; unsigned x; volatile LAS unsigned* st; };
__device__ __forceinline__ XcdBarrier xcd_barrier_post(unsigned* bar, volatile LAS unsigned* st) {
    XcdBarrier b; b.bar = bar; b.x = xb_xcc_id(); b.st = st;
    if (threadIdx.x == 0) (void)xb_add(&bar[XB_XCNT(b.x)], 1u);
    return b;
}
__device__ __forceinline__ void xcd_barrier_complete(unsigned* bar, unsigned x, unsigned& nloc, unsigned& nx) {
    const unsigned G = gridDim.x * gridDim.y * gridDim.z;
    unsigned sum, cnt, mine, sp = 0u;
    for (;;) {
        sum = 0u; cnt = 0u; mine = 0u;
#pragma unroll
        for (unsigned j = 0; j < 16; ++j) { const unsigned c = xb_ld(&bar[XB_XCNT(j)]); sum += c; cnt += (c > 0u) ? 1u : 0u; mine = (j == x) ? c : mine; }
        if (sum == G) break;
        __builtin_amdgcn_s_sleep(1);
        if ((++sp & 255u) == 0u) { if (xb_ld(&bar[XB_TMO])) break; if (sp > XB_SPIN_CAP) { atomicAdd(&bar[XB_TMO], 1u); break; } }
    }
    nloc = mine > 0u ? mine : 1u; nx = cnt > 0u ? cnt : 1u;
}
__device__ __forceinline__ void xcd_barrier(const XcdBarrier& b) {
    asm volatile("s_waitcnt vmcnt(0)" ::: "memory");
    __syncthreads();
    if (threadIdx.x == 0) {
        unsigned* bar = b.bar; unsigned bx = b.x;
        asm volatile("" : "+s"(bar), "+s"(bx));
        __builtin_amdgcn_s_waitcnt(0);
        unsigned nloc = b.st[0], nx = b.st[1];
        if (nloc == 0u) { xcd_barrier_complete(bar, bx, nloc, nx); b.st[0] = nloc; b.st[1] = nx; }
        const unsigned old = xb_add(&bar[XB_XSUB(bx)], 1u);
        const unsigned gen = old / nloc;
        if (old + 1u == (gen + 1u) * nloc) {
            __builtin_amdgcn_fence(__ATOMIC_RELEASE, "agent");
            asm volatile("s_waitcnt vmcnt(0)" ::: "memory");
            const unsigned og = xb_add(&bar[XB_TOP], 1u);
            const unsigned tg = og / nx;
            if (og + 1u == (tg + 1u) * nx) xb_add(&bar[XB_TOPGEN], 1u);
            else XB_SPIN(xb_ld(&bar[XB_TOPGEN]) == tg, bar);
            __builtin_amdgcn_fence(__ATOMIC_ACQUIRE, "agent");
            xb_add(&bar[XB_XGEN(bx)], 1u);
            asm volatile("s_waitcnt vmcnt(0)" ::: "memory");
        } else {
            XB_SPIN(xb_ld(&bar[XB_XGEN(bx)]) == gen, bar);
            __builtin_amdgcn_fence(__ATOMIC_ACQUIRE, "agent");
            asm volatile("s_waitcnt vmcnt(0)" ::: "memory");
        }
    }
    __syncthreads();
}

namespace pg8 {
constexpr int BM = 256, BK = 64, HALF = 128, HTB = HALF * BK * 2, STAGE_BYTES = 8 * HTB, NXCD = 8, WGM = 8;
__host__ __device__ __forceinline__ int lds_byte(int r, int c) { const int st = (r >> 4) * 2 + (c >> 5), rr = r & 15, cc = c & 31, ob = rr * 64 + cc * 2; return st * 1024 + (ob ^ (((ob >> 9) & 1) << 5)); }
__host__ __device__ __forceinline__ int perm32(int rho) { const int n = rho >> 4, i = rho & 15; return 8 * (i >> 2) + 4 * n + (i & 3); }
__host__ __device__ __forceinline__ void stage_rc(int b, int& R, int& C) { const int st = b / 1024, sb = b % 1024, swz = sb ^ (((sb >> 9) & 1) << 5); R = (st >> 1) * 16 + swz / 64; C = (st & 1) * 32 + (swz % 64) / 2; }
struct Unit { int pm, pn, e; };
struct Gemm { int lda, ldb, K; };

__device__ __forceinline__ bool static_tile(int i, int G, int c, int nM, int nN, int& pm, int& pn) {
    const int nwg = nM * nN; const long L = (long)i * G + c; if (L >= nwg) return false;
    int wgid = (int)L; { const int q = nwg / NXCD, r = nwg % NXCD, xcd = wgid % NXCD, off = wgid / NXCD; wgid = (xcd < r ? xcd * (q + 1) : r * (q + 1) + (xcd - r) * q) + off; }
    const int nig = WGM * nN, gid = wgid / nig, fm = gid * WGM, gsz = (nM - fm) < WGM ? (nM - fm) : WGM;
    pm = fm + ((wgid % nig) % gsz); pn = (wgid % nig) / gsz; return true;
}
struct StaticOrder {
    const bf16* A; const bf16* Bt; int lda, ldb, nM, nN, G, c;
    __device__ __forceinline__ bool next(int i, Unit& u) const { u.e = 0; return static_tile(i, G, c, nM, nN, u.pm, u.pn); }
    __device__ __forceinline__ const char* a_base(const Unit& u) const { return (const char*)(A + (size_t)u.pm * BM * lda); }
    __device__ __forceinline__ const char* b_base(const Unit& u) const { return (const char*)(Bt + (size_t)u.pn * BM * ldb); }
};
struct BatchOrder {
    const bf16* A; const bf16* Bt; int lda, ldb, nM, nN, nb, G, c; size_t sA, sB;
    __device__ __forceinline__ bool next(int i, Unit& u) const {
        const long L = (long)i * G + c; const int per = nM * nN; if (L >= (long)per * nb) return false;
        u.e = (int)(L / per); const int r = (int)(L % per); u.pn = r / nM; u.pm = r % nM; return true; }
    __device__ __forceinline__ const char* a_base(const Unit& u) const { return (const char*)(A + (size_t)u.e * sA + (size_t)u.pm * BM * lda); }
    __device__ __forceinline__ const char* b_base(const Unit& u) const { return (const char*)(Bt + (size_t)u.e * sB + (size_t)u.pn * BM * ldb); }
};
struct BranchOrder {
    const bf16* A; const bf16* Bt; int nM, nN, G, c;
    __device__ __forceinline__ bool next(int i, Unit& u) const { u.e = i & 3; return static_tile(i >> 2, G, c, nM, nN, u.pm, u.pn); }
    __device__ __forceinline__ const char* a_base(const Unit& u) const { return (const char*)(A + (size_t)u.pm * BM * D + u.e * 256); }
    __device__ __forceinline__ const char* b_base(const Unit& u) const { return (const char*)(Bt + (size_t)u.e * D * 256 + (size_t)u.pn * BM * 256); }
};
struct MoeOrder {
    const bf16* A; const bf16* Bt; int lda, ldb, nN, G, c; size_t sB; const LAS int* toff;
    __device__ __forceinline__ bool next(int i, Unit& u) const {
        const int nt = toff[NE]; int mt;
        const int Gx = G >> 3;
        if ((G & 7) == 0 && (Gx % nN) == 0) {
            const int per = Gx / nN, x = c & 7, y = c >> 3;
            mt = i * 8 * per + x * per + y / nN; u.pn = y % nN; if (mt >= nt) return false;
        } else { const long L = (long)i * G + c; if (L >= (long)nt * nN) return false; mt = (int)(L / nN); u.pn = (int)(L % nN); }
        u.pm = mt; int e = 0;
#pragma unroll 1
        for (int k = 1; k < NE; ++k) e += (toff[k] <= mt) ? 1 : 0;
        u.e = e; return true; }
    __device__ __forceinline__ const char* a_base(const Unit& u) const { return (const char*)(A + (size_t)u.pm * BM * lda); }
    __device__ __forceinline__ const char* b_base(const Unit& u) const { return (const char*)(Bt + (size_t)u.e * sB + (size_t)u.pn * BM * ldb); }
};

template <class F> __device__ __forceinline__ void epi_foreach(const f32x4 (&acc)[2][2][4][2], const Unit& u, int wr, int wc, int fr, int fq, const F& f) {
#pragma unroll
    for (int ai = 0; ai < 2; ++ai)
#pragma unroll
        for (int m = 0; m < 4; ++m) { const int row = u.pm * BM + ai * HALF + wr * 64 + m * 16 + fr;
#pragma unroll
            for (int bj = 0; bj < 2; ++bj)
#pragma unroll
                for (int n = 0; n < 2; ++n) f(row, u.pn * BM + bj * HALF + wc * 32 + n * 16 + 4 * fq, acc[ai][bj][m][n]);
            if (m == 3) __builtin_amdgcn_sched_barrier(0); }
}

template <class F> __device__ __forceinline__ void epi_foreach8(const f32x4 (&acc)[2][2][4][2], const Unit& u, int wr, int wc, int fr, int fq, const F& f) {
#pragma unroll
    for (int ai = 0; ai < 2; ++ai)
#pragma unroll
        for (int m = 0; m < 4; ++m) { const int row = u.pm * BM + ai * HALF + wr * 64 + m * 16 + fr;
#pragma unroll
            for (int bj = 0; bj < 2; ++bj) f(row, u.pn * BM + bj * HALF + wc * 32 + 8 * fq, acc[ai][bj][m][0], acc[ai][bj][m][1]);
            if (m == 3) __builtin_amdgcn_sched_barrier(0); }
}
template <class Epi, class Sched, bool ALIGN_EPI = true, bool SP2 = true>
__device__ __forceinline__ void gemm_phase(LAS unsigned char* lds, const int tid, const Gemm g, const Sched& S, const Epi& E) {
    const int wid = __builtin_amdgcn_readfirstlane(tid >> 6), lane = tid & 63, wr = wid >> 2, wc = wid & 3, fr = lane & 15, fq = lane >> 4;
    const int K = g.K, nt = K / BK;
    unsigned voffA[2], voffB[2];
#pragma unroll
    for (int i = 0; i < 2; ++i) { int R, C; stage_rc(tid * 16 + i * 8192, R, C);
        const int Rb = Epi::PERM ? ((R & ~31) + perm32(R & 31)) : R;
        voffA[i] = (unsigned)(R * g.lda + C) * 2u; voffB[i] = (unsigned)(Rb * g.ldb + C) * 2u; }
    const size_t kstep = (size_t)(BK * 2);
    const size_t hstepA = (size_t)HALF * g.lda * 2, hstepB = (size_t)HALF * g.ldb * 2;
    const unsigned ldsw = (unsigned)wid * 1024u;
    const int aoff = lds_byte(wr * 64 + fr, fq * 8), boff = lds_byte(wc * 32 + fr, fq * 8);
#define PG8_SA(b, h) (((b) * 2 + (h)) * HTB)
#define PG8_SB(b, h) ((4 + (b) * 2 + (h)) * HTB)
#define PG8_STAGE(bufoff, gbase, voff) do { _Pragma("unroll") for (int _i = 0; _i < 2; ++_i) \
        __builtin_amdgcn_global_load_lds((const unsigned*)((const char*)(gbase) + (voff)[_i]), (LAS unsigned*)(lds + (bufoff) + ldsw + _i * 8192), 16, 0, 0); } while (0)
#define PG8_LDA(dst, b, h) do { _Pragma("unroll") for (int m = 0; m < 4; ++m) _Pragma("unroll") for (int k = 0; k < 2; ++k) dst[m][k] = *(const LAS bf16x8*)(lds + PG8_SA(b, h) + aoff + m * 2048 + k * 1024); } while (0)
#define PG8_LDB(dst, b, h) do { _Pragma("unroll") for (int n = 0; n < 2; ++n) _Pragma("unroll") for (int k = 0; k < 2; ++k) dst[n][k] = *(const LAS bf16x8*)(lds + PG8_SB(b, h) + boff + n * 2048 + k * 1024); } while (0)
#define PG8_MMA(ai, bj, At, Bt) do { __builtin_amdgcn_s_setprio(1); _Pragma("unroll") for (int m = 0; m < 4; ++m) _Pragma("unroll") for (int n = 0; n < 2; ++n) _Pragma("unroll") for (int k = 0; k < 2; ++k) \
        acc[ai][bj][m][n] = __builtin_amdgcn_mfma_f32_16x16x32_bf16(Bt[n][k], At[m][k], acc[ai][bj][m][n], 0, 0, 0); __builtin_amdgcn_s_setprio(0); } while (0)
#define PG8_WAIT_V(n) asm volatile("s_waitcnt vmcnt(" #n ")" ::: "memory")
#define PG8_WAIT_L(n) asm volatile("s_waitcnt lgkmcnt(" #n ")" ::: "memory")
#define PG8_BAR __builtin_amdgcn_s_barrier()
#define PG8_SCHED __builtin_amdgcn_sched_barrier(0)
    Unit cur, nxt; int ui = 0;
    if (!S.next(0, cur)) return;
    f32x4 acc[2][2][4][2];
#pragma unroll
    for (int a = 0; a < 2; ++a)
#pragma unroll
        for (int b = 0; b < 2; ++b)
#pragma unroll
            for (int m = 0; m < 4; ++m)
#pragma unroll
                for (int n = 0; n < 2; ++n) acc[a][b][m][n] = (f32x4){0.f, 0.f, 0.f, 0.f};
    bf16x8 At[4][2], B0[2][2], B1[2][2];
    const char* cA = S.a_base(cur); const char* cB = S.b_base(cur);
    if constexpr (SP2) {
        PG8_STAGE(PG8_SB(0, 0), cB, voffB); PG8_STAGE(PG8_SB(0, 1), cB + hstepB, voffB); PG8_STAGE(PG8_SA(0, 0), cA, voffA); PG8_STAGE(PG8_SA(0, 1), cA + hstepA, voffA);
        if (wr == 1) PG8_BAR;
        PG8_WAIT_V(2); PG8_BAR;
        PG8_STAGE(PG8_SB(1, 0), cB + kstep, voffB); PG8_STAGE(PG8_SA(1, 0), cA + kstep, voffA); PG8_STAGE(PG8_SB(1, 1), cB + hstepB + kstep, voffB);
        PG8_WAIT_V(6); PG8_BAR;
    } else {
        PG8_STAGE(PG8_SB(0, 0), cB, voffB); PG8_STAGE(PG8_SA(0, 0), cA, voffA); PG8_STAGE(PG8_SB(0, 1), cB + hstepB, voffB); PG8_STAGE(PG8_SA(0, 1), cA + hstepA, voffA);
        if (wr == 1) PG8_BAR;
        PG8_WAIT_V(4); PG8_BAR;
        PG8_STAGE(PG8_SB(1, 0), cB + kstep, voffB); PG8_STAGE(PG8_SA(1, 0), cA + kstep, voffA); PG8_STAGE(PG8_SB(1, 1), cB + hstepB + kstep, voffB);
        PG8_WAIT_V(6); PG8_BAR;
    }
    for (;;) {
        const bool has_next = S.next(ui + 1, nxt);
        const char* nA = has_next ? S.a_base(nxt) : cA; const char* nB = has_next ? S.b_base(nxt) : cB;
        for (int t = 0; t < nt; t += 2) {
            const bool last = (t == nt - 2);
            const char* a1 = cA + (size_t)(t + 1) * kstep;
            const char* a2 = last ? nA : cA + (size_t)(t + 2) * kstep; const char* b2 = last ? nB : cB + (size_t)(t + 2) * kstep;
            const char* a3 = a2 + kstep; const char* b3 = b2 + kstep;
            if constexpr (SP2) {
            PG8_LDB(B0, 0, 0); PG8_LDB(B1, 0, 1); PG8_SCHED; PG8_LDA(At, 0, 0); PG8_STAGE(PG8_SA(1, 1), a1 + hstepA, voffA);
            PG8_WAIT_V(8); PG8_WAIT_L(0); PG8_BAR; PG8_MMA(0, 0, At, B0); PG8_MMA(0, 1, At, B1); PG8_BAR; PG8_SCHED;
            PG8_LDA(At, 0, 1); PG8_STAGE(PG8_SB(0, 0), b2, voffB); PG8_STAGE(PG8_SB(0, 1), b2 + hstepB, voffB); PG8_STAGE(PG8_SA(0, 0), a2, voffA);
            PG8_WAIT_V(8); PG8_WAIT_L(0); PG8_BAR; PG8_MMA(1, 0, At, B0); PG8_MMA(1, 1, At, B1); PG8_BAR; PG8_SCHED;
            PG8_LDB(B0, 1, 0); PG8_LDB(B1, 1, 1); PG8_SCHED; PG8_LDA(At, 1, 0); PG8_STAGE(PG8_SA(0, 1), a2 + hstepA, voffA);
            PG8_WAIT_V(8); PG8_WAIT_L(0); PG8_BAR; PG8_MMA(0, 0, At, B0); PG8_MMA(0, 1, At, B1); PG8_BAR; PG8_SCHED;
            PG8_LDA(At, 1, 1); PG8_STAGE(PG8_SB(1, 0), b3, voffB); PG8_STAGE(PG8_SB(1, 1), b3 + hstepB, voffB); PG8_STAGE(PG8_SA(1, 0), a3, voffA);
            PG8_WAIT_V(8); PG8_WAIT_L(0); PG8_BAR; PG8_MMA(1, 0, At, B0); PG8_MMA(1, 1, At, B1); PG8_BAR; PG8_SCHED;
            } else {
            PG8_LDB(B0, 0, 0); PG8_SCHED; PG8_LDA(At, 0, 0); PG8_STAGE(PG8_SA(1, 1), a1 + hstepA, voffA);
            PG8_WAIT_L(8); PG8_BAR; PG8_WAIT_L(0); PG8_MMA(0, 0, At, B0); PG8_BAR; PG8_SCHED;
            PG8_LDB(B1, 0, 1); PG8_STAGE(PG8_SB(0, 0), b2, voffB);
            PG8_BAR; PG8_WAIT_L(0); PG8_MMA(0, 1, At, B1); PG8_BAR;
            PG8_LDA(At, 0, 1); PG8_STAGE(PG8_SA(0, 0), a2, voffA);
            PG8_BAR; PG8_WAIT_L(0); PG8_MMA(1, 0, At, B0); PG8_BAR; PG8_SCHED;
            PG8_STAGE(PG8_SB(0, 1), b2 + hstepB, voffB);
            PG8_WAIT_V(6); PG8_BAR; PG8_MMA(1, 1, At, B1); PG8_BAR;
            PG8_LDB(B0, 1, 0); PG8_SCHED; PG8_LDA(At, 1, 0); PG8_STAGE(PG8_SA(0, 1), a2 + hstepA, voffA);
            PG8_WAIT_L(8); PG8_BAR; PG8_WAIT_L(0); PG8_MMA(0, 0, At, B0); PG8_BAR; PG8_SCHED;
            PG8_LDB(B1, 1, 1); PG8_STAGE(PG8_SB(1, 0), b3, voffB);
            PG8_BAR; PG8_WAIT_L(0); PG8_MMA(0, 1, At, B1); PG8_BAR;
            PG8_LDA(At, 1, 1); PG8_STAGE(PG8_SA(1, 0), a3, voffA);
            PG8_BAR; PG8_WAIT_L(0); PG8_MMA(1, 0, At, B0); PG8_BAR; PG8_SCHED;
            PG8_STAGE(PG8_SB(1, 1), b3 + hstepB, voffB);
            PG8_WAIT_V(6); PG8_BAR; PG8_MMA(1, 1, At, B1); PG8_BAR;
            }
        }
        if constexpr (ALIGN_EPI) { if (wr == 0) PG8_BAR; }
        { const int lane2 = my_lane();
          E(acc, cur, wid >> 2, wid & 3, lane2 & 15, lane2 >> 4); }
        if (!has_next) break;
#pragma unroll
        for (int a = 0; a < 2; ++a)
#pragma unroll
            for (int b = 0; b < 2; ++b)
#pragma unroll
                for (int m = 0; m < 4; ++m)
#pragma unroll
                    for (int n = 0; n < 2; ++n) acc[a][b][m][n] = (f32x4){0.f, 0.f, 0.f, 0.f};
        cur = nxt; cA = nA; cB = nB; ++ui;
        if constexpr (ALIGN_EPI) { if (wr == 1) PG8_BAR; }
    }
    PG8_WAIT_V(0);
    if constexpr (!ALIGN_EPI) { if (wr == 0) PG8_BAR; }
    PG8_BAR;
#undef PG8_SA
#undef PG8_SB
#undef PG8_STAGE
#undef PG8_LDA
#undef PG8_LDB
#undef PG8_MMA
#undef PG8_WAIT_V
#undef PG8_WAIT_L
#undef PG8_BAR
#undef PG8_SCHED
}
}
using pg8::Unit;

struct Args { const float* in[50]; float* out; unsigned char* ws; int ph_lo, ph_hi; };
typedef const __attribute__((address_space(4))) Args KArgs;
__device__ __forceinline__ KArgs* kargs() { KArgs* p = (KArgs*)__builtin_amdgcn_kernarg_segment_ptr(); asm volatile("" : "+s"(p)); return p; }
__device__ __forceinline__ unsigned char* launder_p(unsigned char* p) { asm volatile("" : "+s"(p)); return (unsigned char*)(GAS unsigned char*)p; }
__device__ __forceinline__ const float* kin(KArgs& A, int i) { return (const float*)(const GAS float*)A.in[i]; }
__device__ __forceinline__ float* kout(KArgs& A) { return (float*)(GAS float*)A.out; }
__device__ __forceinline__ unsigned char* kws(KArgs& A) { return (unsigned char*)(GAS unsigned char*)A.ws; }
__device__ __forceinline__ int launder_i(int v) { asm volatile("" : "+s"(v)); return v; }
__device__ __forceinline__ int launder_v(int v) { asm volatile("" : "+v"(v)); return v; }
enum { I_X = 0, I_MEM, I_LN_IN_G, I_LN_IN_B, I_W_IN, I_CONV_W, I_SG_NG, I_SG_NB, I_SG_W, I_SG_B, I_RW_MU, I_RW_W0, I_RW_WUP, I_RW_A0, I_RW_AUP, I_RW_GUP,
       I_RW_KK, I_RW_KA, I_RW_RK, I_RW_LNG, I_RW_LNB, I_S5_ARE, I_S5_AIM, I_S5_BRE, I_S5_BIM, I_S5_CRE, I_S5_CIM, I_S5_D, I_S5_LOGDT, I_S5_GLUW, I_S5_GLUB,
       I_BR_PROJ, I_GATE_B, I_W_OUT, I_LN1_G, I_LN1_B, I_XA_WQ, I_XA_WK, I_XA_WV, I_XA_WO, I_LN2_G, I_LN2_B, I_ROUTER_W, I_ROUTER_B, I_EX_W1, I_EX_B1, I_EX_W2, I_EX_B2,
       I_LN3_G, I_LN3_B };
struct Frame { LAS unsigned char* lds; volatile LAS unsigned* MISC; unsigned* ctl; unsigned char* ws; int tid, lane, wave, G, bid; };
constexpr int MI_TOFF = 16, MI_HIST = 64, MI_LBASE = 96, MI_LCUR = 128;

__device__ __forceinline__ void ln_stats(const f32x4 (&v)[4], float& mean, float& rstd) {
    float s = 0.f;
#pragma unroll
    for (int j = 0; j < 4; ++j) s += (v[j].x + v[j].y) + (v[j].z + v[j].w);
    mean = wave_sum(s) * (1.f / D); float s2 = 0.f;
#pragma unroll
    for (int j = 0; j < 4; ++j) { const f32x4 d = v[j] - mean; s2 += (d.x * d.x + d.y * d.y) + (d.z * d.z + d.w * d.w); }
    rstd = 1.0f / sqrtf(wave_sum(s2) * (1.f / D) + LN_EPS);
}
__device__ __forceinline__ void ln_apply_store(const f32x4 (&v)[4], float mean, float rstd, const float* g, const float* b, float* o32, bf16* o16, int lane) {
#pragma unroll
    for (int j = 0; j < 4; ++j) {
        const f32x4 gg = *(const f32x4*)(g + 256 * j + 4 * lane), bb = *(const f32x4*)(b + 256 * j + 4 * lane);
        const f32x4 y = (v[j] - mean) * rstd * gg + bb;
        if (o32) *(f32x4*)(o32 + 256 * j + 4 * lane) = y;
        if (o16) { v2u w; w.x = pk2(y.x, y.y); w.y = pk2(y.z, y.w); *(v2u*)(o16 + 256 * j + 4 * lane) = w; }
    }
}

__device__ __forceinline__ void transpose_item(const float* W, int K, int N, bf16* WT, int mode, LAS float* scr, int item, int lane) {
    const int nblk = N / 32, kb = item / nblk, nb = item % nblk, k0 = 64 * kb, n0 = 32 * nb;
    { float tv[32]; const float* wp = W + (size_t)(k0 + (lane >> 5)) * N + n0 + (lane & 31);
#pragma unroll
      for (int i = 0; i < 32; ++i) tv[i] = wp[(size_t)(2 * i) * N];
#pragma unroll
      for (int i = 0; i < 32; ++i) scr[(2 * i + (lane >> 5)) * 33 + (lane & 31)] = tv[i]; }
    LDS_WAIT();
    const int c = lane & 7;
#pragma unroll
    for (int j = 0; j < 4; ++j) { const int n = (lane >> 3) + 8 * j; const LAS float* s = scr + (8 * c) * 33 + n;
        v4u o; o.x = pk2(s[0 * 33], s[1 * 33]); o.y = pk2(s[2 * 33], s[3 * 33]); o.z = pk2(s[4 * 33], s[5 * 33]); o.w = pk2(s[6 * 33], s[7 * 33]);
        const int nn = n0 + n; const int jj = nn >> 1;
        const int row = mode ? ((jj >> 7) * 256 + (nn & 1) * 128 + (jj & 127)) : nn;
        *(v4u*)(WT + (size_t)row * K + k0 + 8 * c) = o; }
    LDS_WAIT();
}
__device__ __forceinline__ void s5_setup_item(KArgs& A, const Frame& F, int item) {
    const int l = item >> 4, g = item & 15, tid = F.tid;
    LAS float* Kt = (LAS float*)F.lds;
    LAS float* Pw = (LAS float*)(F.lds + 65536);
    LAS float* Bb = (LAS float*)(F.lds + 65536 + 33280);
    LAS float* Cc = Bb + 2048;
    const float* a_re = kin(A, I_S5_ARE) + (l * 16 + g) * 64; const float* a_im = kin(A, I_S5_AIM) + (l * 16 + g) * 64;
    const float* b_re = kin(A, I_S5_BRE) + (size_t)(l * 16 + g) * 1024; const float* b_im = kin(A, I_S5_BIM) + (size_t)(l * 16 + g) * 1024;
    const float* c_re = kin(A, I_S5_CRE) + (size_t)(l * 16 + g) * 1024; const float* c_im = kin(A, I_S5_CIM) + (size_t)(l * 16 + g) * 1024;
    const float dt = expf(kin(A, I_S5_LOGDT)[l * 16 + g]);
    for (int o = tid; o < 65 * 64; o += NTHREADS) { const int n = o >> 6, p = o & 63; const float mag = expf(a_re[p] * dt * (float)n); float sn, cs; sincosf(a_im[p] * dt * (float)n, &sn, &cs);
        Pw[o * 2] = mag * cs; Pw[o * 2 + 1] = mag * sn; }
    for (int o = tid; o < 1024; o += NTHREADS) { const int p = o >> 4;
        const float are = a_re[p], aim = a_im[p], mag = expf(are * dt); float sn, cs; sincosf(aim * dt, &sn, &cs); const float abr = mag * cs, abi = mag * sn;
        const float den = are * are + aim * aim, nr = abr - 1.0f, cr = (nr * are + abi * aim) / den, ci = (abi * are - nr * aim) / den;
        const float br = b_re[o], bi = b_im[o]; Bb[o * 2] = cr * br - ci * bi; Bb[o * 2 + 1] = cr * bi + ci * br; }
    for (int o = tid; o < 1024; o += NTHREADS) { Cc[o * 2] = c_re[o]; Cc[o * 2 + 1] = c_im[o]; }
    __syncthreads();
    for (int o = tid; o < 16384; o += NTHREADS) { const int tau = o >> 8, c = (o >> 4) & 15, cp = o & 15; float acc = 0.f;
        for (int p = 0; p < 64; ++p) { const float cr = Cc[(c * 64 + p) * 2], ci = Cc[(c * 64 + p) * 2 + 1], pr = Pw[(tau * 64 + p) * 2], pi = Pw[(tau * 64 + p) * 2 + 1];
            const float er = cr * pr - ci * pi, ei = cr * pi + ci * pr; acc += er * Bb[(p * 16 + cp) * 2] - ei * Bb[(p * 16 + cp) * 2 + 1]; }
        Kt[o] = acc; }
    __syncthreads();
    bf16* Bt = (bf16*)(F.ws + WS_S5BT) + (size_t)(l * 16 + g) * 1024 * S5K;
    for (int o = tid; o < 1024 * 128; o += NTHREADS) { const int rr = o >> 7, q = o & 127, t = rr >> 4, c = rr & 15, s = q >> 1, cp0 = (q & 1) * 8;
        v4u w = {0u, 0u, 0u, 0u};
        if (s <= t) { const LAS float* k = Kt + ((t - s) * 16 + c) * 16 + cp0; w.x = pk2(k[0], k[1]); w.y = pk2(k[2], k[3]); w.z = pk2(k[4], k[5]); w.w = pk2(k[6], k[7]); }
        *(v4u*)(Bt + (size_t)rr * S5K + q * 8) = w; }
    for (int o = tid; o < 1024 * 16; o += NTHREADS) { const int rr = o >> 4, q = o & 15, t = rr >> 4, c = rr & 15; float vals[8];
#pragma unroll
        for (int j = 0; j < 4; ++j) { const int p = 4 * q + j; const float cr = Cc[(c * 64 + p) * 2], ci = Cc[(c * 64 + p) * 2 + 1], pr = Pw[((t + 1) * 64 + p) * 2], pi = Pw[((t + 1) * 64 + p) * 2 + 1];
            vals[2 * j] = cr * pr - ci * pi; vals[2 * j + 1] = -(cr * pi + ci * pr); }
        v4u w; w.x = pk2(vals[0], vals[1]); w.y = pk2(vals[2], vals[3]); w.z = pk2(vals[4], vals[5]); w.w = pk2(vals[6], vals[7]);
        *(v4u*)(Bt + (size_t)rr * S5K + 1024 + q * 8) = w; }
    bf16* Bc = (bf16*)(F.ws + WS_S5BC) + (size_t)(l * 16 + g) * 256 * 1024;
    for (int o = tid; o < 128 * 128; o += NTHREADS) { const int row = o >> 7, q = o & 127, p = row >> 1, im = row & 1, s = q >> 1, cp0 = (q & 1) * 8;
        const float pr = Pw[((63 - s) * 64 + p) * 2], pi = Pw[((63 - s) * 64 + p) * 2 + 1]; float vals[8];
#pragma unroll
        for (int j = 0; j < 8; ++j) { const float br = Bb[(p * 16 + cp0 + j) * 2], bi = Bb[(p * 16 + cp0 + j) * 2 + 1]; vals[j] = im ? (pr * bi + pi * br) : (pr * br - pi * bi); }
        v4u w; w.x = pk2(vals[0], vals[1]); w.y = pk2(vals[2], vals[3]); w.z = pk2(vals[4], vals[5]); w.w = pk2(vals[6], vals[7]);
        *(v4u*)(Bc + (size_t)row * 1024 + q * 8) = w;
        *(v4u*)(Bc + (size_t)(128 + row) * 1024 + q * 8) = (v4u){0u, 0u, 0u, 0u}; }
    __syncthreads();
}
__device__ __forceinline__ void p_prologue(KArgs& A, const Frame& F) {
    const int gw = F.bid * NWAVES + F.wave, NGW = F.G * NWAVES, lane = F.lane;
    for (int item = F.bid; item < NL * 16; item += F.G) s5_setup_item(A, F, item);
    LAS float* scr = (LAS float*)(F.lds + F.wave * 16384);
#pragma unroll 1
    for (int d = 0; d < 10; ++d) {
        const float* src; bf16* dst; int K, N, batch, mode = 0;
        switch (d) {
            case 0: src = kin(A, I_EX_W1); dst = (bf16*)(F.ws + WS_W1T); K = 1024; N = 2048; batch = NL * NE; mode = 1; break;
            case 1: src = kin(A, I_EX_W2); dst = (bf16*)(F.ws + WS_W2T); K = 1024; N = 1024; batch = NL * NE; break;
            case 2: src = kin(A, I_W_IN); dst = (bf16*)(F.ws + WS_WINT); K = 1024; N = N_IN; batch = NL; break;
            case 3: src = kin(A, I_BR_PROJ); dst = (bf16*)(F.ws + WS_BRT); K = 256; N = 1024; batch = NL * 4; break;
            case 4: src = kin(A, I_W_OUT); dst = (bf16*)(F.ws + WS_WOUTT); K = 1024; N = 1024; batch = NL; break;
            case 5: src = kin(A, I_XA_WQ); dst = (bf16*)(F.ws + WS_WQT); K = 1024; N = 1024; batch = NL; break;
            case 6: src = kin(A, I_XA_WK); dst = (bf16*)(F.ws + WS_WKT); K = 1024; N = 1024; batch = NL; break;
            case 7: src = kin(A, I_XA_WV); dst = (bf16*)(F.ws + WS_WVT); K = 1024; N = 1024; batch = NL; break;
            case 8: src = kin(A, I_XA_WO); dst = (bf16*)(F.ws + WS_WOT); K = 1024; N = 1024; batch = NL; break;
            default: src = kin(A, I_S5_GLUW); dst = (bf16*)(F.ws + WS_GLUT); K = 256; N = 256; batch = NL; break;
        }
        const int per = (K / 64) * (N / 32), nitems = per * batch;
        for (int it = gw; it < nitems; it += NGW) { const int b = it / per, r = it - b * per;
            transpose_item(src + (size_t)b * K * N, K, N, dst + (size_t)b * K * N, mode, scr, r, lane); }
    }
    { bf16* lwt = (bf16*)(F.ws + WS_LWT);
      for (int it = gw * 64 + lane; it < NL * 768 * 32; it += NGW * 64) { const int kc = it & 31, row = (it >> 5) % 768, ll = it / (768 * 32), blk = row >> 8, c = row & 255, k0 = kc * 8; float v[8];
#pragma unroll
          for (int j = 0; j < 8; ++j) { const int k = k0 + j; float x = 0.f;
              if (blk == 0 && k < 64) x = kin(A, I_RW_WUP)[((size_t)ll * 64 + k) * 256 + c];
              else if (blk == 1 && k >= 64 && k < 128) x = kin(A, I_RW_AUP)[((size_t)ll * 64 + (k - 64)) * 256 + c];
              else if (blk == 2 && k >= 128) x = kin(A, I_RW_GUP)[((size_t)ll * 128 + (k - 128)) * 256 + c];
              v[j] = x; }
          v4u w; w.x = pk2(v[0], v[1]); w.y = pk2(v[2], v[3]); w.z = pk2(v[4], v[5]); w.w = pk2(v[6], v[7]);
          *(v4u*)(lwt + ((size_t)ll * 768 + row) * 256 + k0) = w; } }
    { const float* mem = kin(A, I_MEM); bf16* m16 = (bf16*)(F.ws + WS_MEM16);
      for (int r = gw; r < NB * NMEM; r += NGW) {
#pragma unroll
          for (int j = 0; j < 4; ++j) { const f32x4 v = *(const f32x4*)(mem + (size_t)r * D + 256 * j + 4 * lane); v2u w; w.x = pk2(v.x, v.y); w.y = pk2(v.z, v.w); *(v2u*)(m16 + (size_t)r * D + 256 * j + 4 * lane) = w; } } }
    { const float* x = kin(A, I_X); float* h32 = nullptr; bf16* h16 = (bf16*)(F.ws + WS_H16);
      for (int r0 = gw * 2; r0 < T; r0 += NGW * 2) { f32x4 v[2][4];
#pragma unroll
          for (int i = 0; i < 2; ++i)
#pragma unroll
              for (int j = 0; j < 4; ++j) v[i][j] = *(const f32x4*)(x + (size_t)(r0 + i) * D + 256 * j + 4 * lane);
#pragma unroll
          for (int i = 0; i < 2; ++i) { float mean, rstd; ln_stats(v[i], mean, rstd);
              ln_apply_store(v[i], mean, rstd, kin(A, I_LN_IN_G), kin(A, I_LN_IN_B), h32, h16 + (size_t)(r0 + i) * D, lane); } } }
}

typedef f32x4 AccT[2][2][4][2];
#define EPI_BASES KArgs& KA = *kargs(); unsigned char* ws = kws(KA); (void)ws;
__device__ __forceinline__ v4u pk8(const f32x4 a, const f32x4 b) { v4u w; w.x = pk2(a.x, a.y); w.y = pk2(a.z, a.w); w.z = pk2(b.x, b.y); w.w = pk2(b.z, b.w); return w; }
__device__ __forceinline__ void unpk8(const v4u w, f32x4& a, f32x4& b) { a.x = bf2f(w.x & 0xffffu); a.y = bf2f(w.x >> 16); a.z = bf2f(w.y & 0xffffu); a.w = bf2f(w.y >> 16); b.x = bf2f(w.z & 0xffffu); b.y = bf2f(w.z >> 16); b.z = bf2f(w.w & 0xffffu); b.w = bf2f(w.w >> 16); }
__device__ __forceinline__ f32x4 ld4bf(const bf16* p) { const v2u w = *(const v2u*)p; f32x4 a; a.x = bf2f(w.x & 0xffffu); a.y = bf2f(w.x >> 16); a.z = bf2f(w.y & 0xffffu); a.w = bf2f(w.y >> 16); return a; }
__device__ __forceinline__ f32x4 sig4(const f32x4 v) { return (f32x4){sigmoidf_(v.x), sigmoidf_(v.y), sigmoidf_(v.z), sigmoidf_(v.w)}; }
struct EpiNull { static constexpr bool PERM = false; int dummy;
    __device__ __forceinline__ void operator()(const AccT& acc, const Unit& u, int wr, int wc, int fr, int fq) const { f32x4 t = {0, 0, 0, 0};
#pragma unroll
        for (int a = 0; a < 2; ++a)
#pragma unroll
            for (int b = 0; b < 2; ++b)
#pragma unroll
                for (int m = 0; m < 4; ++m) { t += acc[a][b][m][0]; t += acc[a][b][m][1]; }
        if (t.x + t.y + t.z + t.w == 1234.5f) { EPI_BASES *(f32x4*)(ws + WS_END) = t; } } };
struct EpiIn { static constexpr bool PERM = true; int l;
    __device__ __forceinline__ void operator()(const AccT& acc, const Unit& u, int wr, int wc, int fr, int fq) const { EPI_BASES
        bf16* Z = (bf16*)(ws + WS_Z); bf16* SG = (bf16*)(ws + WS_SG); bf16* AOUT = (bf16*)(ws + WS_AOUT); const float* gate_b = kin(KA, I_GATE_B) + (size_t)l * 4096;
        if (u.pn < 10) {
            pg8::epi_foreach8(acc, u, wr, wc, fr, fq, [&](int row, int col, f32x4 v0, f32x4 v1) { const v4u w = pk8(v0, v1);
                *(v4u*)(Z + (size_t)row * ZLD + col) = w;
                if (u.pn == 9) { const int cc = col - OFF_D, g = cc >> 4, c0 = cc & 15, chunk = row >> 6, s = row & 63; *(v4u*)(AOUT + ((size_t)(g * NCHT + chunk)) * S5K + s * 16 + c0) = w; } });
        } else {
            pg8::epi_foreach8(acc, u, wr, wc, fr, fq, [&](int row, int col, f32x4 v0, f32x4 v1) {
                const int gc = col - OFF_G; const f32x4 g0 = *(const f32x4*)(gate_b + gc), g1 = *(const f32x4*)(gate_b + gc + 4);
                *(v4u*)(SG + (size_t)row * 4096 + gc) = pk8(sig4(v0 + g0), sig4(v1 + g1)); });
        }
    } };
struct EpiBranch { static constexpr bool PERM = true; int dummy;
    __device__ __forceinline__ void operator()(const AccT& acc, const Unit& u, int wr, int wc, int fr, int fq) const { EPI_BASES const int br = u.e;
        bf16* MG = (bf16*)(ws + WS_MG16); const bf16* SG = (const bf16*)(ws + WS_SG);
        pg8::epi_foreach8(acc, u, wr, wc, fr, fq, [&](int row, int col, f32x4 v0, f32x4 v1) {
            f32x4 s0, s1; unpk8(*(const v4u*)(SG + (size_t)row * 4096 + br * 1024 + col), s0, s1);
            f32x4 r0 = v0 * s0, r1 = v1 * s1; bf16* p = MG + (size_t)row * D + col;
            if (br > 0) { f32x4 m0, m1; unpk8(*(const v4u*)p, m0, m1); r0 += m0; r1 += m1; }
            *(v4u*)p = pk8(r0, r1); });
    } };
struct EpiResid { static constexpr bool PERM = true; int dummy;
    __device__ __forceinline__ void operator()(const AccT& acc, const Unit& u, int wr, int wc, int fr, int fq) const { EPI_BASES
        const bf16* H = (const bf16*)(ws + WS_H16); bf16* P = (bf16*)(ws + WS_PRE16);
        pg8::epi_foreach8(acc, u, wr, wc, fr, fq, [&](int row, int col, f32x4 v0, f32x4 v1) { f32x4 h0, h1; unpk8(*(const v4u*)(H + (size_t)row * D + col), h0, h1);
            *(v4u*)(P + (size_t)row * D + col) = pk8(h0 * DN_ALPHA + v0, h1 * DN_ALPHA + v1); });
    } };
struct EpiBf16 { static constexpr bool PERM = true; unsigned off_mib; float scale;
    __device__ __forceinline__ void operator()(const AccT& acc, const Unit& u, int wr, int wc, int fr, int fq) const { EPI_BASES
        bf16* O = (bf16*)(ws + (size_t)off_mib * MiB);
        pg8::epi_foreach8(acc, u, wr, wc, fr, fq, [&](int row, int col, f32x4 v0, f32x4 v1) { *(v4u*)(O + (size_t)row * D + col) = pk8(v0 * scale, v1 * scale); });
    } };
struct EpiVT { static constexpr bool PERM = false; int dummy;
    __device__ __forceinline__ void operator()(const AccT& acc, const Unit& u, int wr, int wc, int fr, int fq) const { EPI_BASES
        bf16* VT = (bf16*)(ws + WS_VMT16);
        pg8::epi_foreach(acc, u, wr, wc, fr, fq, [&](int row, int col, f32x4 v) { const int b = row >> 8, m = row & 255; bf16* p = VT + ((size_t)(b * D + col)) * NMEM + m;
            p[0] = (bf16)f2bf(v.x); p[NMEM] = (bf16)f2bf(v.y); p[2 * NMEM] = (bf16)f2bf(v.z); p[3 * NMEM] = (bf16)f2bf(v.w); });
    } };
struct EpiXloc { static constexpr bool PERM = false; int dummy;
    __device__ __forceinline__ void operator()(const AccT& acc, const Unit& u, int wr, int wc, int fr, int fq) const { EPI_BASES
        float* X = (float*)(ws + WS_XLOC);
        pg8::epi_foreach(acc, u, wr, wc, fr, fq, [&](int row, int col, f32x4 v) { if (col < 128) *(f32x4*)(X + ((size_t)(u.e * NCHT + row)) * 128 + col) = v; });
    } };
struct EpiLora { static constexpr bool PERM = false; int l;
    __device__ __forceinline__ void operator()(const AccT& acc, const Unit& u, int wr, int wc, int fr, int fq) const { EPI_BASES
        if (u.pn == 0) { float* DEC = (float*)(ws + WS_DEC); const float* w0 = kin(KA, I_RW_W0) + l * 256;
            pg8::epi_foreach(acc, u, wr, wc, fr, fq, [&](int row, int col, f32x4 v) { const f32x4 wp = v + *(const f32x4*)(w0 + col); f32x4 o;
#pragma unroll
                for (int e = 0; e < 4; ++e) { const float sp = log1pf(__expf(-wp[e])); o[e] = __expf(-__expf(-sp - 0.5f)); }
                *(f32x4*)(DEC + (size_t)row * 256 + col) = o; });
        } else if (u.pn == 1) { float* AV = (float*)(ws + WS_AV); const float* a0 = kin(KA, I_RW_A0) + l * 256;
            pg8::epi_foreach(acc, u, wr, wc, fr, fq, [&](int row, int col, f32x4 v) { const int c = col - 256; *(f32x4*)(AV + (size_t)row * 256 + c) = sig4(v + *(const f32x4*)(a0 + c)); });
        } else { float* G = (float*)(ws + WS_RWG);
            pg8::epi_foreach(acc, u, wr, wc, fr, fq, [&](int row, int col, f32x4 v) { *(f32x4*)(G + (size_t)row * 256 + col - 512) = v; });
        }
    } };
__device__ __forceinline__ float gelu_tanh(float x) { const float u = 0.7978845608028654f * (x + 0.044715f * x * x * x); const float e = __expf(2.0f * u); const float th = 1.0f - 2.0f * __builtin_amdgcn_rcpf(e + 1.0f); return 0.5f * x * (1.0f + th); }
__device__ __forceinline__ f32x4 gelu4(const f32x4 v) { return (f32x4){gelu_tanh(v.x), gelu_tanh(v.y), gelu_tanh(v.z), gelu_tanh(v.w)}; }
struct EpiS5Y { static constexpr bool PERM = true; int l;
    __device__ __forceinline__ void operator()(const AccT& acc, const Unit& u, int wr, int wc, int fr, int fq) const { EPI_BASES
        bf16* YD = (bf16*)(ws + WS_YD16); const bf16* AOUT = (const bf16*)(ws + WS_AOUT); const float* dvec = kin(KA, I_S5_D) + l * 256;
        pg8::epi_foreach8(acc, u, wr, wc, fr, fq, [&](int row, int col, f32x4 v0, f32x4 v1) { const int t = col >> 4, c0 = col & 15, tok = row * CH + t, ch = u.e * 16 + c0;
            f32x4 u0, u1; unpk8(*(const v4u*)(AOUT + ((size_t)(u.e * NCHT + row)) * S5K + t * 16 + c0), u0, u1);
            const f32x4 d0 = *(const f32x4*)(dvec + ch), d1 = *(const f32x4*)(dvec + ch + 4);
            *(v4u*)(YD + (size_t)tok * 256 + ch) = pk8(gelu4(v0 + d0 * u0), gelu4(v1 + d1 * u1)); });
    } };
struct EpiGlu { static constexpr bool PERM = true; int l;
    __device__ __forceinline__ void operator()(const AccT& acc, const Unit& u, int wr, int wc, int fr, int fq) const { EPI_BASES
        bf16* O = (bf16*)(ws + WS_O16); const bf16* YD = (const bf16*)(ws + WS_YD16); const float* gb = kin(KA, I_S5_GLUB) + l * 256;
        pg8::epi_foreach8(acc, u, wr, wc, fr, fq, [&](int row, int col, f32x4 v0, f32x4 v1) { f32x4 y0, y1; unpk8(*(const v4u*)(YD + (size_t)row * 256 + col), y0, y1);
            const f32x4 b0 = *(const f32x4*)(gb + col), b1 = *(const f32x4*)(gb + col + 4);
            *(v4u*)(O + (size_t)row * D + 768 + col) = pk8(y0 * sig4(v0 + b0), y1 * sig4(v1 + b1)); });
    } };
__device__ __forceinline__ float swiglu(float g, float u) { g = fminf(g, 7.0f); u = fminf(fmaxf(u, -7.0f), 7.0f); return (u + 1.0f) * g * sigmoidf_(1.702f * g); }
struct EpiSwiglu { static constexpr bool PERM = true; int l;
    __device__ __forceinline__ void operator()(const AccT& acc, const Unit& u, int wr, int wc, int fr, int fq) const { EPI_BASES
        bf16* ACT = (bf16*)(ws + WS_ACT); const float* bb = kin(KA, I_EX_B1) + (size_t)(l * NE + u.e) * 2048;
#pragma unroll
        for (int ai = 0; ai < 2; ++ai)
#pragma unroll
            for (int m = 0; m < 4; ++m) { const int row = u.pm * 256 + ai * 128 + wr * 64 + m * 16 + fr; const int j = u.pn * 128 + wc * 32 + 8 * fq;
                f32x4 o[2];
#pragma unroll
                for (int n = 0; n < 2; ++n) { const f32x4 b0 = *(const f32x4*)(bb + 2 * (j + 4 * n)), b1v = *(const f32x4*)(bb + 2 * (j + 4 * n) + 4);
                    const f32x4 g = acc[ai][0][m][n], uu = acc[ai][1][m][n];
                    o[n] = (f32x4){swiglu(g.x + b0.x, uu.x + b0.y), swiglu(g.y + b0.z, uu.y + b0.w), swiglu(g.z + b1v.x, uu.z + b1v.y), swiglu(g.w + b1v.z, uu.w + b1v.w)}; }
                *(v4u*)(ACT + (size_t)row * DFF + j) = pk8(o[0], o[1]);
                if (m == 3) __builtin_amdgcn_sched_barrier(0); }
    } };
struct EpiMoeOut { static constexpr bool PERM = true; int l;
    __device__ __forceinline__ void operator()(const AccT& acc, const Unit& u, int wr, int wc, int fr, int fq) const { EPI_BASES
        bf16* YS = (bf16*)(ws + WS_YS); const float* SLOTW = (const float*)(ws + WS_SLOTW); const float* bb = kin(KA, I_EX_B2) + (size_t)(l * NE + u.e) * D;
        pg8::epi_foreach8(acc, u, wr, wc, fr, fq, [&](int row, int col, f32x4 v0, f32x4 v1) { const float sw = SLOTW[row]; const f32x4 b0 = *(const f32x4*)(bb + col), b1 = *(const f32x4*)(bb + col + 4);
            *(v4u*)(YS + (size_t)row * D + col) = pk8((v0 + b0) * sw, (v1 + b1) * sw); });
    } };

__device__ __forceinline__ void p_mix1(KArgs& A, const Frame& F, int l) {
    const int gw = F.bid * NWAVES + F.wave, NGW = F.G * NWAVES, lane = F.lane, tid = F.tid;
    const bf16* Z = (const bf16*)(F.ws + WS_Z); bf16* O16 = (bf16*)(F.ws + WS_O16);
    for (int rp_ = 0; rp_ < ((PROBE_PHASE == 101) ? PROBE_REPS : 1); ++rp_) { const float* cw = kin(A, I_CONV_W) + l * 3 * 256; const f32x4 w0 = *(const f32x4*)(cw + 4 * lane), w1 = *(const f32x4*)(cw + 256 + 4 * lane), w2 = *(const f32x4*)(cw + 512 + 4 * lane);
      for (int t0 = gw * 4; t0 < T; t0 += NGW * 4) {
          f32x4 bg[4], ch[6];
#pragma unroll
          for (int i = 0; i < 6; ++i) { const int t = t0 - 2 + i; const bool ok = (t >= 0) && ((t & ~(SEQ - 1)) == (t0 & ~(SEQ - 1)));
              ch[i] = (f32x4){0, 0, 0, 0}; if (ok) { const bf16* zr = Z + (size_t)t * ZLD + 4 * lane; ch[i] = ld4bf(zr + 256) * ld4bf(zr + 512); } }
#pragma unroll
          for (int i = 0; i < 4; ++i) bg[i] = ld4bf(Z + (size_t)(t0 + i) * ZLD + 4 * lane);
#pragma unroll
          for (int i = 0; i < 4; ++i) { const f32x4 y = (w2 * ch[i + 2] + w1 * ch[i + 1] + w0 * ch[i]) * bg[i];
              v2u w; w.x = pk2(y.x, y.y); w.y = pk2(y.z, y.w); *(v2u*)(O16 + (size_t)(t0 + i) * D + 4 * lane) = w; } } }
    for (int rp_ = 0; rp_ < ((PROBE_PHASE == 102) ? PROBE_REPS : 1); ++rp_) { LAS float* VN = (LAS float*)F.lds;
      const float* ng = kin(A, I_SG_NG) + l * 256; const float* nb = kin(A, I_SG_NB) + l * 256;
      for (int blk = F.bid; blk < T / 128; blk += F.G) {
          const f32x4 gg = *(const f32x4*)(ng + 4 * lane), bb = *(const f32x4*)(nb + 4 * lane);
          for (int rb = 0; rb < 128 / NWAVES; rb += 4) { f32x4 vv[4];
#pragma unroll
              for (int i = 0; i < 4; ++i) vv[i] = ld4bf(Z + (size_t)(blk * 128 + F.wave + (rb + i) * NWAVES) * ZLD + OFF_B + 256 + 4 * lane);
              float s1[4], s2[4];
#pragma unroll
              for (int i = 0; i < 4; ++i) { s1[i] = (vv[i].x + vv[i].y) + (vv[i].z + vv[i].w); s2[i] = (vv[i].x * vv[i].x + vv[i].y * vv[i].y) + (vv[i].z * vv[i].z + vv[i].w * vv[i].w); }
#pragma unroll
              for (int o = 1; o < 64; o <<= 1) {
#pragma unroll
                  for (int i = 0; i < 4; ++i) { s1[i] += shfl_xor_l(s1[i], o, lane); s2[i] += shfl_xor_l(s2[i], o, lane); } }
#pragma unroll
              for (int i = 0; i < 4; ++i) { const float mean = s1[i] * (1.f / 256), var = fmaxf(s2[i] * (1.f / 256) - mean * mean, 0.f), rstd = __builtin_amdgcn_rsqf(var + LN_EPS);
                  *(LAS f32x4*)(VN + (F.wave + (rb + i) * NWAVES) * 256 + 4 * lane) = (vv[i] - mean) * rstd * gg + bb; } }
          __syncthreads();
          const int i = tid >> 2, cq = tid & 3, t = blk * 128 + i, jmax = (i < 64) ? 64 : 128;
#pragma unroll 1
          for (int g = 0; g < 4; ++g) { f32x4 a0 = {0, 0, 0, 0}, a1 = a0, a2 = a0, a3 = a0;
              const float* wrow = kin(A, I_SG_W) + ((size_t)((l * 4 + g) * 128 + i)) * 128; const LAS float* vb = VN + g * 64 + cq * 16;
              for (int j = 0; j < jmax; j += 4) { const f32x4 w4 = *(const f32x4*)(wrow + j);
#pragma unroll
                  for (int jj = 0; jj < 4; ++jj) { const LAS f32x4* vp = (const LAS f32x4*)(vb + (j + jj) * 256); const float w = w4[jj];
                      a0 += vp[0] * w; a1 += vp[1] * w; a2 += vp[2] * w; a3 += vp[3] * w; } }
              const float bias = kin(A, I_SG_B)[(l * 4 + g) * 128 + i]; const bf16* up = Z + (size_t)t * ZLD + OFF_B + g * 64 + cq * 16;
              const f32x4 o0 = ld4bf(up) * (a0 + bias), o1 = ld4bf(up + 4) * (a1 + bias), o2 = ld4bf(up + 8) * (a2 + bias), o3 = ld4bf(up + 12) * (a3 + bias);
              v4u wa, wb; wa.x = pk2(o0.x, o0.y); wa.y = pk2(o0.z, o0.w); wa.z = pk2(o1.x, o1.y); wa.w = pk2(o1.z, o1.w); wb.x = pk2(o2.x, o2.y); wb.y = pk2(o2.z, o2.w); wb.z = pk2(o3.x, o3.y); wb.w = pk2(o3.z, o3.w);
              bf16* op = O16 + (size_t)t * D + 256 + g * 64 + cq * 16; *(v4u*)op = wa; *(v4u*)(op + 8) = wb; }
          __syncthreads();
      } }
    for (int rp_ = 0; rp_ < ((PROBE_PHASE == 103) ? PROBE_REPS : 1); ++rp_) {
      bf16* LA = (bf16*)(F.ws + WS_LA16); const f32x4 mul = *(const f32x4*)(kin(A, I_RW_MU) + l * 1024 + 768 + 4 * lane);
      for (int t0 = gw * 4; t0 < T; t0 += NGW * 4) { f32x4 xr[5];
#pragma unroll
          for (int i = 0; i < 5; ++i) { const int t = t0 - 1 + i; xr[i] = (f32x4){0, 0, 0, 0}; if (i > 0 || (t0 & (SEQ - 1)) > 0) xr[i] = ld4bf(Z + (size_t)t * ZLD + OFF_C + 768 + 4 * lane); }
#pragma unroll
          for (int i = 0; i < 4; ++i) { f32x4 x = xr[i + 1] + (xr[i] - xr[i + 1]) * mul;
              if (lane < 16) x = sig4(x * 2.0f) * 2.0f - 1.0f;
              else if (lane >= 32) x = sig4(x);
              v2u w; w.x = pk2(x.x, x.y); w.y = pk2(x.z, x.w); *(v2u*)(LA + (size_t)(t0 + i) * 256 + 4 * lane) = w; } } }
}

__device__ __forceinline__ void p_rw_chunks(KArgs& A, const Frame& F, int l) {
    const int gw = F.bid * NWAVES + F.wave, NGW = F.G * NWAVES, lane = F.lane;
    const bf16* Z = (const bf16*)(F.ws + WS_Z); const float* DEC = (const float*)(F.ws + WS_DEC); const float* AV = (const float*)(F.ws + WS_AV);
    float* QH = (float*)(F.ws + WS_QH); float* YL = (float*)(F.ws + WS_YL); float* GC = (float*)(F.ws + WS_GC); float* HC = (float*)(F.ws + WS_HC); float* RK = (float*)(F.ws + WS_RK);
    LAS float* wl = (LAS float*)(F.lds + F.wave * 16384);
    for (int task = gw; task < 16 * NCH; task += NGW) { const int bh = task / NCH, ck = task % NCH, b = bh >> 2, head = bh & 3, c = head * 64 + lane;
        const float mu_r = kin(A, I_RW_MU)[l * 1024 + c], mu_k = kin(A, I_RW_MU)[l * 1024 + 256 + c], mu_v = kin(A, I_RW_MU)[l * 1024 + 512 + c];
        const float kkc = kin(A, I_RW_KK)[l * 256 + c], kac = kin(A, I_RW_KA)[l * 256 + c], rkc = kin(A, I_RW_RK)[l * 256 + c];
        float sp[64], sl[64];
        { const int ln = launder_v(lane);
#pragma unroll
          for (int k = 0; k < 64; ++k) { sp[k] = (k == ln) ? 1.0f : 0.0f; sl[k] = 0.0f; } }
        wl[8 * 320 + lane] = 0.f;
        const int tg0 = b * SEQ + ck * CH;
        float pr = 0.f, pk = 0.f, pv = 0.f, gam = 1.0f;
        if (ck > 0) { const bf16* zp = Z + (size_t)(tg0 - 1) * ZLD + OFF_C + c; pr = bf2f(zp[0]); pk = bf2f(zp[256]); pv = bf2f(zp[512]); }
#pragma unroll 1
        for (int sb = 0; sb < CH / 8; ++sb) {
#pragma unroll 1
            for (int hb = 0; hb < 2; ++hb) {
                float kk[4], dc[4], av[4], rs[4], k2[4], vs[4], ss[4], rkp[4];
#pragma unroll
                for (int i = 0; i < 4; ++i) { const int t = tg0 + sb * 8 + hb * 4 + i; const bf16* zr = Z + (size_t)t * ZLD + OFF_C + c;
                    const float r = bf2f(zr[0]), k = bf2f(zr[256]), v = bf2f(zr[512]); dc[i] = DEC[(size_t)t * 256 + c]; av[i] = AV[(size_t)t * 256 + c];
                    rs[i] = r + (pr - r) * mu_r; const float ks = k + (pk - k) * mu_k; vs[i] = v + (pv - v) * mu_v; pr = r; pk = k; pv = v;
                    kk[i] = ks * kkc; k2[i] = ks * (1.0f + (av[i] - 1.0f) * kac); ss[i] = kk[i] * kk[i]; rkp[i] = rs[i] * k2[i] * rkc; }
#pragma unroll
                for (int o = 1; o < 64; o <<= 1) {
#pragma unroll
                    for (int i = 0; i < 4; ++i) { ss[i] += shfl_xor_l(ss[i], o, lane); rkp[i] += shfl_xor_l(rkp[i], o, lane); } }
#pragma unroll
                for (int i = 0; i < 4; ++i) { const float kn = kk[i] * __builtin_amdgcn_rcpf(fmaxf(sqrtf(ss[i]), 1e-12f)); LAS float* w = wl + (hb * 4 + i) * 320 + lane;
                    const float g1 = gam * dc[i], ig = __builtin_amdgcn_rcpf(g1);
                    w[0] = -kn * gam; w[64] = kn * av[i] * ig; w[128] = rs[i] * g1; w[192] = k2[i] * ig; w[256] = vs[i]; gam = g1;
                    if (lane == 0) RK[(size_t)(tg0 + sb * 8 + hb * 4 + i) * 4 + head] = rkp[i]; }
            }
            LDS_WAIT();
            const LAS float* wr16 = wl + (lane & 15);
            float saP = 0.f, saL = 0.f;
            { float A0[4];
#pragma unroll
              for (int J = 0; J < 4; ++J) A0[J] = wr16[16 * J];
#define RW_SA(k) { fmac_bc<(k) & 15>(saP, A0[(k) >> 4], sp[k]); fmac_bc<(k) & 15>(saL, A0[(k) >> 4], sl[k]); }
#define RW_REP16(M, o) M(o + 0) M(o + 1) M(o + 2) M(o + 3) M(o + 4) M(o + 5) M(o + 6) M(o + 7) M(o + 8) M(o + 9) M(o + 10) M(o + 11) M(o + 12) M(o + 13) M(o + 14) M(o + 15)
              RW_REP16(RW_SA, 0) RW_REP16(RW_SA, 16) RW_REP16(RW_SA, 32) RW_REP16(RW_SA, 48) }
            float Bv[4], Rv[4], Kv[4], Av[4], vj;
#pragma unroll
            for (int J = 0; J < 4; ++J) { Bv[J] = wr16[64 + 16 * J]; Rv[J] = wr16[128 + 16 * J]; Kv[J] = wr16[192 + 16 * J]; Av[J] = wr16[320 + 16 * J]; }
            vj = wl[256 + lane];
#pragma unroll 1
            for (int st_ = 0; st_ < 8; ++st_) {
                float Bn[4], Rn[4], Kn[4], An[4], vn;
                { const LAS float* nb = wr16 + (st_ + 1) * 320; const int lim = (st_ < 7) ? 0 : -320;
#pragma unroll
                  for (int J = 0; J < 4; ++J) { Bn[J] = nb[lim + 64 + 16 * J]; Rn[J] = nb[lim + 128 + 16 * J]; Kn[J] = nb[lim + 192 + 16 * J]; An[J] = nb[320 + 16 * J]; }
                  vn = wl[(st_ + 1) * 320 + lim + 256 + lane]; }
                float yP = 0.f, yL = 0.f, nP = 0.f, nL = 0.f;
#define RW_STEP(k) { fmac_bc<(k) & 15>(sp[k], Bv[(k) >> 4], saP); fmac_bc<(k) & 15>(sl[k], Bv[(k) >> 4], saL); fmac_bc<(k) & 15>(sl[k], Kv[(k) >> 4], vj); \
                     fmac_bc<(k) & 15>(yP, Rv[(k) >> 4], sp[k]); fmac_bc<(k) & 15>(yL, Rv[(k) >> 4], sl[k]); fmac_bc<(k) & 15>(nP, Av[(k) >> 4], sp[k]); fmac_bc<(k) & 15>(nL, Av[(k) >> 4], sl[k]); }
                RW_REP16(RW_STEP, 0) RW_REP16(RW_STEP, 16) RW_REP16(RW_STEP, 32) RW_REP16(RW_STEP, 48)
                const size_t oi = ((size_t)(bh * SEQ + ck * CH + sb * 8 + st_)) * 64 + lane;
                QH[oi] = yP; YL[oi] = yL; saP = nP; saL = nL;
#pragma unroll
                for (int J = 0; J < 4; ++J) { Bv[J] = Bn[J]; Rv[J] = Rn[J]; Kv[J] = Kn[J]; Av[J] = An[J]; }
                vj = vn; }
#undef RW_SA
#undef RW_STEP
#undef RW_REP16
        }
        wl[lane] = gam; LDS_WAIT();
        float* hp = HC + ((size_t)(bh * NCH + ck) * 64 + lane) * 64;
#pragma unroll
        for (int q = 0; q < 16; ++q) { const f32x4 gq = *(const LAS f32x4*)(wl + 4 * q);
            sp[4 * q] *= gq.x; sp[4 * q + 1] *= gq.y; sp[4 * q + 2] *= gq.z; sp[4 * q + 3] *= gq.w;
            *(f32x4*)(hp + 4 * q) = (f32x4){sl[4 * q] * gq.x, sl[4 * q + 1] * gq.y, sl[4 * q + 2] * gq.z, sl[4 * q + 3] * gq.w}; }
        { float* gp = GC + (size_t)(bh * NCH + ck) * 4096 + (size_t)(((lane >> 2) & 3) * 16) * 64 + ((lane >> 4) * 4 + (lane & 3)) * 4;
#pragma unroll
          for (int f = 0; f < 16; ++f) *(f32x4*)(gp + f * 64) = (f32x4){sp[f], sp[16 + f], sp[32 + f], sp[48 + f]}; }
        LDS_WAIT();
    }
}
__device__ __forceinline__ void p_s5_chain(KArgs& A, const Frame& F, int l) {
    const int gt = F.bid * NTHREADS + F.tid; if (gt >= NB * 16 * 64) return;
    const int b = gt >> 10, g = (gt >> 6) & 15, p = gt & 63;
    const float dt = expf(kin(A, I_S5_LOGDT)[l * 16 + g]); const float are = kin(A, I_S5_ARE)[(l * 16 + g) * 64 + p], aim = kin(A, I_S5_AIM)[(l * 16 + g) * 64 + p];
    const float mag = expf(are * dt * 64.0f); float sn, cs; sincosf(aim * dt * 64.0f, &sn, &cs); const float ar = mag * cs, ai = mag * sn;
    bf16* AO = (bf16*)(F.ws + WS_AOUT); const float* XL = (const float*)(F.ws + WS_XLOC);
    float xr = 0.f, xi = 0.f;
#pragma unroll 1
    for (int c0 = 0; c0 < NCH; c0 += 16) {
        f32x2 xl[16]; unsigned outw[16];
#pragma unroll
        for (int i = 0; i < 16; ++i) xl[i] = *(const f32x2*)(XL + ((size_t)g * NCHT + b * NCH + c0 + i) * 128 + 2 * p);
#pragma unroll
        for (int i = 0; i < 16; ++i) { outw[i] = pk2(xr, xi); const float nr = ar * xr - ai * xi + xl[i].x, ni = ar * xi + ai * xr + xl[i].y; xr = nr; xi = ni; }
#pragma unroll
        for (int i = 0; i < 16; ++i) *(unsigned*)(AO + ((size_t)g * NCHT + b * NCH + c0 + i) * S5K + 1024 + 2 * p) = outw[i];
    }
}
constexpr int CB = 8, NBLK = NCH / CB;
__device__ __forceinline__ void chain_load_g(const float* G, float (&ga)[64], int fr, int fq) {
    const f32x4* gp = (const f32x4*)(G + (size_t)(16 * fq + fr) * 64);
#pragma unroll
    for (int q = 0; q < 16; ++q) { const f32x4 x = gp[q]; ga[4 * q] = x.x; ga[4 * q + 1] = x.y; ga[4 * q + 2] = x.z; ga[4 * q + 3] = x.w; }
}
__device__ __forceinline__ void chain_store_g(float* G, int rb, const f32x4 (&t)[4], int fr, int fq) {
#pragma unroll
    for (int reg = 0; reg < 4; ++reg) *(f32x4*)(G + (size_t)((fr >> 2) * 16 + 4 * fq + reg) * 64 + (rb * 4 + (fr & 3)) * 4) = (f32x4){t[0][reg], t[1][reg], t[2][reg], t[3][reg]};
}
__device__ __forceinline__ void chain_step(f32x4 (&acc)[4], const float (&ga)[64], const f32x4 (&ci)[4]) {
    f32x4 na[4] = {ci[0], ci[1], ci[2], ci[3]};
#pragma unroll
    for (int jr = 0; jr < 16; ++jr)
#pragma unroll
        for (int mt = 0; mt < 4; ++mt) na[mt] = __builtin_amdgcn_mfma_f32_16x16x4f32(ga[jr * 4 + mt], acc[jr >> 2][jr & 3], na[mt], 0, 0, 0);
#pragma unroll
    for (int mt = 0; mt < 4; ++mt) acc[mt] = na[mt];
}
__device__ __forceinline__ void chain_load_tile(const float* M, int rb, f32x4 (&t)[4], int fr, int fq) {
#pragma unroll
    for (int jt = 0; jt < 4; ++jt) t[jt] = *(const f32x4*)(M + (size_t)(16 * rb + fr) * 64 + 16 * jt + 4 * fq);
}
__device__ __forceinline__ void chain_store_tile(float* M, int rb, const f32x4 (&t)[4], int fr, int fq) {
#pragma unroll
    for (int jt = 0; jt < 4; ++jt) *(f32x4*)(M + (size_t)(16 * rb + fr) * 64 + 16 * jt + 4 * fq) = t[jt];
}
__device__ __forceinline__ void p_chain_compose(const Frame& F) {
    const int nlow = (F.G >= 256) ? 128 : 0; if (F.bid < nlow) return;
    const int gw = (F.bid - nlow) * NWAVES + F.wave, NGW = (F.G - nlow) * NWAVES, ln_ = my_lane(), fr = ln_ & 15, fq = ln_ >> 4;
    const float* GC = (const float*)(F.ws + WS_GC); const float* HC = (const float*)(F.ws + WS_HC); float* GB = (float*)(F.ws + WS_GB); float* HB = (float*)(F.ws + WS_HB);
    for (int task = gw; task < 16 * NBLK * 8; task += NGW) { const int cb = task & 7, bb = task >> 3, rb = cb & 3; const bool isH = cb >= 4;
        const size_t c0 = (size_t)bb * CB;
        f32x4 acc[4];
        if (isH) chain_load_tile(HC + c0 * 4096, rb, acc, fr, fq);
        else {
            const float* gq = GC + c0 * 4096 + (size_t)((fr >> 2) * 16 + 4 * fq) * 64 + (rb * 4 + (fr & 3)) * 4;
#pragma unroll
            for (int reg = 0; reg < 4; ++reg) { const f32x4 x = *(const f32x4*)(gq + reg * 64); acc[0][reg] = x.x; acc[1][reg] = x.y; acc[2][reg] = x.z; acc[3][reg] = x.w; } }
        float ga[64]; chain_load_g(GC + (c0 + 1) * 4096, ga, fr, fq);
        f32x4 ci[4] = {{0, 0, 0, 0}, {0, 0, 0, 0}, {0, 0, 0, 0}, {0, 0, 0, 0}};
        if (isH) chain_load_tile(HC + (c0 + 1) * 4096, rb, ci, fr, fq);
#pragma unroll 1
        for (int i = 1; i < CB; ++i) { const int nx = (i + 1 < CB) ? i + 1 : i;
            f32x4 cn[4] = {{0, 0, 0, 0}, {0, 0, 0, 0}, {0, 0, 0, 0}, {0, 0, 0, 0}};
            if (isH) chain_load_tile(HC + (c0 + nx) * 4096, rb, cn, fr, fq);
            float gn[64]; chain_load_g(GC + (c0 + nx) * 4096, gn, fr, fq);
            chain_step(acc, ga, ci);
#pragma unroll
            for (int k = 0; k < 64; ++k) ga[k] = gn[k];
#pragma unroll
            for (int k = 0; k < 4; ++k) ci[k] = cn[k]; }
        if (isH) chain_store_tile(HB + (size_t)bb * 4096, rb, acc, fr, fq); else chain_store_g(GB + (size_t)bb * 4096, rb, acc, fr, fq);
    }
}
__device__ __forceinline__ void p_chain_blocks(const Frame& F, int gw, int NGW) {
    const int ln_ = my_lane(), fr = ln_ & 15, fq = ln_ >> 4;
    const float* GB = (const float*)(F.ws + WS_GB); const float* HB = (const float*)(F.ws + WS_HB); float* SB = (float*)(F.ws + WS_SB);
    for (int task = gw; task < 16 * 4; task += NGW) { const int vb = task & 3, bh = task >> 2;
        f32x4 acc[4] = {{0, 0, 0, 0}, {0, 0, 0, 0}, {0, 0, 0, 0}, {0, 0, 0, 0}};
        float ga[64]; chain_load_g(GB + (size_t)bh * NBLK * 4096, ga, fr, fq);
        f32x4 ci[4]; chain_load_tile(HB + (size_t)bh * NBLK * 4096, vb, ci, fr, fq);
#pragma unroll 1
        for (int blk = 0; blk < NBLK; ++blk) { const size_t bb = (size_t)bh * NBLK + blk;
            chain_store_tile(SB + bb * 4096, vb, acc, fr, fq);
            if (blk + 1 == NBLK) break;
            f32x4 cn[4]; chain_load_tile(HB + (bb + 1) * 4096, vb, cn, fr, fq);
            float gn[64]; chain_load_g(GB + (bb + 1) * 4096, gn, fr, fq);
            chain_step(acc, ga, ci);
#pragma unroll
            for (int k = 0; k < 64; ++k) ga[k] = gn[k];
#pragma unroll
            for (int k = 0; k < 4; ++k) ci[k] = cn[k]; }
    }
}
__device__ __forceinline__ void chain_inblock(const Frame& F, int bb, int vb) {
    const int ln_ = my_lane(), fr = ln_ & 15, fq = ln_ >> 4;
    const float* GC = (const float*)(F.ws + WS_GC); const float* HC = (const float*)(F.ws + WS_HC); const float* SB = (const float*)(F.ws + WS_SB); float* SC = (float*)(F.ws + WS_SC);
    const size_t c0 = (size_t)bb * CB;
    f32x4 acc[4]; chain_load_tile(SB + (size_t)bb * 4096, vb, acc, fr, fq);
    float ga[64]; chain_load_g(GC + c0 * 4096, ga, fr, fq);
    f32x4 ci[4]; chain_load_tile(HC + c0 * 4096, vb, ci, fr, fq);
#pragma unroll 1
    for (int i = 0; i < CB; ++i) {
        chain_store_tile(SC + (c0 + i) * 4096, vb, acc, fr, fq);
        if (i + 1 == CB) break;
        f32x4 cn[4]; chain_load_tile(HC + (c0 + i + 1) * 4096, vb, cn, fr, fq);
        float gn[64]; chain_load_g(GC + (c0 + i + 1) * 4096, gn, fr, fq);
        chain_step(acc, ga, ci);
#pragma unroll
        for (int k = 0; k < 64; ++k) ga[k] = gn[k];
#pragma unroll
        for (int k = 0; k < 4; ++k) ci[k] = cn[k]; }
}
__device__ __forceinline__ void rw_out_task(KArgs& A, const Frame& F, int l, int task) {
    const int lane = F.lane, fr = lane & 15, fq = lane >> 4;
    const bf16* Z = (const bf16*)(F.ws + WS_Z); const float* QH = (const float*)(F.ws + WS_QH); const float* YL = (const float*)(F.ws + WS_YL); const float* SC = (const float*)(F.ws + WS_SC);
    const float* RWG = (const float*)(F.ws + WS_RWG); const float* RK = (const float*)(F.ws + WS_RK); bf16* O16 = (bf16*)(F.ws + WS_O16);
    const int bh = task / NCH, ck = task % NCH, b = bh >> 2, head = bh & 3;
    const size_t ti0 = (size_t)(bh * SEQ + ck * CH); const int t0g = b * SEQ + ck * CH;
    float sa[4][16];
    { const float* sp = SC + (size_t)(bh * NCH + ck) * 4096 + (size_t)fr * 64 + 16 * fq;
#pragma unroll
      for (int vt = 0; vt < 4; ++vt)
#pragma unroll
          for (int q = 0; q < 4; ++q) { const f32x4 x = *(const f32x4*)(sp + vt * 1024 + 4 * q); sa[vt][4 * q] = x.x; sa[vt][4 * q + 1] = x.y; sa[vt][4 * q + 2] = x.z; sa[vt][4 * q + 3] = x.w; } }
    const float* lgp = kin(A, I_RW_LNG) + l * 256 + head * 64 + 4 * fq; const float* lbp = kin(A, I_RW_LNB) + l * 256 + head * 64 + 4 * fq; const float* mup = kin(A, I_RW_MU) + l * 1024 + 512 + head * 64 + 4 * fq;
#pragma unroll 1
    for (int tt = 0; tt < 4; ++tt) { const int t = 16 * tt + fr;
        float qb[16];
        { const float* qp = QH + (ti0 + t) * 64 + 16 * fq;
#pragma unroll
          for (int q = 0; q < 4; ++q) { const f32x4 x = *(const f32x4*)(qp + 4 * q); qb[4 * q] = x.x; qb[4 * q + 1] = x.y; qb[4 * q + 2] = x.z; qb[4 * q + 3] = x.w; } }
        f32x4 y[4];
#pragma unroll
        for (int vt = 0; vt < 4; ++vt) y[vt] = *(const f32x4*)(YL + (ti0 + t) * 64 + 16 * vt + 4 * fq);
#pragma unroll
        for (int s_ = 0; s_ < 16; ++s_)
#pragma unroll
            for (int vt = 0; vt < 4; ++vt) y[vt] = __builtin_amdgcn_mfma_f32_16x16x4f32(sa[vt][s_], qb[s_], y[vt], 0, 0, 0);
        float s1 = 0.f, s2 = 0.f;
#pragma unroll
        for (int vt = 0; vt < 4; ++vt) { s1 += (y[vt].x + y[vt].y) + (y[vt].z + y[vt].w); s2 += (y[vt].x * y[vt].x + y[vt].y * y[vt].y) + (y[vt].z * y[vt].z + y[vt].w * y[vt].w); }
        s1 += shfl_xor_l(s1, 16, lane); s1 += shfl_xor_l(s1, 32, lane); s2 += shfl_xor_l(s2, 16, lane); s2 += shfl_xor_l(s2, 32, lane);
        const float m = s1 * (1.f / 64), var = fmaxf(s2 * (1.f / 64) - m * m, 0.f), rstd = __builtin_amdgcn_rsqf(var + RW_LN_EPS);
        const int tg = t0g + t; const float rk = RK[(size_t)tg * 4 + head]; const bool hasprev = (ck * CH + t) > 0;
        const bf16* zv = Z + (size_t)tg * ZLD + OFF_C + 512 + head * 64 + 4 * fq; const float* gp = RWG + (size_t)tg * 256 + head * 64 + 4 * fq; bf16* op = O16 + (size_t)tg * D + 512 + head * 64 + 4 * fq;
#pragma unroll
        for (int vt = 0; vt < 4; ++vt) { const f32x4 v1 = ld4bf(zv + 16 * vt); f32x4 v0 = {0, 0, 0, 0}; if (hasprev) v0 = ld4bf(zv - ZLD + 16 * vt);
            const f32x4 vv = v1 + (v0 - v1) * *(const f32x4*)(mup + 16 * vt), g4 = *(const f32x4*)(gp + 16 * vt), lg4 = *(const f32x4*)(lgp + 16 * vt), lb4 = *(const f32x4*)(lbp + 16 * vt);
            const f32x4 o = ((y[vt] - m) * rstd * lg4 + lb4 + vv * rk) * g4;
            v2u w; w.x = pk2(o.x, o.y); w.y = pk2(o.z, o.w); *(v2u*)(op + 16 * vt) = w; }
    }
}

template <int LSTRIDE> __device__ __forceinline__ void attn_stage(LAS unsigned char* lds, const bf16* src, size_t row_stride, int tid) {
    const int r0 = tid >> 5, c = tid & 31; const bf16* sp = src + (size_t)r0 * row_stride + c * 8; LAS unsigned char* dp = lds + r0 * LSTRIDE + c * 16;
#pragma unroll 4
    for (int i = 0; i < 16; ++i) { const v4u v = *(const v4u*)(sp + (size_t)(16 * i) * row_stride); *(LAS v4u*)(dp + 16 * i * LSTRIDE) = v; }
}
constexpr int KSTR = 544, VSTR = 528;
__device__ __forceinline__ void p_attn(const Frame& F) {
    const int lane = F.lane, fr = lane & 15, fq = lane >> 4;
    const bf16* Q = (const bf16*)(F.ws + WS_Q16); const bf16* KM = (const bf16*)(F.ws + WS_KM16); const bf16* VT = (const bf16*)(F.ws + WS_VMT16); bf16* AO = (bf16*)(F.ws + WS_AO16);
    for (int item = F.bid; item < NB * 4 * (SEQ / 256); item += F.G) {
        const int qg = item % (SEQ / 256), bhd = item / (SEQ / 256), head = bhd & 3, b = bhd >> 2;
        attn_stage<KSTR>(F.lds, KM + (size_t)(b * NMEM) * D + head * 256, D, F.tid);
        __syncthreads();
        v4u pf[2][8]; float inv[2];
#pragma unroll
        for (int u = 0; u < 2; ++u) { const int q0 = b * SEQ + qg * 256 + u * 128 + F.wave * 16;
            bf16x8 qf[8];
#pragma unroll
            for (int ks = 0; ks < 8; ++ks) qf[ks] = *(const bf16x8*)(Q + (size_t)(q0 + fr) * D + head * 256 + ks * 32 + fq * 8);
            f32x4 sT[16];
            const LAS unsigned char* kbase = F.lds + fr * KSTR + fq * 16;
#pragma unroll
            for (int kt = 0; kt < 16; ++kt) { f32x4 a = {0, 0, 0, 0}; const LAS unsigned char* kp = kbase + kt * 16 * KSTR;
#pragma unroll
                for (int ks = 0; ks < 8; ++ks) { const bf16x8 kf = *(const LAS bf16x8*)(kp + ks * 64); a = __builtin_amdgcn_mfma_f32_16x16x32_bf16(kf, qf[ks], a, 0, 0, 0); }
                sT[kt] = a; if (kt & 1) __builtin_amdgcn_sched_barrier(0); }
            float mx = -3.0e38f;
#pragma unroll
            for (int kt = 0; kt < 16; ++kt) mx = fmaxf(fmaxf(fmaxf(mx, sT[kt].x), fmaxf(sT[kt].y, sT[kt].z)), sT[kt].w);
            mx = fmaxf(mx, shfl_xor_l(mx, 16, lane)); mx = fmaxf(mx, shfl_xor_l(mx, 32, lane));
            float sum = 0.f;
#pragma unroll
            for (int kt = 0; kt < 16; ++kt) { sT[kt].x = __expf(sT[kt].x - mx); sT[kt].y = __expf(sT[kt].y - mx); sT[kt].z = __expf(sT[kt].z - mx); sT[kt].w = __expf(sT[kt].w - mx); sum += (sT[kt].x + sT[kt].y) + (sT[kt].z + sT[kt].w); }
            sum += shfl_xor_l(sum, 16, lane); sum += shfl_xor_l(sum, 32, lane);
            inv[u] = 1.0f / sum;
#pragma unroll
            for (int kp = 0; kp < 8; ++kp) { v4u w; w.x = pk2(sT[2 * kp].x, sT[2 * kp].y); w.y = pk2(sT[2 * kp].z, sT[2 * kp].w); w.z = pk2(sT[2 * kp + 1].x, sT[2 * kp + 1].y); w.w = pk2(sT[2 * kp + 1].z, sT[2 * kp + 1].w); pf[u][kp] = w; }
            __builtin_amdgcn_sched_barrier(0);
        }
        __syncthreads();
        attn_stage<VSTR>(F.lds, VT + (size_t)(b * D + head * 256) * NMEM, NMEM, F.tid);
        __syncthreads();
#pragma unroll
        for (int u = 0; u < 2; ++u) { const int q0 = b * SEQ + qg * 256 + u * 128 + F.wave * 16;
#pragma unroll 2
            for (int dt = 0; dt < 16; ++dt) { f32x4 o = {0, 0, 0, 0}; const LAS unsigned char* vp = F.lds + (dt * 16 + fr) * VSTR + fq * 8;
#pragma unroll
                for (int kp = 0; kp < 8; ++kp) {
                    const v2u lo = *(const LAS v2u*)(vp + 64 * kp), hi = *(const LAS v2u*)(vp + 64 * kp + 32); v4u w; w.x = lo.x; w.y = lo.y; w.z = hi.x; w.w = hi.y;
                    o = __builtin_amdgcn_mfma_f32_16x16x32_bf16(__builtin_bit_cast(bf16x8, w), __builtin_bit_cast(bf16x8, pf[u][kp]), o, 0, 0, 0); }
                v2u w; w.x = pk2(o.x * inv[u], o.y * inv[u]); w.y = pk2(o.z * inv[u], o.w * inv[u]);
                *(v2u*)(AO + (size_t)(q0 + fr) * D + head * 256 + dt * 16 + 4 * fq) = w; __builtin_amdgcn_sched_barrier(0); } }
        __syncthreads();
    }
}

__device__ __forceinline__ void p_ln(const Frame& F, const float* g, const float* b, bool dummy) {
    const int gw = F.bid * NWAVES + F.wave, NGW = F.G * NWAVES, lane = F.lane; const bf16* P = (const bf16*)(F.ws + WS_PRE16); bf16* H16 = (bf16*)(F.ws + (dummy ? WS_Z + 128 * MiB : WS_H16));
    for (int r0 = gw * 4; r0 < T; r0 += NGW * 4) { f32x4 v[4][4];
#pragma unroll
        for (int i = 0; i < 4; ++i)
#pragma unroll
            for (int j = 0; j < 4; ++j) v[i][j] = ld4bf(P + (size_t)(r0 + i) * D + 256 * j + 4 * lane);
#pragma unroll
        for (int i = 0; i < 4; ++i) { float mean, rstd; ln_stats(v[i], mean, rstd); ln_apply_store(v[i], mean, rstd, g, b, (float*)nullptr, H16 + (size_t)(r0 + i) * D, lane); } }
}
__device__ __forceinline__ void p_ln_router(KArgs& A, const Frame& F, int l, bool dummy) {
    const int gw = F.bid * NWAVES + F.wave, NGW = F.G * NWAVES, lane = F.lane, tid = F.tid, fr = lane & 15, fq = lane >> 4;
    const bf16* H = (const bf16*)(F.ws + WS_PRE16); bf16* H16 = (bf16*)(F.ws + (dummy ? WS_Z + 128 * MiB : WS_H16)); int* TOKE = (int*)(F.ws + (dummy ? WS_Z + 200 * MiB : WS_TOKE)); float* TOKW = (float*)(F.ws + (dummy ? WS_Z + 201 * MiB : WS_TOKW));
    LAS v4u* TB = (LAS v4u*)F.lds;
    LAS float* PS = (LAS float*)(F.lds + 131072);
    volatile LAS unsigned* hist = F.MISC + MI_HIST;
    const float* rw = kin(A, I_ROUTER_W) + (size_t)l * D * NE; const float* rb = kin(A, I_ROUTER_B) + l * NE; const float* g = kin(A, I_LN2_G) + l * D; const float* bb = kin(A, I_LN2_B) + l * D;
    for (int en = tid; en < 32 * 2 * 64; en += NTHREADS) { const int ln = en & 63, et = (en >> 6) & 1, ks = en >> 7, efr = ln & 15, efq = ln >> 4; float hi[8], lo[8];
#pragma unroll
        for (int j = 0; j < 8; ++j) { const int d = 32 * ks + 8 * efq + j; const float v = g[d] * rw[d * NE + et * 16 + efr]; const float h = bf2f(f2bf(v)); hi[j] = h; lo[j] = v - h; }
        v4u wh, wl; wh.x = pk2(hi[0], hi[1]); wh.y = pk2(hi[2], hi[3]); wh.z = pk2(hi[4], hi[5]); wh.w = pk2(hi[6], hi[7]); wl.x = pk2(lo[0], lo[1]); wl.y = pk2(lo[2], lo[3]); wl.z = pk2(lo[4], lo[5]); wl.w = pk2(lo[6], lo[7]);
        TB[((ks * 2 + et) * 2 + 0) * 64 + ln] = wh; TB[((ks * 2 + et) * 2 + 1) * 64 + ln] = wl; }
    { const int e = tid & 31, part = tid >> 5; float sg = 0.f, sb = 0.f;
      for (int d = part * 64; d < part * 64 + 64; ++d) { const float w = rw[d * NE + e]; sg += g[d] * w; sb += bb[d] * w; }
      PS[part * 32 + e] = sg; PS[512 + part * 32 + e] = sb; }
    if (tid < NE) hist[tid] = 0u;
    __syncthreads();
    if (tid < NE) { float sg = 0.f, sb = 0.f;
#pragma unroll
        for (int p = 0; p < 16; ++p) { sg += PS[p * 32 + tid]; sb += PS[512 + p * 32 + tid]; }
        PS[1024 + tid] = sg; PS[1056 + tid] = sb + rb[tid]; }
    __syncthreads();
    const float cg0 = PS[1024 + fr], cg1 = PS[1024 + 16 + fr], cb0 = PS[1056 + fr], cb1 = PS[1056 + 16 + fr];
    for (int grp = gw; grp < T / 16; grp += NGW) { const int r0 = grp * 16; const bf16* xrow = H + (size_t)(r0 + fr) * D + 8 * fq;
        f32x4 acc0 = {0, 0, 0, 0}, acc1 = {0, 0, 0, 0}; float sum = 0.f, sq = 0.f;
#pragma unroll 2
        for (int ks = 0; ks < 32; ++ks) { const v4u xw = *(const v4u*)(xrow + 32 * ks); f32x4 xa, xb; unpk8(xw, xa, xb);
            sum += (xa.x + xa.y) + (xa.z + xa.w) + (xb.x + xb.y) + (xb.z + xb.w);
            sq += (xa.x * xa.x + xa.y * xa.y) + (xa.z * xa.z + xa.w * xa.w) + (xb.x * xb.x + xb.y * xb.y) + (xb.z * xb.z + xb.w * xb.w);
            const LAS v4u* tb = TB + (ks * 4) * 64 + lane; const v4u b0h = tb[0], b0l = tb[64], b1h = tb[128], b1l = tb[192];
            const bf16x8 Ah = __builtin_bit_cast(bf16x8, xw);
            acc0 = __builtin_amdgcn_mfma_f32_16x16x32_bf16(Ah, __builtin_bit_cast(bf16x8, b0h), acc0, 0, 0, 0); acc0 = __builtin_amdgcn_mfma_f32_16x16x32_bf16(Ah, __builtin_bit_cast(bf16x8, b0l), acc0, 0, 0, 0);
            acc1 = __builtin_amdgcn_mfma_f32_16x16x32_bf16(Ah, __builtin_bit_cast(bf16x8, b1h), acc1, 0, 0, 0); acc1 = __builtin_amdgcn_mfma_f32_16x16x32_bf16(Ah, __builtin_bit_cast(bf16x8, b1l), acc1, 0, 0, 0); }
        sum += shfl_xor_l(sum, 16, lane); sum += shfl_xor_l(sum, 32, lane); sq += shfl_xor_l(sq, 16, lane); sq += shfl_xor_l(sq, 32, lane);
        const float mean = sum * (1.f / D), rstd = 1.0f / sqrtf(fmaxf(sq * (1.f / D) - mean * mean, 0.f) + LN_EPS);
        float v0[4], v1[4];
#pragma unroll
        for (int reg = 0; reg < 4; ++reg) { const float rs = __builtin_bit_cast(float, shfl_idx_l(__builtin_bit_cast(int, rstd), 4 * fq + reg)), mn = __builtin_bit_cast(float, shfl_idx_l(__builtin_bit_cast(int, mean), 4 * fq + reg));
            v0[reg] = rs * acc0[reg] - rs * mn * cg0 + cb0; v1[reg] = rs * acc1[reg] - rs * mn * cg1 + cb1; }
        float wv[4][4]; int wi[4][4];
#pragma unroll
        for (int k = 0; k < 4; ++k) {
#pragma unroll
            for (int reg = 0; reg < 4; ++reg) { float bv = v0[reg]; int bi = fr; if (v1[reg] > bv) { bv = v1[reg]; bi = 16 + fr; }
#pragma unroll
                for (int o = 1; o < 16; o <<= 1) { const float ov = shfl_xor_l(bv, o, lane); const int oi = shfl_idx_l(bi, lane ^ o); if (ov > bv || (ov == bv && oi < bi)) { bv = ov; bi = oi; } }
                wv[k][reg] = bv; wi[k][reg] = bi; if (bi == fr) v0[reg] = -3.0e38f; if (bi == 16 + fr) v1[reg] = -3.0e38f; } }
        if (fr == 0) {
#pragma unroll
            for (int reg = 0; reg < 4; ++reg) { const int t = r0 + 4 * fq + reg; const float e1 = __expf(wv[1][reg] - wv[0][reg]), e2 = __expf(wv[2][reg] - wv[0][reg]), e3 = __expf(wv[3][reg] - wv[0][reg]), inv = 1.0f / (1.0f + e1 + e2 + e3);
                *(int4*)(TOKE + (size_t)t * 4) = make_int4(wi[0][reg], wi[1][reg], wi[2][reg], wi[3][reg]); *(f32x4*)(TOKW + (size_t)t * 4) = (f32x4){inv, e1 * inv, e2 * inv, e3 * inv};
#pragma unroll
                for (int k = 0; k < 4; ++k) __hip_atomic_fetch_add((LAS unsigned*)&hist[wi[k][reg]], 1u, __ATOMIC_RELAXED, __HIP_MEMORY_SCOPE_WORKGROUP); } }
        bf16* o16 = H16 + (size_t)(r0 + fr) * D + 8 * fq;
#pragma unroll 2
        for (int ks = 0; ks < 32; ++ks) { f32x4 xa, xb; unpk8(*(const v4u*)(xrow + 32 * ks), xa, xb);
            const f32x4 ga = *(const f32x4*)(g + 32 * ks + 8 * fq), gb = *(const f32x4*)(g + 32 * ks + 8 * fq + 4), ba = *(const f32x4*)(bb + 32 * ks + 8 * fq), bc = *(const f32x4*)(bb + 32 * ks + 8 * fq + 4);
            *(v4u*)(o16 + 32 * ks) = pk8((xa - mean) * rstd * ga + ba, (xb - mean) * rstd * gb + bc); }
    }
    __syncthreads();
    if (tid < NE && !dummy) { const unsigned c = hist[tid]; if (c) atomicAdd(F.ctl + CW_CNT + l * NE + tid, c); F.ctl[CW_WGH + (l * 512 + F.bid) * NE + tid] = c; }
}
__device__ __forceinline__ void moe_offsets(const Frame& F, int l) {
    if (F.tid == 0) { int acc = 0;
        for (int e = 0; e < NE; ++e) { F.MISC[MI_TOFF + e] = (unsigned)acc; const unsigned c = __hip_atomic_load(F.ctl + CW_CNT + l * NE + e, __ATOMIC_RELAXED, __HIP_MEMORY_SCOPE_AGENT); acc += (int)((c + 255u) >> 8); }
        F.MISC[MI_TOFF + NE] = (unsigned)acc; }
    __syncthreads();
}
__device__ __forceinline__ void p_moe_slots(const Frame& F, int l, int dummy) {
    const int gw = F.bid * NWAVES + F.wave, NGW = F.G * NWAVES, lane = F.lane;
    moe_offsets(F, l);
    const int* TOKE = (const int*)(F.ws + WS_TOKE); const float* TOKW = (const float*)(F.ws + WS_TOKW); int* TOKS = (int*)(F.ws + (dummy ? WS_END : WS_TOKS)); float* SLOTW = (float*)(F.ws + (dummy ? WS_END + 1 * MiB : WS_SLOTW));
    const bf16* H16 = (const bf16*)(F.ws + WS_H16); bf16* XG = (bf16*)(F.ws + (dummy ? WS_ACT : WS_XG)); unsigned* CUR = F.ctl + CW_CUR + l * NE + dummy * 256;
    if (F.tid < NE) { const unsigned c = F.ctl[CW_WGH + (l * 512 + F.bid) * NE + F.tid]; const unsigned base = c ? atomicAdd(CUR + F.tid, c) : 0u;
        F.MISC[MI_LBASE + F.tid] = F.MISC[MI_TOFF + F.tid] * 256u + base; F.MISC[MI_LCUR + F.tid] = 0u; }
    __syncthreads();
    for (int grp = gw; grp < T / 16; grp += NGW)
    for (int r = grp * 16; r < grp * 16 + 16; ++r) { int slot = 0;
        if (lane < 4) { const int e = TOKE[(size_t)r * 4 + lane]; const unsigned pos = __hip_atomic_fetch_add((LAS unsigned*)&F.MISC[MI_LCUR + e], 1u, __ATOMIC_RELAXED, __HIP_MEMORY_SCOPE_WORKGROUP); slot = (int)(F.MISC[MI_LBASE + e] + pos);
            TOKS[(size_t)r * 4 + lane] = slot; SLOTW[slot] = TOKW[(size_t)r * 4 + lane]; }
        const v4u a = *(const v4u*)(H16 + (size_t)r * D + 8 * lane), b = *(const v4u*)(H16 + (size_t)r * D + 512 + 8 * lane);
#pragma unroll
        for (int k = 0; k < 4; ++k) { const int sk = shfl_idx_l(slot, k); *(v4u*)(XG + (size_t)sk * D + 8 * lane) = a; *(v4u*)(XG + (size_t)sk * D + 512 + 8 * lane) = b; } }
}
__device__ __forceinline__ void p_moe_combine(KArgs& A, const Frame& F, int l, bool dummy) {
    const int gw = F.bid * NWAVES + F.wave, NGW = F.G * NWAVES, lane = F.lane;
    const bf16* H = (const bf16*)(F.ws + WS_H16); bf16* H16 = (bf16*)(F.ws + (dummy ? WS_Z + 128 * MiB : WS_H16)); const int* TOKS = (const int*)(F.ws + WS_TOKS); const bf16* YS = (const bf16*)(F.ws + WS_YS);
    const bool last = (l == NL - 1) && !dummy;
    for (int r0 = gw * 2; r0 < T; r0 += NGW * 2) {
        int4 sl[2]; sl[0] = *(const int4*)(TOKS + (size_t)r0 * 4); sl[1] = *(const int4*)(TOKS + (size_t)(r0 + 1) * 4);
        v2u hh[2][4], ys[2][4][4];
#pragma unroll
        for (int i = 0; i < 2; ++i)
#pragma unroll
            for (int j = 0; j < 4; ++j) { const int o = 256 * j + 4 * lane; hh[i][j] = *(const v2u*)(H + (size_t)(r0 + i) * D + o);
                ys[i][j][0] = *(const v2u*)(YS + (size_t)sl[i].x * D + o); ys[i][j][1] = *(const v2u*)(YS + (size_t)sl[i].y * D + o); ys[i][j][2] = *(const v2u*)(YS + (size_t)sl[i].z * D + o); ys[i][j][3] = *(const v2u*)(YS + (size_t)sl[i].w * D + o); }
#pragma unroll
        for (int i = 0; i < 2; ++i) { f32x4 v[4]; const int r = r0 + i;
#pragma unroll
            for (int j = 0; j < 4; ++j) { const v2u h2 = hh[i][j], y0 = ys[i][j][0], y1 = ys[i][j][1], y2 = ys[i][j][2], y3 = ys[i][j][3];
                v[j].x = bf2f(h2.x & 0xffffu) * DN_ALPHA + ((bf2f(y0.x & 0xffffu) + bf2f(y1.x & 0xffffu)) + (bf2f(y2.x & 0xffffu) + bf2f(y3.x & 0xffffu)));
                v[j].y = bf2f(h2.x >> 16) * DN_ALPHA + ((bf2f(y0.x >> 16) + bf2f(y1.x >> 16)) + (bf2f(y2.x >> 16) + bf2f(y3.x >> 16)));
                v[j].z = bf2f(h2.y & 0xffffu) * DN_ALPHA + ((bf2f(y0.y & 0xffffu) + bf2f(y1.y & 0xffffu)) + (bf2f(y2.y & 0xffffu) + bf2f(y3.y & 0xffffu)));
                v[j].w = bf2f(h2.y >> 16) * DN_ALPHA + ((bf2f(y0.y >> 16) + bf2f(y1.y >> 16)) + (bf2f(y2.y >> 16) + bf2f(y3.y >> 16))); }
            float mean, rstd; ln_stats(v, mean, rstd);
            if (last) ln_apply_store(v, mean, rstd, kin(A, I_LN3_G) + l * D, kin(A, I_LN3_B) + l * D, kout(A) + (size_t)r * D, (bf16*)nullptr, lane);
            else ln_apply_store(v, mean, rstd, kin(A, I_LN3_G) + l * D, kin(A, I_LN3_B) + l * D, (float*)nullptr, H16 + (size_t)r * D, lane); } }
}

constexpr int NPL = 18;
constexpr int NPHASES = 1 + NL * NPL;
#ifndef ONLY
#define ONLY -1
#endif
#define EN(j) (ONLY < 0 || ONLY == (j))
#define DUMMY(j) ((PROBE_PHASE == (j)) && (rep_ + 1 < PROBE_REPS))
#define REPS(j) for (int rep_ = 0; rep_ < ((PROBE_PHASE == (j)) ? PROBE_REPS : 1); ++rep_, __syncthreads())
__global__ void __launch_bounds__(NTHREADS, 2) fwd_kernel(Args args) {
    extern __shared__ __attribute__((aligned(16))) unsigned char lds_raw[];
    Frame F;
    F.lds = (LAS unsigned char*)lds_raw; F.MISC = (volatile LAS unsigned*)(F.lds + MISC_OFF);
    F.tid = threadIdx.x; F.lane = F.tid & 63; F.wave = __builtin_amdgcn_readfirstlane(F.tid >> 6); F.G = gridDim.x; F.bid = blockIdx.x;
    F.ws = (unsigned char*)(GAS unsigned char*)args.ws; F.ctl = (unsigned*)(F.ws + WS_CTL);
    for (int u = F.tid; u < (LDS_BYTES - MISC_OFF) / 4; u += NTHREADS) F.MISC[u] = 0u;
    __syncthreads();
    XcdBarrier bar; bar.bar = F.ctl + CW_BAR; bar.x = 0; bar.st = nullptr;
    const int lo = args.ph_lo, hi = args.ph_hi;
    if (hi - lo > 1) bar = xcd_barrier_post(F.ctl + CW_BAR, F.MISC + 8);
#define IN(k) (launder_i(lo) <= (k) && (k) < launder_i(hi))
#define SEAM(k) do { if (IN(k) && IN((k) + 1)) xcd_barrier(bar); } while (0)
#define PH_BEGIN KArgs& KA = *kargs(); unsigned char* ws = launder_p(args.ws); F.ws = ws; (void)KA; (void)ws; { int ln_; asm volatile("v_mbcnt_lo_u32_b32 %0, -1, 0\n\tv_mbcnt_hi_u32_b32 %0, -1, %0" : "=v"(ln_)); F.lane = ln_; } F.tid = F.wave * 64 + F.lane; F.bid = launder_i((int)blockIdx.x); F.G = launder_i((int)gridDim.x);

    if (EN(100) && IN(0)) REPS(100) { PH_BEGIN p_prologue(KA, F); } SEAM(0);
    if (PROBE_PHASE == 300) { for (int q_ = 0; q_ < 20; ++q_) xcd_barrier(bar); }

#pragma unroll 1
    for (int l_ = 0; l_ < NL; ++l_) {
        const int l = launder_i(l_); const int p0 = 1 + l * NPL;
        if (EN(0) && IN(p0 + 0)) REPS(0) { PH_BEGIN
            pg8::Gemm g{D, D, D}; pg8::StaticOrder S{(const bf16*)(ws + WS_H16), (const bf16*)(ws + WS_WINT) + (size_t)l * N_IN * D, D, D, T / 256, N_IN / 256, F.G, F.bid};
            if (PROBE_PHASE == 200) { for (int q_ = 0; q_ < PROBE_REPS - 1; ++q_) { EpiNull E0{0}; pg8::gemm_phase(F.lds, F.wave * 64 + my_lane(), g, S, E0); __syncthreads(); } }
            EpiIn E{l};
            pg8::gemm_phase(F.lds, F.wave * 64 + my_lane(), g, S, E);
        } SEAM(p0 + 0);
        if (EN(1) && IN(p0 + 1)) REPS(1) { PH_BEGIN p_mix1(KA, F, l); } SEAM(p0 + 1);
        if (EN(2) && IN(p0 + 2)) REPS(2) { PH_BEGIN
            { pg8::Gemm g{S5K, 1024, 1024}; pg8::BatchOrder S{(const bf16*)(ws + WS_AOUT), (const bf16*)(ws + WS_S5BC) + (size_t)l * 16 * 256 * 1024, S5K, 1024, NCHT / 256, 1, 16, F.G, (F.bid + 192) % F.G, (size_t)NCHT * S5K, (size_t)256 * 1024};
              EpiXloc E{0}; pg8::gemm_phase(F.lds, F.wave * 64 + my_lane(), g, S, E); }
            __syncthreads();
            { pg8::Gemm g{D, D, D}; pg8::StaticOrder S{(const bf16*)(ws + WS_MEM16), (const bf16*)(ws + WS_WKT) + (size_t)l * D * D, D, D, NB * NMEM / 256, D / 256, F.G, (F.bid + 160) % F.G};
              EpiBf16 E{(unsigned)(WS_KM16 / MiB), 1.0f}; pg8::gemm_phase(F.lds, F.wave * 64 + my_lane(), g, S, E); }
            __syncthreads();
            { pg8::Gemm g{D, D, D}; pg8::StaticOrder S{(const bf16*)(ws + WS_MEM16), (const bf16*)(ws + WS_WVT) + (size_t)l * D * D, D, D, NB * NMEM / 256, D / 256, F.G, (F.bid + 144) % F.G};
              EpiVT E{0}; pg8::gemm_phase(F.lds, F.wave * 64 + my_lane(), g, S, E); }
            __syncthreads();
            { pg8::Gemm g{256, 256, 256}; pg8::StaticOrder S{(const bf16*)(ws + WS_LA16), (const bf16*)(ws + WS_LWT) + (size_t)l * 768 * 256, 256, 256, T / 256, 3, F.G, (F.bid + 128) % F.G};
              EpiLora E{l}; pg8::gemm_phase(F.lds, F.wave * 64 + my_lane(), g, S, E); }
        } SEAM(p0 + 2);
        if (EN(3) && IN(p0 + 3)) REPS(3) { PH_BEGIN
            for (int q_ = 0; q_ < ((PROBE_PHASE == 301) ? PROBE_REPS : 1); ++q_) p_s5_chain(KA, F, l);
            for (int q_ = 0; q_ < ((PROBE_PHASE == 302) ? PROBE_REPS : 1); ++q_) p_rw_chunks(KA, F, l); } SEAM(p0 + 3);
        if (EN(4) && IN(p0 + 4)) REPS(4) { PH_BEGIN
            p_chain_compose(F);
            pg8::Gemm g{S5K, S5K, S5K}; pg8::BatchOrder S{(const bf16*)(ws + WS_AOUT), (const bf16*)(ws + WS_S5BT) + (size_t)l * 16 * 1024 * S5K, S5K, S5K, NCHT / 256, 1024 / 256, 16, F.G, F.bid, (size_t)NCHT * S5K, (size_t)1024 * S5K};
            EpiS5Y E{l}; pg8::gemm_phase(F.lds, F.wave * 64 + my_lane(), g, S, E);
        } SEAM(p0 + 4);
        if (EN(5) && IN(p0 + 5)) REPS(5) { PH_BEGIN
            const int nchain = (F.G >= 128) ? 64 : 0;
            if (F.bid < nchain) { if (F.wave == 0) p_chain_blocks(F, F.bid, nchain); }
            else {
                if (nchain == 0) { p_chain_blocks(F, F.bid * NWAVES + F.wave, F.G * NWAVES); __syncthreads(); }
                pg8::Gemm g{256, 256, 256}; pg8::StaticOrder S{(const bf16*)(ws + WS_YD16), (const bf16*)(ws + WS_GLUT) + (size_t)l * 256 * 256, 256, 256, T / 256, 1, F.G - nchain, F.bid - nchain};
                EpiGlu E{l}; pg8::gemm_phase(F.lds, F.wave * 64 + my_lane(), g, S, E);
            }
        } SEAM(p0 + 5);
        if (EN(6) && IN(p0 + 6)) REPS(6) { PH_BEGIN
            for (int bb = F.bid; bb < 16 * NBLK; bb += F.G) {
                if (F.wave < 4) chain_inblock(F, bb, F.wave);
                VM_WAIT(); __syncthreads();
                rw_out_task(KA, F, l, bb * CB + F.wave);
                __syncthreads();
            }
        } SEAM(p0 + 6);
        if (EN(7) && IN(p0 + 7)) REPS(7) { PH_BEGIN
            pg8::Gemm g{D, 256, 256}; pg8::BranchOrder S{(const bf16*)(ws + WS_O16), (const bf16*)(ws + WS_BRT) + (size_t)l * 4 * D * 256, T / 256, D / 256, F.G, F.bid};
            EpiBranch E{0}; pg8::gemm_phase(F.lds, F.wave * 64 + my_lane(), g, S, E);
        } SEAM(p0 + 7);
        if (EN(8) && IN(p0 + 8)) REPS(8) { PH_BEGIN
            pg8::Gemm g{D, D, D}; pg8::StaticOrder S{(const bf16*)(ws + WS_MG16), (const bf16*)(ws + WS_WOUTT) + (size_t)l * D * D, D, D, T / 256, D / 256, F.G, F.bid};
            EpiResid E{0}; pg8::gemm_phase(F.lds, F.wave * 64 + my_lane(), g, S, E);
        } SEAM(p0 + 8);
        if (EN(9) && IN(p0 + 9)) REPS(9) { PH_BEGIN p_ln(F, kin(KA, I_LN1_G) + l * D, kin(KA, I_LN1_B) + l * D, DUMMY(9)); } SEAM(p0 + 9);
        if (EN(10) && IN(p0 + 10)) REPS(10) { PH_BEGIN
            pg8::Gemm g{D, D, D}; pg8::StaticOrder S{(const bf16*)(ws + WS_H16), (const bf16*)(ws + WS_WQT) + (size_t)l * D * D, D, D, T / 256, D / 256, F.G, F.bid};
            EpiBf16 E{(unsigned)(WS_Q16 / MiB), 0.0625f}; pg8::gemm_phase(F.lds, F.wave * 64 + my_lane(), g, S, E);
        } SEAM(p0 + 10);
        if (EN(11) && IN(p0 + 11)) REPS(11) { PH_BEGIN p_attn(F); } SEAM(p0 + 11);
        if (EN(12) && IN(p0 + 12)) REPS(12) { PH_BEGIN
            pg8::Gemm g{D, D, D}; pg8::StaticOrder S{(const bf16*)(ws + WS_AO16), (const bf16*)(ws + WS_WOT) + (size_t)l * D * D, D, D, T / 256, D / 256, F.G, F.bid};
            EpiResid E{0}; pg8::gemm_phase(F.lds, F.wave * 64 + my_lane(), g, S, E);
        } SEAM(p0 + 12);
        if (EN(13) && IN(p0 + 13)) REPS(13) { PH_BEGIN p_ln_router(KA, F, l, DUMMY(13)); } SEAM(p0 + 13);
        if (EN(14) && IN(p0 + 14)) REPS(14) { PH_BEGIN p_moe_slots(F, l, DUMMY(14) ? (rep_ + 1) : 0); } SEAM(p0 + 14);
        if (EN(15) && IN(p0 + 15)) REPS(15) { PH_BEGIN
            moe_offsets(F, l);
            pg8::Gemm g{D, D, D}; pg8::MoeOrder S{(const bf16*)(ws + WS_XG), (const bf16*)(ws + WS_W1T) + (size_t)l * NE * 2048 * D, D, D, 2048 / 256, F.G, F.bid, (size_t)2048 * D, (const LAS int*)(F.MISC + MI_TOFF)};
            if (PROBE_PHASE == 201) { for (int q_ = 0; q_ < PROBE_REPS - 1; ++q_) { EpiNull E0{0}; pg8::gemm_phase(F.lds, F.wave * 64 + my_lane(), g, S, E0); __syncthreads(); } }
            EpiSwiglu E{l}; pg8::gemm_phase(F.lds, F.wave * 64 + my_lane(), g, S, E);
        } SEAM(p0 + 15);
        if (EN(16) && IN(p0 + 16)) REPS(16) { PH_BEGIN
            moe_offsets(F, l);
            pg8::Gemm g{DFF, DFF, DFF}; pg8::MoeOrder S{(const bf16*)(ws + WS_ACT), (const bf16*)(ws + WS_W2T) + (size_t)l * NE * D * DFF, DFF, DFF, D / 256, F.G, F.bid, (size_t)D * DFF, (const LAS int*)(F.MISC + MI_TOFF)};
            EpiMoeOut E{l}; pg8::gemm_phase(F.lds, F.wave * 64 + my_lane(), g, S, E);
        } SEAM(p0 + 16);
        if (EN(17) && IN(p0 + 17)) REPS(17) { PH_BEGIN p_moe_combine(KA, F, l, DUMMY(17)); } SEAM(p0 + 17);
    }
#undef IN
#undef SEAM
}

extern "C" void kernel_launch(void* const* d_in, const int* in_sizes, int n_in, void* d_out, int out_size, void* d_ws, size_t ws_size, hipStream_t stream) {
    static int grid = 0;
    if (grid == 0) {
        if (n_in != 50 || ws_size < WS_END) { fprintf(stderr, "kernel_launch: unexpected n_in %d / ws_size %zu\n", n_in, ws_size); grid = -1; return; }
        int dev = 0, cus = 0, per_cu = 0;
        if (hipGetDevice(&dev) != hipSuccess || hipDeviceGetAttribute(&cus, hipDeviceAttributeMultiprocessorCount, dev) != hipSuccess) { grid = -1; return; }
        if (hipFuncSetAttribute((const void*)fwd_kernel, hipFuncAttributeMaxDynamicSharedMemorySize, LDS_BYTES) != hipSuccess) { fprintf(stderr, "kernel_launch: hipFuncSetAttribute failed\n"); grid = -1; return; }
        if (hipOccupancyMaxActiveBlocksPerMultiprocessor(&per_cu, (const void*)fwd_kernel, NTHREADS, LDS_BYTES) != hipSuccess || per_cu < 1) { fprintf(stderr, "kernel_launch: occupancy query says %d\n", per_cu); }
        (void)hipGetLastError();
        grid = cus;
    }
    if (grid < 0) return;
    (void)hipMemsetAsync((char*)d_ws + WS_CTL, 0, CTL_ZERO_BYTES, stream);
    Args a{};
    for (int i = 0; i < 50; ++i) a.in[i] = (const float*)d_in[i];
    a.out = (float*)d_out; a.ws = (unsigned char*)d_ws;
#if N_LAUNCHES == 1
    a.ph_lo = 0; a.ph_hi = NPHASES;
    hipLaunchKernelGGL(fwd_kernel, dim3(grid), dim3(NTHREADS), LDS_BYTES, stream, a);
#else
    for (int p = 0; p < NPHASES; ++p) { a.ph_lo = p; a.ph_hi = p + 1; hipLaunchKernelGGL(fwd_kernel, dim3(grid), dim3(NTHREADS), LDS_BYTES, stream, a); }
#endif
}
```

```cpp
#include <hip/hip_runtime.h>
#include <cstdio>
#include <cstdint>

#ifndef N_LAUNCHES
#define N_LAUNCHES 1
#endif

#ifndef PROBE_PHASE
#define PROBE_PHASE -1
#endif
#ifndef PROBE_REPS
#define PROBE_REPS 3
#endif
#define GAS __attribute__((address_space(1)))
#define LAS __attribute__((address_space(3)))
typedef unsigned short bf16;
typedef unsigned v4u __attribute__((ext_vector_type(4)));
typedef unsigned v2u __attribute__((ext_vector_type(2)));
typedef float f32x4 __attribute__((ext_vector_type(4)));
typedef float f32x2 __attribute__((ext_vector_type(2)));
typedef short bf16x8 __attribute__((ext_vector_type(8)));
typedef short bf16x4 __attribute__((ext_vector_type(4)));

constexpr int NL = 2, NB = 4, SEQ = 8192, T = NB * SEQ, D = 1024;
constexpr int NMEM = 256;
constexpr int OFF_B = 768, OFF_C = 1280, OFF_D = 2304, OFF_G = 2560, N_IN = 6656, ZLD = 2560;
constexpr int NE = 32, TOPK = 4, DFF = 1024;
constexpr int CH = 64;
constexpr int NCH = SEQ / CH;
constexpr int NCHT = T / CH;
constexpr int S5K = 1152;
constexpr int SLOT_ROWS = T * TOPK + NE * 256;
constexpr float LN_EPS = 1e-5f, RW_LN_EPS = 64e-5f;
constexpr float DN_ALPHA = 1.41421356237309515f;

constexpr size_t MiB = 1u << 20;
constexpr size_t WS_CTL = 0, CTL_ZERO_BYTES = 1 * MiB;
constexpr size_t WS_W1T = 2 * MiB;
constexpr size_t WS_W2T = 258 * MiB;
constexpr size_t WS_WINT = 386 * MiB;
constexpr size_t WS_BRT = 412 * MiB;
constexpr size_t WS_WOUTT = 416 * MiB, WS_WQT = 420 * MiB, WS_WKT = 424 * MiB, WS_WVT = 428 * MiB, WS_WOT = 432 * MiB;
constexpr size_t WS_GLUT = 436 * MiB;
constexpr size_t WS_SGW = 436 * MiB + 512 * 1024;
constexpr size_t WS_MEM16 = 437 * MiB;
constexpr size_t WS_S5BT = 440 * MiB;
constexpr size_t WS_S5BC = 512 * MiB;
constexpr size_t WS_PRE16 = 528 * MiB;
constexpr size_t WS_H16 = 656 * MiB;
constexpr size_t WS_Z = 720 * MiB;
constexpr size_t WS_XG = 720 * MiB;
constexpr size_t WS_SG = 1040 * MiB;
constexpr size_t WS_YS = 1040 * MiB;
constexpr size_t WS_O16 = 1312 * MiB, WS_MG16 = 1376 * MiB, WS_Q16 = 1440 * MiB, WS_AO16 = 1504 * MiB;
constexpr size_t WS_LA16 = 1568 * MiB;
constexpr size_t WS_DEC = 1584 * MiB, WS_AV = 1616 * MiB;
constexpr size_t WS_LWT = 2012 * MiB;
constexpr size_t WS_ACT = 1568 * MiB;
constexpr size_t WS_QH = 1760 * MiB, WS_YL = 1792 * MiB, WS_GC = 1824 * MiB, WS_HC = 1856 * MiB, WS_SC = 1888 * MiB, WS_RWG = 1920 * MiB;
constexpr size_t WS_RK = 1952 * MiB;
constexpr size_t WS_AOUT = 1954 * MiB;
constexpr size_t WS_XLOC = 1972 * MiB;
constexpr size_t WS_YD16 = 1976 * MiB;
constexpr size_t WS_KM16 = 1992 * MiB, WS_VMT16 = 1994 * MiB;
constexpr size_t WS_TOKE = 1996 * MiB, WS_TOKW = 1997 * MiB, WS_TOKS = 1998 * MiB, WS_SLOTW = 1999 * MiB;
constexpr size_t WS_GB = 2000 * MiB, WS_HB = 2004 * MiB, WS_SB = 2008 * MiB;
constexpr size_t WS_END = 2014 * MiB;
static_assert(WS_XG + (size_t)SLOT_ROWS * D * 2 <= WS_SG && WS_YS + (size_t)SLOT_ROWS * D * 2 <= WS_O16 && WS_ACT + (size_t)SLOT_ROWS * D * 2 <= WS_RK, "overlays");
constexpr int CW_BAR = 4096;
constexpr int CW_CNT = 16384;
constexpr int CW_CUR = 16384 + 128;
constexpr int CW_WGH = 65536;

constexpr int LDS_BYTES = 163840;
constexpr int MISC_OFF = LDS_BYTES - 1024;
constexpr int RING_BYTES = 131072;
constexpr int NWAVES = 8, NTHREADS = 512;

#define LDS_WAIT() asm volatile("s_waitcnt lgkmcnt(0)" ::: "memory")
#define VM_WAIT() asm volatile("s_waitcnt vmcnt(0)" ::: "memory")
__device__ __forceinline__ unsigned f2bf(float f) { unsigned u = __float_as_uint(f); return (u + 0x7fffu + ((u >> 16) & 1u)) >> 16; }
__device__ __forceinline__ unsigned pk2(float lo, float hi) { unsigned r; asm("v_cvt_pk_bf16_f32 %0, %1, %2" : "=v"(r) : "v"(lo), "v"(hi)); return r; }
__device__ __forceinline__ float bf2f(unsigned h) { return __uint_as_float(h << 16); }
__device__ __forceinline__ float sigmoidf_(float x) { return __builtin_amdgcn_rcpf(1.0f + __expf(-x)); }
__device__ __forceinline__ int my_lane() { int l; asm volatile("v_mbcnt_lo_u32_b32 %0, -1, 0\n\tv_mbcnt_hi_u32_b32 %0, -1, %0" : "=v"(l)); return l; }
__device__ __forceinline__ float shfl_xor_l(float v, int o, int lane) { return __builtin_bit_cast(float, __builtin_amdgcn_ds_bpermute((lane ^ o) << 2, __builtin_bit_cast(int, v))); }
__device__ __forceinline__ int shfl_idx_l(int v, int src) { return __builtin_amdgcn_ds_bpermute(src << 2, v); }
__device__ __forceinline__ void fmac_(float& c, float a, float b) { asm("v_fmac_f32 %0, %1, %2" : "+v"(c) : "v"(a), "v"(b)); }
template <int R> __device__ __forceinline__ void fmac_bc(float& c, float op, float x) { asm("v_fmac_f32_dpp %0, %1, %2 row_newbcast:%3 row_mask:0xf bank_mask:0xf" : "+v"(c) : "v"(op), "v"(x), "n"(R)); }
__device__ __forceinline__ float wave_sum(float v) {
    const int ln = my_lane();
#pragma unroll
    for (int o = 1; o < 64; o <<= 1) v += shfl_xor_l(v, o, ln);
    return v;
}

#define XB_TMO      128
#define XB_XCNT(j)  (256  + 64 * (j))
#define XB_XSUB(j)  (1280 + 64 * (j))
#define XB_XGEN(j)  (2304 + 64 * (j))
#define XB_TOP      3328
#define XB_TOPGEN   3392
#define XCD_BAR_WORDS 3456
#define XB_SPIN_CAP (1u << 24)
__device__ __forceinline__ unsigned xb_ld(unsigned* p)              { return __hip_atomic_load(p, __ATOMIC_RELAXED, __HIP_MEMORY_SCOPE_AGENT); }
__device__ __forceinline__ unsigned xb_add(unsigned* p, unsigned v) { return __hip_atomic_fetch_add(p, v, __ATOMIC_RELAXED, __HIP_MEMORY_SCOPE_AGENT); }
__device__ __forceinline__ unsigned xb_xcc_id() { return (unsigned)__builtin_amdgcn_s_getreg((3 << 11) | 20) & 0xFu; }
#define XB_SPIN(cond, bar) do { unsigned _sp = 0; while (cond) { __builtin_amdgcn_s_sleep(1); \
    if ((++_sp & 255u) == 0u) { if (xb_ld(&(bar)[XB_TMO])) break; if (_sp > XB_SPIN_CAP) { atomicAdd(&(bar)[XB_TMO], 1u); break; } } } } while (0)
struct XcdBarrier { unsigned* bar; unsigned x; volatile LAS unsigned* st; };
__device__ __forceinline__ XcdBarrier xcd_barrier_post(unsigned* bar, volatile LAS unsigned* st) {
    XcdBarrier b; b.bar = bar; b.x = xb_xcc_id(); b.st = st;
    if (threadIdx.x == 0) (void)xb_add(&bar[XB_XCNT(b.x)], 1u);
    return b;
}
__device__ __forceinline__ void xcd_barrier_complete(unsigned* bar, unsigned x, unsigned& nloc, unsigned& nx) {
    const unsigned G = gridDim.x * gridDim.y * gridDim.z;
    unsigned sum, cnt, mine, sp = 0u;
    for (;;) {
        sum = 0u; cnt = 0u; mine = 0u;
#pragma unroll
        for (unsigned j = 0; j < 16; ++j) { const unsigned c = xb_ld(&bar[XB_XCNT(j)]); sum += c; cnt += (c > 0u) ? 1u : 0u; mine = (j == x) ? c : mine; }
        if (sum == G) break;
        __builtin_amdgcn_s_sleep(1);
        if ((++sp & 255u) == 0u) { if (xb_ld(&bar[XB_TMO])) break; if (sp > XB_SPIN_CAP) { atomicAdd(&bar[XB_TMO], 1u); break; } }
    }
    nloc = mine > 0u ? mine : 1u; nx = cnt > 0u ? cnt : 1u;
}
__device__ __forceinline__ void xcd_barrier(const XcdBarrier& b) {
    asm volatile("s_waitcnt vmcnt(0)" ::: "memory");
    __syncthreads();
    if (threadIdx.x == 0) {
        unsigned* bar = b.bar; unsigned bx = b.x;
        asm volatile("" : "+s"(bar), "+s"(bx));
        __builtin_amdgcn_s_waitcnt(0);
        unsigned nloc = b.st[0], nx = b.st[1];
        if (nloc == 0u) { xcd_barrier_complete(bar, bx, nloc, nx); b.st[0] = nloc; b.st[1] = nx; }
        const unsigned old = xb_add(&bar[XB_XSUB(bx)], 1u);
        const unsigned gen = old / nloc;
        if (old + 1u == (gen + 1u) * nloc) {
            __builtin_amdgcn_fence(__ATOMIC_RELEASE, "agent");
            asm volatile("s_waitcnt vmcnt(0)" ::: "memory");
            const unsigned og = xb_add(&bar[XB_TOP], 1u);
            const unsigned tg = og / nx;
            if (og + 1u == (tg + 1u) * nx) xb_add(&bar[XB_TOPGEN], 1u);
            else XB_SPIN(xb_ld(&bar[XB_TOPGEN]) == tg, bar);
            __builtin_amdgcn_fence(__ATOMIC_ACQUIRE, "agent");
            xb_add(&bar[XB_XGEN(bx)], 1u);
            asm volatile("s_waitcnt vmcnt(0)" ::: "memory");
        } else {
            XB_SPIN(xb_ld(&bar[XB_XGEN(bx)]) == gen, bar);
            __builtin_amdgcn_fence(__ATOMIC_ACQUIRE, "agent");
            asm volatile("s_waitcnt vmcnt(0)" ::: "memory");
        }
    }
    __syncthreads();
}

namespace pg8 {
constexpr int BM = 256, BK = 64, HALF = 128, HTB = HALF * BK * 2, STAGE_BYTES = 8 * HTB, NXCD = 8, WGM = 8;
__host__ __device__ __forceinline__ int lds_byte(int r, int c) { const int st = (r >> 4) * 2 + (c >> 5), rr = r & 15, cc = c & 31, ob = rr * 64 + cc * 2; return st * 1024 + (ob ^ (((ob >> 9) & 1) << 5)); }
__host__ __device__ __forceinline__ int perm32(int rho) { const int n = rho >> 4, i = rho & 15; return 8 * (i >> 2) + 4 * n + (i & 3); }
__host__ __device__ __forceinline__ void stage_rc(int b, int& R, int& C) { const int st = b / 1024, sb = b % 1024, swz = sb ^ (((sb >> 9) & 1) << 5); R = (st >> 1) * 16 + swz / 64; C = (st & 1) * 32 + (swz % 64) / 2; }
struct Unit { int pm, pn, e; };
struct Gemm { int lda, ldb, K; };

__device__ __forceinline__ bool static_tile(int i, int G, int c, int nM, int nN, int& pm, int& pn) {
    const int nwg = nM * nN; const long L = (long)i * G + c; if (L >= nwg) return false;
    int wgid = (int)L; { const int q = nwg / NXCD, r = nwg % NXCD, xcd = wgid % NXCD, off = wgid / NXCD; wgid = (xcd < r ? xcd * (q + 1) : r * (q + 1) + (xcd - r) * q) + off; }
    const int nig = WGM * nN, gid = wgid / nig, fm = gid * WGM, gsz = (nM - fm) < WGM ? (nM - fm) : WGM;
    pm = fm + ((wgid % nig) % gsz); pn = (wgid % nig) / gsz; return true;
}
struct StaticOrder {
    const bf16* A; const bf16* Bt; int lda, ldb, nM, nN, G, c;
    __device__ __forceinline__ bool next(int i, Unit& u) const { u.e = 0; return static_tile(i, G, c, nM, nN, u.pm, u.pn); }
    __device__ __forceinline__ const char* a_base(const Unit& u) const { return (const char*)(A + (size_t)u.pm * BM * lda); }
    __device__ __forceinline__ const char* b_base(const Unit& u) const { return (const char*)(Bt + (size_t)u.pn * BM * ldb); }
};
struct BatchOrder {
    const bf16* A; const bf16* Bt; int lda, ldb, nM, nN, nb, G, c; size_t sA, sB;
    __device__ __forceinline__ bool next(int i, Unit& u) const {
        const long L = (long)i * G + c; const int per = nM * nN; if (L >= (long)per * nb) return false;
        u.e = (int)(L / per); const int r = (int)(L % per); u.pn = r / nM; u.pm = r % nM; return true; }
    __device__ __forceinline__ const char* a_base(const Unit& u) const { return (const char*)(A + (size_t)u.e * sA + (size_t)u.pm * BM * lda); }
    __device__ __forceinline__ const char* b_base(const Unit& u) const { return (const char*)(Bt + (size_t)u.e * sB + (size_t)u.pn * BM * ldb); }
};
struct BranchOrder {
    const bf16* A; const bf16* Bt; int nM, nN, G, c;
    __device__ __forceinline__ bool next(int i, Unit& u) const { u.e = i & 3; return static_tile(i >> 2, G, c, nM, nN, u.pm, u.pn); }
    __device__ __forceinline__ const char* a_base(const Unit& u) const { return (const char*)(A + (size_t)u.pm * BM * D + u.e * 256); }
    __device__ __forceinline__ const char* b_base(const Unit& u) const { return (const char*)(Bt + (size_t)u.e * D * 256 + (size_t)u.pn * BM * 256); }
};
struct MoeOrder {
    const bf16* A; const bf16* Bt; int lda, ldb, nN, G, c; size_t sB; const LAS int* toff;
    __device__ __forceinline__ bool next(int i, Unit& u) const {
        const int nt = toff[NE]; int mt;
        const int Gx = G >> 3;
        if ((G & 7) == 0 && (Gx % nN) == 0) {
            const int per = Gx / nN, x = c & 7, y = c >> 3;
            mt = i * 8 * per + x * per + y / nN; u.pn = y % nN; if (mt >= nt) return false;
        } else { const long L = (long)i * G + c; if (L >= (long)nt * nN) return false; mt = (int)(L / nN); u.pn = (int)(L % nN); }
        u.pm = mt; int e = 0;
#pragma unroll 1
        for (int k = 1; k < NE; ++k) e += (toff[k] <= mt) ? 1 : 0;
        u.e = e; return true; }
    __device__ __forceinline__ const char* a_base(const Unit& u) const { return (const char*)(A + (size_t)u.pm * BM * lda); }
    __device__ __forceinline__ const char* b_base(const Unit& u) const { return (const char*)(Bt + (size_t)u.e * sB + (size_t)u.pn * BM * ldb); }
};

template <class F> __device__ __forceinline__ void epi_foreach(const f32x4 (&acc)[2][2][4][2], const Unit& u, int wr, int wc, int fr, int fq, const F& f) {
#pragma unroll
    for (int ai = 0; ai < 2; ++ai)
#pragma unroll
        for (int m = 0; m < 4; ++m) { const int row = u.pm * BM + ai * HALF + wr * 64 + m * 16 + fr;
#pragma unroll
            for (int bj = 0; bj < 2; ++bj)
#pragma unroll
                for (int n = 0; n < 2; ++n) f(row, u.pn * BM + bj * HALF + wc * 32 + n * 16 + 4 * fq, acc[ai][bj][m][n]);
            if (m == 3) __builtin_amdgcn_sched_barrier(0); }
}

template <class F> __device__ __forceinline__ void epi_foreach8(const f32x4 (&acc)[2][2][4][2], const Unit& u, int wr, int wc, int fr, int fq, const F& f) {
#pragma unroll
    for (int ai = 0; ai < 2; ++ai)
#pragma unroll
        for (int m = 0; m < 4; ++m) { const int row = u.pm * BM + ai * HALF + wr * 64 + m * 16 + fr;
#pragma unroll
            for (int bj = 0; bj < 2; ++bj) f(row, u.pn * BM + bj * HALF + wc * 32 + 8 * fq, acc[ai][bj][m][0], acc[ai][bj][m][1]);
            if (m == 3) __builtin_amdgcn_sched_barrier(0); }
}
template <class Epi, class Sched, bool ALIGN_EPI = true, bool SP2 = true>
__device__ __forceinline__ void gemm_phase(LAS unsigned char* lds, const int tid, const Gemm g, const Sched& S, const Epi& E) {
    const int wid = __builtin_amdgcn_readfirstlane(tid >> 6), lane = tid & 63, wr = wid >> 2, wc = wid & 3, fr = lane & 15, fq = lane >> 4;
    const int K = g.K, nt = K / BK;
    unsigned voffA[2], voffB[2];
#pragma unroll
    for (int i = 0; i < 2; ++i) { int R, C; stage_rc(tid * 16 + i * 8192, R, C);
        const int Rb = Epi::PERM ? ((R & ~31) + perm32(R & 31)) : R;
        voffA[i] = (unsigned)(R * g.lda + C) * 2u; voffB[i] = (unsigned)(Rb * g.ldb + C) * 2u; }
    const size_t kstep = (size_t)(BK * 2);
    const size_t hstepA = (size_t)HALF * g.lda * 2, hstepB = (size_t)HALF * g.ldb * 2;
    const unsigned ldsw = (unsigned)wid * 1024u;
    const int aoff = lds_byte(wr * 64 + fr, fq * 8), boff = lds_byte(wc * 32 + fr, fq * 8);
#define PG8_SA(b, h) (((b) * 2 + (h)) * HTB)
#define PG8_SB(b, h) ((4 + (b) * 2 + (h)) * HTB)
#define PG8_STAGE(bufoff, gbase, voff) do { _Pragma("unroll") for (int _i = 0; _i < 2; ++_i) \
        __builtin_amdgcn_global_load_lds((const unsigned*)((const char*)(gbase) + (voff)[_i]), (LAS unsigned*)(lds + (bufoff) + ldsw + _i * 8192), 16, 0, 0); } while (0)
#define PG8_LDA(dst, b, h) do { _Pragma("unroll") for (int m = 0; m < 4; ++m) _Pragma("unroll") for (int k = 0; k < 2; ++k) dst[m][k] = *(const LAS bf16x8*)(lds + PG8_SA(b, h) + aoff + m * 2048 + k * 1024); } while (0)
#define PG8_LDB(dst, b, h) do { _Pragma("unroll") for (int n = 0; n < 2; ++n) _Pragma("unroll") for (int k = 0; k < 2; ++k) dst[n][k] = *(const LAS bf16x8*)(lds + PG8_SB(b, h) + boff + n * 2048 + k * 1024); } while (0)
#define PG8_MMA(ai, bj, At, Bt) do { __builtin_amdgcn_s_setprio(1); _Pragma("unroll") for (int m = 0; m < 4; ++m) _Pragma("unroll") for (int n = 0; n < 2; ++n) _Pragma("unroll") for (int k = 0; k < 2; ++k) \
        acc[ai][bj][m][n] = __builtin_amdgcn_mfma_f32_16x16x32_bf16(Bt[n][k], At[m][k], acc[ai][bj][m][n], 0, 0, 0); __builtin_amdgcn_s_setprio(0); } while (0)
#define PG8_WAIT_V(n) asm volatile("s_waitcnt vmcnt(" #n ")" ::: "memory")
#define PG8_WAIT_L(n) asm volatile("s_waitcnt lgkmcnt(" #n ")" ::: "memory")
#define PG8_BAR __builtin_amdgcn_s_barrier()
#define PG8_SCHED __builtin_amdgcn_sched_barrier(0)
    Unit cur, nxt; int ui = 0;
    if (!S.next(0, cur)) return;
    f32x4 acc[2][2][4][2];
#pragma unroll
    for (int a = 0; a < 2; ++a)
#pragma unroll
        for (int b = 0; b < 2; ++b)
#pragma unroll
            for (int m = 0; m < 4; ++m)
#pragma unroll
                for (int n = 0; n < 2; ++n) acc[a][b][m][n] = (f32x4){0.f, 0.f, 0.f, 0.f};
    bf16x8 At[4][2], B0[2][2], B1[2][2];
    const char* cA = S.a_base(cur); const char* cB = S.b_base(cur);
    if constexpr (SP2) {
        PG8_STAGE(PG8_SB(0, 0), cB, voffB); PG8_STAGE(PG8_SB(0, 1), cB + hstepB, voffB); PG8_STAGE(PG8_SA(0, 0), cA, voffA); PG8_STAGE(PG8_SA(0, 1), cA + hstepA, voffA);
        if (wr == 1) PG8_BAR;
        PG8_WAIT_V(2); PG8_BAR;
        PG8_STAGE(PG8_SB(1, 0), cB + kstep, voffB); PG8_STAGE(PG8_SA(1, 0), cA + kstep, voffA); PG8_STAGE(PG8_SB(1, 1), cB + hstepB + kstep, voffB);
        PG8_WAIT_V(6); PG8_BAR;
    } else {
        PG8_STAGE(PG8_SB(0, 0), cB, voffB); PG8_STAGE(PG8_SA(0, 0), cA, voffA); PG8_STAGE(PG8_SB(0, 1), cB + hstepB, voffB); PG8_STAGE(PG8_SA(0, 1), cA + hstepA, voffA);
        if (wr == 1) PG8_BAR;
        PG8_WAIT_V(4); PG8_BAR;
        PG8_STAGE(PG8_SB(1, 0), cB + kstep, voffB); PG8_STAGE(PG8_SA(1, 0), cA + kstep, voffA); PG8_STAGE(PG8_SB(1, 1), cB + hstepB + kstep, voffB);
        PG8_WAIT_V(6); PG8_BAR;
    }
    for (;;) {
        const bool has_next = S.next(ui + 1, nxt);
        const char* nA = has_next ? S.a_base(nxt) : cA; const char* nB = has_next ? S.b_base(nxt) : cB;
        for (int t = 0; t < nt; t += 2) {
            const bool last = (t == nt - 2);
            const char* a1 = cA + (size_t)(t + 1) * kstep;
            const char* a2 = last ? nA : cA + (size_t)(t + 2) * kstep; const char* b2 = last ? nB : cB + (size_t)(t + 2) * kstep;
            const char* a3 = a2 + kstep; const char* b3 = b2 + kstep;
            if constexpr (SP2) {
            PG8_LDB(B0, 0, 0); PG8_LDB(B1, 0, 1); PG8_SCHED; PG8_LDA(At, 0, 0); PG8_STAGE(PG8_SA(1, 1), a1 + hstepA, voffA);
            PG8_WAIT_V(8); PG8_WAIT_L(0); PG8_BAR; PG8_MMA(0, 0, At, B0); PG8_MMA(0, 1, At, B1); PG8_BAR; PG8_SCHED;
            PG8_LDA(At, 0, 1); PG8_STAGE(PG8_SB(0, 0), b2, voffB); PG8_STAGE(PG8_SB(0, 1), b2 + hstepB, voffB); PG8_STAGE(PG8_SA(0, 0), a2, voffA);
            PG8_WAIT_V(8); PG8_WAIT_L(0); PG8_BAR; PG8_MMA(1, 0, At, B0); PG8_MMA(1, 1, At, B1); PG8_BAR; PG8_SCHED;
            PG8_LDB(B0, 1, 0); PG8_LDB(B1, 1, 1); PG8_SCHED; PG8_LDA(At, 1, 0); PG8_STAGE(PG8_SA(0, 1), a2 + hstepA, voffA);
            PG8_WAIT_V(8); PG8_WAIT_L(0); PG8_BAR; PG8_MMA(0, 0, At, B0); PG8_MMA(0, 1, At, B1); PG8_BAR; PG8_SCHED;
            PG8_LDA(At, 1, 1); PG8_STAGE(PG8_SB(1, 0), b3, voffB); PG8_STAGE(PG8_SB(1, 1), b3 + hstepB, voffB); PG8_STAGE(PG8_SA(1, 0), a3, voffA);
            PG8_WAIT_V(8); PG8_WAIT_L(0); PG8_BAR; PG8_MMA(1, 0, At, B0); PG8_MMA(1, 1, At, B1); PG8_BAR; PG8_SCHED;
            } else {
            PG8_LDB(B0, 0, 0); PG8_SCHED; PG8_LDA(At, 0, 0); PG8_STAGE(PG8_SA(1, 1), a1 + hstepA, voffA);
            PG8_WAIT_L(8); PG8_BAR; PG8_WAIT_L(0); PG8_MMA(0, 0, At, B0); PG8_BAR; PG8_SCHED;
            PG8_LDB(B1, 0, 1); PG8_STAGE(PG8_SB(0, 0), b2, voffB);
            PG8_BAR; PG8_WAIT_L(0); PG8_MMA(0, 1, At, B1); PG8_BAR;
            PG8_LDA(At, 0, 1); PG8_STAGE(PG8_SA(0, 0), a2, voffA);
            PG8_BAR; PG8_WAIT_L(0); PG8_MMA(1, 0, At, B0); PG8_BAR; PG8_SCHED;
            PG8_STAGE(PG8_SB(0, 1), b2 + hstepB, voffB);
            PG8_WAIT_V(6); PG8_BAR; PG8_MMA(1, 1, At, B1); PG8_BAR;
            PG8_LDB(B0, 1, 0); PG8_SCHED; PG8_LDA(At, 1, 0); PG8_STAGE(PG8_SA(0, 1), a2 + hstepA, voffA);
            PG8_WAIT_L(8); PG8_BAR; PG8_WAIT_L(0); PG8_MMA(0, 0, At, B0); PG8_BAR; PG8_SCHED;
            PG8_LDB(B1, 1, 1); PG8_STAGE(PG8_SB(1, 0), b3, voffB);
            PG8_BAR; PG8_WAIT_L(0); PG8_MMA(0, 1, At, B1); PG8_BAR;
            PG8_LDA(At, 1, 1); PG8_STAGE(PG8_SA(1, 0), a3, voffA);
            PG8_BAR; PG8_WAIT_L(0); PG8_MMA(1, 0, At, B0); PG8_BAR; PG8_SCHED;
            PG8_STAGE(PG8_SB(1, 1), b3 + hstepB, voffB);
            PG8_WAIT_V(6); PG8_BAR; PG8_MMA(1, 1, At, B1); PG8_BAR;
            }
        }
        if constexpr (ALIGN_EPI) { if (wr == 0) PG8_BAR; }
        { const int lane2 = my_lane();
          E(acc, cur, wid >> 2, wid & 3, lane2 & 15, lane2 >> 4); }
        if (!has_next) break;
        if (!Epi::keep_acc(cur)) {
#pragma unroll
        for (int a = 0; a < 2; ++a)
#pragma unroll
            for (int b = 0; b < 2; ++b)
#pragma unroll
                for (int m = 0; m < 4; ++m)
#pragma unroll
                    for (int n = 0; n < 2; ++n) acc[a][b][m][n] = (f32x4){0.f, 0.f, 0.f, 0.f};
        }
        cur = nxt; cA = nA; cB = nB; ++ui;
        if constexpr (ALIGN_EPI) { if (wr == 1) PG8_BAR; }
    }
    PG8_WAIT_V(0);
    if constexpr (!ALIGN_EPI) { if (wr == 0) PG8_BAR; }
    PG8_BAR;
#undef PG8_SA
#undef PG8_SB
#undef PG8_STAGE
#undef PG8_LDA
#undef PG8_LDB
#undef PG8_MMA
#undef PG8_WAIT_V
#undef PG8_WAIT_L
#undef PG8_BAR
#undef PG8_SCHED
}
}
using pg8::Unit;

struct Args { const float* in[50]; float* out; unsigned char* ws; int ph_lo, ph_hi; };
typedef const __attribute__((address_space(4))) Args KArgs;
__device__ __forceinline__ KArgs* kargs() { KArgs* p = (KArgs*)__builtin_amdgcn_kernarg_segment_ptr(); asm volatile("" : "+s"(p)); return p; }
__device__ __forceinline__ unsigned char* launder_p(unsigned char* p) { asm volatile("" : "+s"(p)); return (unsigned char*)(GAS unsigned char*)p; }
__device__ __forceinline__ const float* kin(KArgs& A, int i) { return (const float*)(const GAS float*)A.in[i]; }
__device__ __forceinline__ float* kout(KArgs& A) { return (float*)(GAS float*)A.out; }
__device__ __forceinline__ unsigned char* kws(KArgs& A) { return (unsigned char*)(GAS unsigned char*)A.ws; }
__device__ __forceinline__ int launder_i(int v) { asm volatile("" : "+s"(v)); return v; }
__device__ __forceinline__ int launder_v(int v) { asm volatile("" : "+v"(v)); return v; }
enum { I_X = 0, I_MEM, I_LN_IN_G, I_LN_IN_B, I_W_IN, I_CONV_W, I_SG_NG, I_SG_NB, I_SG_W, I_SG_B, I_RW_MU, I_RW_W0, I_RW_WUP, I_RW_A0, I_RW_AUP, I_RW_GUP,
       I_RW_KK, I_RW_KA, I_RW_RK, I_RW_LNG, I_RW_LNB, I_S5_ARE, I_S5_AIM, I_S5_BRE, I_S5_BIM, I_S5_CRE, I_S5_CIM, I_S5_D, I_S5_LOGDT, I_S5_GLUW, I_S5_GLUB,
       I_BR_PROJ, I_GATE_B, I_W_OUT, I_LN1_G, I_LN1_B, I_XA_WQ, I_XA_WK, I_XA_WV, I_XA_WO, I_LN2_G, I_LN2_B, I_ROUTER_W, I_ROUTER_B, I_EX_W1, I_EX_B1, I_EX_W2, I_EX_B2,
       I_LN3_G, I_LN3_B };
struct Frame { LAS unsigned char* lds; volatile LAS unsigned* MISC; unsigned* ctl; unsigned char* ws; int tid, lane, wave, G, bid; };
constexpr int MI_TOFF = 16, MI_HIST = 64, MI_LBASE = 96, MI_LCUR = 128;

__device__ __forceinline__ void ln_stats(const f32x4 (&v)[4], float& mean, float& rstd) {
    float s = 0.f;
#pragma unroll
    for (int j = 0; j < 4; ++j) s += (v[j].x + v[j].y) + (v[j].z + v[j].w);
    mean = wave_sum(s) * (1.f / D); float s2 = 0.f;
#pragma unroll
    for (int j = 0; j < 4; ++j) { const f32x4 d = v[j] - mean; s2 += (d.x * d.x + d.y * d.y) + (d.z * d.z + d.w * d.w); }
    rstd = 1.0f / sqrtf(wave_sum(s2) * (1.f / D) + LN_EPS);
}
__device__ __forceinline__ void ln_apply_store(const f32x4 (&v)[4], float mean, float rstd, const float* g, const float* b, float* o32, bf16* o16, int lane) {
#pragma unroll
    for (int j = 0; j < 4; ++j) {
        const f32x4 gg = *(const f32x4*)(g + 256 * j + 4 * lane), bb = *(const f32x4*)(b + 256 * j + 4 * lane);
        const f32x4 y = (v[j] - mean) * rstd * gg + bb;
        if (o32) *(f32x4*)(o32 + 256 * j + 4 * lane) = y;
        if (o16) { v2u w; w.x = pk2(y.x, y.y); w.y = pk2(y.z, y.w); *(v2u*)(o16 + 256 * j + 4 * lane) = w; }
    }
}

__device__ __forceinline__ void transpose_item(const float* W, int K, int N, bf16* WT, int mode, LAS float* scr, int item, int lane) {
    const int nblk = N / 32, kb = item / nblk, nb = item % nblk, k0 = 64 * kb, n0 = 32 * nb;
    { float tv[32]; const float* wp = W + (size_t)(k0 + (lane >> 5)) * N + n0 + (lane & 31);
#pragma unroll
      for (int i = 0; i < 32; ++i) tv[i] = wp[(size_t)(2 * i) * N];
#pragma unroll
      for (int i = 0; i < 32; ++i) scr[(2 * i + (lane >> 5)) * 33 + (lane & 31)] = tv[i]; }
    LDS_WAIT();
    const int c = lane & 7;
#pragma unroll
    for (int j = 0; j < 4; ++j) { const int n = (lane >> 3) + 8 * j; const LAS float* s = scr + (8 * c) * 33 + n;
        v4u o; o.x = pk2(s[0 * 33], s[1 * 33]); o.y = pk2(s[2 * 33], s[3 * 33]); o.z = pk2(s[4 * 33], s[5 * 33]); o.w = pk2(s[6 * 33], s[7 * 33]);
        const int nn = n0 + n; const int jj = nn >> 1;
        const int row = mode ? ((jj >> 7) * 256 + (nn & 1) * 128 + (jj & 127)) : nn;
        *(v4u*)(WT + (size_t)row * K + k0 + 8 * c) = o; }
    LDS_WAIT();
}
__device__ __forceinline__ void s5_setup_item(KArgs& A, const Frame& F, int item) {
    const int l = item >> 4, g = item & 15, tid = F.tid;
    LAS float* Kt = (LAS float*)F.lds;
    LAS float* Pw = (LAS float*)(F.lds + 65536);
    LAS float* Bb = (LAS float*)(F.lds + 65536 + 33280);
    LAS float* Cc = Bb + 2048;
    const float* a_re = kin(A, I_S5_ARE) + (l * 16 + g) * 64; const float* a_im = kin(A, I_S5_AIM) + (l * 16 + g) * 64;
    const float* b_re = kin(A, I_S5_BRE) + (size_t)(l * 16 + g) * 1024; const float* b_im = kin(A, I_S5_BIM) + (size_t)(l * 16 + g) * 1024;
    const float* c_re = kin(A, I_S5_CRE) + (size_t)(l * 16 + g) * 1024; const float* c_im = kin(A, I_S5_CIM) + (size_t)(l * 16 + g) * 1024;
    const float dt = expf(kin(A, I_S5_LOGDT)[l * 16 + g]);
    for (int o = tid; o < 65 * 64; o += NTHREADS) { const int n = o >> 6, p = o & 63; const float mag = expf(a_re[p] * dt * (float)n); float sn, cs; sincosf(a_im[p] * dt * (float)n, &sn, &cs);
        Pw[o * 2] = mag * cs; Pw[o * 2 + 1] = mag * sn; }
    for (int o = tid; o < 1024; o += NTHREADS) { const int p = o >> 4;
        const float are = a_re[p], aim = a_im[p], mag = expf(are * dt); float sn, cs; sincosf(aim * dt, &sn, &cs); const float abr = mag * cs, abi = mag * sn;
        const float den = are * are + aim * aim, nr = abr - 1.0f, cr = (nr * are + abi * aim) / den, ci = (abi * are - nr * aim) / den;
        const float br = b_re[o], bi = b_im[o]; Bb[o * 2] = cr * br - ci * bi; Bb[o * 2 + 1] = cr * bi + ci * br; }
    for (int o = tid; o < 1024; o += NTHREADS) { Cc[o * 2] = c_re[o]; Cc[o * 2 + 1] = c_im[o]; }
    __syncthreads();
    for (int o = tid; o < 16384; o += NTHREADS) { const int tau = o >> 8, c = (o >> 4) & 15, cp = o & 15; float acc = 0.f;
        for (int p = 0; p < 64; ++p) { const float cr = Cc[(c * 64 + p) * 2], ci = Cc[(c * 64 + p) * 2 + 1], pr = Pw[(tau * 64 + p) * 2], pi = Pw[(tau * 64 + p) * 2 + 1];
            const float er = cr * pr - ci * pi, ei = cr * pi + ci * pr; acc += er * Bb[(p * 16 + cp) * 2] - ei * Bb[(p * 16 + cp) * 2 + 1]; }
        Kt[o] = acc; }
    __syncthreads();
    bf16* Bt = (bf16*)(F.ws + WS_S5BT) + (size_t)(l * 16 + g) * 1024 * S5K;
    for (int o = tid; o < 1024 * 128; o += NTHREADS) { const int rr = o >> 7, q = o & 127, t = rr >> 4, c = rr & 15, s = q >> 1, cp0 = (q & 1) * 8;
        v4u w = {0u, 0u, 0u, 0u};
        if (s <= t) { const LAS float* k = Kt + ((t - s) * 16 + c) * 16 + cp0; w.x = pk2(k[0], k[1]); w.y = pk2(k[2], k[3]); w.z = pk2(k[4], k[5]); w.w = pk2(k[6], k[7]); }
        *(v4u*)(Bt + (size_t)rr * S5K + q * 8) = w; }
    for (int o = tid; o < 1024 * 16; o += NTHREADS) { const int rr = o >> 4, q = o & 15, t = rr >> 4, c = rr & 15; float vals[8];
#pragma unroll
        for (int j = 0; j < 4; ++j) { const int p = 4 * q + j; const float cr = Cc[(c * 64 + p) * 2], ci = Cc[(c * 64 + p) * 2 + 1], pr = Pw[((t + 1) * 64 + p) * 2], pi = Pw[((t + 1) * 64 + p) * 2 + 1];
            vals[2 * j] = cr * pr - ci * pi; vals[2 * j + 1] = -(cr * pi + ci * pr); }
        v4u w; w.x = pk2(vals[0], vals[1]); w.y = pk2(vals[2], vals[3]); w.z = pk2(vals[4], vals[5]); w.w = pk2(vals[6], vals[7]);
        *(v4u*)(Bt + (size_t)rr * S5K + 1024 + q * 8) = w; }
    bf16* Bc = (bf16*)(F.ws + WS_S5BC) + (size_t)(l * 16 + g) * 256 * 1024;
    for (int o = tid; o < 128 * 128; o += NTHREADS) { const int row = o >> 7, q = o & 127, p = row >> 1, im = row & 1, s = q >> 1, cp0 = (q & 1) * 8;
        const float pr = Pw[((63 - s) * 64 + p) * 2], pi = Pw[((63 - s) * 64 + p) * 2 + 1]; float vals[8];
#pragma unroll
        for (int j = 0; j < 8; ++j) { const float br = Bb[(p * 16 + cp0 + j) * 2], bi = Bb[(p * 16 + cp0 + j) * 2 + 1]; vals[j] = im ? (pr * bi + pi * br) : (pr * br - pi * bi); }
        v4u w; w.x = pk2(vals[0], vals[1]); w.y = pk2(vals[2], vals[3]); w.z = pk2(vals[4], vals[5]); w.w = pk2(vals[6], vals[7]);
        *(v4u*)(Bc + (size_t)row * 1024 + q * 8) = w;
        *(v4u*)(Bc + (size_t)(128 + row) * 1024 + q * 8) = (v4u){0u, 0u, 0u, 0u}; }
    __syncthreads();
}
__device__ __forceinline__ void p_prologue(KArgs& A, const Frame& F) {
    const int gw = F.bid * NWAVES + F.wave, NGW = F.G * NWAVES, lane = F.lane;
    for (int item = F.bid; item < NL * 16; item += F.G) s5_setup_item(A, F, item);
    LAS float* scr = (LAS float*)(F.lds + F.wave * 16384);
#pragma unroll 1
    for (int d = 0; d < 10; ++d) {
        const float* src; bf16* dst; int K, N, batch, mode = 0;
        switch (d) {
            case 0: src = kin(A, I_EX_W1); dst = (bf16*)(F.ws + WS_W1T); K = 1024; N = 2048; batch = NL * NE; mode = 1; break;
            case 1: src = kin(A, I_EX_W2); dst = (bf16*)(F.ws + WS_W2T); K = 1024; N = 1024; batch = NL * NE; break;
            case 2: src = kin(A, I_W_IN); dst = (bf16*)(F.ws + WS_WINT); K = 1024; N = N_IN; batch = NL; break;
            case 3: src = kin(A, I_BR_PROJ); dst = (bf16*)(F.ws + WS_BRT); K = 256; N = 1024; batch = NL * 4; break;
            case 4: src = kin(A, I_W_OUT); dst = (bf16*)(F.ws + WS_WOUTT); K = 1024; N = 1024; batch = NL; break;
            case 5: src = kin(A, I_XA_WQ); dst = (bf16*)(F.ws + WS_WQT); K = 1024; N = 1024; batch = NL; break;
            case 6: src = kin(A, I_XA_WK); dst = (bf16*)(F.ws + WS_WKT); K = 1024; N = 1024; batch = NL; break;
            case 7: src = kin(A, I_XA_WV); dst = (bf16*)(F.ws + WS_WVT); K = 1024; N = 1024; batch = NL; break;
            case 8: src = kin(A, I_XA_WO); dst = (bf16*)(F.ws + WS_WOT); K = 1024; N = 1024; batch = NL; break;
            default: src = kin(A, I_S5_GLUW); dst = (bf16*)(F.ws + WS_GLUT); K = 256; N = 256; batch = NL; break;
        }
        const int per = (K / 64) * (N / 32), nitems = per * batch;
        for (int it = gw; it < nitems; it += NGW) { const int b = it / per, r = it - b * per;
            transpose_item(src + (size_t)b * K * N, K, N, dst + (size_t)b * K * N, mode, scr, r, lane); }
    }
    { bf16* lwt = (bf16*)(F.ws + WS_LWT);
      for (int it = gw * 64 + lane; it < NL * 768 * 32; it += NGW * 64) { const int kc = it & 31, row = (it >> 5) % 768, ll = it / (768 * 32), blk = row >> 8, c = row & 255, k0 = kc * 8; float v[8];
#pragma unroll
          for (int j = 0; j < 8; ++j) { const int k = k0 + j; float x = 0.f;
              if (blk == 0 && k < 64) x = kin(A, I_RW_WUP)[((size_t)ll * 64 + k) * 256 + c];
              else if (blk == 1 && k >= 64 && k < 128) x = kin(A, I_RW_AUP)[((size_t)ll * 64 + (k - 64)) * 256 + c];
              else if (blk == 2 && k >= 128) x = kin(A, I_RW_GUP)[((size_t)ll * 128 + (k - 128)) * 256 + c];
              v[j] = x; }
          v4u w; w.x = pk2(v[0], v[1]); w.y = pk2(v[2], v[3]); w.z = pk2(v[4], v[5]); w.w = pk2(v[6], v[7]);
          *(v4u*)(lwt + ((size_t)ll * 768 + row) * 256 + k0) = w; } }
    { bf16* sgw = (bf16*)(F.ws + WS_SGW); const float* src = kin(A, I_SG_W);
      for (int it = gw * 64 + lane; it < NL * 4 * 128 * 16; it += NGW * 64) { const int j0 = (it & 15) * 8, i = (it >> 4) & 127; const float* sp = src + (size_t)(it >> 4) * 128 + j0; float v[8];
#pragma unroll
          for (int e = 0; e < 8; ++e) v[e] = ((j0 + e) >> 6) <= (i >> 6) ? sp[e] : 0.f;
          v4u w; w.x = pk2(v[0], v[1]); w.y = pk2(v[2], v[3]); w.z = pk2(v[4], v[5]); w.w = pk2(v[6], v[7]); *(v4u*)(sgw + (size_t)(it >> 4) * 128 + j0) = w; } }
    { const float* mem = kin(A, I_MEM); bf16* m16 = (bf16*)(F.ws + WS_MEM16);
      for (int r = gw; r < NB * NMEM; r += NGW) {
#pragma unroll
          for (int j = 0; j < 4; ++j) { const f32x4 v = *(const f32x4*)(mem + (size_t)r * D + 256 * j + 4 * lane); v2u w; w.x = pk2(v.x, v.y); w.y = pk2(v.z, v.w); *(v2u*)(m16 + (size_t)r * D + 256 * j + 4 * lane) = w; } } }
    { const float* x = kin(A, I_X); float* h32 = nullptr; bf16* h16 = (bf16*)(F.ws + WS_H16);
      for (int r0 = gw * 2; r0 < T; r0 += NGW * 2) { f32x4 v[2][4];
#pragma unroll
          for (int i = 0; i < 2; ++i)
#pragma unroll
              for (int j = 0; j < 4; ++j) v[i][j] = *(const f32x4*)(x + (size_t)(r0 + i) * D + 256 * j + 4 * lane);
#pragma unroll
          for (int i = 0; i < 2; ++i) { float mean, rstd; ln_stats(v[i], mean, rstd);
              ln_apply_store(v[i], mean, rstd, kin(A, I_LN_IN_G), kin(A, I_LN_IN_B), h32, h16 + (size_t)(r0 + i) * D, lane); } } }
}

typedef f32x4 AccT[2][2][4][2];
#define EPI_BASES KArgs& KA = *kargs(); unsigned char* ws = kws(KA); (void)ws;
__device__ __forceinline__ v4u pk8(const f32x4 a, const f32x4 b) { v4u w; w.x = pk2(a.x, a.y); w.y = pk2(a.z, a.w); w.z = pk2(b.x, b.y); w.w = pk2(b.z, b.w); return w; }
__device__ __forceinline__ void unpk8(const v4u w, f32x4& a, f32x4& b) { a.x = bf2f(w.x & 0xffffu); a.y = bf2f(w.x >> 16); a.z = bf2f(w.y & 0xffffu); a.w = bf2f(w.y >> 16); b.x = bf2f(w.z & 0xffffu); b.y = bf2f(w.z >> 16); b.z = bf2f(w.w & 0xffffu); b.w = bf2f(w.w >> 16); }
__device__ __forceinline__ f32x4 ld4bf(const bf16* p) { const v2u w = *(const v2u*)p; f32x4 a; a.x = bf2f(w.x & 0xffffu); a.y = bf2f(w.x >> 16); a.z = bf2f(w.y & 0xffffu); a.w = bf2f(w.y >> 16); return a; }
__device__ __forceinline__ f32x4 sig4(const f32x4 v) { return (f32x4){sigmoidf_(v.x), sigmoidf_(v.y), sigmoidf_(v.z), sigmoidf_(v.w)}; }
struct EpiNull { static constexpr bool PERM = false; static __device__ __forceinline__ bool keep_acc(const Unit&) { return false; } int dummy;
    __device__ __forceinline__ void operator()(const AccT& acc, const Unit& u, int wr, int wc, int fr, int fq) const { f32x4 t = {0, 0, 0, 0};
#pragma unroll
        for (int a = 0; a < 2; ++a)
#pragma unroll
            for (int b = 0; b < 2; ++b)
#pragma unroll
                for (int m = 0; m < 4; ++m) { t += acc[a][b][m][0]; t += acc[a][b][m][1]; }
        if (t.x + t.y + t.z + t.w == 1234.5f) { EPI_BASES *(f32x4*)(ws + WS_END) = t; } } };
struct EpiIn { static constexpr bool PERM = true; static __device__ __forceinline__ bool keep_acc(const Unit&) { return false; } int l;
    __device__ __forceinline__ void operator()(const AccT& acc, const Unit& u, int wr, int wc, int fr, int fq) const { EPI_BASES
        bf16* Z = (bf16*)(ws + WS_Z); bf16* SG = (bf16*)(ws + WS_SG); bf16* AOUT = (bf16*)(ws + WS_AOUT); const float* gate_b = kin(KA, I_GATE_B) + (size_t)l * 4096;
        if (u.pn < 10) {
            pg8::epi_foreach8(acc, u, wr, wc, fr, fq, [&](int row, int col, f32x4 v0, f32x4 v1) { const v4u w = pk8(v0, v1);
                *(v4u*)(Z + (size_t)row * ZLD + col) = w;
                if (u.pn == 9) { const int cc = col - OFF_D, g = cc >> 4, c0 = cc & 15, chunk = row >> 6, s = row & 63; *(v4u*)(AOUT + ((size_t)(g * NCHT + chunk)) * S5K + s * 16 + c0) = w; } });
        } else {
            pg8::epi_foreach8(acc, u, wr, wc, fr, fq, [&](int row, int col, f32x4 v0, f32x4 v1) {
                const int gc = col - OFF_G; const f32x4 g0 = *(const f32x4*)(gate_b + gc), g1 = *(const f32x4*)(gate_b + gc + 4);
                *(v4u*)(SG + (size_t)row * 4096 + gc) = pk8(sig4(v0 + g0), sig4(v1 + g1)); });
        }
    } };
struct EpiBranch { static constexpr bool PERM = true; int dummy;
    static __device__ __forceinline__ bool keep_acc(const Unit& u) { return u.e < 3; }
    __device__ __forceinline__ void operator()(AccT& acc, const Unit& u, int wr, int wc, int fr, int fq) const { EPI_BASES const int br = u.e;
        bf16* MG = (bf16*)(ws + WS_MG16); const bf16* SG = (const bf16*)(ws + WS_SG);
#pragma unroll
        for (int ai = 0; ai < 2; ++ai)
#pragma unroll
            for (int m = 0; m < 4; ++m) { const int row = u.pm * 256 + ai * 128 + wr * 64 + m * 16 + fr;
#pragma unroll
                for (int bj = 0; bj < 2; ++bj) { const int col = u.pn * 256 + bj * 128 + wc * 32 + 8 * fq; const bf16* sp = SG + (size_t)row * 4096 + br * 1024 + col;
                    f32x4 n0, n1; unpk8(*(const v4u*)sp, n0, n1);
#pragma unroll
                    for (int e = 0; e < 4; ++e) { n0[e] = fmaxf(n0[e], 1e-6f); n1[e] = fmaxf(n1[e], 1e-6f); }
                    if (br < 3) { f32x4 d0, d1; unpk8(*(const v4u*)(sp + 1024), d0, d1);
#pragma unroll
                        for (int e = 0; e < 4; ++e) { acc[ai][bj][m][0][e] *= n0[e] * __builtin_amdgcn_rcpf(fmaxf(d0[e], 1e-6f)); acc[ai][bj][m][1][e] *= n1[e] * __builtin_amdgcn_rcpf(fmaxf(d1[e], 1e-6f)); }
                    } else *(v4u*)(MG + (size_t)row * D + col) = pk8(acc[ai][bj][m][0] * n0, acc[ai][bj][m][1] * n1); }
                if (m == 3) __builtin_amdgcn_sched_barrier(0); }
    } };
struct EpiResid { static constexpr bool PERM = true; static __device__ __forceinline__ bool keep_acc(const Unit&) { return false; } int dummy;
    __device__ __forceinline__ void operator()(const AccT& acc, const Unit& u, int wr, int wc, int fr, int fq) const { EPI_BASES
        const bf16* H = (const bf16*)(ws + WS_H16); bf16* P = (bf16*)(ws + WS_PRE16);
        pg8::epi_foreach8(acc, u, wr, wc, fr, fq, [&](int row, int col, f32x4 v0, f32x4 v1) { f32x4 h0, h1; unpk8(*(const v4u*)(H + (size_t)row * D + col), h0, h1);
            *(v4u*)(P + (size_t)row * D + col) = pk8(h0 * DN_ALPHA + v0, h1 * DN_ALPHA + v1); });
    } };
struct EpiBf16 { static constexpr bool PERM = true; static __device__ __forceinline__ bool keep_acc(const Unit&) { return false; } unsigned off_mib; float scale;
    __device__ __forceinline__ void operator()(const AccT& acc, const Unit& u, int wr, int wc, int fr, int fq) const { EPI_BASES
        bf16* O = (bf16*)(ws + (size_t)off_mib * MiB);
        pg8::epi_foreach8(acc, u, wr, wc, fr, fq, [&](int row, int col, f32x4 v0, f32x4 v1) { *(v4u*)(O + (size_t)row * D + col) = pk8(v0 * scale, v1 * scale); });
    } };
struct EpiVT { static constexpr bool PERM = false; static __device__ __forceinline__ bool keep_acc(const Unit&) { return false; } int dummy;
    __device__ __forceinline__ void operator()(const AccT& acc, const Unit& u, int wr, int wc, int fr, int fq) const { EPI_BASES
        bf16* VT = (bf16*)(ws + WS_VMT16);
        pg8::epi_foreach(acc, u, wr, wc, fr, fq, [&](int row, int col, f32x4 v) { const int b = row >> 8, m = row & 255; bf16* p = VT + ((size_t)(b * D + col)) * NMEM + m;
            p[0] = (bf16)f2bf(v.x); p[NMEM] = (bf16)f2bf(v.y); p[2 * NMEM] = (bf16)f2bf(v.z); p[3 * NMEM] = (bf16)f2bf(v.w); });
    } };
struct EpiXloc { static constexpr bool PERM = false; static __device__ __forceinline__ bool keep_acc(const Unit&) { return false; } int dummy;
    __device__ __forceinline__ void operator()(const AccT& acc, const Unit& u, int wr, int wc, int fr, int fq) const { EPI_BASES
        float* X = (float*)(ws + WS_XLOC);
        pg8::epi_foreach(acc, u, wr, wc, fr, fq, [&](int row, int col, f32x4 v) { if (col < 128) *(f32x4*)(X + ((size_t)(u.e * NCHT + row)) * 128 + col) = v; });
    } };
struct EpiLora { static constexpr bool PERM = false; static __device__ __forceinline__ bool keep_acc(const Unit&) { return false; } int l;
    __device__ __forceinline__ void operator()(const AccT& acc, const Unit& u, int wr, int wc, int fr, int fq) const { EPI_BASES
        if (u.pn == 0) { float* DEC = (float*)(ws + WS_DEC); const float* w0 = kin(KA, I_RW_W0) + l * 256;
            pg8::epi_foreach(acc, u, wr, wc, fr, fq, [&](int row, int col, f32x4 v) { const f32x4 wp = v + *(const f32x4*)(w0 + col); f32x4 o;
#pragma unroll
                for (int e = 0; e < 4; ++e) { const float sp = log1pf(__expf(-wp[e])); o[e] = __expf(-__expf(-sp - 0.5f)); }
                *(f32x4*)(DEC + (size_t)row * 256 + col) = o; });
        } else if (u.pn == 1) { float* AV = (float*)(ws + WS_AV); const float* a0 = kin(KA, I_RW_A0) + l * 256;
            pg8::epi_foreach(acc, u, wr, wc, fr, fq, [&](int row, int col, f32x4 v) { const int c = col - 256; *(f32x4*)(AV + (size_t)row * 256 + c) = sig4(v + *(const f32x4*)(a0 + c)); });
        } else { float* G = (float*)(ws + WS_RWG);
            pg8::epi_foreach(acc, u, wr, wc, fr, fq, [&](int row, int col, f32x4 v) { *(f32x4*)(G + (size_t)row * 256 + col - 512) = v; });
        }
    } };
__device__ __forceinline__ float gelu_tanh(float x) { const float u = 0.7978845608028654f * (x + 0.044715f * x * x * x); const float e = __expf(2.0f * u); const float th = 1.0f - 2.0f * __builtin_amdgcn_rcpf(e + 1.0f); return 0.5f * x * (1.0f + th); }
__device__ __forceinline__ f32x4 gelu4(const f32x4 v) { return (f32x4){gelu_tanh(v.x), gelu_tanh(v.y), gelu_tanh(v.z), gelu_tanh(v.w)}; }
struct EpiS5Y { static constexpr bool PERM = true; static __device__ __forceinline__ bool keep_acc(const Unit&) { return false; } int l;
    __device__ __forceinline__ void operator()(const AccT& acc, const Unit& u, int wr, int wc, int fr, int fq) const { EPI_BASES
        bf16* YD = (bf16*)(ws + WS_YD16); const bf16* AOUT = (const bf16*)(ws + WS_AOUT); const float* dvec = kin(KA, I_S5_D) + l * 256;
        pg8::epi_foreach8(acc, u, wr, wc, fr, fq, [&](int row, int col, f32x4 v0, f32x4 v1) { const int t = col >> 4, c0 = col & 15, tok = row * CH + t, ch = u.e * 16 + c0;
            f32x4 u0, u1; unpk8(*(const v4u*)(AOUT + ((size_t)(u.e * NCHT + row)) * S5K + t * 16 + c0), u0, u1);
            const f32x4 d0 = *(const f32x4*)(dvec + ch), d1 = *(const f32x4*)(dvec + ch + 4);
            *(v4u*)(YD + (size_t)tok * 256 + ch) = pk8(gelu4(v0 + d0 * u0), gelu4(v1 + d1 * u1)); });
    } };
struct EpiGlu { static constexpr bool PERM = true; static __device__ __forceinline__ bool keep_acc(const Unit&) { return false; } int l;
    __device__ __forceinline__ void operator()(const AccT& acc, const Unit& u, int wr, int wc, int fr, int fq) const { EPI_BASES
        bf16* O = (bf16*)(ws + WS_O16); const bf16* YD = (const bf16*)(ws + WS_YD16); const float* gb = kin(KA, I_S5_GLUB) + l * 256;
        pg8::epi_foreach8(acc, u, wr, wc, fr, fq, [&](int row, int col, f32x4 v0, f32x4 v1) { f32x4 y0, y1; unpk8(*(const v4u*)(YD + (size_t)row * 256 + col), y0, y1);
            const f32x4 b0 = *(const f32x4*)(gb + col), b1 = *(const f32x4*)(gb + col + 4);
            *(v4u*)(O + (size_t)row * D + 768 + col) = pk8(y0 * sig4(v0 + b0), y1 * sig4(v1 + b1)); });
    } };
__device__ __forceinline__ float swiglu(float g, float u) { g = fminf(g, 7.0f); u = fminf(fmaxf(u, -7.0f), 7.0f); return (u + 1.0f) * g * sigmoidf_(1.702f * g); }
struct EpiSwiglu { static constexpr bool PERM = true; static __device__ __forceinline__ bool keep_acc(const Unit&) { return false; } int l;
    __device__ __forceinline__ void operator()(const AccT& acc, const Unit& u, int wr, int wc, int fr, int fq) const { EPI_BASES
        bf16* ACT = (bf16*)(ws + WS_ACT); const float* bb = kin(KA, I_EX_B1) + (size_t)(l * NE + u.e) * 2048;
#pragma unroll
        for (int ai = 0; ai < 2; ++ai)
#pragma unroll
            for (int m = 0; m < 4; ++m) { const int row = u.pm * 256 + ai * 128 + wr * 64 + m * 16 + fr; const int j = u.pn * 128 + wc * 32 + 8 * fq;
                f32x4 o[2];
#pragma unroll
                for (int n = 0; n < 2; ++n) { const f32x4 b0 = *(const f32x4*)(bb + 2 * (j + 4 * n)), b1v = *(const f32x4*)(bb + 2 * (j + 4 * n) + 4);
                    const f32x4 g = acc[ai][0][m][n], uu = acc[ai][1][m][n];
                    o[n] = (f32x4){swiglu(g.x + b0.x, uu.x + b0.y), swiglu(g.y + b0.z, uu.y + b0.w), swiglu(g.z + b1v.x, uu.z + b1v.y), swiglu(g.w + b1v.z, uu.w + b1v.w)}; }
                *(v4u*)(ACT + (size_t)row * DFF + j) = pk8(o[0], o[1]);
                if (m == 3) __builtin_amdgcn_sched_barrier(0); }
    } };
struct EpiMoeOut { static constexpr bool PERM = true; static __device__ __forceinline__ bool keep_acc(const Unit&) { return false; } int l;
    __device__ __forceinline__ void operator()(const AccT& acc, const Unit& u, int wr, int wc, int fr, int fq) const { EPI_BASES
        bf16* YS = (bf16*)(ws + WS_YS); const float* SLOTW = (const float*)(ws + WS_SLOTW); const float* bb = kin(KA, I_EX_B2) + (size_t)(l * NE + u.e) * D;
        pg8::epi_foreach8(acc, u, wr, wc, fr, fq, [&](int row, int col, f32x4 v0, f32x4 v1) { const float sw = SLOTW[row]; const f32x4 b0 = *(const f32x4*)(bb + col), b1 = *(const f32x4*)(bb + col + 4);
            *(v4u*)(YS + (size_t)row * D + col) = pk8((v0 + b0) * sw, (v1 + b1) * sw); });
    } };

__device__ __forceinline__ void p_mix1(KArgs& A, const Frame& F, int l) {
    const int gw = F.bid * NWAVES + F.wave, NGW = F.G * NWAVES, lane = F.lane, tid = F.tid;
    const bf16* Z = (const bf16*)(F.ws + WS_Z); bf16* O16 = (bf16*)(F.ws + WS_O16);
    for (int rp_ = 0; rp_ < ((PROBE_PHASE == 101) ? PROBE_REPS : 1); ++rp_) { const float* cw = kin(A, I_CONV_W) + l * 3 * 256; const f32x4 w0 = *(const f32x4*)(cw + 4 * lane), w1 = *(const f32x4*)(cw + 256 + 4 * lane), w2 = *(const f32x4*)(cw + 512 + 4 * lane);
      for (int t0 = gw * 4; t0 < T; t0 += NGW * 4) {
          f32x4 bg[4], ch[6];
#pragma unroll
          for (int i = 0; i < 6; ++i) { const int t = t0 - 2 + i; const bool ok = (t >= 0) && ((t & ~(SEQ - 1)) == (t0 & ~(SEQ - 1)));
              ch[i] = (f32x4){0, 0, 0, 0}; if (ok) { const bf16* zr = Z + (size_t)t * ZLD + 4 * lane; ch[i] = ld4bf(zr + 256) * ld4bf(zr + 512); } }
#pragma unroll
          for (int i = 0; i < 4; ++i) bg[i] = ld4bf(Z + (size_t)(t0 + i) * ZLD + 4 * lane);
#pragma unroll
          for (int i = 0; i < 4; ++i) { const f32x4 y = (w2 * ch[i + 2] + w1 * ch[i + 1] + w0 * ch[i]) * bg[i];
              v2u w; w.x = pk2(y.x, y.y); w.y = pk2(y.z, y.w); *(v2u*)(O16 + (size_t)(t0 + i) * D + 4 * lane) = w; } } }
    for (int rp_ = 0; rp_ < ((PROBE_PHASE == 102) ? PROBE_REPS : 1); ++rp_) { LAS unsigned char* VT = F.lds;
      const float* ng = kin(A, I_SG_NG) + l * 256; const float* nb = kin(A, I_SG_NB) + l * 256; const bf16* sgw = (const bf16*)(F.ws + WS_SGW) + (size_t)l * 4 * 128 * 128;
      for (int blk = F.bid; blk < T / 128; blk += F.G) {
          const f32x4 gg = *(const f32x4*)(ng + 4 * lane), bb = *(const f32x4*)(nb + 4 * lane);
          for (int rb = 0; rb < 128 / NWAVES; rb += 4) { f32x4 vv[4];
#pragma unroll
              for (int i = 0; i < 4; ++i) vv[i] = ld4bf(Z + (size_t)(blk * 128 + F.wave + (rb + i) * NWAVES) * ZLD + OFF_B + 256 + 4 * lane);
              float s1[4], s2[4];
#pragma unroll
              for (int i = 0; i < 4; ++i) { s1[i] = (vv[i].x + vv[i].y) + (vv[i].z + vv[i].w); s2[i] = (vv[i].x * vv[i].x + vv[i].y * vv[i].y) + (vv[i].z * vv[i].z + vv[i].w * vv[i].w); }
#pragma unroll
              for (int o = 1; o < 64; o <<= 1) {
#pragma unroll
                  for (int i = 0; i < 4; ++i) { s1[i] += shfl_xor_l(s1[i], o, lane); s2[i] += shfl_xor_l(s2[i], o, lane); } }
#pragma unroll
              for (int i = 0; i < 4; ++i) { const float mean = s1[i] * (1.f / 256), var = fmaxf(s2[i] * (1.f / 256) - mean * mean, 0.f), rstd = __builtin_amdgcn_rsqf(var + LN_EPS);
                  const f32x4 y = (vv[i] - mean) * rstd * gg + bb; const int j = F.wave + (rb + i) * NWAVES;
                  LAS unsigned char* wp = VT + (4 * lane) * 272 + (((j >> 3) ^ (lane & 15)) << 4) + (j & 7) * 2;
                  *(LAS bf16*)(wp) = (bf16)f2bf(y.x); *(LAS bf16*)(wp + 272) = (bf16)f2bf(y.y); *(LAS bf16*)(wp + 544) = (bf16)f2bf(y.z); *(LAS bf16*)(wp + 816) = (bf16)f2bf(y.w); } }
          __syncthreads();
          { const int fr = lane & 15, fq = lane >> 4, it = F.wave, i = 16 * it + fr, t = blk * 128 + i, nks = (it < 4) ? 2 : 4;
#pragma unroll 1
            for (int g = 0; g < 4; ++g) { bf16x8 wf[4];
#pragma unroll
                for (int ks = 0; ks < 4; ++ks) wf[ks] = *(const bf16x8*)(sgw + ((size_t)(g * 128 + i)) * 128 + 32 * ks + 8 * fq);
                const float bias = kin(A, I_SG_B)[(l * 4 + g) * 128 + i];
#pragma unroll
                for (int ct = 0; ct < 4; ++ct) { f32x4 acc = {0, 0, 0, 0}; const int c = g * 64 + ct * 16 + fr; const LAS unsigned char* rowp = VT + c * 272; const int sw = (c >> 2) & 15;
#pragma unroll
                    for (int ks = 0; ks < 4; ++ks) if (ks < nks) { const bf16x8 af = *(const LAS bf16x8*)(rowp + (((4 * ks + fq) ^ sw) << 4)); acc = __builtin_amdgcn_mfma_f32_16x16x32_bf16(af, wf[ks], acc, 0, 0, 0); }
                    const int c0 = g * 64 + ct * 16 + 4 * fq;
                    const f32x4 o = ld4bf(Z + (size_t)t * ZLD + OFF_B + c0) * (acc + bias);
                    v2u w; w.x = pk2(o.x, o.y); w.y = pk2(o.z, o.w); *(v2u*)(O16 + (size_t)t * D + 256 + c0) = w; } } }
          __syncthreads();
      } }
    for (int rp_ = 0; rp_ < ((PROBE_PHASE == 103) ? PROBE_REPS : 1); ++rp_) {
      bf16* LA = (bf16*)(F.ws + WS_LA16); const f32x4 mul = *(const f32x4*)(kin(A, I_RW_MU) + l * 1024 + 768 + 4 * lane);
      for (int t0 = gw * 4; t0 < T; t0 += NGW * 4) { f32x4 xr[5];
#pragma unroll
          for (int i = 0; i < 5; ++i) { const int t = t0 - 1 + i; xr[i] = (f32x4){0, 0, 0, 0}; if (i > 0 || (t0 & (SEQ - 1)) > 0) xr[i] = ld4bf(Z + (size_t)t * ZLD + OFF_C + 768 + 4 * lane); }
#pragma unroll
          for (int i = 0; i < 4; ++i) { f32x4 x = xr[i + 1] + (xr[i] - xr[i + 1]) * mul;
              if (lane < 16) x = sig4(x * 2.0f) * 2.0f - 1.0f;
              else if (lane >= 32) x = sig4(x);
              v2u w; w.x = pk2(x.x, x.y); w.y = pk2(x.z, x.w); *(v2u*)(LA + (size_t)(t0 + i) * 256 + 4 * lane) = w; } } }
}

__device__ __forceinline__ void p_rw_chunks(KArgs& A, const Frame& F, int l) {
    const int gw = F.bid * NWAVES + F.wave, NGW = F.G * NWAVES, lane = F.lane;
    const bf16* Z = (const bf16*)(F.ws + WS_Z); const float* DEC = (const float*)(F.ws + WS_DEC); const float* AV = (const float*)(F.ws + WS_AV);
    float* QH = (float*)(F.ws + WS_QH); float* YL = (float*)(F.ws + WS_YL); float* GC = (float*)(F.ws + WS_GC); float* HC = (float*)(F.ws + WS_HC); float* RK = (float*)(F.ws + WS_RK);
    LAS float* wl = (LAS float*)(F.lds + F.wave * 16384);
    for (int task = gw; task < 16 * NCH; task += NGW) { const int bh = task / NCH, ck = task % NCH, b = bh >> 2, head = bh & 3, c = head * 64 + lane;
        const float mu_r = kin(A, I_RW_MU)[l * 1024 + c], mu_k = kin(A, I_RW_MU)[l * 1024 + 256 + c], mu_v = kin(A, I_RW_MU)[l * 1024 + 512 + c];
        const float kkc = kin(A, I_RW_KK)[l * 256 + c], kac = kin(A, I_RW_KA)[l * 256 + c], rkc = kin(A, I_RW_RK)[l * 256 + c];
        float sp[64], sl[64];
        { const int ln = launder_v(lane);
#pragma unroll
          for (int k = 0; k < 64; ++k) { sp[k] = (k == ln) ? 1.0f : 0.0f; sl[k] = 0.0f; } }
        wl[8 * 320 + lane] = 0.f;
        const int tg0 = b * SEQ + ck * CH;
        float pr = 0.f, pk = 0.f, pv = 0.f, gam = 1.0f;
        if (ck > 0) { const bf16* zp = Z + (size_t)(tg0 - 1) * ZLD + OFF_C + c; pr = bf2f(zp[0]); pk = bf2f(zp[256]); pv = bf2f(zp[512]); }
#pragma unroll 1
        for (int sb = 0; sb < CH / 8; ++sb) {
#pragma unroll 1
            for (int hb = 0; hb < 2; ++hb) {
                float kk[4], dc[4], av[4], rs[4], k2[4], vs[4], ss[4], rkp[4];
#pragma unroll
                for (int i = 0; i < 4; ++i) { const int t = tg0 + sb * 8 + hb * 4 + i; const bf16* zr = Z + (size_t)t * ZLD + OFF_C + c;
                    const float r = bf2f(zr[0]), k = bf2f(zr[256]), v = bf2f(zr[512]); dc[i] = DEC[(size_t)t * 256 + c]; av[i] = AV[(size_t)t * 256 + c];
                    rs[i] = r + (pr - r) * mu_r; const float ks = k + (pk - k) * mu_k; vs[i] = v + (pv - v) * mu_v; pr = r; pk = k; pv = v;
                    kk[i] = ks * kkc; k2[i] = ks * (1.0f + (av[i] - 1.0f) * kac); ss[i] = kk[i] * kk[i]; rkp[i] = rs[i] * k2[i] * rkc; }
#pragma unroll
                for (int o = 1; o < 64; o <<= 1) {
#pragma unroll
                    for (int i = 0; i < 4; ++i) { ss[i] += shfl_xor_l(ss[i], o, lane); rkp[i] += shfl_xor_l(rkp[i], o, lane); } }
#pragma unroll
                for (int i = 0; i < 4; ++i) { const float kn = kk[i] * __builtin_amdgcn_rcpf(fmaxf(sqrtf(ss[i]), 1e-12f)); LAS float* w = wl + (hb * 4 + i) * 320 + lane;
                    const float g1 = gam * dc[i], ig = __builtin_amdgcn_rcpf(g1);
                    w[0] = -kn * gam; w[64] = kn * av[i] * ig; w[128] = rs[i] * g1; w[192] = k2[i] * ig; w[256] = vs[i]; gam = g1;
                    if (lane == 0) RK[(size_t)(tg0 + sb * 8 + hb * 4 + i) * 4 + head] = rkp[i]; }
            }
            LDS_WAIT();
            const LAS float* wr16 = wl + (lane & 15);
            float saP = 0.f, saL = 0.f;
            { float A0[4];
#pragma unroll
              for (int J = 0; J < 4; ++J) A0[J] = wr16[16 * J];
#define RW_SA(k) { fmac_bc<(k) & 15>(saP, A0[(k) >> 4], sp[k]); fmac_bc<(k) & 15>(saL, A0[(k) >> 4], sl[k]); }
#define RW_REP16(M, o) M(o + 0) M(o + 1) M(o + 2) M(o + 3) M(o + 4) M(o + 5) M(o + 6) M(o + 7) M(o + 8) M(o + 9) M(o + 10) M(o + 11) M(o + 12) M(o + 13) M(o + 14) M(o + 15)
              RW_REP16(RW_SA, 0) RW_REP16(RW_SA, 16) RW_REP16(RW_SA, 32) RW_REP16(RW_SA, 48) }
            float Bv[4], Rv[4], Kv[4], Av[4], vj;
#pragma unroll
            for (int J = 0; J < 4; ++J) { Bv[J] = wr16[64 + 16 * J]; Rv[J] = wr16[128 + 16 * J]; Kv[J] = wr16[192 + 16 * J]; Av[J] = wr16[320 + 16 * J]; }
            vj = wl[256 + lane];
#pragma unroll 1
            for (int st_ = 0; st_ < 8; ++st_) {
                float Bn[4], Rn[4], Kn[4], An[4], vn;
                { const LAS float* nb = wr16 + (st_ + 1) * 320; const int lim = (st_ < 7) ? 0 : -320;
#pragma unroll
                  for (int J = 0; J < 4; ++J) { Bn[J] = nb[lim + 64 + 16 * J]; Rn[J] = nb[lim + 128 + 16 * J]; Kn[J] = nb[lim + 192 + 16 * J]; An[J] = nb[320 + 16 * J]; }
                  vn = wl[(st_ + 1) * 320 + lim + 256 + lane]; }
                float yP = 0.f, yL = 0.f, nP = 0.f, nL = 0.f;
#define RW_STEP(k) { fmac_bc<(k) & 15>(sp[k], Bv[(k) >> 4], saP); fmac_bc<(k) & 15>(sl[k], Bv[(k) >> 4], saL); fmac_bc<(k) & 15>(sl[k], Kv[(k) >> 4], vj); \
                     fmac_bc<(k) & 15>(yP, Rv[(k) >> 4], sp[k]); fmac_bc<(k) & 15>(yL, Rv[(k) >> 4], sl[k]); fmac_bc<(k) & 15>(nP, Av[(k) >> 4], sp[k]); fmac_bc<(k) & 15>(nL, Av[(k) >> 4], sl[k]); }
                RW_REP16(RW_STEP, 0) RW_REP16(RW_STEP, 16) RW_REP16(RW_STEP, 32) RW_REP16(RW_STEP, 48)
                const size_t oi = ((size_t)(bh * SEQ + ck * CH + sb * 8 + st_)) * 64 + lane;
                QH[oi] = yP; YL[oi] = yL; saP = nP; saL = nL;
#pragma unroll
                for (int J = 0; J < 4; ++J) { Bv[J] = Bn[J]; Rv[J] = Rn[J]; Kv[J] = Kn[J]; Av[J] = An[J]; }
                vj = vn; }
#undef RW_SA
#undef RW_STEP
#undef RW_REP16
        }
        wl[lane] = gam; LDS_WAIT();
        float* hp = HC + ((size_t)(bh * NCH + ck) * 64 + lane) * 64;
#pragma unroll
        for (int q = 0; q < 16; ++q) { const f32x4 gq = *(const LAS f32x4*)(wl + 4 * q);
            sp[4 * q] *= gq.x; sp[4 * q + 1] *= gq.y; sp[4 * q + 2] *= gq.z; sp[4 * q + 3] *= gq.w;
            *(f32x4*)(hp + 4 * q) = (f32x4){sl[4 * q] * gq.x, sl[4 * q + 1] * gq.y, sl[4 * q + 2] * gq.z, sl[4 * q + 3] * gq.w}; }
        { float* gp = GC + (size_t)(bh * NCH + ck) * 4096 + (size_t)(((lane >> 2) & 3) * 16) * 64 + ((lane >> 4) * 4 + (lane & 3)) * 4;
#pragma unroll
          for (int f = 0; f < 16; ++f) *(f32x4*)(gp + f * 64) = (f32x4){sp[f], sp[16 + f], sp[32 + f], sp[48 + f]}; }
        LDS_WAIT();
    }
}
__device__ __forceinline__ void p_s5_chain(KArgs& A, const Frame& F, int l) {
    const int gt = F.bid * NTHREADS + F.tid; if (gt >= NB * 16 * 64) return;
    const int b = gt >> 10, g = (gt >> 6) & 15, p = gt & 63;
    const float dt = expf(kin(A, I_S5_LOGDT)[l * 16 + g]); const float are = kin(A, I_S5_ARE)[(l * 16 + g) * 64 + p], aim = kin(A, I_S5_AIM)[(l * 16 + g) * 64 + p];
    const float mag = expf(are * dt * 64.0f); float sn, cs; sincosf(aim * dt * 64.0f, &sn, &cs); const float ar = mag * cs, ai = mag * sn;
    bf16* AO = (bf16*)(F.ws + WS_AOUT); const float* XL = (const float*)(F.ws + WS_XLOC);
    float xr = 0.f, xi = 0.f;
#pragma unroll 1
    for (int c0 = 0; c0 < NCH; c0 += 16) {
        f32x2 xl[16]; unsigned outw[16];
#pragma unroll
        for (int i = 0; i < 16; ++i) xl[i] = *(const f32x2*)(XL + ((size_t)g * NCHT + b * NCH + c0 + i) * 128 + 2 * p);
#pragma unroll
        for (int i = 0; i < 16; ++i) { outw[i] = pk2(xr, xi); const float nr = ar * xr - ai * xi + xl[i].x, ni = ar * xi + ai * xr + xl[i].y; xr = nr; xi = ni; }
#pragma unroll
        for (int i = 0; i < 16; ++i) *(unsigned*)(AO + ((size_t)g * NCHT + b * NCH + c0 + i) * S5K + 1024 + 2 * p) = outw[i];
    }
}
constexpr int CB = 8, NBLK = NCH / CB;
__device__ __forceinline__ void chain_load_g(const float* G, float (&ga)[64], int fr, int fq) {
    const f32x4* gp = (const f32x4*)(G + (size_t)(16 * fq + fr) * 64);
#pragma unroll
    for (int q = 0; q < 16; ++q) { const f32x4 x = gp[q]; ga[4 * q] = x.x; ga[4 * q + 1] = x.y; ga[4 * q + 2] = x.z; ga[4 * q + 3] = x.w; }
}
__device__ __forceinline__ void chain_store_g(float* G, int rb, const f32x4 (&t)[4], int fr, int fq) {
#pragma unroll
    for (int reg = 0; reg < 4; ++reg) *(f32x4*)(G + (size_t)((fr >> 2) * 16 + 4 * fq + reg) * 64 + (rb * 4 + (fr & 3)) * 4) = (f32x4){t[0][reg], t[1][reg], t[2][reg], t[3][reg]};
}
__device__ __forceinline__ void chain_step(f32x4 (&acc)[4], const float (&ga)[64], const f32x4 (&ci)[4]) {
    f32x4 na[4] = {ci[0], ci[1], ci[2], ci[3]};
#pragma unroll
    for (int jr = 0; jr < 16; ++jr)
#pragma unroll
        for (int mt = 0; mt < 4; ++mt) na[mt] = __builtin_amdgcn_mfma_f32_16x16x4f32(ga[jr * 4 + mt], acc[jr >> 2][jr & 3], na[mt], 0, 0, 0);
#pragma unroll
    for (int mt = 0; mt < 4; ++mt) acc[mt] = na[mt];
}
__device__ __forceinline__ void chain_load_tile(const float* M, int rb, f32x4 (&t)[4], int fr, int fq) {
#pragma unroll
    for (int jt = 0; jt < 4; ++jt) t[jt] = *(const f32x4*)(M + (size_t)(16 * rb + fr) * 64 + 16 * jt + 4 * fq);
}
__device__ __forceinline__ void chain_store_tile(float* M, int rb, const f32x4 (&t)[4], int fr, int fq) {
#pragma unroll
    for (int jt = 0; jt < 4; ++jt) *(f32x4*)(M + (size_t)(16 * rb + fr) * 64 + 16 * jt + 4 * fq) = t[jt];
}
__device__ __forceinline__ void p_chain_compose(const Frame& F) {
    const int nlow = (F.G >= 256) ? 128 : 0; if (F.bid < nlow) return;
    const int gw = (F.bid - nlow) * NWAVES + F.wave, NGW = (F.G - nlow) * NWAVES, ln_ = my_lane(), fr = ln_ & 15, fq = ln_ >> 4;
    const float* GC = (const float*)(F.ws + WS_GC); const float* HC = (const float*)(F.ws + WS_HC); float* GB = (float*)(F.ws + WS_GB); float* HB = (float*)(F.ws + WS_HB);
    for (int task = gw; task < 16 * NBLK * 8; task += NGW) { const int cb = task & 7, bb = task >> 3, rb = cb & 3; const bool isH = cb >= 4;
        const size_t c0 = (size_t)bb * CB;
        f32x4 acc[4];
        if (isH) chain_load_tile(HC + c0 * 4096, rb, acc, fr, fq);
        else {
            const float* gq = GC + c0 * 4096 + (size_t)((fr >> 2) * 16 + 4 * fq) * 64 + (rb * 4 + (fr & 3)) * 4;
#pragma unroll
            for (int reg = 0; reg < 4; ++reg) { const f32x4 x = *(const f32x4*)(gq + reg * 64); acc[0][reg] = x.x; acc[1][reg] = x.y; acc[2][reg] = x.z; acc[3][reg] = x.w; } }
        float ga[64]; chain_load_g(GC + (c0 + 1) * 4096, ga, fr, fq);
        f32x4 ci[4] = {{0, 0, 0, 0}, {0, 0, 0, 0}, {0, 0, 0, 0}, {0, 0, 0, 0}};
        if (isH) chain_load_tile(HC + (c0 + 1) * 4096, rb, ci, fr, fq);
#pragma unroll 1
        for (int i = 1; i < CB; ++i) { const int nx = (i + 1 < CB) ? i + 1 : i;
            f32x4 cn[4] = {{0, 0, 0, 0}, {0, 0, 0, 0}, {0, 0, 0, 0}, {0, 0, 0, 0}};
            if (isH) chain_load_tile(HC + (c0 + nx) * 4096, rb, cn, fr, fq);
            float gn[64]; chain_load_g(GC + (c0 + nx) * 4096, gn, fr, fq);
            chain_step(acc, ga, ci);
#pragma unroll
            for (int k = 0; k < 64; ++k) ga[k] = gn[k];
#pragma unroll
            for (int k = 0; k < 4; ++k) ci[k] = cn[k]; }
        if (isH) chain_store_tile(HB + (size_t)bb * 4096, rb, acc, fr, fq); else chain_store_g(GB + (size_t)bb * 4096, rb, acc, fr, fq);
    }
}
__device__ __forceinline__ void p_chain_blocks(const Frame& F, int gw, int NGW) {
    const int ln_ = my_lane(), fr = ln_ & 15, fq = ln_ >> 4;
    const float* GB = (const float*)(F.ws + WS_GB); const float* HB = (const float*)(F.ws + WS_HB); float* SB = (float*)(F.ws + WS_SB);
    for (int task = gw; task < 16 * 4; task += NGW) { const int vb = task & 3, bh = task >> 2;
        f32x4 acc[4] = {{0, 0, 0, 0}, {0, 0, 0, 0}, {0, 0, 0, 0}, {0, 0, 0, 0}};
        float ga[64]; chain_load_g(GB + (size_t)bh * NBLK * 4096, ga, fr, fq);
        f32x4 ci[4]; chain_load_tile(HB + (size_t)bh * NBLK * 4096, vb, ci, fr, fq);
#pragma unroll 1
        for (int blk = 0; blk < NBLK; ++blk) { const size_t bb = (size_t)bh * NBLK + blk;
            chain_store_tile(SB + bb * 4096, vb, acc, fr, fq);
            if (blk + 1 == NBLK) break;
            f32x4 cn[4]; chain_load_tile(HB + (bb + 1) * 4096, vb, cn, fr, fq);
            float gn[64]; chain_load_g(GB + (bb + 1) * 4096, gn, fr, fq);
            chain_step(acc, ga, ci);
#pragma unroll
            for (int k = 0; k < 64; ++k) ga[k] = gn[k];
#pragma unroll
            for (int k = 0; k < 4; ++k) ci[k] = cn[k]; }
    }
}
__device__ __forceinline__ void chain_inblock(const Frame& F, int bb, int vb) {
    const int ln_ = my_lane(), fr = ln_ & 15, fq = ln_ >> 4;
    const float* GC = (const float*)(F.ws + WS_GC); const float* HC = (const float*)(F.ws + WS_HC); const float* SB = (const float*)(F.ws + WS_SB); float* SC = (float*)(F.ws + WS_SC);
    const size_t c0 = (size_t)bb * CB;
    f32x4 acc[4]; chain_load_tile(SB + (size_t)bb * 4096, vb, acc, fr, fq);
    float ga[64]; chain_load_g(GC + c0 * 4096, ga, fr, fq);
    f32x4 ci[4]; chain_load_tile(HC + c0 * 4096, vb, ci, fr, fq);
#pragma unroll 1
    for (int i = 0; i < CB; ++i) {
        chain_store_tile(SC + (c0 + i) * 4096, vb, acc, fr, fq);
        if (i + 1 == CB) break;
        f32x4 cn[4]; chain_load_tile(HC + (c0 + i + 1) * 4096, vb, cn, fr, fq);
        float gn[64]; chain_load_g(GC + (c0 + i + 1) * 4096, gn, fr, fq);
        chain_step(acc, ga, ci);
#pragma unroll
        for (int k = 0; k < 64; ++k) ga[k] = gn[k];
#pragma unroll
        for (int k = 0; k < 4; ++k) ci[k] = cn[k]; }
}
__device__ __forceinline__ void rw_out_task(KArgs& A, const Frame& F, int l, int task) {
    const int lane = F.lane, fr = lane & 15, fq = lane >> 4;
    const bf16* Z = (const bf16*)(F.ws + WS_Z); const float* QH = (const float*)(F.ws + WS_QH); const float* YL = (const float*)(F.ws + WS_YL); const float* SC = (const float*)(F.ws + WS_SC);
    const float* RWG = (const float*)(F.ws + WS_RWG); const float* RK = (const float*)(F.ws + WS_RK); bf16* O16 = (bf16*)(F.ws + WS_O16);
    const int bh = task / NCH, ck = task % NCH, b = bh >> 2, head = bh & 3;
    const size_t ti0 = (size_t)(bh * SEQ + ck * CH); const int t0g = b * SEQ + ck * CH;
    float sa[4][16];
    { const float* sp = SC + (size_t)(bh * NCH + ck) * 4096 + (size_t)fr * 64 + 16 * fq;
#pragma unroll
      for (int vt = 0; vt < 4; ++vt)
#pragma unroll
          for (int q = 0; q < 4; ++q) { const f32x4 x = *(const f32x4*)(sp + vt * 1024 + 4 * q); sa[vt][4 * q] = x.x; sa[vt][4 * q + 1] = x.y; sa[vt][4 * q + 2] = x.z; sa[vt][4 * q + 3] = x.w; } }
    const float* lgp = kin(A, I_RW_LNG) + l * 256 + head * 64 + 4 * fq; const float* lbp = kin(A, I_RW_LNB) + l * 256 + head * 64 + 4 * fq; const float* mup = kin(A, I_RW_MU) + l * 1024 + 512 + head * 64 + 4 * fq;
#pragma unroll 1
    for (int tt = 0; tt < 4; ++tt) { const int t = 16 * tt + fr;
        float qb[16];
        { const float* qp = QH + (ti0 + t) * 64 + 16 * fq;
#pragma unroll
          for (int q = 0; q < 4; ++q) { const f32x4 x = *(const f32x4*)(qp + 4 * q); qb[4 * q] = x.x; qb[4 * q + 1] = x.y; qb[4 * q + 2] = x.z; qb[4 * q + 3] = x.w; } }
        f32x4 y[4];
#pragma unroll
        for (int vt = 0; vt < 4; ++vt) y[vt] = *(const f32x4*)(YL + (ti0 + t) * 64 + 16 * vt + 4 * fq);
#pragma unroll
        for (int s_ = 0; s_ < 16; ++s_)
#pragma unroll
            for (int vt = 0; vt < 4; ++vt) y[vt] = __builtin_amdgcn_mfma_f32_16x16x4f32(sa[vt][s_], qb[s_], y[vt], 0, 0, 0);
        float s1 = 0.f, s2 = 0.f;
#pragma unroll
        for (int vt = 0; vt < 4; ++vt) { s1 += (y[vt].x + y[vt].y) + (y[vt].z + y[vt].w); s2 += (y[vt].x * y[vt].x + y[vt].y * y[vt].y) + (y[vt].z * y[vt].z + y[vt].w * y[vt].w); }
        s1 += shfl_xor_l(s1, 16, lane); s1 += shfl_xor_l(s1, 32, lane); s2 += shfl_xor_l(s2, 16, lane); s2 += shfl_xor_l(s2, 32, lane);
        const float m = s1 * (1.f / 64), var = fmaxf(s2 * (1.f / 64) - m * m, 0.f), rstd = __builtin_amdgcn_rsqf(var + RW_LN_EPS);
        const int tg = t0g + t; const float rk = RK[(size_t)tg * 4 + head]; const bool hasprev = (ck * CH + t) > 0;
        const bf16* zv = Z + (size_t)tg * ZLD + OFF_C + 512 + head * 64 + 4 * fq; const float* gp = RWG + (size_t)tg * 256 + head * 64 + 4 * fq; bf16* op = O16 + (size_t)tg * D + 512 + head * 64 + 4 * fq;
#pragma unroll
        for (int vt = 0; vt < 4; ++vt) { const f32x4 v1 = ld4bf(zv + 16 * vt); f32x4 v0 = {0, 0, 0, 0}; if (hasprev) v0 = ld4bf(zv - ZLD + 16 * vt);
            const f32x4 vv = v1 + (v0 - v1) * *(const f32x4*)(mup + 16 * vt), g4 = *(const f32x4*)(gp + 16 * vt), lg4 = *(const f32x4*)(lgp + 16 * vt), lb4 = *(const f32x4*)(lbp + 16 * vt);
            const f32x4 o = ((y[vt] - m) * rstd * lg4 + lb4 + vv * rk) * g4;
            v2u w; w.x = pk2(o.x, o.y); w.y = pk2(o.z, o.w); *(v2u*)(op + 16 * vt) = w; }
    }
}

template <int LSTRIDE> __device__ __forceinline__ void attn_stage(LAS unsigned char* lds, const bf16* src, size_t row_stride, int tid) {
    const int r0 = tid >> 5, c = tid & 31; const bf16* sp = src + (size_t)r0 * row_stride + c * 8; LAS unsigned char* dp = lds + r0 * LSTRIDE + c * 16;
#pragma unroll 4
    for (int i = 0; i < 16; ++i) { const v4u v = *(const v4u*)(sp + (size_t)(16 * i) * row_stride); *(LAS v4u*)(dp + 16 * i * LSTRIDE) = v; }
}
constexpr int KSTR = 544, VSTR = 528;
__device__ __forceinline__ void p_attn(const Frame& F) {
    const int lane = F.lane, fr = lane & 15, fq = lane >> 4;
    const bf16* Q = (const bf16*)(F.ws + WS_Q16); const bf16* KM = (const bf16*)(F.ws + WS_KM16); const bf16* VT = (const bf16*)(F.ws + WS_VMT16); bf16* AO = (bf16*)(F.ws + WS_AO16);
    for (int item = F.bid; item < NB * 4 * (SEQ / 256); item += F.G) {
        const int qg = item % (SEQ / 256), bhd = item / (SEQ / 256), head = bhd & 3, b = bhd >> 2;
        attn_stage<KSTR>(F.lds, KM + (size_t)(b * NMEM) * D + head * 256, D, F.tid);
        __syncthreads();
        v4u pf[2][8]; float inv[2];
#pragma unroll
        for (int u = 0; u < 2; ++u) { const int q0 = b * SEQ + qg * 256 + u * 128 + F.wave * 16;
            bf16x8 qf[8];
#pragma unroll
            for (int ks = 0; ks < 8; ++ks) qf[ks] = *(const bf16x8*)(Q + (size_t)(q0 + fr) * D + head * 256 + ks * 32 + fq * 8);
            f32x4 sT[16];
            const LAS unsigned char* kbase = F.lds + fr * KSTR + fq * 16;
#pragma unroll
            for (int kt = 0; kt < 16; ++kt) { f32x4 a = {0, 0, 0, 0}; const LAS unsigned char* kp = kbase + kt * 16 * KSTR;
#pragma unroll
                for (int ks = 0; ks < 8; ++ks) { const bf16x8 kf = *(const LAS bf16x8*)(kp + ks * 64); a = __builtin_amdgcn_mfma_f32_16x16x32_bf16(kf, qf[ks], a, 0, 0, 0); }
                sT[kt] = a; if (kt & 1) __builtin_amdgcn_sched_barrier(0); }
            float mx = -3.0e38f;
#pragma unroll
            for (int kt = 0; kt < 16; ++kt) mx = fmaxf(fmaxf(fmaxf(mx, sT[kt].x), fmaxf(sT[kt].y, sT[kt].z)), sT[kt].w);
            mx = fmaxf(mx, shfl_xor_l(mx, 16, lane)); mx = fmaxf(mx, shfl_xor_l(mx, 32, lane));
            float sum = 0.f;
#pragma unroll
            for (int kt = 0; kt < 16; ++kt) { sT[kt].x = __expf(sT[kt].x - mx); sT[kt].y = __expf(sT[kt].y - mx); sT[kt].z = __expf(sT[kt].z - mx); sT[kt].w = __expf(sT[kt].w - mx); sum += (sT[kt].x + sT[kt].y) + (sT[kt].z + sT[kt].w); }
            sum += shfl_xor_l(sum, 16, lane); sum += shfl_xor_l(sum, 32, lane);
            inv[u] = 1.0f / sum;
#pragma unroll
            for (int kp = 0; kp < 8; ++kp) { v4u w; w.x = pk2(sT[2 * kp].x, sT[2 * kp].y); w.y = pk2(sT[2 * kp].z, sT[2 * kp].w); w.z = pk2(sT[2 * kp + 1].x, sT[2 * kp + 1].y); w.w = pk2(sT[2 * kp + 1].z, sT[2 * kp + 1].w); pf[u][kp] = w; }
            __builtin_amdgcn_sched_barrier(0);
        }
        __syncthreads();
        attn_stage<VSTR>(F.lds, VT + (size_t)(b * D + head * 256) * NMEM, NMEM, F.tid);
        __syncthreads();
#pragma unroll
        for (int u = 0; u < 2; ++u) { const int q0 = b * SEQ + qg * 256 + u * 128 + F.wave * 16;
#pragma unroll 2
            for (int dt = 0; dt < 16; ++dt) { f32x4 o = {0, 0, 0, 0}; const LAS unsigned char* vp = F.lds + (dt * 16 + fr) * VSTR + fq * 8;
#pragma unroll
                for (int kp = 0; kp < 8; ++kp) {
                    const v2u lo = *(const LAS v2u*)(vp + 64 * kp), hi = *(const LAS v2u*)(vp + 64 * kp + 32); v4u w; w.x = lo.x; w.y = lo.y; w.z = hi.x; w.w = hi.y;
                    o = __builtin_amdgcn_mfma_f32_16x16x32_bf16(__builtin_bit_cast(bf16x8, w), __builtin_bit_cast(bf16x8, pf[u][kp]), o, 0, 0, 0); }
                v2u w; w.x = pk2(o.x * inv[u], o.y * inv[u]); w.y = pk2(o.z * inv[u], o.w * inv[u]);
                *(v2u*)(AO + (size_t)(q0 + fr) * D + head * 256 + dt * 16 + 4 * fq) = w; __builtin_amdgcn_sched_barrier(0); } }
        __syncthreads();
    }
}

__device__ __forceinline__ void p_ln(const Frame& F, const float* g, const float* b, bool dummy) {
    const int gw = F.bid * NWAVES + F.wave, NGW = F.G * NWAVES, lane = F.lane; const bf16* P = (const bf16*)(F.ws + WS_PRE16); bf16* H16 = (bf16*)(F.ws + (dummy ? WS_Z + 128 * MiB : WS_H16));
    for (int r0 = gw * 4; r0 < T; r0 += NGW * 4) { f32x4 v[4][4];
#pragma unroll
        for (int i = 0; i < 4; ++i)
#pragma unroll
            for (int j = 0; j < 4; ++j) v[i][j] = ld4bf(P + (size_t)(r0 + i) * D + 256 * j + 4 * lane);
#pragma unroll
        for (int i = 0; i < 4; ++i) { float mean, rstd; ln_stats(v[i], mean, rstd); ln_apply_store(v[i], mean, rstd, g, b, (float*)nullptr, H16 + (size_t)(r0 + i) * D, lane); } }
}
__device__ __forceinline__ void p_ln_router(KArgs& A, const Frame& F, int l, bool dummy) {
    const int gw = F.bid * NWAVES + F.wave, NGW = F.G * NWAVES, lane = F.lane, tid = F.tid, fr = lane & 15, fq = lane >> 4;
    const bf16* H = (const bf16*)(F.ws + WS_PRE16); bf16* H16 = (bf16*)(F.ws + (dummy ? WS_Z + 128 * MiB : WS_H16)); int* TOKE = (int*)(F.ws + (dummy ? WS_Z + 200 * MiB : WS_TOKE)); float* TOKW = (float*)(F.ws + (dummy ? WS_Z + 201 * MiB : WS_TOKW));
    LAS v4u* TB = (LAS v4u*)F.lds;
    LAS float* PS = (LAS float*)(F.lds + 131072);
    volatile LAS unsigned* hist = F.MISC + MI_HIST;
    const float* rw = kin(A, I_ROUTER_W) + (size_t)l * D * NE; const float* rb = kin(A, I_ROUTER_B) + l * NE; const float* g = kin(A, I_LN2_G) + l * D; const float* bb = kin(A, I_LN2_B) + l * D;
    for (int en = tid; en < 32 * 2 * 64; en += NTHREADS) { const int ln = en & 63, et = (en >> 6) & 1, ks = en >> 7, efr = ln & 15, efq = ln >> 4; float hi[8], lo[8];
#pragma unroll
        for (int j = 0; j < 8; ++j) { const int d = 32 * ks + 8 * efq + j; const float v = g[d] * rw[d * NE + et * 16 + efr]; const float h = bf2f(f2bf(v)); hi[j] = h; lo[j] = v - h; }
        v4u wh, wl; wh.x = pk2(hi[0], hi[1]); wh.y = pk2(hi[2], hi[3]); wh.z = pk2(hi[4], hi[5]); wh.w = pk2(hi[6], hi[7]); wl.x = pk2(lo[0], lo[1]); wl.y = pk2(lo[2], lo[3]); wl.z = pk2(lo[4], lo[5]); wl.w = pk2(lo[6], lo[7]);
        TB[((ks * 2 + et) * 2 + 0) * 64 + ln] = wh; TB[((ks * 2 + et) * 2 + 1) * 64 + ln] = wl; }
    { const int e = tid & 31, part = tid >> 5; float sg = 0.f, sb = 0.f;
      for (int d = part * 64; d < part * 64 + 64; ++d) { const float w = rw[d * NE + e]; sg += g[d] * w; sb += bb[d] * w; }
      PS[part * 32 + e] = sg; PS[512 + part * 32 + e] = sb; }
    if (tid < NE) hist[tid] = 0u;
    __syncthreads();
    if (tid < NE) { float sg = 0.f, sb = 0.f;
#pragma unroll
        for (int p = 0; p < 16; ++p) { sg += PS[p * 32 + tid]; sb += PS[512 + p * 32 + tid]; }
        PS[1024 + tid] = sg; PS[1056 + tid] = sb + rb[tid]; }
    __syncthreads();
    const float cg0 = PS[1024 + fr], cg1 = PS[1024 + 16 + fr], cb0 = PS[1056 + fr], cb1 = PS[1056 + 16 + fr];
    for (int grp = gw; grp < T / 16; grp += NGW) { const int r0 = grp * 16; const bf16* xrow = H + (size_t)(r0 + fr) * D + 8 * fq;
        f32x4 acc0 = {0, 0, 0, 0}, acc1 = {0, 0, 0, 0}; float sum = 0.f, sq = 0.f;
#pragma unroll 2
        for (int ks = 0; ks < 32; ++ks) { const v4u xw = *(const v4u*)(xrow + 32 * ks); f32x4 xa, xb; unpk8(xw, xa, xb);
            sum += (xa.x + xa.y) + (xa.z + xa.w) + (xb.x + xb.y) + (xb.z + xb.w);
            sq += (xa.x * xa.x + xa.y * xa.y) + (xa.z * xa.z + xa.w * xa.w) + (xb.x * xb.x + xb.y * xb.y) + (xb.z * xb.z + xb.w * xb.w);
            const LAS v4u* tb = TB + (ks * 4) * 64 + lane; const v4u b0h = tb[0], b0l = tb[64], b1h = tb[128], b1l = tb[192];
            const bf16x8 Ah = __builtin_bit_cast(bf16x8, xw);
            acc0 = __builtin_amdgcn_mfma_f32_16x16x32_bf16(Ah, __builtin_bit_cast(bf16x8, b0h), acc0, 0, 0, 0); acc0 = __builtin_amdgcn_mfma_f32_16x16x32_bf16(Ah, __builtin_bit_cast(bf16x8, b0l), acc0, 0, 0, 0);
            acc1 = __builtin_amdgcn_mfma_f32_16x16x32_bf16(Ah, __builtin_bit_cast(bf16x8, b1h), acc1, 0, 0, 0); acc1 = __builtin_amdgcn_mfma_f32_16x16x32_bf16(Ah, __builtin_bit_cast(bf16x8, b1l), acc1, 0, 0, 0); }
        sum += shfl_xor_l(sum, 16, lane); sum += shfl_xor_l(sum, 32, lane); sq += shfl_xor_l(sq, 16, lane); sq += shfl_xor_l(sq, 32, lane);
        const float mean = sum * (1.f / D), rstd = 1.0f / sqrtf(fmaxf(sq * (1.f / D) - mean * mean, 0.f) + LN_EPS);
        float v0[4], v1[4];
#pragma unroll
        for (int reg = 0; reg < 4; ++reg) { const float rs = __builtin_bit_cast(float, shfl_idx_l(__builtin_bit_cast(int, rstd), 4 * fq + reg)), mn = __builtin_bit_cast(float, shfl_idx_l(__builtin_bit_cast(int, mean), 4 * fq + reg));
            v0[reg] = rs * acc0[reg] - rs * mn * cg0 + cb0; v1[reg] = rs * acc1[reg] - rs * mn * cg1 + cb1; }
        float wv[4][4]; int wi[4][4];
#pragma unroll
        for (int k = 0; k < 4; ++k) {
#pragma unroll
            for (int reg = 0; reg < 4; ++reg) { float bv = v0[reg]; int bi = fr; if (v1[reg] > bv) { bv = v1[reg]; bi = 16 + fr; }
#pragma unroll
                for (int o = 1; o < 16; o <<= 1) { const float ov = shfl_xor_l(bv, o, lane); const int oi = shfl_idx_l(bi, lane ^ o); if (ov > bv || (ov == bv && oi < bi)) { bv = ov; bi = oi; } }
                wv[k][reg] = bv; wi[k][reg] = bi; if (bi == fr) v0[reg] = -3.0e38f; if (bi == 16 + fr) v1[reg] = -3.0e38f; } }
        if (fr == 0) {
#pragma unroll
            for (int reg = 0; reg < 4; ++reg) { const int t = r0 + 4 * fq + reg; const float e1 = __expf(wv[1][reg] - wv[0][reg]), e2 = __expf(wv[2][reg] - wv[0][reg]), e3 = __expf(wv[3][reg] - wv[0][reg]), inv = 1.0f / (1.0f + e1 + e2 + e3);
                *(int4*)(TOKE + (size_t)t * 4) = make_int4(wi[0][reg], wi[1][reg], wi[2][reg], wi[3][reg]); *(f32x4*)(TOKW + (size_t)t * 4) = (f32x4){inv, e1 * inv, e2 * inv, e3 * inv};
#pragma unroll
                for (int k = 0; k < 4; ++k) __hip_atomic_fetch_add((LAS unsigned*)&hist[wi[k][reg]], 1u, __ATOMIC_RELAXED, __HIP_MEMORY_SCOPE_WORKGROUP); } }
        bf16* o16 = H16 + (size_t)(r0 + fr) * D + 8 * fq;
#pragma unroll 2
        for (int ks = 0; ks < 32; ++ks) { f32x4 xa, xb; unpk8(*(const v4u*)(xrow + 32 * ks), xa, xb);
            const f32x4 ga = *(const f32x4*)(g + 32 * ks + 8 * fq), gb = *(const f32x4*)(g + 32 * ks + 8 * fq + 4), ba = *(const f32x4*)(bb + 32 * ks + 8 * fq), bc = *(const f32x4*)(bb + 32 * ks + 8 * fq + 4);
            *(v4u*)(o16 + 32 * ks) = pk8((xa - mean) * rstd * ga + ba, (xb - mean) * rstd * gb + bc); }
    }
    __syncthreads();
    if (tid < NE && !dummy) { const unsigned c = hist[tid]; if (c) atomicAdd(F.ctl + CW_CNT + l * NE + tid, c); F.ctl[CW_WGH + (l * 512 + F.bid) * NE + tid] = c; }
}
__device__ __forceinline__ void moe_offsets(const Frame& F, int l) {
    if (F.tid == 0) { int acc = 0;
        for (int e = 0; e < NE; ++e) { F.MISC[MI_TOFF + e] = (unsigned)acc; const unsigned c = __hip_atomic_load(F.ctl + CW_CNT + l * NE + e, __ATOMIC_RELAXED, __HIP_MEMORY_SCOPE_AGENT); acc += (int)((c + 255u) >> 8); }
        F.MISC[MI_TOFF + NE] = (unsigned)acc; }
    __syncthreads();
}
__device__ __forceinline__ void p_moe_slots(const Frame& F, int l, int dummy) {
    const int gw = F.bid * NWAVES + F.wave, NGW = F.G * NWAVES, lane = F.lane;
    moe_offsets(F, l);
    const int* TOKE = (const int*)(F.ws + WS_TOKE); const float* TOKW = (const float*)(F.ws + WS_TOKW); int* TOKS = (int*)(F.ws + (dummy ? WS_END : WS_TOKS)); float* SLOTW = (float*)(F.ws + (dummy ? WS_END + 1 * MiB : WS_SLOTW));
    const bf16* H16 = (const bf16*)(F.ws + WS_H16); bf16* XG = (bf16*)(F.ws + (dummy ? WS_ACT : WS_XG)); unsigned* CUR = F.ctl + CW_CUR + l * NE + dummy * 256;
    if (F.tid < NE) { const unsigned c = F.ctl[CW_WGH + (l * 512 + F.bid) * NE + F.tid]; const unsigned base = c ? atomicAdd(CUR + F.tid, c) : 0u;
        F.MISC[MI_LBASE + F.tid] = F.MISC[MI_TOFF + F.tid] * 256u + base; F.MISC[MI_LCUR + F.tid] = 0u; }
    __syncthreads();
    for (int grp = gw; grp < T / 16; grp += NGW)
    for (int r = grp * 16; r < grp * 16 + 16; ++r) { int slot = 0;
        if (lane < 4) { const int e = TOKE[(size_t)r * 4 + lane]; const unsigned pos = __hip_atomic_fetch_add((LAS unsigned*)&F.MISC[MI_LCUR + e], 1u, __ATOMIC_RELAXED, __HIP_MEMORY_SCOPE_WORKGROUP); slot = (int)(F.MISC[MI_LBASE + e] + pos);
            TOKS[(size_t)r * 4 + lane] = slot; SLOTW[slot] = TOKW[(size_t)r * 4 + lane]; }
        const v4u a = *(const v4u*)(H16 + (size_t)r * D + 8 * lane), b = *(const v4u*)(H16 + (size_t)r * D + 512 + 8 * lane);
#pragma unroll
        for (int k = 0; k < 4; ++k) { const int sk = shfl_idx_l(slot, k); *(v4u*)(XG + (size_t)sk * D + 8 * lane) = a; *(v4u*)(XG + (size_t)sk * D + 512 + 8 * lane) = b; } }
}
__device__ __forceinline__ void p_moe_combine(KArgs& A, const Frame& F, int l, bool dummy) {
    const int gw = F.bid * NWAVES + F.wave, NGW = F.G * NWAVES, lane = F.lane;
    const bf16* H = (const bf16*)(F.ws + WS_H16); bf16* H16 = (bf16*)(F.ws + (dummy ? WS_Z + 128 * MiB : WS_H16)); const int* TOKS = (const int*)(F.ws + WS_TOKS); const bf16* YS = (const bf16*)(F.ws + WS_YS);
    const bool last = (l == NL - 1) && !dummy;
    for (int r0 = gw * 2; r0 < T; r0 += NGW * 2) {
        int4 sl[2]; sl[0] = *(const int4*)(TOKS + (size_t)r0 * 4); sl[1] = *(const int4*)(TOKS + (size_t)(r0 + 1) * 4);
        v2u hh[2][4], ys[2][4][4];
#pragma unroll
        for (int i = 0; i < 2; ++i)
#pragma unroll
            for (int j = 0; j < 4; ++j) { const int o = 256 * j + 4 * lane; hh[i][j] = *(const v2u*)(H + (size_t)(r0 + i) * D + o);
                ys[i][j][0] = *(const v2u*)(YS + (size_t)sl[i].x * D + o); ys[i][j][1] = *(const v2u*)(YS + (size_t)sl[i].y * D + o); ys[i][j][2] = *(const v2u*)(YS + (size_t)sl[i].z * D + o); ys[i][j][3] = *(const v2u*)(YS + (size_t)sl[i].w * D + o); }
#pragma unroll
        for (int i = 0; i < 2; ++i) { f32x4 v[4]; const int r = r0 + i;
#pragma unroll
            for (int j = 0; j < 4; ++j) { const v2u h2 = hh[i][j], y0 = ys[i][j][0], y1 = ys[i][j][1], y2 = ys[i][j][2], y3 = ys[i][j][3];
                v[j].x = bf2f(h2.x & 0xffffu) * DN_ALPHA + ((bf2f(y0.x & 0xffffu) + bf2f(y1.x & 0xffffu)) + (bf2f(y2.x & 0xffffu) + bf2f(y3.x & 0xffffu)));
                v[j].y = bf2f(h2.x >> 16) * DN_ALPHA + ((bf2f(y0.x >> 16) + bf2f(y1.x >> 16)) + (bf2f(y2.x >> 16) + bf2f(y3.x >> 16)));
                v[j].z = bf2f(h2.y & 0xffffu) * DN_ALPHA + ((bf2f(y0.y & 0xffffu) + bf2f(y1.y & 0xffffu)) + (bf2f(y2.y & 0xffffu) + bf2f(y3.y & 0xffffu)));
                v[j].w = bf2f(h2.y >> 16) * DN_ALPHA + ((bf2f(y0.y >> 16) + bf2f(y1.y >> 16)) + (bf2f(y2.y >> 16) + bf2f(y3.y >> 16))); }
            float mean, rstd; ln_stats(v, mean, rstd);
            if (last) ln_apply_store(v, mean, rstd, kin(A, I_LN3_G) + l * D, kin(A, I_LN3_B) + l * D, kout(A) + (size_t)r * D, (bf16*)nullptr, lane);
            else ln_apply_store(v, mean, rstd, kin(A, I_LN3_G) + l * D, kin(A, I_LN3_B) + l * D, (float*)nullptr, H16 + (size_t)r * D, lane); } }
}

constexpr int NPL = 18;
constexpr int NPHASES = 1 + NL * NPL;
#ifndef ONLY
#define ONLY -1
#endif
#define EN(j) (ONLY < 0 || ONLY == (j))
#define DUMMY(j) ((PROBE_PHASE == (j)) && (rep_ + 1 < PROBE_REPS))
#define REPS(j) for (int rep_ = 0; rep_ < ((PROBE_PHASE == (j)) ? PROBE_REPS : 1); ++rep_, __syncthreads())
__global__ void __launch_bounds__(NTHREADS, 2) fwd_kernel(Args args) {
    extern __shared__ __attribute__((aligned(16))) unsigned char lds_raw[];
    Frame F;
    F.lds = (LAS unsigned char*)lds_raw; F.MISC = (volatile LAS unsigned*)(F.lds + MISC_OFF);
    F.tid = threadIdx.x; F.lane = F.tid & 63; F.wave = __builtin_amdgcn_readfirstlane(F.tid >> 6); F.G = gridDim.x; F.bid = blockIdx.x;
    F.ws = (unsigned char*)(GAS unsigned char*)args.ws; F.ctl = (unsigned*)(F.ws + WS_CTL);
    for (int u = F.tid; u < (LDS_BYTES - MISC_OFF) / 4; u += NTHREADS) F.MISC[u] = 0u;
    __syncthreads();
    XcdBarrier bar; bar.bar = F.ctl + CW_BAR; bar.x = 0; bar.st = nullptr;
    const int lo = args.ph_lo, hi = args.ph_hi;
    if (hi - lo > 1) bar = xcd_barrier_post(F.ctl + CW_BAR, F.MISC + 8);
#define IN(k) (launder_i(lo) <= (k) && (k) < launder_i(hi))
#define SEAM(k) do { if (IN(k) && IN((k) + 1)) xcd_barrier(bar); } while (0)
#define PH_BEGIN KArgs& KA = *kargs(); unsigned char* ws = launder_p(args.ws); F.ws = ws; (void)KA; (void)ws; { int ln_; asm volatile("v_mbcnt_lo_u32_b32 %0, -1, 0\n\tv_mbcnt_hi_u32_b32 %0, -1, %0" : "=v"(ln_)); F.lane = ln_; } F.tid = F.wave * 64 + F.lane; F.bid = launder_i((int)blockIdx.x); F.G = launder_i((int)gridDim.x);

    if (EN(100) && IN(0)) REPS(100) { PH_BEGIN p_prologue(KA, F); } SEAM(0);
    if (PROBE_PHASE == 300) { for (int q_ = 0; q_ < 20; ++q_) xcd_barrier(bar); }

#pragma unroll 1
    for (int l_ = 0; l_ < NL; ++l_) {
        const int l = launder_i(l_); const int p0 = 1 + l * NPL;
        if (EN(0) && IN(p0 + 0)) REPS(0) { PH_BEGIN
            pg8::Gemm g{D, D, D}; pg8::StaticOrder S{(const bf16*)(ws + WS_H16), (const bf16*)(ws + WS_WINT) + (size_t)l * N_IN * D, D, D, T / 256, N_IN / 256, F.G, F.bid};
            if (PROBE_PHASE == 200) { for (int q_ = 0; q_ < PROBE_REPS - 1; ++q_) { EpiNull E0{0}; pg8::gemm_phase(F.lds, F.wave * 64 + my_lane(), g, S, E0); __syncthreads(); } }
            EpiIn E{l};
            pg8::gemm_phase(F.lds, F.wave * 64 + my_lane(), g, S, E);
        } SEAM(p0 + 0);
        if (EN(1) && IN(p0 + 1)) REPS(1) { PH_BEGIN p_mix1(KA, F, l); } SEAM(p0 + 1);
        if (EN(2) && IN(p0 + 2)) REPS(2) { PH_BEGIN
            { pg8::Gemm g{S5K, 1024, 1024}; pg8::BatchOrder S{(const bf16*)(ws + WS_AOUT), (const bf16*)(ws + WS_S5BC) + (size_t)l * 16 * 256 * 1024, S5K, 1024, NCHT / 256, 1, 16, F.G, (F.bid + 192) % F.G, (size_t)NCHT * S5K, (size_t)256 * 1024};
              EpiXloc E{0}; pg8::gemm_phase(F.lds, F.wave * 64 + my_lane(), g, S, E); }
            __syncthreads();
            { pg8::Gemm g{D, D, D}; pg8::StaticOrder S{(const bf16*)(ws + WS_MEM16), (const bf16*)(ws + WS_WKT) + (size_t)l * D * D, D, D, NB * NMEM / 256, D / 256, F.G, (F.bid + 160) % F.G};
              EpiBf16 E{(unsigned)(WS_KM16 / MiB), 1.0f}; pg8::gemm_phase(F.lds, F.wave * 64 + my_lane(), g, S, E); }
            __syncthreads();
            { pg8::Gemm g{D, D, D}; pg8::StaticOrder S{(const bf16*)(ws + WS_MEM16), (const bf16*)(ws + WS_WVT) + (size_t)l * D * D, D, D, NB * NMEM / 256, D / 256, F.G, (F.bid + 144) % F.G};
              EpiVT E{0}; pg8::gemm_phase(F.lds, F.wave * 64 + my_lane(), g, S, E); }
            __syncthreads();
            { pg8::Gemm g{256, 256, 256}; pg8::StaticOrder S{(const bf16*)(ws + WS_LA16), (const bf16*)(ws + WS_LWT) + (size_t)l * 768 * 256, 256, 256, T / 256, 3, F.G, (F.bid + 128) % F.G};
              EpiLora E{l}; pg8::gemm_phase(F.lds, F.wave * 64 + my_lane(), g, S, E); }
        } SEAM(p0 + 2);
        if (EN(3) && IN(p0 + 3)) REPS(3) { PH_BEGIN
            for (int q_ = 0; q_ < ((PROBE_PHASE == 301) ? PROBE_REPS : 1); ++q_) p_s5_chain(KA, F, l);
            for (int q_ = 0; q_ < ((PROBE_PHASE == 302) ? PROBE_REPS : 1); ++q_) p_rw_chunks(KA, F, l); } SEAM(p0 + 3);
        if (EN(4) && IN(p0 + 4)) REPS(4) { PH_BEGIN
            p_chain_compose(F);
            pg8::Gemm g{S5K, S5K, S5K}; pg8::BatchOrder S{(const bf16*)(ws + WS_AOUT), (const bf16*)(ws + WS_S5BT) + (size_t)l * 16 * 1024 * S5K, S5K, S5K, NCHT / 256, 1024 / 256, 16, F.G, F.bid, (size_t)NCHT * S5K, (size_t)1024 * S5K};
            EpiS5Y E{l}; pg8::gemm_phase(F.lds, F.wave * 64 + my_lane(), g, S, E);
        } SEAM(p0 + 4);
        if (EN(5) && IN(p0 + 5)) REPS(5) { PH_BEGIN
            const int nchain = (F.G >= 128) ? 64 : 0;
            if (F.bid < nchain) { if (F.wave == 0) p_chain_blocks(F, F.bid, nchain); }
            else {
                if (nchain == 0) { p_chain_blocks(F, F.bid * NWAVES + F.wave, F.G * NWAVES); __syncthreads(); }
                pg8::Gemm g{256, 256, 256}; pg8::StaticOrder S{(const bf16*)(ws + WS_YD16), (const bf16*)(ws + WS_GLUT) + (size_t)l * 256 * 256, 256, 256, T / 256, 1, F.G - nchain, F.bid - nchain};
                EpiGlu E{l}; pg8::gemm_phase(F.lds, F.wave * 64 + my_lane(), g, S, E);
            }
        } SEAM(p0 + 5);
        if (EN(6) && IN(p0 + 6)) REPS(6) { PH_BEGIN
            for (int bb = F.bid; bb < 16 * NBLK; bb += F.G) {
                if (F.wave < 4) chain_inblock(F, bb, F.wave);
                VM_WAIT(); __syncthreads();
                rw_out_task(KA, F, l, bb * CB + F.wave);
                __syncthreads();
            }
        } SEAM(p0 + 6);
        if (EN(7) && IN(p0 + 7)) REPS(7) { PH_BEGIN
            pg8::Gemm g{D, 256, 256}; pg8::BranchOrder S{(const bf16*)(ws + WS_O16), (const bf16*)(ws + WS_BRT) + (size_t)l * 4 * D * 256, T / 256, D / 256, F.G, F.bid};
            EpiBranch E{0}; pg8::gemm_phase(F.lds, F.wave * 64 + my_lane(), g, S, E);
        } SEAM(p0 + 7);
        if (EN(8) && IN(p0 + 8)) REPS(8) { PH_BEGIN
            pg8::Gemm g{D, D, D}; pg8::StaticOrder S{(const bf16*)(ws + WS_MG16), (const bf16*)(ws + WS_WOUTT) + (size_t)l * D * D, D, D, T / 256, D / 256, F.G, F.bid};
            EpiResid E{0}; pg8::gemm_phase(F.lds, F.wave * 64 + my_lane(), g, S, E);
        } SEAM(p0 + 8);
        if (EN(9) && IN(p0 + 9)) REPS(9) { PH_BEGIN p_ln(F, kin(KA, I_LN1_G) + l * D, kin(KA, I_LN1_B) + l * D, DUMMY(9)); } SEAM(p0 + 9);
        if (EN(10) && IN(p0 + 10)) REPS(10) { PH_BEGIN
            pg8::Gemm g{D, D, D}; pg8::StaticOrder S{(const bf16*)(ws + WS_H16), (const bf16*)(ws + WS_WQT) + (size_t)l * D * D, D, D, T / 256, D / 256, F.G, F.bid};
            EpiBf16 E{(unsigned)(WS_Q16 / MiB), 0.0625f}; pg8::gemm_phase(F.lds, F.wave * 64 + my_lane(), g, S, E);
        } SEAM(p0 + 10);
        if (EN(11) && IN(p0 + 11)) REPS(11) { PH_BEGIN p_attn(F); } SEAM(p0 + 11);
        if (EN(12) && IN(p0 + 12)) REPS(12) { PH_BEGIN
            pg8::Gemm g{D, D, D}; pg8::StaticOrder S{(const bf16*)(ws + WS_AO16), (const bf16*)(ws + WS_WOT) + (size_t)l * D * D, D, D, T / 256, D / 256, F.G, F.bid};
            EpiResid E{0}; pg8::gemm_phase(F.lds, F.wave * 64 + my_lane(), g, S, E);
        } SEAM(p0 + 12);
        if (EN(13) && IN(p0 + 13)) REPS(13) { PH_BEGIN p_ln_router(KA, F, l, DUMMY(13)); } SEAM(p0 + 13);
        if (EN(14) && IN(p0 + 14)) REPS(14) { PH_BEGIN p_moe_slots(F, l, DUMMY(14) ? (rep_ + 1) : 0); } SEAM(p0 + 14);
        if (EN(15) && IN(p0 + 15)) REPS(15) { PH_BEGIN
            moe_offsets(F, l);
            pg8::Gemm g{D, D, D}; pg8::MoeOrder S{(const bf16*)(ws + WS_XG), (const bf16*)(ws + WS_W1T) + (size_t)l * NE * 2048 * D, D, D, 2048 / 256, F.G, F.bid, (size_t)2048 * D, (const LAS int*)(F.MISC + MI_TOFF)};
            if (PROBE_PHASE == 201) { for (int q_ = 0; q_ < PROBE_REPS - 1; ++q_) { EpiNull E0{0}; pg8::gemm_phase(F.lds, F.wave * 64 + my_lane(), g, S, E0); __syncthreads(); } }
            EpiSwiglu E{l}; pg8::gemm_phase(F.lds, F.wave * 64 + my_lane(), g, S, E);
        } SEAM(p0 + 15);
        if (EN(16) && IN(p0 + 16)) REPS(16) { PH_BEGIN
            moe_offsets(F, l);
            pg8::Gemm g{DFF, DFF, DFF}; pg8::MoeOrder S{(const bf16*)(ws + WS_ACT), (const bf16*)(ws + WS_W2T) + (size_t)l * NE * D * DFF, DFF, DFF, D / 256, F.G, F.bid, (size_t)D * DFF, (const LAS int*)(F.MISC + MI_TOFF)};
            EpiMoeOut E{l}; pg8::gemm_phase(F.lds, F.wave * 64 + my_lane(), g, S, E);
        } SEAM(p0 + 16);
        if (EN(17) && IN(p0 + 17)) REPS(17) { PH_BEGIN p_moe_combine(KA, F, l, DUMMY(17)); } SEAM(p0 + 17);
    }
#undef IN
#undef SEAM
}

extern "C" void kernel_launch(void* const* d_in, const int* in_sizes, int n_in, void* d_out, int out_size, void* d_ws, size_t ws_size, hipStream_t stream) {
    static int grid = 0;
    if (grid == 0) {
        if (n_in != 50 || ws_size < WS_END) { fprintf(stderr, "kernel_launch: unexpected n_in %d / ws_size %zu\n", n_in, ws_size); grid = -1; return; }
        int dev = 0, cus = 0, per_cu = 0;
        if (hipGetDevice(&dev) != hipSuccess || hipDeviceGetAttribute(&cus, hipDeviceAttributeMultiprocessorCount, dev) != hipSuccess) { grid = -1; return; }
        if (hipFuncSetAttribute((const void*)fwd_kernel, hipFuncAttributeMaxDynamicSharedMemorySize, LDS_BYTES) != hipSuccess) { fprintf(stderr, "kernel_launch: hipFuncSetAttribute failed\n"); grid = -1; return; }
        if (hipOccupancyMaxActiveBlocksPerMultiprocessor(&per_cu, (const void*)fwd_kernel, NTHREADS, LDS_BYTES) != hipSuccess || per_cu < 1) { fprintf(stderr, "kernel_launch: occupancy query says %d\n", per_cu); }
        (void)hipGetLastError();
        grid = cus;
    }
    if (grid < 0) return;
    (void)hipMemsetAsync((char*)d_ws + WS_CTL, 0, CTL_ZERO_BYTES, stream);
    Args a{};
    for (int i = 0; i < 50; ++i) a.in[i] = (const float*)d_in[i];
    a.out = (float*)d_out; a.ws = (unsigned char*)d_ws;
#if N_LAUNCHES == 1
    a.ph_lo = 0; a.ph_hi = NPHASES;
    hipLaunchKernelGGL(fwd_kernel, dim3(grid), dim3(NTHREADS), LDS_BYTES, stream, a);
#else
    for (int p = 0; p < NPHASES; ++p) { a.ph_lo = p; a.ph_hi = p + 1; hipLaunchKernelGGL(fwd_kernel, dim3(grid), dim3(NTHREADS), LDS_BYTES, stream, a); }
#endif
}
```

```cpp
#include <hip/hip_runtime.h>
#include <cstdio>
#include <cstdint>

#ifndef N_LAUNCHES
#define N_LAUNCHES 1
#endif

#ifndef PROBE_PHASE
#define PROBE_PHASE -1
#endif
#ifndef PROBE_REPS
#define PROBE_REPS 3
#endif
#define GAS __attribute__((address_space(1)))
#define LAS __attribute__((address_space(3)))
typedef unsigned short bf16;
typedef unsigned v4u __attribute__((ext_vector_type(4)));
typedef unsigned v2u __attribute__((ext_vector_type(2)));
typedef float f32x4 __attribute__((ext_vector_type(4)));
typedef float f32x2 __attribute__((ext_vector_type(2)));
typedef short bf16x8 __attribute__((ext_vector_type(8)));
typedef short bf16x4 __attribute__((ext_vector_type(4)));

constexpr int NL = 2, NB = 4, SEQ = 8192, T = NB * SEQ, D = 1024;
constexpr int NMEM = 256;
constexpr int OFF_B = 768, OFF_C = 1280, OFF_D = 2304, OFF_G = 2560, N_IN = 6656, ZLD = 2560;
constexpr int NE = 32, TOPK = 4, DFF = 1024;
constexpr int CH = 64;
constexpr int NCH = SEQ / CH;
constexpr int NCHT = T / CH;
constexpr int S5K = 1152;
constexpr int SLOT_ROWS = T * TOPK + NE * 256;
constexpr float LN_EPS = 1e-5f, RW_LN_EPS = 64e-5f;
constexpr float DN_ALPHA = 1.41421356237309515f;

constexpr size_t MiB = 1u << 20;
constexpr size_t WS_CTL = 0, CTL_ZERO_BYTES = 1 * MiB;
constexpr size_t WS_W1T = 2 * MiB;
constexpr size_t WS_W2T = 258 * MiB;
constexpr size_t WS_WINT = 386 * MiB;
constexpr size_t WS_BRT = 412 * MiB;
constexpr size_t WS_WOUTT = 416 * MiB, WS_WQT = 420 * MiB, WS_WKT = 424 * MiB, WS_WVT = 428 * MiB, WS_WOT = 432 * MiB;
constexpr size_t WS_GLUT = 436 * MiB;
constexpr size_t WS_SGW = 436 * MiB + 512 * 1024;
constexpr size_t WS_MEM16 = 437 * MiB;
constexpr size_t WS_S5BT = 440 * MiB;
constexpr size_t WS_S5BC = 512 * MiB;
constexpr size_t WS_PRE16 = 528 * MiB;
constexpr size_t WS_H16 = 656 * MiB;
constexpr size_t WS_Z = 720 * MiB;
constexpr size_t WS_XG = 720 * MiB;
constexpr size_t WS_SG = 1040 * MiB;
constexpr size_t WS_YS = 1040 * MiB;
constexpr size_t WS_O16 = 1312 * MiB, WS_MG16 = 1376 * MiB, WS_Q16 = 1440 * MiB, WS_AO16 = 1504 * MiB;
constexpr size_t WS_LA16 = 1568 * MiB;
constexpr size_t WS_DEC = 1584 * MiB, WS_AV = 1616 * MiB;
constexpr size_t WS_LWT = 2012 * MiB;
constexpr size_t WS_ACT = 1568 * MiB;
constexpr size_t WS_QH = 1760 * MiB, WS_YL = 1792 * MiB, WS_GC = 1824 * MiB, WS_HC = 1856 * MiB, WS_SC = 1888 * MiB, WS_RWG = 1920 * MiB;
constexpr size_t WS_RK = 1952 * MiB;
constexpr size_t WS_AOUT = 1954 * MiB;
constexpr size_t WS_XLOC = 1972 * MiB;
constexpr size_t WS_YD16 = 1976 * MiB;
constexpr size_t WS_KM16 = 1992 * MiB, WS_VMT16 = 1994 * MiB;
constexpr size_t WS_TOKE = 1996 * MiB, WS_TOKW = 1997 * MiB, WS_TOKS = 1998 * MiB, WS_SLOTW = 1999 * MiB;
constexpr size_t WS_GB = 2000 * MiB, WS_HB = 2004 * MiB, WS_SB = 2008 * MiB;
constexpr size_t WS_STOK = 2014 * MiB;
constexpr size_t WS_END = 2016 * MiB;
static_assert(WS_XG + (size_t)SLOT_ROWS * D * 2 <= WS_SG && WS_YS + (size_t)SLOT_ROWS * D * 2 <= WS_O16 && WS_ACT + (size_t)SLOT_ROWS * D * 2 <= WS_RK, "overlays");
constexpr int CW_BAR = 4096;
constexpr int CW_CNT = 16384;
constexpr int CW_CUR = 16384 + 128;
constexpr int CW_WGH = 65536;

constexpr int LDS_BYTES = 163840;
constexpr int MISC_OFF = LDS_BYTES - 1024;
constexpr int RING_BYTES = 131072;
constexpr int NWAVES = 8, NTHREADS = 512;

#define LDS_WAIT() asm volatile("s_waitcnt lgkmcnt(0)" ::: "memory")
#define VM_WAIT() asm volatile("s_waitcnt vmcnt(0)" ::: "memory")
__device__ __forceinline__ unsigned f2bf(float f) { unsigned u = __float_as_uint(f); return (u + 0x7fffu + ((u >> 16) & 1u)) >> 16; }
__device__ __forceinline__ unsigned pk2(float lo, float hi) { unsigned r; asm("v_cvt_pk_bf16_f32 %0, %1, %2" : "=v"(r) : "v"(lo), "v"(hi)); return r; }
__device__ __forceinline__ float bf2f(unsigned h) { return __uint_as_float(h << 16); }
__device__ __forceinline__ float sigmoidf_(float x) { return __builtin_amdgcn_rcpf(1.0f + __expf(-x)); }
__device__ __forceinline__ int my_lane() { int l; asm volatile("v_mbcnt_lo_u32_b32 %0, -1, 0\n\tv_mbcnt_hi_u32_b32 %0, -1, %0" : "=v"(l)); return l; }
__device__ __forceinline__ float shfl_xor_l(float v, int o, int lane) { return __builtin_bit_cast(float, __builtin_amdgcn_ds_bpermute((lane ^ o) << 2, __builtin_bit_cast(int, v))); }
__device__ __forceinline__ int shfl_idx_l(int v, int src) { return __builtin_amdgcn_ds_bpermute(src << 2, v); }
__device__ __forceinline__ void fmac_(float& c, float a, float b) { asm("v_fmac_f32 %0, %1, %2" : "+v"(c) : "v"(a), "v"(b)); }
template <int R> __device__ __forceinline__ void fmac_bc(float& c, float op, float x) { asm("v_fmac_f32_dpp %0, %1, %2 row_newbcast:%3 row_mask:0xf bank_mask:0xf" : "+v"(c) : "v"(op), "v"(x), "n"(R)); }
__device__ __forceinline__ float wave_sum(float v) {
    const int ln = my_lane();
#pragma unroll
    for (int o = 1; o < 64; o <<= 1) v += shfl_xor_l(v, o, ln);
    return v;
}

#define XB_TMO      128
#define XB_XCNT(j)  (256  + 64 * (j))
#define XB_XSUB(j)  (1280 + 64 * (j))
#define XB_XGEN(j)  (2304 + 64 * (j))
#define XB_TOP      3328
#define XB_TOPGEN   3392
#define XCD_BAR_WORDS 3456
#define XB_SPIN_CAP (1u << 24)
__device__ __forceinline__ unsigned xb_ld(unsigned* p)              { return __hip_atomic_load(p, __ATOMIC_RELAXED, __HIP_MEMORY_SCOPE_AGENT); }
__device__ __forceinline__ unsigned xb_add(unsigned* p, unsigned v) { return __hip_atomic_fetch_add(p, v, __ATOMIC_RELAXED, __HIP_MEMORY_SCOPE_AGENT); }
__device__ __forceinline__ unsigned xb_xcc_id() { return (unsigned)__builtin_amdgcn_s_getreg((3 << 11) | 20) & 0xFu; }
#define XB_SPIN(cond, bar) do { unsigned _sp = 0; while (cond) { __builtin_amdgcn_s_sleep(1); \
    if ((++_sp & 255u) == 0u) { if (xb_ld(&(bar)[XB_TMO])) break; if (_sp > XB_SPIN_CAP) { atomicAdd(&(bar)[XB_TMO], 1u); break; } } } } while (0)
struct XcdBarrier { unsigned* bar; unsigned x; volatile LAS unsigned* st; };
__device__ __forceinline__ XcdBarrier xcd_barrier_post(unsigned* bar, volatile LAS unsigned* st) {
    XcdBarrier b; b.bar = bar; b.x = xb_xcc_id(); b.st = st;
    if (threadIdx.x == 0) (void)xb_add(&bar[XB_XCNT(b.x)], 1u);
    return b;
}
__device__ __forceinline__ void xcd_barrier_complete(unsigned* bar, unsigned x, unsigned& nloc, unsigned& nx) {
    const unsigned G = gridDim.x * gridDim.y * gridDim.z;
    unsigned sum, cnt, mine, sp = 0u;
    for (;;) {
        sum = 0u; cnt = 0u; mine = 0u;
#pragma unroll
        for (unsigned j = 0; j < 16; ++j) { const unsigned c = xb_ld(&bar[XB_XCNT(j)]); sum += c; cnt += (c > 0u) ? 1u : 0u; mine = (j == x) ? c : mine; }
        if (sum == G) break;
        __builtin_amdgcn_s_sleep(1);
        if ((++sp & 255u) == 0u) { if (xb_ld(&bar[XB_TMO])) break; if (sp > XB_SPIN_CAP) { atomicAdd(&bar[XB_TMO], 1u); break; } }
    }
    nloc = mine > 0u ? mine : 1u; nx = cnt > 0u ? cnt : 1u;
}
__device__ __forceinline__ void xcd_barrier(const XcdBarrier& b) {
    asm volatile("s_waitcnt vmcnt(0)" ::: "memory");
    __syncthreads();
    if (threadIdx.x == 0) {
        unsigned* bar = b.bar; unsigned bx = b.x;
        asm volatile("" : "+s"(bar), "+s"(bx));
        __builtin_amdgcn_s_waitcnt(0);
        unsigned nloc = b.st[0], nx = b.st[1];
        if (nloc == 0u) { xcd_barrier_complete(bar, bx, nloc, nx); b.st[0] = nloc; b.st[1] = nx; }
        const unsigned old = xb_add(&bar[XB_XSUB(bx)], 1u);
        const unsigned gen = old / nloc;
        if (old + 1u == (gen + 1u) * nloc) {
            __builtin_amdgcn_fence(__ATOMIC_RELEASE, "agent");
            asm volatile("s_waitcnt vmcnt(0)" ::: "memory");
            const unsigned og = xb_add(&bar[XB_TOP], 1u);
            const unsigned tg = og / nx;
            if (og + 1u == (tg + 1u) * nx) xb_add(&bar[XB_TOPGEN], 1u);
            else XB_SPIN(xb_ld(&bar[XB_TOPGEN]) == tg, bar);
            __builtin_amdgcn_fence(__ATOMIC_ACQUIRE, "agent");
            xb_add(&bar[XB_XGEN(bx)], 1u);
            asm volatile("s_waitcnt vmcnt(0)" ::: "memory");
        } else {
            XB_SPIN(xb_ld(&bar[XB_XGEN(bx)]) == gen, bar);
            __builtin_amdgcn_fence(__ATOMIC_ACQUIRE, "agent");
            asm volatile("s_waitcnt vmcnt(0)" ::: "memory");
        }
    }
    __syncthreads();
}

namespace pg8 {
constexpr int BM = 256, BK = 64, HALF = 128, HTB = HALF * BK * 2, STAGE_BYTES = 8 * HTB, NXCD = 8, WGM = 8;
__host__ __device__ __forceinline__ int lds_byte(int r, int c) { const int st = (r >> 4) * 2 + (c >> 5), rr = r & 15, cc = c & 31, ob = rr * 64 + cc * 2; return st * 1024 + (ob ^ (((ob >> 9) & 1) << 5)); }
__host__ __device__ __forceinline__ int perm32(int rho) { const int n = rho >> 4, i = rho & 15; return 8 * (i >> 2) + 4 * n + (i & 3); }
__host__ __device__ __forceinline__ void stage_rc(int b, int& R, int& C) { const int st = b / 1024, sb = b % 1024, swz = sb ^ (((sb >> 9) & 1) << 5); R = (st >> 1) * 16 + swz / 64; C = (st & 1) * 32 + (swz % 64) / 2; }
struct Unit { int pm, pn, e; };
struct Gemm { int lda, ldb, K; };

__device__ __forceinline__ bool static_tile(int i, int G, int c, int nM, int nN, int& pm, int& pn) {
    const int nwg = nM * nN; const long L = (long)i * G + c; if (L >= nwg) return false;
    int wgid = (int)L; { const int q = nwg / NXCD, r = nwg % NXCD, xcd = wgid % NXCD, off = wgid / NXCD; wgid = (xcd < r ? xcd * (q + 1) : r * (q + 1) + (xcd - r) * q) + off; }
    const int nig = WGM * nN, gid = wgid / nig, fm = gid * WGM, gsz = (nM - fm) < WGM ? (nM - fm) : WGM;
    pm = fm + ((wgid % nig) % gsz); pn = (wgid % nig) / gsz; return true;
}
struct StaticOrder { static constexpr bool GATHER = false;
    const bf16* A; const bf16* Bt; int lda, ldb, nM, nN, G, c;
    __device__ __forceinline__ bool next(int i, Unit& u) const { u.e = 0; return static_tile(i, G, c, nM, nN, u.pm, u.pn); }
    __device__ __forceinline__ const char* a_base(const Unit& u) const { return (const char*)(A + (size_t)u.pm * BM * lda); }
    __device__ __forceinline__ const char* b_base(const Unit& u) const { return (const char*)(Bt + (size_t)u.pn * BM * ldb); }
};
struct BatchOrder { static constexpr bool GATHER = false;
    const bf16* A; const bf16* Bt; int lda, ldb, nM, nN, nb, G, c; size_t sA, sB;
    __device__ __forceinline__ bool next(int i, Unit& u) const {
        const long L = (long)i * G + c; const int per = nM * nN; if (L >= (long)per * nb) return false;
        u.e = (int)(L / per); const int r = (int)(L % per); u.pn = r / nM; u.pm = r % nM; return true; }
    __device__ __forceinline__ const char* a_base(const Unit& u) const { return (const char*)(A + (size_t)u.e * sA + (size_t)u.pm * BM * lda); }
    __device__ __forceinline__ const char* b_base(const Unit& u) const { return (const char*)(Bt + (size_t)u.e * sB + (size_t)u.pn * BM * ldb); }
};
struct BranchOrder { static constexpr bool GATHER = false;
    const bf16* A; const bf16* Bt; int nM, nN, G, c;
    __device__ __forceinline__ bool next(int i, Unit& u) const { u.e = i & 3; return static_tile(i >> 2, G, c, nM, nN, u.pm, u.pn); }
    __device__ __forceinline__ const char* a_base(const Unit& u) const { return (const char*)(A + (size_t)u.pm * BM * D + u.e * 256); }
    __device__ __forceinline__ const char* b_base(const Unit& u) const { return (const char*)(Bt + (size_t)u.e * D * 256 + (size_t)u.pn * BM * 256); }
};
template <bool GATHER_> struct MoeOrderT { static constexpr bool GATHER = GATHER_;
    const bf16* A; const bf16* Bt; int lda, ldb, nN, G, c; size_t sB; const LAS int* toff; const int* tok;
    __device__ __forceinline__ bool next(int i, Unit& u) const {
        const int nt = toff[NE]; int mt;
        const int Gx = G >> 3;
        if ((G & 7) == 0 && (Gx % nN) == 0) {
            const int per = Gx / nN, x = c & 7, y = c >> 3;
            mt = i * 8 * per + x * per + y / nN; u.pn = y % nN; if (mt >= nt) return false;
        } else { const long L = (long)i * G + c; if (L >= (long)nt * nN) return false; mt = (int)(L / nN); u.pn = (int)(L % nN); }
        u.pm = mt; int e = 0;
#pragma unroll 1
        for (int k = 1; k < NE; ++k) e += (toff[k] <= mt) ? 1 : 0;
        u.e = e; return true; }
    __device__ __forceinline__ const char* a_base(const Unit& u) const { return GATHER_ ? (const char*)A : (const char*)(A + (size_t)u.pm * BM * lda); }
    __device__ __forceinline__ const char* b_base(const Unit& u) const { return (const char*)(Bt + (size_t)u.e * sB + (size_t)u.pn * BM * ldb); }
    __device__ __forceinline__ unsigned tok2(const Unit& u, int r) const { return (unsigned)tok[u.pm * BM + r] | ((unsigned)tok[u.pm * BM + r + 64] << 16); }
};
typedef MoeOrderT<false> MoeOrder;

template <class F> __device__ __forceinline__ void epi_foreach(const f32x4 (&acc)[2][2][4][2], const Unit& u, int wr, int wc, int fr, int fq, const F& f) {
#pragma unroll
    for (int ai = 0; ai < 2; ++ai)
#pragma unroll
        for (int m = 0; m < 4; ++m) { const int row = u.pm * BM + ai * HALF + wr * 64 + m * 16 + fr;
#pragma unroll
            for (int bj = 0; bj < 2; ++bj)
#pragma unroll
                for (int n = 0; n < 2; ++n) f(row, u.pn * BM + bj * HALF + wc * 32 + n * 16 + 4 * fq, acc[ai][bj][m][n]);
            if (m == 3) __builtin_amdgcn_sched_barrier(0); }
}

template <class F> __device__ __forceinline__ void epi_foreach8(const f32x4 (&acc)[2][2][4][2], const Unit& u, int wr, int wc, int fr, int fq, const F& f) {
#pragma unroll
    for (int ai = 0; ai < 2; ++ai)
#pragma unroll
        for (int m = 0; m < 4; ++m) { const int row = u.pm * BM + ai * HALF + wr * 64 + m * 16 + fr;
#pragma unroll
            for (int bj = 0; bj < 2; ++bj) f(row, u.pn * BM + bj * HALF + wc * 32 + 8 * fq, acc[ai][bj][m][0], acc[ai][bj][m][1]);
            if (m == 3) __builtin_amdgcn_sched_barrier(0); }
}
template <class Epi, class Sched, bool ALIGN_EPI = true, bool SP2 = true>
__device__ __forceinline__ void gemm_phase(LAS unsigned char* lds, const int tid, const Gemm g, const Sched& S, const Epi& E) {
    const int wid = __builtin_amdgcn_readfirstlane(tid >> 6), lane = tid & 63, wr = wid >> 2, wc = wid & 3, fr = lane & 15, fq = lane >> 4;
    const int K = g.K, nt = K / BK;
    unsigned voffA[2], voffB[2]; int gR0 = 0; unsigned gC = 0;
    { int R, C; stage_rc(tid * 16, R, C); gR0 = R; gC = (unsigned)C * 2u; }
#pragma unroll
    for (int i = 0; i < 2; ++i) { int R, C; stage_rc(tid * 16 + i * 8192, R, C);
        const int Rb = Epi::PERM ? ((R & ~31) + perm32(R & 31)) : R;
        voffA[i] = (unsigned)(R * g.lda + C) * 2u; voffB[i] = (unsigned)(Rb * g.ldb + C) * 2u; }
    const size_t kstep = (size_t)(BK * 2);
    const size_t hstepA = (size_t)HALF * g.lda * 2, hstepB = (size_t)HALF * g.ldb * 2;
    const unsigned ldsw = (unsigned)wid * 1024u;
    const int aoff = lds_byte(wr * 64 + fr, fq * 8), boff = lds_byte(wc * 32 + fr, fq * 8);
#define PG8_SA(b, h) (((b) * 2 + (h)) * HTB)
#define PG8_SB(b, h) ((4 + (b) * 2 + (h)) * HTB)
#define PG8_STAGE(bufoff, gbase, voff) do { _Pragma("unroll") for (int _i = 0; _i < 2; ++_i) \
        __builtin_amdgcn_global_load_lds((const unsigned*)((const char*)(gbase) + (voff)[_i]), (LAS unsigned*)(lds + (bufoff) + ldsw + _i * 8192), 16, 0, 0); } while (0)
#define PG8_STAGE_A(bufoff, gbase, h, nextsel) do { if constexpr (Sched::GATHER) { const unsigned _p = (nextsel) ? tkn[h] : tkc[h]; unsigned _v[2]; \
        _v[0] = (_p & 0xffffu) * (unsigned)(g.lda * 2) + gC; _v[1] = (_p >> 16) * (unsigned)(g.lda * 2) + gC; PG8_STAGE(bufoff, gbase, _v); } \
    else { PG8_STAGE(bufoff, (gbase) + ((h) ? hstepA : 0), voffA); } } while (0)
#define PG8_LDA(dst, b, h) do { _Pragma("unroll") for (int m = 0; m < 4; ++m) _Pragma("unroll") for (int k = 0; k < 2; ++k) dst[m][k] = *(const LAS bf16x8*)(lds + PG8_SA(b, h) + aoff + m * 2048 + k * 1024); } while (0)
#define PG8_LDB(dst, b, h) do { _Pragma("unroll") for (int n = 0; n < 2; ++n) _Pragma("unroll") for (int k = 0; k < 2; ++k) dst[n][k] = *(const LAS bf16x8*)(lds + PG8_SB(b, h) + boff + n * 2048 + k * 1024); } while (0)
#define PG8_MMA(ai, bj, At, Bt) do { __builtin_amdgcn_s_setprio(1); _Pragma("unroll") for (int m = 0; m < 4; ++m) _Pragma("unroll") for (int n = 0; n < 2; ++n) _Pragma("unroll") for (int k = 0; k < 2; ++k) \
        acc[ai][bj][m][n] = __builtin_amdgcn_mfma_f32_16x16x32_bf16(Bt[n][k], At[m][k], acc[ai][bj][m][n], 0, 0, 0); __builtin_amdgcn_s_setprio(0); } while (0)
#define PG8_WAIT_V(n) asm volatile("s_waitcnt vmcnt(" #n ")" ::: "memory")
#define PG8_WAIT_L(n) asm volatile("s_waitcnt lgkmcnt(" #n ")" ::: "memory")
#define PG8_BAR __builtin_amdgcn_s_barrier()
#define PG8_SCHED __builtin_amdgcn_sched_barrier(0)
    Unit cur, nxt; int ui = 0;
    if (!S.next(0, cur)) return;
    f32x4 acc[2][2][4][2];
#pragma unroll
    for (int a = 0; a < 2; ++a)
#pragma unroll
        for (int b = 0; b < 2; ++b)
#pragma unroll
            for (int m = 0; m < 4; ++m)
#pragma unroll
                for (int n = 0; n < 2; ++n) acc[a][b][m][n] = (f32x4){0.f, 0.f, 0.f, 0.f};
    bf16x8 At[4][2], B0[2][2], B1[2][2];
    const char* cA = S.a_base(cur); const char* cB = S.b_base(cur);
    unsigned tkc[2] = {0u, 0u}, tkn[2] = {0u, 0u};
    if constexpr (Sched::GATHER) { tkc[0] = S.tok2(cur, gR0); tkc[1] = S.tok2(cur, gR0 + HALF); }
    if constexpr (SP2) {
        PG8_STAGE(PG8_SB(0, 0), cB, voffB); PG8_STAGE(PG8_SB(0, 1), cB + hstepB, voffB); PG8_STAGE_A(PG8_SA(0, 0), cA, 0, false); PG8_STAGE_A(PG8_SA(0, 1), cA, 1, false);
        if (wr == 1) PG8_BAR;
        PG8_WAIT_V(2); PG8_BAR;
        PG8_STAGE(PG8_SB(1, 0), cB + kstep, voffB); PG8_STAGE_A(PG8_SA(1, 0), cA + kstep, 0, false); PG8_STAGE(PG8_SB(1, 1), cB + hstepB + kstep, voffB);
        PG8_WAIT_V(6); PG8_BAR;
    } else {
        PG8_STAGE(PG8_SB(0, 0), cB, voffB); PG8_STAGE_A(PG8_SA(0, 0), cA, 0, false); PG8_STAGE(PG8_SB(0, 1), cB + hstepB, voffB); PG8_STAGE_A(PG8_SA(0, 1), cA, 1, false);
        if (wr == 1) PG8_BAR;
        PG8_WAIT_V(4); PG8_BAR;
        PG8_STAGE(PG8_SB(1, 0), cB + kstep, voffB); PG8_STAGE_A(PG8_SA(1, 0), cA + kstep, 0, false); PG8_STAGE(PG8_SB(1, 1), cB + hstepB + kstep, voffB);
        PG8_WAIT_V(6); PG8_BAR;
    }
    for (;;) {
        const bool has_next = S.next(ui + 1, nxt);
        const char* nA = has_next ? S.a_base(nxt) : cA; const char* nB = has_next ? S.b_base(nxt) : cB;
        if constexpr (Sched::GATHER) { if (has_next) { tkn[0] = S.tok2(nxt, gR0); tkn[1] = S.tok2(nxt, gR0 + HALF); } else { tkn[0] = tkc[0]; tkn[1] = tkc[1]; } }
        for (int t = 0; t < nt; t += 2) {
            const bool last = (t == nt - 2);
            const char* a1 = cA + (size_t)(t + 1) * kstep;
            const char* a2 = last ? nA : cA + (size_t)(t + 2) * kstep; const char* b2 = last ? nB : cB + (size_t)(t + 2) * kstep;
            const char* a3 = a2 + kstep; const char* b3 = b2 + kstep;
            if constexpr (SP2) {
            PG8_LDB(B0, 0, 0); PG8_LDB(B1, 0, 1); PG8_SCHED; PG8_LDA(At, 0, 0); PG8_STAGE_A(PG8_SA(1, 1), a1, 1, false);
            PG8_WAIT_V(8); PG8_WAIT_L(0); PG8_BAR; PG8_MMA(0, 0, At, B0); PG8_MMA(0, 1, At, B1); PG8_BAR; PG8_SCHED;
            PG8_LDA(At, 0, 1); PG8_STAGE(PG8_SB(0, 0), b2, voffB); PG8_STAGE(PG8_SB(0, 1), b2 + hstepB, voffB); PG8_STAGE_A(PG8_SA(0, 0), a2, 0, last);
            PG8_WAIT_V(8); PG8_WAIT_L(0); PG8_BAR; PG8_MMA(1, 0, At, B0); PG8_MMA(1, 1, At, B1); PG8_BAR; PG8_SCHED;
            PG8_LDB(B0, 1, 0); PG8_LDB(B1, 1, 1); PG8_SCHED; PG8_LDA(At, 1, 0); PG8_STAGE_A(PG8_SA(0, 1), a2, 1, last);
            PG8_WAIT_V(8); PG8_WAIT_L(0); PG8_BAR; PG8_MMA(0, 0, At, B0); PG8_MMA(0, 1, At, B1); PG8_BAR; PG8_SCHED;
            PG8_LDA(At, 1, 1); PG8_STAGE(PG8_SB(1, 0), b3, voffB); PG8_STAGE(PG8_SB(1, 1), b3 + hstepB, voffB); PG8_STAGE_A(PG8_SA(1, 0), a3, 0, last);
            PG8_WAIT_V(8); PG8_WAIT_L(0); PG8_BAR; PG8_MMA(1, 0, At, B0); PG8_MMA(1, 1, At, B1); PG8_BAR; PG8_SCHED;
            } else {
            PG8_LDB(B0, 0, 0); PG8_SCHED; PG8_LDA(At, 0, 0); PG8_STAGE_A(PG8_SA(1, 1), a1, 1, false);
            PG8_WAIT_L(8); PG8_BAR; PG8_WAIT_L(0); PG8_MMA(0, 0, At, B0); PG8_BAR; PG8_SCHED;
            PG8_LDB(B1, 0, 1); PG8_STAGE(PG8_SB(0, 0), b2, voffB);
            PG8_BAR; PG8_WAIT_L(0); PG8_MMA(0, 1, At, B1); PG8_BAR;
            PG8_LDA(At, 0, 1); PG8_STAGE_A(PG8_SA(0, 0), a2, 0, last);
            PG8_BAR; PG8_WAIT_L(0); PG8_MMA(1, 0, At, B0); PG8_BAR; PG8_SCHED;
            PG8_STAGE(PG8_SB(0, 1), b2 + hstepB, voffB);
            PG8_WAIT_V(6); PG8_BAR; PG8_MMA(1, 1, At, B1); PG8_BAR;
            PG8_LDB(B0, 1, 0); PG8_SCHED; PG8_LDA(At, 1, 0); PG8_STAGE_A(PG8_SA(0, 1), a2, 1, last);
            PG8_WAIT_L(8); PG8_BAR; PG8_WAIT_L(0); PG8_MMA(0, 0, At, B0); PG8_BAR; PG8_SCHED;
            PG8_LDB(B1, 1, 1); PG8_STAGE(PG8_SB(1, 0), b3, voffB);
            PG8_BAR; PG8_WAIT_L(0); PG8_MMA(0, 1, At, B1); PG8_BAR;
            PG8_LDA(At, 1, 1); PG8_STAGE_A(PG8_SA(1, 0), a3, 0, last);
            PG8_BAR; PG8_WAIT_L(0); PG8_MMA(1, 0, At, B0); PG8_BAR; PG8_SCHED;
            PG8_STAGE(PG8_SB(1, 1), b3 + hstepB, voffB);
            PG8_WAIT_V(6); PG8_BAR; PG8_MMA(1, 1, At, B1); PG8_BAR;
            }
        }
        if constexpr (ALIGN_EPI) { if (wr == 0) PG8_BAR; }
        { const int lane2 = my_lane();
          E(acc, cur, wid >> 2, wid & 3, lane2 & 15, lane2 >> 4); }
        if (!has_next) break;
        if (!Epi::keep_acc(cur)) {
#pragma unroll
        for (int a = 0; a < 2; ++a)
#pragma unroll
            for (int b = 0; b < 2; ++b)
#pragma unroll
                for (int m = 0; m < 4; ++m)
#pragma unroll
                    for (int n = 0; n < 2; ++n) acc[a][b][m][n] = (f32x4){0.f, 0.f, 0.f, 0.f};
        }
        cur = nxt; cA = nA; cB = nB; ++ui; tkc[0] = tkn[0]; tkc[1] = tkn[1];
        if constexpr (ALIGN_EPI) { if (wr == 1) PG8_BAR; }
    }
    PG8_WAIT_V(0);
    if constexpr (!ALIGN_EPI) { if (wr == 0) PG8_BAR; }
    PG8_BAR;
#undef PG8_SA
#undef PG8_SB
#undef PG8_STAGE
#undef PG8_STAGE_A
#undef PG8_LDA
#undef PG8_LDB
#undef PG8_MMA
#undef PG8_WAIT_V
#undef PG8_WAIT_L
#undef PG8_BAR
#undef PG8_SCHED
}
}
using pg8::Unit;

struct Args { const float* in[50]; float* out; unsigned char* ws; int ph_lo, ph_hi; };
typedef const __attribute__((address_space(4))) Args KArgs;
__device__ __forceinline__ KArgs* kargs() { KArgs* p = (KArgs*)__builtin_amdgcn_kernarg_segment_ptr(); asm volatile("" : "+s"(p)); return p; }
__device__ __forceinline__ unsigned char* launder_p(unsigned char* p) { asm volatile("" : "+s"(p)); return (unsigned char*)(GAS unsigned char*)p; }
__device__ __forceinline__ const float* kin(KArgs& A, int i) { return (const float*)(const GAS float*)A.in[i]; }
__device__ __forceinline__ float* kout(KArgs& A) { return (float*)(GAS float*)A.out; }
__device__ __forceinline__ unsigned char* kws(KArgs& A) { return (unsigned char*)(GAS unsigned char*)A.ws; }
__device__ __forceinline__ int launder_i(int v) { asm volatile("" : "+s"(v)); return v; }
__device__ __forceinline__ int launder_v(int v) { asm volatile("" : "+v"(v)); return v; }
enum { I_X = 0, I_MEM, I_LN_IN_G, I_LN_IN_B, I_W_IN, I_CONV_W, I_SG_NG, I_SG_NB, I_SG_W, I_SG_B, I_RW_MU, I_RW_W0, I_RW_WUP, I_RW_A0, I_RW_AUP, I_RW_GUP,
       I_RW_KK, I_RW_KA, I_RW_RK, I_RW_LNG, I_RW_LNB, I_S5_ARE, I_S5_AIM, I_S5_BRE, I_S5_BIM, I_S5_CRE, I_S5_CIM, I_S5_D, I_S5_LOGDT, I_S5_GLUW, I_S5_GLUB,
       I_BR_PROJ, I_GATE_B, I_W_OUT, I_LN1_G, I_LN1_B, I_XA_WQ, I_XA_WK, I_XA_WV, I_XA_WO, I_LN2_G, I_LN2_B, I_ROUTER_W, I_ROUTER_B, I_EX_W1, I_EX_B1, I_EX_W2, I_EX_B2,
       I_LN3_G, I_LN3_B };
struct Frame { LAS unsigned char* lds; volatile LAS unsigned* MISC; unsigned* ctl; unsigned char* ws; int tid, lane, wave, G, bid; };
constexpr int MI_TOFF = 16, MI_HIST = 64, MI_LBASE = 96, MI_LCUR = 128;

__device__ __forceinline__ void ln_stats(const f32x4 (&v)[4], float& mean, float& rstd) {
    float s = 0.f;
#pragma unroll
    for (int j = 0; j < 4; ++j) s += (v[j].x + v[j].y) + (v[j].z + v[j].w);
    mean = wave_sum(s) * (1.f / D); float s2 = 0.f;
#pragma unroll
    for (int j = 0; j < 4; ++j) { const f32x4 d = v[j] - mean; s2 += (d.x * d.x + d.y * d.y) + (d.z * d.z + d.w * d.w); }
    rstd = 1.0f / sqrtf(wave_sum(s2) * (1.f / D) + LN_EPS);
}
__device__ __forceinline__ void ln_apply_store(const f32x4 (&v)[4], float mean, float rstd, const float* g, const float* b, float* o32, bf16* o16, int lane) {
#pragma unroll
    for (int j = 0; j < 4; ++j) {
        const f32x4 gg = *(const f32x4*)(g + 256 * j + 4 * lane), bb = *(const f32x4*)(b + 256 * j + 4 * lane);
        const f32x4 y = (v[j] - mean) * rstd * gg + bb;
        if (o32) *(f32x4*)(o32 + 256 * j + 4 * lane) = y;
        if (o16) { v2u w; w.x = pk2(y.x, y.y); w.y = pk2(y.z, y.w); *(v2u*)(o16 + 256 * j + 4 * lane) = w; }
    }
}

__device__ __forceinline__ void transpose_item(const float* W, int K, int N, bf16* WT, int mode, LAS float* scr, int item, int lane) {
    const int nblk = N / 32, kb = item / nblk, nb = item % nblk, k0 = 64 * kb, n0 = 32 * nb;
    { float tv[32]; const float* wp = W + (size_t)(k0 + (lane >> 5)) * N + n0 + (lane & 31);
#pragma unroll
      for (int i = 0; i < 32; ++i) tv[i] = wp[(size_t)(2 * i) * N];
#pragma unroll
      for (int i = 0; i < 32; ++i) scr[(2 * i + (lane >> 5)) * 33 + (lane & 31)] = tv[i]; }
    LDS_WAIT();
    const int c = lane & 7;
#pragma unroll
    for (int j = 0; j < 4; ++j) { const int n = (lane >> 3) + 8 * j; const LAS float* s = scr + (8 * c) * 33 + n;
        v4u o; o.x = pk2(s[0 * 33], s[1 * 33]); o.y = pk2(s[2 * 33], s[3 * 33]); o.z = pk2(s[4 * 33], s[5 * 33]); o.w = pk2(s[6 * 33], s[7 * 33]);
        const int nn = n0 + n; const int jj = nn >> 1;
        const int row = mode ? ((jj >> 7) * 256 + (nn & 1) * 128 + (jj & 127)) : nn;
        *(v4u*)(WT + (size_t)row * K + k0 + 8 * c) = o; }
    LDS_WAIT();
}
__device__ __forceinline__ void s5_setup_item(KArgs& A, const Frame& F, int item) {
    const int l = item >> 4, g = item & 15, tid = F.tid;
    LAS float* Kt = (LAS float*)F.lds;
    LAS float* Pw = (LAS float*)(F.lds + 65536);
    LAS float* Bb = (LAS float*)(F.lds + 65536 + 33280);
    LAS float* Cc = Bb + 2048;
    const float* a_re = kin(A, I_S5_ARE) + (l * 16 + g) * 64; const float* a_im = kin(A, I_S5_AIM) + (l * 16 + g) * 64;
    const float* b_re = kin(A, I_S5_BRE) + (size_t)(l * 16 + g) * 1024; const float* b_im = kin(A, I_S5_BIM) + (size_t)(l * 16 + g) * 1024;
    const float* c_re = kin(A, I_S5_CRE) + (size_t)(l * 16 + g) * 1024; const float* c_im = kin(A, I_S5_CIM) + (size_t)(l * 16 + g) * 1024;
    const float dt = expf(kin(A, I_S5_LOGDT)[l * 16 + g]);
    for (int o = tid; o < 65 * 64; o += NTHREADS) { const int n = o >> 6, p = o & 63; const float mag = expf(a_re[p] * dt * (float)n); float sn, cs; sincosf(a_im[p] * dt * (float)n, &sn, &cs);
        Pw[o * 2] = mag * cs; Pw[o * 2 + 1] = mag * sn; }
    for (int o = tid; o < 1024; o += NTHREADS) { const int p = o >> 4;
        const float are = a_re[p], aim = a_im[p], mag = expf(are * dt); float sn, cs; sincosf(aim * dt, &sn, &cs); const float abr = mag * cs, abi = mag * sn;
        const float den = are * are + aim * aim, nr = abr - 1.0f, cr = (nr * are + abi * aim) / den, ci = (abi * are - nr * aim) / den;
        const float br = b_re[o], bi = b_im[o]; Bb[o * 2] = cr * br - ci * bi; Bb[o * 2 + 1] = cr * bi + ci * br; }
    for (int o = tid; o < 1024; o += NTHREADS) { Cc[o * 2] = c_re[o]; Cc[o * 2 + 1] = c_im[o]; }
    __syncthreads();
    for (int o = tid; o < 16384; o += NTHREADS) { const int tau = o >> 8, c = (o >> 4) & 15, cp = o & 15; float acc = 0.f;
        for (int p = 0; p < 64; ++p) { const float cr = Cc[(c * 64 + p) * 2], ci = Cc[(c * 64 + p) * 2 + 1], pr = Pw[(tau * 64 + p) * 2], pi = Pw[(tau * 64 + p) * 2 + 1];
            const float er = cr * pr - ci * pi, ei = cr * pi + ci * pr; acc += er * Bb[(p * 16 + cp) * 2] - ei * Bb[(p * 16 + cp) * 2 + 1]; }
        Kt[o] = acc; }
    __syncthreads();
    bf16* Bt = (bf16*)(F.ws + WS_S5BT) + (size_t)(l * 16 + g) * 1024 * S5K;
    for (int o = tid; o < 1024 * 128; o += NTHREADS) { const int rr = o >> 7, q = o & 127, t = rr >> 4, c = rr & 15, s = q >> 1, cp0 = (q & 1) * 8;
        v4u w = {0u, 0u, 0u, 0u};
        if (s <= t) { const LAS float* k = Kt + ((t - s) * 16 + c) * 16 + cp0; w.x = pk2(k[0], k[1]); w.y = pk2(k[2], k[3]); w.z = pk2(k[4], k[5]); w.w = pk2(k[6], k[7]); }
        *(v4u*)(Bt + (size_t)rr * S5K + q * 8) = w; }
    for (int o = tid; o < 1024 * 16; o += NTHREADS) { const int rr = o >> 4, q = o & 15, t = rr >> 4, c = rr & 15; float vals[8];
#pragma unroll
        for (int j = 0; j < 4; ++j) { const int p = 4 * q + j; const float cr = Cc[(c * 64 + p) * 2], ci = Cc[(c * 64 + p) * 2 + 1], pr = Pw[((t + 1) * 64 + p) * 2], pi = Pw[((t + 1) * 64 + p) * 2 + 1];
            vals[2 * j] = cr * pr - ci * pi; vals[2 * j + 1] = -(cr * pi + ci * pr); }
        v4u w; w.x = pk2(vals[0], vals[1]); w.y = pk2(vals[2], vals[3]); w.z = pk2(vals[4], vals[5]); w.w = pk2(vals[6], vals[7]);
        *(v4u*)(Bt + (size_t)rr * S5K + 1024 + q * 8) = w; }
    bf16* Bc = (bf16*)(F.ws + WS_S5BC) + (size_t)(l * 16 + g) * 256 * 1024;
    for (int o = tid; o < 128 * 128; o += NTHREADS) { const int row = o >> 7, q = o & 127, p = row >> 1, im = row & 1, s = q >> 1, cp0 = (q & 1) * 8;
        const float pr = Pw[((63 - s) * 64 + p) * 2], pi = Pw[((63 - s) * 64 + p) * 2 + 1]; float vals[8];
#pragma unroll
        for (int j = 0; j < 8; ++j) { const float br = Bb[(p * 16 + cp0 + j) * 2], bi = Bb[(p * 16 + cp0 + j) * 2 + 1]; vals[j] = im ? (pr * bi + pi * br) : (pr * br - pi * bi); }
        v4u w; w.x = pk2(vals[0], vals[1]); w.y = pk2(vals[2], vals[3]); w.z = pk2(vals[4], vals[5]); w.w = pk2(vals[6], vals[7]);
        *(v4u*)(Bc + (size_t)row * 1024 + q * 8) = w;
        *(v4u*)(Bc + (size_t)(128 + row) * 1024 + q * 8) = (v4u){0u, 0u, 0u, 0u}; }
    __syncthreads();
}
__device__ __forceinline__ void p_prologue(KArgs& A, const Frame& F) {
    const int gw = F.bid * NWAVES + F.wave, NGW = F.G * NWAVES, lane = F.lane;
    for (int item = F.bid; item < NL * 16; item += F.G) s5_setup_item(A, F, item);
    LAS float* scr = (LAS float*)(F.lds + F.wave * 16384);
#pragma unroll 1
    for (int d = 0; d < 10; ++d) {
        const float* src; bf16* dst; int K, N, batch, mode = 0;
        switch (d) {
            case 0: src = kin(A, I_EX_W1); dst = (bf16*)(F.ws + WS_W1T); K = 1024; N = 2048; batch = NL * NE; mode = 1; break;
            case 1: src = kin(A, I_EX_W2); dst = (bf16*)(F.ws + WS_W2T); K = 1024; N = 1024; batch = NL * NE; break;
            case 2: src = kin(A, I_W_IN); dst = (bf16*)(F.ws + WS_WINT); K = 1024; N = N_IN; batch = NL; break;
            case 3: src = kin(A, I_BR_PROJ); dst = (bf16*)(F.ws + WS_BRT); K = 256; N = 1024; batch = NL * 4; break;
            case 4: src = kin(A, I_W_OUT); dst = (bf16*)(F.ws + WS_WOUTT); K = 1024; N = 1024; batch = NL; break;
            case 5: src = kin(A, I_XA_WQ); dst = (bf16*)(F.ws + WS_WQT); K = 1024; N = 1024; batch = NL; break;
            case 6: src = kin(A, I_XA_WK); dst = (bf16*)(F.ws + WS_WKT); K = 1024; N = 1024; batch = NL; break;
            case 7: src = kin(A, I_XA_WV); dst = (bf16*)(F.ws + WS_WVT); K = 1024; N = 1024; batch = NL; break;
            case 8: src = kin(A, I_XA_WO); dst = (bf16*)(F.ws + WS_WOT); K = 1024; N = 1024; batch = NL; break;
            default: src = kin(A, I_S5_GLUW); dst = (bf16*)(F.ws + WS_GLUT); K = 256; N = 256; batch = NL; break;
        }
        const int per = (K / 64) * (N / 32), nitems = per * batch;
        for (int it = gw; it < nitems; it += NGW) { const int b = it / per, r = it - b * per;
            transpose_item(src + (size_t)b * K * N, K, N, dst + (size_t)b * K * N, mode, scr, r, lane); }
    }
    { bf16* lwt = (bf16*)(F.ws + WS_LWT);
      for (int it = gw * 64 + lane; it < NL * 768 * 32; it += NGW * 64) { const int kc = it & 31, row = (it >> 5) % 768, ll = it / (768 * 32), blk = row >> 8, c = row & 255, k0 = kc * 8; float v[8];
#pragma unroll
          for (int j = 0; j < 8; ++j) { const int k = k0 + j; float x = 0.f;
              if (blk == 0 && k < 64) x = kin(A, I_RW_WUP)[((size_t)ll * 64 + k) * 256 + c];
              else if (blk == 1 && k >= 64 && k < 128) x = kin(A, I_RW_AUP)[((size_t)ll * 64 + (k - 64)) * 256 + c];
              else if (blk == 2 && k >= 128) x = kin(A, I_RW_GUP)[((size_t)ll * 128 + (k - 128)) * 256 + c];
              v[j] = x; }
          v4u w; w.x = pk2(v[0], v[1]); w.y = pk2(v[2], v[3]); w.z = pk2(v[4], v[5]); w.w = pk2(v[6], v[7]);
          *(v4u*)(lwt + ((size_t)ll * 768 + row) * 256 + k0) = w; } }
    { bf16* sgw = (bf16*)(F.ws + WS_SGW); const float* src = kin(A, I_SG_W);
      for (int it = gw * 64 + lane; it < NL * 4 * 128 * 16; it += NGW * 64) { const int j0 = (it & 15) * 8, i = (it >> 4) & 127; const float* sp = src + (size_t)(it >> 4) * 128 + j0; float v[8];
#pragma unroll
          for (int e = 0; e < 8; ++e) v[e] = ((j0 + e) >> 6) <= (i >> 6) ? sp[e] : 0.f;
          v4u w; w.x = pk2(v[0], v[1]); w.y = pk2(v[2], v[3]); w.z = pk2(v[4], v[5]); w.w = pk2(v[6], v[7]); *(v4u*)(sgw + (size_t)(it >> 4) * 128 + j0) = w; } }
    { const float* mem = kin(A, I_MEM); bf16* m16 = (bf16*)(F.ws + WS_MEM16);
      for (int r = gw; r < NB * NMEM; r += NGW) {
#pragma unroll
          for (int j = 0; j < 4; ++j) { const f32x4 v = *(const f32x4*)(mem + (size_t)r * D + 256 * j + 4 * lane); v2u w; w.x = pk2(v.x, v.y); w.y = pk2(v.z, v.w); *(v2u*)(m16 + (size_t)r * D + 256 * j + 4 * lane) = w; } } }
    { const float* x = kin(A, I_X); float* h32 = nullptr; bf16* h16 = (bf16*)(F.ws + WS_H16);
      for (int r0 = gw * 2; r0 < T; r0 += NGW * 2) { f32x4 v[2][4];
#pragma unroll
          for (int i = 0; i < 2; ++i)
#pragma unroll
              for (int j = 0; j < 4; ++j) v[i][j] = *(const f32x4*)(x + (size_t)(r0 + i) * D + 256 * j + 4 * lane);
#pragma unroll
          for (int i = 0; i < 2; ++i) { float mean, rstd; ln_stats(v[i], mean, rstd);
              ln_apply_store(v[i], mean, rstd, kin(A, I_LN_IN_G), kin(A, I_LN_IN_B), h32, h16 + (size_t)(r0 + i) * D, lane); } } }
}

typedef f32x4 AccT[2][2][4][2];
#define EPI_BASES KArgs& KA = *kargs(); unsigned char* ws = kws(KA); (void)ws;
__device__ __forceinline__ v4u pk8(const f32x4 a, const f32x4 b) { v4u w; w.x = pk2(a.x, a.y); w.y = pk2(a.z, a.w); w.z = pk2(b.x, b.y); w.w = pk2(b.z, b.w); return w; }
__device__ __forceinline__ void unpk8(const v4u w, f32x4& a, f32x4& b) { a.x = bf2f(w.x & 0xffffu); a.y = bf2f(w.x >> 16); a.z = bf2f(w.y & 0xffffu); a.w = bf2f(w.y >> 16); b.x = bf2f(w.z & 0xffffu); b.y = bf2f(w.z >> 16); b.z = bf2f(w.w & 0xffffu); b.w = bf2f(w.w >> 16); }
__device__ __forceinline__ f32x4 ld4bf(const bf16* p) { const v2u w = *(const v2u*)p; f32x4 a; a.x = bf2f(w.x & 0xffffu); a.y = bf2f(w.x >> 16); a.z = bf2f(w.y & 0xffffu); a.w = bf2f(w.y >> 16); return a; }
__device__ __forceinline__ f32x4 sig4(const f32x4 v) { return (f32x4){sigmoidf_(v.x), sigmoidf_(v.y), sigmoidf_(v.z), sigmoidf_(v.w)}; }
struct EpiNull { static constexpr bool PERM = false; static __device__ __forceinline__ bool keep_acc(const Unit&) { return false; } int dummy;
    __device__ __forceinline__ void operator()(const AccT& acc, const Unit& u, int wr, int wc, int fr, int fq) const { f32x4 t = {0, 0, 0, 0};
#pragma unroll
        for (int a = 0; a < 2; ++a)
#pragma unroll
            for (int b = 0; b < 2; ++b)
#pragma unroll
                for (int m = 0; m < 4; ++m) { t += acc[a][b][m][0]; t += acc[a][b][m][1]; }
        if (t.x + t.y + t.z + t.w == 1234.5f) { EPI_BASES *(f32x4*)(ws + WS_END) = t; } } };
struct EpiIn { static constexpr bool PERM = true; static __device__ __forceinline__ bool keep_acc(const Unit&) { return false; } int l;
    __device__ __forceinline__ void operator()(const AccT& acc, const Unit& u, int wr, int wc, int fr, int fq) const { EPI_BASES
        bf16* Z = (bf16*)(ws + WS_Z); bf16* SG = (bf16*)(ws + WS_SG); bf16* AOUT = (bf16*)(ws + WS_AOUT); const float* gate_b = kin(KA, I_GATE_B) + (size_t)l * 4096;
        if (u.pn < 10) {
            pg8::epi_foreach8(acc, u, wr, wc, fr, fq, [&](int row, int col, f32x4 v0, f32x4 v1) { const v4u w = pk8(v0, v1);
                *(v4u*)(Z + (size_t)row * ZLD + col) = w;
                if (u.pn == 9) { const int cc = col - OFF_D, g = cc >> 4, c0 = cc & 15, chunk = row >> 6, s = row & 63; *(v4u*)(AOUT + ((size_t)(g * NCHT + chunk)) * S5K + s * 16 + c0) = w; } });
        } else {
            pg8::epi_foreach8(acc, u, wr, wc, fr, fq, [&](int row, int col, f32x4 v0, f32x4 v1) {
                const int gc = col - OFF_G; const f32x4 g0 = *(const f32x4*)(gate_b + gc), g1 = *(const f32x4*)(gate_b + gc + 4);
                *(v4u*)(SG + (size_t)row * 4096 + gc) = pk8(sig4(v0 + g0), sig4(v1 + g1)); });
        }
    } };
struct EpiBranch { static constexpr bool PERM = true; int dummy;
    static __device__ __forceinline__ bool keep_acc(const Unit& u) { return u.e < 3; }
    __device__ __forceinline__ void operator()(AccT& acc, const Unit& u, int wr, int wc, int fr, int fq) const { EPI_BASES const int br = u.e;
        bf16* MG = (bf16*)(ws + WS_MG16); const bf16* SG = (const bf16*)(ws + WS_SG);
#pragma unroll
        for (int ai = 0; ai < 2; ++ai)
#pragma unroll
            for (int m = 0; m < 4; ++m) { const int row = u.pm * 256 + ai * 128 + wr * 64 + m * 16 + fr;
#pragma unroll
                for (int bj = 0; bj < 2; ++bj) { const int col = u.pn * 256 + bj * 128 + wc * 32 + 8 * fq; const bf16* sp = SG + (size_t)row * 4096 + br * 1024 + col;
                    f32x4 n0, n1; unpk8(*(const v4u*)sp, n0, n1);
#pragma unroll
                    for (int e = 0; e < 4; ++e) { n0[e] = fmaxf(n0[e], 1e-6f); n1[e] = fmaxf(n1[e], 1e-6f); }
                    if (br < 3) { f32x4 d0, d1; unpk8(*(const v4u*)(sp + 1024), d0, d1);
#pragma unroll
                        for (int e = 0; e < 4; ++e) { acc[ai][bj][m][0][e] *= n0[e] * __builtin_amdgcn_rcpf(fmaxf(d0[e], 1e-6f)); acc[ai][bj][m][1][e] *= n1[e] * __builtin_amdgcn_rcpf(fmaxf(d1[e], 1e-6f)); }
                    } else *(v4u*)(MG + (size_t)row * D + col) = pk8(acc[ai][bj][m][0] * n0, acc[ai][bj][m][1] * n1); }
                if (m == 3) __builtin_amdgcn_sched_barrier(0); }
    } };
struct EpiResid { static constexpr bool PERM = true; static __device__ __forceinline__ bool keep_acc(const Unit&) { return false; } int dummy;
    __device__ __forceinline__ void operator()(const AccT& acc, const Unit& u, int wr, int wc, int fr, int fq) const { EPI_BASES
        const bf16* H = (const bf16*)(ws + WS_H16); bf16* P = (bf16*)(ws + WS_PRE16);
        pg8::epi_foreach8(acc, u, wr, wc, fr, fq, [&](int row, int col, f32x4 v0, f32x4 v1) { f32x4 h0, h1; unpk8(*(const v4u*)(H + (size_t)row * D + col), h0, h1);
            *(v4u*)(P + (size_t)row * D + col) = pk8(h0 * DN_ALPHA + v0, h1 * DN_ALPHA + v1); });
    } };
struct EpiBf16 { static constexpr bool PERM = true; static __device__ __forceinline__ bool keep_acc(const Unit&) { return false; } unsigned off_mib; float scale;
    __device__ __forceinline__ void operator()(const AccT& acc, const Unit& u, int wr, int wc, int fr, int fq) const { EPI_BASES
        bf16* O = (bf16*)(ws + (size_t)off_mib * MiB);
        pg8::epi_foreach8(acc, u, wr, wc, fr, fq, [&](int row, int col, f32x4 v0, f32x4 v1) { *(v4u*)(O + (size_t)row * D + col) = pk8(v0 * scale, v1 * scale); });
    } };
struct EpiVT { static constexpr bool PERM = false; static __device__ __forceinline__ bool keep_acc(const Unit&) { return false; } int dummy;
    __device__ __forceinline__ void operator()(const AccT& acc, const Unit& u, int wr, int wc, int fr, int fq) const { EPI_BASES
        bf16* VT = (bf16*)(ws + WS_VMT16);
        pg8::epi_foreach(acc, u, wr, wc, fr, fq, [&](int row, int col, f32x4 v) { const int b = row >> 8, m = row & 255; bf16* p = VT + ((size_t)(b * D + col)) * NMEM + m;
            p[0] = (bf16)f2bf(v.x); p[NMEM] = (bf16)f2bf(v.y); p[2 * NMEM] = (bf16)f2bf(v.z); p[3 * NMEM] = (bf16)f2bf(v.w); });
    } };
struct EpiXloc { static constexpr bool PERM = false; static __device__ __forceinline__ bool keep_acc(const Unit&) { return false; } int dummy;
    __device__ __forceinline__ void operator()(const AccT& acc, const Unit& u, int wr, int wc, int fr, int fq) const { EPI_BASES
        float* X = (float*)(ws + WS_XLOC);
        pg8::epi_foreach(acc, u, wr, wc, fr, fq, [&](int row, int col, f32x4 v) { if (col < 128) *(f32x4*)(X + ((size_t)(u.e * NCHT + row)) * 128 + col) = v; });
    } };
struct EpiLora { static constexpr bool PERM = false; static __device__ __forceinline__ bool keep_acc(const Unit&) { return false; } int l;
    __device__ __forceinline__ void operator()(const AccT& acc, const Unit& u, int wr, int wc, int fr, int fq) const { EPI_BASES
        if (u.pn == 0) { float* DEC = (float*)(ws + WS_DEC); const float* w0 = kin(KA, I_RW_W0) + l * 256;
            pg8::epi_foreach(acc, u, wr, wc, fr, fq, [&](int row, int col, f32x4 v) { const f32x4 wp = v + *(const f32x4*)(w0 + col); f32x4 o;
#pragma unroll
                for (int e = 0; e < 4; ++e) { const float sp = log1pf(__expf(-wp[e])); o[e] = __expf(-__expf(-sp - 0.5f)); }
                *(f32x4*)(DEC + (size_t)row * 256 + col) = o; });
        } else if (u.pn == 1) { float* AV = (float*)(ws + WS_AV); const float* a0 = kin(KA, I_RW_A0) + l * 256;
            pg8::epi_foreach(acc, u, wr, wc, fr, fq, [&](int row, int col, f32x4 v) { const int c = col - 256; *(f32x4*)(AV + (size_t)row * 256 + c) = sig4(v + *(const f32x4*)(a0 + c)); });
        } else { float* G = (float*)(ws + WS_RWG);
            pg8::epi_foreach(acc, u, wr, wc, fr, fq, [&](int row, int col, f32x4 v) { *(f32x4*)(G + (size_t)row * 256 + col - 512) = v; });
        }
    } };
__device__ __forceinline__ float gelu_tanh(float x) { const float u = 0.7978845608028654f * (x + 0.044715f * x * x * x); const float e = __expf(2.0f * u); const float th = 1.0f - 2.0f * __builtin_amdgcn_rcpf(e + 1.0f); return 0.5f * x * (1.0f + th); }
__device__ __forceinline__ f32x4 gelu4(const f32x4 v) { return (f32x4){gelu_tanh(v.x), gelu_tanh(v.y), gelu_tanh(v.z), gelu_tanh(v.w)}; }
struct EpiS5Y { static constexpr bool PERM = true; static __device__ __forceinline__ bool keep_acc(const Unit&) { return false; } int l;
    __device__ __forceinline__ void operator()(const AccT& acc, const Unit& u, int wr, int wc, int fr, int fq) const { EPI_BASES
        bf16* YD = (bf16*)(ws + WS_YD16); const bf16* AOUT = (const bf16*)(ws + WS_AOUT); const float* dvec = kin(KA, I_S5_D) + l * 256;
        pg8::epi_foreach8(acc, u, wr, wc, fr, fq, [&](int row, int col, f32x4 v0, f32x4 v1) { const int t = col >> 4, c0 = col & 15, tok = row * CH + t, ch = u.e * 16 + c0;
            f32x4 u0, u1; unpk8(*(const v4u*)(AOUT + ((size_t)(u.e * NCHT + row)) * S5K + t * 16 + c0), u0, u1);
            const f32x4 d0 = *(const f32x4*)(dvec + ch), d1 = *(const f32x4*)(dvec + ch + 4);
            *(v4u*)(YD + (size_t)tok * 256 + ch) = pk8(gelu4(v0 + d0 * u0), gelu4(v1 + d1 * u1)); });
    } };
struct EpiGlu { static constexpr bool PERM = true; static __device__ __forceinline__ bool keep_acc(const Unit&) { return false; } int l;
    __device__ __forceinline__ void operator()(const AccT& acc, const Unit& u, int wr, int wc, int fr, int fq) const { EPI_BASES
        bf16* O = (bf16*)(ws + WS_O16); const bf16* YD = (const bf16*)(ws + WS_YD16); const float* gb = kin(KA, I_S5_GLUB) + l * 256;
        pg8::epi_foreach8(acc, u, wr, wc, fr, fq, [&](int row, int col, f32x4 v0, f32x4 v1) { f32x4 y0, y1; unpk8(*(const v4u*)(YD + (size_t)row * 256 + col), y0, y1);
            const f32x4 b0 = *(const f32x4*)(gb + col), b1 = *(const f32x4*)(gb + col + 4);
            *(v4u*)(O + (size_t)row * D + 768 + col) = pk8(y0 * sig4(v0 + b0), y1 * sig4(v1 + b1)); });
    } };
__device__ __forceinline__ float swiglu(float g, float u) { g = fminf(g, 7.0f); u = fminf(fmaxf(u, -7.0f), 7.0f); return (u + 1.0f) * g * sigmoidf_(1.702f * g); }
struct EpiSwiglu { static constexpr bool PERM = true; static __device__ __forceinline__ bool keep_acc(const Unit&) { return false; } int l;
    __device__ __forceinline__ void operator()(const AccT& acc, const Unit& u, int wr, int wc, int fr, int fq) const { EPI_BASES
        bf16* ACT = (bf16*)(ws + WS_ACT); const float* bb = kin(KA, I_EX_B1) + (size_t)(l * NE + u.e) * 2048;
#pragma unroll
        for (int ai = 0; ai < 2; ++ai)
#pragma unroll
            for (int m = 0; m < 4; ++m) { const int row = u.pm * 256 + ai * 128 + wr * 64 + m * 16 + fr; const int j = u.pn * 128 + wc * 32 + 8 * fq;
                f32x4 o[2];
#pragma unroll
                for (int n = 0; n < 2; ++n) { const f32x4 b0 = *(const f32x4*)(bb + 2 * (j + 4 * n)), b1v = *(const f32x4*)(bb + 2 * (j + 4 * n) + 4);
                    const f32x4 g = acc[ai][0][m][n], uu = acc[ai][1][m][n];
                    o[n] = (f32x4){swiglu(g.x + b0.x, uu.x + b0.y), swiglu(g.y + b0.z, uu.y + b0.w), swiglu(g.z + b1v.x, uu.z + b1v.y), swiglu(g.w + b1v.z, uu.w + b1v.w)}; }
                *(v4u*)(ACT + (size_t)row * DFF + j) = pk8(o[0], o[1]);
                if (m == 3) __builtin_amdgcn_sched_barrier(0); }
    } };
struct EpiMoeOut { static constexpr bool PERM = true; static __device__ __forceinline__ bool keep_acc(const Unit&) { return false; } int l;
    __device__ __forceinline__ void operator()(const AccT& acc, const Unit& u, int wr, int wc, int fr, int fq) const { EPI_BASES
        bf16* YS = (bf16*)(ws + WS_YS); const float* SLOTW = (const float*)(ws + WS_SLOTW); const float* bb = kin(KA, I_EX_B2) + (size_t)(l * NE + u.e) * D;
        pg8::epi_foreach8(acc, u, wr, wc, fr, fq, [&](int row, int col, f32x4 v0, f32x4 v1) { const float sw = SLOTW[row]; const f32x4 b0 = *(const f32x4*)(bb + col), b1 = *(const f32x4*)(bb + col + 4);
            *(v4u*)(YS + (size_t)row * D + col) = pk8((v0 + b0) * sw, (v1 + b1) * sw); });
    } };

__device__ __forceinline__ void p_mix1(KArgs& A, const Frame& F, int l) {
    const int gw = F.bid * NWAVES + F.wave, NGW = F.G * NWAVES, lane = F.lane, tid = F.tid;
    const bf16* Z = (const bf16*)(F.ws + WS_Z); bf16* O16 = (bf16*)(F.ws + WS_O16);
    for (int rp_ = 0; rp_ < ((PROBE_PHASE == 101) ? PROBE_REPS : 1); ++rp_) { const float* cw = kin(A, I_CONV_W) + l * 3 * 256; const f32x4 w0 = *(const f32x4*)(cw + 4 * lane), w1 = *(const f32x4*)(cw + 256 + 4 * lane), w2 = *(const f32x4*)(cw + 512 + 4 * lane);
      for (int t0 = gw * 4; t0 < T; t0 += NGW * 4) {
          f32x4 bg[4], ch[6];
#pragma unroll
          for (int i = 0; i < 6; ++i) { const int t = t0 - 2 + i; const bool ok = (t >= 0) && ((t & ~(SEQ - 1)) == (t0 & ~(SEQ - 1)));
              ch[i] = (f32x4){0, 0, 0, 0}; if (ok) { const bf16* zr = Z + (size_t)t * ZLD + 4 * lane; ch[i] = ld4bf(zr + 256) * ld4bf(zr + 512); } }
#pragma unroll
          for (int i = 0; i < 4; ++i) bg[i] = ld4bf(Z + (size_t)(t0 + i) * ZLD + 4 * lane);
#pragma unroll
          for (int i = 0; i < 4; ++i) { const f32x4 y = (w2 * ch[i + 2] + w1 * ch[i + 1] + w0 * ch[i]) * bg[i];
              v2u w; w.x = pk2(y.x, y.y); w.y = pk2(y.z, y.w); *(v2u*)(O16 + (size_t)(t0 + i) * D + 4 * lane) = w; } } }
    for (int rp_ = 0; rp_ < ((PROBE_PHASE == 102) ? PROBE_REPS : 1); ++rp_) { LAS unsigned char* VT = F.lds;
      const float* ng = kin(A, I_SG_NG) + l * 256; const float* nb = kin(A, I_SG_NB) + l * 256; const bf16* sgw = (const bf16*)(F.ws + WS_SGW) + (size_t)l * 4 * 128 * 128;
      for (int blk = F.bid; blk < T / 128; blk += F.G) {
          const f32x4 gg = *(const f32x4*)(ng + 4 * lane), bb = *(const f32x4*)(nb + 4 * lane);
          for (int rb = 0; rb < 128 / NWAVES; rb += 4) { f32x4 vv[4];
#pragma unroll
              for (int i = 0; i < 4; ++i) vv[i] = ld4bf(Z + (size_t)(blk * 128 + F.wave + (rb + i) * NWAVES) * ZLD + OFF_B + 256 + 4 * lane);
              float s1[4], s2[4];
#pragma unroll
              for (int i = 0; i < 4; ++i) { s1[i] = (vv[i].x + vv[i].y) + (vv[i].z + vv[i].w); s2[i] = (vv[i].x * vv[i].x + vv[i].y * vv[i].y) + (vv[i].z * vv[i].z + vv[i].w * vv[i].w); }
#pragma unroll
              for (int o = 1; o < 64; o <<= 1) {
#pragma unroll
                  for (int i = 0; i < 4; ++i) { s1[i] += shfl_xor_l(s1[i], o, lane); s2[i] += shfl_xor_l(s2[i], o, lane); } }
#pragma unroll
              for (int i = 0; i < 4; ++i) { const float mean = s1[i] * (1.f / 256), var = fmaxf(s2[i] * (1.f / 256) - mean * mean, 0.f), rstd = __builtin_amdgcn_rsqf(var + LN_EPS);
                  const f32x4 y = (vv[i] - mean) * rstd * gg + bb; const int j = F.wave + (rb + i) * NWAVES;
                  LAS unsigned char* wp = VT + (4 * lane) * 272 + (((j >> 3) ^ (lane & 15)) << 4) + (j & 7) * 2;
                  *(LAS bf16*)(wp) = (bf16)f2bf(y.x); *(LAS bf16*)(wp + 272) = (bf16)f2bf(y.y); *(LAS bf16*)(wp + 544) = (bf16)f2bf(y.z); *(LAS bf16*)(wp + 816) = (bf16)f2bf(y.w); } }
          __syncthreads();
          { const int fr = lane & 15, fq = lane >> 4, it = F.wave, i = 16 * it + fr, t = blk * 128 + i, nks = (it < 4) ? 2 : 4;
#pragma unroll 1
            for (int g = 0; g < 4; ++g) { bf16x8 wf[4];
#pragma unroll
                for (int ks = 0; ks < 4; ++ks) wf[ks] = *(const bf16x8*)(sgw + ((size_t)(g * 128 + i)) * 128 + 32 * ks + 8 * fq);
                const float bias = kin(A, I_SG_B)[(l * 4 + g) * 128 + i];
#pragma unroll
                for (int ct = 0; ct < 4; ++ct) { f32x4 acc = {0, 0, 0, 0}; const int c = g * 64 + ct * 16 + fr; const LAS unsigned char* rowp = VT + c * 272; const int sw = (c >> 2) & 15;
#pragma unroll
                    for (int ks = 0; ks < 4; ++ks) if (ks < nks) { const bf16x8 af = *(const LAS bf16x8*)(rowp + (((4 * ks + fq) ^ sw) << 4)); acc = __builtin_amdgcn_mfma_f32_16x16x32_bf16(af, wf[ks], acc, 0, 0, 0); }
                    const int c0 = g * 64 + ct * 16 + 4 * fq;
                    const f32x4 o = ld4bf(Z + (size_t)t * ZLD + OFF_B + c0) * (acc + bias);
                    v2u w; w.x = pk2(o.x, o.y); w.y = pk2(o.z, o.w); *(v2u*)(O16 + (size_t)t * D + 256 + c0) = w; } } }
          __syncthreads();
      } }
    for (int rp_ = 0; rp_ < ((PROBE_PHASE == 103) ? PROBE_REPS : 1); ++rp_) {
      bf16* LA = (bf16*)(F.ws + WS_LA16); const f32x4 mul = *(const f32x4*)(kin(A, I_RW_MU) + l * 1024 + 768 + 4 * lane);
      for (int t0 = gw * 4; t0 < T; t0 += NGW * 4) { f32x4 xr[5];
#pragma unroll
          for (int i = 0; i < 5; ++i) { const int t = t0 - 1 + i; xr[i] = (f32x4){0, 0, 0, 0}; if (i > 0 || (t0 & (SEQ - 1)) > 0) xr[i] = ld4bf(Z + (size_t)t * ZLD + OFF_C + 768 + 4 * lane); }
#pragma unroll
          for (int i = 0; i < 4; ++i) { f32x4 x = xr[i + 1] + (xr[i] - xr[i + 1]) * mul;
              if (lane < 16) x = sig4(x * 2.0f) * 2.0f - 1.0f;
              else if (lane >= 32) x = sig4(x);
              v2u w; w.x = pk2(x.x, x.y); w.y = pk2(x.z, x.w); *(v2u*)(LA + (size_t)(t0 + i) * 256 + 4 * lane) = w; } } }
}

__device__ __forceinline__ void p_rw_chunks(KArgs& A, const Frame& F, int l) {
    const int gw = F.bid * NWAVES + F.wave, NGW = F.G * NWAVES, lane = F.lane;
    const bf16* Z = (const bf16*)(F.ws + WS_Z); const float* DEC = (const float*)(F.ws + WS_DEC); const float* AV = (const float*)(F.ws + WS_AV);
    float* QH = (float*)(F.ws + WS_QH); float* YL = (float*)(F.ws + WS_YL); float* GC = (float*)(F.ws + WS_GC); float* HC = (float*)(F.ws + WS_HC); float* RK = (float*)(F.ws + WS_RK);
    LAS float* wl = (LAS float*)(F.lds + F.wave * 16384);
    for (int task = gw; task < 16 * NCH; task += NGW) { const int bh = task / NCH, ck = task % NCH, b = bh >> 2, head = bh & 3, c = head * 64 + lane;
        const float mu_r = kin(A, I_RW_MU)[l * 1024 + c], mu_k = kin(A, I_RW_MU)[l * 1024 + 256 + c], mu_v = kin(A, I_RW_MU)[l * 1024 + 512 + c];
        const float kkc = kin(A, I_RW_KK)[l * 256 + c], kac = kin(A, I_RW_KA)[l * 256 + c], rkc = kin(A, I_RW_RK)[l * 256 + c];
        float sp[64], sl[64];
        { const int ln = launder_v(lane);
#pragma unroll
          for (int k = 0; k < 64; ++k) { sp[k] = (k == ln) ? 1.0f : 0.0f; sl[k] = 0.0f; } }
        wl[8 * 320 + lane] = 0.f;
        const int tg0 = b * SEQ + ck * CH;
        float pr = 0.f, pk = 0.f, pv = 0.f, gam = 1.0f;
        if (ck > 0) { const bf16* zp = Z + (size_t)(tg0 - 1) * ZLD + OFF_C + c; pr = bf2f(zp[0]); pk = bf2f(zp[256]); pv = bf2f(zp[512]); }
#pragma unroll 1
        for (int sb = 0; sb < CH / 8; ++sb) {
#pragma unroll 1
            for (int hb = 0; hb < 2; ++hb) {
                float kk[4], dc[4], av[4], rs[4], k2[4], vs[4], ss[4], rkp[4];
#pragma unroll
                for (int i = 0; i < 4; ++i) { const int t = tg0 + sb * 8 + hb * 4 + i; const bf16* zr = Z + (size_t)t * ZLD + OFF_C + c;
                    const float r = bf2f(zr[0]), k = bf2f(zr[256]), v = bf2f(zr[512]); dc[i] = DEC[(size_t)t * 256 + c]; av[i] = AV[(size_t)t * 256 + c];
                    rs[i] = r + (pr - r) * mu_r; const float ks = k + (pk - k) * mu_k; vs[i] = v + (pv - v) * mu_v; pr = r; pk = k; pv = v;
                    kk[i] = ks * kkc; k2[i] = ks * (1.0f + (av[i] - 1.0f) * kac); ss[i] = kk[i] * kk[i]; rkp[i] = rs[i] * k2[i] * rkc; }
#pragma unroll
                for (int o = 1; o < 64; o <<= 1) {
#pragma unroll
                    for (int i = 0; i < 4; ++i) { ss[i] += shfl_xor_l(ss[i], o, lane); rkp[i] += shfl_xor_l(rkp[i], o, lane); } }
#pragma unroll
                for (int i = 0; i < 4; ++i) { const float kn = kk[i] * __builtin_amdgcn_rcpf(fmaxf(sqrtf(ss[i]), 1e-12f)); LAS float* w = wl + (hb * 4 + i) * 320 + lane;
                    const float g1 = gam * dc[i], ig = __builtin_amdgcn_rcpf(g1);
                    w[0] = -kn * gam; w[64] = kn * av[i] * ig; w[128] = rs[i] * g1; w[192] = k2[i] * ig; w[256] = vs[i]; gam = g1;
                    if (lane == 0) RK[(size_t)(tg0 + sb * 8 + hb * 4 + i) * 4 + head] = rkp[i]; }
            }
            LDS_WAIT();
            const LAS float* wr16 = wl + (lane & 15);
            float saP = 0.f, saL = 0.f;
            { float A0[4];
#pragma unroll
              for (int J = 0; J < 4; ++J) A0[J] = wr16[16 * J];
#define RW_SA(k) { fmac_bc<(k) & 15>(saP, A0[(k) >> 4], sp[k]); fmac_bc<(k) & 15>(saL, A0[(k) >> 4], sl[k]); }
#define RW_REP16(M, o) M(o + 0) M(o + 1) M(o + 2) M(o + 3) M(o + 4) M(o + 5) M(o + 6) M(o + 7) M(o + 8) M(o + 9) M(o + 10) M(o + 11) M(o + 12) M(o + 13) M(o + 14) M(o + 15)
              RW_REP16(RW_SA, 0) RW_REP16(RW_SA, 16) RW_REP16(RW_SA, 32) RW_REP16(RW_SA, 48) }
            float Bv[4], Rv[4], Kv[4], Av[4], vj;
#pragma unroll
            for (int J = 0; J < 4; ++J) { Bv[J] = wr16[64 + 16 * J]; Rv[J] = wr16[128 + 16 * J]; Kv[J] = wr16[192 + 16 * J]; Av[J] = wr16[320 + 16 * J]; }
            vj = wl[256 + lane];
#pragma unroll 1
            for (int st_ = 0; st_ < 8; ++st_) {
                float Bn[4], Rn[4], Kn[4], An[4], vn;
                { const LAS float* nb = wr16 + (st_ + 1) * 320; const int lim = (st_ < 7) ? 0 : -320;
#pragma unroll
                  for (int J = 0; J < 4; ++J) { Bn[J] = nb[lim + 64 + 16 * J]; Rn[J] = nb[lim + 128 + 16 * J]; Kn[J] = nb[lim + 192 + 16 * J]; An[J] = nb[320 + 16 * J]; }
                  vn = wl[(st_ + 1) * 320 + lim + 256 + lane]; }
                float yP = 0.f, yL = 0.f, nP = 0.f, nL = 0.f;
#define RW_STEP(k) { fmac_bc<(k) & 15>(sp[k], Bv[(k) >> 4], saP); fmac_bc<(k) & 15>(sl[k], Bv[(k) >> 4], saL); fmac_bc<(k) & 15>(sl[k], Kv[(k) >> 4], vj); \
                     fmac_bc<(k) & 15>(yP, Rv[(k) >> 4], sp[k]); fmac_bc<(k) & 15>(yL, Rv[(k) >> 4], sl[k]); fmac_bc<(k) & 15>(nP, Av[(k) >> 4], sp[k]); fmac_bc<(k) & 15>(nL, Av[(k) >> 4], sl[k]); }
                RW_REP16(RW_STEP, 0) RW_REP16(RW_STEP, 16) RW_REP16(RW_STEP, 32) RW_REP16(RW_STEP, 48)
                const size_t oi = ((size_t)(bh * SEQ + ck * CH + sb * 8 + st_)) * 64 + lane;
                QH[oi] = yP; YL[oi] = yL; saP = nP; saL = nL;
#pragma unroll
                for (int J = 0; J < 4; ++J) { Bv[J] = Bn[J]; Rv[J] = Rn[J]; Kv[J] = Kn[J]; Av[J] = An[J]; }
                vj = vn; }
#undef RW_SA
#undef RW_STEP
#undef RW_REP16
        }
        wl[lane] = gam; LDS_WAIT();
        float* hp = HC + ((size_t)(bh * NCH + ck) * 64 + lane) * 64;
#pragma unroll
        for (int q = 0; q < 16; ++q) { const f32x4 gq = *(const LAS f32x4*)(wl + 4 * q);
            sp[4 * q] *= gq.x; sp[4 * q + 1] *= gq.y; sp[4 * q + 2] *= gq.z; sp[4 * q + 3] *= gq.w;
            *(f32x4*)(hp + 4 * q) = (f32x4){sl[4 * q] * gq.x, sl[4 * q + 1] * gq.y, sl[4 * q + 2] * gq.z, sl[4 * q + 3] * gq.w}; }
        { float* gp = GC + (size_t)(bh * NCH + ck) * 4096 + (size_t)(((lane >> 2) & 3) * 16) * 64 + ((lane >> 4) * 4 + (lane & 3)) * 4;
#pragma unroll
          for (int f = 0; f < 16; ++f) *(f32x4*)(gp + f * 64) = (f32x4){sp[f], sp[16 + f], sp[32 + f], sp[48 + f]}; }
        LDS_WAIT();
    }
}
__device__ __forceinline__ void p_s5_chain(KArgs& A, const Frame& F, int l) {
    const int gt = F.bid * NTHREADS + F.tid; if (gt >= NB * 16 * 64) return;
    const int b = gt >> 10, g = (gt >> 6) & 15, p = gt & 63;
    const float dt = expf(kin(A, I_S5_LOGDT)[l * 16 + g]); const float are = kin(A, I_S5_ARE)[(l * 16 + g) * 64 + p], aim = kin(A, I_S5_AIM)[(l * 16 + g) * 64 + p];
    const float mag = expf(are * dt * 64.0f); float sn, cs; sincosf(aim * dt * 64.0f, &sn, &cs); const float ar = mag * cs, ai = mag * sn;
    bf16* AO = (bf16*)(F.ws + WS_AOUT); const float* XL = (const float*)(F.ws + WS_XLOC);
    float xr = 0.f, xi = 0.f;
#pragma unroll 1
    for (int c0 = 0; c0 < NCH; c0 += 16) {
        f32x2 xl[16]; unsigned outw[16];
#pragma unroll
        for (int i = 0; i < 16; ++i) xl[i] = *(const f32x2*)(XL + ((size_t)g * NCHT + b * NCH + c0 + i) * 128 + 2 * p);
#pragma unroll
        for (int i = 0; i < 16; ++i) { outw[i] = pk2(xr, xi); const float nr = ar * xr - ai * xi + xl[i].x, ni = ar * xi + ai * xr + xl[i].y; xr = nr; xi = ni; }
#pragma unroll
        for (int i = 0; i < 16; ++i) *(unsigned*)(AO + ((size_t)g * NCHT + b * NCH + c0 + i) * S5K + 1024 + 2 * p) = outw[i];
    }
}
constexpr int CB = 8, NBLK = NCH / CB;
__device__ __forceinline__ void chain_load_g(const float* G, float (&ga)[64], int fr, int fq) {
    const f32x4* gp = (const f32x4*)(G + (size_t)(16 * fq + fr) * 64);
#pragma unroll
    for (int q = 0; q < 16; ++q) { const f32x4 x = gp[q]; ga[4 * q] = x.x; ga[4 * q + 1] = x.y; ga[4 * q + 2] = x.z; ga[4 * q + 3] = x.w; }
}
__device__ __forceinline__ void chain_store_g(float* G, int rb, const f32x4 (&t)[4], int fr, int fq) {
#pragma unroll
    for (int reg = 0; reg < 4; ++reg) *(f32x4*)(G + (size_t)((fr >> 2) * 16 + 4 * fq + reg) * 64 + (rb * 4 + (fr & 3)) * 4) = (f32x4){t[0][reg], t[1][reg], t[2][reg], t[3][reg]};
}
__device__ __forceinline__ void chain_step(f32x4 (&acc)[4], const float (&ga)[64], const f32x4 (&ci)[4]) {
    f32x4 na[4] = {ci[0], ci[1], ci[2], ci[3]};
#pragma unroll
    for (int jr = 0; jr < 16; ++jr)
#pragma unroll
        for (int mt = 0; mt < 4; ++mt) na[mt] = __builtin_amdgcn_mfma_f32_16x16x4f32(ga[jr * 4 + mt], acc[jr >> 2][jr & 3], na[mt], 0, 0, 0);
#pragma unroll
    for (int mt = 0; mt < 4; ++mt) acc[mt] = na[mt];
}
__device__ __forceinline__ void chain_load_tile(const float* M, int rb, f32x4 (&t)[4], int fr, int fq) {
#pragma unroll
    for (int jt = 0; jt < 4; ++jt) t[jt] = *(const f32x4*)(M + (size_t)(16 * rb + fr) * 64 + 16 * jt + 4 * fq);
}
__device__ __forceinline__ void chain_store_tile(float* M, int rb, const f32x4 (&t)[4], int fr, int fq) {
#pragma unroll
    for (int jt = 0; jt < 4; ++jt) *(f32x4*)(M + (size_t)(16 * rb + fr) * 64 + 16 * jt + 4 * fq) = t[jt];
}
__device__ __forceinline__ void p_chain_compose(const Frame& F) {
    const int nlow = (F.G >= 256) ? 128 : 0; if (F.bid < nlow) return;
    const int gw = (F.bid - nlow) * NWAVES + F.wave, NGW = (F.G - nlow) * NWAVES, ln_ = my_lane(), fr = ln_ & 15, fq = ln_ >> 4;
    const float* GC = (const float*)(F.ws + WS_GC); const float* HC = (const float*)(F.ws + WS_HC); float* GB = (float*)(F.ws + WS_GB); float* HB = (float*)(F.ws + WS_HB);
    for (int task = gw; task < 16 * NBLK * 8; task += NGW) { const int cb = task & 7, bb = task >> 3, rb = cb & 3; const bool isH = cb >= 4;
        const size_t c0 = (size_t)bb * CB;
        f32x4 acc[4];
        if (isH) chain_load_tile(HC + c0 * 4096, rb, acc, fr, fq);
        else {
            const float* gq = GC + c0 * 4096 + (size_t)((fr >> 2) * 16 + 4 * fq) * 64 + (rb * 4 + (fr & 3)) * 4;
#pragma unroll
            for (int reg = 0; reg < 4; ++reg) { const f32x4 x = *(const f32x4*)(gq + reg * 64); acc[0][reg] = x.x; acc[1][reg] = x.y; acc[2][reg] = x.z; acc[3][reg] = x.w; } }
        float ga[64]; chain_load_g(GC + (c0 + 1) * 4096, ga, fr, fq);
        f32x4 ci[4] = {{0, 0, 0, 0}, {0, 0, 0, 0}, {0, 0, 0, 0}, {0, 0, 0, 0}};
        if (isH) chain_load_tile(HC + (c0 + 1) * 4096, rb, ci, fr, fq);
#pragma unroll 1
        for (int i = 1; i < CB; ++i) { const int nx = (i + 1 < CB) ? i + 1 : i;
            f32x4 cn[4] = {{0, 0, 0, 0}, {0, 0, 0, 0}, {0, 0, 0, 0}, {0, 0, 0, 0}};
            if (isH) chain_load_tile(HC + (c0 + nx) * 4096, rb, cn, fr, fq);
            float gn[64]; chain_load_g(GC + (c0 + nx) * 4096, gn, fr, fq);
            chain_step(acc, ga, ci);
#pragma unroll
            for (int k = 0; k < 64; ++k) ga[k] = gn[k];
#pragma unroll
            for (int k = 0; k < 4; ++k) ci[k] = cn[k]; }
        if (isH) chain_store_tile(HB + (size_t)bb * 4096, rb, acc, fr, fq); else chain_store_g(GB + (size_t)bb * 4096, rb, acc, fr, fq);
    }
}
__device__ __forceinline__ void p_chain_blocks(const Frame& F, int gw, int NGW) {
    const int ln_ = my_lane(), fr = ln_ & 15, fq = ln_ >> 4;
    const float* GB = (const float*)(F.ws + WS_GB); const float* HB = (const float*)(F.ws + WS_HB); float* SB = (float*)(F.ws + WS_SB);
    for (int task = gw; task < 16 * 4; task += NGW) { const int vb = task & 3, bh = task >> 2;
        f32x4 acc[4] = {{0, 0, 0, 0}, {0, 0, 0, 0}, {0, 0, 0, 0}, {0, 0, 0, 0}};
        float ga[64]; chain_load_g(GB + (size_t)bh * NBLK * 4096, ga, fr, fq);
        f32x4 ci[4]; chain_load_tile(HB + (size_t)bh * NBLK * 4096, vb, ci, fr, fq);
#pragma unroll 1
        for (int blk = 0; blk < NBLK; ++blk) { const size_t bb = (size_t)bh * NBLK + blk;
            chain_store_tile(SB + bb * 4096, vb, acc, fr, fq);
            if (blk + 1 == NBLK) break;
            f32x4 cn[4]; chain_load_tile(HB + (bb + 1) * 4096, vb, cn, fr, fq);
            float gn[64]; chain_load_g(GB + (bb + 1) * 4096, gn, fr, fq);
            chain_step(acc, ga, ci);
#pragma unroll
            for (int k = 0; k < 64; ++k) ga[k] = gn[k];
#pragma unroll
            for (int k = 0; k < 4; ++k) ci[k] = cn[k]; }
    }
}
__device__ __forceinline__ void chain_inblock(const Frame& F, int bb, int vb) {
    const int ln_ = my_lane(), fr = ln_ & 15, fq = ln_ >> 4;
    const float* GC = (const float*)(F.ws + WS_GC); const float* HC = (const float*)(F.ws + WS_HC); const float* SB = (const float*)(F.ws + WS_SB); float* SC = (float*)(F.ws + WS_SC);
    const size_t c0 = (size_t)bb * CB;
    f32x4 acc[4]; chain_load_tile(SB + (size_t)bb * 4096, vb, acc, fr, fq);
    float ga[64]; chain_load_g(GC + c0 * 4096, ga, fr, fq);
    f32x4 ci[4]; chain_load_tile(HC + c0 * 4096, vb, ci, fr, fq);
#pragma unroll 1
    for (int i = 0; i < CB; ++i) {
        chain_store_tile(SC + (c0 + i) * 4096, vb, acc, fr, fq);
        if (i + 1 == CB) break;
        f32x4 cn[4]; chain_load_tile(HC + (c0 + i + 1) * 4096, vb, cn, fr, fq);
        float gn[64]; chain_load_g(GC + (c0 + i + 1) * 4096, gn, fr, fq);
        chain_step(acc, ga, ci);
#pragma unroll
        for (int k = 0; k < 64; ++k) ga[k] = gn[k];
#pragma unroll
        for (int k = 0; k < 4; ++k) ci[k] = cn[k]; }
}
__device__ __forceinline__ void rw_out_task(KArgs& A, const Frame& F, int l, int task) {
    const int lane = F.lane, fr = lane & 15, fq = lane >> 4;
    const bf16* Z = (const bf16*)(F.ws + WS_Z); const float* QH = (const float*)(F.ws + WS_QH); const float* YL = (const float*)(F.ws + WS_YL); const float* SC = (const float*)(F.ws + WS_SC);
    const float* RWG = (const float*)(F.ws + WS_RWG); const float* RK = (const float*)(F.ws + WS_RK); bf16* O16 = (bf16*)(F.ws + WS_O16);
    const int bh = task / NCH, ck = task % NCH, b = bh >> 2, head = bh & 3;
    const size_t ti0 = (size_t)(bh * SEQ + ck * CH); const int t0g = b * SEQ + ck * CH;
    float sa[4][16];
    { const float* sp = SC + (size_t)(bh * NCH + ck) * 4096 + (size_t)fr * 64 + 16 * fq;
#pragma unroll
      for (int vt = 0; vt < 4; ++vt)
#pragma unroll
          for (int q = 0; q < 4; ++q) { const f32x4 x = *(const f32x4*)(sp + vt * 1024 + 4 * q); sa[vt][4 * q] = x.x; sa[vt][4 * q + 1] = x.y; sa[vt][4 * q + 2] = x.z; sa[vt][4 * q + 3] = x.w; } }
    const float* lgp = kin(A, I_RW_LNG) + l * 256 + head * 64 + 4 * fq; const float* lbp = kin(A, I_RW_LNB) + l * 256 + head * 64 + 4 * fq; const float* mup = kin(A, I_RW_MU) + l * 1024 + 512 + head * 64 + 4 * fq;
#pragma unroll 1
    for (int tt = 0; tt < 4; ++tt) { const int t = 16 * tt + fr;
        float qb[16];
        { const float* qp = QH + (ti0 + t) * 64 + 16 * fq;
#pragma unroll
          for (int q = 0; q < 4; ++q) { const f32x4 x = *(const f32x4*)(qp + 4 * q); qb[4 * q] = x.x; qb[4 * q + 1] = x.y; qb[4 * q + 2] = x.z; qb[4 * q + 3] = x.w; } }
        f32x4 y[4];
#pragma unroll
        for (int vt = 0; vt < 4; ++vt) y[vt] = *(const f32x4*)(YL + (ti0 + t) * 64 + 16 * vt + 4 * fq);
#pragma unroll
        for (int s_ = 0; s_ < 16; ++s_)
#pragma unroll
            for (int vt = 0; vt < 4; ++vt) y[vt] = __builtin_amdgcn_mfma_f32_16x16x4f32(sa[vt][s_], qb[s_], y[vt], 0, 0, 0);
        float s1 = 0.f, s2 = 0.f;
#pragma unroll
        for (int vt = 0; vt < 4; ++vt) { s1 += (y[vt].x + y[vt].y) + (y[vt].z + y[vt].w); s2 += (y[vt].x * y[vt].x + y[vt].y * y[vt].y) + (y[vt].z * y[vt].z + y[vt].w * y[vt].w); }
        s1 += shfl_xor_l(s1, 16, lane); s1 += shfl_xor_l(s1, 32, lane); s2 += shfl_xor_l(s2, 16, lane); s2 += shfl_xor_l(s2, 32, lane);
        const float m = s1 * (1.f / 64), var = fmaxf(s2 * (1.f / 64) - m * m, 0.f), rstd = __builtin_amdgcn_rsqf(var + RW_LN_EPS);
        const int tg = t0g + t; const float rk = RK[(size_t)tg * 4 + head]; const bool hasprev = (ck * CH + t) > 0;
        const bf16* zv = Z + (size_t)tg * ZLD + OFF_C + 512 + head * 64 + 4 * fq; const float* gp = RWG + (size_t)tg * 256 + head * 64 + 4 * fq; bf16* op = O16 + (size_t)tg * D + 512 + head * 64 + 4 * fq;
#pragma unroll
        for (int vt = 0; vt < 4; ++vt) { const f32x4 v1 = ld4bf(zv + 16 * vt); f32x4 v0 = {0, 0, 0, 0}; if (hasprev) v0 = ld4bf(zv - ZLD + 16 * vt);
            const f32x4 vv = v1 + (v0 - v1) * *(const f32x4*)(mup + 16 * vt), g4 = *(const f32x4*)(gp + 16 * vt), lg4 = *(const f32x4*)(lgp + 16 * vt), lb4 = *(const f32x4*)(lbp + 16 * vt);
            const f32x4 o = ((y[vt] - m) * rstd * lg4 + lb4 + vv * rk) * g4;
            v2u w; w.x = pk2(o.x, o.y); w.y = pk2(o.z, o.w); *(v2u*)(op + 16 * vt) = w; }
    }
}

template <int LSTRIDE> __device__ __forceinline__ void attn_stage(LAS unsigned char* lds, const bf16* src, size_t row_stride, int tid) {
    const int r0 = tid >> 5, c = tid & 31; const bf16* sp = src + (size_t)r0 * row_stride + c * 8; LAS unsigned char* dp = lds + r0 * LSTRIDE + c * 16;
#pragma unroll 4
    for (int i = 0; i < 16; ++i) { const v4u v = *(const v4u*)(sp + (size_t)(16 * i) * row_stride); *(LAS v4u*)(dp + 16 * i * LSTRIDE) = v; }
}
constexpr int KSTR = 544, VSTR = 528;
__device__ __forceinline__ void p_attn(const Frame& F) {
    const int lane = F.lane, fr = lane & 15, fq = lane >> 4;
    const bf16* Q = (const bf16*)(F.ws + WS_Q16); const bf16* KM = (const bf16*)(F.ws + WS_KM16); const bf16* VT = (const bf16*)(F.ws + WS_VMT16); bf16* AO = (bf16*)(F.ws + WS_AO16);
    for (int item = F.bid; item < NB * 4 * (SEQ / 256); item += F.G) {
        const int qg = item % (SEQ / 256), bhd = item / (SEQ / 256), head = bhd & 3, b = bhd >> 2;
        attn_stage<KSTR>(F.lds, KM + (size_t)(b * NMEM) * D + head * 256, D, F.tid);
        __syncthreads();
        v4u pf[2][8]; float inv[2];
#pragma unroll
        for (int u = 0; u < 2; ++u) { const int q0 = b * SEQ + qg * 256 + u * 128 + F.wave * 16;
            bf16x8 qf[8];
#pragma unroll
            for (int ks = 0; ks < 8; ++ks) qf[ks] = *(const bf16x8*)(Q + (size_t)(q0 + fr) * D + head * 256 + ks * 32 + fq * 8);
            f32x4 sT[16];
            const LAS unsigned char* kbase = F.lds + fr * KSTR + fq * 16;
#pragma unroll
            for (int kt = 0; kt < 16; ++kt) { f32x4 a = {0, 0, 0, 0}; const LAS unsigned char* kp = kbase + kt * 16 * KSTR;
#pragma unroll
                for (int ks = 0; ks < 8; ++ks) { const bf16x8 kf = *(const LAS bf16x8*)(kp + ks * 64); a = __builtin_amdgcn_mfma_f32_16x16x32_bf16(kf, qf[ks], a, 0, 0, 0); }
                sT[kt] = a; if (kt & 1) __builtin_amdgcn_sched_barrier(0); }
            float mx = -3.0e38f;
#pragma unroll
            for (int kt = 0; kt < 16; ++kt) mx = fmaxf(fmaxf(fmaxf(mx, sT[kt].x), fmaxf(sT[kt].y, sT[kt].z)), sT[kt].w);
            mx = fmaxf(mx, shfl_xor_l(mx, 16, lane)); mx = fmaxf(mx, shfl_xor_l(mx, 32, lane));
            float sum = 0.f;
#pragma unroll
            for (int kt = 0; kt < 16; ++kt) { sT[kt].x = __expf(sT[kt].x - mx); sT[kt].y = __expf(sT[kt].y - mx); sT[kt].z = __expf(sT[kt].z - mx); sT[kt].w = __expf(sT[kt].w - mx); sum += (sT[kt].x + sT[kt].y) + (sT[kt].z + sT[kt].w); }
            sum += shfl_xor_l(sum, 16, lane); sum += shfl_xor_l(sum, 32, lane);
            inv[u] = 1.0f / sum;
#pragma unroll
            for (int kp = 0; kp < 8; ++kp) { v4u w; w.x = pk2(sT[2 * kp].x, sT[2 * kp].y); w.y = pk2(sT[2 * kp].z, sT[2 * kp].w); w.z = pk2(sT[2 * kp + 1].x, sT[2 * kp + 1].y); w.w = pk2(sT[2 * kp + 1].z, sT[2 * kp + 1].w); pf[u][kp] = w; }
            __builtin_amdgcn_sched_barrier(0);
        }
        __syncthreads();
        attn_stage<VSTR>(F.lds, VT + (size_t)(b * D + head * 256) * NMEM, NMEM, F.tid);
        __syncthreads();
#pragma unroll
        for (int u = 0; u < 2; ++u) { const int q0 = b * SEQ + qg * 256 + u * 128 + F.wave * 16;
#pragma unroll 2
            for (int dt = 0; dt < 16; ++dt) { f32x4 o = {0, 0, 0, 0}; const LAS unsigned char* vp = F.lds + (dt * 16 + fr) * VSTR + fq * 8;
#pragma unroll
                for (int kp = 0; kp < 8; ++kp) {
                    const v2u lo = *(const LAS v2u*)(vp + 64 * kp), hi = *(const LAS v2u*)(vp + 64 * kp + 32); v4u w; w.x = lo.x; w.y = lo.y; w.z = hi.x; w.w = hi.y;
                    o = __builtin_amdgcn_mfma_f32_16x16x32_bf16(__builtin_bit_cast(bf16x8, w), __builtin_bit_cast(bf16x8, pf[u][kp]), o, 0, 0, 0); }
                v2u w; w.x = pk2(o.x * inv[u], o.y * inv[u]); w.y = pk2(o.z * inv[u], o.w * inv[u]);
                *(v2u*)(AO + (size_t)(q0 + fr) * D + head * 256 + dt * 16 + 4 * fq) = w; __builtin_amdgcn_sched_barrier(0); } }
        __syncthreads();
    }
}

__device__ __forceinline__ void p_ln(const Frame& F, const float* g, const float* b, bool dummy) {
    const int gw = F.bid * NWAVES + F.wave, NGW = F.G * NWAVES, lane = F.lane; const bf16* P = (const bf16*)(F.ws + WS_PRE16); bf16* H16 = (bf16*)(F.ws + (dummy ? WS_Z + 128 * MiB : WS_H16));
    for (int r0 = gw * 4; r0 < T; r0 += NGW * 4) { f32x4 v[4][4];
#pragma unroll
        for (int i = 0; i < 4; ++i)
#pragma unroll
            for (int j = 0; j < 4; ++j) v[i][j] = ld4bf(P + (size_t)(r0 + i) * D + 256 * j + 4 * lane);
#pragma unroll
        for (int i = 0; i < 4; ++i) { float mean, rstd; ln_stats(v[i], mean, rstd); ln_apply_store(v[i], mean, rstd, g, b, (float*)nullptr, H16 + (size_t)(r0 + i) * D, lane); } }
}
__device__ __forceinline__ void p_ln_router(KArgs& A, const Frame& F, int l, bool dummy) {
    const int gw = F.bid * NWAVES + F.wave, NGW = F.G * NWAVES, lane = F.lane, tid = F.tid, fr = lane & 15, fq = lane >> 4;
    const bf16* H = (const bf16*)(F.ws + WS_PRE16); bf16* H16 = (bf16*)(F.ws + (dummy ? WS_Z + 128 * MiB : WS_H16)); int* TOKE = (int*)(F.ws + (dummy ? WS_Z + 200 * MiB : WS_TOKE)); float* TOKW = (float*)(F.ws + (dummy ? WS_Z + 201 * MiB : WS_TOKW));
    LAS v4u* TB = (LAS v4u*)F.lds;
    LAS float* PS = (LAS float*)(F.lds + 131072);
    volatile LAS unsigned* hist = F.MISC + MI_HIST;
    const float* rw = kin(A, I_ROUTER_W) + (size_t)l * D * NE; const float* rb = kin(A, I_ROUTER_B) + l * NE; const float* g = kin(A, I_LN2_G) + l * D; const float* bb = kin(A, I_LN2_B) + l * D;
    for (int en = tid; en < 32 * 2 * 64; en += NTHREADS) { const int ln = en & 63, et = (en >> 6) & 1, ks = en >> 7, efr = ln & 15, efq = ln >> 4; float hi[8], lo[8];
#pragma unroll
        for (int j = 0; j < 8; ++j) { const int d = 32 * ks + 8 * efq + j; const float v = g[d] * rw[d * NE + et * 16 + efr]; const float h = bf2f(f2bf(v)); hi[j] = h; lo[j] = v - h; }
        v4u wh, wl; wh.x = pk2(hi[0], hi[1]); wh.y = pk2(hi[2], hi[3]); wh.z = pk2(hi[4], hi[5]); wh.w = pk2(hi[6], hi[7]); wl.x = pk2(lo[0], lo[1]); wl.y = pk2(lo[2], lo[3]); wl.z = pk2(lo[4], lo[5]); wl.w = pk2(lo[6], lo[7]);
        TB[((ks * 2 + et) * 2 + 0) * 64 + ln] = wh; TB[((ks * 2 + et) * 2 + 1) * 64 + ln] = wl; }
    { const int e = tid & 31, part = tid >> 5; float sg = 0.f, sb = 0.f;
      for (int d = part * 64; d < part * 64 + 64; ++d) { const float w = rw[d * NE + e]; sg += g[d] * w; sb += bb[d] * w; }
      PS[part * 32 + e] = sg; PS[512 + part * 32 + e] = sb; }
    if (tid < NE) hist[tid] = 0u;
    if (!dummy) { int* stok = (int*)(F.ws + WS_STOK); for (int i = F.bid * NTHREADS + tid; i < SLOT_ROWS; i += F.G * NTHREADS) stok[i] = 0; }
    __syncthreads();
    if (tid < NE) { float sg = 0.f, sb = 0.f;
#pragma unroll
        for (int p = 0; p < 16; ++p) { sg += PS[p * 32 + tid]; sb += PS[512 + p * 32 + tid]; }
        PS[1024 + tid] = sg; PS[1056 + tid] = sb + rb[tid]; }
    __syncthreads();
    const float cg0 = PS[1024 + fr], cg1 = PS[1024 + 16 + fr], cb0 = PS[1056 + fr], cb1 = PS[1056 + 16 + fr];
    for (int grp = gw; grp < T / 16; grp += NGW) { const int r0 = grp * 16; const bf16* xrow = H + (size_t)(r0 + fr) * D + 8 * fq;
        f32x4 acc0 = {0, 0, 0, 0}, acc1 = {0, 0, 0, 0}; float sum = 0.f, sq = 0.f;
#pragma unroll 2
        for (int ks = 0; ks < 32; ++ks) { const v4u xw = *(const v4u*)(xrow + 32 * ks); f32x4 xa, xb; unpk8(xw, xa, xb);
            sum += (xa.x + xa.y) + (xa.z + xa.w) + (xb.x + xb.y) + (xb.z + xb.w);
            sq += (xa.x * xa.x + xa.y * xa.y) + (xa.z * xa.z + xa.w * xa.w) + (xb.x * xb.x + xb.y * xb.y) + (xb.z * xb.z + xb.w * xb.w);
            const LAS v4u* tb = TB + (ks * 4) * 64 + lane; const v4u b0h = tb[0], b0l = tb[64], b1h = tb[128], b1l = tb[192];
            const bf16x8 Ah = __builtin_bit_cast(bf16x8, xw);
            acc0 = __builtin_amdgcn_mfma_f32_16x16x32_bf16(Ah, __builtin_bit_cast(bf16x8, b0h), acc0, 0, 0, 0); acc0 = __builtin_amdgcn_mfma_f32_16x16x32_bf16(Ah, __builtin_bit_cast(bf16x8, b0l), acc0, 0, 0, 0);
            acc1 = __builtin_amdgcn_mfma_f32_16x16x32_bf16(Ah, __builtin_bit_cast(bf16x8, b1h), acc1, 0, 0, 0); acc1 = __builtin_amdgcn_mfma_f32_16x16x32_bf16(Ah, __builtin_bit_cast(bf16x8, b1l), acc1, 0, 0, 0); }
        sum += shfl_xor_l(sum, 16, lane); sum += shfl_xor_l(sum, 32, lane); sq += shfl_xor_l(sq, 16, lane); sq += shfl_xor_l(sq, 32, lane);
        const float mean = sum * (1.f / D), rstd = 1.0f / sqrtf(fmaxf(sq * (1.f / D) - mean * mean, 0.f) + LN_EPS);
        float v0[4], v1[4];
#pragma unroll
        for (int reg = 0; reg < 4; ++reg) { const float rs = __builtin_bit_cast(float, shfl_idx_l(__builtin_bit_cast(int, rstd), 4 * fq + reg)), mn = __builtin_bit_cast(float, shfl_idx_l(__builtin_bit_cast(int, mean), 4 * fq + reg));
            v0[reg] = rs * acc0[reg] - rs * mn * cg0 + cb0; v1[reg] = rs * acc1[reg] - rs * mn * cg1 + cb1; }
        float wv[4][4]; int wi[4][4];
#pragma unroll
        for (int k = 0; k < 4; ++k) {
#pragma unroll
            for (int reg = 0; reg < 4; ++reg) { float bv = v0[reg]; int bi = fr; if (v1[reg] > bv) { bv = v1[reg]; bi = 16 + fr; }
#pragma unroll
                for (int o = 1; o < 16; o <<= 1) { const float ov = shfl_xor_l(bv, o, lane); const int oi = shfl_idx_l(bi, lane ^ o); if (ov > bv || (ov == bv && oi < bi)) { bv = ov; bi = oi; } }
                wv[k][reg] = bv; wi[k][reg] = bi; if (bi == fr) v0[reg] = -3.0e38f; if (bi == 16 + fr) v1[reg] = -3.0e38f; } }
        if (fr == 0) {
#pragma unroll
            for (int reg = 0; reg < 4; ++reg) { const int t = r0 + 4 * fq + reg; const float e1 = __expf(wv[1][reg] - wv[0][reg]), e2 = __expf(wv[2][reg] - wv[0][reg]), e3 = __expf(wv[3][reg] - wv[0][reg]), inv = 1.0f / (1.0f + e1 + e2 + e3);
                *(int4*)(TOKE + (size_t)t * 4) = make_int4(wi[0][reg], wi[1][reg], wi[2][reg], wi[3][reg]); *(f32x4*)(TOKW + (size_t)t * 4) = (f32x4){inv, e1 * inv, e2 * inv, e3 * inv};
#pragma unroll
                for (int k = 0; k < 4; ++k) __hip_atomic_fetch_add((LAS unsigned*)&hist[wi[k][reg]], 1u, __ATOMIC_RELAXED, __HIP_MEMORY_SCOPE_WORKGROUP); } }
        bf16* o16 = H16 + (size_t)(r0 + fr) * D + 8 * fq;
#pragma unroll 2
        for (int ks = 0; ks < 32; ++ks) { f32x4 xa, xb; unpk8(*(const v4u*)(xrow + 32 * ks), xa, xb);
            const f32x4 ga = *(const f32x4*)(g + 32 * ks + 8 * fq), gb = *(const f32x4*)(g + 32 * ks + 8 * fq + 4), ba = *(const f32x4*)(bb + 32 * ks + 8 * fq), bc = *(const f32x4*)(bb + 32 * ks + 8 * fq + 4);
            *(v4u*)(o16 + 32 * ks) = pk8((xa - mean) * rstd * ga + ba, (xb - mean) * rstd * gb + bc); }
    }
    __syncthreads();
    if (tid < NE && !dummy) { const unsigned c = hist[tid]; if (c) atomicAdd(F.ctl + CW_CNT + l * NE + tid, c); F.ctl[CW_WGH + (l * 512 + F.bid) * NE + tid] = c; }
}
__device__ __forceinline__ void moe_offsets(const Frame& F, int l) {
    if (F.tid == 0) { int acc = 0;
        for (int e = 0; e < NE; ++e) { F.MISC[MI_TOFF + e] = (unsigned)acc; const unsigned c = __hip_atomic_load(F.ctl + CW_CNT + l * NE + e, __ATOMIC_RELAXED, __HIP_MEMORY_SCOPE_AGENT); acc += (int)((c + 255u) >> 8); }
        F.MISC[MI_TOFF + NE] = (unsigned)acc; }
    __syncthreads();
}
__device__ __forceinline__ void p_moe_slots(const Frame& F, int l, int dummy) {
    const int gw = F.bid * NWAVES + F.wave, NGW = F.G * NWAVES, lane = F.lane;
    moe_offsets(F, l);
    const int* TOKE = (const int*)(F.ws + WS_TOKE); const float* TOKW = (const float*)(F.ws + WS_TOKW); int* TOKS = (int*)(F.ws + (dummy ? WS_END : WS_TOKS)); float* SLOTW = (float*)(F.ws + (dummy ? WS_END + 1 * MiB : WS_SLOTW));
    const bf16* H16 = (const bf16*)(F.ws + WS_H16); bf16* XG = (bf16*)(F.ws + (dummy ? WS_ACT : WS_XG)); unsigned* CUR = F.ctl + CW_CUR + l * NE + dummy * 256;
    if (F.tid < NE) { const unsigned c = F.ctl[CW_WGH + (l * 512 + F.bid) * NE + F.tid]; const unsigned base = c ? atomicAdd(CUR + F.tid, c) : 0u;
        F.MISC[MI_LBASE + F.tid] = F.MISC[MI_TOFF + F.tid] * 256u + base; F.MISC[MI_LCUR + F.tid] = 0u; }
    __syncthreads();
    int* STOK = (int*)(F.ws + (dummy ? WS_END + 2 * MiB : WS_STOK));
    for (int grp = gw; grp < T / 16; grp += NGW) {
        const int r = grp * 16 + (lane >> 2), k = lane & 3; const int e = TOKE[(size_t)r * 4 + k];
        const unsigned pos = __hip_atomic_fetch_add((LAS unsigned*)&F.MISC[MI_LCUR + e], 1u, __ATOMIC_RELAXED, __HIP_MEMORY_SCOPE_WORKGROUP); const int slot = (int)(F.MISC[MI_LBASE + e] + pos);
        TOKS[(size_t)r * 4 + k] = slot; SLOTW[slot] = TOKW[(size_t)r * 4 + k]; STOK[slot] = r; }
}
__device__ __forceinline__ void p_moe_combine(KArgs& A, const Frame& F, int l, bool dummy) {
    const int gw = F.bid * NWAVES + F.wave, NGW = F.G * NWAVES, lane = F.lane;
    const bf16* H = (const bf16*)(F.ws + WS_H16); bf16* H16 = (bf16*)(F.ws + (dummy ? WS_Z + 128 * MiB : WS_H16)); const int* TOKS = (const int*)(F.ws + WS_TOKS); const bf16* YS = (const bf16*)(F.ws + WS_YS);
    const bool last = (l == NL - 1) && !dummy;
    for (int r0 = gw * 2; r0 < T; r0 += NGW * 2) {
        int4 sl[2]; sl[0] = *(const int4*)(TOKS + (size_t)r0 * 4); sl[1] = *(const int4*)(TOKS + (size_t)(r0 + 1) * 4);
        v2u hh[2][4], ys[2][4][4];
#pragma unroll
        for (int i = 0; i < 2; ++i)
#pragma unroll
            for (int j = 0; j < 4; ++j) { const int o = 256 * j + 4 * lane; hh[i][j] = *(const v2u*)(H + (size_t)(r0 + i) * D + o);
                ys[i][j][0] = *(const v2u*)(YS + (size_t)sl[i].x * D + o); ys[i][j][1] = *(const v2u*)(YS + (size_t)sl[i].y * D + o); ys[i][j][2] = *(const v2u*)(YS + (size_t)sl[i].z * D + o); ys[i][j][3] = *(const v2u*)(YS + (size_t)sl[i].w * D + o); }
#pragma unroll
        for (int i = 0; i < 2; ++i) { f32x4 v[4]; const int r = r0 + i;
#pragma unroll
            for (int j = 0; j < 4; ++j) { const v2u h2 = hh[i][j], y0 = ys[i][j][0], y1 = ys[i][j][1], y2 = ys[i][j][2], y3 = ys[i][j][3];
                v[j].x = bf2f(h2.x & 0xffffu) * DN_ALPHA + ((bf2f(y0.x & 0xffffu) + bf2f(y1.x & 0xffffu)) + (bf2f(y2.x & 0xffffu) + bf2f(y3.x & 0xffffu)));
                v[j].y = bf2f(h2.x >> 16) * DN_ALPHA + ((bf2f(y0.x >> 16) + bf2f(y1.x >> 16)) + (bf2f(y2.x >> 16) + bf2f(y3.x >> 16)));
                v[j].z = bf2f(h2.y & 0xffffu) * DN_ALPHA + ((bf2f(y0.y & 0xffffu) + bf2f(y1.y & 0xffffu)) + (bf2f(y2.y & 0xffffu) + bf2f(y3.y & 0xffffu)));
                v[j].w = bf2f(h2.y >> 16) * DN_ALPHA + ((bf2f(y0.y >> 16) + bf2f(y1.y >> 16)) + (bf2f(y2.y >> 16) + bf2f(y3.y >> 16))); }
            float mean, rstd; ln_stats(v, mean, rstd);
            if (last) ln_apply_store(v, mean, rstd, kin(A, I_LN3_G) + l * D, kin(A, I_LN3_B) + l * D, kout(A) + (size_t)r * D, (bf16*)nullptr, lane);
            else ln_apply_store(v, mean, rstd, kin(A, I_LN3_G) + l * D, kin(A, I_LN3_B) + l * D, (float*)nullptr, H16 + (size_t)r * D, lane); } }
}

constexpr int NPL = 18;
constexpr int NPHASES = 1 + NL * NPL;
#ifndef ONLY
#define ONLY -1
#endif
#define EN(j) (ONLY < 0 || ONLY == (j))
#define DUMMY(j) ((PROBE_PHASE == (j)) && (rep_ + 1 < PROBE_REPS))
#define REPS(j) for (int rep_ = 0; rep_ < ((PROBE_PHASE == (j)) ? PROBE_REPS : 1); ++rep_, __syncthreads())
__global__ void __launch_bounds__(NTHREADS, 2) fwd_kernel(Args args) {
    extern __shared__ __attribute__((aligned(16))) unsigned char lds_raw[];
    Frame F;
    F.lds = (LAS unsigned char*)lds_raw; F.MISC = (volatile LAS unsigned*)(F.lds + MISC_OFF);
    F.tid = threadIdx.x; F.lane = F.tid & 63; F.wave = __builtin_amdgcn_readfirstlane(F.tid >> 6); F.G = gridDim.x; F.bid = blockIdx.x;
    F.ws = (unsigned char*)(GAS unsigned char*)args.ws; F.ctl = (unsigned*)(F.ws + WS_CTL);
    for (int u = F.tid; u < (LDS_BYTES - MISC_OFF) / 4; u += NTHREADS) F.MISC[u] = 0u;
    __syncthreads();
    XcdBarrier bar; bar.bar = F.ctl + CW_BAR; bar.x = 0; bar.st = nullptr;
    const int lo = args.ph_lo, hi = args.ph_hi;
    if (hi - lo > 1) bar = xcd_barrier_post(F.ctl + CW_BAR, F.MISC + 8);
#define IN(k) (launder_i(lo) <= (k) && (k) < launder_i(hi))
#define SEAM(k) do { if (IN(k) && IN((k) + 1)) xcd_barrier(bar); } while (0)
#define PH_BEGIN KArgs& KA = *kargs(); unsigned char* ws = launder_p(args.ws); F.ws = ws; (void)KA; (void)ws; { int ln_; asm volatile("v_mbcnt_lo_u32_b32 %0, -1, 0\n\tv_mbcnt_hi_u32_b32 %0, -1, %0" : "=v"(ln_)); F.lane = ln_; } F.tid = F.wave * 64 + F.lane; F.bid = launder_i((int)blockIdx.x); F.G = launder_i((int)gridDim.x);

    if (EN(100) && IN(0)) REPS(100) { PH_BEGIN p_prologue(KA, F); } SEAM(0);
    if (PROBE_PHASE == 300) { for (int q_ = 0; q_ < 20; ++q_) xcd_barrier(bar); }

#pragma unroll 1
    for (int l_ = 0; l_ < NL; ++l_) {
        const int l = launder_i(l_); const int p0 = 1 + l * NPL;
        if (EN(0) && IN(p0 + 0)) REPS(0) { PH_BEGIN
            pg8::Gemm g{D, D, D}; pg8::StaticOrder S{(const bf16*)(ws + WS_H16), (const bf16*)(ws + WS_WINT) + (size_t)l * N_IN * D, D, D, T / 256, N_IN / 256, F.G, F.bid};
            if (PROBE_PHASE == 200) { for (int q_ = 0; q_ < PROBE_REPS - 1; ++q_) { EpiNull E0{0}; pg8::gemm_phase(F.lds, F.wave * 64 + my_lane(), g, S, E0); __syncthreads(); } }
            EpiIn E{l};
            pg8::gemm_phase(F.lds, F.wave * 64 + my_lane(), g, S, E);
        } SEAM(p0 + 0);
        if (EN(1) && IN(p0 + 1)) REPS(1) { PH_BEGIN p_mix1(KA, F, l); } SEAM(p0 + 1);
        if (EN(2) && IN(p0 + 2)) REPS(2) { PH_BEGIN
            { pg8::Gemm g{S5K, 1024, 1024}; pg8::BatchOrder S{(const bf16*)(ws + WS_AOUT), (const bf16*)(ws + WS_S5BC) + (size_t)l * 16 * 256 * 1024, S5K, 1024, NCHT / 256, 1, 16, F.G, (F.bid + 192) % F.G, (size_t)NCHT * S5K, (size_t)256 * 1024};
              EpiXloc E{0}; pg8::gemm_phase(F.lds, F.wave * 64 + my_lane(), g, S, E); }
            __syncthreads();
            { pg8::Gemm g{D, D, D}; pg8::StaticOrder S{(const bf16*)(ws + WS_MEM16), (const bf16*)(ws + WS_WKT) + (size_t)l * D * D, D, D, NB * NMEM / 256, D / 256, F.G, (F.bid + 160) % F.G};
              EpiBf16 E{(unsigned)(WS_KM16 / MiB), 1.0f}; pg8::gemm_phase(F.lds, F.wave * 64 + my_lane(), g, S, E); }
            __syncthreads();
            { pg8::Gemm g{D, D, D}; pg8::StaticOrder S{(const bf16*)(ws + WS_MEM16), (const bf16*)(ws + WS_WVT) + (size_t)l * D * D, D, D, NB * NMEM / 256, D / 256, F.G, (F.bid + 144) % F.G};
              EpiVT E{0}; pg8::gemm_phase(F.lds, F.wave * 64 + my_lane(), g, S, E); }
            __syncthreads();
            { pg8::Gemm g{256, 256, 256}; pg8::StaticOrder S{(const bf16*)(ws + WS_LA16), (const bf16*)(ws + WS_LWT) + (size_t)l * 768 * 256, 256, 256, T / 256, 3, F.G, (F.bid + 128) % F.G};
              EpiLora E{l}; pg8::gemm_phase(F.lds, F.wave * 64 + my_lane(), g, S, E); }
        } SEAM(p0 + 2);
        if (EN(3) && IN(p0 + 3)) REPS(3) { PH_BEGIN
            for (int q_ = 0; q_ < ((PROBE_PHASE == 301) ? PROBE_REPS : 1); ++q_) p_s5_chain(KA, F, l);
            for (int q_ = 0; q_ < ((PROBE_PHASE == 302) ? PROBE_REPS : 1); ++q_) p_rw_chunks(KA, F, l); } SEAM(p0 + 3);
        if (EN(4) && IN(p0 + 4)) REPS(4) { PH_BEGIN
            p_chain_compose(F);
            pg8::Gemm g{S5K, S5K, S5K}; pg8::BatchOrder S{(const bf16*)(ws + WS_AOUT), (const bf16*)(ws + WS_S5BT) + (size_t)l * 16 * 1024 * S5K, S5K, S5K, NCHT / 256, 1024 / 256, 16, F.G, F.bid, (size_t)NCHT * S5K, (size_t)1024 * S5K};
            EpiS5Y E{l}; pg8::gemm_phase(F.lds, F.wave * 64 + my_lane(), g, S, E);
        } SEAM(p0 + 4);
        if (EN(5) && IN(p0 + 5)) REPS(5) { PH_BEGIN
            const int nchain = (F.G >= 128) ? 64 : 0;
            if (F.bid < nchain) { if (F.wave == 0) p_chain_blocks(F, F.bid, nchain); }
            else {
                if (nchain == 0) { p_chain_blocks(F, F.bid * NWAVES + F.wave, F.G * NWAVES); __syncthreads(); }
                pg8::Gemm g{256, 256, 256}; pg8::StaticOrder S{(const bf16*)(ws + WS_YD16), (const bf16*)(ws + WS_GLUT) + (size_t)l * 256 * 256, 256, 256, T / 256, 1, F.G - nchain, F.bid - nchain};
                EpiGlu E{l}; pg8::gemm_phase(F.lds, F.wave * 64 + my_lane(), g, S, E);
            }
        } SEAM(p0 + 5);
        if (EN(6) && IN(p0 + 6)) REPS(6) { PH_BEGIN
            for (int bb = F.bid; bb < 16 * NBLK; bb += F.G) {
                if (F.wave < 4) chain_inblock(F, bb, F.wave);
                VM_WAIT(); __syncthreads();
                rw_out_task(KA, F, l, bb * CB + F.wave);
                __syncthreads();
            }
        } SEAM(p0 + 6);
        if (EN(7) && IN(p0 + 7)) REPS(7) { PH_BEGIN
            pg8::Gemm g{D, 256, 256}; pg8::BranchOrder S{(const bf16*)(ws + WS_O16), (const bf16*)(ws + WS_BRT) + (size_t)l * 4 * D * 256, T / 256, D / 256, F.G, F.bid};
            EpiBranch E{0}; pg8::gemm_phase(F.lds, F.wave * 64 + my_lane(), g, S, E);
        } SEAM(p0 + 7);
        if (EN(8) && IN(p0 + 8)) REPS(8) { PH_BEGIN
            pg8::Gemm g{D, D, D}; pg8::StaticOrder S{(const bf16*)(ws + WS_MG16), (const bf16*)(ws + WS_WOUTT) + (size_t)l * D * D, D, D, T / 256, D / 256, F.G, F.bid};
            EpiResid E{0}; pg8::gemm_phase(F.lds, F.wave * 64 + my_lane(), g, S, E);
        } SEAM(p0 + 8);
        if (EN(9) && IN(p0 + 9)) REPS(9) { PH_BEGIN p_ln(F, kin(KA, I_LN1_G) + l * D, kin(KA, I_LN1_B) + l * D, DUMMY(9)); } SEAM(p0 + 9);
        if (EN(10) && IN(p0 + 10)) REPS(10) { PH_BEGIN
            pg8::Gemm g{D, D, D}; pg8::StaticOrder S{(const bf16*)(ws + WS_H16), (const bf16*)(ws + WS_WQT) + (size_t)l * D * D, D, D, T / 256, D / 256, F.G, F.bid};
            EpiBf16 E{(unsigned)(WS_Q16 / MiB), 0.0625f}; pg8::gemm_phase(F.lds, F.wave * 64 + my_lane(), g, S, E);
        } SEAM(p0 + 10);
        if (EN(11) && IN(p0 + 11)) REPS(11) { PH_BEGIN p_attn(F); } SEAM(p0 + 11);
        if (EN(12) && IN(p0 + 12)) REPS(12) { PH_BEGIN
            pg8::Gemm g{D, D, D}; pg8::StaticOrder S{(const bf16*)(ws + WS_AO16), (const bf16*)(ws + WS_WOT) + (size_t)l * D * D, D, D, T / 256, D / 256, F.G, F.bid};
            EpiResid E{0}; pg8::gemm_phase(F.lds, F.wave * 64 + my_lane(), g, S, E);
        } SEAM(p0 + 12);
        if (EN(13) && IN(p0 + 13)) REPS(13) { PH_BEGIN p_ln_router(KA, F, l, DUMMY(13)); } SEAM(p0 + 13);
        if (EN(14) && IN(p0 + 14)) REPS(14) { PH_BEGIN p_moe_slots(F, l, DUMMY(14) ? (rep_ + 1) : 0); } SEAM(p0 + 14);
        if (EN(15) && IN(p0 + 15)) REPS(15) { PH_BEGIN
            moe_offsets(F, l);
            pg8::Gemm g{D, D, D}; pg8::MoeOrderT<true> S{(const bf16*)(ws + WS_H16), (const bf16*)(ws + WS_W1T) + (size_t)l * NE * 2048 * D, D, D, 2048 / 256, F.G, F.bid, (size_t)2048 * D, (const LAS int*)(F.MISC + MI_TOFF), (const int*)(ws + WS_STOK)};
            if (PROBE_PHASE == 201) { for (int q_ = 0; q_ < PROBE_REPS - 1; ++q_) { EpiNull E0{0}; pg8::gemm_phase(F.lds, F.wave * 64 + my_lane(), g, S, E0); __syncthreads(); } }
            EpiSwiglu E{l}; pg8::gemm_phase(F.lds, F.wave * 64 + my_lane(), g, S, E);
        } SEAM(p0 + 15);
        if (EN(16) && IN(p0 + 16)) REPS(16) { PH_BEGIN
            moe_offsets(F, l);
            pg8::Gemm g{DFF, DFF, DFF}; pg8::MoeOrder S{(const bf16*)(ws + WS_ACT), (const bf16*)(ws + WS_W2T) + (size_t)l * NE * D * DFF, DFF, DFF, D / 256, F.G, F.bid, (size_t)D * DFF, (const LAS int*)(F.MISC + MI_TOFF), nullptr};
            EpiMoeOut E{l}; pg8::gemm_phase(F.lds, F.wave * 64 + my_lane(), g, S, E);
        } SEAM(p0 + 16);
        if (EN(17) && IN(p0 + 17)) REPS(17) { PH_BEGIN p_moe_combine(KA, F, l, DUMMY(17)); } SEAM(p0 + 17);
    }
#undef IN
#undef SEAM
}

extern "C" void kernel_launch(void* const* d_in, const int* in_sizes, int n_in, void* d_out, int out_size, void* d_ws, size_t ws_size, hipStream_t stream) {
    static int grid = 0;
    if (grid == 0) {
        if (n_in != 50 || ws_size < WS_END) { fprintf(stderr, "kernel_launch: unexpected n_in %d / ws_size %zu\n", n_in, ws_size); grid = -1; return; }
        int dev = 0, cus = 0, per_cu = 0;
        if (hipGetDevice(&dev) != hipSuccess || hipDeviceGetAttribute(&cus, hipDeviceAttributeMultiprocessorCount, dev) != hipSuccess) { grid = -1; return; }
        if (hipFuncSetAttribute((const void*)fwd_kernel, hipFuncAttributeMaxDynamicSharedMemorySize, LDS_BYTES) != hipSuccess) { fprintf(stderr, "kernel_launch: hipFuncSetAttribute failed\n"); grid = -1; return; }
        if (hipOccupancyMaxActiveBlocksPerMultiprocessor(&per_cu, (const void*)fwd_kernel, NTHREADS, LDS_BYTES) != hipSuccess || per_cu < 1) { fprintf(stderr, "kernel_launch: occupancy query says %d\n", per_cu); }
        (void)hipGetLastError();
        grid = cus;
    }
    if (grid < 0) return;
    (void)hipMemsetAsync((char*)d_ws + WS_CTL, 0, CTL_ZERO_BYTES, stream);
    Args a{};
    for (int i = 0; i < 50; ++i) a.in[i] = (const float*)d_in[i];
    a.out = (float*)d_out; a.ws = (unsigned char*)d_ws;
#if N_LAUNCHES == 1
    a.ph_lo = 0; a.ph_hi = NPHASES;
    hipLaunchKernelGGL(fwd_kernel, dim3(grid), dim3(NTHREADS), LDS_BYTES, stream, a);
#else
    for (int p = 0; p < NPHASES; ++p) { a.ph_lo = p; a.ph_hi = p + 1; hipLaunchKernelGGL(fwd_kernel, dim3(grid), dim3(NTHREADS), LDS_BYTES, stream, a); }
#endif
}
```

```cpp
#include <hip/hip_runtime.h>
#include <cstdio>
#include <cstdint>

#ifndef N_LAUNCHES
#define N_LAUNCHES 1
#endif

#ifndef PROBE_PHASE
#define PROBE_PHASE -1
#endif
#ifndef PROBE_REPS
#define PROBE_REPS 3
#endif
#define GAS __attribute__((address_space(1)))
#define LAS __attribute__((address_space(3)))
typedef unsigned short bf16;
typedef unsigned v4u __attribute__((ext_vector_type(4)));
typedef unsigned v2u __attribute__((ext_vector_type(2)));
typedef float f32x4 __attribute__((ext_vector_type(4)));
typedef float f32x2 __attribute__((ext_vector_type(2)));
typedef short bf16x8 __attribute__((ext_vector_type(8)));
typedef short bf16x4 __attribute__((ext_vector_type(4)));

constexpr int NL = 2, NB = 4, SEQ = 8192, T = NB * SEQ, D = 1024;
constexpr int NMEM = 256;
constexpr int OFF_B = 768, OFF_C = 1280, OFF_D = 2304, OFF_G = 2560, N_IN = 6656, ZLD = 2560;
constexpr int NE = 32, TOPK = 4, DFF = 1024;
constexpr int CH = 64;
constexpr int NCH = SEQ / CH;
constexpr int NCHT = T / CH;
constexpr int S5K = 1152;
constexpr int SLOT_ROWS = T * TOPK + NE * 256;
constexpr float LN_EPS = 1e-5f, RW_LN_EPS = 64e-5f;
constexpr float DN_ALPHA = 1.41421356237309515f;

constexpr size_t MiB = 1u << 20;
constexpr size_t WS_CTL = 0, CTL_ZERO_BYTES = 1 * MiB;
constexpr size_t WS_W1T = 2 * MiB;
constexpr size_t WS_W2T = 258 * MiB;
constexpr size_t WS_WINT = 386 * MiB;
constexpr size_t WS_BRT = 412 * MiB;
constexpr size_t WS_WOUTT = 416 * MiB, WS_WQT = 420 * MiB, WS_WKT = 424 * MiB, WS_WVT = 428 * MiB, WS_WOT = 432 * MiB;
constexpr size_t WS_GLUT = 436 * MiB;
constexpr size_t WS_SGW = 436 * MiB + 512 * 1024;
constexpr size_t WS_MEM16 = 437 * MiB;
constexpr size_t WS_S5BT = 440 * MiB;
constexpr size_t WS_S5BC = 512 * MiB;
constexpr size_t WS_PRE16 = 528 * MiB;
constexpr size_t WS_H16 = 656 * MiB;
constexpr size_t WS_Z = 720 * MiB;
constexpr size_t WS_XG = 720 * MiB;
constexpr size_t WS_SG = 1040 * MiB;
constexpr size_t WS_YS = 1040 * MiB;
constexpr size_t WS_O16 = 1312 * MiB, WS_MG16 = 1376 * MiB, WS_Q16 = 1440 * MiB, WS_AO16 = 1504 * MiB;
constexpr size_t WS_LA16 = 1568 * MiB;
constexpr size_t WS_DEC = 1584 * MiB, WS_AV = 1616 * MiB;
constexpr size_t WS_LWT = 2012 * MiB;
constexpr size_t WS_ACT = 1568 * MiB;
constexpr size_t WS_QH = 1760 * MiB, WS_YL = 1792 * MiB, WS_GC = 1824 * MiB, WS_HC = 1856 * MiB, WS_SC = 1888 * MiB, WS_RWG = 1920 * MiB;
constexpr size_t WS_RK = 1952 * MiB;
constexpr size_t WS_AOUT = 1954 * MiB;
constexpr size_t WS_XLOC = 1972 * MiB;
constexpr size_t WS_YD16 = 1976 * MiB;
constexpr size_t WS_KM16 = 1992 * MiB, WS_VMT16 = 1994 * MiB;
constexpr size_t WS_TOKE = 1996 * MiB, WS_TOKW = 1997 * MiB, WS_TOKS = 1998 * MiB, WS_SLOTW = 1999 * MiB;
constexpr size_t WS_GB = 2000 * MiB, WS_HB = 2004 * MiB, WS_SB = 2008 * MiB;
constexpr size_t WS_STOK = 2014 * MiB;
constexpr size_t WS_SDST = 2015 * MiB;
constexpr size_t WS_END = 2016 * MiB;
static_assert(WS_XG + (size_t)SLOT_ROWS * D * 2 <= WS_SG && WS_YS + (size_t)SLOT_ROWS * D * 2 <= WS_O16 && WS_ACT + (size_t)SLOT_ROWS * D * 2 <= WS_RK, "overlays");
constexpr int CW_BAR = 4096;
constexpr int CW_CNT = 16384;
constexpr int CW_CUR = 16384 + 128;
constexpr int CW_WGH = 65536;

constexpr int LDS_BYTES = 163840;
constexpr int MISC_OFF = LDS_BYTES - 1024;
constexpr int RING_BYTES = 131072;
constexpr int NWAVES = 8, NTHREADS = 512;

#define LDS_WAIT() asm volatile("s_waitcnt lgkmcnt(0)" ::: "memory")
#define VM_WAIT() asm volatile("s_waitcnt vmcnt(0)" ::: "memory")
__device__ __forceinline__ unsigned f2bf(float f) { unsigned u = __float_as_uint(f); return (u + 0x7fffu + ((u >> 16) & 1u)) >> 16; }
__device__ __forceinline__ unsigned pk2(float lo, float hi) { unsigned r; asm("v_cvt_pk_bf16_f32 %0, %1, %2" : "=v"(r) : "v"(lo), "v"(hi)); return r; }
__device__ __forceinline__ float bf2f(unsigned h) { return __uint_as_float(h << 16); }
__device__ __forceinline__ float sigmoidf_(float x) { return __builtin_amdgcn_rcpf(1.0f + __expf(-x)); }
__device__ __forceinline__ int my_lane() { int l; asm volatile("v_mbcnt_lo_u32_b32 %0, -1, 0\n\tv_mbcnt_hi_u32_b32 %0, -1, %0" : "=v"(l)); return l; }
__device__ __forceinline__ float shfl_xor_l(float v, int o, int lane) { return __builtin_bit_cast(float, __builtin_amdgcn_ds_bpermute((lane ^ o) << 2, __builtin_bit_cast(int, v))); }
__device__ __forceinline__ int shfl_idx_l(int v, int src) { return __builtin_amdgcn_ds_bpermute(src << 2, v); }
__device__ __forceinline__ void fmac_(float& c, float a, float b) { asm("v_fmac_f32 %0, %1, %2" : "+v"(c) : "v"(a), "v"(b)); }
template <int R> __device__ __forceinline__ void fmac_bc(float& c, float op, float x) { asm("v_fmac_f32_dpp %0, %1, %2 row_newbcast:%3 row_mask:0xf bank_mask:0xf" : "+v"(c) : "v"(op), "v"(x), "n"(R)); }
__device__ __forceinline__ float wave_sum(float v) {
    const int ln = my_lane();
#pragma unroll
    for (int o = 1; o < 64; o <<= 1) v += shfl_xor_l(v, o, ln);
    return v;
}

#define XB_TMO      128
#define XB_XCNT(j)  (256  + 64 * (j))
#define XB_XSUB(j)  (1280 + 64 * (j))
#define XB_XGEN(j)  (2304 + 64 * (j))
#define XB_TOP      3328
#define XB_TOPGEN   3392
#define XCD_BAR_WORDS 3456
#define XB_SPIN_CAP (1u << 24)
__device__ __forceinline__ unsigned xb_ld(unsigned* p)              { return __hip_atomic_load(p, __ATOMIC_RELAXED, __HIP_MEMORY_SCOPE_AGENT); }
__device__ __forceinline__ unsigned xb_add(unsigned* p, unsigned v) { return __hip_atomic_fetch_add(p, v, __ATOMIC_RELAXED, __HIP_MEMORY_SCOPE_AGENT); }
__device__ __forceinline__ unsigned xb_xcc_id() { return (unsigned)__builtin_amdgcn_s_getreg((3 << 11) | 20) & 0xFu; }
#define XB_SPIN(cond, bar) do { unsigned _sp = 0; while (cond) { __builtin_amdgcn_s_sleep(1); \
    if ((++_sp & 255u) == 0u) { if (xb_ld(&(bar)[XB_TMO])) break; if (_sp > XB_SPIN_CAP) { atomicAdd(&(bar)[XB_TMO], 1u); break; } } } } while (0)
struct XcdBarrier { unsigned* bar; unsigned x; volatile LAS unsigned* st; };
__device__ __forceinline__ XcdBarrier xcd_barrier_post(unsigned* bar, volatile LAS unsigned* st) {
    XcdBarrier b; b.bar = bar; b.x = xb_xcc_id(); b.st = st;
    if (threadIdx.x == 0) (void)xb_add(&bar[XB_XCNT(b.x)], 1u);
    return b;
}
__device__ __forceinline__ void xcd_barrier_complete(unsigned* bar, unsigned x, unsigned& nloc, unsigned& nx) {
    const unsigned G = gridDim.x * gridDim.y * gridDim.z;
    unsigned sum, cnt, mine, sp = 0u;
    for (;;) {
        sum = 0u; cnt = 0u; mine = 0u;
#pragma unroll
        for (unsigned j = 0; j < 16; ++j) { const unsigned c = xb_ld(&bar[XB_XCNT(j)]); sum += c; cnt += (c > 0u) ? 1u : 0u; mine = (j == x) ? c : mine; }
        if (sum == G) break;
        __builtin_amdgcn_s_sleep(1);
        if ((++sp & 255u) == 0u) { if (xb_ld(&bar[XB_TMO])) break; if (sp > XB_SPIN_CAP) { atomicAdd(&bar[XB_TMO], 1u); break; } }
    }
    nloc = mine > 0u ? mine : 1u; nx = cnt > 0u ? cnt : 1u;
}
__device__ __forceinline__ void xcd_barrier(const XcdBarrier& b) {
    asm volatile("s_waitcnt vmcnt(0)" ::: "memory");
    __syncthreads();
    if (threadIdx.x == 0) {
        unsigned* bar = b.bar; unsigned bx = b.x;
        asm volatile("" : "+s"(bar), "+s"(bx));
        __builtin_amdgcn_s_waitcnt(0);
        unsigned nloc = b.st[0], nx = b.st[1];
        if (nloc == 0u) { xcd_barrier_complete(bar, bx, nloc, nx); b.st[0] = nloc; b.st[1] = nx; }
        const unsigned old = xb_add(&bar[XB_XSUB(bx)], 1u);
        const unsigned gen = old / nloc;
        if (old + 1u == (gen + 1u) * nloc) {
            __builtin_amdgcn_fence(__ATOMIC_RELEASE, "agent");
            asm volatile("s_waitcnt vmcnt(0)" ::: "memory");
            const unsigned og = xb_add(&bar[XB_TOP], 1u);
            const unsigned tg = og / nx;
            if (og + 1u == (tg + 1u) * nx) xb_add(&bar[XB_TOPGEN], 1u);
            else XB_SPIN(xb_ld(&bar[XB_TOPGEN]) == tg, bar);
            __builtin_amdgcn_fence(__ATOMIC_ACQUIRE, "agent");
            xb_add(&bar[XB_XGEN(bx)], 1u);
            asm volatile("s_waitcnt vmcnt(0)" ::: "memory");
        } else {
            XB_SPIN(xb_ld(&bar[XB_XGEN(bx)]) == gen, bar);
            __builtin_amdgcn_fence(__ATOMIC_ACQUIRE, "agent");
            asm volatile("s_waitcnt vmcnt(0)" ::: "memory");
        }
    }
    __syncthreads();
}

namespace pg8 {
constexpr int BM = 256, BK = 64, HALF = 128, HTB = HALF * BK * 2, STAGE_BYTES = 8 * HTB, NXCD = 8, WGM = 8;
__host__ __device__ __forceinline__ int lds_byte(int r, int c) { const int st = (r >> 4) * 2 + (c >> 5), rr = r & 15, cc = c & 31, ob = rr * 64 + cc * 2; return st * 1024 + (ob ^ (((ob >> 9) & 1) << 5)); }
__host__ __device__ __forceinline__ int perm32(int rho) { const int n = rho >> 4, i = rho & 15; return 8 * (i >> 2) + 4 * n + (i & 3); }
__host__ __device__ __forceinline__ void stage_rc(int b, int& R, int& C) { const int st = b / 1024, sb = b % 1024, swz = sb ^ (((sb >> 9) & 1) << 5); R = (st >> 1) * 16 + swz / 64; C = (st & 1) * 32 + (swz % 64) / 2; }
struct Unit { int pm, pn, e; };
struct Gemm { int lda, ldb, K; };

__device__ __forceinline__ bool static_tile(int i, int G, int c, int nM, int nN, int& pm, int& pn) {
    const int nwg = nM * nN; const long L = (long)i * G + c; if (L >= nwg) return false;
    int wgid = (int)L; { const int q = nwg / NXCD, r = nwg % NXCD, xcd = wgid % NXCD, off = wgid / NXCD; wgid = (xcd < r ? xcd * (q + 1) : r * (q + 1) + (xcd - r) * q) + off; }
    const int nig = WGM * nN, gid = wgid / nig, fm = gid * WGM, gsz = (nM - fm) < WGM ? (nM - fm) : WGM;
    pm = fm + ((wgid % nig) % gsz); pn = (wgid % nig) / gsz; return true;
}
struct StaticOrder { static constexpr bool GATHER = false;
    const bf16* A; const bf16* Bt; int lda, ldb, nM, nN, G, c;
    __device__ __forceinline__ bool next(int i, Unit& u) const { u.e = 0; return static_tile(i, G, c, nM, nN, u.pm, u.pn); }
    __device__ __forceinline__ const char* a_base(const Unit& u) const { return (const char*)(A + (size_t)u.pm * BM * lda); }
    __device__ __forceinline__ const char* b_base(const Unit& u) const { return (const char*)(Bt + (size_t)u.pn * BM * ldb); }
};
struct BatchOrder { static constexpr bool GATHER = false;
    const bf16* A; const bf16* Bt; int lda, ldb, nM, nN, nb, G, c; size_t sA, sB;
    __device__ __forceinline__ bool next(int i, Unit& u) const {
        const long L = (long)i * G + c; const int per = nM * nN; if (L >= (long)per * nb) return false;
        u.e = (int)(L / per); const int r = (int)(L % per); u.pn = r / nM; u.pm = r % nM; return true; }
    __device__ __forceinline__ const char* a_base(const Unit& u) const { return (const char*)(A + (size_t)u.e * sA + (size_t)u.pm * BM * lda); }
    __device__ __forceinline__ const char* b_base(const Unit& u) const { return (const char*)(Bt + (size_t)u.e * sB + (size_t)u.pn * BM * ldb); }
};
struct BranchOrder { static constexpr bool GATHER = false;
    const bf16* A; const bf16* Bt; int nM, nN, G, c;
    __device__ __forceinline__ bool next(int i, Unit& u) const { u.e = i & 3; return static_tile(i >> 2, G, c, nM, nN, u.pm, u.pn); }
    __device__ __forceinline__ const char* a_base(const Unit& u) const { return (const char*)(A + (size_t)u.pm * BM * D + u.e * 256); }
    __device__ __forceinline__ const char* b_base(const Unit& u) const { return (const char*)(Bt + (size_t)u.e * D * 256 + (size_t)u.pn * BM * 256); }
};
template <bool GATHER_> struct MoeOrderT { static constexpr bool GATHER = GATHER_;
    const bf16* A; const bf16* Bt; int lda, ldb, nN, G, c; size_t sB; const LAS int* toff; const int* tok;
    __device__ __forceinline__ bool next(int i, Unit& u) const {
        const int nt = toff[NE]; int mt;
        const int Gx = G >> 3;
        if ((G & 7) == 0 && (Gx % nN) == 0) {
            const int per = Gx / nN, x = c & 7, y = c >> 3;
            mt = i * 8 * per + x * per + y / nN; u.pn = y % nN; if (mt >= nt) return false;
        } else { const long L = (long)i * G + c; if (L >= (long)nt * nN) return false; mt = (int)(L / nN); u.pn = (int)(L % nN); }
        u.pm = mt; int e = 0;
#pragma unroll 1
        for (int k = 1; k < NE; ++k) e += (toff[k] <= mt) ? 1 : 0;
        u.e = e; return true; }
    __device__ __forceinline__ const char* a_base(const Unit& u) const { return GATHER_ ? (const char*)A : (const char*)(A + (size_t)u.pm * BM * lda); }
    __device__ __forceinline__ const char* b_base(const Unit& u) const { return (const char*)(Bt + (size_t)u.e * sB + (size_t)u.pn * BM * ldb); }
    __device__ __forceinline__ unsigned tok2(const Unit& u, int r) const { return (unsigned)tok[u.pm * BM + r] | ((unsigned)tok[u.pm * BM + r + 64] << 16); }
};
typedef MoeOrderT<false> MoeOrder;

template <class F> __device__ __forceinline__ void epi_foreach(const f32x4 (&acc)[2][2][4][2], const Unit& u, int wr, int wc, int fr, int fq, const F& f) {
#pragma unroll
    for (int ai = 0; ai < 2; ++ai)
#pragma unroll
        for (int m = 0; m < 4; ++m) { const int row = u.pm * BM + ai * HALF + wr * 64 + m * 16 + fr;
#pragma unroll
            for (int bj = 0; bj < 2; ++bj)
#pragma unroll
                for (int n = 0; n < 2; ++n) f(row, u.pn * BM + bj * HALF + wc * 32 + n * 16 + 4 * fq, acc[ai][bj][m][n]);
            if (m == 3) __builtin_amdgcn_sched_barrier(0); }
}

template <class F> __device__ __forceinline__ void epi_foreach8(const f32x4 (&acc)[2][2][4][2], const Unit& u, int wr, int wc, int fr, int fq, const F& f) {
#pragma unroll
    for (int ai = 0; ai < 2; ++ai)
#pragma unroll
        for (int m = 0; m < 4; ++m) { const int row = u.pm * BM + ai * HALF + wr * 64 + m * 16 + fr;
#pragma unroll
            for (int bj = 0; bj < 2; ++bj) f(row, u.pn * BM + bj * HALF + wc * 32 + 8 * fq, acc[ai][bj][m][0], acc[ai][bj][m][1]);
            if (m == 3) __builtin_amdgcn_sched_barrier(0); }
}
template <class Epi, class Sched, bool ALIGN_EPI = true, bool SP2 = true>
__device__ __forceinline__ void gemm_phase(LAS unsigned char* lds, const int tid, const Gemm g, const Sched& S, const Epi& E) {
    const int wid = __builtin_amdgcn_readfirstlane(tid >> 6), lane = tid & 63, wr = wid >> 2, wc = wid & 3, fr = lane & 15, fq = lane >> 4;
    const int K = g.K, nt = K / BK;
    unsigned voffA[2], voffB[2]; int gR0 = 0; unsigned gC = 0;
    { int R, C; stage_rc(tid * 16, R, C); gR0 = R; gC = (unsigned)C * 2u; }
#pragma unroll
    for (int i = 0; i < 2; ++i) { int R, C; stage_rc(tid * 16 + i * 8192, R, C);
        const int Rb = Epi::PERM ? ((R & ~31) + perm32(R & 31)) : R;
        voffA[i] = (unsigned)(R * g.lda + C) * 2u; voffB[i] = (unsigned)(Rb * g.ldb + C) * 2u; }
    const size_t kstep = (size_t)(BK * 2);
    const size_t hstepA = (size_t)HALF * g.lda * 2, hstepB = (size_t)HALF * g.ldb * 2;
    const unsigned ldsw = (unsigned)wid * 1024u;
    const int aoff = lds_byte(wr * 64 + fr, fq * 8), boff = lds_byte(wc * 32 + fr, fq * 8);
#define PG8_SA(b, h) (((b) * 2 + (h)) * HTB)
#define PG8_SB(b, h) ((4 + (b) * 2 + (h)) * HTB)
#define PG8_STAGE(bufoff, gbase, voff) do { _Pragma("unroll") for (int _i = 0; _i < 2; ++_i) \
        __builtin_amdgcn_global_load_lds((const unsigned*)((const char*)(gbase) + (voff)[_i]), (LAS unsigned*)(lds + (bufoff) + ldsw + _i * 8192), 16, 0, 0); } while (0)
#define PG8_STAGE_A(bufoff, gbase, h, nextsel) do { if constexpr (Sched::GATHER) { const unsigned _p = (nextsel) ? tkn[h] : tkc[h]; unsigned _v[2]; \
        _v[0] = (_p & 0xffffu) * (unsigned)(g.lda * 2) + gC; _v[1] = (_p >> 16) * (unsigned)(g.lda * 2) + gC; PG8_STAGE(bufoff, gbase, _v); } \
    else { PG8_STAGE(bufoff, (gbase) + ((h) ? hstepA : 0), voffA); } } while (0)
#define PG8_LDA(dst, b, h) do { _Pragma("unroll") for (int m = 0; m < 4; ++m) _Pragma("unroll") for (int k = 0; k < 2; ++k) dst[m][k] = *(const LAS bf16x8*)(lds + PG8_SA(b, h) + aoff + m * 2048 + k * 1024); } while (0)
#define PG8_LDB(dst, b, h) do { _Pragma("unroll") for (int n = 0; n < 2; ++n) _Pragma("unroll") for (int k = 0; k < 2; ++k) dst[n][k] = *(const LAS bf16x8*)(lds + PG8_SB(b, h) + boff + n * 2048 + k * 1024); } while (0)
#define PG8_MMA(ai, bj, At, Bt) do { __builtin_amdgcn_s_setprio(1); _Pragma("unroll") for (int m = 0; m < 4; ++m) _Pragma("unroll") for (int n = 0; n < 2; ++n) _Pragma("unroll") for (int k = 0; k < 2; ++k) \
        acc[ai][bj][m][n] = __builtin_amdgcn_mfma_f32_16x16x32_bf16(Bt[n][k], At[m][k], acc[ai][bj][m][n], 0, 0, 0); __builtin_amdgcn_s_setprio(0); } while (0)
#define PG8_WAIT_V(n) asm volatile("s_waitcnt vmcnt(" #n ")" ::: "memory")
#define PG8_WAIT_L(n) asm volatile("s_waitcnt lgkmcnt(" #n ")" ::: "memory")
#define PG8_BAR __builtin_amdgcn_s_barrier()
#define PG8_SCHED __builtin_amdgcn_sched_barrier(0)
    Unit cur, nxt; int ui = 0;
    if (!S.next(0, cur)) return;
    f32x4 acc[2][2][4][2];
#pragma unroll
    for (int a = 0; a < 2; ++a)
#pragma unroll
        for (int b = 0; b < 2; ++b)
#pragma unroll
            for (int m = 0; m < 4; ++m)
#pragma unroll
                for (int n = 0; n < 2; ++n) acc[a][b][m][n] = (f32x4){0.f, 0.f, 0.f, 0.f};
    bf16x8 At[4][2], B0[2][2], B1[2][2];
    const char* cA = S.a_base(cur); const char* cB = S.b_base(cur);
    unsigned tkc[2] = {0u, 0u}, tkn[2] = {0u, 0u};
    if constexpr (Sched::GATHER) { tkc[0] = S.tok2(cur, gR0); tkc[1] = S.tok2(cur, gR0 + HALF); }
    if constexpr (SP2) {
        PG8_STAGE(PG8_SB(0, 0), cB, voffB); PG8_STAGE(PG8_SB(0, 1), cB + hstepB, voffB); PG8_STAGE_A(PG8_SA(0, 0), cA, 0, false); PG8_STAGE_A(PG8_SA(0, 1), cA, 1, false);
        if (wr == 1) PG8_BAR;
        PG8_WAIT_V(2); PG8_BAR;
        PG8_STAGE(PG8_SB(1, 0), cB + kstep, voffB); PG8_STAGE_A(PG8_SA(1, 0), cA + kstep, 0, false); PG8_STAGE(PG8_SB(1, 1), cB + hstepB + kstep, voffB);
        PG8_WAIT_V(6); PG8_BAR;
    } else {
        PG8_STAGE(PG8_SB(0, 0), cB, voffB); PG8_STAGE_A(PG8_SA(0, 0), cA, 0, false); PG8_STAGE(PG8_SB(0, 1), cB + hstepB, voffB); PG8_STAGE_A(PG8_SA(0, 1), cA, 1, false);
        if (wr == 1) PG8_BAR;
        PG8_WAIT_V(4); PG8_BAR;
        PG8_STAGE(PG8_SB(1, 0), cB + kstep, voffB); PG8_STAGE_A(PG8_SA(1, 0), cA + kstep, 0, false); PG8_STAGE(PG8_SB(1, 1), cB + hstepB + kstep, voffB);
        PG8_WAIT_V(6); PG8_BAR;
    }
    for (;;) {
        const bool has_next = S.next(ui + 1, nxt);
        const char* nA = has_next ? S.a_base(nxt) : cA; const char* nB = has_next ? S.b_base(nxt) : cB;
        if constexpr (Sched::GATHER) { if (has_next) { tkn[0] = S.tok2(nxt, gR0); tkn[1] = S.tok2(nxt, gR0 + HALF); } else { tkn[0] = tkc[0]; tkn[1] = tkc[1]; } }
        for (int t = 0; t < nt; t += 2) {
            const bool last = (t == nt - 2);
            const char* a1 = cA + (size_t)(t + 1) * kstep;
            const char* a2 = last ? nA : cA + (size_t)(t + 2) * kstep; const char* b2 = last ? nB : cB + (size_t)(t + 2) * kstep;
            const char* a3 = a2 + kstep; const char* b3 = b2 + kstep;
            if constexpr (SP2) {
            PG8_LDB(B0, 0, 0); PG8_LDB(B1, 0, 1); PG8_SCHED; PG8_LDA(At, 0, 0); PG8_STAGE_A(PG8_SA(1, 1), a1, 1, false);
            PG8_WAIT_V(8); PG8_WAIT_L(0); PG8_BAR; PG8_MMA(0, 0, At, B0); PG8_MMA(0, 1, At, B1); PG8_BAR; PG8_SCHED;
            PG8_LDA(At, 0, 1); PG8_STAGE(PG8_SB(0, 0), b2, voffB); PG8_STAGE(PG8_SB(0, 1), b2 + hstepB, voffB); PG8_STAGE_A(PG8_SA(0, 0), a2, 0, last);
            PG8_WAIT_V(8); PG8_WAIT_L(0); PG8_BAR; PG8_MMA(1, 0, At, B0); PG8_MMA(1, 1, At, B1); PG8_BAR; PG8_SCHED;
            PG8_LDB(B0, 1, 0); PG8_LDB(B1, 1, 1); PG8_SCHED; PG8_LDA(At, 1, 0); PG8_STAGE_A(PG8_SA(0, 1), a2, 1, last);
            PG8_WAIT_V(8); PG8_WAIT_L(0); PG8_BAR; PG8_MMA(0, 0, At, B0); PG8_MMA(0, 1, At, B1); PG8_BAR; PG8_SCHED;
            PG8_LDA(At, 1, 1); PG8_STAGE(PG8_SB(1, 0), b3, voffB); PG8_STAGE(PG8_SB(1, 1), b3 + hstepB, voffB); PG8_STAGE_A(PG8_SA(1, 0), a3, 0, last);
            PG8_WAIT_V(8); PG8_WAIT_L(0); PG8_BAR; PG8_MMA(1, 0, At, B0); PG8_MMA(1, 1, At, B1); PG8_BAR; PG8_SCHED;
            } else {
            PG8_LDB(B0, 0, 0); PG8_SCHED; PG8_LDA(At, 0, 0); PG8_STAGE_A(PG8_SA(1, 1), a1, 1, false);
            PG8_WAIT_L(8); PG8_BAR; PG8_WAIT_L(0); PG8_MMA(0, 0, At, B0); PG8_BAR; PG8_SCHED;
            PG8_LDB(B1, 0, 1); PG8_STAGE(PG8_SB(0, 0), b2, voffB);
            PG8_BAR; PG8_WAIT_L(0); PG8_MMA(0, 1, At, B1); PG8_BAR;
            PG8_LDA(At, 0, 1); PG8_STAGE_A(PG8_SA(0, 0), a2, 0, last);
            PG8_BAR; PG8_WAIT_L(0); PG8_MMA(1, 0, At, B0); PG8_BAR; PG8_SCHED;
            PG8_STAGE(PG8_SB(0, 1), b2 + hstepB, voffB);
            PG8_WAIT_V(6); PG8_BAR; PG8_MMA(1, 1, At, B1); PG8_BAR;
            PG8_LDB(B0, 1, 0); PG8_SCHED; PG8_LDA(At, 1, 0); PG8_STAGE_A(PG8_SA(0, 1), a2, 1, last);
            PG8_WAIT_L(8); PG8_BAR; PG8_WAIT_L(0); PG8_MMA(0, 0, At, B0); PG8_BAR; PG8_SCHED;
            PG8_LDB(B1, 1, 1); PG8_STAGE(PG8_SB(1, 0), b3, voffB);
            PG8_BAR; PG8_WAIT_L(0); PG8_MMA(0, 1, At, B1); PG8_BAR;
            PG8_LDA(At, 1, 1); PG8_STAGE_A(PG8_SA(1, 0), a3, 0, last);
            PG8_BAR; PG8_WAIT_L(0); PG8_MMA(1, 0, At, B0); PG8_BAR; PG8_SCHED;
            PG8_STAGE(PG8_SB(1, 1), b3 + hstepB, voffB);
            PG8_WAIT_V(6); PG8_BAR; PG8_MMA(1, 1, At, B1); PG8_BAR;
            }
        }
        if constexpr (ALIGN_EPI) { if (wr == 0) PG8_BAR; }
        { const int lane2 = my_lane();
          E(acc, cur, wid >> 2, wid & 3, lane2 & 15, lane2 >> 4); }
        if (!has_next) break;
        if (!Epi::keep_acc(cur)) {
#pragma unroll
        for (int a = 0; a < 2; ++a)
#pragma unroll
            for (int b = 0; b < 2; ++b)
#pragma unroll
                for (int m = 0; m < 4; ++m)
#pragma unroll
                    for (int n = 0; n < 2; ++n) acc[a][b][m][n] = (f32x4){0.f, 0.f, 0.f, 0.f};
        }
        cur = nxt; cA = nA; cB = nB; ++ui; tkc[0] = tkn[0]; tkc[1] = tkn[1];
        if constexpr (ALIGN_EPI) { if (wr == 1) PG8_BAR; }
    }
    PG8_WAIT_V(0);
    if constexpr (!ALIGN_EPI) { if (wr == 0) PG8_BAR; }
    PG8_BAR;
#undef PG8_SA
#undef PG8_SB
#undef PG8_STAGE
#undef PG8_STAGE_A
#undef PG8_LDA
#undef PG8_LDB
#undef PG8_MMA
#undef PG8_WAIT_V
#undef PG8_WAIT_L
#undef PG8_BAR
#undef PG8_SCHED
}
}
using pg8::Unit;

struct Args { const float* in[50]; float* out; unsigned char* ws; int ph_lo, ph_hi; };
typedef const __attribute__((address_space(4))) Args KArgs;
__device__ __forceinline__ KArgs* kargs() { KArgs* p = (KArgs*)__builtin_amdgcn_kernarg_segment_ptr(); asm volatile("" : "+s"(p)); return p; }
__device__ __forceinline__ unsigned char* launder_p(unsigned char* p) { asm volatile("" : "+s"(p)); return (unsigned char*)(GAS unsigned char*)p; }
__device__ __forceinline__ const float* kin(KArgs& A, int i) { return (const float*)(const GAS float*)A.in[i]; }
__device__ __forceinline__ float* kout(KArgs& A) { return (float*)(GAS float*)A.out; }
__device__ __forceinline__ unsigned char* kws(KArgs& A) { return (unsigned char*)(GAS unsigned char*)A.ws; }
__device__ __forceinline__ int launder_i(int v) { asm volatile("" : "+s"(v)); return v; }
__device__ __forceinline__ int launder_v(int v) { asm volatile("" : "+v"(v)); return v; }
enum { I_X = 0, I_MEM, I_LN_IN_G, I_LN_IN_B, I_W_IN, I_CONV_W, I_SG_NG, I_SG_NB, I_SG_W, I_SG_B, I_RW_MU, I_RW_W0, I_RW_WUP, I_RW_A0, I_RW_AUP, I_RW_GUP,
       I_RW_KK, I_RW_KA, I_RW_RK, I_RW_LNG, I_RW_LNB, I_S5_ARE, I_S5_AIM, I_S5_BRE, I_S5_BIM, I_S5_CRE, I_S5_CIM, I_S5_D, I_S5_LOGDT, I_S5_GLUW, I_S5_GLUB,
       I_BR_PROJ, I_GATE_B, I_W_OUT, I_LN1_G, I_LN1_B, I_XA_WQ, I_XA_WK, I_XA_WV, I_XA_WO, I_LN2_G, I_LN2_B, I_ROUTER_W, I_ROUTER_B, I_EX_W1, I_EX_B1, I_EX_W2, I_EX_B2,
       I_LN3_G, I_LN3_B };
struct Frame { LAS unsigned char* lds; volatile LAS unsigned* MISC; unsigned* ctl; unsigned char* ws; int tid, lane, wave, G, bid; };
constexpr int MI_TOFF = 16, MI_HIST = 64, MI_LBASE = 96, MI_LCUR = 128;

__device__ __forceinline__ void ln_stats(const f32x4 (&v)[4], float& mean, float& rstd) {
    float s = 0.f;
#pragma unroll
    for (int j = 0; j < 4; ++j) s += (v[j].x + v[j].y) + (v[j].z + v[j].w);
    mean = wave_sum(s) * (1.f / D); float s2 = 0.f;
#pragma unroll
    for (int j = 0; j < 4; ++j) { const f32x4 d = v[j] - mean; s2 += (d.x * d.x + d.y * d.y) + (d.z * d.z + d.w * d.w); }
    rstd = 1.0f / sqrtf(wave_sum(s2) * (1.f / D) + LN_EPS);
}
__device__ __forceinline__ void ln_apply_store(const f32x4 (&v)[4], float mean, float rstd, const float* g, const float* b, float* o32, bf16* o16, int lane) {
#pragma unroll
    for (int j = 0; j < 4; ++j) {
        const f32x4 gg = *(const f32x4*)(g + 256 * j + 4 * lane), bb = *(const f32x4*)(b + 256 * j + 4 * lane);
        const f32x4 y = (v[j] - mean) * rstd * gg + bb;
        if (o32) *(f32x4*)(o32 + 256 * j + 4 * lane) = y;
        if (o16) { v2u w; w.x = pk2(y.x, y.y); w.y = pk2(y.z, y.w); *(v2u*)(o16 + 256 * j + 4 * lane) = w; }
    }
}

__device__ __forceinline__ void transpose_item(const float* W, int K, int N, bf16* WT, int mode, LAS float* scr, int item, int lane) {
    const int nblk = N / 32, kb = item / nblk, nb = item % nblk, k0 = 64 * kb, n0 = 32 * nb;
    { float tv[32]; const float* wp = W + (size_t)(k0 + (lane >> 5)) * N + n0 + (lane & 31);
#pragma unroll
      for (int i = 0; i < 32; ++i) tv[i] = wp[(size_t)(2 * i) * N];
#pragma unroll
      for (int i = 0; i < 32; ++i) scr[(2 * i + (lane >> 5)) * 33 + (lane & 31)] = tv[i]; }
    LDS_WAIT();
    const int c = lane & 7;
#pragma unroll
    for (int j = 0; j < 4; ++j) { const int n = (lane >> 3) + 8 * j; const LAS float* s = scr + (8 * c) * 33 + n;
        v4u o; o.x = pk2(s[0 * 33], s[1 * 33]); o.y = pk2(s[2 * 33], s[3 * 33]); o.z = pk2(s[4 * 33], s[5 * 33]); o.w = pk2(s[6 * 33], s[7 * 33]);
        const int nn = n0 + n; const int jj = nn >> 1;
        const int row = mode ? ((jj >> 7) * 256 + (nn & 1) * 128 + (jj & 127)) : nn;
        *(v4u*)(WT + (size_t)row * K + k0 + 8 * c) = o; }
    LDS_WAIT();
}
__device__ __forceinline__ void s5_setup_item(KArgs& A, const Frame& F, int item) {
    const int l = item >> 4, g = item & 15, tid = F.tid;
    LAS float* Kt = (LAS float*)F.lds;
    LAS float* Pw = (LAS float*)(F.lds + 65536);
    LAS float* Bb = (LAS float*)(F.lds + 65536 + 33280);
    LAS float* Cc = Bb + 2048;
    const float* a_re = kin(A, I_S5_ARE) + (l * 16 + g) * 64; const float* a_im = kin(A, I_S5_AIM) + (l * 16 + g) * 64;
    const float* b_re = kin(A, I_S5_BRE) + (size_t)(l * 16 + g) * 1024; const float* b_im = kin(A, I_S5_BIM) + (size_t)(l * 16 + g) * 1024;
    const float* c_re = kin(A, I_S5_CRE) + (size_t)(l * 16 + g) * 1024; const float* c_im = kin(A, I_S5_CIM) + (size_t)(l * 16 + g) * 1024;
    const float dt = expf(kin(A, I_S5_LOGDT)[l * 16 + g]);
    for (int o = tid; o < 65 * 64; o += NTHREADS) { const int n = o >> 6, p = o & 63; const float mag = expf(a_re[p] * dt * (float)n); float sn, cs; sincosf(a_im[p] * dt * (float)n, &sn, &cs);
        Pw[o * 2] = mag * cs; Pw[o * 2 + 1] = mag * sn; }
    for (int o = tid; o < 1024; o += NTHREADS) { const int p = o >> 4;
        const float are = a_re[p], aim = a_im[p], mag = expf(are * dt); float sn, cs; sincosf(aim * dt, &sn, &cs); const float abr = mag * cs, abi = mag * sn;
        const float den = are * are + aim * aim, nr = abr - 1.0f, cr = (nr * are + abi * aim) / den, ci = (abi * are - nr * aim) / den;
        const float br = b_re[o], bi = b_im[o]; Bb[o * 2] = cr * br - ci * bi; Bb[o * 2 + 1] = cr * bi + ci * br; }
    for (int o = tid; o < 1024; o += NTHREADS) { Cc[o * 2] = c_re[o]; Cc[o * 2 + 1] = c_im[o]; }
    __syncthreads();
    for (int o = tid; o < 16384; o += NTHREADS) { const int tau = o >> 8, c = (o >> 4) & 15, cp = o & 15; float acc = 0.f;
        for (int p = 0; p < 64; ++p) { const float cr = Cc[(c * 64 + p) * 2], ci = Cc[(c * 64 + p) * 2 + 1], pr = Pw[(tau * 64 + p) * 2], pi = Pw[(tau * 64 + p) * 2 + 1];
            const float er = cr * pr - ci * pi, ei = cr * pi + ci * pr; acc += er * Bb[(p * 16 + cp) * 2] - ei * Bb[(p * 16 + cp) * 2 + 1]; }
        Kt[o] = acc; }
    __syncthreads();
    bf16* Bt = (bf16*)(F.ws + WS_S5BT) + (size_t)(l * 16 + g) * 1024 * S5K;
    for (int o = tid; o < 1024 * 128; o += NTHREADS) { const int rr = o >> 7, q = o & 127, t = rr >> 4, c = rr & 15, s = q >> 1, cp0 = (q & 1) * 8;
        v4u w = {0u, 0u, 0u, 0u};
        if (s <= t) { const LAS float* k = Kt + ((t - s) * 16 + c) * 16 + cp0; w.x = pk2(k[0], k[1]); w.y = pk2(k[2], k[3]); w.z = pk2(k[4], k[5]); w.w = pk2(k[6], k[7]); }
        *(v4u*)(Bt + (size_t)rr * S5K + q * 8) = w; }
    for (int o = tid; o < 1024 * 16; o += NTHREADS) { const int rr = o >> 4, q = o & 15, t = rr >> 4, c = rr & 15; float vals[8];
#pragma unroll
        for (int j = 0; j < 4; ++j) { const int p = 4 * q + j; const float cr = Cc[(c * 64 + p) * 2], ci = Cc[(c * 64 + p) * 2 + 1], pr = Pw[((t + 1) * 64 + p) * 2], pi = Pw[((t + 1) * 64 + p) * 2 + 1];
            vals[2 * j] = cr * pr - ci * pi; vals[2 * j + 1] = -(cr * pi + ci * pr); }
        v4u w; w.x = pk2(vals[0], vals[1]); w.y = pk2(vals[2], vals[3]); w.z = pk2(vals[4], vals[5]); w.w = pk2(vals[6], vals[7]);
        *(v4u*)(Bt + (size_t)rr * S5K + 1024 + q * 8) = w; }
    bf16* Bc = (bf16*)(F.ws + WS_S5BC) + (size_t)(l * 16 + g) * 256 * 1024;
    for (int o = tid; o < 128 * 128; o += NTHREADS) { const int row = o >> 7, q = o & 127, p = row >> 1, im = row & 1, s = q >> 1, cp0 = (q & 1) * 8;
        const float pr = Pw[((63 - s) * 64 + p) * 2], pi = Pw[((63 - s) * 64 + p) * 2 + 1]; float vals[8];
#pragma unroll
        for (int j = 0; j < 8; ++j) { const float br = Bb[(p * 16 + cp0 + j) * 2], bi = Bb[(p * 16 + cp0 + j) * 2 + 1]; vals[j] = im ? (pr * bi + pi * br) : (pr * br - pi * bi); }
        v4u w; w.x = pk2(vals[0], vals[1]); w.y = pk2(vals[2], vals[3]); w.z = pk2(vals[4], vals[5]); w.w = pk2(vals[6], vals[7]);
        *(v4u*)(Bc + (size_t)row * 1024 + q * 8) = w;
        *(v4u*)(Bc + (size_t)(128 + row) * 1024 + q * 8) = (v4u){0u, 0u, 0u, 0u}; }
    __syncthreads();
}
__device__ __forceinline__ void p_prologue(KArgs& A, const Frame& F) {
    const int gw = F.bid * NWAVES + F.wave, NGW = F.G * NWAVES, lane = F.lane;
    for (int item = F.bid; item < NL * 16; item += F.G) s5_setup_item(A, F, item);
    LAS float* scr = (LAS float*)(F.lds + F.wave * 16384);
#pragma unroll 1
    for (int d = 0; d < 10; ++d) {
        const float* src; bf16* dst; int K, N, batch, mode = 0;
        switch (d) {
            case 0: src = kin(A, I_EX_W1); dst = (bf16*)(F.ws + WS_W1T); K = 1024; N = 2048; batch = NL * NE; mode = 1; break;
            case 1: src = kin(A, I_EX_W2); dst = (bf16*)(F.ws + WS_W2T); K = 1024; N = 1024; batch = NL * NE; break;
            case 2: src = kin(A, I_W_IN); dst = (bf16*)(F.ws + WS_WINT); K = 1024; N = N_IN; batch = NL; break;
            case 3: src = kin(A, I_BR_PROJ); dst = (bf16*)(F.ws + WS_BRT); K = 256; N = 1024; batch = NL * 4; break;
            case 4: src = kin(A, I_W_OUT); dst = (bf16*)(F.ws + WS_WOUTT); K = 1024; N = 1024; batch = NL; break;
            case 5: src = kin(A, I_XA_WQ); dst = (bf16*)(F.ws + WS_WQT); K = 1024; N = 1024; batch = NL; break;
            case 6: src = kin(A, I_XA_WK); dst = (bf16*)(F.ws + WS_WKT); K = 1024; N = 1024; batch = NL; break;
            case 7: src = kin(A, I_XA_WV); dst = (bf16*)(F.ws + WS_WVT); K = 1024; N = 1024; batch = NL; break;
            case 8: src = kin(A, I_XA_WO); dst = (bf16*)(F.ws + WS_WOT); K = 1024; N = 1024; batch = NL; break;
            default: src = kin(A, I_S5_GLUW); dst = (bf16*)(F.ws + WS_GLUT); K = 256; N = 256; batch = NL; break;
        }
        const int per = (K / 64) * (N / 32), nitems = per * batch;
        for (int it = gw; it < nitems; it += NGW) { const int b = it / per, r = it - b * per;
            transpose_item(src + (size_t)b * K * N, K, N, dst + (size_t)b * K * N, mode, scr, r, lane); }
    }
    { bf16* lwt = (bf16*)(F.ws + WS_LWT);
      for (int it = gw * 64 + lane; it < NL * 768 * 32; it += NGW * 64) { const int kc = it & 31, row = (it >> 5) % 768, ll = it / (768 * 32), blk = row >> 8, c = row & 255, k0 = kc * 8; float v[8];
#pragma unroll
          for (int j = 0; j < 8; ++j) { const int k = k0 + j; float x = 0.f;
              if (blk == 0 && k < 64) x = kin(A, I_RW_WUP)[((size_t)ll * 64 + k) * 256 + c];
              else if (blk == 1 && k >= 64 && k < 128) x = kin(A, I_RW_AUP)[((size_t)ll * 64 + (k - 64)) * 256 + c];
              else if (blk == 2 && k >= 128) x = kin(A, I_RW_GUP)[((size_t)ll * 128 + (k - 128)) * 256 + c];
              v[j] = x; }
          v4u w; w.x = pk2(v[0], v[1]); w.y = pk2(v[2], v[3]); w.z = pk2(v[4], v[5]); w.w = pk2(v[6], v[7]);
          *(v4u*)(lwt + ((size_t)ll * 768 + row) * 256 + k0) = w; } }
    { bf16* sgw = (bf16*)(F.ws + WS_SGW); const float* src = kin(A, I_SG_W);
      for (int it = gw * 64 + lane; it < NL * 4 * 128 * 16; it += NGW * 64) { const int j0 = (it & 15) * 8, i = (it >> 4) & 127; const float* sp = src + (size_t)(it >> 4) * 128 + j0; float v[8];
#pragma unroll
          for (int e = 0; e < 8; ++e) v[e] = ((j0 + e) >> 6) <= (i >> 6) ? sp[e] : 0.f;
          v4u w; w.x = pk2(v[0], v[1]); w.y = pk2(v[2], v[3]); w.z = pk2(v[4], v[5]); w.w = pk2(v[6], v[7]); *(v4u*)(sgw + (size_t)(it >> 4) * 128 + j0) = w; } }
    { const float* mem = kin(A, I_MEM); bf16* m16 = (bf16*)(F.ws + WS_MEM16);
      for (int r = gw; r < NB * NMEM; r += NGW) {
#pragma unroll
          for (int j = 0; j < 4; ++j) { const f32x4 v = *(const f32x4*)(mem + (size_t)r * D + 256 * j + 4 * lane); v2u w; w.x = pk2(v.x, v.y); w.y = pk2(v.z, v.w); *(v2u*)(m16 + (size_t)r * D + 256 * j + 4 * lane) = w; } } }
    { const float* x = kin(A, I_X); float* h32 = nullptr; bf16* h16 = (bf16*)(F.ws + WS_H16);
      for (int r0 = gw * 2; r0 < T; r0 += NGW * 2) { f32x4 v[2][4];
#pragma unroll
          for (int i = 0; i < 2; ++i)
#pragma unroll
              for (int j = 0; j < 4; ++j) v[i][j] = *(const f32x4*)(x + (size_t)(r0 + i) * D + 256 * j + 4 * lane);
#pragma unroll
          for (int i = 0; i < 2; ++i) { float mean, rstd; ln_stats(v[i], mean, rstd);
              ln_apply_store(v[i], mean, rstd, kin(A, I_LN_IN_G), kin(A, I_LN_IN_B), h32, h16 + (size_t)(r0 + i) * D, lane); } } }
}

typedef f32x4 AccT[2][2][4][2];
#define EPI_BASES KArgs& KA = *kargs(); unsigned char* ws = kws(KA); (void)ws;
__device__ __forceinline__ v4u pk8(const f32x4 a, const f32x4 b) { v4u w; w.x = pk2(a.x, a.y); w.y = pk2(a.z, a.w); w.z = pk2(b.x, b.y); w.w = pk2(b.z, b.w); return w; }
__device__ __forceinline__ void unpk8(const v4u w, f32x4& a, f32x4& b) { a.x = bf2f(w.x & 0xffffu); a.y = bf2f(w.x >> 16); a.z = bf2f(w.y & 0xffffu); a.w = bf2f(w.y >> 16); b.x = bf2f(w.z & 0xffffu); b.y = bf2f(w.z >> 16); b.z = bf2f(w.w & 0xffffu); b.w = bf2f(w.w >> 16); }
__device__ __forceinline__ f32x4 ld4bf(const bf16* p) { const v2u w = *(const v2u*)p; f32x4 a; a.x = bf2f(w.x & 0xffffu); a.y = bf2f(w.x >> 16); a.z = bf2f(w.y & 0xffffu); a.w = bf2f(w.y >> 16); return a; }
__device__ __forceinline__ f32x4 sig4(const f32x4 v) { return (f32x4){sigmoidf_(v.x), sigmoidf_(v.y), sigmoidf_(v.z), sigmoidf_(v.w)}; }
struct EpiNull { static constexpr bool PERM = false; static __device__ __forceinline__ bool keep_acc(const Unit&) { return false; } int dummy;
    __device__ __forceinline__ void operator()(const AccT& acc, const Unit& u, int wr, int wc, int fr, int fq) const { f32x4 t = {0, 0, 0, 0};
#pragma unroll
        for (int a = 0; a < 2; ++a)
#pragma unroll
            for (int b = 0; b < 2; ++b)
#pragma unroll
                for (int m = 0; m < 4; ++m) { t += acc[a][b][m][0]; t += acc[a][b][m][1]; }
        if (t.x + t.y + t.z + t.w == 1234.5f) { EPI_BASES *(f32x4*)(ws + WS_END) = t; } } };
struct EpiIn { static constexpr bool PERM = true; static __device__ __forceinline__ bool keep_acc(const Unit&) { return false; } int l;
    __device__ __forceinline__ void operator()(const AccT& acc, const Unit& u, int wr, int wc, int fr, int fq) const { EPI_BASES
        bf16* Z = (bf16*)(ws + WS_Z); bf16* SG = (bf16*)(ws + WS_SG); bf16* AOUT = (bf16*)(ws + WS_AOUT); const float* gate_b = kin(KA, I_GATE_B) + (size_t)l * 4096;
        if (u.pn < 10) {
            pg8::epi_foreach8(acc, u, wr, wc, fr, fq, [&](int row, int col, f32x4 v0, f32x4 v1) { const v4u w = pk8(v0, v1);
                *(v4u*)(Z + (size_t)row * ZLD + col) = w;
                if (u.pn == 9) { const int cc = col - OFF_D, g = cc >> 4, c0 = cc & 15, chunk = row >> 6, s = row & 63; *(v4u*)(AOUT + ((size_t)(g * NCHT + chunk)) * S5K + s * 16 + c0) = w; } });
        } else {
            pg8::epi_foreach8(acc, u, wr, wc, fr, fq, [&](int row, int col, f32x4 v0, f32x4 v1) {
                const int gc = col - OFF_G; const f32x4 g0 = *(const f32x4*)(gate_b + gc), g1 = *(const f32x4*)(gate_b + gc + 4);
                *(v4u*)(SG + (size_t)row * 4096 + gc) = pk8(sig4(v0 + g0), sig4(v1 + g1)); });
        }
    } };
struct EpiBranch { static constexpr bool PERM = true; int dummy;
    static __device__ __forceinline__ bool keep_acc(const Unit& u) { return u.e < 3; }
    __device__ __forceinline__ void operator()(AccT& acc, const Unit& u, int wr, int wc, int fr, int fq) const { EPI_BASES const int br = u.e;
        bf16* MG = (bf16*)(ws + WS_MG16); const bf16* SG = (const bf16*)(ws + WS_SG);
#pragma unroll
        for (int ai = 0; ai < 2; ++ai)
#pragma unroll
            for (int m = 0; m < 4; ++m) { const int row = u.pm * 256 + ai * 128 + wr * 64 + m * 16 + fr;
#pragma unroll
                for (int bj = 0; bj < 2; ++bj) { const int col = u.pn * 256 + bj * 128 + wc * 32 + 8 * fq; const bf16* sp = SG + (size_t)row * 4096 + br * 1024 + col;
                    f32x4 n0, n1; unpk8(*(const v4u*)sp, n0, n1);
#pragma unroll
                    for (int e = 0; e < 4; ++e) { n0[e] = fmaxf(n0[e], 1e-6f); n1[e] = fmaxf(n1[e], 1e-6f); }
                    if (br < 3) { f32x4 d0, d1; unpk8(*(const v4u*)(sp + 1024), d0, d1);
#pragma unroll
                        for (int e = 0; e < 4; ++e) { acc[ai][bj][m][0][e] *= n0[e] * __builtin_amdgcn_rcpf(fmaxf(d0[e], 1e-6f)); acc[ai][bj][m][1][e] *= n1[e] * __builtin_amdgcn_rcpf(fmaxf(d1[e], 1e-6f)); }
                    } else *(v4u*)(MG + (size_t)row * D + col) = pk8(acc[ai][bj][m][0] * n0, acc[ai][bj][m][1] * n1); }
                if (m == 3) __builtin_amdgcn_sched_barrier(0); }
    } };
struct EpiResid { static constexpr bool PERM = true; static __device__ __forceinline__ bool keep_acc(const Unit&) { return false; } int dummy;
    __device__ __forceinline__ void operator()(const AccT& acc, const Unit& u, int wr, int wc, int fr, int fq) const { EPI_BASES
        const bf16* H = (const bf16*)(ws + WS_H16); bf16* P = (bf16*)(ws + WS_PRE16);
        pg8::epi_foreach8(acc, u, wr, wc, fr, fq, [&](int row, int col, f32x4 v0, f32x4 v1) { f32x4 h0, h1; unpk8(*(const v4u*)(H + (size_t)row * D + col), h0, h1);
            *(v4u*)(P + (size_t)row * D + col) = pk8(h0 * DN_ALPHA + v0, h1 * DN_ALPHA + v1); });
    } };
struct EpiBf16 { static constexpr bool PERM = true; static __device__ __forceinline__ bool keep_acc(const Unit&) { return false; } unsigned off_mib; float scale;
    __device__ __forceinline__ void operator()(const AccT& acc, const Unit& u, int wr, int wc, int fr, int fq) const { EPI_BASES
        bf16* O = (bf16*)(ws + (size_t)off_mib * MiB);
        pg8::epi_foreach8(acc, u, wr, wc, fr, fq, [&](int row, int col, f32x4 v0, f32x4 v1) { *(v4u*)(O + (size_t)row * D + col) = pk8(v0 * scale, v1 * scale); });
    } };
struct EpiVT { static constexpr bool PERM = false; static __device__ __forceinline__ bool keep_acc(const Unit&) { return false; } int dummy;
    __device__ __forceinline__ void operator()(const AccT& acc, const Unit& u, int wr, int wc, int fr, int fq) const { EPI_BASES
        bf16* VT = (bf16*)(ws + WS_VMT16);
        pg8::epi_foreach(acc, u, wr, wc, fr, fq, [&](int row, int col, f32x4 v) { const int b = row >> 8, m = row & 255; bf16* p = VT + ((size_t)(b * D + col)) * NMEM + m;
            p[0] = (bf16)f2bf(v.x); p[NMEM] = (bf16)f2bf(v.y); p[2 * NMEM] = (bf16)f2bf(v.z); p[3 * NMEM] = (bf16)f2bf(v.w); });
    } };
struct EpiXloc { static constexpr bool PERM = false; static __device__ __forceinline__ bool keep_acc(const Unit&) { return false; } int dummy;
    __device__ __forceinline__ void operator()(const AccT& acc, const Unit& u, int wr, int wc, int fr, int fq) const { EPI_BASES
        float* X = (float*)(ws + WS_XLOC);
        pg8::epi_foreach(acc, u, wr, wc, fr, fq, [&](int row, int col, f32x4 v) { if (col < 128) *(f32x4*)(X + ((size_t)(u.e * NCHT + row)) * 128 + col) = v; });
    } };
struct EpiLora { static constexpr bool PERM = false; static __device__ __forceinline__ bool keep_acc(const Unit&) { return false; } int l;
    __device__ __forceinline__ void operator()(const AccT& acc, const Unit& u, int wr, int wc, int fr, int fq) const { EPI_BASES
        if (u.pn == 0) { float* DEC = (float*)(ws + WS_DEC); const float* w0 = kin(KA, I_RW_W0) + l * 256;
            pg8::epi_foreach(acc, u, wr, wc, fr, fq, [&](int row, int col, f32x4 v) { const f32x4 wp = v + *(const f32x4*)(w0 + col); f32x4 o;
#pragma unroll
                for (int e = 0; e < 4; ++e) { const float sp = log1pf(__expf(-wp[e])); o[e] = __expf(-__expf(-sp - 0.5f)); }
                *(f32x4*)(DEC + (size_t)row * 256 + col) = o; });
        } else if (u.pn == 1) { float* AV = (float*)(ws + WS_AV); const float* a0 = kin(KA, I_RW_A0) + l * 256;
            pg8::epi_foreach(acc, u, wr, wc, fr, fq, [&](int row, int col, f32x4 v) { const int c = col - 256; *(f32x4*)(AV + (size_t)row * 256 + c) = sig4(v + *(const f32x4*)(a0 + c)); });
        } else { float* G = (float*)(ws + WS_RWG);
            pg8::epi_foreach(acc, u, wr, wc, fr, fq, [&](int row, int col, f32x4 v) { *(f32x4*)(G + (size_t)row * 256 + col - 512) = v; });
        }
    } };
__device__ __forceinline__ float gelu_tanh(float x) { const float u = 0.7978845608028654f * (x + 0.044715f * x * x * x); const float e = __expf(2.0f * u); const float th = 1.0f - 2.0f * __builtin_amdgcn_rcpf(e + 1.0f); return 0.5f * x * (1.0f + th); }
__device__ __forceinline__ f32x4 gelu4(const f32x4 v) { return (f32x4){gelu_tanh(v.x), gelu_tanh(v.y), gelu_tanh(v.z), gelu_tanh(v.w)}; }
struct EpiS5Y { static constexpr bool PERM = true; static __device__ __forceinline__ bool keep_acc(const Unit&) { return false; } int l;
    __device__ __forceinline__ void operator()(const AccT& acc, const Unit& u, int wr, int wc, int fr, int fq) const { EPI_BASES
        bf16* YD = (bf16*)(ws + WS_YD16); const bf16* AOUT = (const bf16*)(ws + WS_AOUT); const float* dvec = kin(KA, I_S5_D) + l * 256;
        pg8::epi_foreach8(acc, u, wr, wc, fr, fq, [&](int row, int col, f32x4 v0, f32x4 v1) { const int t = col >> 4, c0 = col & 15, tok = row * CH + t, ch = u.e * 16 + c0;
            f32x4 u0, u1; unpk8(*(const v4u*)(AOUT + ((size_t)(u.e * NCHT + row)) * S5K + t * 16 + c0), u0, u1);
            const f32x4 d0 = *(const f32x4*)(dvec + ch), d1 = *(const f32x4*)(dvec + ch + 4);
            *(v4u*)(YD + (size_t)tok * 256 + ch) = pk8(gelu4(v0 + d0 * u0), gelu4(v1 + d1 * u1)); });
    } };
struct EpiGlu { static constexpr bool PERM = true; static __device__ __forceinline__ bool keep_acc(const Unit&) { return false; } int l;
    __device__ __forceinline__ void operator()(const AccT& acc, const Unit& u, int wr, int wc, int fr, int fq) const { EPI_BASES
        bf16* O = (bf16*)(ws + WS_O16); const bf16* YD = (const bf16*)(ws + WS_YD16); const float* gb = kin(KA, I_S5_GLUB) + l * 256;
        pg8::epi_foreach8(acc, u, wr, wc, fr, fq, [&](int row, int col, f32x4 v0, f32x4 v1) { f32x4 y0, y1; unpk8(*(const v4u*)(YD + (size_t)row * 256 + col), y0, y1);
            const f32x4 b0 = *(const f32x4*)(gb + col), b1 = *(const f32x4*)(gb + col + 4);
            *(v4u*)(O + (size_t)row * D + 768 + col) = pk8(y0 * sig4(v0 + b0), y1 * sig4(v1 + b1)); });
    } };
__device__ __forceinline__ float swiglu(float g, float u) { g = fminf(g, 7.0f); u = fminf(fmaxf(u, -7.0f), 7.0f); return (u + 1.0f) * g * sigmoidf_(1.702f * g); }
struct EpiSwiglu { static constexpr bool PERM = true; static __device__ __forceinline__ bool keep_acc(const Unit&) { return false; } int l;
    __device__ __forceinline__ void operator()(const AccT& acc, const Unit& u, int wr, int wc, int fr, int fq) const { EPI_BASES
        bf16* ACT = (bf16*)(ws + WS_ACT); const float* bb = kin(KA, I_EX_B1) + (size_t)(l * NE + u.e) * 2048;
#pragma unroll
        for (int ai = 0; ai < 2; ++ai)
#pragma unroll
            for (int m = 0; m < 4; ++m) { const int row = u.pm * 256 + ai * 128 + wr * 64 + m * 16 + fr; const int j = u.pn * 128 + wc * 32 + 8 * fq;
                f32x4 o[2];
#pragma unroll
                for (int n = 0; n < 2; ++n) { const f32x4 b0 = *(const f32x4*)(bb + 2 * (j + 4 * n)), b1v = *(const f32x4*)(bb + 2 * (j + 4 * n) + 4);
                    const f32x4 g = acc[ai][0][m][n], uu = acc[ai][1][m][n];
                    o[n] = (f32x4){swiglu(g.x + b0.x, uu.x + b0.y), swiglu(g.y + b0.z, uu.y + b0.w), swiglu(g.z + b1v.x, uu.z + b1v.y), swiglu(g.w + b1v.z, uu.w + b1v.w)}; }
                *(v4u*)(ACT + (size_t)row * DFF + j) = pk8(o[0], o[1]);
                if (m == 3) __builtin_amdgcn_sched_barrier(0); }
    } };
struct EpiMoeOut { static constexpr bool PERM = true; static __device__ __forceinline__ bool keep_acc(const Unit&) { return false; } int l;
    __device__ __forceinline__ void operator()(const AccT& acc, const Unit& u, int wr, int wc, int fr, int fq) const { EPI_BASES
        bf16* YS = (bf16*)(ws + WS_YS); const float* SLOTW = (const float*)(ws + WS_SLOTW); const int* SDST = (const int*)(ws + WS_SDST); const float* bb = kin(KA, I_EX_B2) + (size_t)(l * NE + u.e) * D;
        pg8::epi_foreach8(acc, u, wr, wc, fr, fq, [&](int srow, int col, f32x4 v0, f32x4 v1) { const float sw = SLOTW[srow]; const int row = SDST[srow];        const f32x4 b0 = *(const f32x4*)(bb + col), b1 = *(const f32x4*)(bb + col + 4);
            *(v4u*)(YS + (size_t)row * D + col) = pk8((v0 + b0) * sw, (v1 + b1) * sw); });
    } };

__device__ __forceinline__ void p_mix1(KArgs& A, const Frame& F, int l) {
    const int gw = F.bid * NWAVES + F.wave, NGW = F.G * NWAVES, lane = F.lane, tid = F.tid;
    const bf16* Z = (const bf16*)(F.ws + WS_Z); bf16* O16 = (bf16*)(F.ws + WS_O16);
    for (int rp_ = 0; rp_ < ((PROBE_PHASE == 101) ? PROBE_REPS : 1); ++rp_) { const float* cw = kin(A, I_CONV_W) + l * 3 * 256; const f32x4 w0 = *(const f32x4*)(cw + 4 * lane), w1 = *(const f32x4*)(cw + 256 + 4 * lane), w2 = *(const f32x4*)(cw + 512 + 4 * lane);
      for (int t0 = gw * 4; t0 < T; t0 += NGW * 4) {
          f32x4 bg[4], ch[6];
#pragma unroll
          for (int i = 0; i < 6; ++i) { const int t = t0 - 2 + i; const bool ok = (t >= 0) && ((t & ~(SEQ - 1)) == (t0 & ~(SEQ - 1)));
              ch[i] = (f32x4){0, 0, 0, 0}; if (ok) { const bf16* zr = Z + (size_t)t * ZLD + 4 * lane; ch[i] = ld4bf(zr + 256) * ld4bf(zr + 512); } }
#pragma unroll
          for (int i = 0; i < 4; ++i) bg[i] = ld4bf(Z + (size_t)(t0 + i) * ZLD + 4 * lane);
#pragma unroll
          for (int i = 0; i < 4; ++i) { const f32x4 y = (w2 * ch[i + 2] + w1 * ch[i + 1] + w0 * ch[i]) * bg[i];
              v2u w; w.x = pk2(y.x, y.y); w.y = pk2(y.z, y.w); *(v2u*)(O16 + (size_t)(t0 + i) * D + 4 * lane) = w; } } }
    for (int rp_ = 0; rp_ < ((PROBE_PHASE == 102) ? PROBE_REPS : 1); ++rp_) { LAS unsigned char* VT = F.lds;
      const float* ng = kin(A, I_SG_NG) + l * 256; const float* nb = kin(A, I_SG_NB) + l * 256; const bf16* sgw = (const bf16*)(F.ws + WS_SGW) + (size_t)l * 4 * 128 * 128;
      for (int blk = F.bid; blk < T / 128; blk += F.G) {
          const f32x4 gg = *(const f32x4*)(ng + 4 * lane), bb = *(const f32x4*)(nb + 4 * lane);
          for (int rb = 0; rb < 128 / NWAVES; rb += 4) { f32x4 vv[4];
#pragma unroll
              for (int i = 0; i < 4; ++i) vv[i] = ld4bf(Z + (size_t)(blk * 128 + F.wave + (rb + i) * NWAVES) * ZLD + OFF_B + 256 + 4 * lane);
              float s1[4], s2[4];
#pragma unroll
              for (int i = 0; i < 4; ++i) { s1[i] = (vv[i].x + vv[i].y) + (vv[i].z + vv[i].w); s2[i] = (vv[i].x * vv[i].x + vv[i].y * vv[i].y) + (vv[i].z * vv[i].z + vv[i].w * vv[i].w); }
#pragma unroll
              for (int o = 1; o < 64; o <<= 1) {
#pragma unroll
                  for (int i = 0; i < 4; ++i) { s1[i] += shfl_xor_l(s1[i], o, lane); s2[i] += shfl_xor_l(s2[i], o, lane); } }
#pragma unroll
              for (int i = 0; i < 4; ++i) { const float mean = s1[i] * (1.f / 256), var = fmaxf(s2[i] * (1.f / 256) - mean * mean, 0.f), rstd = __builtin_amdgcn_rsqf(var + LN_EPS);
                  const f32x4 y = (vv[i] - mean) * rstd * gg + bb; const int j = F.wave + (rb + i) * NWAVES;
                  LAS unsigned char* wp = VT + (4 * lane) * 272 + (((j >> 3) ^ (lane & 15)) << 4) + (j & 7) * 2;
                  *(LAS bf16*)(wp) = (bf16)f2bf(y.x); *(LAS bf16*)(wp + 272) = (bf16)f2bf(y.y); *(LAS bf16*)(wp + 544) = (bf16)f2bf(y.z); *(LAS bf16*)(wp + 816) = (bf16)f2bf(y.w); } }
          __syncthreads();
          { const int fr = lane & 15, fq = lane >> 4, it = F.wave, i = 16 * it + fr, t = blk * 128 + i, nks = (it < 4) ? 2 : 4;
#pragma unroll 1
            for (int g = 0; g < 4; ++g) { bf16x8 wf[4];
#pragma unroll
                for (int ks = 0; ks < 4; ++ks) wf[ks] = *(const bf16x8*)(sgw + ((size_t)(g * 128 + i)) * 128 + 32 * ks + 8 * fq);
                const float bias = kin(A, I_SG_B)[(l * 4 + g) * 128 + i];
#pragma unroll
                for (int ct = 0; ct < 4; ++ct) { f32x4 acc = {0, 0, 0, 0}; const int c = g * 64 + ct * 16 + fr; const LAS unsigned char* rowp = VT + c * 272; const int sw = (c >> 2) & 15;
#pragma unroll
                    for (int ks = 0; ks < 4; ++ks) if (ks < nks) { const bf16x8 af = *(const LAS bf16x8*)(rowp + (((4 * ks + fq) ^ sw) << 4)); acc = __builtin_amdgcn_mfma_f32_16x16x32_bf16(af, wf[ks], acc, 0, 0, 0); }
                    const int c0 = g * 64 + ct * 16 + 4 * fq;
                    const f32x4 o = ld4bf(Z + (size_t)t * ZLD + OFF_B + c0) * (acc + bias);
                    v2u w; w.x = pk2(o.x, o.y); w.y = pk2(o.z, o.w); *(v2u*)(O16 + (size_t)t * D + 256 + c0) = w; } } }
          __syncthreads();
      } }
    for (int rp_ = 0; rp_ < ((PROBE_PHASE == 103) ? PROBE_REPS : 1); ++rp_) {
      bf16* LA = (bf16*)(F.ws + WS_LA16); const f32x4 mul = *(const f32x4*)(kin(A, I_RW_MU) + l * 1024 + 768 + 4 * lane);
      for (int t0 = gw * 4; t0 < T; t0 += NGW * 4) { f32x4 xr[5];
#pragma unroll
          for (int i = 0; i < 5; ++i) { const int t = t0 - 1 + i; xr[i] = (f32x4){0, 0, 0, 0}; if (i > 0 || (t0 & (SEQ - 1)) > 0) xr[i] = ld4bf(Z + (size_t)t * ZLD + OFF_C + 768 + 4 * lane); }
#pragma unroll
          for (int i = 0; i < 4; ++i) { f32x4 x = xr[i + 1] + (xr[i] - xr[i + 1]) * mul;
              if (lane < 16) x = sig4(x * 2.0f) * 2.0f - 1.0f;
              else if (lane >= 32) x = sig4(x);
              v2u w; w.x = pk2(x.x, x.y); w.y = pk2(x.z, x.w); *(v2u*)(LA + (size_t)(t0 + i) * 256 + 4 * lane) = w; } } }
}

__device__ __forceinline__ void p_rw_chunks(KArgs& A, const Frame& F, int l) {
    const int gw = F.bid * NWAVES + F.wave, NGW = F.G * NWAVES, lane = F.lane;
    const bf16* Z = (const bf16*)(F.ws + WS_Z); const float* DEC = (const float*)(F.ws + WS_DEC); const float* AV = (const float*)(F.ws + WS_AV);
    float* QH = (float*)(F.ws + WS_QH); float* YL = (float*)(F.ws + WS_YL); float* GC = (float*)(F.ws + WS_GC); float* HC = (float*)(F.ws + WS_HC); float* RK = (float*)(F.ws + WS_RK);
    LAS float* wl = (LAS float*)(F.lds + F.wave * 16384);
    for (int task = gw; task < 16 * NCH; task += NGW) { const int bh = task / NCH, ck = task % NCH, b = bh >> 2, head = bh & 3, c = head * 64 + lane;
        const float mu_r = kin(A, I_RW_MU)[l * 1024 + c], mu_k = kin(A, I_RW_MU)[l * 1024 + 256 + c], mu_v = kin(A, I_RW_MU)[l * 1024 + 512 + c];
        const float kkc = kin(A, I_RW_KK)[l * 256 + c], kac = kin(A, I_RW_KA)[l * 256 + c], rkc = kin(A, I_RW_RK)[l * 256 + c];
        float sp[64], sl[64];
        { const int ln = launder_v(lane);
#pragma unroll
          for (int k = 0; k < 64; ++k) { sp[k] = (k == ln) ? 1.0f : 0.0f; sl[k] = 0.0f; } }
        wl[8 * 320 + lane] = 0.f;
        const int tg0 = b * SEQ + ck * CH;
        float pr = 0.f, pk = 0.f, pv = 0.f, gam = 1.0f;
        if (ck > 0) { const bf16* zp = Z + (size_t)(tg0 - 1) * ZLD + OFF_C + c; pr = bf2f(zp[0]); pk = bf2f(zp[256]); pv = bf2f(zp[512]); }
#pragma unroll 1
        for (int sb = 0; sb < CH / 8; ++sb) {
#pragma unroll 1
            for (int hb = 0; hb < 2; ++hb) {
                float kk[4], dc[4], av[4], rs[4], k2[4], vs[4], ss[4], rkp[4];
#pragma unroll
                for (int i = 0; i < 4; ++i) { const int t = tg0 + sb * 8 + hb * 4 + i; const bf16* zr = Z + (size_t)t * ZLD + OFF_C + c;
                    const float r = bf2f(zr[0]), k = bf2f(zr[256]), v = bf2f(zr[512]); dc[i] = DEC[(size_t)t * 256 + c]; av[i] = AV[(size_t)t * 256 + c];
                    rs[i] = r + (pr - r) * mu_r; const float ks = k + (pk - k) * mu_k; vs[i] = v + (pv - v) * mu_v; pr = r; pk = k; pv = v;
                    kk[i] = ks * kkc; k2[i] = ks * (1.0f + (av[i] - 1.0f) * kac); ss[i] = kk[i] * kk[i]; rkp[i] = rs[i] * k2[i] * rkc; }
#pragma unroll
                for (int o = 1; o < 64; o <<= 1) {
#pragma unroll
                    for (int i = 0; i < 4; ++i) { ss[i] += shfl_xor_l(ss[i], o, lane); rkp[i] += shfl_xor_l(rkp[i], o, lane); } }
#pragma unroll
                for (int i = 0; i < 4; ++i) { const float kn = kk[i] * __builtin_amdgcn_rcpf(fmaxf(sqrtf(ss[i]), 1e-12f)); LAS float* w = wl + (hb * 4 + i) * 320 + lane;
                    const float g1 = gam * dc[i], ig = __builtin_amdgcn_rcpf(g1);
                    w[0] = -kn * gam; w[64] = kn * av[i] * ig; w[128] = rs[i] * g1; w[192] = k2[i] * ig; w[256] = vs[i]; gam = g1;
                    if (lane == 0) RK[(size_t)(tg0 + sb * 8 + hb * 4 + i) * 4 + head] = rkp[i]; }
            }
            LDS_WAIT();
            const LAS float* wr16 = wl + (lane & 15);
            float saP = 0.f, saL = 0.f;
            { float A0[4];
#pragma unroll
              for (int J = 0; J < 4; ++J) A0[J] = wr16[16 * J];
#define RW_SA(k) { fmac_bc<(k) & 15>(saP, A0[(k) >> 4], sp[k]); fmac_bc<(k) & 15>(saL, A0[(k) >> 4], sl[k]); }
#define RW_REP16(M, o) M(o + 0) M(o + 1) M(o + 2) M(o + 3) M(o + 4) M(o + 5) M(o + 6) M(o + 7) M(o + 8) M(o + 9) M(o + 10) M(o + 11) M(o + 12) M(o + 13) M(o + 14) M(o + 15)
              RW_REP16(RW_SA, 0) RW_REP16(RW_SA, 16) RW_REP16(RW_SA, 32) RW_REP16(RW_SA, 48) }
            float Bv[4], Rv[4], Kv[4], Av[4], vj;
#pragma unroll
            for (int J = 0; J < 4; ++J) { Bv[J] = wr16[64 + 16 * J]; Rv[J] = wr16[128 + 16 * J]; Kv[J] = wr16[192 + 16 * J]; Av[J] = wr16[320 + 16 * J]; }
            vj = wl[256 + lane];
#pragma unroll 1
            for (int st_ = 0; st_ < 8; ++st_) {
                float Bn[4], Rn[4], Kn[4], An[4], vn;
                { const LAS float* nb = wr16 + (st_ + 1) * 320; const int lim = (st_ < 7) ? 0 : -320;
#pragma unroll
                  for (int J = 0; J < 4; ++J) { Bn[J] = nb[lim + 64 + 16 * J]; Rn[J] = nb[lim + 128 + 16 * J]; Kn[J] = nb[lim + 192 + 16 * J]; An[J] = nb[320 + 16 * J]; }
                  vn = wl[(st_ + 1) * 320 + lim + 256 + lane]; }
                float yP = 0.f, yL = 0.f, nP = 0.f, nL = 0.f;
#define RW_STEP(k) { fmac_bc<(k) & 15>(sp[k], Bv[(k) >> 4], saP); fmac_bc<(k) & 15>(sl[k], Bv[(k) >> 4], saL); fmac_bc<(k) & 15>(sl[k], Kv[(k) >> 4], vj); \
                     fmac_bc<(k) & 15>(yP, Rv[(k) >> 4], sp[k]); fmac_bc<(k) & 15>(yL, Rv[(k) >> 4], sl[k]); fmac_bc<(k) & 15>(nP, Av[(k) >> 4], sp[k]); fmac_bc<(k) & 15>(nL, Av[(k) >> 4], sl[k]); }
                RW_REP16(RW_STEP, 0) RW_REP16(RW_STEP, 16) RW_REP16(RW_STEP, 32) RW_REP16(RW_STEP, 48)
                const size_t oi = ((size_t)(bh * SEQ + ck * CH + sb * 8 + st_)) * 64 + lane;
                QH[oi] = yP; YL[oi] = yL; saP = nP; saL = nL;
#pragma unroll
                for (int J = 0; J < 4; ++J) { Bv[J] = Bn[J]; Rv[J] = Rn[J]; Kv[J] = Kn[J]; Av[J] = An[J]; }
                vj = vn; }
#undef RW_SA
#undef RW_STEP
#undef RW_REP16
        }
        wl[lane] = gam; LDS_WAIT();
        float* hp = HC + ((size_t)(bh * NCH + ck) * 64 + lane) * 64;
#pragma unroll
        for (int q = 0; q < 16; ++q) { const f32x4 gq = *(const LAS f32x4*)(wl + 4 * q);
            sp[4 * q] *= gq.x; sp[4 * q + 1] *= gq.y; sp[4 * q + 2] *= gq.z; sp[4 * q + 3] *= gq.w;
            *(f32x4*)(hp + 4 * q) = (f32x4){sl[4 * q] * gq.x, sl[4 * q + 1] * gq.y, sl[4 * q + 2] * gq.z, sl[4 * q + 3] * gq.w}; }
        { float* gp = GC + (size_t)(bh * NCH + ck) * 4096 + (size_t)(((lane >> 2) & 3) * 16) * 64 + ((lane >> 4) * 4 + (lane & 3)) * 4;
#pragma unroll
          for (int f = 0; f < 16; ++f) *(f32x4*)(gp + f * 64) = (f32x4){sp[f], sp[16 + f], sp[32 + f], sp[48 + f]}; }
        LDS_WAIT();
    }
}
__device__ __forceinline__ void p_s5_chain(KArgs& A, const Frame& F, int l) {
    const int gt = F.bid * NTHREADS + F.tid; if (gt >= NB * 16 * 64) return;
    const int b = gt >> 10, g = (gt >> 6) & 15, p = gt & 63;
    const float dt = expf(kin(A, I_S5_LOGDT)[l * 16 + g]); const float are = kin(A, I_S5_ARE)[(l * 16 + g) * 64 + p], aim = kin(A, I_S5_AIM)[(l * 16 + g) * 64 + p];
    const float mag = expf(are * dt * 64.0f); float sn, cs; sincosf(aim * dt * 64.0f, &sn, &cs); const float ar = mag * cs, ai = mag * sn;
    bf16* AO = (bf16*)(F.ws + WS_AOUT); const float* XL = (const float*)(F.ws + WS_XLOC);
    float xr = 0.f, xi = 0.f;
#pragma unroll 1
    for (int c0 = 0; c0 < NCH; c0 += 16) {
        f32x2 xl[16]; unsigned outw[16];
#pragma unroll
        for (int i = 0; i < 16; ++i) xl[i] = *(const f32x2*)(XL + ((size_t)g * NCHT + b * NCH + c0 + i) * 128 + 2 * p);
#pragma unroll
        for (int i = 0; i < 16; ++i) { outw[i] = pk2(xr, xi); const float nr = ar * xr - ai * xi + xl[i].x, ni = ar * xi + ai * xr + xl[i].y; xr = nr; xi = ni; }
#pragma unroll
        for (int i = 0; i < 16; ++i) *(unsigned*)(AO + ((size_t)g * NCHT + b * NCH + c0 + i) * S5K + 1024 + 2 * p) = outw[i];
    }
}
constexpr int CB = 8, NBLK = NCH / CB;
__device__ __forceinline__ void chain_load_g(const float* G, float (&ga)[64], int fr, int fq) {
    const f32x4* gp = (const f32x4*)(G + (size_t)(16 * fq + fr) * 64);
#pragma unroll
    for (int q = 0; q < 16; ++q) { const f32x4 x = gp[q]; ga[4 * q] = x.x; ga[4 * q + 1] = x.y; ga[4 * q + 2] = x.z; ga[4 * q + 3] = x.w; }
}
__device__ __forceinline__ void chain_store_g(float* G, int rb, const f32x4 (&t)[4], int fr, int fq) {
#pragma unroll
    for (int reg = 0; reg < 4; ++reg) *(f32x4*)(G + (size_t)((fr >> 2) * 16 + 4 * fq + reg) * 64 + (rb * 4 + (fr & 3)) * 4) = (f32x4){t[0][reg], t[1][reg], t[2][reg], t[3][reg]};
}
__device__ __forceinline__ void chain_step(f32x4 (&acc)[4], const float (&ga)[64], const f32x4 (&ci)[4]) {
    f32x4 na[4] = {ci[0], ci[1], ci[2], ci[3]};
#pragma unroll
    for (int jr = 0; jr < 16; ++jr)
#pragma unroll
        for (int mt = 0; mt < 4; ++mt) na[mt] = __builtin_amdgcn_mfma_f32_16x16x4f32(ga[jr * 4 + mt], acc[jr >> 2][jr & 3], na[mt], 0, 0, 0);
#pragma unroll
    for (int mt = 0; mt < 4; ++mt) acc[mt] = na[mt];
}
__device__ __forceinline__ void chain_load_tile(const float* M, int rb, f32x4 (&t)[4], int fr, int fq) {
#pragma unroll
    for (int jt = 0; jt < 4; ++jt) t[jt] = *(const f32x4*)(M + (size_t)(16 * rb + fr) * 64 + 16 * jt + 4 * fq);
}
__device__ __forceinline__ void chain_store_tile(float* M, int rb, const f32x4 (&t)[4], int fr, int fq) {
#pragma unroll
    for (int jt = 0; jt < 4; ++jt) *(f32x4*)(M + (size_t)(16 * rb + fr) * 64 + 16 * jt + 4 * fq) = t[jt];
}
__device__ __forceinline__ void p_chain_compose(const Frame& F) {
    const int nlow = (F.G >= 256) ? 128 : 0; if (F.bid < nlow) return;
    const int gw = (F.bid - nlow) * NWAVES + F.wave, NGW = (F.G - nlow) * NWAVES, ln_ = my_lane(), fr = ln_ & 15, fq = ln_ >> 4;
    const float* GC = (const float*)(F.ws + WS_GC); const float* HC = (const float*)(F.ws + WS_HC); float* GB = (float*)(F.ws + WS_GB); float* HB = (float*)(F.ws + WS_HB);
    for (int task = gw; task < 16 * NBLK * 8; task += NGW) { const int cb = task & 7, bb = task >> 3, rb = cb & 3; const bool isH = cb >= 4;
        const size_t c0 = (size_t)bb * CB;
        f32x4 acc[4];
        if (isH) chain_load_tile(HC + c0 * 4096, rb, acc, fr, fq);
        else {
            const float* gq = GC + c0 * 4096 + (size_t)((fr >> 2) * 16 + 4 * fq) * 64 + (rb * 4 + (fr & 3)) * 4;
#pragma unroll
            for (int reg = 0; reg < 4; ++reg) { const f32x4 x = *(const f32x4*)(gq + reg * 64); acc[0][reg] = x.x; acc[1][reg] = x.y; acc[2][reg] = x.z; acc[3][reg] = x.w; } }
        float ga[64]; chain_load_g(GC + (c0 + 1) * 4096, ga, fr, fq);
        f32x4 ci[4] = {{0, 0, 0, 0}, {0, 0, 0, 0}, {0, 0, 0, 0}, {0, 0, 0, 0}};
        if (isH) chain_load_tile(HC + (c0 + 1) * 4096, rb, ci, fr, fq);
#pragma unroll 1
        for (int i = 1; i < CB; ++i) { const int nx = (i + 1 < CB) ? i + 1 : i;
            f32x4 cn[4] = {{0, 0, 0, 0}, {0, 0, 0, 0}, {0, 0, 0, 0}, {0, 0, 0, 0}};
            if (isH) chain_load_tile(HC + (c0 + nx) * 4096, rb, cn, fr, fq);
            float gn[64]; chain_load_g(GC + (c0 + nx) * 4096, gn, fr, fq);
            chain_step(acc, ga, ci);
#pragma unroll
            for (int k = 0; k < 64; ++k) ga[k] = gn[k];
#pragma unroll
            for (int k = 0; k < 4; ++k) ci[k] = cn[k]; }
        if (isH) chain_store_tile(HB + (size_t)bb * 4096, rb, acc, fr, fq); else chain_store_g(GB + (size_t)bb * 4096, rb, acc, fr, fq);
    }
}
__device__ __forceinline__ void p_chain_blocks(const Frame& F, int gw, int NGW) {
    const int ln_ = my_lane(), fr = ln_ & 15, fq = ln_ >> 4;
    const float* GB = (const float*)(F.ws + WS_GB); const float* HB = (const float*)(F.ws + WS_HB); float* SB = (float*)(F.ws + WS_SB);
    for (int task = gw; task < 16 * 4; task += NGW) { const int vb = task & 3, bh = task >> 2;
        f32x4 acc[4] = {{0, 0, 0, 0}, {0, 0, 0, 0}, {0, 0, 0, 0}, {0, 0, 0, 0}};
        float ga[64]; chain_load_g(GB + (size_t)bh * NBLK * 4096, ga, fr, fq);
        f32x4 ci[4]; chain_load_tile(HB + (size_t)bh * NBLK * 4096, vb, ci, fr, fq);
#pragma unroll 1
        for (int blk = 0; blk < NBLK; ++blk) { const size_t bb = (size_t)bh * NBLK + blk;
            chain_store_tile(SB + bb * 4096, vb, acc, fr, fq);
            if (blk + 1 == NBLK) break;
            f32x4 cn[4]; chain_load_tile(HB + (bb + 1) * 4096, vb, cn, fr, fq);
            float gn[64]; chain_load_g(GB + (bb + 1) * 4096, gn, fr, fq);
            chain_step(acc, ga, ci);
#pragma unroll
            for (int k = 0; k < 64; ++k) ga[k] = gn[k];
#pragma unroll
            for (int k = 0; k < 4; ++k) ci[k] = cn[k]; }
    }
}
__device__ __forceinline__ void chain_inblock(const Frame& F, int bb, int vb) {
    const int ln_ = my_lane(), fr = ln_ & 15, fq = ln_ >> 4;
    const float* GC = (const float*)(F.ws + WS_GC); const float* HC = (const float*)(F.ws + WS_HC); const float* SB = (const float*)(F.ws + WS_SB); float* SC = (float*)(F.ws + WS_SC);
    const size_t c0 = (size_t)bb * CB;
    f32x4 acc[4]; chain_load_tile(SB + (size_t)bb * 4096, vb, acc, fr, fq);
    float ga[64]; chain_load_g(GC + c0 * 4096, ga, fr, fq);
    f32x4 ci[4]; chain_load_tile(HC + c0 * 4096, vb, ci, fr, fq);
#pragma unroll 1
    for (int i = 0; i < CB; ++i) {
        chain_store_tile(SC + (c0 + i) * 4096, vb, acc, fr, fq);
        if (i + 1 == CB) break;
        f32x4 cn[4]; chain_load_tile(HC + (c0 + i + 1) * 4096, vb, cn, fr, fq);
        float gn[64]; chain_load_g(GC + (c0 + i + 1) * 4096, gn, fr, fq);
        chain_step(acc, ga, ci);
#pragma unroll
        for (int k = 0; k < 64; ++k) ga[k] = gn[k];
#pragma unroll
        for (int k = 0; k < 4; ++k) ci[k] = cn[k]; }
}
__device__ __forceinline__ void rw_out_task(KArgs& A, const Frame& F, int l, int task) {
    const int lane = F.lane, fr = lane & 15, fq = lane >> 4;
    const bf16* Z = (const bf16*)(F.ws + WS_Z); const float* QH = (const float*)(F.ws + WS_QH); const float* YL = (const float*)(F.ws + WS_YL); const float* SC = (const float*)(F.ws + WS_SC);
    const float* RWG = (const float*)(F.ws + WS_RWG); const float* RK = (const float*)(F.ws + WS_RK); bf16* O16 = (bf16*)(F.ws + WS_O16);
    const int bh = task / NCH, ck = task % NCH, b = bh >> 2, head = bh & 3;
    const size_t ti0 = (size_t)(bh * SEQ + ck * CH); const int t0g = b * SEQ + ck * CH;
    float sa[4][16];
    { const float* sp = SC + (size_t)(bh * NCH + ck) * 4096 + (size_t)fr * 64 + 16 * fq;
#pragma unroll
      for (int vt = 0; vt < 4; ++vt)
#pragma unroll
          for (int q = 0; q < 4; ++q) { const f32x4 x = *(const f32x4*)(sp + vt * 1024 + 4 * q); sa[vt][4 * q] = x.x; sa[vt][4 * q + 1] = x.y; sa[vt][4 * q + 2] = x.z; sa[vt][4 * q + 3] = x.w; } }
    const float* lgp = kin(A, I_RW_LNG) + l * 256 + head * 64 + 4 * fq; const float* lbp = kin(A, I_RW_LNB) + l * 256 + head * 64 + 4 * fq; const float* mup = kin(A, I_RW_MU) + l * 1024 + 512 + head * 64 + 4 * fq;
#pragma unroll 1
    for (int tt = 0; tt < 4; ++tt) { const int t = 16 * tt + fr;
        float qb[16];
        { const float* qp = QH + (ti0 + t) * 64 + 16 * fq;
#pragma unroll
          for (int q = 0; q < 4; ++q) { const f32x4 x = *(const f32x4*)(qp + 4 * q); qb[4 * q] = x.x; qb[4 * q + 1] = x.y; qb[4 * q + 2] = x.z; qb[4 * q + 3] = x.w; } }
        f32x4 y[4];
#pragma unroll
        for (int vt = 0; vt < 4; ++vt) y[vt] = *(const f32x4*)(YL + (ti0 + t) * 64 + 16 * vt + 4 * fq);
#pragma unroll
        for (int s_ = 0; s_ < 16; ++s_)
#pragma unroll
            for (int vt = 0; vt < 4; ++vt) y[vt] = __builtin_amdgcn_mfma_f32_16x16x4f32(sa[vt][s_], qb[s_], y[vt], 0, 0, 0);
        float s1 = 0.f, s2 = 0.f;
#pragma unroll
        for (int vt = 0; vt < 4; ++vt) { s1 += (y[vt].x + y[vt].y) + (y[vt].z + y[vt].w); s2 += (y[vt].x * y[vt].x + y[vt].y * y[vt].y) + (y[vt].z * y[vt].z + y[vt].w * y[vt].w); }
        s1 += shfl_xor_l(s1, 16, lane); s1 += shfl_xor_l(s1, 32, lane); s2 += shfl_xor_l(s2, 16, lane); s2 += shfl_xor_l(s2, 32, lane);
        const float m = s1 * (1.f / 64), var = fmaxf(s2 * (1.f / 64) - m * m, 0.f), rstd = __builtin_amdgcn_rsqf(var + RW_LN_EPS);
        const int tg = t0g + t; const float rk = RK[(size_t)tg * 4 + head]; const bool hasprev = (ck * CH + t) > 0;
        const bf16* zv = Z + (size_t)tg * ZLD + OFF_C + 512 + head * 64 + 4 * fq; const float* gp = RWG + (size_t)tg * 256 + head * 64 + 4 * fq; bf16* op = O16 + (size_t)tg * D + 512 + head * 64 + 4 * fq;
#pragma unroll
        for (int vt = 0; vt < 4; ++vt) { const f32x4 v1 = ld4bf(zv + 16 * vt); f32x4 v0 = {0, 0, 0, 0}; if (hasprev) v0 = ld4bf(zv - ZLD + 16 * vt);
            const f32x4 vv = v1 + (v0 - v1) * *(const f32x4*)(mup + 16 * vt), g4 = *(const f32x4*)(gp + 16 * vt), lg4 = *(const f32x4*)(lgp + 16 * vt), lb4 = *(const f32x4*)(lbp + 16 * vt);
            const f32x4 o = ((y[vt] - m) * rstd * lg4 + lb4 + vv * rk) * g4;
            v2u w; w.x = pk2(o.x, o.y); w.y = pk2(o.z, o.w); *(v2u*)(op + 16 * vt) = w; }
    }
}

template <int LSTRIDE> __device__ __forceinline__ void attn_stage(LAS unsigned char* lds, const bf16* src, size_t row_stride, int tid) {
    const int r0 = tid >> 5, c = tid & 31; const bf16* sp = src + (size_t)r0 * row_stride + c * 8; LAS unsigned char* dp = lds + r0 * LSTRIDE + c * 16;
#pragma unroll 4
    for (int i = 0; i < 16; ++i) { const v4u v = *(const v4u*)(sp + (size_t)(16 * i) * row_stride); *(LAS v4u*)(dp + 16 * i * LSTRIDE) = v; }
}
constexpr int KSTR = 544, VSTR = 528;
__device__ __forceinline__ void p_attn(const Frame& F) {
    const int lane = F.lane, fr = lane & 15, fq = lane >> 4;
    const bf16* Q = (const bf16*)(F.ws + WS_Q16); const bf16* KM = (const bf16*)(F.ws + WS_KM16); const bf16* VT = (const bf16*)(F.ws + WS_VMT16); bf16* AO = (bf16*)(F.ws + WS_AO16);
    for (int item = F.bid; item < NB * 4 * (SEQ / 256); item += F.G) {
        const int qg = item % (SEQ / 256), bhd = item / (SEQ / 256), head = bhd & 3, b = bhd >> 2;
        attn_stage<KSTR>(F.lds, KM + (size_t)(b * NMEM) * D + head * 256, D, F.tid);
        __syncthreads();
        v4u pf[2][8]; float inv[2];
#pragma unroll
        for (int u = 0; u < 2; ++u) { const int q0 = b * SEQ + qg * 256 + u * 128 + F.wave * 16;
            bf16x8 qf[8];
#pragma unroll
            for (int ks = 0; ks < 8; ++ks) qf[ks] = *(const bf16x8*)(Q + (size_t)(q0 + fr) * D + head * 256 + ks * 32 + fq * 8);
            f32x4 sT[16];
            const LAS unsigned char* kbase = F.lds + fr * KSTR + fq * 16;
#pragma unroll
            for (int kt = 0; kt < 16; ++kt) { f32x4 a = {0, 0, 0, 0}; const LAS unsigned char* kp = kbase + kt * 16 * KSTR;
#pragma unroll
                for (int ks = 0; ks < 8; ++ks) { const bf16x8 kf = *(const LAS bf16x8*)(kp + ks * 64); a = __builtin_amdgcn_mfma_f32_16x16x32_bf16(kf, qf[ks], a, 0, 0, 0); }
                sT[kt] = a; if (kt & 1) __builtin_amdgcn_sched_barrier(0); }
            float mx = -3.0e38f;
#pragma unroll
            for (int kt = 0; kt < 16; ++kt) mx = fmaxf(fmaxf(fmaxf(mx, sT[kt].x), fmaxf(sT[kt].y, sT[kt].z)), sT[kt].w);
            mx = fmaxf(mx, shfl_xor_l(mx, 16, lane)); mx = fmaxf(mx, shfl_xor_l(mx, 32, lane));
            float sum = 0.f;
#pragma unroll
            for (int kt = 0; kt < 16; ++kt) { sT[kt].x = __expf(sT[kt].x - mx); sT[kt].y = __expf(sT[kt].y - mx); sT[kt].z = __expf(sT[kt].z - mx); sT[kt].w = __expf(sT[kt].w - mx); sum += (sT[kt].x + sT[kt].y) + (sT[kt].z + sT[kt].w); }
            sum += shfl_xor_l(sum, 16, lane); sum += shfl_xor_l(sum, 32, lane);
            inv[u] = 1.0f / sum;
#pragma unroll
            for (int kp = 0; kp < 8; ++kp) { v4u w; w.x = pk2(sT[2 * kp].x, sT[2 * kp].y); w.y = pk2(sT[2 * kp].z, sT[2 * kp].w); w.z = pk2(sT[2 * kp + 1].x, sT[2 * kp + 1].y); w.w = pk2(sT[2 * kp + 1].z, sT[2 * kp + 1].w); pf[u][kp] = w; }
            __builtin_amdgcn_sched_barrier(0);
        }
        __syncthreads();
        attn_stage<VSTR>(F.lds, VT + (size_t)(b * D + head * 256) * NMEM, NMEM, F.tid);
        __syncthreads();
#pragma unroll
        for (int u = 0; u < 2; ++u) { const int q0 = b * SEQ + qg * 256 + u * 128 + F.wave * 16;
#pragma unroll 2
            for (int dt = 0; dt < 16; ++dt) { f32x4 o = {0, 0, 0, 0}; const LAS unsigned char* vp = F.lds + (dt * 16 + fr) * VSTR + fq * 8;
#pragma unroll
                for (int kp = 0; kp < 8; ++kp) {
                    const v2u lo = *(const LAS v2u*)(vp + 64 * kp), hi = *(const LAS v2u*)(vp + 64 * kp + 32); v4u w; w.x = lo.x; w.y = lo.y; w.z = hi.x; w.w = hi.y;
                    o = __builtin_amdgcn_mfma_f32_16x16x32_bf16(__builtin_bit_cast(bf16x8, w), __builtin_bit_cast(bf16x8, pf[u][kp]), o, 0, 0, 0); }
                v2u w; w.x = pk2(o.x * inv[u], o.y * inv[u]); w.y = pk2(o.z * inv[u], o.w * inv[u]);
                *(v2u*)(AO + (size_t)(q0 + fr) * D + head * 256 + dt * 16 + 4 * fq) = w; __builtin_amdgcn_sched_barrier(0); } }
        __syncthreads();
    }
}

__device__ __forceinline__ void p_ln(const Frame& F, const float* g, const float* b, bool dummy) {
    const int gw = F.bid * NWAVES + F.wave, NGW = F.G * NWAVES, lane = F.lane; const bf16* P = (const bf16*)(F.ws + WS_PRE16); bf16* H16 = (bf16*)(F.ws + (dummy ? WS_Z + 128 * MiB : WS_H16));
    for (int r0 = gw * 4; r0 < T; r0 += NGW * 4) { f32x4 v[4][4];
#pragma unroll
        for (int i = 0; i < 4; ++i)
#pragma unroll
            for (int j = 0; j < 4; ++j) v[i][j] = ld4bf(P + (size_t)(r0 + i) * D + 256 * j + 4 * lane);
#pragma unroll
        for (int i = 0; i < 4; ++i) { float mean, rstd; ln_stats(v[i], mean, rstd); ln_apply_store(v[i], mean, rstd, g, b, (float*)nullptr, H16 + (size_t)(r0 + i) * D, lane); } }
}
__device__ __forceinline__ void p_ln_router(KArgs& A, const Frame& F, int l, bool dummy) {
    const int gw = F.bid * NWAVES + F.wave, NGW = F.G * NWAVES, lane = F.lane, tid = F.tid, fr = lane & 15, fq = lane >> 4;
    const bf16* H = (const bf16*)(F.ws + WS_PRE16); bf16* H16 = (bf16*)(F.ws + (dummy ? WS_Z + 128 * MiB : WS_H16)); int* TOKE = (int*)(F.ws + (dummy ? WS_Z + 200 * MiB : WS_TOKE)); float* TOKW = (float*)(F.ws + (dummy ? WS_Z + 201 * MiB : WS_TOKW));
    LAS v4u* TB = (LAS v4u*)F.lds;
    LAS float* PS = (LAS float*)(F.lds + 131072);
    volatile LAS unsigned* hist = F.MISC + MI_HIST;
    const float* rw = kin(A, I_ROUTER_W) + (size_t)l * D * NE; const float* rb = kin(A, I_ROUTER_B) + l * NE; const float* g = kin(A, I_LN2_G) + l * D; const float* bb = kin(A, I_LN2_B) + l * D;
    for (int en = tid; en < 32 * 2 * 64; en += NTHREADS) { const int ln = en & 63, et = (en >> 6) & 1, ks = en >> 7, efr = ln & 15, efq = ln >> 4; float hi[8], lo[8];
#pragma unroll
        for (int j = 0; j < 8; ++j) { const int d = 32 * ks + 8 * efq + j; const float v = g[d] * rw[d * NE + et * 16 + efr]; const float h = bf2f(f2bf(v)); hi[j] = h; lo[j] = v - h; }
        v4u wh, wl; wh.x = pk2(hi[0], hi[1]); wh.y = pk2(hi[2], hi[3]); wh.z = pk2(hi[4], hi[5]); wh.w = pk2(hi[6], hi[7]); wl.x = pk2(lo[0], lo[1]); wl.y = pk2(lo[2], lo[3]); wl.z = pk2(lo[4], lo[5]); wl.w = pk2(lo[6], lo[7]);
        TB[((ks * 2 + et) * 2 + 0) * 64 + ln] = wh; TB[((ks * 2 + et) * 2 + 1) * 64 + ln] = wl; }
    { const int e = tid & 31, part = tid >> 5; float sg = 0.f, sb = 0.f;
      for (int d = part * 64; d < part * 64 + 64; ++d) { const float w = rw[d * NE + e]; sg += g[d] * w; sb += bb[d] * w; }
      PS[part * 32 + e] = sg; PS[512 + part * 32 + e] = sb; }
    if (tid < NE) hist[tid] = 0u;
    if (!dummy) { int* stok = (int*)(F.ws + WS_STOK); int* sdst = (int*)(F.ws + WS_SDST); for (int i = F.bid * NTHREADS + tid; i < SLOT_ROWS; i += F.G * NTHREADS) { stok[i] = 0; sdst[i] = T * TOPK; } }
    __syncthreads();
    if (tid < NE) { float sg = 0.f, sb = 0.f;
#pragma unroll
        for (int p = 0; p < 16; ++p) { sg += PS[p * 32 + tid]; sb += PS[512 + p * 32 + tid]; }
        PS[1024 + tid] = sg; PS[1056 + tid] = sb + rb[tid]; }
    __syncthreads();
    const float cg0 = PS[1024 + fr], cg1 = PS[1024 + 16 + fr], cb0 = PS[1056 + fr], cb1 = PS[1056 + 16 + fr];
    for (int grp = gw; grp < T / 16; grp += NGW) { const int r0 = grp * 16; const bf16* xrow = H + (size_t)(r0 + fr) * D + 8 * fq;
        f32x4 acc0 = {0, 0, 0, 0}, acc1 = {0, 0, 0, 0}; float sum = 0.f, sq = 0.f;
#pragma unroll 2
        for (int ks = 0; ks < 32; ++ks) { const v4u xw = *(const v4u*)(xrow + 32 * ks); f32x4 xa, xb; unpk8(xw, xa, xb);
            sum += (xa.x + xa.y) + (xa.z + xa.w) + (xb.x + xb.y) + (xb.z + xb.w);
            sq += (xa.x * xa.x + xa.y * xa.y) + (xa.z * xa.z + xa.w * xa.w) + (xb.x * xb.x + xb.y * xb.y) + (xb.z * xb.z + xb.w * xb.w);
            const LAS v4u* tb = TB + (ks * 4) * 64 + lane; const v4u b0h = tb[0], b0l = tb[64], b1h = tb[128], b1l = tb[192];
            const bf16x8 Ah = __builtin_bit_cast(bf16x8, xw);
            acc0 = __builtin_amdgcn_mfma_f32_16x16x32_bf16(Ah, __builtin_bit_cast(bf16x8, b0h), acc0, 0, 0, 0); acc0 = __builtin_amdgcn_mfma_f32_16x16x32_bf16(Ah, __builtin_bit_cast(bf16x8, b0l), acc0, 0, 0, 0);
            acc1 = __builtin_amdgcn_mfma_f32_16x16x32_bf16(Ah, __builtin_bit_cast(bf16x8, b1h), acc1, 0, 0, 0); acc1 = __builtin_amdgcn_mfma_f32_16x16x32_bf16(Ah, __builtin_bit_cast(bf16x8, b1l), acc1, 0, 0, 0); }
        sum += shfl_xor_l(sum, 16, lane); sum += shfl_xor_l(sum, 32, lane); sq += shfl_xor_l(sq, 16, lane); sq += shfl_xor_l(sq, 32, lane);
        const float mean = sum * (1.f / D), rstd = 1.0f / sqrtf(fmaxf(sq * (1.f / D) - mean * mean, 0.f) + LN_EPS);
        float v0[4], v1[4];
#pragma unroll
        for (int reg = 0; reg < 4; ++reg) { const float rs = __builtin_bit_cast(float, shfl_idx_l(__builtin_bit_cast(int, rstd), 4 * fq + reg)), mn = __builtin_bit_cast(float, shfl_idx_l(__builtin_bit_cast(int, mean), 4 * fq + reg));
            v0[reg] = rs * acc0[reg] - rs * mn * cg0 + cb0; v1[reg] = rs * acc1[reg] - rs * mn * cg1 + cb1; }
        float wv[4][4]; int wi[4][4];
#pragma unroll
        for (int k = 0; k < 4; ++k) {
#pragma unroll
            for (int reg = 0; reg < 4; ++reg) { float bv = v0[reg]; int bi = fr; if (v1[reg] > bv) { bv = v1[reg]; bi = 16 + fr; }
#pragma unroll
                for (int o = 1; o < 16; o <<= 1) { const float ov = shfl_xor_l(bv, o, lane); const int oi = shfl_idx_l(bi, lane ^ o); if (ov > bv || (ov == bv && oi < bi)) { bv = ov; bi = oi; } }
                wv[k][reg] = bv; wi[k][reg] = bi; if (bi == fr) v0[reg] = -3.0e38f; if (bi == 16 + fr) v1[reg] = -3.0e38f; } }
        if (fr == 0) {
#pragma unroll
            for (int reg = 0; reg < 4; ++reg) { const int t = r0 + 4 * fq + reg; const float e1 = __expf(wv[1][reg] - wv[0][reg]), e2 = __expf(wv[2][reg] - wv[0][reg]), e3 = __expf(wv[3][reg] - wv[0][reg]), inv = 1.0f / (1.0f + e1 + e2 + e3);
                *(int4*)(TOKE + (size_t)t * 4) = make_int4(wi[0][reg], wi[1][reg], wi[2][reg], wi[3][reg]); *(f32x4*)(TOKW + (size_t)t * 4) = (f32x4){inv, e1 * inv, e2 * inv, e3 * inv};
#pragma unroll
                for (int k = 0; k < 4; ++k) __hip_atomic_fetch_add((LAS unsigned*)&hist[wi[k][reg]], 1u, __ATOMIC_RELAXED, __HIP_MEMORY_SCOPE_WORKGROUP); } }
        bf16* o16 = H16 + (size_t)(r0 + fr) * D + 8 * fq;
#pragma unroll 2
        for (int ks = 0; ks < 32; ++ks) { f32x4 xa, xb; unpk8(*(const v4u*)(xrow + 32 * ks), xa, xb);
            const f32x4 ga = *(const f32x4*)(g + 32 * ks + 8 * fq), gb = *(const f32x4*)(g + 32 * ks + 8 * fq + 4), ba = *(const f32x4*)(bb + 32 * ks + 8 * fq), bc = *(const f32x4*)(bb + 32 * ks + 8 * fq + 4);
            *(v4u*)(o16 + 32 * ks) = pk8((xa - mean) * rstd * ga + ba, (xb - mean) * rstd * gb + bc); }
    }
    __syncthreads();
    if (tid < NE && !dummy) { const unsigned c = hist[tid]; if (c) atomicAdd(F.ctl + CW_CNT + l * NE + tid, c); F.ctl[CW_WGH + (l * 512 + F.bid) * NE + tid] = c; }
}
__device__ __forceinline__ void moe_offsets(const Frame& F, int l) {
    if (F.tid == 0) { int acc = 0;
        for (int e = 0; e < NE; ++e) { F.MISC[MI_TOFF + e] = (unsigned)acc; const unsigned c = __hip_atomic_load(F.ctl + CW_CNT + l * NE + e, __ATOMIC_RELAXED, __HIP_MEMORY_SCOPE_AGENT); acc += (int)((c + 255u) >> 8); }
        F.MISC[MI_TOFF + NE] = (unsigned)acc; }
    __syncthreads();
}
__device__ __forceinline__ void p_moe_slots(const Frame& F, int l, int dummy) {
    const int gw = F.bid * NWAVES + F.wave, NGW = F.G * NWAVES, lane = F.lane;
    moe_offsets(F, l);
    const int* TOKE = (const int*)(F.ws + WS_TOKE); const float* TOKW = (const float*)(F.ws + WS_TOKW); int* TOKS = (int*)(F.ws + (dummy ? WS_END : WS_TOKS)); float* SLOTW = (float*)(F.ws + (dummy ? WS_END + 1 * MiB : WS_SLOTW));
    const bf16* H16 = (const bf16*)(F.ws + WS_H16); bf16* XG = (bf16*)(F.ws + (dummy ? WS_ACT : WS_XG)); unsigned* CUR = F.ctl + CW_CUR + l * NE + dummy * 256;
    if (F.tid < NE) { const unsigned c = F.ctl[CW_WGH + (l * 512 + F.bid) * NE + F.tid]; const unsigned base = c ? atomicAdd(CUR + F.tid, c) : 0u;
        F.MISC[MI_LBASE + F.tid] = F.MISC[MI_TOFF + F.tid] * 256u + base; F.MISC[MI_LCUR + F.tid] = 0u; }
    __syncthreads();
    int* STOK = (int*)(F.ws + (dummy ? WS_END + 2 * MiB : WS_STOK)); int* SDST = (int*)(F.ws + (dummy ? WS_END + 3 * MiB : WS_SDST));
    for (int grp = gw; grp < T / 16; grp += NGW) {
        const int r = grp * 16 + (lane >> 2), k = lane & 3; const int e = TOKE[(size_t)r * 4 + k];
        const unsigned pos = __hip_atomic_fetch_add((LAS unsigned*)&F.MISC[MI_LCUR + e], 1u, __ATOMIC_RELAXED, __HIP_MEMORY_SCOPE_WORKGROUP); const int slot = (int)(F.MISC[MI_LBASE + e] + pos);
        TOKS[(size_t)r * 4 + k] = slot; SLOTW[slot] = TOKW[(size_t)r * 4 + k]; STOK[slot] = r; SDST[slot] = r * 4 + k; }
}
__device__ __forceinline__ void p_moe_combine(KArgs& A, const Frame& F, int l, bool dummy) {
    const int gw = F.bid * NWAVES + F.wave, NGW = F.G * NWAVES, lane = F.lane;
    const bf16* H = (const bf16*)(F.ws + WS_H16); bf16* H16 = (bf16*)(F.ws + (dummy ? WS_Z + 128 * MiB : WS_H16)); const int* TOKS = (const int*)(F.ws + WS_TOKS); const bf16* YS = (const bf16*)(F.ws + WS_YS);
    const bool last = (l == NL - 1) && !dummy;
    for (int r0 = gw * 2; r0 < T; r0 += NGW * 2) {
        int4 sl[2]; sl[0] = make_int4(r0 * 4, r0 * 4 + 1, r0 * 4 + 2, r0 * 4 + 3); sl[1] = make_int4(r0 * 4 + 4, r0 * 4 + 5, r0 * 4 + 6, r0 * 4 + 7);
        v2u hh[2][4], ys[2][4][4];
#pragma unroll
        for (int i = 0; i < 2; ++i)
#pragma unroll
            for (int j = 0; j < 4; ++j) { const int o = 256 * j + 4 * lane; hh[i][j] = *(const v2u*)(H + (size_t)(r0 + i) * D + o);
                ys[i][j][0] = *(const v2u*)(YS + (size_t)sl[i].x * D + o); ys[i][j][1] = *(const v2u*)(YS + (size_t)sl[i].y * D + o); ys[i][j][2] = *(const v2u*)(YS + (size_t)sl[i].z * D + o); ys[i][j][3] = *(const v2u*)(YS + (size_t)sl[i].w * D + o); }
#pragma unroll
        for (int i = 0; i < 2; ++i) { f32x4 v[4]; const int r = r0 + i;
#pragma unroll
            for (int j = 0; j < 4; ++j) { const v2u h2 = hh[i][j], y0 = ys[i][j][0], y1 = ys[i][j][1], y2 = ys[i][j][2], y3 = ys[i][j][3];
                v[j].x = bf2f(h2.x & 0xffffu) * DN_ALPHA + ((bf2f(y0.x & 0xffffu) + bf2f(y1.x & 0xffffu)) + (bf2f(y2.x & 0xffffu) + bf2f(y3.x & 0xffffu)));
                v[j].y = bf2f(h2.x >> 16) * DN_ALPHA + ((bf2f(y0.x >> 16) + bf2f(y1.x >> 16)) + (bf2f(y2.x >> 16) + bf2f(y3.x >> 16)));
                v[j].z = bf2f(h2.y & 0xffffu) * DN_ALPHA + ((bf2f(y0.y & 0xffffu) + bf2f(y1.y & 0xffffu)) + (bf2f(y2.y & 0xffffu) + bf2f(y3.y & 0xffffu)));
                v[j].w = bf2f(h2.y >> 16) * DN_ALPHA + ((bf2f(y0.y >> 16) + bf2f(y1.y >> 16)) + (bf2f(y2.y >> 16) + bf2f(y3.y >> 16))); }
            float mean, rstd; ln_stats(v, mean, rstd);
            if (last) ln_apply_store(v, mean, rstd, kin(A, I_LN3_G) + l * D, kin(A, I_LN3_B) + l * D, kout(A) + (size_t)r * D, (bf16*)nullptr, lane);
            else ln_apply_store(v, mean, rstd, kin(A, I_LN3_G) + l * D, kin(A, I_LN3_B) + l * D, (float*)nullptr, H16 + (size_t)r * D, lane); } }
}

constexpr int NPL = 18;
constexpr int NPHASES = 1 + NL * NPL;
#ifndef ONLY
#define ONLY -1
#endif
#define EN(j) (ONLY < 0 || ONLY == (j))
#define DUMMY(j) ((PROBE_PHASE == (j)) && (rep_ + 1 < PROBE_REPS))
#define REPS(j) for (int rep_ = 0; rep_ < ((PROBE_PHASE == (j)) ? PROBE_REPS : 1); ++rep_, __syncthreads())
__global__ void __launch_bounds__(NTHREADS, 2) fwd_kernel(Args args) {
    extern __shared__ __attribute__((aligned(16))) unsigned char lds_raw[];
    Frame F;
    F.lds = (LAS unsigned char*)lds_raw; F.MISC = (volatile LAS unsigned*)(F.lds + MISC_OFF);
    F.tid = threadIdx.x; F.lane = F.tid & 63; F.wave = __builtin_amdgcn_readfirstlane(F.tid >> 6); F.G = gridDim.x; F.bid = blockIdx.x;
    F.ws = (unsigned char*)(GAS unsigned char*)args.ws; F.ctl = (unsigned*)(F.ws + WS_CTL);
    for (int u = F.tid; u < (LDS_BYTES - MISC_OFF) / 4; u += NTHREADS) F.MISC[u] = 0u;
    __syncthreads();
    XcdBarrier bar; bar.bar = F.ctl + CW_BAR; bar.x = 0; bar.st = nullptr;
    const int lo = args.ph_lo, hi = args.ph_hi;
    if (hi - lo > 1) bar = xcd_barrier_post(F.ctl + CW_BAR, F.MISC + 8);
#define IN(k) (launder_i(lo) <= (k) && (k) < launder_i(hi))
#define SEAM(k) do { if (IN(k) && IN((k) + 1)) xcd_barrier(bar); } while (0)
#define PH_BEGIN KArgs& KA = *kargs(); unsigned char* ws = launder_p(args.ws); F.ws = ws; (void)KA; (void)ws; { int ln_; asm volatile("v_mbcnt_lo_u32_b32 %0, -1, 0\n\tv_mbcnt_hi_u32_b32 %0, -1, %0" : "=v"(ln_)); F.lane = ln_; } F.tid = F.wave * 64 + F.lane; F.bid = launder_i((int)blockIdx.x); F.G = launder_i((int)gridDim.x);

    if (EN(100) && IN(0)) REPS(100) { PH_BEGIN p_prologue(KA, F); } SEAM(0);
    if (PROBE_PHASE == 300) { for (int q_ = 0; q_ < 20; ++q_) xcd_barrier(bar); }

#pragma unroll 1
    for (int l_ = 0; l_ < NL; ++l_) {
        const int l = launder_i(l_); const int p0 = 1 + l * NPL;
        if (EN(0) && IN(p0 + 0)) REPS(0) { PH_BEGIN
            pg8::Gemm g{D, D, D}; pg8::StaticOrder S{(const bf16*)(ws + WS_H16), (const bf16*)(ws + WS_WINT) + (size_t)l * N_IN * D, D, D, T / 256, N_IN / 256, F.G, F.bid};
            if (PROBE_PHASE == 200) { for (int q_ = 0; q_ < PROBE_REPS - 1; ++q_) { EpiNull E0{0}; pg8::gemm_phase(F.lds, F.wave * 64 + my_lane(), g, S, E0); __syncthreads(); } }
            EpiIn E{l};
            pg8::gemm_phase(F.lds, F.wave * 64 + my_lane(), g, S, E);
        } SEAM(p0 + 0);
        if (EN(1) && IN(p0 + 1)) REPS(1) { PH_BEGIN p_mix1(KA, F, l); } SEAM(p0 + 1);
        if (EN(2) && IN(p0 + 2)) REPS(2) { PH_BEGIN
            { pg8::Gemm g{S5K, 1024, 1024}; pg8::BatchOrder S{(const bf16*)(ws + WS_AOUT), (const bf16*)(ws + WS_S5BC) + (size_t)l * 16 * 256 * 1024, S5K, 1024, NCHT / 256, 1, 16, F.G, (F.bid + 192) % F.G, (size_t)NCHT * S5K, (size_t)256 * 1024};
              EpiXloc E{0}; pg8::gemm_phase(F.lds, F.wave * 64 + my_lane(), g, S, E); }
            __syncthreads();
            { pg8::Gemm g{D, D, D}; pg8::StaticOrder S{(const bf16*)(ws + WS_MEM16), (const bf16*)(ws + WS_WKT) + (size_t)l * D * D, D, D, NB * NMEM / 256, D / 256, F.G, (F.bid + 160) % F.G};
              EpiBf16 E{(unsigned)(WS_KM16 / MiB), 1.0f}; pg8::gemm_phase(F.lds, F.wave * 64 + my_lane(), g, S, E); }
            __syncthreads();
            { pg8::Gemm g{D, D, D}; pg8::StaticOrder S{(const bf16*)(ws + WS_MEM16), (const bf16*)(ws + WS_WVT) + (size_t)l * D * D, D, D, NB * NMEM / 256, D / 256, F.G, (F.bid + 144) % F.G};
              EpiVT E{0}; pg8::gemm_phase(F.lds, F.wave * 64 + my_lane(), g, S, E); }
            __syncthreads();
            { pg8::Gemm g{256, 256, 256}; pg8::StaticOrder S{(const bf16*)(ws + WS_LA16), (const bf16*)(ws + WS_LWT) + (size_t)l * 768 * 256, 256, 256, T / 256, 3, F.G, (F.bid + 128) % F.G};
              EpiLora E{l}; pg8::gemm_phase(F.lds, F.wave * 64 + my_lane(), g, S, E); }
        } SEAM(p0 + 2);
        if (EN(3) && IN(p0 + 3)) REPS(3) { PH_BEGIN
            for (int q_ = 0; q_ < ((PROBE_PHASE == 301) ? PROBE_REPS : 1); ++q_) p_s5_chain(KA, F, l);
            for (int q_ = 0; q_ < ((PROBE_PHASE == 302) ? PROBE_REPS : 1); ++q_) p_rw_chunks(KA, F, l); } SEAM(p0 + 3);
        if (EN(4) && IN(p0 + 4)) REPS(4) { PH_BEGIN
            p_chain_compose(F);
            pg8::Gemm g{S5K, S5K, S5K}; pg8::BatchOrder S{(const bf16*)(ws + WS_AOUT), (const bf16*)(ws + WS_S5BT) + (size_t)l * 16 * 1024 * S5K, S5K, S5K, NCHT / 256, 1024 / 256, 16, F.G, F.bid, (size_t)NCHT * S5K, (size_t)1024 * S5K};
            EpiS5Y E{l}; pg8::gemm_phase(F.lds, F.wave * 64 + my_lane(), g, S, E);
        } SEAM(p0 + 4);
        if (EN(5) && IN(p0 + 5)) REPS(5) { PH_BEGIN
            const int nchain = (F.G >= 128) ? 64 : 0;
            if (F.bid < nchain) { if (F.wave == 0) p_chain_blocks(F, F.bid, nchain); }
            else {
                if (nchain == 0) { p_chain_blocks(F, F.bid * NWAVES + F.wave, F.G * NWAVES); __syncthreads(); }
                pg8::Gemm g{256, 256, 256}; pg8::StaticOrder S{(const bf16*)(ws + WS_YD16), (const bf16*)(ws + WS_GLUT) + (size_t)l * 256 * 256, 256, 256, T / 256, 1, F.G - nchain, F.bid - nchain};
                EpiGlu E{l}; pg8::gemm_phase(F.lds, F.wave * 64 + my_lane(), g, S, E);
            }
        } SEAM(p0 + 5);
        if (EN(6) && IN(p0 + 6)) REPS(6) { PH_BEGIN
            for (int bb = F.bid; bb < 16 * NBLK; bb += F.G) {
                if (F.wave < 4) chain_inblock(F, bb, F.wave);
                VM_WAIT(); __syncthreads();
                rw_out_task(KA, F, l, bb * CB + F.wave);
                __syncthreads();
            }
        } SEAM(p0 + 6);
        if (EN(7) && IN(p0 + 7)) REPS(7) { PH_BEGIN
            pg8::Gemm g{D, 256, 256}; pg8::BranchOrder S{(const bf16*)(ws + WS_O16), (const bf16*)(ws + WS_BRT) + (size_t)l * 4 * D * 256, T / 256, D / 256, F.G, F.bid};
            EpiBranch E{0}; pg8::gemm_phase(F.lds, F.wave * 64 + my_lane(), g, S, E);
        } SEAM(p0 + 7);
        if (EN(8) && IN(p0 + 8)) REPS(8) { PH_BEGIN
            pg8::Gemm g{D, D, D}; pg8::StaticOrder S{(const bf16*)(ws + WS_MG16), (const bf16*)(ws + WS_WOUTT) + (size_t)l * D * D, D, D, T / 256, D / 256, F.G, F.bid};
            EpiResid E{0}; pg8::gemm_phase(F.lds, F.wave * 64 + my_lane(), g, S, E);
        } SEAM(p0 + 8);
        if (EN(9) && IN(p0 + 9)) REPS(9) { PH_BEGIN p_ln(F, kin(KA, I_LN1_G) + l * D, kin(KA, I_LN1_B) + l * D, DUMMY(9)); } SEAM(p0 + 9);
        if (EN(10) && IN(p0 + 10)) REPS(10) { PH_BEGIN
            pg8::Gemm g{D, D, D}; pg8::StaticOrder S{(const bf16*)(ws + WS_H16), (const bf16*)(ws + WS_WQT) + (size_t)l * D * D, D, D, T / 256, D / 256, F.G, F.bid};
            EpiBf16 E{(unsigned)(WS_Q16 / MiB), 0.0625f}; pg8::gemm_phase(F.lds, F.wave * 64 + my_lane(), g, S, E);
        } SEAM(p0 + 10);
        if (EN(11) && IN(p0 + 11)) REPS(11) { PH_BEGIN p_attn(F); } SEAM(p0 + 11);
        if (EN(12) && IN(p0 + 12)) REPS(12) { PH_BEGIN
            pg8::Gemm g{D, D, D}; pg8::StaticOrder S{(const bf16*)(ws + WS_AO16), (const bf16*)(ws + WS_WOT) + (size_t)l * D * D, D, D, T / 256, D / 256, F.G, F.bid};
            EpiResid E{0}; pg8::gemm_phase(F.lds, F.wave * 64 + my_lane(), g, S, E);
        } SEAM(p0 + 12);
        if (EN(13) && IN(p0 + 13)) REPS(13) { PH_BEGIN p_ln_router(KA, F, l, DUMMY(13)); } SEAM(p0 + 13);
        if (EN(14) && IN(p0 + 14)) REPS(14) { PH_BEGIN p_moe_slots(F, l, DUMMY(14) ? (rep_ + 1) : 0); } SEAM(p0 + 14);
        if (EN(15) && IN(p0 + 15)) REPS(15) { PH_BEGIN
            moe_offsets(F, l);
            pg8::Gemm g{D, D, D}; pg8::MoeOrderT<true> S{(const bf16*)(ws + WS_H16), (const bf16*)(ws + WS_W1T) + (size_t)l * NE * 2048 * D, D, D, 2048 / 256, F.G, F.bid, (size_t)2048 * D, (const LAS int*)(F.MISC + MI_TOFF), (const int*)(ws + WS_STOK)};
            if (PROBE_PHASE == 201) { for (int q_ = 0; q_ < PROBE_REPS - 1; ++q_) { EpiNull E0{0}; pg8::gemm_phase(F.lds, F.wave * 64 + my_lane(), g, S, E0); __syncthreads(); } }
            EpiSwiglu E{l}; pg8::gemm_phase(F.lds, F.wave * 64 + my_lane(), g, S, E);
        } SEAM(p0 + 15);
        if (EN(16) && IN(p0 + 16)) REPS(16) { PH_BEGIN
            moe_offsets(F, l);
            pg8::Gemm g{DFF, DFF, DFF}; pg8::MoeOrder S{(const bf16*)(ws + WS_ACT), (const bf16*)(ws + WS_W2T) + (size_t)l * NE * D * DFF, DFF, DFF, D / 256, F.G, F.bid, (size_t)D * DFF, (const LAS int*)(F.MISC + MI_TOFF), nullptr};
            EpiMoeOut E{l}; pg8::gemm_phase(F.lds, F.wave * 64 + my_lane(), g, S, E);
        } SEAM(p0 + 16);
        if (EN(17) && IN(p0 + 17)) REPS(17) { PH_BEGIN p_moe_combine(KA, F, l, DUMMY(17)); } SEAM(p0 + 17);
    }
#undef IN
#undef SEAM
}

extern "C" void kernel_launch(void* const* d_in, const int* in_sizes, int n_in, void* d_out, int out_size, void* d_ws, size_t ws_size, hipStream_t stream) {
    static int grid = 0;
    if (grid == 0) {
        if (n_in != 50 || ws_size < WS_END) { fprintf(stderr, "kernel_launch: unexpected n_in %d / ws_size %zu\n", n_in, ws_size); grid = -1; return; }
        int dev = 0, cus = 0, per_cu = 0;
        if (hipGetDevice(&dev) != hipSuccess || hipDeviceGetAttribute(&cus, hipDeviceAttributeMultiprocessorCount, dev) != hipSuccess) { grid = -1; return; }
        if (hipFuncSetAttribute((const void*)fwd_kernel, hipFuncAttributeMaxDynamicSharedMemorySize, LDS_BYTES) != hipSuccess) { fprintf(stderr, "kernel_launch: hipFuncSetAttribute failed\n"); grid = -1; return; }
        if (hipOccupancyMaxActiveBlocksPerMultiprocessor(&per_cu, (const void*)fwd_kernel, NTHREADS, LDS_BYTES) != hipSuccess || per_cu < 1) { fprintf(stderr, "kernel_launch: occupancy query says %d\n", per_cu); }
        (void)hipGetLastError();
        grid = cus;
    }
    if (grid < 0) return;
    (void)hipMemsetAsync((char*)d_ws + WS_CTL, 0, CTL_ZERO_BYTES, stream);
    Args a{};
    for (int i = 0; i < 50; ++i) a.in[i] = (const float*)d_in[i];
    a.out = (float*)d_out; a.ws = (unsigned char*)d_ws;
#if N_LAUNCHES == 1
    a.ph_lo = 0; a.ph_hi = NPHASES;
    hipLaunchKernelGGL(fwd_kernel, dim3(grid), dim3(NTHREADS), LDS_BYTES, stream, a);
#else
    for (int p = 0; p < NPHASES; ++p) { a.ph_lo = p; a.ph_hi = p + 1; hipLaunchKernelGGL(fwd_kernel, dim3(grid), dim3(NTHREADS), LDS_BYTES, stream, a); }
#endif
}
```
